# Optimizing an MI355X kernel written in HIP

```python
import math
import jax, jax.numpy as jnp
from jax import lax
import numpy as np

D_MODEL = 1024
BATCH = 8
SEQ = 4096
DEPTH = 2

EPS = 1e-6
ATT_HEAD_DIM = 64
ATT_WIDTH = D_MODEL // 2
ATT_HEADS = ATT_WIDTH // ATT_HEAD_DIM
Q_BLOCK = 128
POOL_WIDTH = D_MODEL // 4
POOL_WINDOWS = (2, 4, 8, 16)
POOL_GROUPS = len(POOL_WINDOWS)
POOL_GROUP_DIM = POOL_WIDTH // POOL_GROUPS
SSM_WIDTH = D_MODEL - ATT_WIDTH - POOL_WIDTH
SSM_GROUP_CH = 16
SSM_GROUPS = SSM_WIDTH // SSM_GROUP_CH
SSM_STATE = 64
IN_COLS = 3 * ATT_WIDTH + ATT_HEADS + POOL_WIDTH + SSM_WIDTH
IN_SPLITS = (ATT_WIDTH, 2 * ATT_WIDTH, 3 * ATT_WIDTH, 3 * ATT_WIDTH + ATT_HEADS,
             3 * ATT_WIDTH + ATT_HEADS + POOL_WIDTH)
PEER_HEADS = 8
PEER_KEYS = 128
PEER_EXPERTS = PEER_KEYS * PEER_KEYS
PEER_QDIM = 256
PEER_HALF = PEER_QDIM // 2
PEER_TOPK = 16
PEER_CHUNK = 128

kernel_name = 'hybrid_fox_pool_s5_peer'


def rms_norm(x, g):
    xf = x.astype(jnp.float32)
    y = xf * lax.rsqrt(jnp.mean(xf * xf, axis=-1, keepdims=True) + EPS)
    return (y * g.astype(jnp.float32)).astype(x.dtype)


def forgetting_attention(q, k, v, f_logit, q_gain, k_gain):
    b, s, h, dh = q.shape
    qf = rms_norm(q, q_gain).astype(jnp.float32) * (dh ** -0.5)
    kf = rms_norm(k, k_gain).astype(jnp.float32)
    vf = v.astype(jnp.float32)
    c_t = jnp.cumsum(jax.nn.log_sigmoid(f_logit.astype(jnp.float32)), axis=1).transpose(0, 2, 1)
    nb = s // Q_BLOCK
    q_blocks = qf.reshape(b, nb, Q_BLOCK, h, dh).transpose(1, 0, 2, 3, 4)
    c_blocks = c_t.reshape(b, h, nb, Q_BLOCK).transpose(2, 0, 1, 3)
    key_pos = jnp.arange(s)

    def block(args):
        i, q_i, c_i = args
        logits = jnp.einsum('bqhd,bkhd->bhqk', q_i, kf) + c_i[..., :, None] - c_t[:, :, None, :]
        q_pos = i * Q_BLOCK + jnp.arange(Q_BLOCK)
        causal = key_pos[None, :] <= q_pos[:, None]
        p = jax.nn.softmax(jnp.where(causal, logits, -jnp.inf), axis=-1)
        return jnp.einsum('bhqk,bkhd->bqhd', p, vf)

    out = lax.map(block, (jnp.arange(nb), q_blocks, c_blocks))
    return out.transpose(1, 0, 2, 3, 4).reshape(b, s, h * dh).astype(v.dtype)


def multiscale_pool(u, pool_w, pool_scale):
    b, s, _ = u.shape
    uf = u.astype(jnp.float32).reshape(b, s, POOL_GROUPS, POOL_GROUP_DIM)
    cs = jnp.pad(jnp.cumsum(uf, axis=1), ((0, 0), (1, 0), (0, 0), (0, 0)))
    pos = jnp.arange(s)
    means = []
    for g, w in enumerate(POOL_WINDOWS):
        lo = jnp.maximum(pos + 1 - w, 0)
        cnt = (pos + 1 - lo).astype(jnp.float32)[None, :, None]
        means.append((cs[:, pos + 1, g] - cs[:, lo, g]) / cnt)
    pooled = jnp.stack(means, axis=2) - uf
    mixed = jnp.einsum('bsgc,gcd->bsgd', pooled, pool_w.astype(jnp.float32)).reshape(b, s, POOL_WIDTH)
    return (mixed * pool_scale.astype(jnp.float32)).astype(u.dtype)


def s5_mixer(u, a_re, a_im, log_dt, b_re, b_im, c_re, c_im, d_skip, glu_w, glu_b):
    bsz, s, _ = u.shape
    uf = u.astype(jnp.float32).reshape(bsz, s, SSM_GROUPS, SSM_GROUP_CH)
    a = lax.complex(a_re.astype(jnp.float32), a_im.astype(jnp.float32))
    dt = jnp.exp(log_dt.astype(jnp.float32))[:, None]
    a_bar = jnp.exp(a * dt)
    b_mat = lax.complex(b_re.astype(jnp.float32), b_im.astype(jnp.float32))
    b_bar = ((a_bar - 1.0) / a)[..., None] * b_mat
    bu = jnp.einsum('bsgc,gpc->bsgp', uf.astype(jnp.complex64), b_bar)
    a_full = jnp.broadcast_to(a_bar, bu.shape)

    def combine(left, right):
        a_l, x_l = left
        a_r, x_r = right
        return a_l * a_r, a_r * x_l + x_r

    _, states = lax.associative_scan(combine, (a_full, bu), axis=1)
    c_mat = lax.complex(c_re.astype(jnp.float32), c_im.astype(jnp.float32))
    y = jnp.real(jnp.einsum('bsgp,gcp->bsgc', states, c_mat))
    y = y + d_skip.astype(jnp.float32).reshape(SSM_GROUPS, SSM_GROUP_CH) * uf
    z = jax.nn.gelu(y.reshape(bsz, s, SSM_WIDTH))
    out = z * jax.nn.sigmoid(z @ glu_w.astype(jnp.float32) + glu_b.astype(jnp.float32))
    return out.astype(u.dtype)


def mixer_sublayer(x, norm_g, w_in, f_bias, q_gain, k_gain, pool_w, pool_scale,
                   a_re, a_im, log_dt, b_re, b_im, c_re, c_im, d_skip, glu_w, glu_b,
                   out_norm_g, w_out):
    b, s, _ = x.shape
    h = rms_norm(x, norm_g)
    proj = jnp.einsum('bsd,de->bse', h, w_in)
    q, k, v, f_logit, u_pool, u_ssm = jnp.split(proj, IN_SPLITS, axis=-1)
    shp = (b, s, ATT_HEADS, ATT_HEAD_DIM)
    att = forgetting_attention(q.reshape(shp), k.reshape(shp), v.reshape(shp),
                               f_logit + f_bias, q_gain, k_gain)
    pool = multiscale_pool(u_pool, pool_w, pool_scale)
    ssm = s5_mixer(u_ssm, a_re, a_im, log_dt, b_re, b_im, c_re, c_im, d_skip, glu_w, glu_b)
    p0 = ATT_WIDTH
    p1 = ATT_WIDTH + POOL_WIDTH
    merged = jnp.concatenate([rms_norm(att, out_norm_g[:p0]),
                              rms_norm(pool, out_norm_g[p0:p1]),
                              rms_norm(ssm, out_norm_g[p1:])], axis=-1)
    return x + jnp.einsum('bse,ed->bsd', merged, w_out)


def peer_ffn(h, w_q, sub_keys, u_tab, v_tab):
    bsz, s, d = h.shape
    q = jnp.einsum('bsd,de->bse', h, w_q).astype(jnp.float32).reshape(bsz, s, PEER_HEADS, 2, PEER_HALF)
    scores = jnp.einsum('bshid,hikd->bshik', q, sub_keys.astype(jnp.float32))
    top_s, top_i = lax.top_k(scores, PEER_TOPK)
    cand = (top_s[..., 0, :, None] + top_s[..., 1, None, :]).reshape(bsz, s, PEER_HEADS, PEER_TOPK * PEER_TOPK)
    best_s, best_j = lax.top_k(cand, PEER_TOPK)
    i1 = jnp.take_along_axis(top_i[..., 0, :], best_j // PEER_TOPK, axis=-1)
    i2 = jnp.take_along_axis(top_i[..., 1, :], best_j % PEER_TOPK, axis=-1)
    experts = i1 * PEER_KEYS + i2
    gates = jax.nn.softmax(best_s, axis=-1)
    n_chunks = (bsz * s) // PEER_CHUNK
    hk = PEER_HEADS * PEER_TOPK
    h_c = h.astype(jnp.float32).reshape(n_chunks, PEER_CHUNK, d)
    e_c = experts.reshape(n_chunks, PEER_CHUNK, hk)
    g_c = gates.reshape(n_chunks, PEER_CHUNK, hk)

    def chunk(args):
        hh, ee, gg = args
        u_sel = u_tab[ee].astype(jnp.float32)
        v_sel = v_tab[ee].astype(jnp.float32)
        act = jax.nn.gelu(jnp.einsum('td,tkd->tk', hh, u_sel))
        return jnp.einsum('tk,tkd->td', gg * act, v_sel)

    out = lax.map(chunk, (h_c, e_c, g_c))
    return out.reshape(bsz, s, d).astype(h.dtype)


def setup_inputs(seed: int = 0) -> dict:
    key = jax.random.key(seed)
    ks = jax.random.split(key, 26)
    L, D = DEPTH, D_MODEL
    f32 = jnp.float32

    def nrm(k, shape, scale):
        return jax.random.normal(k, shape, f32) * scale

    def gain(k, shape):
        return 1.0 + 0.05 * jax.random.normal(k, shape, f32)

    n_idx = jnp.arange(SSM_STATE, dtype=f32)
    return {
        'x': nrm(ks[0], (BATCH, SEQ, D), 1.0),
        'norm1_g': gain(ks[1], (L, D)),
        'w_in': nrm(ks[2], (L, D, IN_COLS), D ** -0.5),
        'f_bias': jax.random.uniform(ks[3], (L, ATT_HEADS), f32, 1.0, 5.0),
        'q_gain': gain(ks[4], (L, ATT_HEAD_DIM)),
        'k_gain': gain(ks[5], (L, ATT_HEAD_DIM)),
        'pool_w': nrm(ks[6], (L, POOL_GROUPS, POOL_GROUP_DIM, POOL_GROUP_DIM), POOL_GROUP_DIM ** -0.5),
        'pool_scale': gain(ks[7], (L, POOL_WIDTH)),
        'ssm_a_re': -0.5 + 0.01 * jax.random.normal(ks[8], (L, SSM_GROUPS, SSM_STATE), f32),
        'ssm_a_im': math.pi * n_idx + 0.01 * jax.random.normal(ks[9], (L, SSM_GROUPS, SSM_STATE), f32),
        'ssm_log_dt': jax.random.uniform(ks[10], (L, SSM_GROUPS), f32, math.log(1e-3), math.log(1e-1)),
        'ssm_b_re': nrm(ks[11], (L, SSM_GROUPS, SSM_STATE, SSM_GROUP_CH), (2 * SSM_GROUP_CH) ** -0.5),
        'ssm_b_im': nrm(ks[12], (L, SSM_GROUPS, SSM_STATE, SSM_GROUP_CH), (2 * SSM_GROUP_CH) ** -0.5),
        'ssm_c_re': nrm(ks[13], (L, SSM_GROUPS, SSM_GROUP_CH, SSM_STATE), 0.5),
        'ssm_c_im': nrm(ks[14], (L, SSM_GROUPS, SSM_GROUP_CH, SSM_STATE), 0.5),
        'ssm_d': gain(ks[15], (L, SSM_WIDTH)),
        'glu_w': nrm(ks[16], (L, SSM_WIDTH, SSM_WIDTH), SSM_WIDTH ** -0.5),
        'glu_b': nrm(ks[17], (L, SSM_WIDTH), 0.01),
        'out_norm_g': gain(ks[18], (L, D)),
        'w_out': nrm(ks[19], (L, D, D), D ** -0.5),
        'norm2_g': gain(ks[20], (L, D)),
        'peer_wq': nrm(ks[21], (L, D, PEER_HEADS * PEER_QDIM), D ** -0.5),
        'peer_keys': nrm(ks[22], (L, PEER_HEADS, 2, PEER_KEYS, PEER_HALF), PEER_HALF ** -0.5),
        'peer_u': nrm(ks[23], (L, PEER_EXPERTS, D), D ** -0.5),
        'peer_v': nrm(ks[24], (L, PEER_EXPERTS, D), PEER_HEADS ** -0.5),
    }


def reference(x, norm1_g, w_in, f_bias, q_gain, k_gain, pool_w, pool_scale,
              ssm_a_re, ssm_a_im, ssm_log_dt, ssm_b_re, ssm_b_im, ssm_c_re, ssm_c_im,
              ssm_d, glu_w, glu_b, out_norm_g, w_out, norm2_g,
              peer_wq, peer_keys, peer_u, peer_v):
    for l in range(DEPTH):
        x = mixer_sublayer(x, norm1_g[l], w_in[l], f_bias[l], q_gain[l], k_gain[l],
                           pool_w[l], pool_scale[l], ssm_a_re[l], ssm_a_im[l], ssm_log_dt[l],
                           ssm_b_re[l], ssm_b_im[l], ssm_c_re[l], ssm_c_im[l], ssm_d[l],
                           glu_w[l], glu_b[l], out_norm_g[l], w_out[l])
        x = x + peer_ffn(rms_norm(x, norm2_g[l]), peer_wq[l], peer_keys[l], peer_u[l], peer_v[l])
    return x
```

```cpp
#include <hip/hip_runtime.h>
#include <hip/hip_bf16.h>
#include <hip/hip_fp16.h>
#include <cstdio>
#include <cstdint>
#include <cmath>
#ifndef MK_ONE_LAUNCH
#define MK_ONE_LAUNCH 1
#endif
#ifndef ATT_SKIP
#define ATT_SKIP true
#endif
#ifndef PH_MASK
#define PH_MASK 0xffffffffu
#endif
__device__ __forceinline__ int otid() { int t = threadIdx.x; asm volatile("" : "+v"(t)); return t; }
#ifndef GATHER_NAIVE
#define GATHER_NAIVE 0
#endif
namespace pg8 {
#define PG8_LAS __attribute__((address_space(3)))
typedef unsigned short bf16_t;
typedef short bf16x8 __attribute__((ext_vector_type(8)));
typedef float f32x4 __attribute__((ext_vector_type(4)));
typedef unsigned u32x4 __attribute__((ext_vector_type(4)));
constexpr int BM = 256, BK = 64, HALF = 128, HTB = HALF * BK * 2  , STAGE_BYTES = 8 * HTB, NXCD = 8, WGM = 8;

__host__ __device__ __forceinline__ int lds_byte(int r, int c) { const int st = (r >> 4) * 2 + (c >> 5), rr = r & 15, cc = c & 31, ob = rr * 64 + cc * 2; return st * 1024 + (ob ^ (((ob >> 9) & 1) << 5)); }
__host__ __device__ __forceinline__ void stage_rc(int b, int& R, int& C) { const int st = b / 1024, sb = b % 1024, swz = sb ^ (((sb >> 9) & 1) << 5); R = (st >> 1) * 16 + swz / 64; C = (st & 1) * 32 + (swz % 64) / 2; }
__host__ __device__ __forceinline__ int perm32(int rho) { const int n = rho >> 4, i = rho & 15; return 8 * (i >> 2) + 4 * n + (i & 3); }

struct Unit { int pm, pn; };
struct Gemm { const bf16_t* A; const bf16_t* Bt; int M, N, K; };

struct StaticOrder {
    int nM, nN, nwg, G, c;
    __host__ __device__ void init(int M, int N, int G_, int c_) { nM = M / BM; nN = N / BM; nwg = nM * nN; G = G_; c = c_; }
    __host__ __device__ bool next(int i, Unit& u) const {
        const long L = (long)i * G + c; if (L >= nwg) return false;
        int wgid = (int)L; { const int q = nwg / NXCD, r = nwg % NXCD, xcd = wgid % NXCD, off = wgid / NXCD; wgid = (xcd < r ? xcd * (q + 1) : r * (q + 1) + (xcd - r) * q) + off; }
        const int nig = WGM * nN, gid = wgid / nig, fm = gid * WGM, gsz = (nM - fm) < WGM ? (nM - fm) : WGM;
        u.pm = fm + ((wgid % nig) % gsz); u.pn = (wgid % nig) / gsz; return true;
    }
    __device__ __forceinline__ void a_ready(const Unit&) const {}
    __device__ __forceinline__ void done(const Unit&) const {}
};

__device__ __forceinline__ unsigned cvt_pk_bf16(float lo, float hi) { unsigned r; asm volatile("v_cvt_pk_bf16_f32 %0, %1, %2" : "=v"(r) : "v"(lo), "v"(hi)); return r; }
typedef float f32x2 __attribute__((ext_vector_type(2)));
__device__ __forceinline__ f32x2 gelu_pk(f32x2 v) {
    const f32x2 av = __builtin_elementwise_abs(v), d = av * 0.2316418882f + 1.0f;
    f32x2 t; t.x = __builtin_amdgcn_rcpf(d.x); t.y = __builtin_amdgcn_rcpf(d.y);
    f32x2 q = t * 0.5307027145f + (-0.7265760135f); q = q * t + 0.7107068705f; q = q * t + (-0.142248368f); q = q * t + 0.127414796f; q = q * t;
    const f32x2 s = (v * v) * (-0.72134752044f);
    f32x2 e; e.x = __builtin_amdgcn_exp2f(s.x); e.y = __builtin_amdgcn_exp2f(s.y);
    const f32x2 m = v * (q * e), r = v - m;
    f32x2 o; o.x = v.x < 0.f ? m.x : r.x; o.y = v.y < 0.f ? m.y : r.y; return o;
}

template <int ACT  > struct EpiBf16 {
    static constexpr bool PERM = true, AFTER_DRAIN = false; static_assert(ACT == 0 || ACT == 1, "EpiBf16: ACT is 0 (none) or 1 (gelu_pk)");
    bf16_t* O; int ldc; const float* bias; int split_cols; size_t split_stride; float scale0;
    __device__ __forceinline__ void operator()(const f32x4 (&acc)[2][2][4][2], const Unit& u, int wr, int wc, int fr, int fq) const {
        const int row0 = u.pm * BM + wr * 64 + fr; int colt = u.pn * BM; bf16_t* base = O;
        float sc = 1.f; if (split_cols) { const int t = colt / split_cols; base += (size_t)t * split_stride; colt -= t * split_cols; if (t == 0) sc = scale0; }
        const int col0 = colt + wc * 32 + 8 * fq, bcol0 = u.pn * BM + wc * 32 + 8 * fq;
        f32x4 bv[2][2];
#pragma unroll
        for (int bj = 0; bj < 2; ++bj)
#pragma unroll
            for (int n = 0; n < 2; ++n) bv[bj][n] = bias ? *(const f32x4*)(bias + bcol0 + bj * HALF + 4 * n) : (f32x4){0.f, 0.f, 0.f, 0.f};
#pragma unroll
        for (int ai = 0; ai < 2; ++ai)
#pragma unroll
            for (int m = 0; m < 4; ++m) { bf16_t* rowp = base + (size_t)(row0 + ai * HALF + m * 16) * ldc + col0;
#pragma unroll
                for (int bj = 0; bj < 2; ++bj) { f32x4 v0 = acc[ai][bj][m][0] + bv[bj][0], v1 = acc[ai][bj][m][1] + bv[bj][1];
                    if (ACT == 1) { f32x2 a = gelu_pk((f32x2){v0[0], v0[1]}), b = gelu_pk((f32x2){v0[2], v0[3]}), c = gelu_pk((f32x2){v1[0], v1[1]}), d = gelu_pk((f32x2){v1[2], v1[3]});
                        v0 = (f32x4){a.x, a.y, b.x, b.y}; v1 = (f32x4){c.x, c.y, d.x, d.y}; }
                    v0 = v0 * sc; v1 = v1 * sc; u32x4 w; w.x = cvt_pk_bf16(v0[0], v0[1]); w.y = cvt_pk_bf16(v0[2], v0[3]); w.z = cvt_pk_bf16(v1[0], v1[1]); w.w = cvt_pk_bf16(v1[2], v1[3]);
                    *(u32x4*)(rowp + bj * HALF) = w; } }
    }
};
struct EpiResF32 {
    static constexpr bool PERM = false, AFTER_DRAIN = false;
    const float* base; float* out; int ldc;
    __device__ __forceinline__ void operator()(const f32x4 (&acc)[2][2][4][2], const Unit& u, int wr, int wc, int fr, int fq) const {
        const int col0 = u.pn * BM + wc * 32 + 4 * fq;
#pragma unroll
        for (int ai = 0; ai < 2; ++ai)
#pragma unroll
            for (int m = 0; m < 4; ++m) { const size_t off = (size_t)(u.pm * BM + ai * HALF + wr * 64 + m * 16 + fr) * ldc + col0;
#pragma unroll
                for (int bj = 0; bj < 2; ++bj)
#pragma unroll
                    for (int n = 0; n < 2; ++n) { const f32x4 bs = *(const f32x4*)(base + off + bj * HALF + n * 16); *(f32x4*)(out + off + bj * HALF + n * 16) = bs + acc[ai][bj][m][n]; } }
    }
};
template <class Epi, class Sched, bool ALIGN_EPI = false, bool SP2 = false>
__device__ __forceinline__ void gemm_phase(PG8_LAS unsigned char* lds, const Gemm g, const Sched& S, const Epi& E) {
    const int tid = otid(), wid = __builtin_amdgcn_readfirstlane(tid >> 6), lane = tid & 63, wr = wid >> 2, wc = wid & 3, fr = lane & 15, fq = lane >> 4;
    const int K = g.K, nt = K / BK;
    unsigned voffA[2], voffB[2];
#pragma unroll
    for (int i = 0; i < 2; ++i) { int R, C; stage_rc(tid * 16 + i * 8192, R, C); const int Rb = Epi::PERM ? ((R & ~31) + perm32(R & 31)) : R;
        voffA[i] = (unsigned)(R * K + C) * 2u; voffB[i] = (unsigned)(Rb * K + C) * 2u; }
    const size_t kstep = (size_t)(BK * 2);
    const size_t hstep = (size_t)HALF * K * 2;
    const size_t tstep = 2 * hstep;
    const unsigned ldsw = (unsigned)wid * 1024u;
    const int aoff = lds_byte(wr * 64 + fr, fq * 8), boff = lds_byte(wc * 32 + fr, fq * 8);
#define PG8_SA(b, h) (((b) * 2 + (h)) * HTB)
#define PG8_SB(b, h) ((4 + (b) * 2 + (h)) * HTB)
#define PG8_STAGE(bufoff, gbase, voff) do { _Pragma("unroll") for (int _i = 0; _i < 2; ++_i) \
        __builtin_amdgcn_global_load_lds((const unsigned*)((const char*)(gbase) + (voff)[_i]), (PG8_LAS unsigned*)(lds + (bufoff) + ldsw + _i * 8192), 16, 0, 0); } while (0)
#define PG8_LDA(dst, b, h) do { _Pragma("unroll") for (int m = 0; m < 4; ++m) _Pragma("unroll") for (int k = 0; k < 2; ++k) dst[m][k] = *(const PG8_LAS bf16x8*)(lds + PG8_SA(b, h) + aoff + m * 2048 + k * 1024); } while (0)
#define PG8_LDB(dst, b, h) do { _Pragma("unroll") for (int n = 0; n < 2; ++n) _Pragma("unroll") for (int k = 0; k < 2; ++k) dst[n][k] = *(const PG8_LAS bf16x8*)(lds + PG8_SB(b, h) + boff + n * 2048 + k * 1024); } while (0)
#define PG8_MMA(ai, bj, At, Bt) do { __builtin_amdgcn_s_setprio(1); _Pragma("unroll") for (int m = 0; m < 4; ++m) _Pragma("unroll") for (int n = 0; n < 2; ++n) _Pragma("unroll") for (int k = 0; k < 2; ++k) \
        acc[ai][bj][m][n] = __builtin_amdgcn_mfma_f32_16x16x32_bf16(Bt[n][k], At[m][k], acc[ai][bj][m][n], 0, 0, 0); __builtin_amdgcn_s_setprio(0); } while (0)
#define PG8_WAIT_V(n) asm volatile("s_waitcnt vmcnt(" #n ")" ::: "memory")
#define PG8_WAIT_L(n) asm volatile("s_waitcnt lgkmcnt(" #n ")" ::: "memory")
#define PG8_BAR __builtin_amdgcn_s_barrier()
#define PG8_SCHED __builtin_amdgcn_sched_barrier(0)
    Unit cur, nxt; int ui = 0;
    if (!S.next(0, cur)) return;
    f32x4 acc[2][2][4][2];
#pragma unroll
    for (int a = 0; a < 2; ++a)
#pragma unroll
        for (int b = 0; b < 2; ++b)
#pragma unroll
            for (int m = 0; m < 4; ++m)
#pragma unroll
                for (int n = 0; n < 2; ++n) acc[a][b][m][n] = (f32x4){0.f, 0.f, 0.f, 0.f};
    bf16x8 At[4][2], B0[2][2], B1[2][2];
    const char* cA = (const char*)g.A + (size_t)cur.pm * tstep; const char* cB = (const char*)g.Bt + (size_t)cur.pn * tstep;
    S.a_ready(cur);
    if constexpr (SP2) {
        PG8_STAGE(PG8_SB(0, 0), cB, voffB); PG8_STAGE(PG8_SB(0, 1), cB + hstep, voffB); PG8_STAGE(PG8_SA(0, 0), cA, voffA); PG8_STAGE(PG8_SA(0, 1), cA + hstep, voffA);
        if (wr == 1) PG8_BAR;
        PG8_WAIT_V(2); PG8_BAR;
        PG8_STAGE(PG8_SB(1, 0), cB + kstep, voffB); PG8_STAGE(PG8_SA(1, 0), cA + kstep, voffA); PG8_STAGE(PG8_SB(1, 1), cB + hstep + kstep, voffB);
        PG8_WAIT_V(6); PG8_BAR;
    } else {
        PG8_STAGE(PG8_SB(0, 0), cB, voffB); PG8_STAGE(PG8_SA(0, 0), cA, voffA); PG8_STAGE(PG8_SB(0, 1), cB + hstep, voffB); PG8_STAGE(PG8_SA(0, 1), cA + hstep, voffA);
        if (wr == 1) PG8_BAR;
        PG8_WAIT_V(4); PG8_BAR;
        PG8_STAGE(PG8_SB(1, 0), cB + kstep, voffB); PG8_STAGE(PG8_SA(1, 0), cA + kstep, voffA); PG8_STAGE(PG8_SB(1, 1), cB + hstep + kstep, voffB);
        PG8_WAIT_V(6); PG8_BAR;
    }
    for (;;) {
        const bool has_next = S.next(ui + 1, nxt);
        const char* nA = has_next ? (const char*)g.A + (size_t)nxt.pm * tstep : cA; const char* nB = has_next ? (const char*)g.Bt + (size_t)nxt.pn * tstep : cB;
        for (int t = 0; t < nt; t += 2) {
            const bool last = (t == nt - 2);
            const char* a1 = cA + (size_t)(t + 1) * kstep;
            const char* a2 = last ? nA : cA + (size_t)(t + 2) * kstep; const char* b2 = last ? nB : cB + (size_t)(t + 2) * kstep;
            const char* a3 = a2 + kstep; const char* b3 = b2 + kstep;
            if (last && has_next) S.a_ready(nxt);
            if constexpr (SP2) {
            PG8_LDB(B0, 0, 0); PG8_LDB(B1, 0, 1); PG8_SCHED; PG8_LDA(At, 0, 0); PG8_STAGE(PG8_SA(1, 1), a1 + hstep, voffA);
            PG8_WAIT_V(8); PG8_WAIT_L(0); PG8_BAR; PG8_MMA(0, 0, At, B0); PG8_MMA(0, 1, At, B1); PG8_BAR; PG8_SCHED;
            PG8_LDA(At, 0, 1); PG8_STAGE(PG8_SB(0, 0), b2, voffB); PG8_STAGE(PG8_SB(0, 1), b2 + hstep, voffB); PG8_STAGE(PG8_SA(0, 0), a2, voffA);
            PG8_WAIT_V(8); PG8_WAIT_L(0); PG8_BAR; PG8_MMA(1, 0, At, B0); PG8_MMA(1, 1, At, B1); PG8_BAR; PG8_SCHED;
            PG8_LDB(B0, 1, 0); PG8_LDB(B1, 1, 1); PG8_SCHED; PG8_LDA(At, 1, 0); PG8_STAGE(PG8_SA(0, 1), a2 + hstep, voffA);
            PG8_WAIT_V(8); PG8_WAIT_L(0); PG8_BAR; PG8_MMA(0, 0, At, B0); PG8_MMA(0, 1, At, B1); PG8_BAR; PG8_SCHED;
            PG8_LDA(At, 1, 1); PG8_STAGE(PG8_SB(1, 0), b3, voffB); PG8_STAGE(PG8_SB(1, 1), b3 + hstep, voffB); PG8_STAGE(PG8_SA(1, 0), a3, voffA);
            PG8_WAIT_V(8); PG8_WAIT_L(0); PG8_BAR; PG8_MMA(1, 0, At, B0); PG8_MMA(1, 1, At, B1); PG8_BAR; PG8_SCHED;
            } else {
            PG8_LDB(B0, 0, 0); PG8_SCHED; PG8_LDA(At, 0, 0); PG8_STAGE(PG8_SA(1, 1), a1 + hstep, voffA);
            PG8_WAIT_L(8); PG8_BAR; PG8_WAIT_L(0); PG8_MMA(0, 0, At, B0); PG8_BAR; PG8_SCHED;
            PG8_LDB(B1, 0, 1); PG8_STAGE(PG8_SB(0, 0), b2, voffB);
            PG8_BAR; PG8_WAIT_L(0); PG8_MMA(0, 1, At, B1); PG8_BAR;
            PG8_LDA(At, 0, 1); PG8_STAGE(PG8_SA(0, 0), a2, voffA);
            PG8_BAR; PG8_WAIT_L(0); PG8_MMA(1, 0, At, B0); PG8_BAR; PG8_SCHED;
            PG8_STAGE(PG8_SB(0, 1), b2 + hstep, voffB);
            PG8_WAIT_V(6); PG8_BAR; PG8_MMA(1, 1, At, B1); PG8_BAR;
            PG8_LDB(B0, 1, 0); PG8_SCHED; PG8_LDA(At, 1, 0); PG8_STAGE(PG8_SA(0, 1), a2 + hstep, voffA);
            PG8_WAIT_L(8); PG8_BAR; PG8_WAIT_L(0); PG8_MMA(0, 0, At, B0); PG8_BAR; PG8_SCHED;
            PG8_LDB(B1, 1, 1); PG8_STAGE(PG8_SB(1, 0), b3, voffB);
            PG8_BAR; PG8_WAIT_L(0); PG8_MMA(0, 1, At, B1); PG8_BAR;
            PG8_LDA(At, 1, 1); PG8_STAGE(PG8_SA(1, 0), a3, voffA);
            PG8_BAR; PG8_WAIT_L(0); PG8_MMA(1, 0, At, B0); PG8_BAR; PG8_SCHED;
            PG8_STAGE(PG8_SB(1, 1), b3 + hstep, voffB);
            PG8_WAIT_V(6); PG8_BAR; PG8_MMA(1, 1, At, B1); PG8_BAR;
            }
        }
        if constexpr (ALIGN_EPI) { if (wr == 0) PG8_BAR; }
        if constexpr (!Epi::AFTER_DRAIN) { E(acc, cur, wr, wc, fr, fq); S.done(cur); }
        if (!has_next) break;
#pragma unroll
        for (int a = 0; a < 2; ++a)
#pragma unroll
            for (int b = 0; b < 2; ++b)
#pragma unroll
                for (int m = 0; m < 4; ++m)
#pragma unroll
                    for (int n = 0; n < 2; ++n) acc[a][b][m][n] = (f32x4){0.f, 0.f, 0.f, 0.f};
        cur = nxt; cA = nA; cB = nB; ++ui;
        if constexpr (ALIGN_EPI) { if (wr == 1) PG8_BAR; }
    }
    PG8_WAIT_V(0);
    if constexpr (!ALIGN_EPI) { if (wr == 0) PG8_BAR; }
    PG8_BAR;
    if constexpr (Epi::AFTER_DRAIN) { E.fused(acc, cur, wr, wc, fr, fq, lds, wid, lane); S.done(cur); }
#undef PG8_SA
#undef PG8_SB
#undef PG8_STAGE
#undef PG8_LDA
#undef PG8_LDB
#undef PG8_MMA
#undef PG8_WAIT_V
#undef PG8_WAIT_L
#undef PG8_BAR
#undef PG8_SCHED
}
}
#include <hip/hip_bf16.h>
#include <cmath>
namespace attn_body {
using bf16=__hip_bfloat16;
using bf16x8=__attribute__((ext_vector_type(8)))short;
using s16x4=__attribute__((ext_vector_type(4)))short;
using f32x16=__attribute__((ext_vector_type(16)))float;
using u32x4=__attribute__((ext_vector_type(4)))unsigned;
using f32x4v=__attribute__((ext_vector_type(4)))float;
constexpr int BATCH=8,NHEAD=8,SEQ=4096,D=64,DM=NHEAD*D,OPITCH=1024;
constexpr int NW=8,QBLK=32,QB=QBLK*NW,KVBLK=64,NQB=SEQ/QB;
constexpr int ATTN_PITCH=DM, ATTN_UNIT_ROWS=QB;
__device__ __forceinline__ int crow(int r,int hi){return (r&3)+8*(r>>2)+4*hi;}
#define SBAR() __builtin_amdgcn_sched_barrier(0)
__device__ __forceinline__ void cmask(f32x16&p0,f32x16&p1,int jb,int qrel,int hi){
  const float NEG=-INFINITY; int kb=64*jb+4*hi;
  #pragma unroll
  for(int r=0;r<16;++r){int kv=kb+(r&3)+8*(r>>2); if(kv>qrel)p0[r]=NEG; if(kv+32>qrel)p1[r]=NEG;}
}

constexpr int NSLOT=3, SLOTB=8192;
constexpr int LDS_K=0, LDS_V=NSLOT*SLOTB, LDS_WS=2*NSLOT*SLOTB, LDS_OST=LDS_WS+NW*64*4, LDS_BYTES=LDS_OST+NW*4096, LDS_BIAS=LDS_BYTES, LDS_TOTAL=LDS_BIAS+SEQ*4;
constexpr float C2=0.125f*1.4426950408889634f;
__device__ __forceinline__ void glds16(const void*sbase,unsigned voff,unsigned lds_dst){unsigned keep;
  asm volatile("s_mov_b32 %0, m0\n\ts_mov_b32 m0, %3\n\ts_nop 0\n\tglobal_load_lds_dwordx4 %1, %2\n\ts_mov_b32 m0, %0":"=&s"(keep):"v"(voff),"s"(sbase),"s"(lds_dst):"memory");}
__device__ __forceinline__ float max3f(float a,float b,float c){float r;asm("v_max3_f32 %0, %1, %2, %3":"=v"(r):"v"(a),"v"(b),"v"(c));return r;}
__device__ __forceinline__ float max2f(float a,float b){float r;asm("v_max_f32_e32 %0, %1, %2":"=v"(r):"v"(a),"v"(b));return r;}
__device__ __forceinline__ float fadd_s(float a,float b){float r;asm("v_add_f32_e32 %0, %1, %2":"=v"(r):"v"(a),"v"(b));return r;}
__device__ __forceinline__ float fsub_s(float a,float b){float r;asm("v_sub_f32_e32 %0, %1, %2":"=v"(r):"v"(a),"v"(b));return r;}
typedef float f32x2_t __attribute__((ext_vector_type(2))); typedef __bf16 bf16x2_t __attribute__((ext_vector_type(2)));
__device__ __forceinline__ unsigned cvtpk_s(float lo,float hi){f32x2_t v={lo,hi};bf16x2_t b=__builtin_convertvector(v,bf16x2_t);return __builtin_bit_cast(unsigned,b);}
#define WAIT_BAR(N) asm volatile("s_waitcnt vmcnt(" #N ") lgkmcnt(0)\n\ts_barrier":::"memory")

__device__ __forceinline__ void qkt(f32x16&p0,f32x16&p1,const __attribute__((address_space(3))) char*kb,const bf16x8*qr){
  #pragma unroll
  for(int d0=0;d0<4;++d0){
    const bf16x8 b0=*(const __attribute__((address_space(3))) bf16x8*)(kb+d0*2048);
    const bf16x8 b1=*(const __attribute__((address_space(3))) bf16x8*)(kb+d0*2048+512);
    p0=__builtin_amdgcn_mfma_f32_32x32x16_bf16(b0,qr[d0],p0,0,0,0);p1=__builtin_amdgcn_mfma_f32_32x32x16_bf16(b1,qr[d0],p1,0,0,0);}
}
typedef __attribute__((address_space(3))) const char* lds_cptr;
typedef short v4i16_t __attribute__((ext_vector_type(4)));
__device__ __forceinline__ void kload8(bf16x8*kf,lds_cptr kp){
  kf[0]=*(const __attribute__((address_space(3))) bf16x8*)(kp);      kf[1]=*(const __attribute__((address_space(3))) bf16x8*)(kp+512);
  kf[2]=*(const __attribute__((address_space(3))) bf16x8*)(kp+2048); kf[3]=*(const __attribute__((address_space(3))) bf16x8*)(kp+2560);
  kf[4]=*(const __attribute__((address_space(3))) bf16x8*)(kp+4096); kf[5]=*(const __attribute__((address_space(3))) bf16x8*)(kp+4608);
  kf[6]=*(const __attribute__((address_space(3))) bf16x8*)(kp+6144); kf[7]=*(const __attribute__((address_space(3))) bf16x8*)(kp+6656);
}
__device__ __forceinline__ void kload2(bf16x8*kf,lds_cptr kp,int j){ kf[2*j]=*(const __attribute__((address_space(3))) bf16x8*)(kp+j*2048); kf[2*j+1]=*(const __attribute__((address_space(3))) bf16x8*)(kp+j*2048+512); }
__device__ __forceinline__ s16x4 vtr(lds_cptr p){ return __builtin_bit_cast(s16x4,__builtin_amdgcn_ds_read_tr16_b64_v4i16((__attribute__((address_space(3))) v4i16_t*)p)); }
__device__ __forceinline__ float rowmax(const f32x16&p0,const f32x16&p1){
  float a=max3f(p0[0],p0[1],p1[0]),b=max3f(p0[2],p0[3],p1[1]);a=max3f(a,p1[2],p1[3]);
  #pragma unroll
  for(int r=4;r<16;r+=4){a=max3f(a,p0[r],p0[r+1]);b=max3f(b,p0[r+2],p0[r+3]);a=max3f(a,p1[r],p1[r+1]);b=max3f(b,p1[r+2],p1[r+3]);}
  const float m=max2f(a,b);
  auto rr=__builtin_amdgcn_permlane32_swap(__float_as_uint(m),__float_as_uint(m),false,false);
  return max2f(__uint_as_float(rr[0]),__uint_as_float(rr[1]));
}
__device__ __forceinline__ void pv(f32x16*o,int vb,bf16x8 pa0,bf16x8 pa1,bf16x8 pa2,bf16x8 pa3){
  #pragma unroll
  for(int d0=0;d0<2;++d0){s16x4 lo[4],hi[4];
    #pragma unroll
    for(int ks=0;ks<4;++ks){
      asm volatile("ds_read_b64_tr_b16 %0,%1 offset:%c2":"=&v"(lo[ks]):"v"(vb),"i"(d0*4096+ks*1024):"memory");
      asm volatile("ds_read_b64_tr_b16 %0,%1 offset:%c2":"=&v"(hi[ks]):"v"(vb),"i"(d0*4096+ks*1024+512):"memory");}
    asm volatile("s_waitcnt lgkmcnt(0)":::"memory");SBAR();
    #define PK(k) (bf16x8){lo[k][0],lo[k][1],lo[k][2],lo[k][3],hi[k][0],hi[k][1],hi[k][2],hi[k][3]}
    o[d0]=__builtin_amdgcn_mfma_f32_32x32x16_bf16(pa0,PK(0),o[d0],0,0,0);
    o[d0]=__builtin_amdgcn_mfma_f32_32x32x16_bf16(pa1,PK(1),o[d0],0,0,0);
    o[d0]=__builtin_amdgcn_mfma_f32_32x32x16_bf16(pa2,PK(2),o[d0],0,0,0);
    o[d0]=__builtin_amdgcn_mfma_f32_32x32x16_bf16(pa3,PK(3),o[d0],0,0,0);
    #undef PK
  }
}

#ifndef ATTN_STORE16
#define ATTN_STORE16(p,v) (*(u32x4*)(p)=(v))
#endif
template<bool SKIP> __device__ __forceinline__ void attn_unit(int b,int h,int qb,const bf16*Q,const bf16*__restrict__ K,const bf16*__restrict__ V,bf16*O,const float*__restrict__ CB,float qkb,char*shm){
  const int tid=otid(),lane=tid&63,r32=lane&31,hi=lane>>5; const int wid=__builtin_amdgcn_readfirstlane(tid>>6);
  const long rowbase=(long)b*SEQ; const int q0=qb*QB;
  const float*cb=CB+(long)(b*NHEAD+h)*SEQ;
  int t0=0;
  if(SKIP){ const int NTf=(q0+QB)/KVBLK; const float thr=2.f*qkb+40.f; const float cq0=cb[q0];
    bool pred=false; if(lane<NTf-4){ pred=(cq0-cb[64*lane+63])<-thr; }
    const unsigned long long mk=__ballot(pred); t0=(int)__builtin_ctzll(~mk); t0&=~1; t0=__builtin_amdgcn_readfirstlane(t0); }
  const int kv0=t0*KVBLK;
  const int NT=(q0+QB)/KVBLK-t0;
  { __attribute__((address_space(3))) float*bl=(__attribute__((address_space(3))) float*)((lds_cptr)shm+LDS_BIAS); const float*cbk=cb+kv0; for(int i=tid;i<NT*KVBLK;i+=NW*64) bl[i]=-*(const float*)((const char*)cbk+(unsigned)(i*4)); }
  const float negm0=*(const float*)((const char*)(cb+q0+wid*QBLK)+(unsigned)((lane&31)*4))-qkb;
  const bf16*Qw=Q+(rowbase+q0+wid*QBLK)*DM+h*D;
  const bf16*Kh=K+(rowbase+kv0)*DM+h*D,*Vh=V+(rowbase+kv0)*DM+h*D;
  const unsigned lds0=(unsigned)(uintptr_t)shm;
  const unsigned koff=(unsigned)(lane*DM+wid*8)*2u;
  const unsigned voff=(unsigned)((16*(wid&3)+(lane>>2))*DM+(wid>>2)*32+(lane&3)*8)*2u;
  const unsigned kdst=lds0+LDS_K+wid*1024, vdst=lds0+LDS_V+wid*1024;
  #define DMA_K(t,slot) glds16(Kh+(long)(t)*KVBLK*DM,koff,(unsigned)__builtin_amdgcn_readfirstlane(kdst+(slot)))
  #define DMA_V(t,slot) glds16(Vh+(long)(t)*KVBLK*DM,voff,(unsigned)__builtin_amdgcn_readfirstlane(vdst+(slot)))
  bf16x8 kf[8];
  const lds_cptr shm3=(lds_cptr)shm; __attribute__((address_space(3))) float*const wsf=(__attribute__((address_space(3))) float*)(shm3+LDS_WS)+wid*64;
  const lds_cptr kp0=shm3+LDS_K+hi*1024+r32*16; const lds_cptr vp0=shm3+LDS_V+((lane>>4)&1)*32+(lane&3)*8+(4*hi+((lane&15)>>2))*64;
  DMA_K(0,0);DMA_V(0,0);DMA_K(1,SLOTB);
  bf16x8 qr[4];
  #pragma unroll
  for(int d0=0;d0<4;++d0)qr[d0]=*reinterpret_cast<const bf16x8*>((const char*)Qw+(unsigned)((r32*DM+d0*16+hi*8)*2));
  float l_reg=0.f;f32x16 o[2];o[0]=f32x16{};o[1]=f32x16{};
  const __attribute__((address_space(3))) char* bl3=(const __attribute__((address_space(3))) char*)shm+LDS_BIAS+hi*16;
  #define BINIT_ALL(P0,P1,t) do{ const __attribute__((address_space(3))) f32x4v* bp_=(const __attribute__((address_space(3))) f32x4v*)(bl3+(t)*256); \
    _Pragma("unroll") for(int g_=0;g_<4;++g_){ const f32x4v x0_=bp_[2*g_], x1_=bp_[8+2*g_]; \
      P0[4*g_]=x0_[0]+negm0;P0[4*g_+1]=x0_[1]+negm0;P0[4*g_+2]=x0_[2]+negm0;P0[4*g_+3]=x0_[3]+negm0; \
      P1[4*g_]=x1_[0]+negm0;P1[4*g_+1]=x1_[1]+negm0;P1[4*g_+2]=x1_[2]+negm0;P1[4*g_+3]=x1_[3]+negm0; } }while(0)
  const int qrel=wid*QBLK+r32;
  #define CMASK(P0,P1,t) do{int jb_=(t)-(NT-4); if(jb_>=0)cmask(P0,P1,jb_,qrel,hi);}while(0)
  f32x16 pA0,pA1,pB0,pB1;
  int sl_prev=0,sl_cur=0,sl_next=SLOTB;
  #define ROT() do{sl_prev=sl_cur;sl_cur=sl_next;sl_next=(sl_next==(NSLOT-1)*SLOTB)?0:sl_next+SLOTB;}while(0)
  DMA_K(2,2*SLOTB);
  WAIT_BAR(3);
  BINIT_ALL(pA0,pA1,0); qkt(pA0,pA1,kp0,qr);asm volatile("s_nop 15\n\ts_nop 7":"+v"(pA0),"+v"(pA1));CMASK(pA0,pA1,0);
  _Pragma("unroll") for(int r=0;r<16;++r){pA0[r]=__builtin_amdgcn_exp2f(pA0[r]);pA1[r]=__builtin_amdgcn_exp2f(pA1[r]);}
  BINIT_ALL(pB0,pB1,1);
  WAIT_BAR(0);
  DMA_K(3,0);DMA_V(1,SLOTB);
  ROT();
  kload8(kf,kp0+sl_cur);
  WAIT_BAR(2);
  s16x4 vlo[8],vhi[8]; u32x4 pw0,pw1,pw2,pw3;
  #define PKW(P,B) cvtpk_s(P[B],P[B+1])
  #define PAF(k) __builtin_bit_cast(bf16x8,pw##k)
  #define VFR(i) (bf16x8){vlo[i][0],vlo[i][1],vlo[i][2],vlo[i][3],vhi[i][0],vhi[i][1],vhi[i][2],vhi[i][3]}
  #define PIN(x) asm volatile("":"+v"(x))
  #define MX3(a,b,c) __builtin_fmaxf(__builtin_fmaxf((a),(b)),(c))
  #define GAPA(MF,A0,A1,A2,A3,W0,W1,PW) do{ MF; sacc+=A0; sacc+=A1; sacc+=A2; sacc+=A3; PIN(sacc); W0; W1; PIN(PW); SBAR(); }while(0)
  #define EX(v) __builtin_amdgcn_exp2f(v)
  #define GAPB(MF,X,B,GL_,P,GI,NI) do{ MF; X[B]=EX(X[B]); X[B+1]=EX(X[B+1]); X[B+2]=EX(X[B+2]); X[B+3]=EX(X[B+3]); PIN(X); \
    if(GL_){ const f32x4v nx_=bpn_[NI]; P[4*(GI)]=bq_[0]+negm0; P[4*(GI)+1]=bq_[1]+negm0; P[4*(GI)+2]=bq_[2]+negm0; P[4*(GI)+3]=bq_[3]+negm0; bq_=nx_; PIN(P); } SBAR(); }while(0)
  #define VRD(i) do{ vlo[i]=vtr(vp_+(((i)>>2)*4096+((i)&3)*1024)); vhi[i]=vtr(vp_+(((i)>>2)*4096+((i)&3)*1024+512)); }while(0)
  #define KRD(G,j) do{ if(G){ kload2(kf,kp0+sl_next,j); SBAR(); } }while(0)
  #define STEP(C0,C1,P0,P1,t,GK,GV,GL) do{ SBAR(); \
    const lds_cptr vp_=vp0+sl_prev; \
    VRD(0); SBAR(); float sacc=(P0[0]+P0[1]); \
    GAPA(C0=__builtin_amdgcn_mfma_f32_32x32x16_bf16(kf[0],qr[0],C0,0,0,0), P0[2],P0[3],P0[4],P0[5],     pw0[0]=PKW(P0,0), pw0[1]=PKW(P0,2), pw0); \
    VRD(4); SBAR(); GAPA(C1=__builtin_amdgcn_mfma_f32_32x32x16_bf16(kf[1],qr[0],C1,0,0,0), P0[6],P0[7],P0[8],P0[9],     pw0[2]=PKW(P0,4), pw0[3]=PKW(P0,6), pw0); \
    VRD(1); SBAR(); GAPA(C0=__builtin_amdgcn_mfma_f32_32x32x16_bf16(kf[2],qr[1],C0,0,0,0),   P0[10],P0[11],P0[12],P0[13], pw1[0]=PKW(P0,8), pw1[1]=PKW(P0,10), pw1); \
    VRD(5); SBAR(); GAPA(C1=__builtin_amdgcn_mfma_f32_32x32x16_bf16(kf[3],qr[1],C1,0,0,0),   P0[14],P0[15],P1[0],P1[1],   pw1[2]=PKW(P0,12),pw1[3]=PKW(P0,14), pw1); \
    VRD(2); SBAR(); GAPA(C0=__builtin_amdgcn_mfma_f32_32x32x16_bf16(kf[4],qr[2],C0,0,0,0),   P1[2],P1[3],P1[4],P1[5],     pw2[0]=PKW(P1,0), pw2[1]=PKW(P1,2), pw2); \
    VRD(6); SBAR(); GAPA(C1=__builtin_amdgcn_mfma_f32_32x32x16_bf16(kf[5],qr[2],C1,0,0,0),   P1[6],P1[7],P1[8],P1[9],     pw2[2]=PKW(P1,4), pw2[3]=PKW(P1,6), pw2); \
    VRD(3); SBAR(); GAPA(C0=__builtin_amdgcn_mfma_f32_32x32x16_bf16(kf[6],qr[3],C0,0,0,0),   P1[10],P1[11],P1[12],P1[13], pw3[0]=PKW(P1,8), pw3[1]=PKW(P1,10), pw3); \
    VRD(7); SBAR(); GAPA(C1=__builtin_amdgcn_mfma_f32_32x32x16_bf16(kf[7],qr[3],C1,0,0,0),   P1[14],P1[15],0.f,0.f,       pw3[2]=PKW(P1,12),pw3[3]=PKW(P1,14), pw3); \
    l_reg+=sacc; \
    if(GK){DMA_K((t)+3,sl_cur);} if(GV){DMA_V((t)+1,sl_next);} \
    CMASK(C0,C1,t); \
    const __attribute__((address_space(3))) f32x4v* bpn_=(const __attribute__((address_space(3))) f32x4v*)(bl3+((t)+1)*256); f32x4v bq_=f32x4v{}; if(GL){bq_=bpn_[0];} \
    SBAR(); \
    GAPB(o[0]=__builtin_amdgcn_mfma_f32_32x32x16_bf16(PAF(0),VFR(0),o[0],0,0,0), C0,0,GL,P0,0,8); \
    GAPB(o[1]=__builtin_amdgcn_mfma_f32_32x32x16_bf16(PAF(0),VFR(4),o[1],0,0,0), C0,4,GL,P1,0,2); \
    KRD(GL,0); GAPB(o[0]=__builtin_amdgcn_mfma_f32_32x32x16_bf16(PAF(1),VFR(1),o[0],0,0,0), C0,8,GL,P0,1,10); \
    KRD(GL,1); GAPB(o[1]=__builtin_amdgcn_mfma_f32_32x32x16_bf16(PAF(1),VFR(5),o[1],0,0,0), C0,12,GL,P1,1,4); \
    KRD(GL,2); GAPB(o[0]=__builtin_amdgcn_mfma_f32_32x32x16_bf16(PAF(2),VFR(2),o[0],0,0,0), C1,0,GL,P0,2,12); \
    KRD(GL,3); GAPB(o[1]=__builtin_amdgcn_mfma_f32_32x32x16_bf16(PAF(2),VFR(6),o[1],0,0,0), C1,4,GL,P1,2,6); \
    GAPB(o[0]=__builtin_amdgcn_mfma_f32_32x32x16_bf16(PAF(3),VFR(3),o[0],0,0,0), C1,8,GL,P0,3,14); \
    GAPB(o[1]=__builtin_amdgcn_mfma_f32_32x32x16_bf16(PAF(3),VFR(7),o[1],0,0,0), C1,12,GL,P1,3,14); \
    }while(0)
  int t=1;
  #undef CMASK
  #define CMASK(P0,P1,t) do{}while(0)
  for(;t+5<NT;t+=2){
    STEP(pB0,pB1,pA0,pA1,t,true,true,true);     WAIT_BAR(2); ROT();
    STEP(pA0,pA1,pB0,pB1,t+1,true,true,true);   WAIT_BAR(2); ROT();
  }
  #undef CMASK
  #define CMASK(P0,P1,t) do{int jb_=(t)-(NT-4); if(jb_>=0)cmask(P0,P1,jb_,qrel,hi);}while(0)
  #define ENDW(tt) do{ if((tt)+3<NT){WAIT_BAR(2);} else if((tt)+2<NT){WAIT_BAR(1);} else {WAIT_BAR(0);} }while(0)
  for(;t+1<NT;t+=2){
    STEP(pB0,pB1,pA0,pA1,t,(t+3<NT),(t+1<NT),(t+1<NT));       ENDW(t);   ROT();
    STEP(pA0,pA1,pB0,pB1,t+1,(t+4<NT),(t+2<NT),(t+2<NT));     ENDW(t+1); ROT();
  }
  STEP(pB0,pB1,pA0,pA1,NT-1,false,false,false);
  { float sacc=pB0[0]+pB0[1]; _Pragma("unroll") for(int r=2;r<16;++r)sacc+=pB0[r]; _Pragma("unroll") for(int r=0;r<16;++r)sacc+=pB1[r]; l_reg+=sacc;
    pw0=(u32x4){PKW(pB0,0),PKW(pB0,2),PKW(pB0,4),PKW(pB0,6)};pw1=(u32x4){PKW(pB0,8),PKW(pB0,10),PKW(pB0,12),PKW(pB0,14)};pw2=(u32x4){PKW(pB1,0),PKW(pB1,2),PKW(pB1,4),PKW(pB1,6)};pw3=(u32x4){PKW(pB1,8),PKW(pB1,10),PKW(pB1,12),PKW(pB1,14)};
    SBAR(); pv(o,(int)(unsigned)(uintptr_t)vp0+sl_cur,PAF(0),PAF(1),PAF(2),PAF(3)); }
  #undef PKW
  #undef PAF
  #undef VFR
  #undef PIN
  #undef MX3
  #undef GAPA
  #undef GAPB
  #undef EX
  #undef VRD
  #undef KRD
  #undef STEP
  #undef ENDW
  {auto rr=__builtin_amdgcn_permlane32_swap(__float_as_uint(l_reg),__float_as_uint(l_reg),false,false);l_reg=__uint_as_float(rr[0])+__uint_as_float(rr[1]);}
  if(hi==0)wsf[32+r32]=l_reg;asm volatile("s_waitcnt lgkmcnt(0)":::"memory");
  float rli[16];
  #pragma unroll
  for(int r=0;r<16;++r)rli[r]=__builtin_amdgcn_rcpf(wsf[32+crow(r,hi)]);
  bf16*Ow=O+(rowbase+q0+wid*QBLK)*OPITCH+h*D;
  { __attribute__((address_space(3))) unsigned short*stg=(__attribute__((address_space(3))) unsigned short*)(shm3+LDS_OST)+wid*2048;
    #pragma unroll
    for(int r=0;r<16;++r){const int orow=crow(r,hi);
      #pragma unroll
      for(int d0=0;d0<2;++d0)stg[orow*64+d0*32+r32]=(unsigned short)(cvtpk_s(o[d0][r]*rli[r],0.f)&0xffffu);}
    asm volatile("s_waitcnt lgkmcnt(0)":::"memory");
    #pragma unroll
    for(int i=0;i<4;++i){const int row=i*8+(lane>>3),ch=lane&7; const u32x4 v=*(const __attribute__((address_space(3))) u32x4*)(stg+row*64+ch*8); ATTN_STORE16((char*)Ow+(unsigned)((row*OPITCH+ch*8)*2),v);} }
  asm volatile("s_waitcnt lgkmcnt(0)\n\ts_barrier":::"memory");
  #undef DMA_K
  #undef DMA_V
  #undef CMASK
  #undef BINIT_ALL
  #undef ROT
}
constexpr int ATTN_LDS_BYTES=LDS_TOTAL;
struct AttnTensors { const bf16* Q; const bf16* K; const bf16* V; bf16* O; const float* CB; float qkb; };
struct AttnUnit { int bh; int qb; };
struct StaticOrder {
  int vcu,G;
  __device__ __forceinline__ explicit StaticOrder(int grid,int block):vcu((grid%8==0)?(block%8)*(grid/8)+block/8:block),G(grid){}
  __device__ __forceinline__ bool next(int i,AttnUnit&u)const{
    if(G==256){ if(i>=4)return false; const int s=vcu&3; u.bh=vcu>>2; u.qb=(i==0)?s:(i==1)?7-s:(i==2)?8+s:15-s; return true; }
    const int id=vcu+i*G; if(id>=BATCH*NHEAD*NQB)return false; u.bh=id/NQB; u.qb=id%NQB; return true; }
};
template<class Sched,bool SKIP> __device__ __forceinline__ void attn_phase(char*lds,const AttnTensors&T,const Sched&S){
  AttnUnit u;
  for(int i=0;S.next(i,u);++i){ attn_unit<SKIP>(u.bh/NHEAD,u.bh%NHEAD,u.qb,T.Q,T.K,T.V,T.O,T.CB,T.qkb,lds); }
}
#undef SBAR
#undef WAIT_BAR
}
#define GAS __attribute__((address_space(1)))
#define LAS __attribute__((address_space(3)))
typedef unsigned short bf16;
typedef unsigned v4u __attribute__((ext_vector_type(4)));
typedef float f32x4 __attribute__((ext_vector_type(4)));
typedef short bf16x8 __attribute__((ext_vector_type(8)));
typedef GAS unsigned gu32;
typedef GAS unsigned long long gu64;
#define RLX_AGENT __ATOMIC_RELAXED, __HIP_MEMORY_SCOPE_AGENT
#define LDS_WAIT() asm volatile("s_waitcnt lgkmcnt(0)" ::: "memory")
#define VM_WAIT() asm volatile("s_waitcnt vmcnt(0)" ::: "memory")
__device__ __forceinline__ unsigned long long rt() { return __builtin_amdgcn_s_memrealtime(); }
__device__ __forceinline__ unsigned f2bf(float f) { unsigned u = __builtin_bit_cast(unsigned, f); return (u + 0x7fffu + ((u >> 16) & 1u)) >> 16; }
__device__ __forceinline__ unsigned pk2(float lo, float hi) { return f2bf(lo) | (f2bf(hi) << 16); }

#define XB_TMO      128
#define XB_XCNT(j)  (256  + 64 * (j))
#define XB_XSUB(j)  (1280 + 64 * (j))
#define XB_XGEN(j)  (2304 + 64 * (j))
#define XB_TOP      3328
#define XB_TOPGEN   3392
#define XCD_BAR_WORDS 3456
#define XB_SPIN_CAP (1u << 18)

__device__ __forceinline__ unsigned xb_ld(unsigned* p)              { return __hip_atomic_load(p, __ATOMIC_RELAXED, __HIP_MEMORY_SCOPE_AGENT); }
__device__ __forceinline__ unsigned xb_add(unsigned* p, unsigned v) { return __hip_atomic_fetch_add(p, v, __ATOMIC_RELAXED, __HIP_MEMORY_SCOPE_AGENT); }
__device__ __forceinline__ unsigned xb_xcc_id() { return (unsigned)__builtin_amdgcn_s_getreg((3 << 11) | 20) & 0xFu; }
#define XB_SPIN(cond, bar) do { unsigned _sp = 0; while (cond) { __builtin_amdgcn_s_sleep(1); \
    if ((++_sp & 255u) == 0u) { if (xb_ld(&(bar)[XB_TMO])) break; if (_sp > XB_SPIN_CAP) { atomicAdd(&(bar)[XB_TMO], 1u); break; } } } } while (0)

struct XcdBarrier {
    unsigned* bar; unsigned x;
    volatile LAS unsigned* st;
};

__device__ __forceinline__ XcdBarrier xcd_barrier_post(unsigned* bar, volatile LAS unsigned* st) {
    XcdBarrier b; b.bar = bar; b.x = xb_xcc_id(); b.st = st;
    if (threadIdx.x == 0) (void)xb_add(&bar[XB_XCNT(b.x)], 1u);
    return b;
}
__device__ __forceinline__ void xcd_barrier_complete(unsigned* bar, unsigned x, unsigned& nloc, unsigned& nx) {
    const unsigned G = gridDim.x * gridDim.y * gridDim.z;
    unsigned sum, cnt, mine, sp = 0u;
    for (;;) {
        sum = 0u; cnt = 0u; mine = 0u;
#pragma unroll
        for (unsigned j = 0; j < 16; ++j) { const unsigned c = xb_ld(&bar[XB_XCNT(j)]); sum += c; cnt += (c > 0u) ? 1u : 0u; mine = (j == x) ? c : mine; }
        if (sum == G) break;
        __builtin_amdgcn_s_sleep(1);
        if ((++sp & 255u) == 0u) { if (xb_ld(&bar[XB_TMO])) break; if (sp > XB_SPIN_CAP) { atomicAdd(&bar[XB_TMO], 1u); break; } }
    }
    nloc = mine > 0u ? mine : 1u; nx = cnt > 0u ? cnt : 1u;
}

__device__ __forceinline__ void xcd_barrier(const XcdBarrier& b) {
    asm volatile("s_waitcnt vmcnt(0)" ::: "memory");
    __syncthreads();
    if (threadIdx.x == 0) {
        unsigned* bar = b.bar;
        __builtin_amdgcn_s_waitcnt(0);
        unsigned nloc = b.st[0], nx = b.st[1];
        if (nloc == 0u) { xcd_barrier_complete(bar, b.x, nloc, nx); b.st[0] = nloc; b.st[1] = nx; }
        const unsigned old = xb_add(&bar[XB_XSUB(b.x)], 1u);
        const unsigned gen = old / nloc;
        if (old + 1u == (gen + 1u) * nloc) {
            __builtin_amdgcn_fence(__ATOMIC_RELEASE, "agent");
            asm volatile("s_waitcnt vmcnt(0)" ::: "memory");
            const unsigned og = xb_add(&bar[XB_TOP], 1u);
            const unsigned tg = og / nx;
            if (og + 1u == (tg + 1u) * nx) xb_add(&bar[XB_TOPGEN], 1u);
            else XB_SPIN(xb_ld(&bar[XB_TOPGEN]) == tg, bar);
            __builtin_amdgcn_fence(__ATOMIC_ACQUIRE, "agent");
            xb_add(&bar[XB_XGEN(b.x)], 1u);
            asm volatile("s_waitcnt vmcnt(0)" ::: "memory");
        } else {
            XB_SPIN(xb_ld(&bar[XB_XGEN(b.x)]) == gen, bar);
            __builtin_amdgcn_fence(__ATOMIC_ACQUIRE, "agent");
            asm volatile("s_waitcnt vmcnt(0)" ::: "memory");
        }
    }
    __syncthreads();
}
struct Args { const float* in[25]; float* out; unsigned char* ws; int ph_lo, ph_hi, use_bar, pad; };
typedef const __attribute__((address_space(4))) Args* KArgs;
#define CAND_LIST CAND(0,0,2,1) CAND(0,1,2,2) CAND(0,2,2,3) CAND(0,3,2,4) CAND(0,4,3,0) CAND(0,5,3,1) CAND(0,6,3,2) CAND(0,7,3,3) CAND(0,8,4,0) CAND(0,9,4,1) CAND(0,10,4,2) CAND(0,11,5,0) CAND(0,12,5,1) CAND(0,13,6,0) CAND(0,14,6,1) CAND(0,15,7,0) CAND(1,0,7,1) CAND(1,1,8,0) CAND(1,2,9,0) CAND(1,3,10,0) CAND(1,4,11,0) CAND(1,5,12,0) CAND(1,6,13,0) CAND(1,7,14,0) CAND(2,0,15,0)
constexpr int NB = 8, SEQ = 4096, DM = 1024, NTOK = NB * SEQ;
constexpr int NH = 8, HD = 64, AW = 512, PWD = 256, SWD = 256, INC = 2056;
constexpr int NEXP = 16384, PQW = 2048;
constexpr float EPSN = 1e-6f, LOG2E = 1.4426950408889634f;
constexpr int NWAVES = 8, NTHR = 512;
constexpr size_t MiB = 1u << 20;
constexpr size_t WS_CTL = 0, CTL_ZERO_BYTES = 1 * MiB;
constexpr size_t WS_WIN = 1 * MiB;
constexpr size_t WS_WOUT = 9 * MiB;
constexpr size_t WS_WQ = 13 * MiB;
constexpr size_t WS_KEYS = 21 * MiB;
constexpr size_t WS_WGLU = 22 * MiB;
constexpr size_t WS_WF = 22 * MiB + 512 * 1024;
constexpr size_t WS_CB = 23 * MiB;
constexpr size_t WS_XLOC = 24 * MiB;
constexpr size_t WS_IDX = 28 * MiB;
constexpr size_t WS_GATE = 44 * MiB;
constexpr size_t WS_Z = 60 * MiB;
constexpr size_t WS_U = 76 * MiB;
constexpr size_t WS_V = 140 * MiB;
constexpr size_t WS_XN = 204 * MiB;
constexpr size_t WS_P = 268 * MiB;
constexpr size_t WS_MG = 396 * MiB;
constexpr size_t WS_END = 460 * MiB;
constexpr int CW_BAR = 4096;
constexpr int RING_BYTES = 131072, LDSCTL_OFF = RING_BYTES, MISC_OFF = LDSCTL_OFF + 320, LDS_BYTES = 147456;
static_assert(attn_body::ATTN_LDS_BYTES <= RING_BYTES, "attention scratch fits the ring");

typedef _Float16 h16x2 __attribute__((ext_vector_type(2)));
typedef float f32x16 __attribute__((ext_vector_type(16)));
typedef unsigned u32x2 __attribute__((ext_vector_type(2)));

__device__ __forceinline__ float bf2f(unsigned short b) { return __uint_as_float((unsigned)b << 16); }
__device__ __forceinline__ float bflo(unsigned w) { return __uint_as_float(w << 16); }
__device__ __forceinline__ float bfhi(unsigned w) { return __uint_as_float(w & 0xffff0000u); }
__device__ __forceinline__ h16x2 as_h2(unsigned w) { return __builtin_bit_cast(h16x2, w); }
__device__ __forceinline__ float gelu_tanh(float x) { const float u = 1.5957691216057308f * (x + 0.044715f * x * x * x); return x / (1.f + __expf(-u)); }
__device__ __forceinline__ float wave_sum(float v) {
#pragma unroll
    for (int o = 1; o < 64; o <<= 1) v += __shfl_xor(v, o);
    return v;
}
__device__ __forceinline__ float wave_max(float v) {
#pragma unroll
    for (int o = 1; o < 64; o <<= 1) v = fmaxf(v, __shfl_xor(v, o));
    return v;
}
template <int N, int S0> __device__ __forceinline__ float bfly_reduce(float (&v)[N], int lane) {
    int s = S0;
#pragma unroll
    for (int cnt = N; cnt > 1; cnt >>= 1) {
        const bool up = (lane & s) != 0;
#pragma unroll
        for (int i = 0; i < cnt / 2; ++i) { const float a = v[i], b = v[i + cnt / 2]; const float send = up ? a : b, keep = up ? b : a; v[i] = keep + __shfl_xor(send, s); }
        s >>= 1;
    }
    float r = v[0];
    for (; s >= 1; s >>= 1) r += __shfl_xor(r, s);
    return r;
}

__device__ __forceinline__ void tr_item(const float* W, int ldw, int srccol, bf16* WT, int K, int dstrow, int k0, LAS float* scr, int lane) {
#pragma unroll 8
    for (int i = 0; i < 32; ++i) { const int kk = 2 * i + (lane >> 5); scr[kk * 33 + (lane & 31)] = W[(size_t)(k0 + kk) * ldw + srccol + (lane & 31)]; }
    LDS_WAIT(); asm volatile("" ::: "memory");
    const int c = lane & 7;
#pragma unroll
    for (int j = 0; j < 4; ++j) { const int n = (lane >> 3) + 8 * j; const LAS float* s = scr + (8 * c) * 33 + n;
        v4u o; o.x = pk2(s[0 * 33], s[1 * 33]); o.y = pk2(s[2 * 33], s[3 * 33]); o.z = pk2(s[4 * 33], s[5 * 33]); o.w = pk2(s[6 * 33], s[7 * 33]);
        *(GAS v4u*)(WT + (size_t)(dstrow + n) * K + k0 + 8 * c) = o; }
    LDS_WAIT(); asm volatile("" ::: "memory");
}
__device__ __forceinline__ void phase_prep(KArgs a, LAS unsigned char* lds, int G, int vcu, int tid, int lane, int wave) {
    unsigned char* ws = a->ws;
    LAS float* scr = (LAS float*)(lds + wave * 16384);
    const int gw = vcu * NWAVES + wave, NGW = G * NWAVES;
    constexpr int I_IN = 2048, I_OUT = 1024, I_WQ = 2048, I_GLU = 64;
    for (int it = gw; it < I_IN + I_OUT + I_WQ + I_GLU; it += NGW) {
        int r = it;
        if (r < I_IN) { const int l = r >> 10, q = r & 1023, kb = q >> 6, nb = q & 63, n0 = nb * 32;
            tr_item(a->in[2] + (size_t)l * DM * INC, INC, n0 + (n0 >= 1536 ? 8 : 0), (bf16*)(ws + WS_WIN) + (size_t)l * 2048 * 1024, 1024, n0, kb * 64, scr, lane); continue; }
        r -= I_IN;
        if (r < I_OUT) { const int l = r >> 9, q = r & 511, kb = q >> 5, nb = q & 31;
            tr_item(a->in[19] + (size_t)l * DM * DM, DM, nb * 32, (bf16*)(ws + WS_WOUT) + (size_t)l * 1024 * 1024, 1024, nb * 32, kb * 64, scr, lane); continue; }
        r -= I_OUT;
        if (r < I_WQ) { const int l = r >> 10, q = r & 1023, kb = q >> 6, nb = q & 63;
            tr_item(a->in[21] + (size_t)l * DM * PQW, PQW, nb * 32, (bf16*)(ws + WS_WQ) + (size_t)l * 2048 * 1024, 1024, nb * 32, kb * 64, scr, lane); continue; }
        r -= I_WQ;
        { const int l = r >> 5, q = r & 31, kb = q >> 3, nb = q & 7;
            tr_item(a->in[16] + (size_t)l * 256 * 256, 256, nb * 32, (bf16*)(ws + WS_WGLU) + (size_t)l * 256 * 256, 256, nb * 32, kb * 64, scr, lane); }
    }
    const size_t gt = (size_t)vcu * NTHR + tid, NGT = (size_t)G * NTHR;
    for (size_t i = gt; i < 2 * 8 * 1024; i += NGT) { const int l = (int)(i >> 13), h = (int)(i >> 10) & 7, k = (int)i & 1023;
        ((float*)(ws + WS_WF))[i] = a->in[2][((size_t)l * DM + k) * INC + 1536 + h]; }
    { const float* src = a->in[22]; bf16* dst = (bf16*)(ws + WS_KEYS);
      for (size_t i = gt; i < (size_t)2 * 8 * 2 * 128 * 128 / 8; i += NGT) { const f32x4 x0 = *(const f32x4*)(src + i * 8), x1 = *(const f32x4*)(src + i * 8 + 4);
          v4u o; o.x = pk2(x0[0], x0[1]); o.y = pk2(x0[2], x0[3]); o.z = pk2(x1[0], x1[1]); o.w = pk2(x1[2], x1[3]); *(v4u*)(dst + i * 8) = o; } }
#pragma unroll 1
    for (int tb = 0; tb < 2; ++tb) { const float* src = a->in[23 + tb]; _Float16* dst = (_Float16*)(ws + (tb ? WS_V : WS_U));
      for (size_t i = gt; i < (size_t)2 * NEXP * DM / 8; i += NGT) { const f32x4 x0 = *(const f32x4*)(src + i * 8), x1 = *(const f32x4*)(src + i * 8 + 4);
          h16x2 p0 = {(_Float16)x0[0], (_Float16)x0[1]}, p1 = {(_Float16)x0[2], (_Float16)x0[3]}, p2 = {(_Float16)x1[0], (_Float16)x1[1]}, p3 = {(_Float16)x1[2], (_Float16)x1[3]};
          v4u o; o.x = __builtin_bit_cast(unsigned, p0); o.y = __builtin_bit_cast(unsigned, p1); o.z = __builtin_bit_cast(unsigned, p2); o.w = __builtin_bit_cast(unsigned, p3);
          *(v4u*)(dst + i * 8) = o; } }
}

template <bool FLOGIT> __device__ __forceinline__ void phase_rownorm(const float* x, const float* g, bf16* XN, const float* WF, const float* fbias, float* CB, int G, int vcu, int lane, int wave) {
    const int gw = vcu * NWAVES + wave, NGW = G * NWAVES;
    f32x4 gv[4];
#pragma unroll
    for (int j = 0; j < 4; ++j) gv[j] = *(const f32x4*)(g + 4 * lane + 256 * j);
    for (int rg = gw; rg < NTOK / 2; rg += NGW) {
        f32x4 v[2][4];
#pragma unroll
        for (int r = 0; r < 2; ++r) { const float* xr = x + (size_t)(rg * 2 + r) * DM + 4 * lane;
#pragma unroll
            for (int j = 0; j < 4; ++j) v[r][j] = *(const f32x4*)(xr + 256 * j); }
#pragma unroll
        for (int r = 0; r < 2; ++r) { float s = 0.f;
#pragma unroll
            for (int j = 0; j < 4; ++j) s += (v[r][j][0] * v[r][j][0] + v[r][j][1] * v[r][j][1]) + (v[r][j][2] * v[r][j][2] + v[r][j][3] * v[r][j][3]);
            const float rstd = 1.0f / sqrtf(wave_sum(s) * (1.f / DM) + EPSN);
            bf16* orow = XN + (size_t)(rg * 2 + r) * DM + 4 * lane;
#pragma unroll
            for (int j = 0; j < 4; ++j) { v[r][j] = v[r][j] * rstd * gv[j]; u32x2 w; w.x = pk2(v[r][j][0], v[r][j][1]); w.y = pk2(v[r][j][2], v[r][j][3]); *(u32x2*)(orow + 256 * j) = w; } }
        if (FLOGIT) {
            float acc[16];
#pragma unroll
            for (int i = 0; i < 16; ++i) acc[i] = 0.f;
#pragma unroll
            for (int h = 0; h < 8; ++h)
#pragma unroll
                for (int j = 0; j < 4; ++j) { const f32x4 w = *(const f32x4*)(WF + h * 1024 + 4 * lane + 256 * j);
#pragma unroll
                    for (int r = 0; r < 2; ++r) acc[r * 8 + h] += (v[r][j][0] * w[0] + v[r][j][1] * w[1]) + (v[r][j][2] * w[2] + v[r][j][3] * w[3]); }
            const float tot = bfly_reduce<16, 32>(acc, lane);
            if ((lane & 3) == 0) { const int id = (lane >> 2) & 15, r = id >> 3, h = id & 7; const int row = rg * 2 + r, b = row / SEQ, s = row % SEQ;
                const float z = tot + fbias[h];
                const float ls = fminf(z, 0.f) - log1pf(__expf(-fabsf(z)));
                CB[((size_t)(b * NH + h)) * SEQ + s] = ls * LOG2E; }
        }
    }
}

__device__ __forceinline__ void phase_headnorm(bf16* Q, bf16* K, const float* qg, const float* kg, float* CB, int G, int vcu, int lane, int wave) {
    const int gw = vcu * NWAVES + wave, NGW = G * NWAVES;
    for (int sq = gw; sq < NB * NH; sq += NGW) {
        float* c = CB + (size_t)sq * SEQ; float carry = 0.f;
        for (int it = 0; it < SEQ / 64; ++it) { float v = c[it * 64 + lane];
#pragma unroll
            for (int o = 1; o < 64; o <<= 1) { const float t = __shfl_up(v, o); if (lane >= o) v += t; }
            v += carry; c[it * 64 + lane] = v; carry = __shfl(v, 63); }
    }
    float gq[8], gk[8];
#pragma unroll
    for (int j = 0; j < 8; ++j) { gq[j] = qg[8 * (lane & 7) + j] * (0.125f * LOG2E); gk[j] = kg[8 * (lane & 7) + j]; }
    for (int row = gw; row < NTOK; row += NGW) {
#pragma unroll
        for (int which = 0; which < 2; ++which) {
            bf16* p = (which ? K : Q) + (size_t)row * AW + 8 * lane;
            const v4u w = *(const v4u*)p; float f[8] = {bflo(w.x), bfhi(w.x), bflo(w.y), bfhi(w.y), bflo(w.z), bfhi(w.z), bflo(w.w), bfhi(w.w)};
            float s = 0.f;
#pragma unroll
            for (int j = 0; j < 8; ++j) s += f[j] * f[j];
            s += __shfl_xor(s, 1); s += __shfl_xor(s, 2); s += __shfl_xor(s, 4);
            const float rstd = 1.0f / sqrtf(s * (1.f / 64.f) + EPSN);
#pragma unroll
            for (int j = 0; j < 8; ++j) f[j] = f[j] * rstd * (which ? gk[j] : gq[j]);
            v4u o; o.x = pk2(f[0], f[1]); o.y = pk2(f[2], f[3]); o.z = pk2(f[4], f[5]); o.w = pk2(f[6], f[7]); *(v4u*)p = o;
        }
    }
}

__device__ __forceinline__ void phase_pool(const bf16* PS, const float* pw, const float* pscale, const float* ong, bf16* MG, LAS unsigned char* lds, int G, int bx, int tid, int lane, int wave) {
    LAS float* ut = (LAS float*)lds;
    LAS float* pl = (LAS float*)(lds + 47 * 256 * 4);
    const int ch = tid & 255, half = tid >> 8, g = ch >> 6, w = 2 << g;
    float wcol[64];
#pragma unroll
    for (int c = 0; c < 64; ++c) wcol[c] = pw[(g * 64 + c) * 64 + (ch & 63)];
    const float psc = pscale[ch];
    const f32x4 gn = *(const f32x4*)(ong + 512 + 4 * lane);
    for (int tile = bx; tile < NTOK / 32; tile += G) {
        const int tok0 = tile * 32, s0 = tok0 % SEQ;
        for (int idx = tid; idx < 47 * 32; idx += NTHR) { const int rr = idx >> 5, cq = idx & 31, r = rr - 15;
            v4u wv = {0u, 0u, 0u, 0u}; if (s0 + r >= 0) wv = *(const v4u*)(PS + (size_t)(tok0 + r) * 512 + cq * 8);
            LAS float* d = ut + rr * 256 + cq * 8;
            d[0] = bflo(wv.x); d[1] = bfhi(wv.x); d[2] = bflo(wv.y); d[3] = bfhi(wv.y); d[4] = bflo(wv.z); d[5] = bfhi(wv.z); d[6] = bflo(wv.w); d[7] = bfhi(wv.w); }
        __syncthreads();
#pragma unroll 1
        for (int tt = 0; tt < 16; ++tt) { const int ti = half * 16 + tt, rr = ti + 15, pos = s0 + ti;
            float s = 0.f; for (int j = 0; j < w; ++j) s += ut[(rr - j) * 256 + ch];
            const int cnt = (pos + 1 < w) ? pos + 1 : w;
            pl[ti * 256 + ch] = s / (float)cnt - ut[rr * 256 + ch]; }
        __syncthreads();
#pragma unroll 1
        for (int tt = 0; tt < 16; ++tt) { const int ti = half * 16 + tt; const LAS float* pr = pl + ti * 256 + g * 64;
            float acc = 0.f;
#pragma unroll
            for (int c = 0; c < 64; ++c) acc += pr[c] * wcol[c];
            ut[ti * 256 + ch] = acc * psc; }
        __syncthreads();
#pragma unroll
        for (int q = 0; q < 4; ++q) { const int ti = wave * 4 + q; const f32x4 v = *(const LAS f32x4*)(ut + ti * 256 + 4 * lane);
            const float ss = wave_sum((v[0] * v[0] + v[1] * v[1]) + (v[2] * v[2] + v[3] * v[3]));
            const float rstd = 1.0f / sqrtf(ss * (1.f / 256.f) + EPSN);
            u32x2 o; o.x = pk2(v[0] * rstd * gn[0], v[1] * rstd * gn[1]); o.y = pk2(v[2] * rstd * gn[2], v[3] * rstd * gn[3]);
            *(u32x2*)(MG + (size_t)(tok0 + ti) * DM + 512 + 4 * lane) = o; }
        __syncthreads();
    }
}

template <bool PASS2> __device__ __forceinline__ void phase_s5(KArgs a, int l, const bf16* PS, float* XLOC, bf16* Z, LAS unsigned char* lds, int G, int bx, int lane, int wave) {
    LAS float* Xs = (LAS float*)(lds + wave * (16 * 130 * 4));
    const int p = lane, kq = lane >> 4, ln = lane & 15;
    for (int task = bx; task < NB * 16 * 8; task += G) {
        const int b = task >> 7, g = (task >> 3) & 15, c = (task & 7) * 8 + wave;
        const float a_re = a->in[8][(l * 16 + g) * 64 + p], a_im = a->in[9][(l * 16 + g) * 64 + p], dt = expf(a->in[10][l * 16 + g]);
        float abr, abi, fr, fi;
        { const float xx = a_re * dt, yy = a_im * dt; const float ex = expf(xx); float sn, cs; sincosf(yy, &sn, &cs);
          abr = ex * cs; abi = ex * sn;
          const float sh = sinf(0.5f * yy); const float er = expm1f(xx) * cs - 2.f * sh * sh, ei = abi;
          const float den = a_re * a_re + a_im * a_im; fr = (er * a_re + ei * a_im) / den; fi = (ei * a_re - er * a_im) / den; }
        float bfrag[8][4];
        {
            float frq[4], fiq[4];
#pragma unroll
            for (int q = 0; q < 4; ++q) { frq[q] = __shfl(fr, 16 * q + ln); fiq[q] = __shfl(fi, 16 * q + ln); }
#pragma unroll
            for (int q = 0; q < 4; ++q)
#pragma unroll
                for (int ks = 0; ks < 4; ++ks) { const size_t bi = ((size_t)((l * 16 + g) * 64 + 16 * q + ln)) * 16 + 4 * kq + ks;
                    const float br = a->in[11][bi], bm = a->in[12][bi];
                    bfrag[q][ks] = frq[q] * br - fiq[q] * bm; bfrag[4 + q][ks] = frq[q] * bm + fiq[q] * br; }
        }
        float cfrag[32]; float dsk = 0.f;
        if (PASS2) {
#pragma unroll
            for (int ks = 0; ks < 32; ++ks) { const int k = 4 * ks + kq, pp = k & 63; const size_t ci = ((size_t)((l * 16 + g) * 16 + ln)) * 64 + pp;
                cfrag[ks] = (ks < 16) ? a->in[13][ci] : -a->in[14][ci]; }
            dsk = a->in[15][l * 256 + g * 16 + ln];
        }
        float xr = 0.f, xi = 0.f;
        if (PASS2) {
            float pr = abr, pi = abi;
#pragma unroll
            for (int q = 0; q < 6; ++q) { const float nr = pr * pr - pi * pi, ni = 2.f * pr * pi; pr = nr; pi = ni; }
            const float* xl = XLOC + ((size_t)(b * 16 + g) * 64) * 128 + p;
            for (int j = 0; j < c; ++j) { const float lr = xl[(size_t)j * 128], li = xl[(size_t)j * 128 + 64];
                const float nr = pr * xr - pi * xi + lr, ni = pr * xi + pi * xr + li; xr = nr; xi = ni; }
        }
        const size_t tok_c = (size_t)b * SEQ + c * 64;
#pragma unroll 1
        for (int sub = 0; sub < 4; ++sub) {
            const size_t tokb = tok_c + sub * 16;
            float ua[4];
            { const u32x2 w = *(const u32x2*)(PS + (tokb + ln) * 512 + 256 + g * 16 + 4 * kq); ua[0] = bflo(w.x); ua[1] = bfhi(w.x); ua[2] = bflo(w.y); ua[3] = bfhi(w.y); }
#pragma unroll
            for (int nb = 0; nb < 8; ++nb) { f32x4 acc = {0.f, 0.f, 0.f, 0.f};
#pragma unroll
                for (int ks = 0; ks < 4; ++ks) acc = __builtin_amdgcn_mfma_f32_16x16x4f32(ua[ks], bfrag[nb][ks], acc, 0, 0, 0);
#pragma unroll
                for (int r = 0; r < 4; ++r) Xs[(4 * kq + r) * 130 + 16 * nb + ln] = acc[r]; }
#pragma unroll
            for (int i = 0; i < 16; ++i) { const float bur = Xs[i * 130 + p], bui = Xs[i * 130 + 64 + p];
                const float nr = abr * xr - abi * xi + bur, ni = abr * xi + abi * xr + bui; xr = nr; xi = ni;
                if (PASS2) { Xs[i * 130 + p] = xr; Xs[i * 130 + 64 + p] = xi; } }
            if (PASS2) {
                f32x4 y0 = {0.f, 0.f, 0.f, 0.f}, y1 = {0.f, 0.f, 0.f, 0.f};
#pragma unroll
                for (int ks = 0; ks < 32; ks += 2) { y0 = __builtin_amdgcn_mfma_f32_16x16x4f32(Xs[ln * 130 + 4 * ks + kq], cfrag[ks], y0, 0, 0, 0);
                    y1 = __builtin_amdgcn_mfma_f32_16x16x4f32(Xs[ln * 130 + 4 * (ks + 1) + kq], cfrag[ks + 1], y1, 0, 0, 0); }
#pragma unroll
                for (int r = 0; r < 4; ++r) { const size_t tk = tokb + 4 * kq + r; const float uv = bf2f(PS[tk * 512 + 256 + g * 16 + ln]);
                    const float y = y0[r] + y1[r] + dsk * uv; Z[tk * 256 + g * 16 + ln] = (bf16)f2bf(gelu_tanh(y)); }
            }
        }
        if (!PASS2) { float* xl = XLOC + ((size_t)((b * 16 + g) * 64 + c)) * 128 + p; xl[0] = xr; xl[64] = xi; }
    }
}

__device__ __forceinline__ void phase_glu(const bf16* Z, const bf16* WG, const float* gb, const float* ong, bf16* MG, LAS unsigned char* lds, int G, int bx, int vcu, int tid, int lane, int wave) {
    LAS unsigned char* zt = lds;
    LAS float* ssq = (LAS float*)(lds + 64 * 528);
    LAS float* rs = ssq + 64 * 8;
    const int n = 32 * wave + (lane & 31), hs = lane >> 5;
    const float bn = gb[n], gnn = ong[768 + n];
    for (int tile = bx; tile < NTOK / 64; tile += G) {
        const size_t tok0 = (size_t)tile * 64;
        for (int idx = tid; idx < 64 * 32; idx += NTHR) { const int r = idx >> 5, cq = idx & 31; *(LAS v4u*)(zt + r * 528 + cq * 16) = *(const v4u*)(Z + (tok0 + r) * 256 + cq * 8); }
        __syncthreads();
        f32x16 acc[2]; acc[0] = f32x16{}; acc[1] = f32x16{};
#pragma unroll
        for (int ks = 0; ks < 16; ++ks) { const bf16x8 bw = *(const bf16x8*)(WG + (size_t)n * 256 + ks * 16 + 8 * hs);
#pragma unroll
            for (int mb = 0; mb < 2; ++mb) { const bf16x8 az = *(const LAS bf16x8*)(zt + (mb * 32 + (lane & 31)) * 528 + (ks * 16 + 8 * hs) * 2);
                acc[mb] = __builtin_amdgcn_mfma_f32_32x32x16_bf16(az, bw, acc[mb], 0, 0, 0); } }
        float val[32], sq[32];
#pragma unroll
        for (int mb = 0; mb < 2; ++mb)
#pragma unroll
            for (int r = 0; r < 16; ++r) { const int m = mb * 32 + (r & 3) + 8 * (r >> 2) + 4 * hs; const float z = bf2f(*(const LAS unsigned short*)(zt + m * 528 + n * 2));
                const float v = z / (1.f + __expf(-(acc[mb][r] + bn))); val[mb * 16 + r] = v; sq[mb * 16 + r] = v * v; }
        const float tot = bfly_reduce<32, 16>(sq, lane);
        { const int id = lane & 31, mb = id >> 4, r = id & 15, m = mb * 32 + (r & 3) + 8 * (r >> 2) + 4 * hs; ssq[m * 8 + wave] = tot; }
        __syncthreads();
        if (tid < 64) { float s = 0.f;
#pragma unroll
            for (int w8 = 0; w8 < 8; ++w8) s += ssq[tid * 8 + w8];
            rs[tid] = 1.0f / sqrtf(s * (1.f / 256.f) + EPSN); }
        __syncthreads();
#pragma unroll
        for (int mb = 0; mb < 2; ++mb)
#pragma unroll
            for (int r = 0; r < 16; ++r) { const int m = mb * 32 + (r & 3) + 8 * (r >> 2) + 4 * hs;
                MG[(tok0 + m) * DM + 768 + n] = (bf16)f2bf(val[mb * 16 + r] * rs[m] * gnn); }
        __syncthreads();
    }
    const int gw = vcu * NWAVES + wave, NGW = G * NWAVES;
    float g8[8];
#pragma unroll
    for (int j = 0; j < 8; ++j) g8[j] = ong[8 * lane + j];
    for (int row = gw; row < NTOK; row += NGW) {
        bf16* pp = MG + (size_t)row * DM + 8 * lane;
        const v4u w = *(const v4u*)pp; float f[8] = {bflo(w.x), bfhi(w.x), bflo(w.y), bfhi(w.y), bflo(w.z), bfhi(w.z), bflo(w.w), bfhi(w.w)};
        float s = 0.f;
#pragma unroll
        for (int j = 0; j < 8; ++j) s += f[j] * f[j];
        const float rstd = 1.0f / sqrtf(wave_sum(s) * (1.f / 512.f) + EPSN);
        v4u o; o.x = pk2(f[0] * rstd * g8[0], f[1] * rstd * g8[1]); o.y = pk2(f[2] * rstd * g8[2], f[3] * rstd * g8[3]);
        o.z = pk2(f[4] * rstd * g8[4], f[5] * rstd * g8[5]); o.w = pk2(f[6] * rstd * g8[6], f[7] * rstd * g8[7]); *(v4u*)pp = o;
    }
}

__device__ __forceinline__ void ins16(float (&top)[16], float x) {
#pragma unroll
    for (int i = 15; i >= 1; --i) top[i] = __builtin_amdgcn_fmed3f(top[i - 1], top[i], x);
    top[0] = fmaxf(top[0], x);
}
__device__ __forceinline__ float opq(float x) { asm("" : "+v"(x)); return x; }
__device__ __forceinline__ float tagf(float s, unsigned id, unsigned mask) { return __uint_as_float((__float_as_uint(s) & ~mask) | id); }
__device__ __forceinline__ void phase_select(const bf16* PQ, const bf16* KEYS, int* IDX, float* GATE, LAS unsigned char* lds, int G, int vcu, int lane, int wave) {
    const int gw = vcu * NWAVES + wave, NGW = G * NWAVES;
    LAS unsigned* ids = (LAS unsigned*)(lds + wave * 4096);
    const int tl = lane & 31, hs = lane >> 5;
    const float NEG = -__builtin_inff();
    for (int task = gw; task < (NTOK / 32) * 8; task += NGW) {
        const int tb = task >> 3, h = task & 7; const size_t tok = (size_t)tb * 32 + tl;
        float t1[16], t2[16];
#pragma unroll
        for (int half = 0; half < 2; ++half) {
            f32x16 acc[4]; acc[0] = f32x16{}; acc[1] = f32x16{}; acc[2] = f32x16{}; acc[3] = f32x16{};
            const bf16* qp = PQ + tok * PQW + h * 256 + half * 128 + 8 * hs;
            const bf16* kp = KEYS + ((size_t)(h * 2 + half) * 128 + tl) * 128 + 8 * hs;
#pragma unroll 2
            for (int ks = 0; ks < 8; ++ks) { const bf16x8 bq = *(const bf16x8*)(qp + ks * 16);
#pragma unroll
                for (int kb = 0; kb < 4; ++kb) { const bf16x8 ak = *(const bf16x8*)(kp + (size_t)kb * 32 * 128 + ks * 16); acc[kb] = __builtin_amdgcn_mfma_f32_32x32x16_bf16(ak, bq, acc[kb], 0, 0, 0); } }
            float top[16];
#pragma unroll
            for (int i = 0; i < 16; ++i) top[i] = NEG;
#pragma unroll
            for (int kb = 0; kb < 4; ++kb)
#pragma unroll
                for (int r = 0; r < 16; ++r) ins16(top, tagf(acc[kb][r], (unsigned)(32 * kb + (r & 3) + 8 * (r >> 2) + 4 * hs), 127u));
            float oth[16];
#pragma unroll
            for (int i = 0; i < 16; ++i) oth[i] = __shfl_xor(top[i], 32);
#pragma unroll
            for (int i = 0; i < 16; ++i) ins16(top, oth[i]);
#pragma unroll
            for (int i = 0; i < 16; ++i) { if (half == 0) t1[i] = top[i]; else t2[i] = top[i]; }
        }
#pragma unroll
        for (int i = 0; i < 16; ++i) ids[(tl * 2 + hs) * 16 + i] = __float_as_uint(hs ? opq(t2[i]) : opq(t1[i])) & 127u;
        float best[16];
#pragma unroll
        for (int i = 0; i < 16; ++i) best[i] = NEG;
#define CAND(a0, b0, a1, b1) { const float s0_ = opq(t1[a0] + t2[b0]), s1_ = opq(t1[a1] + t2[b1]); ins16(best, hs ? tagf(s1_, (unsigned)((a1) * 16 + (b1)), 255u) : tagf(s0_, (unsigned)((a0) * 16 + (b0)), 255u)); }
        CAND_LIST
#undef CAND
        { float oth[16];
#pragma unroll
          for (int i = 0; i < 16; ++i) oth[i] = __shfl_xor(best[i], 32);
#pragma unroll
          for (int i = 0; i < 16; ++i) ins16(best, oth[i]); }
        float e[16], den = 0.f;
#pragma unroll
        for (int i = 0; i < 16; ++i) { e[i] = __expf(best[i] - best[0]); den += e[i]; }
        const float rden = 1.f / den;
        int ex[8]; float gt[8];
#pragma unroll
        for (int j = 0; j < 8; ++j) { const float bj = hs ? opq(best[8 + j]) : opq(best[j]); const unsigned id = __float_as_uint(bj) & 255u;
            const unsigned i1 = ids[(tl * 2 + 0) * 16 + (id >> 4)], i2 = ids[(tl * 2 + 1) * 16 + (id & 15u)];
            ex[j] = (int)(i1 * 128u + i2); gt[j] = (hs ? opq(e[8 + j]) : opq(e[j])) * rden; }
        int* ip = IDX + tok * 128 + h * 16 + hs * 8; float* gp = GATE + tok * 128 + h * 16 + hs * 8;
        *(v4u*)ip = (v4u){(unsigned)ex[0], (unsigned)ex[1], (unsigned)ex[2], (unsigned)ex[3]}; *(v4u*)(ip + 4) = (v4u){(unsigned)ex[4], (unsigned)ex[5], (unsigned)ex[6], (unsigned)ex[7]};
        *(f32x4*)gp = (f32x4){gt[0], gt[1], gt[2], gt[3]}; *(f32x4*)(gp + 4) = (f32x4){gt[4], gt[5], gt[6], gt[7]};
    }
}

__device__ __forceinline__ void phase_gather(const bf16* XN, const int* IDX, const float* GATE, const _Float16* U, const _Float16* V, float* out, int G, int vcu, int lane, int wave) {
    const int gw = vcu * NWAVES + wave, NGW = G * NWAVES;
    for (int tok = gw; tok < NTOK; tok += NGW) {
        h16x2 hh[8];
        { const v4u w0 = *(const v4u*)(XN + (size_t)tok * DM + 16 * lane), w1 = *(const v4u*)(XN + (size_t)tok * DM + 16 * lane + 8);
          const unsigned ww[8] = {w0.x, w0.y, w0.z, w0.w, w1.x, w1.y, w1.z, w1.w};
#pragma unroll
          for (int j = 0; j < 8; ++j) hh[j] = (h16x2){(_Float16)bflo(ww[j]), (_Float16)bfhi(ww[j])}; }
        const int idxA = IDX[(size_t)tok * 128 + lane], idxB = IDX[(size_t)tok * 128 + 64 + lane];
        const float gA = GATE[(size_t)tok * 128 + lane], gB = GATE[(size_t)tok * 128 + 64 + lane];
        float acc[16];
#pragma unroll
        for (int i = 0; i < 16; ++i) acc[i] = 0.f;
        v4u ub[2][4][2], vb[2][4][2];
#define GLOAD(buf, grp) do { _Pragma("unroll") for (int e_ = 0; e_ < 4; ++e_) { const int k_ = (grp) * 4 + e_; \
            const int ix_ = (k_ < 64) ? __builtin_amdgcn_readlane(idxA, k_ & 63) : __builtin_amdgcn_readlane(idxB, k_ & 63); \
            const v4u* up_ = (const v4u*)(U + (size_t)ix_ * DM) + 2 * lane; const v4u* vp_ = (const v4u*)(V + (size_t)ix_ * DM) + 2 * lane; \
            ub[buf][e_][0] = up_[0]; ub[buf][e_][1] = up_[1]; vb[buf][e_][0] = vp_[0]; vb[buf][e_][1] = vp_[1]; } } while (0)
#define GCOMP(buf, grp) do { float p_[4]; \
            _Pragma("unroll") for (int e_ = 0; e_ < 4; ++e_) { float s_ = 0.f; \
                _Pragma("unroll") for (int j_ = 0; j_ < 8; ++j_) s_ = __builtin_amdgcn_fdot2(hh[j_], as_h2(ub[buf][e_][j_ >> 2][j_ & 3]), s_, false); p_[e_] = s_; } \
            const float tot_ = bfly_reduce<4, 32>(p_, lane); \
            _Pragma("unroll") for (int e_ = 0; e_ < 4; ++e_) { const int k_ = (grp) * 4 + e_; \
                const float d_ = __builtin_bit_cast(float, __builtin_amdgcn_readlane(__builtin_bit_cast(int, tot_), 16 * e_)); \
                const float g_ = __builtin_bit_cast(float, (k_ < 64) ? __builtin_amdgcn_readlane(__builtin_bit_cast(int, gA), k_ & 63) : __builtin_amdgcn_readlane(__builtin_bit_cast(int, gB), k_ & 63)); \
                const float a_ = g_ * gelu_tanh(d_); \
                _Pragma("unroll") for (int j_ = 0; j_ < 8; ++j_) { const h16x2 vv_ = as_h2(vb[buf][e_][j_ >> 2][j_ & 3]); \
                    acc[2 * j_] = fmaf((float)vv_.x, a_, acc[2 * j_]); acc[2 * j_ + 1] = fmaf((float)vv_.y, a_, acc[2 * j_ + 1]); } } } while (0)
        GLOAD(0, 0);
#pragma unroll 1
        for (int grp = 0; grp < 32; grp += 2) {
            GLOAD(1, grp + 1);
            GCOMP(0, grp);
            if (grp + 2 < 32) GLOAD(0, grp + 2);
            GCOMP(1, grp + 1);
        }
#undef GLOAD
#undef GCOMP
        float* op = out + (size_t)tok * DM + 16 * lane;
#pragma unroll
        for (int q = 0; q < 4; ++q) { f32x4 o = *(const f32x4*)(op + 4 * q); o[0] += acc[4 * q]; o[1] += acc[4 * q + 1]; o[2] += acc[4 * q + 2]; o[3] += acc[4 * q + 3]; *(f32x4*)(op + 4 * q) = o; }
    }
}

__device__ __forceinline__ void phase_gather_naive(const bf16* XN, const int* IDX, const float* GATE, const float* U, const float* V, float* out, int G, int vcu, int lane, int wave) {
    const int gw = vcu * NWAVES + wave, NGW = G * NWAVES;
    for (int tok = gw; tok < NTOK; tok += NGW) {
        float hv[16], acc[16];
#pragma unroll
        for (int j = 0; j < 16; ++j) { hv[j] = bf2f(XN[(size_t)tok * DM + lane + 64 * j]); acc[j] = 0.f; }
        for (int k = 0; k < 128; ++k) { const int e = IDX[(size_t)tok * 128 + k]; const float g = GATE[(size_t)tok * 128 + k];
            float s = 0.f;
#pragma unroll
            for (int j = 0; j < 16; ++j) s += hv[j] * U[(size_t)e * DM + lane + 64 * j];
            s = wave_sum(s); const float a = g * gelu_tanh(s);
#pragma unroll
            for (int j = 0; j < 16; ++j) acc[j] += a * V[(size_t)e * DM + lane + 64 * j]; }
#pragma unroll
        for (int j = 0; j < 16; ++j) out[(size_t)tok * DM + lane + 64 * j] += acc[j];
    }
}
constexpr int PH_PER_LAYER = 13, N_PHASES = 1 + 2 * PH_PER_LAYER;
__device__ __forceinline__ KArgs kargs() { KArgs p = (KArgs)__builtin_amdgcn_kernarg_segment_ptr(); asm volatile("" : "+s"(p)); return p; }
__global__ void __launch_bounds__(NTHR, 2) mega_fwd(Args a_unused) {
    extern __shared__ __attribute__((aligned(16))) unsigned char lds_raw[];
    LAS unsigned char* lds = (LAS unsigned char*)lds_raw;
    volatile LAS unsigned* MISC = (volatile LAS unsigned*)(lds + MISC_OFF);
    const int tid0 = threadIdx.x;
    for (int u = tid0; u < (LDS_BYTES - LDSCTL_OFF) / 4; u += NTHR) ((LAS unsigned*)(lds + LDSCTL_OFF))[u] = 0u;
    __syncthreads();
    XcdBarrier bar; { KArgs ka = kargs(); unsigned char* ws0 = ka->ws; bar.bar = (unsigned*)(ws0 + WS_CTL) + CW_BAR; bar.x = 0; bar.st = nullptr;
      if (ka->use_bar) bar = xcd_barrier_post((unsigned*)(ws0 + WS_CTL) + CW_BAR, MISC + 8); }
    const int ph_lo = kargs()->ph_lo, ph_hi = kargs()->ph_hi;
#pragma unroll 1
    for (int ph = ph_lo; ph < ph_hi; ++ph) {
        KArgs a = kargs(); unsigned char* ws = a->ws;
        const int tid = otid(), lane = tid & 63, wave = __builtin_amdgcn_readfirstlane(tid >> 6);
        int G = gridDim.x, bx = blockIdx.x; asm volatile("" : "+s"(G), "+s"(bx)); const int vcu = (G % 8 == 0) ? (bx % 8) * (G / 8) + bx / 8 : bx;
        bf16* const XN = (bf16*)(ws + WS_XN); bf16* const Pq = (bf16*)(ws + WS_P); bf16* const Pk = Pq + (size_t)NTOK * 512; bf16* const Pv = Pk + (size_t)NTOK * 512; bf16* const Ps = Pv + (size_t)NTOK * 512;
        bf16* const MG = (bf16*)(ws + WS_MG); float* const CB = (float*)(ws + WS_CB); float* const XLOC = (float*)(ws + WS_XLOC); bf16* const Z = (bf16*)(ws + WS_Z);
        int* const IDX = (int*)(ws + WS_IDX); float* const GATE = (float*)(ws + WS_GATE);
        if (ph == 0) { if (PH_MASK & 1u) phase_prep(a, lds, G, vcu, tid, lane, wave); }
        else {
            const int l = (ph - 1) / PH_PER_LAYER, sub = (ph - 1) % PH_PER_LAYER;
            const float* xin = (l == 0) ? a->in[0] : a->out;
            switch (sub) {
            case 0: if (PH_MASK & (1u << 1)) phase_rownorm<true>(xin, a->in[1] + l * DM, XN, (const float*)(ws + WS_WF) + l * 8 * 1024, a->in[3] + l * 8, CB, G, vcu, lane, wave); break;
            case 1: if (PH_MASK & (1u << 2)) { pg8::Gemm g{XN, (const bf16*)(ws + WS_WIN) + (size_t)l * 2048 * 1024, NTOK, 2048, 1024}; pg8::StaticOrder S; S.init(NTOK, 2048, G, bx);
                pg8::EpiBf16<0> E{Pq, 512, nullptr, 512, (size_t)NTOK * 512, 1.f};
                pg8::gemm_phase<pg8::EpiBf16<0>, pg8::StaticOrder, true, true>(lds, g, S, E); } break;
            case 2: if (PH_MASK & (1u << 3)) phase_headnorm(Pq, Pk, a->in[4] + l * 64, a->in[5] + l * 64, CB, G, vcu, lane, wave); break;
            case 3: if (PH_MASK & (1u << 4)) { const float gq = wave_max(fabsf(a->in[4][l * 64 + lane])), gk = wave_max(fabsf(a->in[5][l * 64 + lane]));
                const float qkb = 8.f * gq * gk * LOG2E * 1.02f + 0.25f;
                const attn_body::AttnTensors AT{(const attn_body::bf16*)Pq, (const attn_body::bf16*)Pk, (const attn_body::bf16*)Pv, (attn_body::bf16*)MG, CB, qkb};
                const attn_body::StaticOrder S(G, bx);
                attn_body::attn_phase<attn_body::StaticOrder, ATT_SKIP>((char*)lds_raw, AT, S); } break;
            case 4: if (PH_MASK & (1u << 5)) phase_pool(Ps, a->in[6] + (size_t)l * 4 * 64 * 64, a->in[7] + l * 256, a->in[18] + l * DM, MG, lds, G, bx, tid, lane, wave); break;
            case 5: if (PH_MASK & (1u << 6)) phase_s5<false>(a, l, Ps, XLOC, Z, lds, G, bx, lane, wave); break;
            case 6: if (PH_MASK & (1u << 7)) phase_s5<true>(a, l, Ps, XLOC, Z, lds, G, bx, lane, wave); break;
            case 7: if (PH_MASK & (1u << 8)) phase_glu(Z, (const bf16*)(ws + WS_WGLU) + (size_t)l * 256 * 256, a->in[17] + l * 256, a->in[18] + l * DM, MG, lds, G, bx, vcu, tid, lane, wave); break;
            case 8: if (PH_MASK & (1u << 9)) { pg8::Gemm g{MG, (const bf16*)(ws + WS_WOUT) + (size_t)l * 1024 * 1024, NTOK, 1024, 1024}; pg8::StaticOrder S; S.init(NTOK, 1024, G, bx);
                pg8::EpiResF32 E{xin, a->out, DM};
                pg8::gemm_phase<pg8::EpiResF32, pg8::StaticOrder, true, true>(lds, g, S, E); } break;
            case 9: if (PH_MASK & (1u << 10)) phase_rownorm<false>(a->out, a->in[20] + l * DM, XN, nullptr, nullptr, nullptr, G, vcu, lane, wave); break;
            case 10: if (PH_MASK & (1u << 11)) { pg8::Gemm g{XN, (const bf16*)(ws + WS_WQ) + (size_t)l * 2048 * 1024, NTOK, 2048, 1024}; pg8::StaticOrder S; S.init(NTOK, 2048, G, bx);
                pg8::EpiBf16<0> E{Pq, PQW, nullptr, 0, 0, 1.f};
                pg8::gemm_phase<pg8::EpiBf16<0>, pg8::StaticOrder, true, true>(lds, g, S, E); } break;
            case 11: if (PH_MASK & (1u << 12)) phase_select(Pq, (const bf16*)(ws + WS_KEYS) + (size_t)l * 8 * 2 * 128 * 128, IDX, GATE, lds, G, vcu, lane, wave); break;
#if GATHER_NAIVE
            default: if (PH_MASK & (1u << 13)) phase_gather_naive(XN, IDX, GATE, a->in[23] + (size_t)l * NEXP * DM, a->in[24] + (size_t)l * NEXP * DM, a->out, G, vcu, lane, wave); break;
#else
            default: if (PH_MASK & (1u << 13)) phase_gather(XN, IDX, GATE, (const _Float16*)(ws + WS_U) + (size_t)l * NEXP * DM, (const _Float16*)(ws + WS_V) + (size_t)l * NEXP * DM, a->out, G, vcu, lane, wave); break;
#endif
            }
        }
        if (ph + 1 < ph_hi) xcd_barrier(bar);
    }
}

extern "C" void kernel_launch(void* const* d_in, const int* in_sizes, int n_in, void* d_out, int out_size, void* d_ws, size_t ws_size, hipStream_t stream) {
    static int grid = 0;
    if (grid == 0) {
        if (n_in != 25 || in_sizes[0] != NTOK * DM || out_size != NTOK * DM || ws_size < WS_END) {
            fprintf(stderr, "kernel_launch: unexpected problem: n_in %d in0 %d out %d ws %zu (need %zu); nothing launched\n", n_in, n_in > 0 ? in_sizes[0] : -1, out_size, ws_size, (size_t)WS_END); grid = -1; return; }
        int dev = 0, cus = 0;
        if (hipGetDevice(&dev) != hipSuccess || hipDeviceGetAttribute(&cus, hipDeviceAttributeMultiprocessorCount, dev) != hipSuccess) { fprintf(stderr, "kernel_launch: device query failed\n"); grid = -1; return; }
        if (hipFuncSetAttribute((const void*)mega_fwd, hipFuncAttributeMaxDynamicSharedMemorySize, LDS_BYTES) != hipSuccess) { fprintf(stderr, "kernel_launch: hipFuncSetAttribute failed\n"); grid = -1; return; }
        (void)hipGetLastError();
        grid = cus;
    }
    if (grid < 0) return;
    (void)hipMemsetAsync((char*)d_ws + WS_CTL, 0, CTL_ZERO_BYTES, stream);
    Args a{};
    for (int i = 0; i < 25; ++i) a.in[i] = (const float*)d_in[i];
    a.out = (float*)d_out; a.ws = (unsigned char*)d_ws;
#if MK_ONE_LAUNCH
    a.ph_lo = 0; a.ph_hi = N_PHASES; a.use_bar = 1;
    hipLaunchKernelGGL(mega_fwd, dim3(grid), dim3(NTHR), LDS_BYTES, stream, a);
#else
    for (int ph = 0; ph < N_PHASES; ++ph) { a.ph_lo = ph; a.ph_hi = ph + 1; a.use_bar = 0;
        hipLaunchKernelGGL(mega_fwd, dim3(grid), dim3(NTHR), LDS_BYTES, stream, a); }
#endif
    const hipError_t le = hipPeekAtLastError();
    if (le != hipSuccess) fprintf(stderr, "kernel_launch: launch failed: %s\n", hipGetErrorName(le));
}
```

```cpp
#include <hip/hip_runtime.h>
#include <hip/hip_bf16.h>
#include <hip/hip_fp16.h>
#include <cstdio>
#include <cstdint>
#include <cmath>
#ifndef MK_ONE_LAUNCH
#define MK_ONE_LAUNCH 1
#endif
#ifndef ATT_SKIP
#define ATT_SKIP true
#endif
#ifndef PH_MASK
#define PH_MASK 0xffffffffu
#endif
#define OTID_LDS_OFF (131072 + 1024)
__device__ __forceinline__ int otid() {
    int z = 0; asm volatile("" : "+v"(z)); const int lane = __builtin_amdgcn_mbcnt_hi(-1, __builtin_amdgcn_mbcnt_lo(-1, z));
    const unsigned hw = (unsigned)__builtin_amdgcn_s_getreg((6 << 11) | 4);
    const int wv = *(const volatile __attribute__((address_space(3))) int*)(OTID_LDS_OFF + 4 * (hw & 63u));
    return (__builtin_amdgcn_readfirstlane(wv) << 6) | lane;
}
#ifndef GATHER_NAIVE
#define GATHER_NAIVE 0
#endif
#ifndef DUP_PH
#define DUP_PH (-1)
#endif
#ifndef TIME_PH
#define TIME_PH (-1)
#define TIME_MUL 3
#endif
#ifndef DIAG_IMASK
#define DIAG_IMASK 0xffu
#endif
namespace pg8 {
#define PG8_LAS __attribute__((address_space(3)))
typedef unsigned short bf16_t;
typedef short bf16x8 __attribute__((ext_vector_type(8)));
typedef float f32x4 __attribute__((ext_vector_type(4)));
typedef unsigned u32x4 __attribute__((ext_vector_type(4)));
constexpr int BM = 256, BK = 64, HALF = 128, HTB = HALF * BK * 2  , STAGE_BYTES = 8 * HTB, NXCD = 8, WGM = 8;

__host__ __device__ __forceinline__ int lds_byte(int r, int c) { const int st = (r >> 4) * 2 + (c >> 5), rr = r & 15, cc = c & 31, ob = rr * 64 + cc * 2; return st * 1024 + (ob ^ (((ob >> 9) & 1) << 5)); }
__host__ __device__ __forceinline__ void stage_rc(int b, int& R, int& C) { const int st = b / 1024, sb = b % 1024, swz = sb ^ (((sb >> 9) & 1) << 5); R = (st >> 1) * 16 + swz / 64; C = (st & 1) * 32 + (swz % 64) / 2; }
__host__ __device__ __forceinline__ int perm32(int rho) { const int n = rho >> 4, i = rho & 15; return 8 * (i >> 2) + 4 * n + (i & 3); }

struct Unit { int pm, pn; };
struct Gemm { const bf16_t* A; const bf16_t* Bt; int M, N, K; };

struct StaticOrder {
    int nM, nN, nwg, G, c;
    __host__ __device__ void init(int M, int N, int G_, int c_) { nM = M / BM; nN = N / BM; nwg = nM * nN; G = G_; c = c_; }
    __host__ __device__ bool next(int i, Unit& u) const {
        const long L = (long)i * G + c; if (L >= nwg) return false;
        int wgid = (int)L; { const int q = nwg / NXCD, r = nwg % NXCD, xcd = wgid % NXCD, off = wgid / NXCD; wgid = (xcd < r ? xcd * (q + 1) : r * (q + 1) + (xcd - r) * q) + off; }
        const int nig = WGM * nN, gid = wgid / nig, fm = gid * WGM, gsz = (nM - fm) < WGM ? (nM - fm) : WGM;
        u.pm = fm + ((wgid % nig) % gsz); u.pn = (wgid % nig) / gsz; return true;
    }
    __device__ __forceinline__ void a_ready(const Unit&) const {}
    __device__ __forceinline__ void done(const Unit&) const {}
};

__device__ __forceinline__ unsigned cvt_pk_bf16(float lo, float hi) { unsigned r; asm volatile("v_cvt_pk_bf16_f32 %0, %1, %2" : "=v"(r) : "v"(lo), "v"(hi)); return r; }
typedef float f32x2 __attribute__((ext_vector_type(2)));
__device__ __forceinline__ f32x2 gelu_pk(f32x2 v) {
    const f32x2 av = __builtin_elementwise_abs(v), d = av * 0.2316418882f + 1.0f;
    f32x2 t; t.x = __builtin_amdgcn_rcpf(d.x); t.y = __builtin_amdgcn_rcpf(d.y);
    f32x2 q = t * 0.5307027145f + (-0.7265760135f); q = q * t + 0.7107068705f; q = q * t + (-0.142248368f); q = q * t + 0.127414796f; q = q * t;
    const f32x2 s = (v * v) * (-0.72134752044f);
    f32x2 e; e.x = __builtin_amdgcn_exp2f(s.x); e.y = __builtin_amdgcn_exp2f(s.y);
    const f32x2 m = v * (q * e), r = v - m;
    f32x2 o; o.x = v.x < 0.f ? m.x : r.x; o.y = v.y < 0.f ? m.y : r.y; return o;
}

template <int ACT  > struct EpiBf16 {
    static constexpr bool PERM = true, AFTER_DRAIN = false; static_assert(ACT == 0 || ACT == 1, "EpiBf16: ACT is 0 (none) or 1 (gelu_pk)");
    bf16_t* O; int ldc; const float* bias; int split_cols; size_t split_stride; float scale0;
    __device__ __forceinline__ void operator()(const f32x4 (&acc)[2][2][4][2], const Unit& u, int wr, int wc, int fr, int fq) const {
        const int row0 = u.pm * BM + wr * 64 + fr; int colt = u.pn * BM; bf16_t* base = O;
        float sc = 1.f; if (split_cols) { const int t = colt / split_cols; base += (size_t)t * split_stride; colt -= t * split_cols; if (t == 0) sc = scale0; }
        const int col0 = colt + wc * 32 + 8 * fq, bcol0 = u.pn * BM + wc * 32 + 8 * fq;
        f32x4 bv[2][2];
#pragma unroll
        for (int bj = 0; bj < 2; ++bj)
#pragma unroll
            for (int n = 0; n < 2; ++n) bv[bj][n] = bias ? *(const f32x4*)(bias + bcol0 + bj * HALF + 4 * n) : (f32x4){0.f, 0.f, 0.f, 0.f};
#pragma unroll
        for (int ai = 0; ai < 2; ++ai)
#pragma unroll
            for (int m = 0; m < 4; ++m) { bf16_t* rowp = base + (size_t)(row0 + ai * HALF + m * 16) * ldc + col0;
#pragma unroll
                for (int bj = 0; bj < 2; ++bj) { f32x4 v0 = acc[ai][bj][m][0] + bv[bj][0], v1 = acc[ai][bj][m][1] + bv[bj][1];
                    if (ACT == 1) { f32x2 a = gelu_pk((f32x2){v0[0], v0[1]}), b = gelu_pk((f32x2){v0[2], v0[3]}), c = gelu_pk((f32x2){v1[0], v1[1]}), d = gelu_pk((f32x2){v1[2], v1[3]});
                        v0 = (f32x4){a.x, a.y, b.x, b.y}; v1 = (f32x4){c.x, c.y, d.x, d.y}; }
                    v0 = v0 * sc; v1 = v1 * sc; u32x4 w; w.x = cvt_pk_bf16(v0[0], v0[1]); w.y = cvt_pk_bf16(v0[2], v0[3]); w.z = cvt_pk_bf16(v1[0], v1[1]); w.w = cvt_pk_bf16(v1[2], v1[3]);
                    *(u32x4*)(rowp + bj * HALF) = w; } }
    }
};
struct EpiResF32 {
    static constexpr bool PERM = false, AFTER_DRAIN = false;
    const float* base; float* out; int ldc;
    __device__ __forceinline__ void operator()(const f32x4 (&acc)[2][2][4][2], const Unit& u, int wr, int wc, int fr, int fq) const {
        const int col0 = u.pn * BM + wc * 32 + 4 * fq;
#pragma unroll
        for (int ai = 0; ai < 2; ++ai)
#pragma unroll
            for (int m = 0; m < 4; ++m) { const size_t off = (size_t)(u.pm * BM + ai * HALF + wr * 64 + m * 16 + fr) * ldc + col0;
#pragma unroll
                for (int bj = 0; bj < 2; ++bj)
#pragma unroll
                    for (int n = 0; n < 2; ++n) { const f32x4 bs = *(const f32x4*)(base + off + bj * HALF + n * 16); *(f32x4*)(out + off + bj * HALF + n * 16) = bs + acc[ai][bj][m][n]; } }
    }
};
template <class Epi, class Sched, bool ALIGN_EPI = false, bool SP2 = false>
__device__ __forceinline__ void gemm_phase(PG8_LAS unsigned char* lds, const Gemm g, const Sched& S, const Epi& E) {
    const int tid = otid(), wid = __builtin_amdgcn_readfirstlane(tid >> 6), lane = tid & 63, wr = wid >> 2, wc = wid & 3, fr = lane & 15, fq = lane >> 4;
    const int K = g.K, nt = K / BK;
    unsigned voffA[2], voffB[2];
#pragma unroll
    for (int i = 0; i < 2; ++i) { int R, C; stage_rc(tid * 16 + i * 8192, R, C); const int Rb = Epi::PERM ? ((R & ~31) + perm32(R & 31)) : R;
        voffA[i] = (unsigned)(R * K + C) * 2u; voffB[i] = (unsigned)(Rb * K + C) * 2u; }
    const size_t kstep = (size_t)(BK * 2);
    const size_t hstep = (size_t)HALF * K * 2;
    const size_t tstep = 2 * hstep;
    const unsigned ldsw = (unsigned)wid * 1024u;
    const int aoff = lds_byte(wr * 64 + fr, fq * 8), boff = lds_byte(wc * 32 + fr, fq * 8);
#define PG8_SA(b, h) (((b) * 2 + (h)) * HTB)
#define PG8_SB(b, h) ((4 + (b) * 2 + (h)) * HTB)
#define PG8_STAGE(bufoff, gbase, voff) do { _Pragma("unroll") for (int _i = 0; _i < 2; ++_i) \
        __builtin_amdgcn_global_load_lds((const unsigned*)((const char*)(gbase) + (voff)[_i]), (PG8_LAS unsigned*)(lds + (bufoff) + ldsw + _i * 8192), 16, 0, 0); } while (0)
#define PG8_LDA(dst, b, h) do { _Pragma("unroll") for (int m = 0; m < 4; ++m) _Pragma("unroll") for (int k = 0; k < 2; ++k) dst[m][k] = *(const PG8_LAS bf16x8*)(lds + PG8_SA(b, h) + aoff + m * 2048 + k * 1024); } while (0)
#define PG8_LDB(dst, b, h) do { _Pragma("unroll") for (int n = 0; n < 2; ++n) _Pragma("unroll") for (int k = 0; k < 2; ++k) dst[n][k] = *(const PG8_LAS bf16x8*)(lds + PG8_SB(b, h) + boff + n * 2048 + k * 1024); } while (0)
#define PG8_MMA(ai, bj, At, Bt) do { __builtin_amdgcn_s_setprio(1); _Pragma("unroll") for (int m = 0; m < 4; ++m) _Pragma("unroll") for (int n = 0; n < 2; ++n) _Pragma("unroll") for (int k = 0; k < 2; ++k) \
        acc[ai][bj][m][n] = __builtin_amdgcn_mfma_f32_16x16x32_bf16(Bt[n][k], At[m][k], acc[ai][bj][m][n], 0, 0, 0); __builtin_amdgcn_s_setprio(0); } while (0)
#define PG8_WAIT_V(n) asm volatile("s_waitcnt vmcnt(" #n ")" ::: "memory")
#define PG8_WAIT_L(n) asm volatile("s_waitcnt lgkmcnt(" #n ")" ::: "memory")
#define PG8_BAR __builtin_amdgcn_s_barrier()
#define PG8_SCHED __builtin_amdgcn_sched_barrier(0)
    Unit cur, nxt; int ui = 0;
    if (!S.next(0, cur)) return;
    f32x4 acc[2][2][4][2];
#pragma unroll
    for (int a = 0; a < 2; ++a)
#pragma unroll
        for (int b = 0; b < 2; ++b)
#pragma unroll
            for (int m = 0; m < 4; ++m)
#pragma unroll
                for (int n = 0; n < 2; ++n) acc[a][b][m][n] = (f32x4){0.f, 0.f, 0.f, 0.f};
    bf16x8 At[4][2], B0[2][2], B1[2][2];
    const char* cA = (const char*)g.A + (size_t)cur.pm * tstep; const char* cB = (const char*)g.Bt + (size_t)cur.pn * tstep;
    S.a_ready(cur);
    if constexpr (SP2) {
        PG8_STAGE(PG8_SB(0, 0), cB, voffB); PG8_STAGE(PG8_SB(0, 1), cB + hstep, voffB); PG8_STAGE(PG8_SA(0, 0), cA, voffA); PG8_STAGE(PG8_SA(0, 1), cA + hstep, voffA);
        if (wr == 1) PG8_BAR;
        PG8_WAIT_V(2); PG8_BAR;
        PG8_STAGE(PG8_SB(1, 0), cB + kstep, voffB); PG8_STAGE(PG8_SA(1, 0), cA + kstep, voffA); PG8_STAGE(PG8_SB(1, 1), cB + hstep + kstep, voffB);
        PG8_WAIT_V(6); PG8_BAR;
    } else {
        PG8_STAGE(PG8_SB(0, 0), cB, voffB); PG8_STAGE(PG8_SA(0, 0), cA, voffA); PG8_STAGE(PG8_SB(0, 1), cB + hstep, voffB); PG8_STAGE(PG8_SA(0, 1), cA + hstep, voffA);
        if (wr == 1) PG8_BAR;
        PG8_WAIT_V(4); PG8_BAR;
        PG8_STAGE(PG8_SB(1, 0), cB + kstep, voffB); PG8_STAGE(PG8_SA(1, 0), cA + kstep, voffA); PG8_STAGE(PG8_SB(1, 1), cB + hstep + kstep, voffB);
        PG8_WAIT_V(6); PG8_BAR;
    }
    for (;;) {
        const bool has_next = S.next(ui + 1, nxt);
        const char* nA = has_next ? (const char*)g.A + (size_t)nxt.pm * tstep : cA; const char* nB = has_next ? (const char*)g.Bt + (size_t)nxt.pn * tstep : cB;
        for (int t = 0; t < nt; t += 2) {
            const bool last = (t == nt - 2);
            const char* a1 = cA + (size_t)(t + 1) * kstep;
            const char* a2 = last ? nA : cA + (size_t)(t + 2) * kstep; const char* b2 = last ? nB : cB + (size_t)(t + 2) * kstep;
            const char* a3 = a2 + kstep; const char* b3 = b2 + kstep;
            if (last && has_next) S.a_ready(nxt);
            if constexpr (SP2) {
            PG8_LDB(B0, 0, 0); PG8_LDB(B1, 0, 1); PG8_SCHED; PG8_LDA(At, 0, 0); PG8_STAGE(PG8_SA(1, 1), a1 + hstep, voffA);
            PG8_WAIT_V(8); PG8_WAIT_L(0); PG8_BAR; PG8_MMA(0, 0, At, B0); PG8_MMA(0, 1, At, B1); PG8_BAR; PG8_SCHED;
            PG8_LDA(At, 0, 1); PG8_STAGE(PG8_SB(0, 0), b2, voffB); PG8_STAGE(PG8_SB(0, 1), b2 + hstep, voffB); PG8_STAGE(PG8_SA(0, 0), a2, voffA);
            PG8_WAIT_V(8); PG8_WAIT_L(0); PG8_BAR; PG8_MMA(1, 0, At, B0); PG8_MMA(1, 1, At, B1); PG8_BAR; PG8_SCHED;
            PG8_LDB(B0, 1, 0); PG8_LDB(B1, 1, 1); PG8_SCHED; PG8_LDA(At, 1, 0); PG8_STAGE(PG8_SA(0, 1), a2 + hstep, voffA);
            PG8_WAIT_V(8); PG8_WAIT_L(0); PG8_BAR; PG8_MMA(0, 0, At, B0); PG8_MMA(0, 1, At, B1); PG8_BAR; PG8_SCHED;
            PG8_LDA(At, 1, 1); PG8_STAGE(PG8_SB(1, 0), b3, voffB); PG8_STAGE(PG8_SB(1, 1), b3 + hstep, voffB); PG8_STAGE(PG8_SA(1, 0), a3, voffA);
            PG8_WAIT_V(8); PG8_WAIT_L(0); PG8_BAR; PG8_MMA(1, 0, At, B0); PG8_MMA(1, 1, At, B1); PG8_BAR; PG8_SCHED;
            } else {
            PG8_LDB(B0, 0, 0); PG8_SCHED; PG8_LDA(At, 0, 0); PG8_STAGE(PG8_SA(1, 1), a1 + hstep, voffA);
            PG8_WAIT_L(8); PG8_BAR; PG8_WAIT_L(0); PG8_MMA(0, 0, At, B0); PG8_BAR; PG8_SCHED;
            PG8_LDB(B1, 0, 1); PG8_STAGE(PG8_SB(0, 0), b2, voffB);
            PG8_BAR; PG8_WAIT_L(0); PG8_MMA(0, 1, At, B1); PG8_BAR;
            PG8_LDA(At, 0, 1); PG8_STAGE(PG8_SA(0, 0), a2, voffA);
            PG8_BAR; PG8_WAIT_L(0); PG8_MMA(1, 0, At, B0); PG8_BAR; PG8_SCHED;
            PG8_STAGE(PG8_SB(0, 1), b2 + hstep, voffB);
            PG8_WAIT_V(6); PG8_BAR; PG8_MMA(1, 1, At, B1); PG8_BAR;
            PG8_LDB(B0, 1, 0); PG8_SCHED; PG8_LDA(At, 1, 0); PG8_STAGE(PG8_SA(0, 1), a2 + hstep, voffA);
            PG8_WAIT_L(8); PG8_BAR; PG8_WAIT_L(0); PG8_MMA(0, 0, At, B0); PG8_BAR; PG8_SCHED;
            PG8_LDB(B1, 1, 1); PG8_STAGE(PG8_SB(1, 0), b3, voffB);
            PG8_BAR; PG8_WAIT_L(0); PG8_MMA(0, 1, At, B1); PG8_BAR;
            PG8_LDA(At, 1, 1); PG8_STAGE(PG8_SA(1, 0), a3, voffA);
            PG8_BAR; PG8_WAIT_L(0); PG8_MMA(1, 0, At, B0); PG8_BAR; PG8_SCHED;
            PG8_STAGE(PG8_SB(1, 1), b3 + hstep, voffB);
            PG8_WAIT_V(6); PG8_BAR; PG8_MMA(1, 1, At, B1); PG8_BAR;
            }
        }
        if constexpr (ALIGN_EPI) { if (wr == 0) PG8_BAR; }
        if constexpr (!Epi::AFTER_DRAIN) { E(acc, cur, wr, wc, fr, fq); S.done(cur); }
        if (!has_next) break;
#pragma unroll
        for (int a = 0; a < 2; ++a)
#pragma unroll
            for (int b = 0; b < 2; ++b)
#pragma unroll
                for (int m = 0; m < 4; ++m)
#pragma unroll
                    for (int n = 0; n < 2; ++n) acc[a][b][m][n] = (f32x4){0.f, 0.f, 0.f, 0.f};
        cur = nxt; cA = nA; cB = nB; ++ui;
        if constexpr (ALIGN_EPI) { if (wr == 1) PG8_BAR; }
    }
    PG8_WAIT_V(0);
    if constexpr (!ALIGN_EPI) { if (wr == 0) PG8_BAR; }
    PG8_BAR;
    if constexpr (Epi::AFTER_DRAIN) { E.fused(acc, cur, wr, wc, fr, fq, lds, wid, lane); S.done(cur); }
#undef PG8_SA
#undef PG8_SB
#undef PG8_STAGE
#undef PG8_LDA
#undef PG8_LDB
#undef PG8_MMA
#undef PG8_WAIT_V
#undef PG8_WAIT_L
#undef PG8_BAR
#undef PG8_SCHED
}
}
#include <hip/hip_bf16.h>
#include <cmath>
namespace attn_body {
using bf16=__hip_bfloat16;
using bf16x8=__attribute__((ext_vector_type(8)))short;
using s16x4=__attribute__((ext_vector_type(4)))short;
using f32x16=__attribute__((ext_vector_type(16)))float;
using u32x4=__attribute__((ext_vector_type(4)))unsigned;
using f32x4v=__attribute__((ext_vector_type(4)))float;
constexpr int BATCH=8,NHEAD=8,SEQ=4096,D=64,DM=NHEAD*D,OPITCH=1024;
constexpr int NW=8,QBLK=32,QB=QBLK*NW,KVBLK=64,NQB=SEQ/QB;
constexpr int ATTN_PITCH=DM, ATTN_UNIT_ROWS=QB;
__device__ __forceinline__ int crow(int r,int hi){return (r&3)+8*(r>>2)+4*hi;}
#define SBAR() __builtin_amdgcn_sched_barrier(0)
__device__ __forceinline__ void cmask(f32x16&p0,f32x16&p1,int jb,int qrel,int hi){
  const float NEG=-INFINITY; int kb=64*jb+4*hi;
  #pragma unroll
  for(int r=0;r<16;++r){int kv=kb+(r&3)+8*(r>>2); if(kv>qrel)p0[r]=NEG; if(kv+32>qrel)p1[r]=NEG;}
}

constexpr int NSLOT=3, SLOTB=8192;
constexpr int LDS_K=0, LDS_V=NSLOT*SLOTB, LDS_WS=2*NSLOT*SLOTB, LDS_OST=LDS_WS+NW*64*4, LDS_BYTES=LDS_OST+NW*4096, LDS_BIAS=LDS_BYTES, LDS_TOTAL=LDS_BIAS+SEQ*4;
constexpr float C2=0.125f*1.4426950408889634f;
__device__ __forceinline__ void glds16(const void*sbase,unsigned voff,unsigned lds_dst){unsigned keep;
  asm volatile("s_mov_b32 %0, m0\n\ts_mov_b32 m0, %3\n\ts_nop 0\n\tglobal_load_lds_dwordx4 %1, %2\n\ts_mov_b32 m0, %0":"=&s"(keep):"v"(voff),"s"(sbase),"s"(lds_dst):"memory");}
__device__ __forceinline__ float max3f(float a,float b,float c){float r;asm("v_max3_f32 %0, %1, %2, %3":"=v"(r):"v"(a),"v"(b),"v"(c));return r;}
__device__ __forceinline__ float max2f(float a,float b){float r;asm("v_max_f32_e32 %0, %1, %2":"=v"(r):"v"(a),"v"(b));return r;}
__device__ __forceinline__ float fadd_s(float a,float b){float r;asm("v_add_f32_e32 %0, %1, %2":"=v"(r):"v"(a),"v"(b));return r;}
__device__ __forceinline__ float fsub_s(float a,float b){float r;asm("v_sub_f32_e32 %0, %1, %2":"=v"(r):"v"(a),"v"(b));return r;}
typedef float f32x2_t __attribute__((ext_vector_type(2))); typedef __bf16 bf16x2_t __attribute__((ext_vector_type(2)));
__device__ __forceinline__ unsigned cvtpk_s(float lo,float hi){f32x2_t v={lo,hi};bf16x2_t b=__builtin_convertvector(v,bf16x2_t);return __builtin_bit_cast(unsigned,b);}
#define WAIT_BAR(N) asm volatile("s_waitcnt vmcnt(" #N ") lgkmcnt(0)\n\ts_barrier":::"memory")

__device__ __forceinline__ void qkt(f32x16&p0,f32x16&p1,const __attribute__((address_space(3))) char*kb,const bf16x8*qr){
  #pragma unroll
  for(int d0=0;d0<4;++d0){
    const bf16x8 b0=*(const __attribute__((address_space(3))) bf16x8*)(kb+d0*2048);
    const bf16x8 b1=*(const __attribute__((address_space(3))) bf16x8*)(kb+d0*2048+512);
    p0=__builtin_amdgcn_mfma_f32_32x32x16_bf16(b0,qr[d0],p0,0,0,0);p1=__builtin_amdgcn_mfma_f32_32x32x16_bf16(b1,qr[d0],p1,0,0,0);}
}
typedef __attribute__((address_space(3))) const char* lds_cptr;
typedef short v4i16_t __attribute__((ext_vector_type(4)));
__device__ __forceinline__ void kload8(bf16x8*kf,lds_cptr kp){
  kf[0]=*(const __attribute__((address_space(3))) bf16x8*)(kp);      kf[1]=*(const __attribute__((address_space(3))) bf16x8*)(kp+512);
  kf[2]=*(const __attribute__((address_space(3))) bf16x8*)(kp+2048); kf[3]=*(const __attribute__((address_space(3))) bf16x8*)(kp+2560);
  kf[4]=*(const __attribute__((address_space(3))) bf16x8*)(kp+4096); kf[5]=*(const __attribute__((address_space(3))) bf16x8*)(kp+4608);
  kf[6]=*(const __attribute__((address_space(3))) bf16x8*)(kp+6144); kf[7]=*(const __attribute__((address_space(3))) bf16x8*)(kp+6656);
}
__device__ __forceinline__ void kload2(bf16x8*kf,lds_cptr kp,int j){ kf[2*j]=*(const __attribute__((address_space(3))) bf16x8*)(kp+j*2048); kf[2*j+1]=*(const __attribute__((address_space(3))) bf16x8*)(kp+j*2048+512); }
__device__ __forceinline__ s16x4 vtr(lds_cptr p){ return __builtin_bit_cast(s16x4,__builtin_amdgcn_ds_read_tr16_b64_v4i16((__attribute__((address_space(3))) v4i16_t*)p)); }
__device__ __forceinline__ float rowmax(const f32x16&p0,const f32x16&p1){
  float a=max3f(p0[0],p0[1],p1[0]),b=max3f(p0[2],p0[3],p1[1]);a=max3f(a,p1[2],p1[3]);
  #pragma unroll
  for(int r=4;r<16;r+=4){a=max3f(a,p0[r],p0[r+1]);b=max3f(b,p0[r+2],p0[r+3]);a=max3f(a,p1[r],p1[r+1]);b=max3f(b,p1[r+2],p1[r+3]);}
  const float m=max2f(a,b);
  auto rr=__builtin_amdgcn_permlane32_swap(__float_as_uint(m),__float_as_uint(m),false,false);
  return max2f(__uint_as_float(rr[0]),__uint_as_float(rr[1]));
}
__device__ __forceinline__ void pv(f32x16*o,int vb,bf16x8 pa0,bf16x8 pa1,bf16x8 pa2,bf16x8 pa3){
  #pragma unroll
  for(int d0=0;d0<2;++d0){s16x4 lo[4],hi[4];
    #pragma unroll
    for(int ks=0;ks<4;++ks){
      asm volatile("ds_read_b64_tr_b16 %0,%1 offset:%c2":"=&v"(lo[ks]):"v"(vb),"i"(d0*4096+ks*1024):"memory");
      asm volatile("ds_read_b64_tr_b16 %0,%1 offset:%c2":"=&v"(hi[ks]):"v"(vb),"i"(d0*4096+ks*1024+512):"memory");}
    asm volatile("s_waitcnt lgkmcnt(0)":::"memory");SBAR();
    #define PK(k) (bf16x8){lo[k][0],lo[k][1],lo[k][2],lo[k][3],hi[k][0],hi[k][1],hi[k][2],hi[k][3]}
    o[d0]=__builtin_amdgcn_mfma_f32_32x32x16_bf16(pa0,PK(0),o[d0],0,0,0);
    o[d0]=__builtin_amdgcn_mfma_f32_32x32x16_bf16(pa1,PK(1),o[d0],0,0,0);
    o[d0]=__builtin_amdgcn_mfma_f32_32x32x16_bf16(pa2,PK(2),o[d0],0,0,0);
    o[d0]=__builtin_amdgcn_mfma_f32_32x32x16_bf16(pa3,PK(3),o[d0],0,0,0);
    #undef PK
  }
}

#ifndef ATTN_STORE16
#define ATTN_STORE16(p,v) (*(u32x4*)(p)=(v))
#endif
template<bool SKIP> __device__ __forceinline__ void attn_unit(int b,int h,int qb,const bf16*Q,const bf16*__restrict__ K,const bf16*__restrict__ V,bf16*O,const float*__restrict__ CB,float qkb,char*shm){
  const int tid=otid(),lane=tid&63,r32=lane&31,hi=lane>>5; const int wid=__builtin_amdgcn_readfirstlane(tid>>6);
  const long rowbase=(long)b*SEQ; const int q0=qb*QB;
  const float*cb=CB+(long)(b*NHEAD+h)*SEQ;
  int t0=0;
  if(SKIP){ const int NTf=(q0+QB)/KVBLK; const float thr=2.f*qkb+40.f; const float cq0=cb[q0];
    bool pred=false; if(lane<NTf-4){ pred=(cq0-cb[64*lane+63])<-thr; }
    const unsigned long long mk=__ballot(pred); t0=(int)__builtin_ctzll(~mk); t0&=~1; t0=__builtin_amdgcn_readfirstlane(t0); }
  const int kv0=t0*KVBLK;
  const int NT=(q0+QB)/KVBLK-t0;
  { __attribute__((address_space(3))) float*bl=(__attribute__((address_space(3))) float*)((lds_cptr)shm+LDS_BIAS); const float*cbk=cb+kv0; for(int i=tid;i<NT*KVBLK;i+=NW*64) bl[i]=-*(const float*)((const char*)cbk+(unsigned)(i*4)); }
  const float negm0=*(const float*)((const char*)(cb+q0+wid*QBLK)+(unsigned)((lane&31)*4))-qkb;
  const bf16*Qw=Q+(rowbase+q0+wid*QBLK)*DM+h*D;
  const bf16*Kh=K+(rowbase+kv0)*DM+h*D,*Vh=V+(rowbase+kv0)*DM+h*D;
  const unsigned lds0=(unsigned)(uintptr_t)shm;
  const unsigned koff=(unsigned)(lane*DM+wid*8)*2u;
  const unsigned voff=(unsigned)((16*(wid&3)+(lane>>2))*DM+(wid>>2)*32+(lane&3)*8)*2u;
  const unsigned kdst=lds0+LDS_K+wid*1024, vdst=lds0+LDS_V+wid*1024;
  #define DMA_K(t,slot) glds16(Kh+(long)(t)*KVBLK*DM,koff,(unsigned)__builtin_amdgcn_readfirstlane(kdst+(slot)))
  #define DMA_V(t,slot) glds16(Vh+(long)(t)*KVBLK*DM,voff,(unsigned)__builtin_amdgcn_readfirstlane(vdst+(slot)))
  bf16x8 kf[8];
  const lds_cptr shm3=(lds_cptr)shm; __attribute__((address_space(3))) float*const wsf=(__attribute__((address_space(3))) float*)(shm3+LDS_WS)+wid*64;
  const lds_cptr kp0=shm3+LDS_K+hi*1024+r32*16; const lds_cptr vp0=shm3+LDS_V+((lane>>4)&1)*32+(lane&3)*8+(4*hi+((lane&15)>>2))*64;
  DMA_K(0,0);DMA_V(0,0);DMA_K(1,SLOTB);
  bf16x8 qr[4];
  #pragma unroll
  for(int d0=0;d0<4;++d0)qr[d0]=*reinterpret_cast<const bf16x8*>((const char*)Qw+(unsigned)((r32*DM+d0*16+hi*8)*2));
  float l_reg=0.f;f32x16 o[2];o[0]=f32x16{};o[1]=f32x16{};
  const __attribute__((address_space(3))) char* bl3=(const __attribute__((address_space(3))) char*)shm+LDS_BIAS+hi*16;
  #define BINIT_ALL(P0,P1,t) do{ const __attribute__((address_space(3))) f32x4v* bp_=(const __attribute__((address_space(3))) f32x4v*)(bl3+(t)*256); \
    _Pragma("unroll") for(int g_=0;g_<4;++g_){ const f32x4v x0_=bp_[2*g_], x1_=bp_[8+2*g_]; \
      P0[4*g_]=x0_[0]+negm0;P0[4*g_+1]=x0_[1]+negm0;P0[4*g_+2]=x0_[2]+negm0;P0[4*g_+3]=x0_[3]+negm0; \
      P1[4*g_]=x1_[0]+negm0;P1[4*g_+1]=x1_[1]+negm0;P1[4*g_+2]=x1_[2]+negm0;P1[4*g_+3]=x1_[3]+negm0; } }while(0)
  const int qrel=wid*QBLK+r32;
  #define CMASK(P0,P1,t) do{int jb_=(t)-(NT-4); if(jb_>=0)cmask(P0,P1,jb_,qrel,hi);}while(0)
  f32x16 pA0,pA1,pB0,pB1;
  int sl_prev=0,sl_cur=0,sl_next=SLOTB;
  #define ROT() do{sl_prev=sl_cur;sl_cur=sl_next;sl_next=(sl_next==(NSLOT-1)*SLOTB)?0:sl_next+SLOTB;}while(0)
  DMA_K(2,2*SLOTB);
  WAIT_BAR(3);
  BINIT_ALL(pA0,pA1,0); qkt(pA0,pA1,kp0,qr);asm volatile("s_nop 15\n\ts_nop 7":"+v"(pA0),"+v"(pA1));CMASK(pA0,pA1,0);
  _Pragma("unroll") for(int r=0;r<16;++r){pA0[r]=__builtin_amdgcn_exp2f(pA0[r]);pA1[r]=__builtin_amdgcn_exp2f(pA1[r]);}
  BINIT_ALL(pB0,pB1,1);
  WAIT_BAR(0);
  DMA_K(3,0);DMA_V(1,SLOTB);
  ROT();
  kload8(kf,kp0+sl_cur);
  WAIT_BAR(2);
  s16x4 vlo[8],vhi[8]; u32x4 pw0,pw1,pw2,pw3;
  #define PKW(P,B) cvtpk_s(P[B],P[B+1])
  #define PAF(k) __builtin_bit_cast(bf16x8,pw##k)
  #define VFR(i) (bf16x8){vlo[i][0],vlo[i][1],vlo[i][2],vlo[i][3],vhi[i][0],vhi[i][1],vhi[i][2],vhi[i][3]}
  #define PIN(x) asm volatile("":"+v"(x))
  #define MX3(a,b,c) __builtin_fmaxf(__builtin_fmaxf((a),(b)),(c))
  #define GAPA(MF,A0,A1,A2,A3,W0,W1,PW) do{ MF; sacc+=A0; sacc+=A1; sacc+=A2; sacc+=A3; PIN(sacc); W0; W1; PIN(PW); SBAR(); }while(0)
  #define EX(v) __builtin_amdgcn_exp2f(v)
  #define GAPB(MF,X,B,GL_,P,GI,NI) do{ MF; X[B]=EX(X[B]); X[B+1]=EX(X[B+1]); X[B+2]=EX(X[B+2]); X[B+3]=EX(X[B+3]); PIN(X); \
    if(GL_){ const f32x4v nx_=bpn_[NI]; P[4*(GI)]=bq_[0]+negm0; P[4*(GI)+1]=bq_[1]+negm0; P[4*(GI)+2]=bq_[2]+negm0; P[4*(GI)+3]=bq_[3]+negm0; bq_=nx_; PIN(P); } SBAR(); }while(0)
  #define VRD(i) do{ vlo[i]=vtr(vp_+(((i)>>2)*4096+((i)&3)*1024)); vhi[i]=vtr(vp_+(((i)>>2)*4096+((i)&3)*1024+512)); }while(0)
  #define KRD(G,j) do{ if(G){ kload2(kf,kp0+sl_next,j); SBAR(); } }while(0)
  #define STEP(C0,C1,P0,P1,t,GK,GV,GL) do{ SBAR(); \
    const lds_cptr vp_=vp0+sl_prev; \
    VRD(0); SBAR(); float sacc=(P0[0]+P0[1]); \
    GAPA(C0=__builtin_amdgcn_mfma_f32_32x32x16_bf16(kf[0],qr[0],C0,0,0,0), P0[2],P0[3],P0[4],P0[5],     pw0[0]=PKW(P0,0), pw0[1]=PKW(P0,2), pw0); \
    VRD(4); SBAR(); GAPA(C1=__builtin_amdgcn_mfma_f32_32x32x16_bf16(kf[1],qr[0],C1,0,0,0), P0[6],P0[7],P0[8],P0[9],     pw0[2]=PKW(P0,4), pw0[3]=PKW(P0,6), pw0); \
    VRD(1); SBAR(); GAPA(C0=__builtin_amdgcn_mfma_f32_32x32x16_bf16(kf[2],qr[1],C0,0,0,0),   P0[10],P0[11],P0[12],P0[13], pw1[0]=PKW(P0,8), pw1[1]=PKW(P0,10), pw1); \
    VRD(5); SBAR(); GAPA(C1=__builtin_amdgcn_mfma_f32_32x32x16_bf16(kf[3],qr[1],C1,0,0,0),   P0[14],P0[15],P1[0],P1[1],   pw1[2]=PKW(P0,12),pw1[3]=PKW(P0,14), pw1); \
    VRD(2); SBAR(); GAPA(C0=__builtin_amdgcn_mfma_f32_32x32x16_bf16(kf[4],qr[2],C0,0,0,0),   P1[2],P1[3],P1[4],P1[5],     pw2[0]=PKW(P1,0), pw2[1]=PKW(P1,2), pw2); \
    VRD(6); SBAR(); GAPA(C1=__builtin_amdgcn_mfma_f32_32x32x16_bf16(kf[5],qr[2],C1,0,0,0),   P1[6],P1[7],P1[8],P1[9],     pw2[2]=PKW(P1,4), pw2[3]=PKW(P1,6), pw2); \
    VRD(3); SBAR(); GAPA(C0=__builtin_amdgcn_mfma_f32_32x32x16_bf16(kf[6],qr[3],C0,0,0,0),   P1[10],P1[11],P1[12],P1[13], pw3[0]=PKW(P1,8), pw3[1]=PKW(P1,10), pw3); \
    VRD(7); SBAR(); GAPA(C1=__builtin_amdgcn_mfma_f32_32x32x16_bf16(kf[7],qr[3],C1,0,0,0),   P1[14],P1[15],0.f,0.f,       pw3[2]=PKW(P1,12),pw3[3]=PKW(P1,14), pw3); \
    l_reg+=sacc; \
    if(GK){DMA_K((t)+3,sl_cur);} if(GV){DMA_V((t)+1,sl_next);} \
    CMASK(C0,C1,t); \
    const __attribute__((address_space(3))) f32x4v* bpn_=(const __attribute__((address_space(3))) f32x4v*)(bl3+((t)+1)*256); f32x4v bq_=f32x4v{}; if(GL){bq_=bpn_[0];} \
    SBAR(); \
    GAPB(o[0]=__builtin_amdgcn_mfma_f32_32x32x16_bf16(PAF(0),VFR(0),o[0],0,0,0), C0,0,GL,P0,0,8); \
    GAPB(o[1]=__builtin_amdgcn_mfma_f32_32x32x16_bf16(PAF(0),VFR(4),o[1],0,0,0), C0,4,GL,P1,0,2); \
    KRD(GL,0); GAPB(o[0]=__builtin_amdgcn_mfma_f32_32x32x16_bf16(PAF(1),VFR(1),o[0],0,0,0), C0,8,GL,P0,1,10); \
    KRD(GL,1); GAPB(o[1]=__builtin_amdgcn_mfma_f32_32x32x16_bf16(PAF(1),VFR(5),o[1],0,0,0), C0,12,GL,P1,1,4); \
    KRD(GL,2); GAPB(o[0]=__builtin_amdgcn_mfma_f32_32x32x16_bf16(PAF(2),VFR(2),o[0],0,0,0), C1,0,GL,P0,2,12); \
    KRD(GL,3); GAPB(o[1]=__builtin_amdgcn_mfma_f32_32x32x16_bf16(PAF(2),VFR(6),o[1],0,0,0), C1,4,GL,P1,2,6); \
    GAPB(o[0]=__builtin_amdgcn_mfma_f32_32x32x16_bf16(PAF(3),VFR(3),o[0],0,0,0), C1,8,GL,P0,3,14); \
    GAPB(o[1]=__builtin_amdgcn_mfma_f32_32x32x16_bf16(PAF(3),VFR(7),o[1],0,0,0), C1,12,GL,P1,3,14); \
    }while(0)
  int t=1;
  #undef CMASK
  #define CMASK(P0,P1,t) do{}while(0)
  for(;t+5<NT;t+=2){
    STEP(pB0,pB1,pA0,pA1,t,true,true,true);     WAIT_BAR(2); ROT();
    STEP(pA0,pA1,pB0,pB1,t+1,true,true,true);   WAIT_BAR(2); ROT();
  }
  #undef CMASK
  #define CMASK(P0,P1,t) do{int jb_=(t)-(NT-4); if(jb_>=0)cmask(P0,P1,jb_,qrel,hi);}while(0)
  #define ENDW(tt) do{ if((tt)+3<NT){WAIT_BAR(2);} else if((tt)+2<NT){WAIT_BAR(1);} else {WAIT_BAR(0);} }while(0)
  for(;t+1<NT;t+=2){
    STEP(pB0,pB1,pA0,pA1,t,(t+3<NT),(t+1<NT),(t+1<NT));       ENDW(t);   ROT();
    STEP(pA0,pA1,pB0,pB1,t+1,(t+4<NT),(t+2<NT),(t+2<NT));     ENDW(t+1); ROT();
  }
  STEP(pB0,pB1,pA0,pA1,NT-1,false,false,false);
  { float sacc=pB0[0]+pB0[1]; _Pragma("unroll") for(int r=2;r<16;++r)sacc+=pB0[r]; _Pragma("unroll") for(int r=0;r<16;++r)sacc+=pB1[r]; l_reg+=sacc;
    pw0=(u32x4){PKW(pB0,0),PKW(pB0,2),PKW(pB0,4),PKW(pB0,6)};pw1=(u32x4){PKW(pB0,8),PKW(pB0,10),PKW(pB0,12),PKW(pB0,14)};pw2=(u32x4){PKW(pB1,0),PKW(pB1,2),PKW(pB1,4),PKW(pB1,6)};pw3=(u32x4){PKW(pB1,8),PKW(pB1,10),PKW(pB1,12),PKW(pB1,14)};
    SBAR(); pv(o,(int)(unsigned)(uintptr_t)vp0+sl_cur,PAF(0),PAF(1),PAF(2),PAF(3)); }
  #undef PKW
  #undef PAF
  #undef VFR
  #undef PIN
  #undef MX3
  #undef GAPA
  #undef GAPB
  #undef EX
  #undef VRD
  #undef KRD
  #undef STEP
  #undef ENDW
  {auto rr=__builtin_amdgcn_permlane32_swap(__float_as_uint(l_reg),__float_as_uint(l_reg),false,false);l_reg=__uint_as_float(rr[0])+__uint_as_float(rr[1]);}
  if(hi==0)wsf[32+r32]=l_reg;asm volatile("s_waitcnt lgkmcnt(0)":::"memory");
  float rli[16];
  #pragma unroll
  for(int r=0;r<16;++r)rli[r]=__builtin_amdgcn_rcpf(wsf[32+crow(r,hi)]);
  bf16*Ow=O+(rowbase+q0+wid*QBLK)*OPITCH+h*D;
  { __attribute__((address_space(3))) unsigned short*stg=(__attribute__((address_space(3))) unsigned short*)(shm3+LDS_OST)+wid*2048;
    #pragma unroll
    for(int r=0;r<16;++r){const int orow=crow(r,hi);
      #pragma unroll
      for(int d0=0;d0<2;++d0)stg[orow*64+d0*32+r32]=(unsigned short)(cvtpk_s(o[d0][r]*rli[r],0.f)&0xffffu);}
    asm volatile("s_waitcnt lgkmcnt(0)":::"memory");
    #pragma unroll
    for(int i=0;i<4;++i){const int row=i*8+(lane>>3),ch=lane&7; const u32x4 v=*(const __attribute__((address_space(3))) u32x4*)(stg+row*64+ch*8); ATTN_STORE16((char*)Ow+(unsigned)((row*OPITCH+ch*8)*2),v);} }
  asm volatile("s_waitcnt lgkmcnt(0)\n\ts_barrier":::"memory");
  #undef DMA_K
  #undef DMA_V
  #undef CMASK
  #undef BINIT_ALL
  #undef ROT
}
constexpr int ATTN_LDS_BYTES=LDS_TOTAL;
struct AttnTensors { const bf16* Q; const bf16* K; const bf16* V; bf16* O; const float* CB; float qkb; };
struct AttnUnit { int bh; int qb; };
struct StaticOrder {
  int vcu,G;
  __device__ __forceinline__ explicit StaticOrder(int grid,int block):vcu((grid%8==0)?(block%8)*(grid/8)+block/8:block),G(grid){}
  __device__ __forceinline__ bool next(int i,AttnUnit&u)const{
    if(G==256){ if(i>=4)return false; const int s=vcu&3; u.bh=vcu>>2; u.qb=(i==0)?s:(i==1)?7-s:(i==2)?8+s:15-s; return true; }
    const int id=vcu+i*G; if(id>=BATCH*NHEAD*NQB)return false; u.bh=id/NQB; u.qb=id%NQB; return true; }
};
template<class Sched,bool SKIP> __device__ __forceinline__ void attn_phase(char*lds,const AttnTensors&T,const Sched&S){
  AttnUnit u;
  for(int i=0;S.next(i,u);++i){ attn_unit<SKIP>(u.bh/NHEAD,u.bh%NHEAD,u.qb,T.Q,T.K,T.V,T.O,T.CB,T.qkb,lds); }
}
#undef SBAR
#undef WAIT_BAR
}
#define GAS __attribute__((address_space(1)))
#define LAS __attribute__((address_space(3)))
typedef unsigned short bf16;
typedef unsigned v4u __attribute__((ext_vector_type(4)));
typedef float f32x4 __attribute__((ext_vector_type(4)));
typedef short bf16x8 __attribute__((ext_vector_type(8)));
typedef GAS unsigned gu32;
typedef GAS unsigned long long gu64;
#define RLX_AGENT __ATOMIC_RELAXED, __HIP_MEMORY_SCOPE_AGENT
#define LDS_WAIT() asm volatile("s_waitcnt lgkmcnt(0)" ::: "memory")
#define VM_WAIT() asm volatile("s_waitcnt vmcnt(0)" ::: "memory")
__device__ __forceinline__ unsigned long long rt() { return __builtin_amdgcn_s_memrealtime(); }
__device__ __forceinline__ unsigned f2bf(float f) { unsigned u = __builtin_bit_cast(unsigned, f); return (u + 0x7fffu + ((u >> 16) & 1u)) >> 16; }
__device__ __forceinline__ unsigned pk2(float lo, float hi) { return f2bf(lo) | (f2bf(hi) << 16); }

#define XB_TMO      128
#define XB_XCNT(j)  (256  + 64 * (j))
#define XB_XSUB(j)  (1280 + 64 * (j))
#define XB_XGEN(j)  (2304 + 64 * (j))
#define XB_TOP      3328
#define XB_TOPGEN   3392
#define XCD_BAR_WORDS 3456
#define XB_SPIN_CAP (1u << 18)

__device__ __forceinline__ unsigned xb_ld(unsigned* p)              { return __hip_atomic_load(p, __ATOMIC_RELAXED, __HIP_MEMORY_SCOPE_AGENT); }
__device__ __forceinline__ unsigned xb_add(unsigned* p, unsigned v) { return __hip_atomic_fetch_add(p, v, __ATOMIC_RELAXED, __HIP_MEMORY_SCOPE_AGENT); }
__device__ __forceinline__ unsigned xb_xcc_id() { return (unsigned)__builtin_amdgcn_s_getreg((3 << 11) | 20) & 0xFu; }
#define XB_SPIN(cond, bar) do { unsigned _sp = 0; while (cond) { __builtin_amdgcn_s_sleep(1); \
    if ((++_sp & 255u) == 0u) { if (xb_ld(&(bar)[XB_TMO])) break; if (_sp > XB_SPIN_CAP) { atomicAdd(&(bar)[XB_TMO], 1u); break; } } } } while (0)

struct XcdBarrier {
    unsigned* bar; unsigned x;
    volatile LAS unsigned* st;
};

__device__ __forceinline__ XcdBarrier xcd_barrier_post(unsigned* bar, volatile LAS unsigned* st) {
    XcdBarrier b; b.bar = bar; b.x = xb_xcc_id(); b.st = st;
    if (threadIdx.x == 0) (void)xb_add(&bar[XB_XCNT(b.x)], 1u);
    return b;
}
__device__ __forceinline__ void xcd_barrier_complete(unsigned* bar, unsigned x, unsigned& nloc, unsigned& nx) {
    const unsigned G = gridDim.x * gridDim.y * gridDim.z;
    unsigned sum, cnt, mine, sp = 0u;
    for (;;) {
        sum = 0u; cnt = 0u; mine = 0u;
#pragma unroll
        for (unsigned j = 0; j < 16; ++j) { const unsigned c = xb_ld(&bar[XB_XCNT(j)]); sum += c; cnt += (c > 0u) ? 1u : 0u; mine = (j == x) ? c : mine; }
        if (sum == G) break;
        __builtin_amdgcn_s_sleep(1);
        if ((++sp & 255u) == 0u) { if (xb_ld(&bar[XB_TMO])) break; if (sp > XB_SPIN_CAP) { atomicAdd(&bar[XB_TMO], 1u); break; } }
    }
    nloc = mine > 0u ? mine : 1u; nx = cnt > 0u ? cnt : 1u;
}

__device__ __forceinline__ void xcd_barrier(const XcdBarrier& b) {
    asm volatile("s_waitcnt vmcnt(0)" ::: "memory");
    __syncthreads();
    if (threadIdx.x == 0) {
        unsigned* bar = b.bar;
        __builtin_amdgcn_s_waitcnt(0);
        unsigned nloc = b.st[0], nx = b.st[1];
        if (nloc == 0u) { xcd_barrier_complete(bar, b.x, nloc, nx); b.st[0] = nloc; b.st[1] = nx; }
        const unsigned old = xb_add(&bar[XB_XSUB(b.x)], 1u);
        const unsigned gen = old / nloc;
        if (old + 1u == (gen + 1u) * nloc) {
            __builtin_amdgcn_fence(__ATOMIC_RELEASE, "agent");
            asm volatile("s_waitcnt vmcnt(0)" ::: "memory");
            const unsigned og = xb_add(&bar[XB_TOP], 1u);
            const unsigned tg = og / nx;
            if (og + 1u == (tg + 1u) * nx) xb_add(&bar[XB_TOPGEN], 1u);
            else XB_SPIN(xb_ld(&bar[XB_TOPGEN]) == tg, bar);
            __builtin_amdgcn_fence(__ATOMIC_ACQUIRE, "agent");
            xb_add(&bar[XB_XGEN(b.x)], 1u);
            asm volatile("s_waitcnt vmcnt(0)" ::: "memory");
        } else {
            XB_SPIN(xb_ld(&bar[XB_XGEN(b.x)]) == gen, bar);
            __builtin_amdgcn_fence(__ATOMIC_ACQUIRE, "agent");
            asm volatile("s_waitcnt vmcnt(0)" ::: "memory");
        }
    }
    __syncthreads();
}
struct Args { const float* in[25]; float* out; unsigned char* ws; int ph_lo, ph_hi, use_bar, pad; };
typedef const __attribute__((address_space(4))) Args* KArgs;
#define CAND_LIST CAND(0,0,2,1) CAND(0,1,2,2) CAND(0,2,2,3) CAND(0,3,2,4) CAND(0,4,3,0) CAND(0,5,3,1) CAND(0,6,3,2) CAND(0,7,3,3) CAND(0,8,4,0) CAND(0,9,4,1) CAND(0,10,4,2) CAND(0,11,5,0) CAND(0,12,5,1) CAND(0,13,6,0) CAND(0,14,6,1) CAND(0,15,7,0) CAND(1,0,7,1) CAND(1,1,8,0) CAND(1,2,9,0) CAND(1,3,10,0) CAND(1,4,11,0) CAND(1,5,12,0) CAND(1,6,13,0) CAND(1,7,14,0) CAND(2,0,15,0)
constexpr int NB = 8, SEQ = 4096, DM = 1024, NTOK = NB * SEQ;
constexpr int NH = 8, HD = 64, AW = 512, PWD = 256, SWD = 256, INC = 2056;
constexpr int NEXP = 16384, PQW = 2048;
constexpr float EPSN = 1e-6f, LOG2E = 1.4426950408889634f;
constexpr int NWAVES = 8, NTHR = 512;
constexpr size_t MiB = 1u << 20;
constexpr size_t WS_CTL = 0, CTL_ZERO_BYTES = 1 * MiB;
constexpr size_t WS_WIN = 1 * MiB;
constexpr size_t WS_WOUT = 9 * MiB;
constexpr size_t WS_WQ = 13 * MiB;
constexpr size_t WS_KEYS = 21 * MiB;
constexpr size_t WS_WGLU = 22 * MiB;
constexpr size_t WS_WF = 22 * MiB + 512 * 1024;
constexpr size_t WS_CB = 23 * MiB;
constexpr size_t WS_XLOC = 24 * MiB;
constexpr size_t WS_IDX = 28 * MiB;
constexpr size_t WS_GATE = 44 * MiB;
constexpr size_t WS_Z = 60 * MiB;
constexpr size_t WS_U = 76 * MiB;
constexpr size_t WS_V = 140 * MiB;
constexpr size_t WS_XN = 204 * MiB;
constexpr size_t WS_P = 268 * MiB;
constexpr size_t WS_MG = 396 * MiB;
constexpr size_t WS_END = 460 * MiB;
constexpr int CW_BAR = 4096;
constexpr float U8_SCALE = 512.f, V8_SCALE = 32.f, ACT_SCALE = 64.f;
constexpr int RING_BYTES = 131072, LDSCTL_OFF = RING_BYTES, MISC_OFF = LDSCTL_OFF + 320, LDS_BYTES = 147456;
static_assert(attn_body::ATTN_LDS_BYTES <= RING_BYTES, "attention scratch fits the ring");

typedef _Float16 h16x2 __attribute__((ext_vector_type(2)));
typedef float f32x16 __attribute__((ext_vector_type(16)));
typedef unsigned u32x2 __attribute__((ext_vector_type(2)));

__device__ __forceinline__ float bf2f(unsigned short b) { return __uint_as_float((unsigned)b << 16); }
__device__ __forceinline__ float bflo(unsigned w) { return __uint_as_float(w << 16); }
__device__ __forceinline__ float bfhi(unsigned w) { return __uint_as_float(w & 0xffff0000u); }
__device__ __forceinline__ h16x2 as_h2(unsigned w) { return __builtin_bit_cast(h16x2, w); }
template <bool HI> __device__ __forceinline__ h16x2 cvt8h(int w) { return __builtin_bit_cast(h16x2, __builtin_amdgcn_cvt_scalef32_pk_f16_fp8(w, 1.0f, HI)); }
__device__ __forceinline__ float gelu_tanh(float x) { const float u = 1.5957691216057308f * (x + 0.044715f * x * x * x); return x / (1.f + __expf(-u)); }
__device__ __forceinline__ float wave_sum(float v) {
#pragma unroll
    for (int o = 1; o < 64; o <<= 1) v += __shfl_xor(v, o);
    return v;
}
__device__ __forceinline__ float wave_max(float v) {
#pragma unroll
    for (int o = 1; o < 64; o <<= 1) v = fmaxf(v, __shfl_xor(v, o));
    return v;
}
template <int N, int S0> __device__ __forceinline__ float bfly_reduce(float (&v)[N], int lane) {
    int s = S0;
#pragma unroll
    for (int cnt = N; cnt > 1; cnt >>= 1) {
        const bool up = (lane & s) != 0;
#pragma unroll
        for (int i = 0; i < cnt / 2; ++i) { const float a = v[i], b = v[i + cnt / 2]; const float send = up ? a : b, keep = up ? b : a; v[i] = keep + __shfl_xor(send, s); }
        s >>= 1;
    }
    float r = v[0];
    for (; s >= 1; s >>= 1) r += __shfl_xor(r, s);
    return r;
}

__device__ __forceinline__ void tr_item(const float* W, int ldw, int srccol, bf16* WT, int K, int dstrow, int k0, LAS float* scr, int lane) {
#pragma unroll 8
    for (int i = 0; i < 32; ++i) { const int kk = 2 * i + (lane >> 5); scr[kk * 33 + (lane & 31)] = W[(size_t)(k0 + kk) * ldw + srccol + (lane & 31)]; }
    LDS_WAIT(); asm volatile("" ::: "memory");
    const int c = lane & 7;
#pragma unroll
    for (int j = 0; j < 4; ++j) { const int n = (lane >> 3) + 8 * j; const LAS float* s = scr + (8 * c) * 33 + n;
        v4u o; o.x = pk2(s[0 * 33], s[1 * 33]); o.y = pk2(s[2 * 33], s[3 * 33]); o.z = pk2(s[4 * 33], s[5 * 33]); o.w = pk2(s[6 * 33], s[7 * 33]);
        *(GAS v4u*)(WT + (size_t)(dstrow + n) * K + k0 + 8 * c) = o; }
    LDS_WAIT(); asm volatile("" ::: "memory");
}
__device__ __forceinline__ void phase_prep(KArgs a, LAS unsigned char* lds, int G, int vcu, int tid, int lane, int wave) {
    unsigned char* ws = a->ws;
    LAS float* scr = (LAS float*)(lds + wave * 16384);
    const int gw = vcu * NWAVES + wave, NGW = G * NWAVES;
    constexpr int I_IN = 2048, I_OUT = 1024, I_WQ = 2048, I_GLU = 64;
    for (int it = gw; it < I_IN + I_OUT + I_WQ + I_GLU; it += NGW) {
        int r = it;
        if (r < I_IN) { const int l = r >> 10, q = r & 1023, kb = q >> 6, nb = q & 63, n0 = nb * 32;
            tr_item(a->in[2] + (size_t)l * DM * INC, INC, n0 + (n0 >= 1536 ? 8 : 0), (bf16*)(ws + WS_WIN) + (size_t)l * 2048 * 1024, 1024, n0, kb * 64, scr, lane); continue; }
        r -= I_IN;
        if (r < I_OUT) { const int l = r >> 9, q = r & 511, kb = q >> 5, nb = q & 31;
            tr_item(a->in[19] + (size_t)l * DM * DM, DM, nb * 32, (bf16*)(ws + WS_WOUT) + (size_t)l * 1024 * 1024, 1024, nb * 32, kb * 64, scr, lane); continue; }
        r -= I_OUT;
        if (r < I_WQ) { const int l = r >> 10, q = r & 1023, kb = q >> 6, nb = q & 63;
            tr_item(a->in[21] + (size_t)l * DM * PQW, PQW, nb * 32, (bf16*)(ws + WS_WQ) + (size_t)l * 2048 * 1024, 1024, nb * 32, kb * 64, scr, lane); continue; }
        r -= I_WQ;
        { const int l = r >> 5, q = r & 31, kb = q >> 3, nb = q & 7;
            tr_item(a->in[16] + (size_t)l * 256 * 256, 256, nb * 32, (bf16*)(ws + WS_WGLU) + (size_t)l * 256 * 256, 256, nb * 32, kb * 64, scr, lane); }
    }
    const size_t gt = (size_t)vcu * NTHR + tid, NGT = (size_t)G * NTHR;
    for (size_t i = gt; i < 2 * 8 * 1024; i += NGT) { const int l = (int)(i >> 13), h = (int)(i >> 10) & 7, k = (int)i & 1023;
        ((float*)(ws + WS_WF))[i] = a->in[2][((size_t)l * DM + k) * INC + 1536 + h]; }
    { const float* src = a->in[22]; bf16* dst = (bf16*)(ws + WS_KEYS);
      for (size_t i = gt; i < (size_t)2 * 8 * 2 * 128 * 128 / 8; i += NGT) { const f32x4 x0 = *(const f32x4*)(src + i * 8), x1 = *(const f32x4*)(src + i * 8 + 4);
          v4u o; o.x = pk2(x0[0], x0[1]); o.y = pk2(x0[2], x0[3]); o.z = pk2(x1[0], x1[1]); o.w = pk2(x1[2], x1[3]); *(v4u*)(dst + i * 8) = o; } }
#pragma unroll 1
    for (int tb = 0; tb < 2; ++tb) { const float* src = a->in[23 + tb]; unsigned char* dst = ws + (tb ? WS_V : WS_U); const float sc = tb ? V8_SCALE : U8_SCALE;
      for (size_t i = gt; i < (size_t)2 * NEXP * DM / 16; i += NGT) { v4u o;
#pragma unroll
          for (int q = 0; q < 4; ++q) { f32x4 x = *(const f32x4*)(src + i * 16 + 4 * q) * sc;
              x[0] = fminf(fmaxf(x[0], -448.f), 448.f); x[1] = fminf(fmaxf(x[1], -448.f), 448.f); x[2] = fminf(fmaxf(x[2], -448.f), 448.f); x[3] = fminf(fmaxf(x[3], -448.f), 448.f);
              int w = 0; w = __builtin_amdgcn_cvt_pk_fp8_f32(x[0], x[1], w, false); w = __builtin_amdgcn_cvt_pk_fp8_f32(x[2], x[3], w, true); o[q] = (unsigned)w; }
          const size_t r = i >> 6; const unsigned cg = (unsigned)(i & 63), l = (unsigned)(r / NEXP), rl = (unsigned)(r % NEXP);
          *(v4u*)(dst + (size_t)l * NEXP * DM + (size_t)(cg >> 3) * NEXP * 128 + (size_t)rl * 128 + (cg & 7u) * 16u) = o; } }
}

template <bool FLOGIT> __device__ __forceinline__ void phase_rownorm(const float* x, const float* g, bf16* XN, const float* WF, const float* fbias, float* CB, int G, int vcu, int lane, int wave) {
    const int gw = vcu * NWAVES + wave, NGW = G * NWAVES;
    f32x4 gv[4];
#pragma unroll
    for (int j = 0; j < 4; ++j) gv[j] = *(const f32x4*)(g + 4 * lane + 256 * j);
    for (int rg = gw; rg < NTOK / 2; rg += NGW) {
        f32x4 v[2][4];
#pragma unroll
        for (int r = 0; r < 2; ++r) { const float* xr = x + (size_t)(rg * 2 + r) * DM + 4 * lane;
#pragma unroll
            for (int j = 0; j < 4; ++j) v[r][j] = *(const f32x4*)(xr + 256 * j); }
#pragma unroll
        for (int r = 0; r < 2; ++r) { float s = 0.f;
#pragma unroll
            for (int j = 0; j < 4; ++j) s += (v[r][j][0] * v[r][j][0] + v[r][j][1] * v[r][j][1]) + (v[r][j][2] * v[r][j][2] + v[r][j][3] * v[r][j][3]);
            const float rstd = 1.0f / sqrtf(wave_sum(s) * (1.f / DM) + EPSN);
            bf16* orow = XN + (size_t)(rg * 2 + r) * DM + 4 * lane;
#pragma unroll
            for (int j = 0; j < 4; ++j) { v[r][j] = v[r][j] * rstd * gv[j]; u32x2 w; w.x = pk2(v[r][j][0], v[r][j][1]); w.y = pk2(v[r][j][2], v[r][j][3]); *(u32x2*)(orow + 256 * j) = w; } }
        if (FLOGIT) {
            float acc[16];
#pragma unroll
            for (int i = 0; i < 16; ++i) acc[i] = 0.f;
#pragma unroll
            for (int h = 0; h < 8; ++h)
#pragma unroll
                for (int j = 0; j < 4; ++j) { const f32x4 w = *(const f32x4*)(WF + h * 1024 + 4 * lane + 256 * j);
#pragma unroll
                    for (int r = 0; r < 2; ++r) acc[r * 8 + h] += (v[r][j][0] * w[0] + v[r][j][1] * w[1]) + (v[r][j][2] * w[2] + v[r][j][3] * w[3]); }
            const float tot = bfly_reduce<16, 32>(acc, lane);
            if ((lane & 3) == 0) { const int id = (lane >> 2) & 15, r = id >> 3, h = id & 7; const int row = rg * 2 + r, b = row / SEQ, s = row % SEQ;
                const float z = tot + fbias[h];
                const float ls = fminf(z, 0.f) - __logf(1.f + __expf(-fabsf(z)));
                CB[((size_t)(b * NH + h)) * SEQ + s] = ls * LOG2E; }
        }
    }
}

__device__ __forceinline__ void phase_headnorm(bf16* Q, bf16* K, const float* qg, const float* kg, float* CB, int G, int vcu, int lane, int wave) {
    const int gw = vcu * NWAVES + wave, NGW = G * NWAVES;
    for (int sq = gw; sq < NB * NH; sq += NGW) {
        float* c = CB + (size_t)sq * SEQ; float carry = 0.f;
        for (int it = 0; it < SEQ / 64; ++it) { float v = c[it * 64 + lane];
#pragma unroll
            for (int o = 1; o < 64; o <<= 1) { const float t = __shfl_up(v, o); if (lane >= o) v += t; }
            v += carry; c[it * 64 + lane] = v; carry = __shfl(v, 63); }
    }
    float gq[8], gk[8];
#pragma unroll
    for (int j = 0; j < 8; ++j) { gq[j] = qg[8 * (lane & 7) + j] * (0.125f * LOG2E); gk[j] = kg[8 * (lane & 7) + j]; }
    for (int row = gw; row < NTOK; row += NGW) {
#pragma unroll
        for (int which = 0; which < 2; ++which) {
            bf16* p = (which ? K : Q) + (size_t)row * AW + 8 * lane;
            const v4u w = *(const v4u*)p; float f[8] = {bflo(w.x), bfhi(w.x), bflo(w.y), bfhi(w.y), bflo(w.z), bfhi(w.z), bflo(w.w), bfhi(w.w)};
            float s = 0.f;
#pragma unroll
            for (int j = 0; j < 8; ++j) s += f[j] * f[j];
            s += __shfl_xor(s, 1); s += __shfl_xor(s, 2); s += __shfl_xor(s, 4);
            const float rstd = 1.0f / sqrtf(s * (1.f / 64.f) + EPSN);
#pragma unroll
            for (int j = 0; j < 8; ++j) f[j] = f[j] * rstd * (which ? gk[j] : gq[j]);
            v4u o; o.x = pk2(f[0], f[1]); o.y = pk2(f[2], f[3]); o.z = pk2(f[4], f[5]); o.w = pk2(f[6], f[7]); *(v4u*)p = o;
        }
    }
}

__device__ __forceinline__ void phase_pool(const bf16* PS, const float* pw, const float* pscale, const float* ong, bf16* MG, LAS unsigned char* lds, int G, int bx, int tid, int lane, int wave) {
    LAS float* ut = (LAS float*)lds;
    LAS float* pl = (LAS float*)(lds + 47 * 256 * 4);
    const int ch = tid & 255, half = tid >> 8, g = ch >> 6, w = 2 << g;
    float wcol[64];
#pragma unroll
    for (int c = 0; c < 64; ++c) wcol[c] = pw[(g * 64 + c) * 64 + (ch & 63)];
    const float psc = pscale[ch];
    const f32x4 gn = *(const f32x4*)(ong + 512 + 4 * lane);
    for (int tile = bx; tile < NTOK / 32; tile += G) {
        const int tok0 = tile * 32, s0 = tok0 % SEQ;
        for (int idx = tid; idx < 47 * 32; idx += NTHR) { const int rr = idx >> 5, cq = idx & 31, r = rr - 15;
            v4u wv = {0u, 0u, 0u, 0u}; if (s0 + r >= 0) wv = *(const v4u*)(PS + (size_t)(tok0 + r) * 512 + cq * 8);
            LAS float* d = ut + rr * 256 + cq * 8;
            d[0] = bflo(wv.x); d[1] = bfhi(wv.x); d[2] = bflo(wv.y); d[3] = bfhi(wv.y); d[4] = bflo(wv.z); d[5] = bfhi(wv.z); d[6] = bflo(wv.w); d[7] = bfhi(wv.w); }
        __syncthreads();
#pragma unroll 1
        for (int tt = 0; tt < 16; ++tt) { const int ti = half * 16 + tt, rr = ti + 15, pos = s0 + ti;
            float s = 0.f; for (int j = 0; j < w; ++j) s += ut[(rr - j) * 256 + ch];
            const int cnt = (pos + 1 < w) ? pos + 1 : w;
            pl[ti * 256 + ch] = s / (float)cnt - ut[rr * 256 + ch]; }
        __syncthreads();
#pragma unroll 1
        for (int tt = 0; tt < 16; ++tt) { const int ti = half * 16 + tt; const LAS float* pr = pl + ti * 256 + g * 64;
            float acc = 0.f;
#pragma unroll
            for (int c = 0; c < 64; ++c) acc += pr[c] * wcol[c];
            ut[ti * 256 + ch] = acc * psc; }
        __syncthreads();
#pragma unroll
        for (int q = 0; q < 4; ++q) { const int ti = wave * 4 + q; const f32x4 v = *(const LAS f32x4*)(ut + ti * 256 + 4 * lane);
            const float ss = wave_sum((v[0] * v[0] + v[1] * v[1]) + (v[2] * v[2] + v[3] * v[3]));
            const float rstd = 1.0f / sqrtf(ss * (1.f / 256.f) + EPSN);
            u32x2 o; o.x = pk2(v[0] * rstd * gn[0], v[1] * rstd * gn[1]); o.y = pk2(v[2] * rstd * gn[2], v[3] * rstd * gn[3]);
            *(u32x2*)(MG + (size_t)(tok0 + ti) * DM + 512 + 4 * lane) = o; }
        __syncthreads();
    }
}

template <bool PASS2> __device__ __forceinline__ void phase_s5(KArgs a, int l, const bf16* PS, float* XLOC, bf16* Z, LAS unsigned char* lds, int G, int bx, int lane, int wave) {
    LAS float* Xs = (LAS float*)(lds + wave * (16 * 130 * 4));
    const int p = lane, kq = lane >> 4, ln = lane & 15;
    for (int task = bx; task < NB * 16 * 8; task += G) {
        const int b = task >> 7, g = (task >> 3) & 15, c = (task & 7) * 8 + wave;
        const size_t tok_c = (size_t)b * SEQ + c * 64;
        const float a_re = a->in[8][(l * 16 + g) * 64 + p], a_im = a->in[9][(l * 16 + g) * 64 + p], ldt = a->in[10][l * 16 + g];
        u32x2 uraw[4];
#pragma unroll
        for (int sub = 0; sub < 4; ++sub) uraw[sub] = *(const u32x2*)(PS + (tok_c + sub * 16 + ln) * 512 + 256 + g * 16 + 4 * kq);
        float braw[4][4], biaw[4][4];
#pragma unroll
        for (int q = 0; q < 4; ++q)
#pragma unroll
            for (int ks = 0; ks < 4; ++ks) { const size_t bi = ((size_t)((l * 16 + g) * 64 + 16 * q + ln)) * 16 + 4 * kq + ks; braw[q][ks] = a->in[11][bi]; biaw[q][ks] = a->in[12][bi]; }
        float cfrag[32]; float dsk = 0.f; unsigned short usk[16];
        if (PASS2) {
#pragma unroll
            for (int ks = 0; ks < 32; ++ks) { const int k = 4 * ks + kq, pp = k & 63; const size_t ci = ((size_t)((l * 16 + g) * 16 + ln)) * 64 + pp;
                cfrag[ks] = (ks < 16) ? a->in[13][ci] : -a->in[14][ci]; }
            dsk = a->in[15][l * 256 + g * 16 + ln];
#pragma unroll
            for (int i = 0; i < 16; ++i) usk[i] = PS[(tok_c + (i >> 2) * 16 + 4 * kq + (i & 3)) * 512 + 256 + g * 16 + ln];
        }
        const float dt = expf(ldt);
        float abr, abi, fr, fi;
        { const float xx = a_re * dt, yy = a_im * dt; const float ex = expf(xx); float sn, cs; sincosf(yy, &sn, &cs);
          abr = ex * cs; abi = ex * sn;
          const float sh = sinf(0.5f * yy); const float er = expm1f(xx) * cs - 2.f * sh * sh, ei = abi;
          const float den = a_re * a_re + a_im * a_im; fr = (er * a_re + ei * a_im) / den; fi = (ei * a_re - er * a_im) / den; }
        float bfrag[8][4];
#pragma unroll
        for (int q = 0; q < 4; ++q) { const float frq = __shfl(fr, 16 * q + ln), fiq = __shfl(fi, 16 * q + ln);
#pragma unroll
            for (int ks = 0; ks < 4; ++ks) { bfrag[q][ks] = frq * braw[q][ks] - fiq * biaw[q][ks]; bfrag[4 + q][ks] = frq * biaw[q][ks] + fiq * braw[q][ks]; } }
        float xr = 0.f, xi = 0.f;
        if (PASS2) {
            float pr = abr, pi = abi;
#pragma unroll
            for (int q = 0; q < 6; ++q) { const float nr = pr * pr - pi * pi, ni = 2.f * pr * pi; pr = nr; pi = ni; }
            const float* xl = XLOC + ((size_t)(b * 16 + g) * 64) * 128 + p;
            int j = 0;
#pragma unroll 1
            for (; j + 16 <= c; j += 16) { float lr[16], li[16];
#pragma unroll
                for (int q = 0; q < 16; ++q) { lr[q] = xl[(size_t)(j + q) * 128]; li[q] = xl[(size_t)(j + q) * 128 + 64]; }
#pragma unroll
                for (int q = 0; q < 16; ++q) { const float nr = pr * xr - pi * xi + lr[q], ni = pr * xi + pi * xr + li[q]; xr = nr; xi = ni; } }
            { float lr[16], li[16];
#pragma unroll
                for (int q = 0; q < 16; ++q) { const int jj = (j + q < c) ? j + q : 0; lr[q] = xl[(size_t)jj * 128]; li[q] = xl[(size_t)jj * 128 + 64]; }
#pragma unroll
                for (int q = 0; q < 16; ++q) if (j + q < c) { const float nr = pr * xr - pi * xi + lr[q], ni = pr * xi + pi * xr + li[q]; xr = nr; xi = ni; } }
        }
#pragma unroll
        for (int sub = 0; sub < 4; ++sub) {
            const size_t tokb = tok_c + sub * 16;
            const float ua[4] = {bflo(uraw[sub].x), bfhi(uraw[sub].x), bflo(uraw[sub].y), bfhi(uraw[sub].y)};
#pragma unroll
            for (int nb = 0; nb < 8; ++nb) { f32x4 acc = {0.f, 0.f, 0.f, 0.f};
#pragma unroll
                for (int ks = 0; ks < 4; ++ks) acc = __builtin_amdgcn_mfma_f32_16x16x4f32(ua[ks], bfrag[nb][ks], acc, 0, 0, 0);
#pragma unroll
                for (int r = 0; r < 4; ++r) Xs[(4 * kq + r) * 130 + 16 * nb + ln] = acc[r]; }
            float bur[16], bui[16];
#pragma unroll
            for (int i = 0; i < 16; ++i) { bur[i] = Xs[i * 130 + p]; bui[i] = Xs[i * 130 + 64 + p]; }
#pragma unroll
            for (int i = 0; i < 16; ++i) { const float nr = abr * xr - abi * xi + bur[i], ni = abr * xi + abi * xr + bui[i]; xr = nr; xi = ni;
                if (PASS2) { Xs[i * 130 + p] = xr; Xs[i * 130 + 64 + p] = xi; } }
            if (PASS2) {
                f32x4 y0 = {0.f, 0.f, 0.f, 0.f}, y1 = {0.f, 0.f, 0.f, 0.f};
#pragma unroll
                for (int ks = 0; ks < 32; ks += 2) { y0 = __builtin_amdgcn_mfma_f32_16x16x4f32(Xs[ln * 130 + 4 * ks + kq], cfrag[ks], y0, 0, 0, 0);
                    y1 = __builtin_amdgcn_mfma_f32_16x16x4f32(Xs[ln * 130 + 4 * (ks + 1) + kq], cfrag[ks + 1], y1, 0, 0, 0); }
#pragma unroll
                for (int r = 0; r < 4; ++r) { const size_t tk = tokb + 4 * kq + r; const float uv = bf2f(usk[sub * 4 + r]);
                    const float y = y0[r] + y1[r] + dsk * uv; Z[tk * 256 + g * 16 + ln] = (bf16)f2bf(gelu_tanh(y)); }
            }
        }
        if (!PASS2) { float* xl = XLOC + ((size_t)((b * 16 + g) * 64 + c)) * 128 + p; xl[0] = xr; xl[64] = xi; }
    }
}

__device__ __forceinline__ void phase_glu(const bf16* Z, const bf16* WG, const float* gb, const float* ong, bf16* MG, LAS unsigned char* lds, int G, int bx, int vcu, int tid, int lane, int wave) {
    LAS unsigned char* zt = lds;
    LAS float* ssq = (LAS float*)(lds + 64 * 528);
    LAS float* rs = ssq + 64 * 8;
    const int n = 32 * wave + (lane & 31), hs = lane >> 5;
    const float bn = gb[n], gnn = ong[768 + n];
    for (int tile = bx; tile < NTOK / 64; tile += G) {
        const size_t tok0 = (size_t)tile * 64;
        for (int idx = tid; idx < 64 * 32; idx += NTHR) { const int r = idx >> 5, cq = idx & 31; *(LAS v4u*)(zt + r * 528 + cq * 16) = *(const v4u*)(Z + (tok0 + r) * 256 + cq * 8); }
        __syncthreads();
        f32x16 acc[2]; acc[0] = f32x16{}; acc[1] = f32x16{};
#pragma unroll
        for (int ks = 0; ks < 16; ++ks) { const bf16x8 bw = *(const bf16x8*)(WG + (size_t)n * 256 + ks * 16 + 8 * hs);
#pragma unroll
            for (int mb = 0; mb < 2; ++mb) { const bf16x8 az = *(const LAS bf16x8*)(zt + (mb * 32 + (lane & 31)) * 528 + (ks * 16 + 8 * hs) * 2);
                acc[mb] = __builtin_amdgcn_mfma_f32_32x32x16_bf16(az, bw, acc[mb], 0, 0, 0); } }
        float val[32], sq[32];
#pragma unroll
        for (int mb = 0; mb < 2; ++mb)
#pragma unroll
            for (int r = 0; r < 16; ++r) { const int m = mb * 32 + (r & 3) + 8 * (r >> 2) + 4 * hs; const float z = bf2f(*(const LAS unsigned short*)(zt + m * 528 + n * 2));
                const float v = z / (1.f + __expf(-(acc[mb][r] + bn))); val[mb * 16 + r] = v; sq[mb * 16 + r] = v * v; }
        const float tot = bfly_reduce<32, 16>(sq, lane);
        { const int id = lane & 31, mb = id >> 4, r = id & 15, m = mb * 32 + (r & 3) + 8 * (r >> 2) + 4 * hs; ssq[m * 8 + wave] = tot; }
        __syncthreads();
        if (tid < 64) { float s = 0.f;
#pragma unroll
            for (int w8 = 0; w8 < 8; ++w8) s += ssq[tid * 8 + w8];
            rs[tid] = 1.0f / sqrtf(s * (1.f / 256.f) + EPSN); }
        __syncthreads();
#pragma unroll
        for (int mb = 0; mb < 2; ++mb)
#pragma unroll
            for (int r = 0; r < 16; ++r) { const int m = mb * 32 + (r & 3) + 8 * (r >> 2) + 4 * hs;
                MG[(tok0 + m) * DM + 768 + n] = (bf16)f2bf(val[mb * 16 + r] * rs[m] * gnn); }
        __syncthreads();
    }
    const int gw = vcu * NWAVES + wave, NGW = G * NWAVES;
    float g8[8];
#pragma unroll
    for (int j = 0; j < 8; ++j) g8[j] = ong[8 * lane + j];
    for (int row = gw; row < NTOK; row += NGW) {
        bf16* pp = MG + (size_t)row * DM + 8 * lane;
        const v4u w = *(const v4u*)pp; float f[8] = {bflo(w.x), bfhi(w.x), bflo(w.y), bfhi(w.y), bflo(w.z), bfhi(w.z), bflo(w.w), bfhi(w.w)};
        float s = 0.f;
#pragma unroll
        for (int j = 0; j < 8; ++j) s += f[j] * f[j];
        const float rstd = 1.0f / sqrtf(wave_sum(s) * (1.f / 512.f) + EPSN);
        v4u o; o.x = pk2(f[0] * rstd * g8[0], f[1] * rstd * g8[1]); o.y = pk2(f[2] * rstd * g8[2], f[3] * rstd * g8[3]);
        o.z = pk2(f[4] * rstd * g8[4], f[5] * rstd * g8[5]); o.w = pk2(f[6] * rstd * g8[6], f[7] * rstd * g8[7]); *(v4u*)pp = o;
    }
}

__device__ __forceinline__ void ins16(float (&top)[16], float x) {
#pragma unroll
    for (int i = 15; i >= 1; --i) top[i] = __builtin_amdgcn_fmed3f(top[i - 1], top[i], x);
    top[0] = fmaxf(top[0], x);
}
__device__ __forceinline__ float opq(float x) { asm("" : "+v"(x)); return x; }
__device__ __forceinline__ float tagf(float s, unsigned id, unsigned mask) { return __uint_as_float((__float_as_uint(s) & ~mask) | id); }
__device__ __forceinline__ void phase_select(const bf16* PQ, const bf16* KEYS, int* IDX, float* GATE, LAS unsigned char* lds, int G, int vcu, int lane, int wave) {
    const int gw = vcu * NWAVES + wave, NGW = G * NWAVES;
    LAS unsigned* ids = (LAS unsigned*)(lds + wave * 4096);
    const int tl = lane & 31, hs = lane >> 5;
    const float NEG = -__builtin_inff();
    for (int task = gw; task < (NTOK / 32) * 8; task += NGW) {
        const int tb = task >> 3, h = task & 7; const size_t tok = (size_t)tb * 32 + tl;
        float t1[16], t2[16];
#pragma unroll
        for (int half = 0; half < 2; ++half) {
            f32x16 acc[4]; acc[0] = f32x16{}; acc[1] = f32x16{}; acc[2] = f32x16{}; acc[3] = f32x16{};
            const bf16* qp = PQ + tok * PQW + h * 256 + half * 128 + 8 * hs;
            const bf16* kp = KEYS + ((size_t)(h * 2 + half) * 128 + tl) * 128 + 8 * hs;
#pragma unroll 2
            for (int ks = 0; ks < 8; ++ks) { const bf16x8 bq = *(const bf16x8*)(qp + ks * 16);
#pragma unroll
                for (int kb = 0; kb < 4; ++kb) { const bf16x8 ak = *(const bf16x8*)(kp + (size_t)kb * 32 * 128 + ks * 16); acc[kb] = __builtin_amdgcn_mfma_f32_32x32x16_bf16(ak, bq, acc[kb], 0, 0, 0); } }
            float top[16];
#pragma unroll
            for (int i = 0; i < 16; ++i) top[i] = NEG;
#pragma unroll
            for (int kb = 0; kb < 4; ++kb)
#pragma unroll
                for (int r = 0; r < 16; ++r) ins16(top, tagf(acc[kb][r], (unsigned)(32 * kb + (r & 3) + 8 * (r >> 2) + 4 * hs), 127u));
            float oth[16];
#pragma unroll
            for (int i = 0; i < 16; ++i) oth[i] = __shfl_xor(top[i], 32);
#pragma unroll
            for (int i = 0; i < 16; ++i) ins16(top, oth[i]);
#pragma unroll
            for (int i = 0; i < 16; ++i) { if (half == 0) t1[i] = top[i]; else t2[i] = top[i]; }
        }
#pragma unroll
        for (int i = 0; i < 16; ++i) ids[(tl * 2 + hs) * 16 + i] = __float_as_uint(hs ? opq(t2[i]) : opq(t1[i])) & 127u;
        float best[16];
#pragma unroll
        for (int i = 0; i < 16; ++i) best[i] = NEG;
#define CAND(a0, b0, a1, b1) { const float s0_ = opq(t1[a0] + t2[b0]), s1_ = opq(t1[a1] + t2[b1]); ins16(best, hs ? tagf(s1_, (unsigned)((a1) * 16 + (b1)), 255u) : tagf(s0_, (unsigned)((a0) * 16 + (b0)), 255u)); }
        CAND_LIST
#undef CAND
        { float oth[16];
#pragma unroll
          for (int i = 0; i < 16; ++i) oth[i] = __shfl_xor(best[i], 32);
#pragma unroll
          for (int i = 0; i < 16; ++i) ins16(best, oth[i]); }
        float e[16], den = 0.f;
#pragma unroll
        for (int i = 0; i < 16; ++i) { e[i] = __expf(best[i] - best[0]); den += e[i]; }
        const float rden = 1.f / den;
        int ex[8]; float gt[8];
#pragma unroll
        for (int j = 0; j < 8; ++j) { const float bj = hs ? opq(best[8 + j]) : opq(best[j]); const unsigned id = __float_as_uint(bj) & 255u;
            const unsigned i1 = ids[(tl * 2 + 0) * 16 + (id >> 4)], i2 = ids[(tl * 2 + 1) * 16 + (id & 15u)];
            ex[j] = (int)(i1 * 128u + i2); gt[j] = (hs ? opq(e[8 + j]) : opq(e[j])) * rden; }
        int* ip = IDX + tok * 128 + h * 16 + hs * 8; float* gp = GATE + tok * 128 + h * 16 + hs * 8;
        *(v4u*)ip = (v4u){(unsigned)ex[0], (unsigned)ex[1], (unsigned)ex[2], (unsigned)ex[3]}; *(v4u*)(ip + 4) = (v4u){(unsigned)ex[4], (unsigned)ex[5], (unsigned)ex[6], (unsigned)ex[7]};
        *(f32x4*)gp = (f32x4){gt[0], gt[1], gt[2], gt[3]}; *(f32x4*)(gp + 4) = (f32x4){gt[4], gt[5], gt[6], gt[7]};
    }
}

constexpr int GCH = 32;
constexpr int CW_Q = 8192;
template <int CTRL> __device__ __forceinline__ float dpp_mov(float v) { return __builtin_bit_cast(float, __builtin_amdgcn_update_dpp(0, __builtin_bit_cast(int, v), CTRL, 0xF, 0xF, true)); }
__device__ __forceinline__ float sum8(float s) {
    s += dpp_mov<0xB1>(s); s += dpp_mov<0x4E>(s); s += dpp_mov<0x141>(s); return s;
}
__device__ __forceinline__ void phase_gather_u(const bf16* XN, const int* IDX, const unsigned char* U, float* PART, unsigned* queue, int lane, unsigned imask = 0xffffffffu) {
    const unsigned xcc = xb_xcc_id() & 7u; const int g = lane >> 3, j = lane & 7;
#pragma unroll 1
    for (unsigned sx = 0; sx < 8; ++sx) { const unsigned x = (xcc + sx) & 7u; unsigned* q = queue + x * 64;
        const unsigned char* Ux = U + (size_t)x * NEXP * 128; const unsigned jo = (unsigned)j * 16u, lane4 = (unsigned)lane * 4u; const bf16* Hx = XN + x * 128 + j * 16; const int* Ig = IDX + 16 * g;
#pragma unroll 1
        for (;;) {
            unsigned c = 0; if (lane == 0) c = __hip_atomic_fetch_add(q, 1u, __ATOMIC_RELAXED, __HIP_MEMORY_SCOPE_AGENT);
            c = (unsigned)__builtin_amdgcn_readfirstlane((int)c); if (c >= (unsigned)(NTOK / GCH)) break;
            const size_t tb = (size_t)c * GCH;
            v4u ix[2][4], hw[2][2], rw[16];
#define G1_IDX(ib, tok_) do { _Pragma("unroll") for (int q4 = 0; q4 < 4; ++q4) ix[ib][q4] = *(const v4u*)(Ig + (tok_) * 128 + 4 * q4) & imask; } while (0)
#define G1_AUX(ab, tok_) do { hw[ab][0] = *(const v4u*)(Hx + (tok_) * DM); hw[ab][1] = *(const v4u*)(Hx + (tok_) * DM + 8); } while (0)
#define G1_TOKEN(p, tt_) do { G1_AUX((p) ^ 1, tb + (((tt_) + 1 < GCH) ? (tt_) + 1 : (tt_))); \
            h16x2 hh[8]; \
            _Pragma("unroll") for (int q8 = 0; q8 < 8; ++q8) { const unsigned w_ = hw[p][q8 >> 2][q8 & 3]; hh[q8] = (h16x2){(_Float16)bflo(w_), (_Float16)bfhi(w_)}; } \
            float r0 = 0.f, r1 = 0.f; \
            _Pragma("unroll") for (int i = 0; i < 16; ++i) { float s = 0.f; const v4u rv_ = rw[i]; \
                rw[i] = *(const v4u*)(Ux + (ix[(p) ^ 1][i >> 2][i & 3] * 128u + jo)); \
                _Pragma("unroll") for (int q4 = 0; q4 < 4; ++q4) { const int w = (int)rv_[q4]; \
                    s = __builtin_amdgcn_fdot2(hh[2 * q4], __builtin_amdgcn_cvt_scalef32_pk_f16_fp8(w, 1.0f, false), s, false); \
                    s = __builtin_amdgcn_fdot2(hh[2 * q4 + 1], __builtin_amdgcn_cvt_scalef32_pk_f16_fp8(w, 1.0f, true), s, false); } \
                s = sum8(s); \
                if (i < 8) r0 = ((i & 7) == j) ? s : r0; else r1 = ((i & 7) == j) ? s : r1; } \
            float* pp = PART + ((size_t)x * NTOK + tb + (tt_)) * 128; *(float*)((char*)pp + lane4) = r0; *(float*)((char*)(pp + 64) + lane4) = r1; \
            G1_IDX(p, tb + (((tt_) + 2 < GCH) ? (tt_) + 2 : (tt_))); } while (0)
            G1_IDX(0, tb); G1_IDX(1, tb + 1); G1_AUX(0, tb);
#pragma unroll
            for (int i = 0; i < 16; ++i) rw[i] = *(const v4u*)(Ux + (ix[0][i >> 2][i & 3] * 128u + jo));
#pragma unroll 1
            for (int tt = 0; tt < GCH; tt += 2) { G1_TOKEN(0, tt); G1_TOKEN(1, tt + 1); }
#undef G1_IDX
#undef G1_AUX
#undef G1_TOKEN
        }
    }
}
__device__ __forceinline__ void phase_gather_act(const float* PART, const float* GATE, float* ACT, int G, int vcu, int tid) {
    const size_t gt = (size_t)vcu * NTHR + tid, NGT = (size_t)G * NTHR;
    for (size_t e4 = gt; e4 < (size_t)NTOK * 32; e4 += NGT) { const size_t tok = e4 >> 5; const int p = (int)(e4 & 31) * 4;
        f32x4 s = *(const f32x4*)(PART + e4 * 4);
#pragma unroll
        for (int x = 1; x < 8; ++x) s += *(const f32x4*)(PART + (size_t)x * NTOK * 128 + e4 * 4);
        const int k = (p < 64) ? 16 * (p >> 3) + (p & 7) : 16 * ((p - 64) >> 3) + 8 + (p & 7);
        const f32x4 gv = *(const f32x4*)(GATE + tok * 128 + k);
        f32x4 o;
#pragma unroll
        for (int i = 0; i < 4; ++i) o[i] = gv[i] * gelu_tanh(s[i] * (1.f / U8_SCALE)) * (ACT_SCALE / V8_SCALE);
        *(f32x4*)(ACT + e4 * 4) = o; }
}
__device__ __forceinline__ void phase_gather_v(const float* ACT, const int* IDX, const unsigned char* V, float* out, unsigned* queue, int lane) {
    const unsigned xcc = xb_xcc_id() & 7u; const int g = lane >> 3, j = lane & 7;
    typedef float f32x2v __attribute__((ext_vector_type(2)));
#pragma unroll 1
    for (unsigned sx = 0; sx < 8; ++sx) { const unsigned x = (xcc + sx) & 7u; unsigned* q = queue + x * 64;
        const unsigned char* Vx = V + (size_t)x * NEXP * 128; const unsigned jo = (unsigned)j * 16u; const int* Ig = IDX + 16 * g; float* Ob = out + x * 128; const unsigned lo = (unsigned)(16 * j + 2 * g) * 4u;
#pragma unroll 1
        for (;;) {
            unsigned c = 0; if (lane == 0) c = __hip_atomic_fetch_add(q, 1u, __ATOMIC_RELAXED, __HIP_MEMORY_SCOPE_AGENT);
            c = (unsigned)__builtin_amdgcn_readfirstlane((int)c); if (c >= (unsigned)(NTOK / GCH)) break;
            const size_t tb = (size_t)c * GCH;
            v4u ix[2][4], rw[16]; float a0[2], a1[2]; f32x2v ov[2]; const int bsel = (lane & ~7) * 4; const unsigned lane4 = (unsigned)lane * 4u;
#define G3_IDX(ib, tok_) do { _Pragma("unroll") for (int q4 = 0; q4 < 4; ++q4) ix[ib][q4] = *(const v4u*)(Ig + (tok_) * 128 + 4 * q4); } while (0)
#define G3_AUX(ab, tok_) do { a0[ab] = *(const float*)((const char*)(ACT + (tok_) * 128) + lane4); a1[ab] = *(const float*)((const char*)(ACT + (tok_) * 128 + 64) + lane4); { unsigned lo_ = lo; asm volatile("" : "+v"(lo_)); ov[ab] = *(const f32x2v*)((const char*)(Ob + (tok_) * DM) + lo_); } } while (0)
#define G3_TOKEN(p, tt_) do { G3_AUX((p) ^ 1, tb + (((tt_) + 1 < GCH) ? (tt_) + 1 : (tt_))); \
            h16x2 hacc[8]; \
            _Pragma("unroll") for (int i = 0; i < 8; ++i) hacc[i] = (h16x2){(_Float16)0.f, (_Float16)0.f}; \
            _Pragma("unroll") for (int i = 0; i < 16; ++i) { const v4u rv_ = rw[i]; \
                rw[i] = *(const v4u*)(Vx + (ix[(p) ^ 1][i >> 2][i & 3] * 128u + jo)); \
                const float a = __builtin_bit_cast(float, __builtin_amdgcn_ds_bpermute(bsel + 4 * (i & 7), __builtin_bit_cast(int, (i < 8) ? a0[p] : a1[p])));   \
                const _Float16 ah = (_Float16)a; const h16x2 a2 = (h16x2){ah, ah}; \
                _Pragma("unroll") for (int q4 = 0; q4 < 4; ++q4) { const int w = (int)rv_[q4]; \
                    hacc[2 * q4] = __builtin_elementwise_fma(cvt8h<false>(w), a2, hacc[2 * q4]); \
                    hacc[2 * q4 + 1] = __builtin_elementwise_fma(cvt8h<true>(w), a2, hacc[2 * q4 + 1]); } } \
            float acc[16]; \
            _Pragma("unroll") for (int i = 0; i < 8; ++i) { acc[2 * i] = (float)hacc[i].x; acc[2 * i + 1] = (float)hacc[i].y; } \
            int s_ = 32; \
            _Pragma("unroll") for (int cnt = 16; cnt > 2; cnt >>= 1) { const bool up = (lane & s_) != 0; \
                _Pragma("unroll") for (int i = 0; i < cnt / 2; ++i) { const float a = acc[i], b = acc[i + cnt / 2]; const float send = up ? a : b, keep = up ? b : a; acc[i] = keep + __shfl_xor(send, s_); } \
                s_ >>= 1; } \
            f32x2v o = ov[p]; o[0] += acc[0] * (1.f / ACT_SCALE); o[1] += acc[1] * (1.f / ACT_SCALE); \
            { unsigned lo_ = lo; asm volatile("" : "+v"(lo_)); *(f32x2v*)((char*)(Ob + (tb + (tt_)) * DM) + lo_) = o; } \
            G3_IDX(p, tb + (((tt_) + 2 < GCH) ? (tt_) + 2 : (tt_))); } while (0)
            G3_IDX(0, tb); G3_IDX(1, tb + 1); G3_AUX(0, tb);
#pragma unroll
            for (int i = 0; i < 16; ++i) rw[i] = *(const v4u*)(Vx + (ix[0][i >> 2][i & 3] * 128u + jo));
#pragma unroll 1
            for (int tt = 0; tt < GCH; tt += 2) { G3_TOKEN(0, tt); G3_TOKEN(1, tt + 1); }
#undef G3_IDX
#undef G3_AUX
#undef G3_TOKEN
        }
    }
}

__device__ __forceinline__ void phase_gather_naive(const bf16* XN, const int* IDX, const float* GATE, const float* U, const float* V, float* out, int G, int vcu, int lane, int wave) {
    const int gw = vcu * NWAVES + wave, NGW = G * NWAVES;
    for (int tok = gw; tok < NTOK; tok += NGW) {
        float hv[16], acc[16];
#pragma unroll
        for (int j = 0; j < 16; ++j) { hv[j] = bf2f(XN[(size_t)tok * DM + lane + 64 * j]); acc[j] = 0.f; }
        for (int k = 0; k < 128; ++k) { const int e = IDX[(size_t)tok * 128 + k]; const float g = GATE[(size_t)tok * 128 + k];
            float s = 0.f;
#pragma unroll
            for (int j = 0; j < 16; ++j) s += hv[j] * U[(size_t)e * DM + lane + 64 * j];
            s = wave_sum(s); const float a = g * gelu_tanh(s);
#pragma unroll
            for (int j = 0; j < 16; ++j) acc[j] += a * V[(size_t)e * DM + lane + 64 * j]; }
#pragma unroll
        for (int j = 0; j < 16; ++j) out[(size_t)tok * DM + lane + 64 * j] += acc[j];
    }
}
constexpr int PH_PER_LAYER = 15, N_PHASES = 1 + 2 * PH_PER_LAYER;
__device__ __forceinline__ KArgs kargs() { KArgs p = (KArgs)__builtin_amdgcn_kernarg_segment_ptr(); asm volatile("" : "+s"(p)); return p; }
__global__ void __launch_bounds__(NTHR, 2) mega_fwd(Args a_unused) {
    extern __shared__ __attribute__((aligned(16))) unsigned char lds_raw[];
    LAS unsigned char* lds = (LAS unsigned char*)lds_raw;
    volatile LAS unsigned* MISC = (volatile LAS unsigned*)(lds + MISC_OFF);
    const int tid0 = threadIdx.x;
    for (int u = tid0; u < (LDS_BYTES - LDSCTL_OFF) / 4; u += NTHR) ((LAS unsigned*)(lds + LDSCTL_OFF))[u] = 0u;
    __syncthreads();
    { const unsigned hw = (unsigned)__builtin_amdgcn_s_getreg((6 << 11) | 4); if ((tid0 & 63) == 0) *(volatile LAS int*)(lds + OTID_LDS_OFF + 4 * (hw & 63u)) = tid0 >> 6; }
    __syncthreads();
    XcdBarrier bar; { KArgs ka = kargs(); unsigned char* ws0 = ka->ws; bar.bar = (unsigned*)(ws0 + WS_CTL) + CW_BAR; bar.x = 0; bar.st = nullptr;
      if (ka->use_bar) bar = xcd_barrier_post((unsigned*)(ws0 + WS_CTL) + CW_BAR, MISC + 8); }
    const int ph_lo = kargs()->ph_lo, ph_hi = kargs()->ph_hi;
#define TLW const int tid = otid(), lane = tid & 63, wave = __builtin_amdgcn_readfirstlane(tid >> 6); (void)tid; (void)lane; (void)wave;
#pragma unroll 1
    for (int pc = ph_lo; pc < ph_hi + (DUP_PH >= 0 ? 1 : 0); ++pc) {
        const int ph = (DUP_PH >= 0 && pc > DUP_PH) ? pc - 1 : pc;
        unsigned long long tph0_ = 0; if (TIME_PH >= 0 && (pc == TIME_PH || TIME_PH == 99)) tph0_ = __builtin_amdgcn_s_memrealtime();
        KArgs a = kargs(); unsigned char* ws = a->ws;
        int G = gridDim.x, bx = blockIdx.x; asm volatile("" : "+s"(G), "+s"(bx)); const int vcu = (G % 8 == 0) ? (bx % 8) * (G / 8) + bx / 8 : bx;
        bf16* const XN = (bf16*)(ws + WS_XN); bf16* const Pq = (bf16*)(ws + WS_P); bf16* const Pk = Pq + (size_t)NTOK * 512; bf16* const Pv = Pk + (size_t)NTOK * 512; bf16* const Ps = Pv + (size_t)NTOK * 512;
        bf16* const MG = (bf16*)(ws + WS_MG); float* const CB = (float*)(ws + WS_CB); float* const XLOC = (float*)(ws + WS_XLOC); bf16* const Z = (bf16*)(ws + WS_Z);
        int* const IDX = (int*)(ws + WS_IDX); float* const GATE = (float*)(ws + WS_GATE);
        if (ph == 0) { TLW if (PH_MASK & 1u) phase_prep(a, lds, G, vcu, tid, lane, wave); }
        else {
            const int l = (ph - 1) / PH_PER_LAYER, sub = (ph - 1) % PH_PER_LAYER;
            const float* xin = (l == 0) ? a->in[0] : a->out;
            switch (sub) {
            case 0: if (PH_MASK & (1u << 1)) { TLW phase_rownorm<true>(xin, a->in[1] + l * DM, XN, (const float*)(ws + WS_WF) + l * 8 * 1024, a->in[3] + l * 8, CB, G, vcu, lane, wave); } break;
            case 1: if (PH_MASK & (1u << 2)) { pg8::Gemm g{XN, (const bf16*)(ws + WS_WIN) + (size_t)l * 2048 * 1024, NTOK, 2048, 1024}; pg8::StaticOrder S; S.init(NTOK, 2048, G, bx);
                pg8::EpiBf16<0> E{Pq, 512, nullptr, 512, (size_t)NTOK * 512, 1.f};
                pg8::gemm_phase<pg8::EpiBf16<0>, pg8::StaticOrder, true, true>(lds, g, S, E); } break;
            case 2: if (PH_MASK & (1u << 3)) { TLW phase_headnorm(Pq, Pk, a->in[4] + l * 64, a->in[5] + l * 64, CB, G, vcu, lane, wave); } break;
            case 3: if (PH_MASK & (1u << 4)) { TLW { const float gq = wave_max(fabsf(a->in[4][l * 64 + lane])), gk = wave_max(fabsf(a->in[5][l * 64 + lane]));
                const float qkb = 8.f * gq * gk * LOG2E * 1.02f + 0.25f;
                const attn_body::AttnTensors AT{(const attn_body::bf16*)Pq, (const attn_body::bf16*)Pk, (const attn_body::bf16*)Pv, (attn_body::bf16*)MG, CB, qkb};
                const attn_body::StaticOrder S(G, bx);
                attn_body::attn_phase<attn_body::StaticOrder, ATT_SKIP>((char*)lds_raw, AT, S); } } break;
            case 4: if (PH_MASK & (1u << 5)) { TLW phase_pool(Ps, a->in[6] + (size_t)l * 4 * 64 * 64, a->in[7] + l * 256, a->in[18] + l * DM, MG, lds, G, bx, tid, lane, wave); } break;
            case 5: if (PH_MASK & (1u << 6)) { TLW phase_s5<false>(a, l, Ps, XLOC, Z, lds, G, bx, lane, wave); } break;
            case 6: if (PH_MASK & (1u << 7)) { TLW phase_s5<true>(a, l, Ps, XLOC, Z, lds, G, bx, lane, wave); } break;
            case 7: if (PH_MASK & (1u << 8)) { TLW phase_glu(Z, (const bf16*)(ws + WS_WGLU) + (size_t)l * 256 * 256, a->in[17] + l * 256, a->in[18] + l * DM, MG, lds, G, bx, vcu, tid, lane, wave); } break;
            case 8: if (PH_MASK & (1u << 9)) { pg8::Gemm g{MG, (const bf16*)(ws + WS_WOUT) + (size_t)l * 1024 * 1024, NTOK, 1024, 1024}; pg8::StaticOrder S; S.init(NTOK, 1024, G, bx);
                pg8::EpiResF32 E{xin, a->out, DM};
                pg8::gemm_phase<pg8::EpiResF32, pg8::StaticOrder, true, true>(lds, g, S, E); } break;
            case 9: if (PH_MASK & (1u << 10)) { TLW phase_rownorm<false>(a->out, a->in[20] + l * DM, XN, nullptr, nullptr, nullptr, G, vcu, lane, wave); } break;
            case 10: if (PH_MASK & (1u << 11)) { pg8::Gemm g{XN, (const bf16*)(ws + WS_WQ) + (size_t)l * 2048 * 1024, NTOK, 2048, 1024}; pg8::StaticOrder S; S.init(NTOK, 2048, G, bx);
                pg8::EpiBf16<0> E{Pq, PQW, nullptr, 0, 0, 1.f};
                pg8::gemm_phase<pg8::EpiBf16<0>, pg8::StaticOrder, true, true>(lds, g, S, E); } break;
            case 11: if (PH_MASK & (1u << 12)) { TLW phase_select(Pq, (const bf16*)(ws + WS_KEYS) + (size_t)l * 8 * 2 * 128 * 128, IDX, GATE, lds, G, vcu, lane, wave); } break;
            case 12: if (PH_MASK & (1u << 13)) { TLW phase_gather_u(XN, IDX, (const unsigned char*)(ws + WS_U) + (size_t)l * NEXP * DM, (float*)(ws + WS_P), (unsigned*)(ws + WS_CTL) + CW_Q + (l * 2 + 0) * 512 + ((DUP_PH >= 0 && pc == DUP_PH + 1) ? 4096 : 0), lane, (DUP_PH >= 0 && pc == DUP_PH) ? DIAG_IMASK : 0xffffffffu); } break;
            case 13: if (PH_MASK & (1u << 14)) { TLW phase_gather_act((const float*)(ws + WS_P), GATE, (float*)(ws + WS_Z), G, vcu, tid); } break;
            default: if (PH_MASK & (1u << 15)) { TLW phase_gather_v((const float*)(ws + WS_Z), IDX, (const unsigned char*)(ws + WS_V) + (size_t)l * NEXP * DM, a->out, (unsigned*)(ws + WS_CTL) + CW_Q + (l * 2 + 1) * 512, lane); } break;
            }
        }
        if (pc + 1 < ph_hi + (DUP_PH >= 0 ? 1 : 0)) { XcdBarrier b2 = bar; asm volatile("" : "+s"(b2.bar)); xcd_barrier(b2);
            if (TIME_PH >= 0 && (pc == TIME_PH || TIME_PH == 99)) { const unsigned long long t1_ = __builtin_amdgcn_s_memrealtime(), te_ = t1_ + TIME_MUL * (t1_ - tph0_); while (__builtin_amdgcn_s_memrealtime() < te_) __builtin_amdgcn_s_sleep(8); } }
    }
}

extern "C" void kernel_launch(void* const* d_in, const int* in_sizes, int n_in, void* d_out, int out_size, void* d_ws, size_t ws_size, hipStream_t stream) {
    static int grid = 0;
    if (grid == 0) {
        if (n_in != 25 || in_sizes[0] != NTOK * DM || out_size != NTOK * DM || ws_size < WS_END) {
            fprintf(stderr, "kernel_launch: unexpected problem: n_in %d in0 %d out %d ws %zu (need %zu); nothing launched\n", n_in, n_in > 0 ? in_sizes[0] : -1, out_size, ws_size, (size_t)WS_END); grid = -1; return; }
        int dev = 0, cus = 0;
        if (hipGetDevice(&dev) != hipSuccess || hipDeviceGetAttribute(&cus, hipDeviceAttributeMultiprocessorCount, dev) != hipSuccess) { fprintf(stderr, "kernel_launch: device query failed\n"); grid = -1; return; }
        if (hipFuncSetAttribute((const void*)mega_fwd, hipFuncAttributeMaxDynamicSharedMemorySize, LDS_BYTES) != hipSuccess) { fprintf(stderr, "kernel_launch: hipFuncSetAttribute failed\n"); grid = -1; return; }
        (void)hipGetLastError();
        grid = cus;
    }
    if (grid < 0) return;
    (void)hipMemsetAsync((char*)d_ws + WS_CTL, 0, CTL_ZERO_BYTES, stream);
    Args a{};
    for (int i = 0; i < 25; ++i) a.in[i] = (const float*)d_in[i];
    a.out = (float*)d_out; a.ws = (unsigned char*)d_ws;
#if MK_ONE_LAUNCH
    a.ph_lo = 0; a.ph_hi = N_PHASES; a.use_bar = 1;
    hipLaunchKernelGGL(mega_fwd, dim3(grid), dim3(NTHR), LDS_BYTES, stream, a);
#else
    for (int ph = 0; ph < N_PHASES; ++ph) { a.ph_lo = ph; a.ph_hi = ph + 1; a.use_bar = 0;
        hipLaunchKernelGGL(mega_fwd, dim3(grid), dim3(NTHR), LDS_BYTES, stream, a); }
#endif
    const hipError_t le = hipPeekAtLastError();
    if (le != hipSuccess) fprintf(stderr, "kernel_launch: launch failed: %s\n", hipGetErrorName(le));
}
```

```cpp
#include <hip/hip_runtime.h>
#include <hip/hip_bf16.h>
#include <hip/hip_fp16.h>
#include <cstdio>
#include <cstdint>
#include <cmath>
#ifndef MK_ONE_LAUNCH
#define MK_ONE_LAUNCH 1
#endif
#ifndef ATT_SKIP
#define ATT_SKIP true
#endif
#ifndef PH_MASK
#define PH_MASK 0xffffffffu
#endif
#define OTID_LDS_OFF (131072 + 1024)
__device__ __forceinline__ int otid() {
    int z = 0; asm volatile("" : "+v"(z)); const int lane = __builtin_amdgcn_mbcnt_hi(-1, __builtin_amdgcn_mbcnt_lo(-1, z));
    const unsigned hw = (unsigned)__builtin_amdgcn_s_getreg((6 << 11) | 4);
    const int wv = *(const volatile __attribute__((address_space(3))) int*)(OTID_LDS_OFF + 4 * (hw & 63u));
    return (__builtin_amdgcn_readfirstlane(wv) << 6) | lane;
}
#ifndef GATHER_NAIVE
#define GATHER_NAIVE 0
#endif
#ifndef DUP_PH
#define DUP_PH (-1)
#endif
#ifndef TIME_PH
#define TIME_PH (-1)
#define TIME_MUL 3
#endif
#ifndef DIAG_IMASK
#define DIAG_IMASK 0xffu
#endif
namespace pg8 {
#define PG8_LAS __attribute__((address_space(3)))
typedef unsigned short bf16_t;
typedef short bf16x8 __attribute__((ext_vector_type(8)));
typedef float f32x4 __attribute__((ext_vector_type(4)));
typedef unsigned u32x4 __attribute__((ext_vector_type(4)));
constexpr int BM = 256, BK = 64, HALF = 128, HTB = HALF * BK * 2  , STAGE_BYTES = 8 * HTB, NXCD = 8, WGM = 8;

__host__ __device__ __forceinline__ int lds_byte(int r, int c) { const int st = (r >> 4) * 2 + (c >> 5), rr = r & 15, cc = c & 31, ob = rr * 64 + cc * 2; return st * 1024 + (ob ^ (((ob >> 9) & 1) << 5)); }
__host__ __device__ __forceinline__ void stage_rc(int b, int& R, int& C) { const int st = b / 1024, sb = b % 1024, swz = sb ^ (((sb >> 9) & 1) << 5); R = (st >> 1) * 16 + swz / 64; C = (st & 1) * 32 + (swz % 64) / 2; }
__host__ __device__ __forceinline__ int perm32(int rho) { const int n = rho >> 4, i = rho & 15; return 8 * (i >> 2) + 4 * n + (i & 3); }

struct Unit { int pm, pn; };
struct Gemm { const bf16_t* A; const bf16_t* Bt; int M, N, K; };

struct StaticOrder {
    int nM, nN, nwg, G, c;
    __host__ __device__ void init(int M, int N, int G_, int c_) { nM = M / BM; nN = N / BM; nwg = nM * nN; G = G_; c = c_; }
    __host__ __device__ bool next(int i, Unit& u) const {
        const long L = (long)i * G + c; if (L >= nwg) return false;
        int wgid = (int)L; { const int q = nwg / NXCD, r = nwg % NXCD, xcd = wgid % NXCD, off = wgid / NXCD; wgid = (xcd < r ? xcd * (q + 1) : r * (q + 1) + (xcd - r) * q) + off; }
        const int nig = WGM * nN, gid = wgid / nig, fm = gid * WGM, gsz = (nM - fm) < WGM ? (nM - fm) : WGM;
        u.pm = fm + ((wgid % nig) % gsz); u.pn = (wgid % nig) / gsz; return true;
    }
    __device__ __forceinline__ void a_ready(const Unit&) const {}
    __device__ __forceinline__ void done(const Unit&) const {}
};

__device__ __forceinline__ unsigned cvt_pk_bf16(float lo, float hi) { unsigned r; asm volatile("v_cvt_pk_bf16_f32 %0, %1, %2" : "=v"(r) : "v"(lo), "v"(hi)); return r; }
typedef float f32x2 __attribute__((ext_vector_type(2)));
__device__ __forceinline__ f32x2 gelu_pk(f32x2 v) {
    const f32x2 av = __builtin_elementwise_abs(v), d = av * 0.2316418882f + 1.0f;
    f32x2 t; t.x = __builtin_amdgcn_rcpf(d.x); t.y = __builtin_amdgcn_rcpf(d.y);
    f32x2 q = t * 0.5307027145f + (-0.7265760135f); q = q * t + 0.7107068705f; q = q * t + (-0.142248368f); q = q * t + 0.127414796f; q = q * t;
    const f32x2 s = (v * v) * (-0.72134752044f);
    f32x2 e; e.x = __builtin_amdgcn_exp2f(s.x); e.y = __builtin_amdgcn_exp2f(s.y);
    const f32x2 m = v * (q * e), r = v - m;
    f32x2 o; o.x = v.x < 0.f ? m.x : r.x; o.y = v.y < 0.f ? m.y : r.y; return o;
}

template <int ACT  > struct EpiBf16 {
    static constexpr bool PERM = true, AFTER_DRAIN = false; static_assert(ACT == 0 || ACT == 1, "EpiBf16: ACT is 0 (none) or 1 (gelu_pk)");
    bf16_t* O; int ldc; const float* bias; int split_cols; size_t split_stride; float scale0;
    __device__ __forceinline__ void operator()(const f32x4 (&acc)[2][2][4][2], const Unit& u, int wr, int wc, int fr, int fq) const {
        const int row0 = u.pm * BM + wr * 64 + fr; int colt = u.pn * BM; bf16_t* base = O;
        float sc = 1.f; if (split_cols) { const int t = colt / split_cols; base += (size_t)t * split_stride; colt -= t * split_cols; if (t == 0) sc = scale0; }
        const int col0 = colt + wc * 32 + 8 * fq, bcol0 = u.pn * BM + wc * 32 + 8 * fq;
        f32x4 bv[2][2];
#pragma unroll
        for (int bj = 0; bj < 2; ++bj)
#pragma unroll
            for (int n = 0; n < 2; ++n) bv[bj][n] = bias ? *(const f32x4*)(bias + bcol0 + bj * HALF + 4 * n) : (f32x4){0.f, 0.f, 0.f, 0.f};
#pragma unroll
        for (int ai = 0; ai < 2; ++ai)
#pragma unroll
            for (int m = 0; m < 4; ++m) { bf16_t* rowp = base + (size_t)(row0 + ai * HALF + m * 16) * ldc + col0;
#pragma unroll
                for (int bj = 0; bj < 2; ++bj) { f32x4 v0 = acc[ai][bj][m][0] + bv[bj][0], v1 = acc[ai][bj][m][1] + bv[bj][1];
                    if (ACT == 1) { f32x2 a = gelu_pk((f32x2){v0[0], v0[1]}), b = gelu_pk((f32x2){v0[2], v0[3]}), c = gelu_pk((f32x2){v1[0], v1[1]}), d = gelu_pk((f32x2){v1[2], v1[3]});
                        v0 = (f32x4){a.x, a.y, b.x, b.y}; v1 = (f32x4){c.x, c.y, d.x, d.y}; }
                    v0 = v0 * sc; v1 = v1 * sc; u32x4 w; w.x = cvt_pk_bf16(v0[0], v0[1]); w.y = cvt_pk_bf16(v0[2], v0[3]); w.z = cvt_pk_bf16(v1[0], v1[1]); w.w = cvt_pk_bf16(v1[2], v1[3]);
                    *(u32x4*)(rowp + bj * HALF) = w; } }
    }
};
struct EpiResF32 {
    static constexpr bool PERM = false, AFTER_DRAIN = false;
    const float* base; float* out; int ldc;
    __device__ __forceinline__ void operator()(const f32x4 (&acc)[2][2][4][2], const Unit& u, int wr, int wc, int fr, int fq) const {
        const int col0 = u.pn * BM + wc * 32 + 4 * fq;
#pragma unroll
        for (int ai = 0; ai < 2; ++ai)
#pragma unroll
            for (int m = 0; m < 4; ++m) { const size_t off = (size_t)(u.pm * BM + ai * HALF + wr * 64 + m * 16 + fr) * ldc + col0;
#pragma unroll
                for (int bj = 0; bj < 2; ++bj)
#pragma unroll
                    for (int n = 0; n < 2; ++n) { const f32x4 bs = *(const f32x4*)(base + off + bj * HALF + n * 16); *(f32x4*)(out + off + bj * HALF + n * 16) = bs + acc[ai][bj][m][n]; } }
    }
};
template <class Epi, class Sched, bool ALIGN_EPI = false, bool SP2 = false>
__device__ __forceinline__ void gemm_phase(PG8_LAS unsigned char* lds, const Gemm g, const Sched& S, const Epi& E) {
    const int tid = otid(), wid = __builtin_amdgcn_readfirstlane(tid >> 6), lane = tid & 63, wr = wid >> 2, wc = wid & 3, fr = lane & 15, fq = lane >> 4;
    const int K = g.K, nt = K / BK;
    unsigned voffA[2], voffB[2];
#pragma unroll
    for (int i = 0; i < 2; ++i) { int R, C; stage_rc(tid * 16 + i * 8192, R, C); const int Rb = Epi::PERM ? ((R & ~31) + perm32(R & 31)) : R;
        voffA[i] = (unsigned)(R * K + C) * 2u; voffB[i] = (unsigned)(Rb * K + C) * 2u; }
    const size_t kstep = (size_t)(BK * 2);
    const size_t hstep = (size_t)HALF * K * 2;
    const size_t tstep = 2 * hstep;
    const unsigned ldsw = (unsigned)wid * 1024u;
    const int aoff = lds_byte(wr * 64 + fr, fq * 8), boff = lds_byte(wc * 32 + fr, fq * 8);
#define PG8_SA(b, h) (((b) * 2 + (h)) * HTB)
#define PG8_SB(b, h) ((4 + (b) * 2 + (h)) * HTB)
#define PG8_STAGE(bufoff, gbase, voff) do { _Pragma("unroll") for (int _i = 0; _i < 2; ++_i) \
        __builtin_amdgcn_global_load_lds((const unsigned*)((const char*)(gbase) + (voff)[_i]), (PG8_LAS unsigned*)(lds + (bufoff) + ldsw + _i * 8192), 16, 0, 0); } while (0)
#define PG8_LDA(dst, b, h) do { _Pragma("unroll") for (int m = 0; m < 4; ++m) _Pragma("unroll") for (int k = 0; k < 2; ++k) dst[m][k] = *(const PG8_LAS bf16x8*)(lds + PG8_SA(b, h) + aoff + m * 2048 + k * 1024); } while (0)
#define PG8_LDB(dst, b, h) do { _Pragma("unroll") for (int n = 0; n < 2; ++n) _Pragma("unroll") for (int k = 0; k < 2; ++k) dst[n][k] = *(const PG8_LAS bf16x8*)(lds + PG8_SB(b, h) + boff + n * 2048 + k * 1024); } while (0)
#define PG8_MMA(ai, bj, At, Bt) do { __builtin_amdgcn_s_setprio(1); _Pragma("unroll") for (int m = 0; m < 4; ++m) _Pragma("unroll") for (int n = 0; n < 2; ++n) _Pragma("unroll") for (int k = 0; k < 2; ++k) \
        acc[ai][bj][m][n] = __builtin_amdgcn_mfma_f32_16x16x32_bf16(Bt[n][k], At[m][k], acc[ai][bj][m][n], 0, 0, 0); __builtin_amdgcn_s_setprio(0); } while (0)
#define PG8_WAIT_V(n) asm volatile("s_waitcnt vmcnt(" #n ")" ::: "memory")
#define PG8_WAIT_L(n) asm volatile("s_waitcnt lgkmcnt(" #n ")" ::: "memory")
#define PG8_BAR __builtin_amdgcn_s_barrier()
#define PG8_SCHED __builtin_amdgcn_sched_barrier(0)
    Unit cur, nxt; int ui = 0;
    if (!S.next(0, cur)) return;
    f32x4 acc[2][2][4][2];
#pragma unroll
    for (int a = 0; a < 2; ++a)
#pragma unroll
        for (int b = 0; b < 2; ++b)
#pragma unroll
            for (int m = 0; m < 4; ++m)
#pragma unroll
                for (int n = 0; n < 2; ++n) acc[a][b][m][n] = (f32x4){0.f, 0.f, 0.f, 0.f};
    bf16x8 At[4][2], B0[2][2], B1[2][2];
    const char* cA = (const char*)g.A + (size_t)cur.pm * tstep; const char* cB = (const char*)g.Bt + (size_t)cur.pn * tstep;
    S.a_ready(cur);
    if constexpr (SP2) {
        PG8_STAGE(PG8_SB(0, 0), cB, voffB); PG8_STAGE(PG8_SB(0, 1), cB + hstep, voffB); PG8_STAGE(PG8_SA(0, 0), cA, voffA); PG8_STAGE(PG8_SA(0, 1), cA + hstep, voffA);
        if (wr == 1) PG8_BAR;
        PG8_WAIT_V(2); PG8_BAR;
        PG8_STAGE(PG8_SB(1, 0), cB + kstep, voffB); PG8_STAGE(PG8_SA(1, 0), cA + kstep, voffA); PG8_STAGE(PG8_SB(1, 1), cB + hstep + kstep, voffB);
        PG8_WAIT_V(6); PG8_BAR;
    } else {
        PG8_STAGE(PG8_SB(0, 0), cB, voffB); PG8_STAGE(PG8_SA(0, 0), cA, voffA); PG8_STAGE(PG8_SB(0, 1), cB + hstep, voffB); PG8_STAGE(PG8_SA(0, 1), cA + hstep, voffA);
        if (wr == 1) PG8_BAR;
        PG8_WAIT_V(4); PG8_BAR;
        PG8_STAGE(PG8_SB(1, 0), cB + kstep, voffB); PG8_STAGE(PG8_SA(1, 0), cA + kstep, voffA); PG8_STAGE(PG8_SB(1, 1), cB + hstep + kstep, voffB);
        PG8_WAIT_V(6); PG8_BAR;
    }
    for (;;) {
        const bool has_next = S.next(ui + 1, nxt);
        const char* nA = has_next ? (const char*)g.A + (size_t)nxt.pm * tstep : cA; const char* nB = has_next ? (const char*)g.Bt + (size_t)nxt.pn * tstep : cB;
        for (int t = 0; t < nt; t += 2) {
            const bool last = (t == nt - 2);
            const char* a1 = cA + (size_t)(t + 1) * kstep;
            const char* a2 = last ? nA : cA + (size_t)(t + 2) * kstep; const char* b2 = last ? nB : cB + (size_t)(t + 2) * kstep;
            const char* a3 = a2 + kstep; const char* b3 = b2 + kstep;
            if (last && has_next) S.a_ready(nxt);
            if constexpr (SP2) {
            PG8_LDB(B0, 0, 0); PG8_LDB(B1, 0, 1); PG8_SCHED; PG8_LDA(At, 0, 0); PG8_STAGE(PG8_SA(1, 1), a1 + hstep, voffA);
            PG8_WAIT_V(8); PG8_WAIT_L(0); PG8_BAR; PG8_MMA(0, 0, At, B0); PG8_MMA(0, 1, At, B1); PG8_BAR; PG8_SCHED;
            PG8_LDA(At, 0, 1); PG8_STAGE(PG8_SB(0, 0), b2, voffB); PG8_STAGE(PG8_SB(0, 1), b2 + hstep, voffB); PG8_STAGE(PG8_SA(0, 0), a2, voffA);
            PG8_WAIT_V(8); PG8_WAIT_L(0); PG8_BAR; PG8_MMA(1, 0, At, B0); PG8_MMA(1, 1, At, B1); PG8_BAR; PG8_SCHED;
            PG8_LDB(B0, 1, 0); PG8_LDB(B1, 1, 1); PG8_SCHED; PG8_LDA(At, 1, 0); PG8_STAGE(PG8_SA(0, 1), a2 + hstep, voffA);
            PG8_WAIT_V(8); PG8_WAIT_L(0); PG8_BAR; PG8_MMA(0, 0, At, B0); PG8_MMA(0, 1, At, B1); PG8_BAR; PG8_SCHED;
            PG8_LDA(At, 1, 1); PG8_STAGE(PG8_SB(1, 0), b3, voffB); PG8_STAGE(PG8_SB(1, 1), b3 + hstep, voffB); PG8_STAGE(PG8_SA(1, 0), a3, voffA);
            PG8_WAIT_V(8); PG8_WAIT_L(0); PG8_BAR; PG8_MMA(1, 0, At, B0); PG8_MMA(1, 1, At, B1); PG8_BAR; PG8_SCHED;
            } else {
            PG8_LDB(B0, 0, 0); PG8_SCHED; PG8_LDA(At, 0, 0); PG8_STAGE(PG8_SA(1, 1), a1 + hstep, voffA);
            PG8_WAIT_L(8); PG8_BAR; PG8_WAIT_L(0); PG8_MMA(0, 0, At, B0); PG8_BAR; PG8_SCHED;
            PG8_LDB(B1, 0, 1); PG8_STAGE(PG8_SB(0, 0), b2, voffB);
            PG8_BAR; PG8_WAIT_L(0); PG8_MMA(0, 1, At, B1); PG8_BAR;
            PG8_LDA(At, 0, 1); PG8_STAGE(PG8_SA(0, 0), a2, voffA);
            PG8_BAR; PG8_WAIT_L(0); PG8_MMA(1, 0, At, B0); PG8_BAR; PG8_SCHED;
            PG8_STAGE(PG8_SB(0, 1), b2 + hstep, voffB);
            PG8_WAIT_V(6); PG8_BAR; PG8_MMA(1, 1, At, B1); PG8_BAR;
            PG8_LDB(B0, 1, 0); PG8_SCHED; PG8_LDA(At, 1, 0); PG8_STAGE(PG8_SA(0, 1), a2 + hstep, voffA);
            PG8_WAIT_L(8); PG8_BAR; PG8_WAIT_L(0); PG8_MMA(0, 0, At, B0); PG8_BAR; PG8_SCHED;
            PG8_LDB(B1, 1, 1); PG8_STAGE(PG8_SB(1, 0), b3, voffB);
            PG8_BAR; PG8_WAIT_L(0); PG8_MMA(0, 1, At, B1); PG8_BAR;
            PG8_LDA(At, 1, 1); PG8_STAGE(PG8_SA(1, 0), a3, voffA);
            PG8_BAR; PG8_WAIT_L(0); PG8_MMA(1, 0, At, B0); PG8_BAR; PG8_SCHED;
            PG8_STAGE(PG8_SB(1, 1), b3 + hstep, voffB);
            PG8_WAIT_V(6); PG8_BAR; PG8_MMA(1, 1, At, B1); PG8_BAR;
            }
        }
        if constexpr (ALIGN_EPI) { if (wr == 0) PG8_BAR; }
        if constexpr (!Epi::AFTER_DRAIN) { E(acc, cur, wr, wc, fr, fq); S.done(cur); }
        if (!has_next) break;
#pragma unroll
        for (int a = 0; a < 2; ++a)
#pragma unroll
            for (int b = 0; b < 2; ++b)
#pragma unroll
                for (int m = 0; m < 4; ++m)
#pragma unroll
                    for (int n = 0; n < 2; ++n) acc[a][b][m][n] = (f32x4){0.f, 0.f, 0.f, 0.f};
        cur = nxt; cA = nA; cB = nB; ++ui;
        if constexpr (ALIGN_EPI) { if (wr == 1) PG8_BAR; }
    }
    PG8_WAIT_V(0);
    if constexpr (!ALIGN_EPI) { if (wr == 0) PG8_BAR; }
    PG8_BAR;
    if constexpr (Epi::AFTER_DRAIN) { E.fused(acc, cur, wr, wc, fr, fq, lds, wid, lane); S.done(cur); }
#undef PG8_SA
#undef PG8_SB
#undef PG8_STAGE
#undef PG8_LDA
#undef PG8_LDB
#undef PG8_MMA
#undef PG8_WAIT_V
#undef PG8_WAIT_L
#undef PG8_BAR
#undef PG8_SCHED
}
}
#include <hip/hip_bf16.h>
#include <cmath>
namespace attn_body {
using bf16=__hip_bfloat16;
using bf16x8=__attribute__((ext_vector_type(8)))short;
using s16x4=__attribute__((ext_vector_type(4)))short;
using f32x16=__attribute__((ext_vector_type(16)))float;
using u32x4=__attribute__((ext_vector_type(4)))unsigned;
using f32x4v=__attribute__((ext_vector_type(4)))float;
constexpr int BATCH=8,NHEAD=8,SEQ=4096,D=64,DM=NHEAD*D,OPITCH=1024;
constexpr int NW=8,QBLK=32,QB=QBLK*NW,KVBLK=64,NQB=SEQ/QB;
constexpr int ATTN_PITCH=DM, ATTN_UNIT_ROWS=QB;
__device__ __forceinline__ int crow(int r,int hi){return (r&3)+8*(r>>2)+4*hi;}
#define SBAR() __builtin_amdgcn_sched_barrier(0)
__device__ __forceinline__ void cmask(f32x16&p0,f32x16&p1,int jb,int qrel,int hi){
  const float NEG=-INFINITY; int kb=64*jb+4*hi;
  #pragma unroll
  for(int r=0;r<16;++r){int kv=kb+(r&3)+8*(r>>2); if(kv>qrel)p0[r]=NEG; if(kv+32>qrel)p1[r]=NEG;}
}

constexpr int NSLOT=3, SLOTB=8192;
constexpr int LDS_K=0, LDS_V=NSLOT*SLOTB, LDS_WS=2*NSLOT*SLOTB, LDS_OST=LDS_WS+NW*64*4, LDS_BYTES=LDS_OST+NW*4096, LDS_BIAS=LDS_BYTES, LDS_TOTAL=LDS_BIAS+SEQ*4;
constexpr float C2=0.125f*1.4426950408889634f;
__device__ __forceinline__ void glds16(const void*sbase,unsigned voff,unsigned lds_dst){unsigned keep;
  asm volatile("s_mov_b32 %0, m0\n\ts_mov_b32 m0, %3\n\ts_nop 0\n\tglobal_load_lds_dwordx4 %1, %2\n\ts_mov_b32 m0, %0":"=&s"(keep):"v"(voff),"s"(sbase),"s"(lds_dst):"memory");}
__device__ __forceinline__ float max3f(float a,float b,float c){float r;asm("v_max3_f32 %0, %1, %2, %3":"=v"(r):"v"(a),"v"(b),"v"(c));return r;}
__device__ __forceinline__ float max2f(float a,float b){float r;asm("v_max_f32_e32 %0, %1, %2":"=v"(r):"v"(a),"v"(b));return r;}
__device__ __forceinline__ float fadd_s(float a,float b){float r;asm("v_add_f32_e32 %0, %1, %2":"=v"(r):"v"(a),"v"(b));return r;}
__device__ __forceinline__ float fsub_s(float a,float b){float r;asm("v_sub_f32_e32 %0, %1, %2":"=v"(r):"v"(a),"v"(b));return r;}
typedef float f32x2_t __attribute__((ext_vector_type(2))); typedef __bf16 bf16x2_t __attribute__((ext_vector_type(2)));
__device__ __forceinline__ unsigned cvtpk_s(float lo,float hi){f32x2_t v={lo,hi};bf16x2_t b=__builtin_convertvector(v,bf16x2_t);return __builtin_bit_cast(unsigned,b);}
#define WAIT_BAR(N) asm volatile("s_waitcnt vmcnt(" #N ") lgkmcnt(0)\n\ts_barrier":::"memory")

__device__ __forceinline__ void qkt(f32x16&p0,f32x16&p1,const __attribute__((address_space(3))) char*kb,const bf16x8*qr){
  #pragma unroll
  for(int d0=0;d0<4;++d0){
    const bf16x8 b0=*(const __attribute__((address_space(3))) bf16x8*)(kb+d0*2048);
    const bf16x8 b1=*(const __attribute__((address_space(3))) bf16x8*)(kb+d0*2048+512);
    p0=__builtin_amdgcn_mfma_f32_32x32x16_bf16(b0,qr[d0],p0,0,0,0);p1=__builtin_amdgcn_mfma_f32_32x32x16_bf16(b1,qr[d0],p1,0,0,0);}
}
typedef __attribute__((address_space(3))) const char* lds_cptr;
typedef short v4i16_t __attribute__((ext_vector_type(4)));
__device__ __forceinline__ void kload8(bf16x8*kf,lds_cptr kp){
  kf[0]=*(const __attribute__((address_space(3))) bf16x8*)(kp);      kf[1]=*(const __attribute__((address_space(3))) bf16x8*)(kp+512);
  kf[2]=*(const __attribute__((address_space(3))) bf16x8*)(kp+2048); kf[3]=*(const __attribute__((address_space(3))) bf16x8*)(kp+2560);
  kf[4]=*(const __attribute__((address_space(3))) bf16x8*)(kp+4096); kf[5]=*(const __attribute__((address_space(3))) bf16x8*)(kp+4608);
  kf[6]=*(const __attribute__((address_space(3))) bf16x8*)(kp+6144); kf[7]=*(const __attribute__((address_space(3))) bf16x8*)(kp+6656);
}
__device__ __forceinline__ void kload2(bf16x8*kf,lds_cptr kp,int j){ kf[2*j]=*(const __attribute__((address_space(3))) bf16x8*)(kp+j*2048); kf[2*j+1]=*(const __attribute__((address_space(3))) bf16x8*)(kp+j*2048+512); }
__device__ __forceinline__ s16x4 vtr(lds_cptr p){ return __builtin_bit_cast(s16x4,__builtin_amdgcn_ds_read_tr16_b64_v4i16((__attribute__((address_space(3))) v4i16_t*)p)); }
__device__ __forceinline__ float rowmax(const f32x16&p0,const f32x16&p1){
  float a=max3f(p0[0],p0[1],p1[0]),b=max3f(p0[2],p0[3],p1[1]);a=max3f(a,p1[2],p1[3]);
  #pragma unroll
  for(int r=4;r<16;r+=4){a=max3f(a,p0[r],p0[r+1]);b=max3f(b,p0[r+2],p0[r+3]);a=max3f(a,p1[r],p1[r+1]);b=max3f(b,p1[r+2],p1[r+3]);}
  const float m=max2f(a,b);
  auto rr=__builtin_amdgcn_permlane32_swap(__float_as_uint(m),__float_as_uint(m),false,false);
  return max2f(__uint_as_float(rr[0]),__uint_as_float(rr[1]));
}
__device__ __forceinline__ void pv(f32x16*o,int vb,bf16x8 pa0,bf16x8 pa1,bf16x8 pa2,bf16x8 pa3){
  #pragma unroll
  for(int d0=0;d0<2;++d0){s16x4 lo[4],hi[4];
    #pragma unroll
    for(int ks=0;ks<4;++ks){
      asm volatile("ds_read_b64_tr_b16 %0,%1 offset:%c2":"=&v"(lo[ks]):"v"(vb),"i"(d0*4096+ks*1024):"memory");
      asm volatile("ds_read_b64_tr_b16 %0,%1 offset:%c2":"=&v"(hi[ks]):"v"(vb),"i"(d0*4096+ks*1024+512):"memory");}
    asm volatile("s_waitcnt lgkmcnt(0)":::"memory");SBAR();
    #define PK(k) (bf16x8){lo[k][0],lo[k][1],lo[k][2],lo[k][3],hi[k][0],hi[k][1],hi[k][2],hi[k][3]}
    o[d0]=__builtin_amdgcn_mfma_f32_32x32x16_bf16(pa0,PK(0),o[d0],0,0,0);
    o[d0]=__builtin_amdgcn_mfma_f32_32x32x16_bf16(pa1,PK(1),o[d0],0,0,0);
    o[d0]=__builtin_amdgcn_mfma_f32_32x32x16_bf16(pa2,PK(2),o[d0],0,0,0);
    o[d0]=__builtin_amdgcn_mfma_f32_32x32x16_bf16(pa3,PK(3),o[d0],0,0,0);
    #undef PK
  }
}

#ifndef ATTN_STORE16
#define ATTN_STORE16(p,v) (*(u32x4*)(p)=(v))
#endif
template<bool SKIP> __device__ __forceinline__ void attn_unit(int b,int h,int qb,const bf16*Q,const bf16*__restrict__ K,const bf16*__restrict__ V,bf16*O,const float*__restrict__ CB,float qkb,char*shm){
  const int tid=otid(),lane=tid&63,r32=lane&31,hi=lane>>5; const int wid=__builtin_amdgcn_readfirstlane(tid>>6);
  const long rowbase=(long)b*SEQ; const int q0=qb*QB;
  const float*cb=CB+(long)(b*NHEAD+h)*SEQ;
  int t0=0;
  if(SKIP){ const int NTf=(q0+QB)/KVBLK; const float thr=2.f*qkb+40.f; const float cq0=cb[q0];
    bool pred=false; if(lane<NTf-4){ pred=(cq0-cb[64*lane+63])<-thr; }
    const unsigned long long mk=__ballot(pred); t0=(int)__builtin_ctzll(~mk); t0&=~1; t0=__builtin_amdgcn_readfirstlane(t0); }
  const int kv0=t0*KVBLK;
  const int NT=(q0+QB)/KVBLK-t0;
  { __attribute__((address_space(3))) float*bl=(__attribute__((address_space(3))) float*)((lds_cptr)shm+LDS_BIAS); const float*cbk=cb+kv0; for(int i=tid;i<NT*KVBLK;i+=NW*64) bl[i]=-*(const float*)((const char*)cbk+(unsigned)(i*4)); }
  const float negm0=*(const float*)((const char*)(cb+q0+wid*QBLK)+(unsigned)((lane&31)*4))-qkb;
  const bf16*Qw=Q+(rowbase+q0+wid*QBLK)*DM+h*D;
  const bf16*Kh=K+(rowbase+kv0)*DM+h*D,*Vh=V+(rowbase+kv0)*DM+h*D;
  const unsigned lds0=(unsigned)(uintptr_t)shm;
  const unsigned koff=(unsigned)(lane*DM+wid*8)*2u;
  const unsigned voff=(unsigned)((16*(wid&3)+(lane>>2))*DM+(wid>>2)*32+(lane&3)*8)*2u;
  const unsigned kdst=lds0+LDS_K+wid*1024, vdst=lds0+LDS_V+wid*1024;
  #define DMA_K(t,slot) glds16(Kh+(long)(t)*KVBLK*DM,koff,(unsigned)__builtin_amdgcn_readfirstlane(kdst+(slot)))
  #define DMA_V(t,slot) glds16(Vh+(long)(t)*KVBLK*DM,voff,(unsigned)__builtin_amdgcn_readfirstlane(vdst+(slot)))
  bf16x8 kf[8];
  const lds_cptr shm3=(lds_cptr)shm; __attribute__((address_space(3))) float*const wsf=(__attribute__((address_space(3))) float*)(shm3+LDS_WS)+wid*64;
  const lds_cptr kp0=shm3+LDS_K+hi*1024+r32*16; const lds_cptr vp0=shm3+LDS_V+((lane>>4)&1)*32+(lane&3)*8+(4*hi+((lane&15)>>2))*64;
  DMA_K(0,0);DMA_V(0,0);DMA_K(1,SLOTB);
  bf16x8 qr[4];
  #pragma unroll
  for(int d0=0;d0<4;++d0)qr[d0]=*reinterpret_cast<const bf16x8*>((const char*)Qw+(unsigned)((r32*DM+d0*16+hi*8)*2));
  float l_reg=0.f;f32x16 o[2];o[0]=f32x16{};o[1]=f32x16{};
  const __attribute__((address_space(3))) char* bl3=(const __attribute__((address_space(3))) char*)shm+LDS_BIAS+hi*16;
  #define BINIT_ALL(P0,P1,t) do{ const __attribute__((address_space(3))) f32x4v* bp_=(const __attribute__((address_space(3))) f32x4v*)(bl3+(t)*256); \
    _Pragma("unroll") for(int g_=0;g_<4;++g_){ const f32x4v x0_=bp_[2*g_], x1_=bp_[8+2*g_]; \
      P0[4*g_]=x0_[0]+negm0;P0[4*g_+1]=x0_[1]+negm0;P0[4*g_+2]=x0_[2]+negm0;P0[4*g_+3]=x0_[3]+negm0; \
      P1[4*g_]=x1_[0]+negm0;P1[4*g_+1]=x1_[1]+negm0;P1[4*g_+2]=x1_[2]+negm0;P1[4*g_+3]=x1_[3]+negm0; } }while(0)
  const int qrel=wid*QBLK+r32;
  #define CMASK(P0,P1,t) do{int jb_=(t)-(NT-4); if(jb_>=0)cmask(P0,P1,jb_,qrel,hi);}while(0)
  f32x16 pA0,pA1,pB0,pB1;
  int sl_prev=0,sl_cur=0,sl_next=SLOTB;
  #define ROT() do{sl_prev=sl_cur;sl_cur=sl_next;sl_next=(sl_next==(NSLOT-1)*SLOTB)?0:sl_next+SLOTB;}while(0)
  DMA_K(2,2*SLOTB);
  WAIT_BAR(3);
  BINIT_ALL(pA0,pA1,0); qkt(pA0,pA1,kp0,qr);asm volatile("s_nop 15\n\ts_nop 7":"+v"(pA0),"+v"(pA1));CMASK(pA0,pA1,0);
  _Pragma("unroll") for(int r=0;r<16;++r){pA0[r]=__builtin_amdgcn_exp2f(pA0[r]);pA1[r]=__builtin_amdgcn_exp2f(pA1[r]);}
  BINIT_ALL(pB0,pB1,1);
  WAIT_BAR(0);
  DMA_K(3,0);DMA_V(1,SLOTB);
  ROT();
  kload8(kf,kp0+sl_cur);
  WAIT_BAR(2);
  s16x4 vlo[8],vhi[8]; u32x4 pw0,pw1,pw2,pw3;
  #define PKW(P,B) cvtpk_s(P[B],P[B+1])
  #define PAF(k) __builtin_bit_cast(bf16x8,pw##k)
  #define VFR(i) (bf16x8){vlo[i][0],vlo[i][1],vlo[i][2],vlo[i][3],vhi[i][0],vhi[i][1],vhi[i][2],vhi[i][3]}
  #define PIN(x) asm volatile("":"+v"(x))
  #define MX3(a,b,c) __builtin_fmaxf(__builtin_fmaxf((a),(b)),(c))
  #define GAPA(MF,A0,A1,A2,A3,W0,W1,PW) do{ MF; sacc+=A0; sacc+=A1; sacc+=A2; sacc+=A3; PIN(sacc); W0; W1; PIN(PW); SBAR(); }while(0)
  #define EX(v) __builtin_amdgcn_exp2f(v)
  #define GAPB(MF,X,B,GL_,P,GI,NI) do{ MF; X[B]=EX(X[B]); X[B+1]=EX(X[B+1]); X[B+2]=EX(X[B+2]); X[B+3]=EX(X[B+3]); PIN(X); \
    if(GL_){ const f32x4v nx_=bpn_[NI]; P[4*(GI)]=bq_[0]+negm0; P[4*(GI)+1]=bq_[1]+negm0; P[4*(GI)+2]=bq_[2]+negm0; P[4*(GI)+3]=bq_[3]+negm0; bq_=nx_; PIN(P); } SBAR(); }while(0)
  #define VRD(i) do{ vlo[i]=vtr(vp_+(((i)>>2)*4096+((i)&3)*1024)); vhi[i]=vtr(vp_+(((i)>>2)*4096+((i)&3)*1024+512)); }while(0)
  #define KRD(G,j) do{ if(G){ kload2(kf,kp0+sl_next,j); SBAR(); } }while(0)
  #define STEP(C0,C1,P0,P1,t,GK,GV,GL) do{ SBAR(); \
    const lds_cptr vp_=vp0+sl_prev; \
    VRD(0); SBAR(); float sacc=(P0[0]+P0[1]); \
    GAPA(C0=__builtin_amdgcn_mfma_f32_32x32x16_bf16(kf[0],qr[0],C0,0,0,0), P0[2],P0[3],P0[4],P0[5],     pw0[0]=PKW(P0,0), pw0[1]=PKW(P0,2), pw0); \
    VRD(4); SBAR(); GAPA(C1=__builtin_amdgcn_mfma_f32_32x32x16_bf16(kf[1],qr[0],C1,0,0,0), P0[6],P0[7],P0[8],P0[9],     pw0[2]=PKW(P0,4), pw0[3]=PKW(P0,6), pw0); \
    VRD(1); SBAR(); GAPA(C0=__builtin_amdgcn_mfma_f32_32x32x16_bf16(kf[2],qr[1],C0,0,0,0),   P0[10],P0[11],P0[12],P0[13], pw1[0]=PKW(P0,8), pw1[1]=PKW(P0,10), pw1); \
    VRD(5); SBAR(); GAPA(C1=__builtin_amdgcn_mfma_f32_32x32x16_bf16(kf[3],qr[1],C1,0,0,0),   P0[14],P0[15],P1[0],P1[1],   pw1[2]=PKW(P0,12),pw1[3]=PKW(P0,14), pw1); \
    VRD(2); SBAR(); GAPA(C0=__builtin_amdgcn_mfma_f32_32x32x16_bf16(kf[4],qr[2],C0,0,0,0),   P1[2],P1[3],P1[4],P1[5],     pw2[0]=PKW(P1,0), pw2[1]=PKW(P1,2), pw2); \
    VRD(6); SBAR(); GAPA(C1=__builtin_amdgcn_mfma_f32_32x32x16_bf16(kf[5],qr[2],C1,0,0,0),   P1[6],P1[7],P1[8],P1[9],     pw2[2]=PKW(P1,4), pw2[3]=PKW(P1,6), pw2); \
    VRD(3); SBAR(); GAPA(C0=__builtin_amdgcn_mfma_f32_32x32x16_bf16(kf[6],qr[3],C0,0,0,0),   P1[10],P1[11],P1[12],P1[13], pw3[0]=PKW(P1,8), pw3[1]=PKW(P1,10), pw3); \
    VRD(7); SBAR(); GAPA(C1=__builtin_amdgcn_mfma_f32_32x32x16_bf16(kf[7],qr[3],C1,0,0,0),   P1[14],P1[15],0.f,0.f,       pw3[2]=PKW(P1,12),pw3[3]=PKW(P1,14), pw3); \
    l_reg+=sacc; \
    if(GK){DMA_K((t)+3,sl_cur);} if(GV){DMA_V((t)+1,sl_next);} \
    CMASK(C0,C1,t); \
    const __attribute__((address_space(3))) f32x4v* bpn_=(const __attribute__((address_space(3))) f32x4v*)(bl3+((t)+1)*256); f32x4v bq_=f32x4v{}; if(GL){bq_=bpn_[0];} \
    SBAR(); \
    GAPB(o[0]=__builtin_amdgcn_mfma_f32_32x32x16_bf16(PAF(0),VFR(0),o[0],0,0,0), C0,0,GL,P0,0,8); \
    GAPB(o[1]=__builtin_amdgcn_mfma_f32_32x32x16_bf16(PAF(0),VFR(4),o[1],0,0,0), C0,4,GL,P1,0,2); \
    KRD(GL,0); GAPB(o[0]=__builtin_amdgcn_mfma_f32_32x32x16_bf16(PAF(1),VFR(1),o[0],0,0,0), C0,8,GL,P0,1,10); \
    KRD(GL,1); GAPB(o[1]=__builtin_amdgcn_mfma_f32_32x32x16_bf16(PAF(1),VFR(5),o[1],0,0,0), C0,12,GL,P1,1,4); \
    KRD(GL,2); GAPB(o[0]=__builtin_amdgcn_mfma_f32_32x32x16_bf16(PAF(2),VFR(2),o[0],0,0,0), C1,0,GL,P0,2,12); \
    KRD(GL,3); GAPB(o[1]=__builtin_amdgcn_mfma_f32_32x32x16_bf16(PAF(2),VFR(6),o[1],0,0,0), C1,4,GL,P1,2,6); \
    GAPB(o[0]=__builtin_amdgcn_mfma_f32_32x32x16_bf16(PAF(3),VFR(3),o[0],0,0,0), C1,8,GL,P0,3,14); \
    GAPB(o[1]=__builtin_amdgcn_mfma_f32_32x32x16_bf16(PAF(3),VFR(7),o[1],0,0,0), C1,12,GL,P1,3,14); \
    }while(0)
  int t=1;
  #undef CMASK
  #define CMASK(P0,P1,t) do{}while(0)
  for(;t+5<NT;t+=2){
    STEP(pB0,pB1,pA0,pA1,t,true,true,true);     WAIT_BAR(2); ROT();
    STEP(pA0,pA1,pB0,pB1,t+1,true,true,true);   WAIT_BAR(2); ROT();
  }
  #undef CMASK
  #define CMASK(P0,P1,t) do{int jb_=(t)-(NT-4); if(jb_>=0)cmask(P0,P1,jb_,qrel,hi);}while(0)
  #define ENDW(tt) do{ if((tt)+3<NT){WAIT_BAR(2);} else if((tt)+2<NT){WAIT_BAR(1);} else {WAIT_BAR(0);} }while(0)
  for(;t+1<NT;t+=2){
    STEP(pB0,pB1,pA0,pA1,t,(t+3<NT),(t+1<NT),(t+1<NT));       ENDW(t);   ROT();
    STEP(pA0,pA1,pB0,pB1,t+1,(t+4<NT),(t+2<NT),(t+2<NT));     ENDW(t+1); ROT();
  }
  STEP(pB0,pB1,pA0,pA1,NT-1,false,false,false);
  { float sacc=pB0[0]+pB0[1]; _Pragma("unroll") for(int r=2;r<16;++r)sacc+=pB0[r]; _Pragma("unroll") for(int r=0;r<16;++r)sacc+=pB1[r]; l_reg+=sacc;
    pw0=(u32x4){PKW(pB0,0),PKW(pB0,2),PKW(pB0,4),PKW(pB0,6)};pw1=(u32x4){PKW(pB0,8),PKW(pB0,10),PKW(pB0,12),PKW(pB0,14)};pw2=(u32x4){PKW(pB1,0),PKW(pB1,2),PKW(pB1,4),PKW(pB1,6)};pw3=(u32x4){PKW(pB1,8),PKW(pB1,10),PKW(pB1,12),PKW(pB1,14)};
    SBAR(); pv(o,(int)(unsigned)(uintptr_t)vp0+sl_cur,PAF(0),PAF(1),PAF(2),PAF(3)); }
  #undef PKW
  #undef PAF
  #undef VFR
  #undef PIN
  #undef MX3
  #undef GAPA
  #undef GAPB
  #undef EX
  #undef VRD
  #undef KRD
  #undef STEP
  #undef ENDW
  {auto rr=__builtin_amdgcn_permlane32_swap(__float_as_uint(l_reg),__float_as_uint(l_reg),false,false);l_reg=__uint_as_float(rr[0])+__uint_as_float(rr[1]);}
  if(hi==0)wsf[32+r32]=l_reg;asm volatile("s_waitcnt lgkmcnt(0)":::"memory");
  float rli[16];
  #pragma unroll
  for(int r=0;r<16;++r)rli[r]=__builtin_amdgcn_rcpf(wsf[32+crow(r,hi)]);
  bf16*Ow=O+(rowbase+q0+wid*QBLK)*OPITCH+h*D;
  { __attribute__((address_space(3))) unsigned short*stg=(__attribute__((address_space(3))) unsigned short*)(shm3+LDS_OST)+wid*2048;
    #pragma unroll
    for(int r=0;r<16;++r){const int orow=crow(r,hi);
      #pragma unroll
      for(int d0=0;d0<2;++d0)stg[orow*64+d0*32+r32]=(unsigned short)(cvtpk_s(o[d0][r]*rli[r],0.f)&0xffffu);}
    asm volatile("s_waitcnt lgkmcnt(0)":::"memory");
    #pragma unroll
    for(int i=0;i<4;++i){const int row=i*8+(lane>>3),ch=lane&7; const u32x4 v=*(const __attribute__((address_space(3))) u32x4*)(stg+row*64+ch*8); ATTN_STORE16((char*)Ow+(unsigned)((row*OPITCH+ch*8)*2),v);} }
  asm volatile("s_waitcnt lgkmcnt(0)\n\ts_barrier":::"memory");
  #undef DMA_K
  #undef DMA_V
  #undef CMASK
  #undef BINIT_ALL
  #undef ROT
}
constexpr int ATTN_LDS_BYTES=LDS_TOTAL;
struct AttnTensors { const bf16* Q; const bf16* K; const bf16* V; bf16* O; const float* CB; float qkb; };
struct AttnUnit { int bh; int qb; };
struct StaticOrder {
  int vcu,G;
  __device__ __forceinline__ explicit StaticOrder(int grid,int block):vcu((grid%8==0)?(block%8)*(grid/8)+block/8:block),G(grid){}
  __device__ __forceinline__ bool next(int i,AttnUnit&u)const{
    if(G==256){ if(i>=4)return false; const int s=vcu&3; u.bh=vcu>>2; u.qb=(i==0)?s:(i==1)?7-s:(i==2)?8+s:15-s; return true; }
    const int id=vcu+i*G; if(id>=BATCH*NHEAD*NQB)return false; u.bh=id/NQB; u.qb=id%NQB; return true; }
};
template<class Sched,bool SKIP> __device__ __forceinline__ void attn_phase(char*lds,const AttnTensors&T,const Sched&S){
  AttnUnit u;
  for(int i=0;S.next(i,u);++i){ attn_unit<SKIP>(u.bh/NHEAD,u.bh%NHEAD,u.qb,T.Q,T.K,T.V,T.O,T.CB,T.qkb,lds); }
}
template<bool SKIP> __device__ __forceinline__ void attn_phase_q(char*lds,const AttnTensors&T,unsigned*queue){
  const int tid=otid();
  __attribute__((address_space(3))) int*slot=(__attribute__((address_space(3))) int*)((lds_cptr)lds+LDS_TOTAL);
  const unsigned xcc=(unsigned)__builtin_amdgcn_s_getreg((3<<11)|20)&7u;
  for(;;){
    if(tid==0){ int got=-1;
      for(unsigned sx=0;sx<8;++sx){ const unsigned x=(xcc+sx)&7u; const unsigned c=__hip_atomic_fetch_add(queue+x*64,1u,__ATOMIC_RELAXED,__HIP_MEMORY_SCOPE_AGENT); if(c<(unsigned)(NHEAD*NQB)){ got=(int)(x*(NHEAD*NQB)+c); break; } }
      *slot=got; }
    asm volatile("s_waitcnt vmcnt(0) lgkmcnt(0)\n\ts_barrier":::"memory");
    const int id=__builtin_amdgcn_readfirstlane(*slot);
    if(id<0)break;
    const int b=id/(NHEAD*NQB), c=id%(NHEAD*NQB), h=c%NHEAD, qb=NQB-1-c/NHEAD;
    attn_unit<SKIP>(b,h,qb,T.Q,T.K,T.V,T.O,T.CB,T.qkb,lds);
  }
}
#undef SBAR
#undef WAIT_BAR
}
#define GAS __attribute__((address_space(1)))
#define LAS __attribute__((address_space(3)))
typedef unsigned short bf16;
typedef unsigned v4u __attribute__((ext_vector_type(4)));
typedef float f32x4 __attribute__((ext_vector_type(4)));
typedef short bf16x8 __attribute__((ext_vector_type(8)));
typedef GAS unsigned gu32;
typedef GAS unsigned long long gu64;
#define RLX_AGENT __ATOMIC_RELAXED, __HIP_MEMORY_SCOPE_AGENT
#define LDS_WAIT() asm volatile("s_waitcnt lgkmcnt(0)" ::: "memory")
#define VM_WAIT() asm volatile("s_waitcnt vmcnt(0)" ::: "memory")
__device__ __forceinline__ unsigned long long rt() { return __builtin_amdgcn_s_memrealtime(); }
__device__ __forceinline__ unsigned f2bf(float f) { unsigned u = __builtin_bit_cast(unsigned, f); return (u + 0x7fffu + ((u >> 16) & 1u)) >> 16; }
__device__ __forceinline__ unsigned pk2(float lo, float hi) { return f2bf(lo) | (f2bf(hi) << 16); }

#define XB_TMO      128
#define XB_XCNT(j)  (256  + 64 * (j))
#define XB_XSUB(j)  (1280 + 64 * (j))
#define XB_XGEN(j)  (2304 + 64 * (j))
#define XB_TOP      3328
#define XB_TOPGEN   3392
#define XCD_BAR_WORDS 3456
#define XB_SPIN_CAP (1u << 18)

__device__ __forceinline__ unsigned xb_ld(unsigned* p)              { return __hip_atomic_load(p, __ATOMIC_RELAXED, __HIP_MEMORY_SCOPE_AGENT); }
__device__ __forceinline__ unsigned xb_add(unsigned* p, unsigned v) { return __hip_atomic_fetch_add(p, v, __ATOMIC_RELAXED, __HIP_MEMORY_SCOPE_AGENT); }
__device__ __forceinline__ unsigned xb_xcc_id() { return (unsigned)__builtin_amdgcn_s_getreg((3 << 11) | 20) & 0xFu; }
#define XB_SPIN(cond, bar) do { unsigned _sp = 0; while (cond) { __builtin_amdgcn_s_sleep(1); \
    if ((++_sp & 255u) == 0u) { if (xb_ld(&(bar)[XB_TMO])) break; if (_sp > XB_SPIN_CAP) { atomicAdd(&(bar)[XB_TMO], 1u); break; } } } } while (0)

struct XcdBarrier {
    unsigned* bar; unsigned x;
    volatile LAS unsigned* st;
};

__device__ __forceinline__ XcdBarrier xcd_barrier_post(unsigned* bar, volatile LAS unsigned* st) {
    XcdBarrier b; b.bar = bar; b.x = xb_xcc_id(); b.st = st;
    if (threadIdx.x == 0) (void)xb_add(&bar[XB_XCNT(b.x)], 1u);
    return b;
}
__device__ __forceinline__ void xcd_barrier_complete(unsigned* bar, unsigned x, unsigned& nloc, unsigned& nx) {
    const unsigned G = gridDim.x * gridDim.y * gridDim.z;
    unsigned sum, cnt, mine, sp = 0u;
    for (;;) {
        sum = 0u; cnt = 0u; mine = 0u;
#pragma unroll
        for (unsigned j = 0; j < 16; ++j) { const unsigned c = xb_ld(&bar[XB_XCNT(j)]); sum += c; cnt += (c > 0u) ? 1u : 0u; mine = (j == x) ? c : mine; }
        if (sum == G) break;
        __builtin_amdgcn_s_sleep(1);
        if ((++sp & 255u) == 0u) { if (xb_ld(&bar[XB_TMO])) break; if (sp > XB_SPIN_CAP) { atomicAdd(&bar[XB_TMO], 1u); break; } }
    }
    nloc = mine > 0u ? mine : 1u; nx = cnt > 0u ? cnt : 1u;
}

__device__ __forceinline__ void xcd_barrier(const XcdBarrier& b) {
    asm volatile("s_waitcnt vmcnt(0)" ::: "memory");
    __syncthreads();
    if (threadIdx.x == 0) {
        unsigned* bar = b.bar;
        __builtin_amdgcn_s_waitcnt(0);
        unsigned nloc = b.st[0], nx = b.st[1];
        if (nloc == 0u) { xcd_barrier_complete(bar, b.x, nloc, nx); b.st[0] = nloc; b.st[1] = nx; }
        const unsigned old = xb_add(&bar[XB_XSUB(b.x)], 1u);
        const unsigned gen = old / nloc;
        if (old + 1u == (gen + 1u) * nloc) {
            __builtin_amdgcn_fence(__ATOMIC_RELEASE, "agent");
            asm volatile("s_waitcnt vmcnt(0)" ::: "memory");
            const unsigned og = xb_add(&bar[XB_TOP], 1u);
            const unsigned tg = og / nx;
            if (og + 1u == (tg + 1u) * nx) xb_add(&bar[XB_TOPGEN], 1u);
            else XB_SPIN(xb_ld(&bar[XB_TOPGEN]) == tg, bar);
            __builtin_amdgcn_fence(__ATOMIC_ACQUIRE, "agent");
            xb_add(&bar[XB_XGEN(b.x)], 1u);
            asm volatile("s_waitcnt vmcnt(0)" ::: "memory");
        } else {
            XB_SPIN(xb_ld(&bar[XB_XGEN(b.x)]) == gen, bar);
            __builtin_amdgcn_fence(__ATOMIC_ACQUIRE, "agent");
            asm volatile("s_waitcnt vmcnt(0)" ::: "memory");
        }
    }
    __syncthreads();
}
struct Args { const float* in[25]; float* out; unsigned char* ws; int ph_lo, ph_hi, use_bar, pad; };
typedef const __attribute__((address_space(4))) Args* KArgs;
#define CAND_LIST CAND(0,0,2,1) CAND(0,1,2,2) CAND(0,2,2,3) CAND(0,3,2,4) CAND(0,4,3,0) CAND(0,5,3,1) CAND(0,6,3,2) CAND(0,7,3,3) CAND(0,8,4,0) CAND(0,9,4,1) CAND(0,10,4,2) CAND(0,11,5,0) CAND(0,12,5,1) CAND(0,13,6,0) CAND(0,14,6,1) CAND(0,15,7,0) CAND(1,0,7,1) CAND(1,1,8,0) CAND(1,2,9,0) CAND(1,3,10,0) CAND(1,4,11,0) CAND(1,5,12,0) CAND(1,6,13,0) CAND(1,7,14,0) CAND(2,0,15,0)
constexpr int NB = 8, SEQ = 4096, DM = 1024, NTOK = NB * SEQ;
constexpr int NH = 8, HD = 64, AW = 512, PWD = 256, SWD = 256, INC = 2056;
constexpr int NEXP = 16384, PQW = 2048;
constexpr float EPSN = 1e-6f, LOG2E = 1.4426950408889634f;
constexpr int NWAVES = 8, NTHR = 512;
constexpr size_t MiB = 1u << 20;
constexpr size_t WS_CTL = 0, CTL_ZERO_BYTES = 1 * MiB;
constexpr size_t WS_WIN = 1 * MiB;
constexpr size_t WS_WOUT = 9 * MiB;
constexpr size_t WS_WQ = 13 * MiB;
constexpr size_t WS_KEYS = 21 * MiB;
constexpr size_t WS_WGLU = 22 * MiB;
constexpr size_t WS_WF = 22 * MiB + 512 * 1024;
constexpr size_t WS_CB = 23 * MiB;
constexpr size_t WS_XLOC = 24 * MiB;
constexpr size_t WS_IDX = 28 * MiB;
constexpr size_t WS_GATE = 44 * MiB;
constexpr size_t WS_Z = 60 * MiB;
constexpr size_t WS_U = 76 * MiB;
constexpr size_t WS_V = 140 * MiB;
constexpr size_t WS_XN = 204 * MiB;
constexpr size_t WS_P = 268 * MiB;
constexpr size_t WS_MG = 396 * MiB;
constexpr size_t WS_END = 460 * MiB;
constexpr int CW_BAR = 4096, CW_AQ = 20480;
constexpr float U8_SCALE = 512.f, V8_SCALE = 32.f, ACT_SCALE = 64.f;
constexpr int RING_BYTES = 131072, LDSCTL_OFF = RING_BYTES, MISC_OFF = LDSCTL_OFF + 320, LDS_BYTES = 147456;
static_assert(attn_body::ATTN_LDS_BYTES + 16 <= RING_BYTES, "attention scratch fits the ring");

typedef _Float16 h16x2 __attribute__((ext_vector_type(2)));
typedef float f32x16 __attribute__((ext_vector_type(16)));
typedef unsigned u32x2 __attribute__((ext_vector_type(2)));

__device__ __forceinline__ float bf2f(unsigned short b) { return __uint_as_float((unsigned)b << 16); }
__device__ __forceinline__ float bflo(unsigned w) { return __uint_as_float(w << 16); }
__device__ __forceinline__ float bfhi(unsigned w) { return __uint_as_float(w & 0xffff0000u); }
__device__ __forceinline__ h16x2 as_h2(unsigned w) { return __builtin_bit_cast(h16x2, w); }
template <bool HI> __device__ __forceinline__ h16x2 cvt8h(int w) { return __builtin_bit_cast(h16x2, __builtin_amdgcn_cvt_scalef32_pk_f16_fp8(w, 1.0f, HI)); }
__device__ __forceinline__ float gelu_tanh(float x) { const float u = 1.5957691216057308f * (x + 0.044715f * x * x * x); return x / (1.f + __expf(-u)); }
__device__ __forceinline__ float wave_sum(float v) {
#pragma unroll
    for (int o = 1; o < 64; o <<= 1) v += __shfl_xor(v, o);
    return v;
}
__device__ __forceinline__ float wave_max(float v) {
#pragma unroll
    for (int o = 1; o < 64; o <<= 1) v = fmaxf(v, __shfl_xor(v, o));
    return v;
}
template <int N, int S0> __device__ __forceinline__ float bfly_reduce(float (&v)[N], int lane) {
    int s = S0;
#pragma unroll
    for (int cnt = N; cnt > 1; cnt >>= 1) {
        const bool up = (lane & s) != 0;
#pragma unroll
        for (int i = 0; i < cnt / 2; ++i) { const float a = v[i], b = v[i + cnt / 2]; const float send = up ? a : b, keep = up ? b : a; v[i] = keep + __shfl_xor(send, s); }
        s >>= 1;
    }
    float r = v[0];
    for (; s >= 1; s >>= 1) r += __shfl_xor(r, s);
    return r;
}

__device__ __forceinline__ void tr_item(const float* W, int ldw, int srccol, bf16* WT, int K, int dstrow, int k0, LAS float* scr, int lane) {
#pragma unroll 8
    for (int i = 0; i < 32; ++i) { const int kk = 2 * i + (lane >> 5); scr[kk * 33 + (lane & 31)] = W[(size_t)(k0 + kk) * ldw + srccol + (lane & 31)]; }
    LDS_WAIT(); asm volatile("" ::: "memory");
    const int c = lane & 7;
#pragma unroll
    for (int j = 0; j < 4; ++j) { const int n = (lane >> 3) + 8 * j; const LAS float* s = scr + (8 * c) * 33 + n;
        v4u o; o.x = pk2(s[0 * 33], s[1 * 33]); o.y = pk2(s[2 * 33], s[3 * 33]); o.z = pk2(s[4 * 33], s[5 * 33]); o.w = pk2(s[6 * 33], s[7 * 33]);
        *(GAS v4u*)(WT + (size_t)(dstrow + n) * K + k0 + 8 * c) = o; }
    LDS_WAIT(); asm volatile("" ::: "memory");
}
__device__ __forceinline__ void phase_prep(KArgs a, LAS unsigned char* lds, int G, int vcu, int tid, int lane, int wave) {
    unsigned char* ws = a->ws;
    LAS float* scr = (LAS float*)(lds + wave * 16384);
    const int gw = vcu * NWAVES + wave, NGW = G * NWAVES;
    constexpr int I_IN = 2048, I_OUT = 1024, I_WQ = 2048, I_GLU = 64;
    for (int it = gw; it < I_IN + I_OUT + I_WQ + I_GLU; it += NGW) {
        int r = it;
        if (r < I_IN) { const int l = r >> 10, q = r & 1023, kb = q >> 6, nb = q & 63, n0 = nb * 32;
            tr_item(a->in[2] + (size_t)l * DM * INC, INC, n0 + (n0 >= 1536 ? 8 : 0), (bf16*)(ws + WS_WIN) + (size_t)l * 2048 * 1024, 1024, n0, kb * 64, scr, lane); continue; }
        r -= I_IN;
        if (r < I_OUT) { const int l = r >> 9, q = r & 511, kb = q >> 5, nb = q & 31;
            tr_item(a->in[19] + (size_t)l * DM * DM, DM, nb * 32, (bf16*)(ws + WS_WOUT) + (size_t)l * 1024 * 1024, 1024, nb * 32, kb * 64, scr, lane); continue; }
        r -= I_OUT;
        if (r < I_WQ) { const int l = r >> 10, q = r & 1023, kb = q >> 6, nb = q & 63;
            tr_item(a->in[21] + (size_t)l * DM * PQW, PQW, nb * 32, (bf16*)(ws + WS_WQ) + (size_t)l * 2048 * 1024, 1024, nb * 32, kb * 64, scr, lane); continue; }
        r -= I_WQ;
        { const int l = r >> 5, q = r & 31, kb = q >> 3, nb = q & 7;
            tr_item(a->in[16] + (size_t)l * 256 * 256, 256, nb * 32, (bf16*)(ws + WS_WGLU) + (size_t)l * 256 * 256, 256, nb * 32, kb * 64, scr, lane); }
    }
    const size_t gt = (size_t)vcu * NTHR + tid, NGT = (size_t)G * NTHR;
    for (size_t i = gt; i < 2 * 8 * 1024; i += NGT) { const int l = (int)(i >> 13), h = (int)(i >> 10) & 7, k = (int)i & 1023;
        ((float*)(ws + WS_WF))[i] = a->in[2][((size_t)l * DM + k) * INC + 1536 + h]; }
    { const float* src = a->in[22]; bf16* dst = (bf16*)(ws + WS_KEYS);
      for (size_t i = gt; i < (size_t)2 * 8 * 2 * 128 * 128 / 8; i += NGT) { const f32x4 x0 = *(const f32x4*)(src + i * 8), x1 = *(const f32x4*)(src + i * 8 + 4);
          v4u o; o.x = pk2(x0[0], x0[1]); o.y = pk2(x0[2], x0[3]); o.z = pk2(x1[0], x1[1]); o.w = pk2(x1[2], x1[3]); *(v4u*)(dst + i * 8) = o; } }
#pragma unroll 1
    for (int tb = 0; tb < 2; ++tb) { const float* src = a->in[23 + tb]; unsigned char* dst = ws + (tb ? WS_V : WS_U); const float sc = tb ? V8_SCALE : U8_SCALE;
      for (size_t i = gt; i < (size_t)2 * NEXP * DM / 16; i += NGT) { v4u o;
#pragma unroll
          for (int q = 0; q < 4; ++q) { f32x4 x = *(const f32x4*)(src + i * 16 + 4 * q) * sc;
              x[0] = fminf(fmaxf(x[0], -448.f), 448.f); x[1] = fminf(fmaxf(x[1], -448.f), 448.f); x[2] = fminf(fmaxf(x[2], -448.f), 448.f); x[3] = fminf(fmaxf(x[3], -448.f), 448.f);
              int w = 0; w = __builtin_amdgcn_cvt_pk_fp8_f32(x[0], x[1], w, false); w = __builtin_amdgcn_cvt_pk_fp8_f32(x[2], x[3], w, true); o[q] = (unsigned)w; }
          const size_t r = i >> 6; const unsigned cg = (unsigned)(i & 63), l = (unsigned)(r / NEXP), rl = (unsigned)(r % NEXP);
          *(v4u*)(dst + (size_t)l * NEXP * DM + (size_t)(cg >> 3) * NEXP * 128 + (size_t)rl * 128 + (cg & 7u) * 16u) = o; } }
}

template <bool FLOGIT> __device__ __forceinline__ void phase_rownorm(const float* x, const float* g, bf16* XN, const float* WF, const float* fbias, float* CB, int G, int vcu, int lane, int wave) {
    const int gw = vcu * NWAVES + wave, NGW = G * NWAVES;
    f32x4 gv[4];
#pragma unroll
    for (int j = 0; j < 4; ++j) gv[j] = *(const f32x4*)(g + 4 * lane + 256 * j);
    f32x4 vn[2][4];
#define RN_LOAD(rg_) do { _Pragma("unroll") for (int r = 0; r < 2; ++r) { const float* xr = x + (size_t)((rg_) * 2 + r) * DM + 4 * lane; _Pragma("unroll") for (int j = 0; j < 4; ++j) vn[r][j] = *(const f32x4*)(xr + 256 * j); } } while (0)
    if (gw < NTOK / 2) RN_LOAD(gw);
    for (int rg = gw; rg < NTOK / 2; rg += NGW) {
        f32x4 v[2][4];
#pragma unroll
        for (int r = 0; r < 2; ++r)
#pragma unroll
            for (int j = 0; j < 4; ++j) v[r][j] = vn[r][j];
        if (rg + NGW < NTOK / 2) RN_LOAD(rg + NGW);
#pragma unroll
        for (int r = 0; r < 2; ++r) { float s = 0.f;
#pragma unroll
            for (int j = 0; j < 4; ++j) s += (v[r][j][0] * v[r][j][0] + v[r][j][1] * v[r][j][1]) + (v[r][j][2] * v[r][j][2] + v[r][j][3] * v[r][j][3]);
            const float rstd = 1.0f / sqrtf(wave_sum(s) * (1.f / DM) + EPSN);
            bf16* orow = XN + (size_t)(rg * 2 + r) * DM + 4 * lane;
#pragma unroll
            for (int j = 0; j < 4; ++j) { v[r][j] = v[r][j] * rstd * gv[j]; u32x2 w; w.x = pk2(v[r][j][0], v[r][j][1]); w.y = pk2(v[r][j][2], v[r][j][3]); *(u32x2*)(orow + 256 * j) = w; } }
        if (FLOGIT) {
            float acc[16];
#pragma unroll
            for (int i = 0; i < 16; ++i) acc[i] = 0.f;
#pragma unroll
            for (int h = 0; h < 8; ++h)
#pragma unroll
                for (int j = 0; j < 4; ++j) { const f32x4 w = *(const f32x4*)(WF + h * 1024 + 4 * lane + 256 * j);
#pragma unroll
                    for (int r = 0; r < 2; ++r) acc[r * 8 + h] += (v[r][j][0] * w[0] + v[r][j][1] * w[1]) + (v[r][j][2] * w[2] + v[r][j][3] * w[3]); }
            const float tot = bfly_reduce<16, 32>(acc, lane);
            if ((lane & 3) == 0) { const int id = (lane >> 2) & 15, r = id >> 3, h = id & 7; const int row = rg * 2 + r, b = row / SEQ, s = row % SEQ;
                const float z = tot + fbias[h];
                const float ls = fminf(z, 0.f) - __logf(1.f + __expf(-fabsf(z)));
                CB[((size_t)(b * NH + h)) * SEQ + s] = ls * LOG2E; }
        }
    }
}

__device__ __forceinline__ void phase_headnorm(bf16* Q, bf16* K, const float* qg, const float* kg, float* CB, int G, int vcu, int lane, int wave) {
    const int gw = vcu * NWAVES + wave, NGW = G * NWAVES;
    for (int sq = gw; sq < NB * NH; sq += NGW) {
        float* c = CB + (size_t)sq * SEQ; float carry = 0.f;
        for (int it = 0; it < SEQ / 64; ++it) { float v = c[it * 64 + lane];
#pragma unroll
            for (int o = 1; o < 64; o <<= 1) { const float t = __shfl_up(v, o); if (lane >= o) v += t; }
            v += carry; c[it * 64 + lane] = v; carry = __shfl(v, 63); }
    }
    float gq[8], gk[8];
#pragma unroll
    for (int j = 0; j < 8; ++j) { gq[j] = qg[8 * (lane & 7) + j] * (0.125f * LOG2E); gk[j] = kg[8 * (lane & 7) + j]; }
    for (int row0 = gw * 4; row0 < NTOK; row0 += NGW * 4) {
      v4u wl[4][2];
#pragma unroll
      for (int rr = 0; rr < 4; ++rr) { wl[rr][0] = *(const v4u*)(Q + (size_t)(row0 + rr) * AW + 8 * lane); wl[rr][1] = *(const v4u*)(K + (size_t)(row0 + rr) * AW + 8 * lane); }
#pragma unroll
      for (int rr = 0; rr < 4; ++rr) { const int row = row0 + rr;
#pragma unroll
        for (int which = 0; which < 2; ++which) {
            bf16* p = (which ? K : Q) + (size_t)row * AW + 8 * lane;
            const v4u w = wl[rr][which]; float f[8] = {bflo(w.x), bfhi(w.x), bflo(w.y), bfhi(w.y), bflo(w.z), bfhi(w.z), bflo(w.w), bfhi(w.w)};
            float s = 0.f;
#pragma unroll
            for (int j = 0; j < 8; ++j) s += f[j] * f[j];
            s += __shfl_xor(s, 1); s += __shfl_xor(s, 2); s += __shfl_xor(s, 4);
            const float rstd = 1.0f / sqrtf(s * (1.f / 64.f) + EPSN);
#pragma unroll
            for (int j = 0; j < 8; ++j) f[j] = f[j] * rstd * (which ? gk[j] : gq[j]);
            v4u o; o.x = pk2(f[0], f[1]); o.y = pk2(f[2], f[3]); o.z = pk2(f[4], f[5]); o.w = pk2(f[6], f[7]); *(v4u*)p = o;
        }
      }
    }
}

__device__ __forceinline__ void phase_pool(const bf16* PS, const float* pw, const float* pscale, const float* ong, bf16* MG, LAS unsigned char* lds, int G, int bx, int tid, int lane, int wave) {
    LAS float* ut = (LAS float*)lds;
    LAS float* pl = (LAS float*)(lds + 47 * 256 * 4);
    const int ch = tid & 255, half = tid >> 8, g = ch >> 6, w = 2 << g;
    float wcol[64];
#pragma unroll
    for (int c = 0; c < 64; ++c) wcol[c] = pw[(g * 64 + c) * 64 + (ch & 63)];
    const float psc = pscale[ch];
    const f32x4 gn = *(const f32x4*)(ong + 512 + 4 * lane);
    v4u wq[3];
#define POOL_LOAD(tile_) do { const int tok0_ = (tile_) * 32, s0_ = tok0_ % SEQ; _Pragma("unroll") for (int q = 0; q < 3; ++q) { const int idx = tid + q * NTHR, rr = idx >> 5, cq = idx & 31, r = rr - 15; \
        wq[q] = (v4u){0u, 0u, 0u, 0u}; if (idx < 47 * 32 && s0_ + r >= 0) wq[q] = *(const v4u*)(PS + (size_t)(tok0_ + r) * 512 + cq * 8); } } while (0)
    if (bx < NTOK / 32) POOL_LOAD(bx);
    for (int tile = bx; tile < NTOK / 32; tile += G) {
        const int tok0 = tile * 32, s0 = tok0 % SEQ;
#pragma unroll
        for (int q = 0; q < 3; ++q) { const int idx = tid + q * NTHR, rr = idx >> 5, cq = idx & 31; const v4u wv = wq[q];
            if (idx < 47 * 32) { LAS float* d = ut + rr * 256 + cq * 8;
                *(LAS f32x4*)d = (f32x4){bflo(wv.x), bfhi(wv.x), bflo(wv.y), bfhi(wv.y)}; *(LAS f32x4*)(d + 4) = (f32x4){bflo(wv.z), bfhi(wv.z), bflo(wv.w), bfhi(wv.w)}; } }
        if (tile + G < NTOK / 32) POOL_LOAD(tile + G);
        __syncthreads();
        { float s = 0.f; const int rr0 = half * 16 + 15;
            for (int j = 1; j < w; ++j) s += ut[(rr0 - j) * 256 + ch];
#pragma unroll 4
            for (int tt = 0; tt < 16; ++tt) { const int ti = half * 16 + tt, rr = ti + 15, pos = s0 + ti; const float cur = ut[rr * 256 + ch];
                s += cur; const int cnt = (pos + 1 < w) ? pos + 1 : w;
                pl[ti * 256 + ch] = s / (float)cnt - cur; s -= ut[(rr - w + 1) * 256 + ch]; } }
        __syncthreads();
#pragma unroll 1
        for (int tt = 0; tt < 16; ++tt) { const int ti = half * 16 + tt; const LAS f32x4* pr = (const LAS f32x4*)(pl + ti * 256 + g * 64);
            float acc = 0.f;
#pragma unroll
            for (int c4 = 0; c4 < 16; ++c4) { const f32x4 v = pr[c4]; acc += (v[0] * wcol[4 * c4] + v[1] * wcol[4 * c4 + 1]) + (v[2] * wcol[4 * c4 + 2] + v[3] * wcol[4 * c4 + 3]); }
            ut[ti * 256 + ch] = acc * psc; }
        __syncthreads();
#pragma unroll
        for (int q = 0; q < 4; ++q) { const int ti = wave * 4 + q; const f32x4 v = *(const LAS f32x4*)(ut + ti * 256 + 4 * lane);
            const float ss = wave_sum((v[0] * v[0] + v[1] * v[1]) + (v[2] * v[2] + v[3] * v[3]));
            const float rstd = 1.0f / sqrtf(ss * (1.f / 256.f) + EPSN);
            u32x2 o; o.x = pk2(v[0] * rstd * gn[0], v[1] * rstd * gn[1]); o.y = pk2(v[2] * rstd * gn[2], v[3] * rstd * gn[3]);
            *(u32x2*)(MG + (size_t)(tok0 + ti) * DM + 512 + 4 * lane) = o; }
        __syncthreads();
    }
}

template <bool PASS2> __device__ __forceinline__ void phase_s5(KArgs a, int l, const bf16* PS, float* XLOC, bf16* Z, LAS unsigned char* lds, int G, int bx, int lane, int wave) {
    LAS float* Xs = (LAS float*)(lds + wave * (16 * 130 * 4));
    const int p = lane, kq = lane >> 4, ln = lane & 15;
    for (int task = bx; task < NB * 16 * 8; task += G) {
        const int b = task >> 7, g = (task >> 3) & 15, c = (task & 7) * 8 + wave;
        const size_t tok_c = (size_t)b * SEQ + c * 64;
        const float a_re = a->in[8][(l * 16 + g) * 64 + p], a_im = a->in[9][(l * 16 + g) * 64 + p], ldt = a->in[10][l * 16 + g];
        u32x2 uraw[4];
#pragma unroll
        for (int sub = 0; sub < 4; ++sub) uraw[sub] = *(const u32x2*)(PS + (tok_c + sub * 16 + ln) * 512 + 256 + g * 16 + 4 * kq);
        float braw[4][4], biaw[4][4];
#pragma unroll
        for (int q = 0; q < 4; ++q)
#pragma unroll
            for (int ks = 0; ks < 4; ++ks) { const size_t bi = ((size_t)((l * 16 + g) * 64 + 16 * q + ln)) * 16 + 4 * kq + ks; braw[q][ks] = a->in[11][bi]; biaw[q][ks] = a->in[12][bi]; }
        float cfrag[32]; float dsk = 0.f; unsigned short usk[16];
        if (PASS2) {
#pragma unroll
            for (int ks = 0; ks < 32; ++ks) { const int k = 4 * ks + kq, pp = k & 63; const size_t ci = ((size_t)((l * 16 + g) * 16 + ln)) * 64 + pp;
                cfrag[ks] = (ks < 16) ? a->in[13][ci] : -a->in[14][ci]; }
            dsk = a->in[15][l * 256 + g * 16 + ln];
#pragma unroll
            for (int i = 0; i < 16; ++i) usk[i] = PS[(tok_c + (i >> 2) * 16 + 4 * kq + (i & 3)) * 512 + 256 + g * 16 + ln];
        }
        const float dt = expf(ldt);
        float abr, abi, fr, fi;
        { const float xx = a_re * dt, yy = a_im * dt; const float ex = expf(xx); float sn, cs; sincosf(yy, &sn, &cs);
          abr = ex * cs; abi = ex * sn;
          const float sh = sinf(0.5f * yy); const float er = expm1f(xx) * cs - 2.f * sh * sh, ei = abi;
          const float den = a_re * a_re + a_im * a_im; fr = (er * a_re + ei * a_im) / den; fi = (ei * a_re - er * a_im) / den; }
        float bfrag[8][4];
#pragma unroll
        for (int q = 0; q < 4; ++q) { const float frq = __shfl(fr, 16 * q + ln), fiq = __shfl(fi, 16 * q + ln);
#pragma unroll
            for (int ks = 0; ks < 4; ++ks) { bfrag[q][ks] = frq * braw[q][ks] - fiq * biaw[q][ks]; bfrag[4 + q][ks] = frq * biaw[q][ks] + fiq * braw[q][ks]; } }
        float xr = 0.f, xi = 0.f;
        if (PASS2) {
            float pr = abr, pi = abi;
#pragma unroll
            for (int q = 0; q < 6; ++q) { const float nr = pr * pr - pi * pi, ni = 2.f * pr * pi; pr = nr; pi = ni; }
            const float* xl = XLOC + ((size_t)(b * 16 + g) * 64) * 128 + p;
            int j = 0;
#pragma unroll 1
            for (; j + 16 <= c; j += 16) { float lr[16], li[16];
#pragma unroll
                for (int q = 0; q < 16; ++q) { lr[q] = xl[(size_t)(j + q) * 128]; li[q] = xl[(size_t)(j + q) * 128 + 64]; }
#pragma unroll
                for (int q = 0; q < 16; ++q) { const float nr = pr * xr - pi * xi + lr[q], ni = pr * xi + pi * xr + li[q]; xr = nr; xi = ni; } }
            { float lr[16], li[16];
#pragma unroll
                for (int q = 0; q < 16; ++q) { const int jj = (j + q < c) ? j + q : 0; lr[q] = xl[(size_t)jj * 128]; li[q] = xl[(size_t)jj * 128 + 64]; }
#pragma unroll
                for (int q = 0; q < 16; ++q) if (j + q < c) { const float nr = pr * xr - pi * xi + lr[q], ni = pr * xi + pi * xr + li[q]; xr = nr; xi = ni; } }
        }
#pragma unroll
        for (int sub = 0; sub < 4; ++sub) {
            const size_t tokb = tok_c + sub * 16;
            const float ua[4] = {bflo(uraw[sub].x), bfhi(uraw[sub].x), bflo(uraw[sub].y), bfhi(uraw[sub].y)};
#pragma unroll
            for (int nb = 0; nb < 8; ++nb) { f32x4 acc = {0.f, 0.f, 0.f, 0.f};
#pragma unroll
                for (int ks = 0; ks < 4; ++ks) acc = __builtin_amdgcn_mfma_f32_16x16x4f32(ua[ks], bfrag[nb][ks], acc, 0, 0, 0);
#pragma unroll
                for (int r = 0; r < 4; ++r) Xs[(4 * kq + r) * 130 + 16 * nb + ln] = acc[r]; }
            float bur[16], bui[16];
#pragma unroll
            for (int i = 0; i < 16; ++i) { bur[i] = Xs[i * 130 + p]; bui[i] = Xs[i * 130 + 64 + p]; }
#pragma unroll
            for (int i = 0; i < 16; ++i) { const float nr = abr * xr - abi * xi + bur[i], ni = abr * xi + abi * xr + bui[i]; xr = nr; xi = ni;
                if (PASS2) { Xs[i * 130 + p] = xr; Xs[i * 130 + 64 + p] = xi; } }
            if (PASS2) {
                f32x4 y0 = {0.f, 0.f, 0.f, 0.f}, y1 = {0.f, 0.f, 0.f, 0.f};
#pragma unroll
                for (int ks = 0; ks < 32; ks += 2) { y0 = __builtin_amdgcn_mfma_f32_16x16x4f32(Xs[ln * 130 + 4 * ks + kq], cfrag[ks], y0, 0, 0, 0);
                    y1 = __builtin_amdgcn_mfma_f32_16x16x4f32(Xs[ln * 130 + 4 * (ks + 1) + kq], cfrag[ks + 1], y1, 0, 0, 0); }
#pragma unroll
                for (int r = 0; r < 4; ++r) { const size_t tk = tokb + 4 * kq + r; const float uv = bf2f(usk[sub * 4 + r]);
                    const float y = y0[r] + y1[r] + dsk * uv; Z[tk * 256 + g * 16 + ln] = (bf16)f2bf(gelu_tanh(y)); }
            }
        }
        if (!PASS2) { float* xl = XLOC + ((size_t)((b * 16 + g) * 64 + c)) * 128 + p; xl[0] = xr; xl[64] = xi; }
    }
}

__device__ __forceinline__ void phase_glu(const bf16* Z, const bf16* WG, const float* gb, const float* ong, bf16* MG, LAS unsigned char* lds, int G, int bx, int vcu, int tid, int lane, int wave) {
    LAS unsigned char* zt = lds;
    LAS float* ssq = (LAS float*)(lds + 64 * 528);
    LAS float* rs = ssq + 64 * 8;
    const int n = 32 * wave + (lane & 31), hs = lane >> 5;
    const float bn = gb[n], gnn = ong[768 + n];
    for (int tile = bx; tile < NTOK / 64; tile += G) {
        const size_t tok0 = (size_t)tile * 64;
        for (int idx = tid; idx < 64 * 32; idx += NTHR) { const int r = idx >> 5, cq = idx & 31; *(LAS v4u*)(zt + r * 528 + cq * 16) = *(const v4u*)(Z + (tok0 + r) * 256 + cq * 8); }
        __syncthreads();
        f32x16 acc[2]; acc[0] = f32x16{}; acc[1] = f32x16{};
#pragma unroll
        for (int ks = 0; ks < 16; ++ks) { const bf16x8 bw = *(const bf16x8*)(WG + (size_t)n * 256 + ks * 16 + 8 * hs);
#pragma unroll
            for (int mb = 0; mb < 2; ++mb) { const bf16x8 az = *(const LAS bf16x8*)(zt + (mb * 32 + (lane & 31)) * 528 + (ks * 16 + 8 * hs) * 2);
                acc[mb] = __builtin_amdgcn_mfma_f32_32x32x16_bf16(az, bw, acc[mb], 0, 0, 0); } }
        float val[32], sq[32];
#pragma unroll
        for (int mb = 0; mb < 2; ++mb)
#pragma unroll
            for (int r = 0; r < 16; ++r) { const int m = mb * 32 + (r & 3) + 8 * (r >> 2) + 4 * hs; const float z = bf2f(*(const LAS unsigned short*)(zt + m * 528 + n * 2));
                const float v = z / (1.f + __expf(-(acc[mb][r] + bn))); val[mb * 16 + r] = v; sq[mb * 16 + r] = v * v; }
        const float tot = bfly_reduce<32, 16>(sq, lane);
        { const int id = lane & 31, mb = id >> 4, r = id & 15, m = mb * 32 + (r & 3) + 8 * (r >> 2) + 4 * hs; ssq[m * 8 + wave] = tot; }
        __syncthreads();
        if (tid < 64) { float s = 0.f;
#pragma unroll
            for (int w8 = 0; w8 < 8; ++w8) s += ssq[tid * 8 + w8];
            rs[tid] = 1.0f / sqrtf(s * (1.f / 256.f) + EPSN); }
        __syncthreads();
#pragma unroll
        for (int mb = 0; mb < 2; ++mb)
#pragma unroll
            for (int r = 0; r < 16; ++r) { const int m = mb * 32 + (r & 3) + 8 * (r >> 2) + 4 * hs;
                MG[(tok0 + m) * DM + 768 + n] = (bf16)f2bf(val[mb * 16 + r] * rs[m] * gnn); }
        __syncthreads();
    }
    const int gw = vcu * NWAVES + wave, NGW = G * NWAVES;
    float g8[8];
#pragma unroll
    for (int j = 0; j < 8; ++j) g8[j] = ong[8 * lane + j];
    for (int row = gw; row < NTOK; row += NGW) {
        bf16* pp = MG + (size_t)row * DM + 8 * lane;
        const v4u w = *(const v4u*)pp; float f[8] = {bflo(w.x), bfhi(w.x), bflo(w.y), bfhi(w.y), bflo(w.z), bfhi(w.z), bflo(w.w), bfhi(w.w)};
        float s = 0.f;
#pragma unroll
        for (int j = 0; j < 8; ++j) s += f[j] * f[j];
        const float rstd = 1.0f / sqrtf(wave_sum(s) * (1.f / 512.f) + EPSN);
        v4u o; o.x = pk2(f[0] * rstd * g8[0], f[1] * rstd * g8[1]); o.y = pk2(f[2] * rstd * g8[2], f[3] * rstd * g8[3]);
        o.z = pk2(f[4] * rstd * g8[4], f[5] * rstd * g8[5]); o.w = pk2(f[6] * rstd * g8[6], f[7] * rstd * g8[7]); *(v4u*)pp = o;
    }
}

__device__ __forceinline__ void ins16(float (&top)[16], float x) {
#pragma unroll
    for (int i = 15; i >= 1; --i) top[i] = __builtin_amdgcn_fmed3f(top[i - 1], top[i], x);
    top[0] = fmaxf(top[0], x);
}
__device__ __forceinline__ float opq(float x) { asm("" : "+v"(x)); return x; }
__device__ __forceinline__ float tagf(float s, unsigned id, unsigned mask) { return __uint_as_float((__float_as_uint(s) & ~mask) | id); }
__device__ __forceinline__ void phase_select(const bf16* PQ, const bf16* KEYS, int* IDX, float* GATE, LAS unsigned char* lds, int G, int vcu, int tid, int lane, int wave) {
    constexpr int KROW = 272, KEYB = 2 * 128 * KROW;
    LAS unsigned* ids = (LAS unsigned*)(lds + KEYB + wave * 4096);
    const int tl = lane & 31, hs = lane >> 5;
    const float NEG = -__builtin_inff();
    const int nslot = (G >= 8) ? G / 8 : 1;
    for (int h = vcu % 8; h < 8; h += (G >= 8 ? 8 : G)) {
        __syncthreads();
        for (int idx = tid; idx < 2 * 128 * 16; idx += NTHR) { const int row = idx >> 4, cq = idx & 15;
            *(LAS v4u*)(lds + row * KROW + cq * 16) = *(const v4u*)(KEYS + ((size_t)h * 256 + row) * 128 + cq * 8); }
        __syncthreads();
        const int slot = (G >= 8) ? vcu / 8 : 0;
        bf16x8 bq[2][8];
        int tb = slot * 8 + wave;
        if (tb < NTOK / 32) {
#pragma unroll
            for (int ks = 0; ks < 8; ++ks) bq[0][ks] = *(const bf16x8*)(PQ + ((size_t)tb * 32 + tl) * PQW + h * 256 + 8 * hs + ks * 16);
        }
#pragma unroll 1
        for (; tb < NTOK / 32; tb += 8 * nslot) {
            const size_t tok = (size_t)tb * 32 + tl;
            float t1[16], t2[16];
#pragma unroll
            for (int half = 0; half < 2; ++half) {
                { const int ntb = (half == 0) ? tb : tb + 8 * nslot; const int ntbc = (ntb < NTOK / 32) ? ntb : tb;
                  const bf16* qn = PQ + ((size_t)ntbc * 32 + tl) * PQW + h * 256 + (half == 0 ? 128 : 0) + 8 * hs;
#pragma unroll
                  for (int ks = 0; ks < 8; ++ks) bq[half ^ 1][ks] = *(const bf16x8*)(qn + ks * 16); }
                f32x16 acc[4]; acc[0] = f32x16{}; acc[1] = f32x16{}; acc[2] = f32x16{}; acc[3] = f32x16{};
                const LAS unsigned char* kp = lds + (half * 128 + tl) * KROW + 16 * hs;
#pragma unroll
                for (int ks = 0; ks < 8; ++ks)
#pragma unroll
                    for (int kb = 0; kb < 4; ++kb) { const bf16x8 ak = *(const LAS bf16x8*)(kp + kb * 32 * KROW + ks * 32); acc[kb] = __builtin_amdgcn_mfma_f32_32x32x16_bf16(ak, bq[half][ks], acc[kb], 0, 0, 0); }
                float top[16];
#pragma unroll
                for (int i = 0; i < 16; ++i) top[i] = NEG;
#pragma unroll
                for (int kb = 0; kb < 4; ++kb)
#pragma unroll
                    for (int r = 0; r < 16; ++r) ins16(top, tagf(acc[kb][r], (unsigned)(32 * kb + (r & 3) + 8 * (r >> 2) + 4 * hs), 127u));
                float oth[16];
#pragma unroll
                for (int i = 0; i < 16; ++i) oth[i] = __shfl_xor(top[i], 32);
#pragma unroll
                for (int i = 0; i < 16; ++i) ins16(top, oth[i]);
#pragma unroll
                for (int i = 0; i < 16; ++i) { if (half == 0) t1[i] = top[i]; else t2[i] = top[i]; }
            }
#pragma unroll
            for (int i = 0; i < 16; ++i) ids[(tl * 2 + hs) * 16 + i] = __float_as_uint(hs ? opq(t2[i]) : opq(t1[i])) & 127u;
            float best[16];
#pragma unroll
            for (int i = 0; i < 16; ++i) best[i] = NEG;
#define CAND(a0, b0, a1, b1) { const float s0_ = opq(t1[a0] + t2[b0]), s1_ = opq(t1[a1] + t2[b1]); ins16(best, hs ? tagf(s1_, (unsigned)((a1) * 16 + (b1)), 255u) : tagf(s0_, (unsigned)((a0) * 16 + (b0)), 255u)); }
            CAND_LIST
#undef CAND
            { float oth[16];
#pragma unroll
              for (int i = 0; i < 16; ++i) oth[i] = __shfl_xor(best[i], 32);
#pragma unroll
              for (int i = 0; i < 16; ++i) ins16(best, oth[i]); }
            float e[16], den = 0.f;
#pragma unroll
            for (int i = 0; i < 16; ++i) { e[i] = __expf(best[i] - best[0]); den += e[i]; }
            const float rden = 1.f / den;
            int ex[8]; float gt[8];
#pragma unroll
            for (int j = 0; j < 8; ++j) { const float bj = hs ? opq(best[8 + j]) : opq(best[j]); const unsigned id = __float_as_uint(bj) & 255u;
                const unsigned i1 = ids[(tl * 2 + 0) * 16 + (id >> 4)], i2 = ids[(tl * 2 + 1) * 16 + (id & 15u)];
                ex[j] = (int)(i1 * 128u + i2); gt[j] = (hs ? opq(e[8 + j]) : opq(e[j])) * rden; }
            int* ip = IDX + tok * 128 + h * 16 + hs * 8; float* gp = GATE + tok * 128 + h * 16 + hs * 8;
            *(v4u*)ip = (v4u){(unsigned)ex[0], (unsigned)ex[1], (unsigned)ex[2], (unsigned)ex[3]}; *(v4u*)(ip + 4) = (v4u){(unsigned)ex[4], (unsigned)ex[5], (unsigned)ex[6], (unsigned)ex[7]};
            *(f32x4*)gp = (f32x4){gt[0], gt[1], gt[2], gt[3]}; *(f32x4*)(gp + 4) = (f32x4){gt[4], gt[5], gt[6], gt[7]};
        }
    }
}

constexpr int GCH = 32;
constexpr int CW_Q = 8192;
template <int CTRL> __device__ __forceinline__ float dpp_mov(float v) { return __builtin_bit_cast(float, __builtin_amdgcn_update_dpp(0, __builtin_bit_cast(int, v), CTRL, 0xF, 0xF, true)); }
__device__ __forceinline__ float sum8(float s) {
    s += dpp_mov<0xB1>(s); s += dpp_mov<0x4E>(s); s += dpp_mov<0x141>(s); return s;
}
__device__ __forceinline__ void phase_gather_u(const bf16* XN, const int* IDX, const unsigned char* U, float* PART, unsigned* queue, int lane, unsigned imask = 0xffffffffu) {
    const unsigned xcc = xb_xcc_id() & 7u; const int g = lane >> 3, j = lane & 7;
#pragma unroll 1
    for (unsigned sx = 0; sx < 8; ++sx) { const unsigned x = (xcc + sx) & 7u; unsigned* q = queue + x * 64;
        const unsigned char* Ux = U + (size_t)x * NEXP * 128; const unsigned jo = (unsigned)j * 16u, lane4 = (unsigned)lane * 4u; const bf16* Hx = XN + x * 128 + j * 16; const int* Ig = IDX + 16 * g;
#pragma unroll 1
        for (;;) {
            unsigned c = 0; if (lane == 0) c = __hip_atomic_fetch_add(q, 1u, __ATOMIC_RELAXED, __HIP_MEMORY_SCOPE_AGENT);
            c = (unsigned)__builtin_amdgcn_readfirstlane((int)c); if (c >= (unsigned)(NTOK / GCH)) break;
            const size_t tb = (size_t)c * GCH;
            v4u ix[2][4], hw[2][2], rw[16];
#define G1_IDX(ib, tok_) do { _Pragma("unroll") for (int q4 = 0; q4 < 4; ++q4) ix[ib][q4] = *(const v4u*)(Ig + (tok_) * 128 + 4 * q4) & imask; } while (0)
#define G1_AUX(ab, tok_) do { hw[ab][0] = *(const v4u*)(Hx + (tok_) * DM); hw[ab][1] = *(const v4u*)(Hx + (tok_) * DM + 8); } while (0)
#define G1_TOKEN(p, tt_) do { G1_AUX((p) ^ 1, tb + (((tt_) + 1 < GCH) ? (tt_) + 1 : (tt_))); \
            h16x2 hh[8]; \
            _Pragma("unroll") for (int q8 = 0; q8 < 8; ++q8) { const unsigned w_ = hw[p][q8 >> 2][q8 & 3]; hh[q8] = (h16x2){(_Float16)bflo(w_), (_Float16)bfhi(w_)}; } \
            float r0 = 0.f, r1 = 0.f; \
            _Pragma("unroll") for (int i = 0; i < 16; ++i) { float s = 0.f; const v4u rv_ = rw[i]; \
                rw[i] = *(const v4u*)(Ux + (ix[(p) ^ 1][i >> 2][i & 3] * 128u + jo)); \
                _Pragma("unroll") for (int q4 = 0; q4 < 4; ++q4) { const int w = (int)rv_[q4]; \
                    s = __builtin_amdgcn_fdot2(hh[2 * q4], __builtin_amdgcn_cvt_scalef32_pk_f16_fp8(w, 1.0f, false), s, false); \
                    s = __builtin_amdgcn_fdot2(hh[2 * q4 + 1], __builtin_amdgcn_cvt_scalef32_pk_f16_fp8(w, 1.0f, true), s, false); } \
                s = sum8(s); \
                if (i < 8) r0 = ((i & 7) == j) ? s : r0; else r1 = ((i & 7) == j) ? s : r1; } \
            float* pp = PART + ((size_t)x * NTOK + tb + (tt_)) * 128; *(float*)((char*)pp + lane4) = r0; *(float*)((char*)(pp + 64) + lane4) = r1; \
            G1_IDX(p, tb + (((tt_) + 2 < GCH) ? (tt_) + 2 : (tt_))); } while (0)
            G1_IDX(0, tb); G1_IDX(1, tb + 1); G1_AUX(0, tb);
#pragma unroll
            for (int i = 0; i < 16; ++i) rw[i] = *(const v4u*)(Ux + (ix[0][i >> 2][i & 3] * 128u + jo));
#pragma unroll 1
            for (int tt = 0; tt < GCH; tt += 2) { G1_TOKEN(0, tt); G1_TOKEN(1, tt + 1); }
#undef G1_IDX
#undef G1_AUX
#undef G1_TOKEN
        }
    }
}
__device__ __forceinline__ void phase_gather_act(const float* PART, const float* GATE, float* ACT, int G, int vcu, int tid) {
    const size_t gt = (size_t)vcu * NTHR + tid, NGT = (size_t)G * NTHR;
    for (size_t e4 = gt; e4 < (size_t)NTOK * 32; e4 += NGT) { const size_t tok = e4 >> 5; const int p = (int)(e4 & 31) * 4;
        f32x4 s = *(const f32x4*)(PART + e4 * 4);
#pragma unroll
        for (int x = 1; x < 8; ++x) s += *(const f32x4*)(PART + (size_t)x * NTOK * 128 + e4 * 4);
        const int k = (p < 64) ? 16 * (p >> 3) + (p & 7) : 16 * ((p - 64) >> 3) + 8 + (p & 7);
        const f32x4 gv = *(const f32x4*)(GATE + tok * 128 + k);
        f32x4 o;
#pragma unroll
        for (int i = 0; i < 4; ++i) o[i] = gv[i] * gelu_tanh(s[i] * (1.f / U8_SCALE)) * (ACT_SCALE / V8_SCALE);
        *(f32x4*)(ACT + e4 * 4) = o; }
}
__device__ __forceinline__ void phase_gather_v(const float* ACT, const int* IDX, const unsigned char* V, float* out, unsigned* queue, int lane) {
    const unsigned xcc = xb_xcc_id() & 7u; const int g = lane >> 3, j = lane & 7;
    typedef float f32x2v __attribute__((ext_vector_type(2)));
#pragma unroll 1
    for (unsigned sx = 0; sx < 8; ++sx) { const unsigned x = (xcc + sx) & 7u; unsigned* q = queue + x * 64;
        const unsigned char* Vx = V + (size_t)x * NEXP * 128; const unsigned jo = (unsigned)j * 16u; const int* Ig = IDX + 16 * g; float* Ob = out + x * 128; const unsigned lo = (unsigned)(16 * j + 2 * g) * 4u;
#pragma unroll 1
        for (;;) {
            unsigned c = 0; if (lane == 0) c = __hip_atomic_fetch_add(q, 1u, __ATOMIC_RELAXED, __HIP_MEMORY_SCOPE_AGENT);
            c = (unsigned)__builtin_amdgcn_readfirstlane((int)c); if (c >= (unsigned)(NTOK / GCH)) break;
            const size_t tb = (size_t)c * GCH;
            v4u ix[2][4], rw[16]; float a0[2], a1[2]; f32x2v ov[2]; const int bsel = (lane & ~7) * 4; const unsigned lane4 = (unsigned)lane * 4u;
#define G3_IDX(ib, tok_) do { _Pragma("unroll") for (int q4 = 0; q4 < 4; ++q4) ix[ib][q4] = *(const v4u*)(Ig + (tok_) * 128 + 4 * q4); } while (0)
#define G3_AUX(ab, tok_) do { a0[ab] = *(const float*)((const char*)(ACT + (tok_) * 128) + lane4); a1[ab] = *(const float*)((const char*)(ACT + (tok_) * 128 + 64) + lane4); { unsigned lo_ = lo; asm volatile("" : "+v"(lo_)); ov[ab] = *(const f32x2v*)((const char*)(Ob + (tok_) * DM) + lo_); } } while (0)
#define G3_TOKEN(p, tt_) do { G3_AUX((p) ^ 1, tb + (((tt_) + 1 < GCH) ? (tt_) + 1 : (tt_))); \
            h16x2 hacc[8]; \
            _Pragma("unroll") for (int i = 0; i < 8; ++i) hacc[i] = (h16x2){(_Float16)0.f, (_Float16)0.f}; \
            _Pragma("unroll") for (int i = 0; i < 16; ++i) { const v4u rv_ = rw[i]; \
                rw[i] = *(const v4u*)(Vx + (ix[(p) ^ 1][i >> 2][i & 3] * 128u + jo)); \
                const float a = __builtin_bit_cast(float, __builtin_amdgcn_ds_bpermute(bsel + 4 * (i & 7), __builtin_bit_cast(int, (i < 8) ? a0[p] : a1[p])));   \
                const _Float16 ah = (_Float16)a; const h16x2 a2 = (h16x2){ah, ah}; \
                _Pragma("unroll") for (int q4 = 0; q4 < 4; ++q4) { const int w = (int)rv_[q4]; \
                    hacc[2 * q4] = __builtin_elementwise_fma(cvt8h<false>(w), a2, hacc[2 * q4]); \
                    hacc[2 * q4 + 1] = __builtin_elementwise_fma(cvt8h<true>(w), a2, hacc[2 * q4 + 1]); } } \
            float acc[16]; \
            _Pragma("unroll") for (int i = 0; i < 8; ++i) { acc[2 * i] = (float)hacc[i].x; acc[2 * i + 1] = (float)hacc[i].y; } \
            int s_ = 32; \
            _Pragma("unroll") for (int cnt = 16; cnt > 2; cnt >>= 1) { const bool up = (lane & s_) != 0; \
                _Pragma("unroll") for (int i = 0; i < cnt / 2; ++i) { const float a = acc[i], b = acc[i + cnt / 2]; const float send = up ? a : b, keep = up ? b : a; acc[i] = keep + __shfl_xor(send, s_); } \
                s_ >>= 1; } \
            f32x2v o = ov[p]; o[0] += acc[0] * (1.f / ACT_SCALE); o[1] += acc[1] * (1.f / ACT_SCALE); \
            { unsigned lo_ = lo; asm volatile("" : "+v"(lo_)); *(f32x2v*)((char*)(Ob + (tb + (tt_)) * DM) + lo_) = o; } \
            G3_IDX(p, tb + (((tt_) + 2 < GCH) ? (tt_) + 2 : (tt_))); } while (0)
            G3_IDX(0, tb); G3_IDX(1, tb + 1); G3_AUX(0, tb);
#pragma unroll
            for (int i = 0; i < 16; ++i) rw[i] = *(const v4u*)(Vx + (ix[0][i >> 2][i & 3] * 128u + jo));
#pragma unroll 1
            for (int tt = 0; tt < GCH; tt += 2) { G3_TOKEN(0, tt); G3_TOKEN(1, tt + 1); }
#undef G3_IDX
#undef G3_AUX
#undef G3_TOKEN
        }
    }
}

__device__ __forceinline__ void phase_gather_naive(const bf16* XN, const int* IDX, const float* GATE, const float* U, const float* V, float* out, int G, int vcu, int lane, int wave) {
    const int gw = vcu * NWAVES + wave, NGW = G * NWAVES;
    for (int tok = gw; tok < NTOK; tok += NGW) {
        float hv[16], acc[16];
#pragma unroll
        for (int j = 0; j < 16; ++j) { hv[j] = bf2f(XN[(size_t)tok * DM + lane + 64 * j]); acc[j] = 0.f; }
        for (int k = 0; k < 128; ++k) { const int e = IDX[(size_t)tok * 128 + k]; const float g = GATE[(size_t)tok * 128 + k];
            float s = 0.f;
#pragma unroll
            for (int j = 0; j < 16; ++j) s += hv[j] * U[(size_t)e * DM + lane + 64 * j];
            s = wave_sum(s); const float a = g * gelu_tanh(s);
#pragma unroll
            for (int j = 0; j < 16; ++j) acc[j] += a * V[(size_t)e * DM + lane + 64 * j]; }
#pragma unroll
        for (int j = 0; j < 16; ++j) out[(size_t)tok * DM + lane + 64 * j] += acc[j];
    }
}
constexpr int PH_PER_LAYER = 15, N_PHASES = 1 + 2 * PH_PER_LAYER;
__device__ __forceinline__ KArgs kargs() { KArgs p = (KArgs)__builtin_amdgcn_kernarg_segment_ptr(); asm volatile("" : "+s"(p)); return p; }
__global__ void __launch_bounds__(NTHR, 2) mega_fwd(Args a_unused) {
    extern __shared__ __attribute__((aligned(16))) unsigned char lds_raw[];
    LAS unsigned char* lds = (LAS unsigned char*)lds_raw;
    volatile LAS unsigned* MISC = (volatile LAS unsigned*)(lds + MISC_OFF);
    const int tid0 = threadIdx.x;
    for (int u = tid0; u < (LDS_BYTES - LDSCTL_OFF) / 4; u += NTHR) ((LAS unsigned*)(lds + LDSCTL_OFF))[u] = 0u;
    __syncthreads();
    { const unsigned hw = (unsigned)__builtin_amdgcn_s_getreg((6 << 11) | 4); if ((tid0 & 63) == 0) *(volatile LAS int*)(lds + OTID_LDS_OFF + 4 * (hw & 63u)) = tid0 >> 6; }
    __syncthreads();
    XcdBarrier bar; { KArgs ka = kargs(); unsigned char* ws0 = ka->ws; bar.bar = (unsigned*)(ws0 + WS_CTL) + CW_BAR; bar.x = 0; bar.st = nullptr;
      if (ka->use_bar) bar = xcd_barrier_post((unsigned*)(ws0 + WS_CTL) + CW_BAR, MISC + 8); }
    const int ph_lo = kargs()->ph_lo, ph_hi = kargs()->ph_hi;
#define TLW const int tid = otid(), lane = tid & 63, wave = __builtin_amdgcn_readfirstlane(tid >> 6); (void)tid; (void)lane; (void)wave;
#pragma unroll 1
    for (int pc = ph_lo; pc < ph_hi + (DUP_PH >= 0 ? 1 : 0); ++pc) {
        const int ph = (DUP_PH >= 0 && pc > DUP_PH) ? pc - 1 : pc;
        unsigned long long tph0_ = 0; if (TIME_PH >= 0 && (pc == TIME_PH || TIME_PH == 99)) tph0_ = __builtin_amdgcn_s_memrealtime();
        KArgs a = kargs(); unsigned char* ws = a->ws;
        int G = gridDim.x, bx = blockIdx.x; asm volatile("" : "+s"(G), "+s"(bx)); const int vcu = (G % 8 == 0) ? (bx % 8) * (G / 8) + bx / 8 : bx;
        bf16* const XN = (bf16*)(ws + WS_XN); bf16* const Pq = (bf16*)(ws + WS_P); bf16* const Pk = Pq + (size_t)NTOK * 512; bf16* const Pv = Pk + (size_t)NTOK * 512; bf16* const Ps = Pv + (size_t)NTOK * 512;
        bf16* const MG = (bf16*)(ws + WS_MG); float* const CB = (float*)(ws + WS_CB); float* const XLOC = (float*)(ws + WS_XLOC); bf16* const Z = (bf16*)(ws + WS_Z);
        int* const IDX = (int*)(ws + WS_IDX); float* const GATE = (float*)(ws + WS_GATE);
        if (ph == 0) { TLW if (PH_MASK & 1u) phase_prep(a, lds, G, vcu, tid, lane, wave); }
        else {
            const int l = (ph - 1) / PH_PER_LAYER, sub = (ph - 1) % PH_PER_LAYER;
            const float* xin = (l == 0) ? a->in[0] : a->out;
            switch (sub) {
            case 0: if (PH_MASK & (1u << 1)) { TLW phase_rownorm<true>(xin, a->in[1] + l * DM, XN, (const float*)(ws + WS_WF) + l * 8 * 1024, a->in[3] + l * 8, CB, G, vcu, lane, wave); } break;
            case 1: if (PH_MASK & (1u << 2)) { pg8::Gemm g{XN, (const bf16*)(ws + WS_WIN) + (size_t)l * 2048 * 1024, NTOK, 2048, 1024}; pg8::StaticOrder S; S.init(NTOK, 2048, G, bx);
                pg8::EpiBf16<0> E{Pq, 512, nullptr, 512, (size_t)NTOK * 512, 1.f};
                pg8::gemm_phase<pg8::EpiBf16<0>, pg8::StaticOrder, true, true>(lds, g, S, E); } break;
            case 2: if (PH_MASK & (1u << 3)) { TLW phase_headnorm(Pq, Pk, a->in[4] + l * 64, a->in[5] + l * 64, CB, G, vcu, lane, wave); } break;
            case 3: if (PH_MASK & (1u << 4)) { TLW { const float gq = wave_max(fabsf(a->in[4][l * 64 + lane])), gk = wave_max(fabsf(a->in[5][l * 64 + lane]));
                const float qkb = 8.f * gq * gk * LOG2E * 1.02f + 0.25f;
                const attn_body::AttnTensors AT{(const attn_body::bf16*)Pq, (const attn_body::bf16*)Pk, (const attn_body::bf16*)Pv, (attn_body::bf16*)MG, CB, qkb};
                attn_body::attn_phase_q<ATT_SKIP>((char*)lds_raw, AT, (unsigned*)(ws + WS_CTL) + CW_AQ + l * 512); } } break;
            case 4: if (PH_MASK & (1u << 5)) { TLW phase_pool(Ps, a->in[6] + (size_t)l * 4 * 64 * 64, a->in[7] + l * 256, a->in[18] + l * DM, MG, lds, G, bx, tid, lane, wave); } break;
            case 5: if (PH_MASK & (1u << 6)) { TLW phase_s5<false>(a, l, Ps, XLOC, Z, lds, G, bx, lane, wave); } break;
            case 6: if (PH_MASK & (1u << 7)) { TLW phase_s5<true>(a, l, Ps, XLOC, Z, lds, G, bx, lane, wave); } break;
            case 7: if (PH_MASK & (1u << 8)) { TLW phase_glu(Z, (const bf16*)(ws + WS_WGLU) + (size_t)l * 256 * 256, a->in[17] + l * 256, a->in[18] + l * DM, MG, lds, G, bx, vcu, tid, lane, wave); } break;
            case 8: if (PH_MASK & (1u << 9)) { pg8::Gemm g{MG, (const bf16*)(ws + WS_WOUT) + (size_t)l * 1024 * 1024, NTOK, 1024, 1024}; pg8::StaticOrder S; S.init(NTOK, 1024, G, bx);
                pg8::EpiResF32 E{xin, a->out, DM};
                pg8::gemm_phase<pg8::EpiResF32, pg8::StaticOrder, true, true>(lds, g, S, E); } break;
            case 9: if (PH_MASK & (1u << 10)) { TLW phase_rownorm<false>(a->out, a->in[20] + l * DM, XN, nullptr, nullptr, nullptr, G, vcu, lane, wave); } break;
            case 10: if (PH_MASK & (1u << 11)) { pg8::Gemm g{XN, (const bf16*)(ws + WS_WQ) + (size_t)l * 2048 * 1024, NTOK, 2048, 1024}; pg8::StaticOrder S; S.init(NTOK, 2048, G, bx);
                pg8::EpiBf16<0> E{Pq, PQW, nullptr, 0, 0, 1.f};
                pg8::gemm_phase<pg8::EpiBf16<0>, pg8::StaticOrder, true, true>(lds, g, S, E); } break;
            case 11: if (PH_MASK & (1u << 12)) { TLW phase_select(Pq, (const bf16*)(ws + WS_KEYS) + (size_t)l * 8 * 2 * 128 * 128, IDX, GATE, lds, G, vcu, tid, lane, wave); } break;
            case 12: if (PH_MASK & (1u << 13)) { TLW phase_gather_u(XN, IDX, (const unsigned char*)(ws + WS_U) + (size_t)l * NEXP * DM, (float*)(ws + WS_P), (unsigned*)(ws + WS_CTL) + CW_Q + (l * 2 + 0) * 512 + ((DUP_PH >= 0 && pc == DUP_PH + 1) ? 4096 : 0), lane, (DUP_PH >= 0 && pc == DUP_PH) ? DIAG_IMASK : 0xffffffffu); } break;
            case 13: if (PH_MASK & (1u << 14)) { TLW phase_gather_act((const float*)(ws + WS_P), GATE, (float*)(ws + WS_Z), G, vcu, tid); } break;
            default: if (PH_MASK & (1u << 15)) { TLW phase_gather_v((const float*)(ws + WS_Z), IDX, (const unsigned char*)(ws + WS_V) + (size_t)l * NEXP * DM, a->out, (unsigned*)(ws + WS_CTL) + CW_Q + (l * 2 + 1) * 512, lane); } break;
            }
        }
        if (pc + 1 < ph_hi + (DUP_PH >= 0 ? 1 : 0)) { XcdBarrier b2 = bar; asm volatile("" : "+s"(b2.bar)); xcd_barrier(b2);
            if (TIME_PH >= 0 && (pc == TIME_PH || TIME_PH == 99)) { const unsigned long long t1_ = __builtin_amdgcn_s_memrealtime(), te_ = t1_ + TIME_MUL * (t1_ - tph0_); while (__builtin_amdgcn_s_memrealtime() < te_) __builtin_amdgcn_s_sleep(8); } }
    }
}

extern "C" void kernel_launch(void* const* d_in, const int* in_sizes, int n_in, void* d_out, int out_size, void* d_ws, size_t ws_size, hipStream_t stream) {
    static int grid = 0;
    if (grid == 0) {
        if (n_in != 25 || in_sizes[0] != NTOK * DM || out_size != NTOK * DM || ws_size < WS_END) {
            fprintf(stderr, "kernel_launch: unexpected problem: n_in %d in0 %d out %d ws %zu (need %zu); nothing launched\n", n_in, n_in > 0 ? in_sizes[0] : -1, out_size, ws_size, (size_t)WS_END); grid = -1; return; }
        int dev = 0, cus = 0;
        if (hipGetDevice(&dev) != hipSuccess || hipDeviceGetAttribute(&cus, hipDeviceAttributeMultiprocessorCount, dev) != hipSuccess) { fprintf(stderr, "kernel_launch: device query failed\n"); grid = -1; return; }
        if (hipFuncSetAttribute((const void*)mega_fwd, hipFuncAttributeMaxDynamicSharedMemorySize, LDS_BYTES) != hipSuccess) { fprintf(stderr, "kernel_launch: hipFuncSetAttribute failed\n"); grid = -1; return; }
        (void)hipGetLastError();
        grid = cus;
    }
    if (grid < 0) return;
    (void)hipMemsetAsync((char*)d_ws + WS_CTL, 0, CTL_ZERO_BYTES, stream);
    Args a{};
    for (int i = 0; i < 25; ++i) a.in[i] = (const float*)d_in[i];
    a.out = (float*)d_out; a.ws = (unsigned char*)d_ws;
#if MK_ONE_LAUNCH
    a.ph_lo = 0; a.ph_hi = N_PHASES; a.use_bar = 1;
    hipLaunchKernelGGL(mega_fwd, dim3(grid), dim3(NTHR), LDS_BYTES, stream, a);
#else
    for (int ph = 0; ph < N_PHASES; ++ph) { a.ph_lo = ph; a.ph_hi = ph + 1; a.use_bar = 0;
        hipLaunchKernelGGL(mega_fwd, dim3(grid), dim3(NTHR), LDS_BYTES, stream, a); }
#endif
    const hipError_t le = hipPeekAtLastError();
    if (le != hipSuccess) fprintf(stderr, "kernel_launch: launch failed: %s\n", hipGetErrorName(le));
}
```

```cpp
#include <hip/hip_runtime.h>
#include <hip/hip_bf16.h>
#include <hip/hip_fp16.h>
#include <cstdio>
#include <cstdint>
#include <cmath>
#ifndef MK_ONE_LAUNCH
#define MK_ONE_LAUNCH 1
#endif
#ifndef ATT_SKIP
#define ATT_SKIP true
#endif
#ifndef PH_MASK
#define PH_MASK 0xffffffffu
#endif
#define OTID_LDS_OFF (131072 + 1024)
__device__ __forceinline__ int otid() {
    int z = 0; asm volatile("" : "+v"(z)); const int lane = __builtin_amdgcn_mbcnt_hi(-1, __builtin_amdgcn_mbcnt_lo(-1, z));
    const unsigned hw = (unsigned)__builtin_amdgcn_s_getreg((6 << 11) | 4);
    const int wv = *(const volatile __attribute__((address_space(3))) int*)(OTID_LDS_OFF + 4 * (hw & 63u));
    return (__builtin_amdgcn_readfirstlane(wv) << 6) | lane;
}
#ifndef GATHER_NAIVE
#define GATHER_NAIVE 0
#endif
#ifndef DUP_PH
#define DUP_PH (-1)
#endif
#ifndef TIME_PH
#define TIME_PH (-1)
#define TIME_MUL 3
#endif
#ifndef DIAG_IMASK
#define DIAG_IMASK 0xffu
#endif
#ifndef S5_CPROJ_F32
#define S5_CPROJ_F32 1
#endif
namespace pg8 {
#define PG8_LAS __attribute__((address_space(3)))
typedef unsigned short bf16_t;
typedef short bf16x8 __attribute__((ext_vector_type(8)));
typedef float f32x4 __attribute__((ext_vector_type(4)));
typedef unsigned u32x4 __attribute__((ext_vector_type(4)));
constexpr int BM = 256, BK = 64, HALF = 128, HTB = HALF * BK * 2  , STAGE_BYTES = 8 * HTB, NXCD = 8, WGM = 8;

__host__ __device__ __forceinline__ int lds_byte(int r, int c) { const int st = (r >> 4) * 2 + (c >> 5), rr = r & 15, cc = c & 31, ob = rr * 64 + cc * 2; return st * 1024 + (ob ^ (((ob >> 9) & 1) << 5)); }
__host__ __device__ __forceinline__ void stage_rc(int b, int& R, int& C) { const int st = b / 1024, sb = b % 1024, swz = sb ^ (((sb >> 9) & 1) << 5); R = (st >> 1) * 16 + swz / 64; C = (st & 1) * 32 + (swz % 64) / 2; }
__host__ __device__ __forceinline__ int perm32(int rho) { const int n = rho >> 4, i = rho & 15; return 8 * (i >> 2) + 4 * n + (i & 3); }

struct Unit { int pm, pn; };
struct Gemm { const bf16_t* A; const bf16_t* Bt; int M, N, K; };

struct StaticOrder {
    int nM, nN, nwg, G, c;
    __host__ __device__ void init(int M, int N, int G_, int c_) { nM = M / BM; nN = N / BM; nwg = nM * nN; G = G_; c = c_; }
    __host__ __device__ bool next(int i, Unit& u) const {
        const long L = (long)i * G + c; if (L >= nwg) return false;
        int wgid = (int)L; { const int q = nwg / NXCD, r = nwg % NXCD, xcd = wgid % NXCD, off = wgid / NXCD; wgid = (xcd < r ? xcd * (q + 1) : r * (q + 1) + (xcd - r) * q) + off; }
        const int nig = WGM * nN, gid = wgid / nig, fm = gid * WGM, gsz = (nM - fm) < WGM ? (nM - fm) : WGM;
        u.pm = fm + ((wgid % nig) % gsz); u.pn = (wgid % nig) / gsz; return true;
    }
    __device__ __forceinline__ void a_ready(const Unit&) const {}
    __device__ __forceinline__ void done(const Unit&) const {}
};

__device__ __forceinline__ unsigned cvt_pk_bf16(float lo, float hi) { unsigned r; asm volatile("v_cvt_pk_bf16_f32 %0, %1, %2" : "=v"(r) : "v"(lo), "v"(hi)); return r; }
typedef float f32x2 __attribute__((ext_vector_type(2)));
__device__ __forceinline__ f32x2 gelu_pk(f32x2 v) {
    const f32x2 av = __builtin_elementwise_abs(v), d = av * 0.2316418882f + 1.0f;
    f32x2 t; t.x = __builtin_amdgcn_rcpf(d.x); t.y = __builtin_amdgcn_rcpf(d.y);
    f32x2 q = t * 0.5307027145f + (-0.7265760135f); q = q * t + 0.7107068705f; q = q * t + (-0.142248368f); q = q * t + 0.127414796f; q = q * t;
    const f32x2 s = (v * v) * (-0.72134752044f);
    f32x2 e; e.x = __builtin_amdgcn_exp2f(s.x); e.y = __builtin_amdgcn_exp2f(s.y);
    const f32x2 m = v * (q * e), r = v - m;
    f32x2 o; o.x = v.x < 0.f ? m.x : r.x; o.y = v.y < 0.f ? m.y : r.y; return o;
}

template <int ACT  > struct EpiBf16 {
    static constexpr bool PERM = true, AFTER_DRAIN = false; static_assert(ACT == 0 || ACT == 1, "EpiBf16: ACT is 0 (none) or 1 (gelu_pk)");
    bf16_t* O; int ldc; const float* bias; int split_cols; size_t split_stride; float scale0;
    __device__ __forceinline__ void operator()(const f32x4 (&acc)[2][2][4][2], const Unit& u, int wr, int wc, int fr, int fq) const {
        const int row0 = u.pm * BM + wr * 64 + fr; int colt = u.pn * BM; bf16_t* base = O;
        float sc = 1.f; if (split_cols) { const int t = colt / split_cols; base += (size_t)t * split_stride; colt -= t * split_cols; if (t == 0) sc = scale0; }
        const int col0 = colt + wc * 32 + 8 * fq, bcol0 = u.pn * BM + wc * 32 + 8 * fq;
        f32x4 bv[2][2];
#pragma unroll
        for (int bj = 0; bj < 2; ++bj)
#pragma unroll
            for (int n = 0; n < 2; ++n) bv[bj][n] = bias ? *(const f32x4*)(bias + bcol0 + bj * HALF + 4 * n) : (f32x4){0.f, 0.f, 0.f, 0.f};
#pragma unroll
        for (int ai = 0; ai < 2; ++ai)
#pragma unroll
            for (int m = 0; m < 4; ++m) { bf16_t* rowp = base + (size_t)(row0 + ai * HALF + m * 16) * ldc + col0;
#pragma unroll
                for (int bj = 0; bj < 2; ++bj) { f32x4 v0 = acc[ai][bj][m][0] + bv[bj][0], v1 = acc[ai][bj][m][1] + bv[bj][1];
                    if (ACT == 1) { f32x2 a = gelu_pk((f32x2){v0[0], v0[1]}), b = gelu_pk((f32x2){v0[2], v0[3]}), c = gelu_pk((f32x2){v1[0], v1[1]}), d = gelu_pk((f32x2){v1[2], v1[3]});
                        v0 = (f32x4){a.x, a.y, b.x, b.y}; v1 = (f32x4){c.x, c.y, d.x, d.y}; }
                    v0 = v0 * sc; v1 = v1 * sc; u32x4 w; w.x = cvt_pk_bf16(v0[0], v0[1]); w.y = cvt_pk_bf16(v0[2], v0[3]); w.z = cvt_pk_bf16(v1[0], v1[1]); w.w = cvt_pk_bf16(v1[2], v1[3]);
                    *(u32x4*)(rowp + bj * HALF) = w; } }
    }
};
struct EpiResF32 {
    static constexpr bool PERM = false, AFTER_DRAIN = false;
    const float* base; float* out; int ldc;
    __device__ __forceinline__ void operator()(const f32x4 (&acc)[2][2][4][2], const Unit& u, int wr, int wc, int fr, int fq) const {
        const int col0 = u.pn * BM + wc * 32 + 4 * fq;
#pragma unroll
        for (int ai = 0; ai < 2; ++ai)
#pragma unroll
            for (int m = 0; m < 4; ++m) { const size_t off = (size_t)(u.pm * BM + ai * HALF + wr * 64 + m * 16 + fr) * ldc + col0;
#pragma unroll
                for (int bj = 0; bj < 2; ++bj)
#pragma unroll
                    for (int n = 0; n < 2; ++n) { const f32x4 bs = *(const f32x4*)(base + off + bj * HALF + n * 16); *(f32x4*)(out + off + bj * HALF + n * 16) = bs + acc[ai][bj][m][n]; } }
    }
};
template <class Epi, class Sched, bool ALIGN_EPI = false, bool SP2 = false>
__device__ __forceinline__ void gemm_phase(PG8_LAS unsigned char* lds, const Gemm g, const Sched& S, const Epi& E) {
    const int tid = otid(), wid = __builtin_amdgcn_readfirstlane(tid >> 6), lane = tid & 63, wr = wid >> 2, wc = wid & 3, fr = lane & 15, fq = lane >> 4;
    const int K = g.K, nt = K / BK;
    unsigned voffA[2], voffB[2];
#pragma unroll
    for (int i = 0; i < 2; ++i) { int R, C; stage_rc(tid * 16 + i * 8192, R, C); const int Rb = Epi::PERM ? ((R & ~31) + perm32(R & 31)) : R;
        voffA[i] = (unsigned)(R * K + C) * 2u; voffB[i] = (unsigned)(Rb * K + C) * 2u; }
    const size_t kstep = (size_t)(BK * 2);
    const size_t hstep = (size_t)HALF * K * 2;
    const size_t tstep = 2 * hstep;
    const unsigned ldsw = (unsigned)wid * 1024u;
    const int aoff = lds_byte(wr * 64 + fr, fq * 8), boff = lds_byte(wc * 32 + fr, fq * 8);
#define PG8_SA(b, h) (((b) * 2 + (h)) * HTB)
#define PG8_SB(b, h) ((4 + (b) * 2 + (h)) * HTB)
#define PG8_STAGE(bufoff, gbase, voff) do { _Pragma("unroll") for (int _i = 0; _i < 2; ++_i) \
        __builtin_amdgcn_global_load_lds((const unsigned*)((const char*)(gbase) + (voff)[_i]), (PG8_LAS unsigned*)(lds + (bufoff) + ldsw + _i * 8192), 16, 0, 0); } while (0)
#define PG8_LDA(dst, b, h) do { _Pragma("unroll") for (int m = 0; m < 4; ++m) _Pragma("unroll") for (int k = 0; k < 2; ++k) dst[m][k] = *(const PG8_LAS bf16x8*)(lds + PG8_SA(b, h) + aoff + m * 2048 + k * 1024); } while (0)
#define PG8_LDB(dst, b, h) do { _Pragma("unroll") for (int n = 0; n < 2; ++n) _Pragma("unroll") for (int k = 0; k < 2; ++k) dst[n][k] = *(const PG8_LAS bf16x8*)(lds + PG8_SB(b, h) + boff + n * 2048 + k * 1024); } while (0)
#define PG8_MMA(ai, bj, At, Bt) do { __builtin_amdgcn_s_setprio(1); _Pragma("unroll") for (int m = 0; m < 4; ++m) _Pragma("unroll") for (int n = 0; n < 2; ++n) _Pragma("unroll") for (int k = 0; k < 2; ++k) \
        acc[ai][bj][m][n] = __builtin_amdgcn_mfma_f32_16x16x32_bf16(Bt[n][k], At[m][k], acc[ai][bj][m][n], 0, 0, 0); __builtin_amdgcn_s_setprio(0); } while (0)
#define PG8_WAIT_V(n) asm volatile("s_waitcnt vmcnt(" #n ")" ::: "memory")
#define PG8_WAIT_L(n) asm volatile("s_waitcnt lgkmcnt(" #n ")" ::: "memory")
#define PG8_BAR __builtin_amdgcn_s_barrier()
#define PG8_SCHED __builtin_amdgcn_sched_barrier(0)
    Unit cur, nxt; int ui = 0;
    if (!S.next(0, cur)) return;
    f32x4 acc[2][2][4][2];
#pragma unroll
    for (int a = 0; a < 2; ++a)
#pragma unroll
        for (int b = 0; b < 2; ++b)
#pragma unroll
            for (int m = 0; m < 4; ++m)
#pragma unroll
                for (int n = 0; n < 2; ++n) acc[a][b][m][n] = (f32x4){0.f, 0.f, 0.f, 0.f};
    bf16x8 At[4][2], B0[2][2], B1[2][2];
    const char* cA = (const char*)g.A + (size_t)cur.pm * tstep; const char* cB = (const char*)g.Bt + (size_t)cur.pn * tstep;
    S.a_ready(cur);
    if constexpr (SP2) {
        PG8_STAGE(PG8_SB(0, 0), cB, voffB); PG8_STAGE(PG8_SB(0, 1), cB + hstep, voffB); PG8_STAGE(PG8_SA(0, 0), cA, voffA); PG8_STAGE(PG8_SA(0, 1), cA + hstep, voffA);
        if (wr == 1) PG8_BAR;
        PG8_WAIT_V(2); PG8_BAR;
        PG8_STAGE(PG8_SB(1, 0), cB + kstep, voffB); PG8_STAGE(PG8_SA(1, 0), cA + kstep, voffA); PG8_STAGE(PG8_SB(1, 1), cB + hstep + kstep, voffB);
        PG8_WAIT_V(6); PG8_BAR;
    } else {
        PG8_STAGE(PG8_SB(0, 0), cB, voffB); PG8_STAGE(PG8_SA(0, 0), cA, voffA); PG8_STAGE(PG8_SB(0, 1), cB + hstep, voffB); PG8_STAGE(PG8_SA(0, 1), cA + hstep, voffA);
        if (wr == 1) PG8_BAR;
        PG8_WAIT_V(4); PG8_BAR;
        PG8_STAGE(PG8_SB(1, 0), cB + kstep, voffB); PG8_STAGE(PG8_SA(1, 0), cA + kstep, voffA); PG8_STAGE(PG8_SB(1, 1), cB + hstep + kstep, voffB);
        PG8_WAIT_V(6); PG8_BAR;
    }
    for (;;) {
        const bool has_next = S.next(ui + 1, nxt);
        const char* nA = has_next ? (const char*)g.A + (size_t)nxt.pm * tstep : cA; const char* nB = has_next ? (const char*)g.Bt + (size_t)nxt.pn * tstep : cB;
        for (int t = 0; t < nt; t += 2) {
            const bool last = (t == nt - 2);
            const char* a1 = cA + (size_t)(t + 1) * kstep;
            const char* a2 = last ? nA : cA + (size_t)(t + 2) * kstep; const char* b2 = last ? nB : cB + (size_t)(t + 2) * kstep;
            const char* a3 = a2 + kstep; const char* b3 = b2 + kstep;
            if (last && has_next) S.a_ready(nxt);
            if constexpr (SP2) {
            PG8_LDB(B0, 0, 0); PG8_LDB(B1, 0, 1); PG8_SCHED; PG8_LDA(At, 0, 0); PG8_STAGE(PG8_SA(1, 1), a1 + hstep, voffA);
            PG8_WAIT_V(8); PG8_WAIT_L(0); PG8_BAR; PG8_MMA(0, 0, At, B0); PG8_MMA(0, 1, At, B1); PG8_BAR; PG8_SCHED;
            PG8_LDA(At, 0, 1); PG8_STAGE(PG8_SB(0, 0), b2, voffB); PG8_STAGE(PG8_SB(0, 1), b2 + hstep, voffB); PG8_STAGE(PG8_SA(0, 0), a2, voffA);
            PG8_WAIT_V(8); PG8_WAIT_L(0); PG8_BAR; PG8_MMA(1, 0, At, B0); PG8_MMA(1, 1, At, B1); PG8_BAR; PG8_SCHED;
            PG8_LDB(B0, 1, 0); PG8_LDB(B1, 1, 1); PG8_SCHED; PG8_LDA(At, 1, 0); PG8_STAGE(PG8_SA(0, 1), a2 + hstep, voffA);
            PG8_WAIT_V(8); PG8_WAIT_L(0); PG8_BAR; PG8_MMA(0, 0, At, B0); PG8_MMA(0, 1, At, B1); PG8_BAR; PG8_SCHED;
            PG8_LDA(At, 1, 1); PG8_STAGE(PG8_SB(1, 0), b3, voffB); PG8_STAGE(PG8_SB(1, 1), b3 + hstep, voffB); PG8_STAGE(PG8_SA(1, 0), a3, voffA);
            PG8_WAIT_V(8); PG8_WAIT_L(0); PG8_BAR; PG8_MMA(1, 0, At, B0); PG8_MMA(1, 1, At, B1); PG8_BAR; PG8_SCHED;
            } else {
            PG8_LDB(B0, 0, 0); PG8_SCHED; PG8_LDA(At, 0, 0); PG8_STAGE(PG8_SA(1, 1), a1 + hstep, voffA);
            PG8_WAIT_L(8); PG8_BAR; PG8_WAIT_L(0); PG8_MMA(0, 0, At, B0); PG8_BAR; PG8_SCHED;
            PG8_LDB(B1, 0, 1); PG8_STAGE(PG8_SB(0, 0), b2, voffB);
            PG8_BAR; PG8_WAIT_L(0); PG8_MMA(0, 1, At, B1); PG8_BAR;
            PG8_LDA(At, 0, 1); PG8_STAGE(PG8_SA(0, 0), a2, voffA);
            PG8_BAR; PG8_WAIT_L(0); PG8_MMA(1, 0, At, B0); PG8_BAR; PG8_SCHED;
            PG8_STAGE(PG8_SB(0, 1), b2 + hstep, voffB);
            PG8_WAIT_V(6); PG8_BAR; PG8_MMA(1, 1, At, B1); PG8_BAR;
            PG8_LDB(B0, 1, 0); PG8_SCHED; PG8_LDA(At, 1, 0); PG8_STAGE(PG8_SA(0, 1), a2 + hstep, voffA);
            PG8_WAIT_L(8); PG8_BAR; PG8_WAIT_L(0); PG8_MMA(0, 0, At, B0); PG8_BAR; PG8_SCHED;
            PG8_LDB(B1, 1, 1); PG8_STAGE(PG8_SB(1, 0), b3, voffB);
            PG8_BAR; PG8_WAIT_L(0); PG8_MMA(0, 1, At, B1); PG8_BAR;
            PG8_LDA(At, 1, 1); PG8_STAGE(PG8_SA(1, 0), a3, voffA);
            PG8_BAR; PG8_WAIT_L(0); PG8_MMA(1, 0, At, B0); PG8_BAR; PG8_SCHED;
            PG8_STAGE(PG8_SB(1, 1), b3 + hstep, voffB);
            PG8_WAIT_V(6); PG8_BAR; PG8_MMA(1, 1, At, B1); PG8_BAR;
            }
        }
        if constexpr (ALIGN_EPI) { if (wr == 0) PG8_BAR; }
        if constexpr (!Epi::AFTER_DRAIN) { E(acc, cur, wr, wc, fr, fq); S.done(cur); }
        if (!has_next) break;
#pragma unroll
        for (int a = 0; a < 2; ++a)
#pragma unroll
            for (int b = 0; b < 2; ++b)
#pragma unroll
                for (int m = 0; m < 4; ++m)
#pragma unroll
                    for (int n = 0; n < 2; ++n) acc[a][b][m][n] = (f32x4){0.f, 0.f, 0.f, 0.f};
        cur = nxt; cA = nA; cB = nB; ++ui;
        if constexpr (ALIGN_EPI) { if (wr == 1) PG8_BAR; }
    }
    PG8_WAIT_V(0);
    if constexpr (!ALIGN_EPI) { if (wr == 0) PG8_BAR; }
    PG8_BAR;
    if constexpr (Epi::AFTER_DRAIN) { E.fused(acc, cur, wr, wc, fr, fq, lds, wid, lane); S.done(cur); }
#undef PG8_SA
#undef PG8_SB
#undef PG8_STAGE
#undef PG8_LDA
#undef PG8_LDB
#undef PG8_MMA
#undef PG8_WAIT_V
#undef PG8_WAIT_L
#undef PG8_BAR
#undef PG8_SCHED
}
}
#include <hip/hip_bf16.h>
#include <cmath>
namespace attn_body {
using bf16=__hip_bfloat16;
using bf16x8=__attribute__((ext_vector_type(8)))short;
using s16x4=__attribute__((ext_vector_type(4)))short;
using f32x16=__attribute__((ext_vector_type(16)))float;
using u32x4=__attribute__((ext_vector_type(4)))unsigned;
using f32x4v=__attribute__((ext_vector_type(4)))float;
constexpr int BATCH=8,NHEAD=8,SEQ=4096,D=64,DM=NHEAD*D,OPITCH=1024;
constexpr int NW=8,QBLK=32,QB=QBLK*NW,KVBLK=64,NQB=SEQ/QB;
constexpr int ATTN_PITCH=DM, ATTN_UNIT_ROWS=QB;
__device__ __forceinline__ int crow(int r,int hi){return (r&3)+8*(r>>2)+4*hi;}
#define SBAR() __builtin_amdgcn_sched_barrier(0)
__device__ __forceinline__ void cmask(f32x16&p0,f32x16&p1,int jb,int qrel,int hi){
  const float NEG=-INFINITY; int kb=64*jb+4*hi;
  #pragma unroll
  for(int r=0;r<16;++r){int kv=kb+(r&3)+8*(r>>2); if(kv>qrel)p0[r]=NEG; if(kv+32>qrel)p1[r]=NEG;}
}

constexpr int NSLOT=3, SLOTB=8192;
constexpr int LDS_K=0, LDS_V=NSLOT*SLOTB, LDS_WS=2*NSLOT*SLOTB, LDS_OST=LDS_WS+NW*64*4, LDS_BYTES=LDS_OST+NW*4096, LDS_BIAS=LDS_BYTES, LDS_TOTAL=LDS_BIAS+SEQ*4;
constexpr float C2=0.125f*1.4426950408889634f;
__device__ __forceinline__ void glds16(const void*sbase,unsigned voff,unsigned lds_dst){unsigned keep;
  asm volatile("s_mov_b32 %0, m0\n\ts_mov_b32 m0, %3\n\ts_nop 0\n\tglobal_load_lds_dwordx4 %1, %2\n\ts_mov_b32 m0, %0":"=&s"(keep):"v"(voff),"s"(sbase),"s"(lds_dst):"memory");}
__device__ __forceinline__ float max3f(float a,float b,float c){float r;asm("v_max3_f32 %0, %1, %2, %3":"=v"(r):"v"(a),"v"(b),"v"(c));return r;}
__device__ __forceinline__ float max2f(float a,float b){float r;asm("v_max_f32_e32 %0, %1, %2":"=v"(r):"v"(a),"v"(b));return r;}
__device__ __forceinline__ float fadd_s(float a,float b){float r;asm("v_add_f32_e32 %0, %1, %2":"=v"(r):"v"(a),"v"(b));return r;}
__device__ __forceinline__ float fsub_s(float a,float b){float r;asm("v_sub_f32_e32 %0, %1, %2":"=v"(r):"v"(a),"v"(b));return r;}
typedef float f32x2_t __attribute__((ext_vector_type(2))); typedef __bf16 bf16x2_t __attribute__((ext_vector_type(2)));
__device__ __forceinline__ unsigned cvtpk_s(float lo,float hi){f32x2_t v={lo,hi};bf16x2_t b=__builtin_convertvector(v,bf16x2_t);return __builtin_bit_cast(unsigned,b);}
#define WAIT_BAR(N) asm volatile("s_waitcnt vmcnt(" #N ") lgkmcnt(0)\n\ts_barrier":::"memory")

__device__ __forceinline__ void qkt(f32x16&p0,f32x16&p1,const __attribute__((address_space(3))) char*kb,const bf16x8*qr){
  #pragma unroll
  for(int d0=0;d0<4;++d0){
    const bf16x8 b0=*(const __attribute__((address_space(3))) bf16x8*)(kb+d0*2048);
    const bf16x8 b1=*(const __attribute__((address_space(3))) bf16x8*)(kb+d0*2048+512);
    p0=__builtin_amdgcn_mfma_f32_32x32x16_bf16(b0,qr[d0],p0,0,0,0);p1=__builtin_amdgcn_mfma_f32_32x32x16_bf16(b1,qr[d0],p1,0,0,0);}
}
typedef __attribute__((address_space(3))) const char* lds_cptr;
typedef short v4i16_t __attribute__((ext_vector_type(4)));
__device__ __forceinline__ void kload8(bf16x8*kf,lds_cptr kp){
  kf[0]=*(const __attribute__((address_space(3))) bf16x8*)(kp);      kf[1]=*(const __attribute__((address_space(3))) bf16x8*)(kp+512);
  kf[2]=*(const __attribute__((address_space(3))) bf16x8*)(kp+2048); kf[3]=*(const __attribute__((address_space(3))) bf16x8*)(kp+2560);
  kf[4]=*(const __attribute__((address_space(3))) bf16x8*)(kp+4096); kf[5]=*(const __attribute__((address_space(3))) bf16x8*)(kp+4608);
  kf[6]=*(const __attribute__((address_space(3))) bf16x8*)(kp+6144); kf[7]=*(const __attribute__((address_space(3))) bf16x8*)(kp+6656);
}
__device__ __forceinline__ void kload2(bf16x8*kf,lds_cptr kp,int j){ kf[2*j]=*(const __attribute__((address_space(3))) bf16x8*)(kp+j*2048); kf[2*j+1]=*(const __attribute__((address_space(3))) bf16x8*)(kp+j*2048+512); }
__device__ __forceinline__ s16x4 vtr(lds_cptr p){ return __builtin_bit_cast(s16x4,__builtin_amdgcn_ds_read_tr16_b64_v4i16((__attribute__((address_space(3))) v4i16_t*)p)); }
__device__ __forceinline__ float rowmax(const f32x16&p0,const f32x16&p1){
  float a=max3f(p0[0],p0[1],p1[0]),b=max3f(p0[2],p0[3],p1[1]);a=max3f(a,p1[2],p1[3]);
  #pragma unroll
  for(int r=4;r<16;r+=4){a=max3f(a,p0[r],p0[r+1]);b=max3f(b,p0[r+2],p0[r+3]);a=max3f(a,p1[r],p1[r+1]);b=max3f(b,p1[r+2],p1[r+3]);}
  const float m=max2f(a,b);
  auto rr=__builtin_amdgcn_permlane32_swap(__float_as_uint(m),__float_as_uint(m),false,false);
  return max2f(__uint_as_float(rr[0]),__uint_as_float(rr[1]));
}
__device__ __forceinline__ void pv(f32x16*o,int vb,bf16x8 pa0,bf16x8 pa1,bf16x8 pa2,bf16x8 pa3){
  #pragma unroll
  for(int d0=0;d0<2;++d0){s16x4 lo[4],hi[4];
    #pragma unroll
    for(int ks=0;ks<4;++ks){
      asm volatile("ds_read_b64_tr_b16 %0,%1 offset:%c2":"=&v"(lo[ks]):"v"(vb),"i"(d0*4096+ks*1024):"memory");
      asm volatile("ds_read_b64_tr_b16 %0,%1 offset:%c2":"=&v"(hi[ks]):"v"(vb),"i"(d0*4096+ks*1024+512):"memory");}
    asm volatile("s_waitcnt lgkmcnt(0)":::"memory");SBAR();
    #define PK(k) (bf16x8){lo[k][0],lo[k][1],lo[k][2],lo[k][3],hi[k][0],hi[k][1],hi[k][2],hi[k][3]}
    o[d0]=__builtin_amdgcn_mfma_f32_32x32x16_bf16(pa0,PK(0),o[d0],0,0,0);
    o[d0]=__builtin_amdgcn_mfma_f32_32x32x16_bf16(pa1,PK(1),o[d0],0,0,0);
    o[d0]=__builtin_amdgcn_mfma_f32_32x32x16_bf16(pa2,PK(2),o[d0],0,0,0);
    o[d0]=__builtin_amdgcn_mfma_f32_32x32x16_bf16(pa3,PK(3),o[d0],0,0,0);
    #undef PK
  }
}

#ifndef ATTN_STORE16
#define ATTN_STORE16(p,v) (*(u32x4*)(p)=(v))
#endif
template<bool SKIP> __device__ __forceinline__ void attn_unit(int b,int h,int qb,const bf16*Q,const bf16*__restrict__ K,const bf16*__restrict__ V,bf16*O,const float*__restrict__ CB,float qkb,char*shm){
  const int tid=otid(),lane=tid&63,r32=lane&31,hi=lane>>5; const int wid=__builtin_amdgcn_readfirstlane(tid>>6);
  const long rowbase=(long)b*SEQ; const int q0=qb*QB;
  const float*cb=CB+(long)(b*NHEAD+h)*SEQ;
  int t0=0;
  if(SKIP){ const int NTf=(q0+QB)/KVBLK; const float thr=2.f*qkb+40.f; const float cq0=cb[q0];
    bool pred=false; if(lane<NTf-4){ pred=(cq0-cb[64*lane+63])<-thr; }
    const unsigned long long mk=__ballot(pred); t0=(int)__builtin_ctzll(~mk); t0&=~1; t0=__builtin_amdgcn_readfirstlane(t0); }
  const int kv0=t0*KVBLK;
  const int NT=(q0+QB)/KVBLK-t0;
  { __attribute__((address_space(3))) float*bl=(__attribute__((address_space(3))) float*)((lds_cptr)shm+LDS_BIAS); const float*cbk=cb+kv0; for(int i=tid;i<NT*KVBLK;i+=NW*64) bl[i]=-*(const float*)((const char*)cbk+(unsigned)(i*4)); }
  const float negm0=*(const float*)((const char*)(cb+q0+wid*QBLK)+(unsigned)((lane&31)*4))-qkb;
  const bf16*Qw=Q+(rowbase+q0+wid*QBLK)*DM+h*D;
  const bf16*Kh=K+(rowbase+kv0)*DM+h*D,*Vh=V+(rowbase+kv0)*DM+h*D;
  const unsigned lds0=(unsigned)(uintptr_t)shm;
  const unsigned koff=(unsigned)(lane*DM+wid*8)*2u;
  const unsigned voff=(unsigned)((16*(wid&3)+(lane>>2))*DM+(wid>>2)*32+(lane&3)*8)*2u;
  const unsigned kdst=lds0+LDS_K+wid*1024, vdst=lds0+LDS_V+wid*1024;
  #define DMA_K(t,slot) glds16(Kh+(long)(t)*KVBLK*DM,koff,(unsigned)__builtin_amdgcn_readfirstlane(kdst+(slot)))
  #define DMA_V(t,slot) glds16(Vh+(long)(t)*KVBLK*DM,voff,(unsigned)__builtin_amdgcn_readfirstlane(vdst+(slot)))
  bf16x8 kf[8];
  const lds_cptr shm3=(lds_cptr)shm; __attribute__((address_space(3))) float*const wsf=(__attribute__((address_space(3))) float*)(shm3+LDS_WS)+wid*64;
  const lds_cptr kp0=shm3+LDS_K+hi*1024+r32*16; const lds_cptr vp0=shm3+LDS_V+((lane>>4)&1)*32+(lane&3)*8+(4*hi+((lane&15)>>2))*64;
  DMA_K(0,0);DMA_V(0,0);DMA_K(1,SLOTB);
  bf16x8 qr[4];
  #pragma unroll
  for(int d0=0;d0<4;++d0)qr[d0]=*reinterpret_cast<const bf16x8*>((const char*)Qw+(unsigned)((r32*DM+d0*16+hi*8)*2));
  float l_reg=0.f;f32x16 o[2];o[0]=f32x16{};o[1]=f32x16{};
  const __attribute__((address_space(3))) char* bl3=(const __attribute__((address_space(3))) char*)shm+LDS_BIAS+hi*16;
  #define BINIT_ALL(P0,P1,t) do{ const __attribute__((address_space(3))) f32x4v* bp_=(const __attribute__((address_space(3))) f32x4v*)(bl3+(t)*256); \
    _Pragma("unroll") for(int g_=0;g_<4;++g_){ const f32x4v x0_=bp_[2*g_], x1_=bp_[8+2*g_]; \
      P0[4*g_]=x0_[0]+negm0;P0[4*g_+1]=x0_[1]+negm0;P0[4*g_+2]=x0_[2]+negm0;P0[4*g_+3]=x0_[3]+negm0; \
      P1[4*g_]=x1_[0]+negm0;P1[4*g_+1]=x1_[1]+negm0;P1[4*g_+2]=x1_[2]+negm0;P1[4*g_+3]=x1_[3]+negm0; } }while(0)
  const int qrel=wid*QBLK+r32;
  #define CMASK(P0,P1,t) do{int jb_=(t)-(NT-4); if(jb_>=0)cmask(P0,P1,jb_,qrel,hi);}while(0)
  f32x16 pA0,pA1,pB0,pB1;
  int sl_prev=0,sl_cur=0,sl_next=SLOTB;
  #define ROT() do{sl_prev=sl_cur;sl_cur=sl_next;sl_next=(sl_next==(NSLOT-1)*SLOTB)?0:sl_next+SLOTB;}while(0)
  DMA_K(2,2*SLOTB);
  WAIT_BAR(3);
  BINIT_ALL(pA0,pA1,0); qkt(pA0,pA1,kp0,qr);asm volatile("s_nop 15\n\ts_nop 7":"+v"(pA0),"+v"(pA1));CMASK(pA0,pA1,0);
  _Pragma("unroll") for(int r=0;r<16;++r){pA0[r]=__builtin_amdgcn_exp2f(pA0[r]);pA1[r]=__builtin_amdgcn_exp2f(pA1[r]);}
  BINIT_ALL(pB0,pB1,1);
  WAIT_BAR(0);
  DMA_K(3,0);DMA_V(1,SLOTB);
  ROT();
  kload8(kf,kp0+sl_cur);
  WAIT_BAR(2);
  s16x4 vlo[8],vhi[8]; u32x4 pw0,pw1,pw2,pw3;
  #define PKW(P,B) cvtpk_s(P[B],P[B+1])
  #define PAF(k) __builtin_bit_cast(bf16x8,pw##k)
  #define VFR(i) (bf16x8){vlo[i][0],vlo[i][1],vlo[i][2],vlo[i][3],vhi[i][0],vhi[i][1],vhi[i][2],vhi[i][3]}
  #define PIN(x) asm volatile("":"+v"(x))
  #define MX3(a,b,c) __builtin_fmaxf(__builtin_fmaxf((a),(b)),(c))
  #define GAPA(MF,A0,A1,A2,A3,W0,W1,PW) do{ MF; sacc+=A0; sacc+=A1; sacc+=A2; sacc+=A3; PIN(sacc); W0; W1; PIN(PW); SBAR(); }while(0)
  #define EX(v) __builtin_amdgcn_exp2f(v)
  #define GAPB(MF,X,B,GL_,P,GI,NI) do{ MF; X[B]=EX(X[B]); X[B+1]=EX(X[B+1]); X[B+2]=EX(X[B+2]); X[B+3]=EX(X[B+3]); PIN(X); \
    if(GL_){ const f32x4v nx_=bpn_[NI]; P[4*(GI)]=bq_[0]+negm0; P[4*(GI)+1]=bq_[1]+negm0; P[4*(GI)+2]=bq_[2]+negm0; P[4*(GI)+3]=bq_[3]+negm0; bq_=nx_; PIN(P); } SBAR(); }while(0)
  #define VRD(i) do{ vlo[i]=vtr(vp_+(((i)>>2)*4096+((i)&3)*1024)); vhi[i]=vtr(vp_+(((i)>>2)*4096+((i)&3)*1024+512)); }while(0)
  #define KRD(G,j) do{ if(G){ kload2(kf,kp0+sl_next,j); SBAR(); } }while(0)
  #define STEP(C0,C1,P0,P1,t,GK,GV,GL) do{ SBAR(); \
    const lds_cptr vp_=vp0+sl_prev; \
    VRD(0); SBAR(); float sacc=(P0[0]+P0[1]); \
    GAPA(C0=__builtin_amdgcn_mfma_f32_32x32x16_bf16(kf[0],qr[0],C0,0,0,0), P0[2],P0[3],P0[4],P0[5],     pw0[0]=PKW(P0,0), pw0[1]=PKW(P0,2), pw0); \
    VRD(4); SBAR(); GAPA(C1=__builtin_amdgcn_mfma_f32_32x32x16_bf16(kf[1],qr[0],C1,0,0,0), P0[6],P0[7],P0[8],P0[9],     pw0[2]=PKW(P0,4), pw0[3]=PKW(P0,6), pw0); \
    VRD(1); SBAR(); GAPA(C0=__builtin_amdgcn_mfma_f32_32x32x16_bf16(kf[2],qr[1],C0,0,0,0),   P0[10],P0[11],P0[12],P0[13], pw1[0]=PKW(P0,8), pw1[1]=PKW(P0,10), pw1); \
    VRD(5); SBAR(); GAPA(C1=__builtin_amdgcn_mfma_f32_32x32x16_bf16(kf[3],qr[1],C1,0,0,0),   P0[14],P0[15],P1[0],P1[1],   pw1[2]=PKW(P0,12),pw1[3]=PKW(P0,14), pw1); \
    VRD(2); SBAR(); GAPA(C0=__builtin_amdgcn_mfma_f32_32x32x16_bf16(kf[4],qr[2],C0,0,0,0),   P1[2],P1[3],P1[4],P1[5],     pw2[0]=PKW(P1,0), pw2[1]=PKW(P1,2), pw2); \
    VRD(6); SBAR(); GAPA(C1=__builtin_amdgcn_mfma_f32_32x32x16_bf16(kf[5],qr[2],C1,0,0,0),   P1[6],P1[7],P1[8],P1[9],     pw2[2]=PKW(P1,4), pw2[3]=PKW(P1,6), pw2); \
    VRD(3); SBAR(); GAPA(C0=__builtin_amdgcn_mfma_f32_32x32x16_bf16(kf[6],qr[3],C0,0,0,0),   P1[10],P1[11],P1[12],P1[13], pw3[0]=PKW(P1,8), pw3[1]=PKW(P1,10), pw3); \
    VRD(7); SBAR(); GAPA(C1=__builtin_amdgcn_mfma_f32_32x32x16_bf16(kf[7],qr[3],C1,0,0,0),   P1[14],P1[15],0.f,0.f,       pw3[2]=PKW(P1,12),pw3[3]=PKW(P1,14), pw3); \
    l_reg+=sacc; \
    if(GK){DMA_K((t)+3,sl_cur);} if(GV){DMA_V((t)+1,sl_next);} \
    CMASK(C0,C1,t); \
    const __attribute__((address_space(3))) f32x4v* bpn_=(const __attribute__((address_space(3))) f32x4v*)(bl3+((t)+1)*256); f32x4v bq_=f32x4v{}; if(GL){bq_=bpn_[0];} \
    SBAR(); \
    GAPB(o[0]=__builtin_amdgcn_mfma_f32_32x32x16_bf16(PAF(0),VFR(0),o[0],0,0,0), C0,0,GL,P0,0,8); \
    GAPB(o[1]=__builtin_amdgcn_mfma_f32_32x32x16_bf16(PAF(0),VFR(4),o[1],0,0,0), C0,4,GL,P1,0,2); \
    KRD(GL,0); GAPB(o[0]=__builtin_amdgcn_mfma_f32_32x32x16_bf16(PAF(1),VFR(1),o[0],0,0,0), C0,8,GL,P0,1,10); \
    KRD(GL,1); GAPB(o[1]=__builtin_amdgcn_mfma_f32_32x32x16_bf16(PAF(1),VFR(5),o[1],0,0,0), C0,12,GL,P1,1,4); \
    KRD(GL,2); GAPB(o[0]=__builtin_amdgcn_mfma_f32_32x32x16_bf16(PAF(2),VFR(2),o[0],0,0,0), C1,0,GL,P0,2,12); \
    KRD(GL,3); GAPB(o[1]=__builtin_amdgcn_mfma_f32_32x32x16_bf16(PAF(2),VFR(6),o[1],0,0,0), C1,4,GL,P1,2,6); \
    GAPB(o[0]=__builtin_amdgcn_mfma_f32_32x32x16_bf16(PAF(3),VFR(3),o[0],0,0,0), C1,8,GL,P0,3,14); \
    GAPB(o[1]=__builtin_amdgcn_mfma_f32_32x32x16_bf16(PAF(3),VFR(7),o[1],0,0,0), C1,12,GL,P1,3,14); \
    }while(0)
  int t=1;
  #undef CMASK
  #define CMASK(P0,P1,t) do{}while(0)
  for(;t+5<NT;t+=2){
    STEP(pB0,pB1,pA0,pA1,t,true,true,true);     WAIT_BAR(2); ROT();
    STEP(pA0,pA1,pB0,pB1,t+1,true,true,true);   WAIT_BAR(2); ROT();
  }
  #undef CMASK
  #define CMASK(P0,P1,t) do{int jb_=(t)-(NT-4); if(jb_>=0)cmask(P0,P1,jb_,qrel,hi);}while(0)
  #define ENDW(tt) do{ if((tt)+3<NT){WAIT_BAR(2);} else if((tt)+2<NT){WAIT_BAR(1);} else {WAIT_BAR(0);} }while(0)
  for(;t+1<NT;t+=2){
    STEP(pB0,pB1,pA0,pA1,t,(t+3<NT),(t+1<NT),(t+1<NT));       ENDW(t);   ROT();
    STEP(pA0,pA1,pB0,pB1,t+1,(t+4<NT),(t+2<NT),(t+2<NT));     ENDW(t+1); ROT();
  }
  STEP(pB0,pB1,pA0,pA1,NT-1,false,false,false);
  { float sacc=pB0[0]+pB0[1]; _Pragma("unroll") for(int r=2;r<16;++r)sacc+=pB0[r]; _Pragma("unroll") for(int r=0;r<16;++r)sacc+=pB1[r]; l_reg+=sacc;
    pw0=(u32x4){PKW(pB0,0),PKW(pB0,2),PKW(pB0,4),PKW(pB0,6)};pw1=(u32x4){PKW(pB0,8),PKW(pB0,10),PKW(pB0,12),PKW(pB0,14)};pw2=(u32x4){PKW(pB1,0),PKW(pB1,2),PKW(pB1,4),PKW(pB1,6)};pw3=(u32x4){PKW(pB1,8),PKW(pB1,10),PKW(pB1,12),PKW(pB1,14)};
    SBAR(); pv(o,(int)(unsigned)(uintptr_t)vp0+sl_cur,PAF(0),PAF(1),PAF(2),PAF(3)); }
  #undef PKW
  #undef PAF
  #undef VFR
  #undef PIN
  #undef MX3
  #undef GAPA
  #undef GAPB
  #undef EX
  #undef VRD
  #undef KRD
  #undef STEP
  #undef ENDW
  {auto rr=__builtin_amdgcn_permlane32_swap(__float_as_uint(l_reg),__float_as_uint(l_reg),false,false);l_reg=__uint_as_float(rr[0])+__uint_as_float(rr[1]);}
  if(hi==0)wsf[32+r32]=l_reg;asm volatile("s_waitcnt lgkmcnt(0)":::"memory");
  float rli[16];
  #pragma unroll
  for(int r=0;r<16;++r)rli[r]=__builtin_amdgcn_rcpf(wsf[32+crow(r,hi)]);
  bf16*Ow=O+(rowbase+q0+wid*QBLK)*OPITCH+h*D;
  { __attribute__((address_space(3))) unsigned short*stg=(__attribute__((address_space(3))) unsigned short*)(shm3+LDS_OST)+wid*2048;
    #pragma unroll
    for(int r=0;r<16;++r){const int orow=crow(r,hi);
      #pragma unroll
      for(int d0=0;d0<2;++d0)stg[orow*64+d0*32+r32]=(unsigned short)(cvtpk_s(o[d0][r]*rli[r],0.f)&0xffffu);}
    asm volatile("s_waitcnt lgkmcnt(0)":::"memory");
    #pragma unroll
    for(int i=0;i<4;++i){const int row=i*8+(lane>>3),ch=lane&7; const u32x4 v=*(const __attribute__((address_space(3))) u32x4*)(stg+row*64+ch*8); ATTN_STORE16((char*)Ow+(unsigned)((row*OPITCH+ch*8)*2),v);} }
  asm volatile("s_waitcnt lgkmcnt(0)\n\ts_barrier":::"memory");
  #undef DMA_K
  #undef DMA_V
  #undef CMASK
  #undef BINIT_ALL
  #undef ROT
}
constexpr int ATTN_LDS_BYTES=LDS_TOTAL;
struct AttnTensors { const bf16* Q; const bf16* K; const bf16* V; bf16* O; const float* CB; float qkb; };
struct AttnUnit { int bh; int qb; };
struct StaticOrder {
  int vcu,G;
  __device__ __forceinline__ explicit StaticOrder(int grid,int block):vcu((grid%8==0)?(block%8)*(grid/8)+block/8:block),G(grid){}
  __device__ __forceinline__ bool next(int i,AttnUnit&u)const{
    if(G==256){ if(i>=4)return false; const int s=vcu&3; u.bh=vcu>>2; u.qb=(i==0)?s:(i==1)?7-s:(i==2)?8+s:15-s; return true; }
    const int id=vcu+i*G; if(id>=BATCH*NHEAD*NQB)return false; u.bh=id/NQB; u.qb=id%NQB; return true; }
};
template<class Sched,bool SKIP> __device__ __forceinline__ void attn_phase(char*lds,const AttnTensors&T,const Sched&S){
  AttnUnit u;
  for(int i=0;S.next(i,u);++i){ attn_unit<SKIP>(u.bh/NHEAD,u.bh%NHEAD,u.qb,T.Q,T.K,T.V,T.O,T.CB,T.qkb,lds); }
}
template<bool SKIP> __device__ __forceinline__ void attn_phase_q(char*lds,const AttnTensors&T,unsigned*queue){
  const int tid=otid();
  __attribute__((address_space(3))) int*slot=(__attribute__((address_space(3))) int*)((lds_cptr)lds+LDS_TOTAL);
  const unsigned xcc=(unsigned)__builtin_amdgcn_s_getreg((3<<11)|20)&7u;
  for(;;){
    if(tid==0){ int got=-1;
      for(unsigned sx=0;sx<8;++sx){ const unsigned x=(xcc+sx)&7u; const unsigned c=__hip_atomic_fetch_add(queue+x*64,1u,__ATOMIC_RELAXED,__HIP_MEMORY_SCOPE_AGENT); if(c<(unsigned)(NHEAD*NQB)){ got=(int)(x*(NHEAD*NQB)+c); break; } }
      *slot=got; }
    asm volatile("s_waitcnt vmcnt(0) lgkmcnt(0)\n\ts_barrier":::"memory");
    const int id=__builtin_amdgcn_readfirstlane(*slot);
    if(id<0)break;
    const int b=id/(NHEAD*NQB), c=id%(NHEAD*NQB), h=c%NHEAD, qb=NQB-1-c/NHEAD;
    attn_unit<SKIP>(b,h,qb,T.Q,T.K,T.V,T.O,T.CB,T.qkb,lds);
  }
}
#undef SBAR
#undef WAIT_BAR
}
#define GAS __attribute__((address_space(1)))
#define LAS __attribute__((address_space(3)))
typedef unsigned short bf16;
typedef unsigned v4u __attribute__((ext_vector_type(4)));
typedef float f32x4 __attribute__((ext_vector_type(4)));
typedef short bf16x8 __attribute__((ext_vector_type(8)));
typedef GAS unsigned gu32;
typedef GAS unsigned long long gu64;
#define RLX_AGENT __ATOMIC_RELAXED, __HIP_MEMORY_SCOPE_AGENT
#define LDS_WAIT() asm volatile("s_waitcnt lgkmcnt(0)" ::: "memory")
#define VM_WAIT() asm volatile("s_waitcnt vmcnt(0)" ::: "memory")
__device__ __forceinline__ unsigned long long rt() { return __builtin_amdgcn_s_memrealtime(); }
__device__ __forceinline__ unsigned f2bf(float f) { unsigned u = __builtin_bit_cast(unsigned, f); return (u + 0x7fffu + ((u >> 16) & 1u)) >> 16; }
__device__ __forceinline__ unsigned pk2(float lo, float hi) { return f2bf(lo) | (f2bf(hi) << 16); }

#define XB_TMO      128
#define XB_XCNT(j)  (256  + 64 * (j))
#define XB_XSUB(j)  (1280 + 64 * (j))
#define XB_XGEN(j)  (2304 + 64 * (j))
#define XB_TOP      3328
#define XB_TOPGEN   3392
#define XCD_BAR_WORDS 3456
#define XB_SPIN_CAP (1u << 18)

__device__ __forceinline__ unsigned xb_ld(unsigned* p)              { return __hip_atomic_load(p, __ATOMIC_RELAXED, __HIP_MEMORY_SCOPE_AGENT); }
__device__ __forceinline__ unsigned xb_add(unsigned* p, unsigned v) { return __hip_atomic_fetch_add(p, v, __ATOMIC_RELAXED, __HIP_MEMORY_SCOPE_AGENT); }
__device__ __forceinline__ unsigned xb_xcc_id() { return (unsigned)__builtin_amdgcn_s_getreg((3 << 11) | 20) & 0xFu; }
#define XB_SPIN(cond, bar) do { unsigned _sp = 0; while (cond) { __builtin_amdgcn_s_sleep(1); \
    if ((++_sp & 255u) == 0u) { if (xb_ld(&(bar)[XB_TMO])) break; if (_sp > XB_SPIN_CAP) { atomicAdd(&(bar)[XB_TMO], 1u); break; } } } } while (0)

struct XcdBarrier {
    unsigned* bar; unsigned x;
    volatile LAS unsigned* st;
};

__device__ __forceinline__ XcdBarrier xcd_barrier_post(unsigned* bar, volatile LAS unsigned* st) {
    XcdBarrier b; b.bar = bar; b.x = xb_xcc_id(); b.st = st;
    if (threadIdx.x == 0) (void)xb_add(&bar[XB_XCNT(b.x)], 1u);
    return b;
}
__device__ __forceinline__ void xcd_barrier_complete(unsigned* bar, unsigned x, unsigned& nloc, unsigned& nx) {
    const unsigned G = gridDim.x * gridDim.y * gridDim.z;
    unsigned sum, cnt, mine, sp = 0u;
    for (;;) {
        sum = 0u; cnt = 0u; mine = 0u;
#pragma unroll
        for (unsigned j = 0; j < 16; ++j) { const unsigned c = xb_ld(&bar[XB_XCNT(j)]); sum += c; cnt += (c > 0u) ? 1u : 0u; mine = (j == x) ? c : mine; }
        if (sum == G) break;
        __builtin_amdgcn_s_sleep(1);
        if ((++sp & 255u) == 0u) { if (xb_ld(&bar[XB_TMO])) break; if (sp > XB_SPIN_CAP) { atomicAdd(&bar[XB_TMO], 1u); break; } }
    }
    nloc = mine > 0u ? mine : 1u; nx = cnt > 0u ? cnt : 1u;
}

__device__ __forceinline__ void xcd_barrier(const XcdBarrier& b) {
    asm volatile("s_waitcnt vmcnt(0)" ::: "memory");
    __syncthreads();
    if (threadIdx.x == 0) {
        unsigned* bar = b.bar;
        __builtin_amdgcn_s_waitcnt(0);
        unsigned nloc = b.st[0], nx = b.st[1];
        if (nloc == 0u) { xcd_barrier_complete(bar, b.x, nloc, nx); b.st[0] = nloc; b.st[1] = nx; }
        const unsigned old = xb_add(&bar[XB_XSUB(b.x)], 1u);
        const unsigned gen = old / nloc;
        if (old + 1u == (gen + 1u) * nloc) {
            __builtin_amdgcn_fence(__ATOMIC_RELEASE, "agent");
            asm volatile("s_waitcnt vmcnt(0)" ::: "memory");
            const unsigned og = xb_add(&bar[XB_TOP], 1u);
            const unsigned tg = og / nx;
            if (og + 1u == (tg + 1u) * nx) xb_add(&bar[XB_TOPGEN], 1u);
            else XB_SPIN(xb_ld(&bar[XB_TOPGEN]) == tg, bar);
            __builtin_amdgcn_fence(__ATOMIC_ACQUIRE, "agent");
            xb_add(&bar[XB_XGEN(b.x)], 1u);
            asm volatile("s_waitcnt vmcnt(0)" ::: "memory");
        } else {
            XB_SPIN(xb_ld(&bar[XB_XGEN(b.x)]) == gen, bar);
            __builtin_amdgcn_fence(__ATOMIC_ACQUIRE, "agent");
            asm volatile("s_waitcnt vmcnt(0)" ::: "memory");
        }
    }
    __syncthreads();
}
struct Args { const float* in[25]; float* out; unsigned char* ws; int ph_lo, ph_hi, use_bar, pad; };
typedef const __attribute__((address_space(4))) Args* KArgs;
#define CAND_LIST CAND(0,0,2,1) CAND(0,1,2,2) CAND(0,2,2,3) CAND(0,3,2,4) CAND(0,4,3,0) CAND(0,5,3,1) CAND(0,6,3,2) CAND(0,7,3,3) CAND(0,8,4,0) CAND(0,9,4,1) CAND(0,10,4,2) CAND(0,11,5,0) CAND(0,12,5,1) CAND(0,13,6,0) CAND(0,14,6,1) CAND(0,15,7,0) CAND(1,0,7,1) CAND(1,1,8,0) CAND(1,2,9,0) CAND(1,3,10,0) CAND(1,4,11,0) CAND(1,5,12,0) CAND(1,6,13,0) CAND(1,7,14,0) CAND(2,0,15,0)
constexpr int NB = 8, SEQ = 4096, DM = 1024, NTOK = NB * SEQ;
constexpr int NH = 8, HD = 64, AW = 512, PWD = 256, SWD = 256, INC = 2056;
constexpr int NEXP = 16384, PQW = 2048;
constexpr float EPSN = 1e-6f, LOG2E = 1.4426950408889634f;
constexpr int NWAVES = 8, NTHR = 512;
constexpr size_t MiB = 1u << 20;
constexpr size_t WS_CTL = 0, CTL_ZERO_BYTES = 1 * MiB;
constexpr size_t WS_WIN = 1 * MiB;
constexpr size_t WS_WOUT = 9 * MiB;
constexpr size_t WS_WQ = 13 * MiB;
constexpr size_t WS_KEYS = 21 * MiB;
constexpr size_t WS_WGLU = 22 * MiB;
constexpr size_t WS_WF = 22 * MiB + 512 * 1024;
constexpr size_t WS_CB = 23 * MiB;
constexpr size_t WS_XLOC = 24 * MiB;
constexpr size_t WS_IDX = 28 * MiB;
constexpr size_t WS_GATE = 44 * MiB;
constexpr size_t WS_Z = 60 * MiB;
constexpr size_t WS_U = 76 * MiB;
constexpr size_t WS_V = 140 * MiB;
constexpr size_t WS_XN8 = 172 * MiB;
constexpr size_t WS_HSC = 22 * MiB + 768 * 1024;
constexpr size_t WS_XN = 204 * MiB;
constexpr size_t WS_P = 268 * MiB;
constexpr size_t WS_MG = 396 * MiB;
constexpr size_t WS_END = 460 * MiB;
constexpr int CW_BAR = 4096, CW_AQ = 20480;
constexpr float U8_SCALE = 768.f, V8_SCALE = 32.f, ACT_SCALE = 64.f;
constexpr int RING_BYTES = 131072, LDSCTL_OFF = RING_BYTES, MISC_OFF = LDSCTL_OFF + 320, LDS_BYTES = 147456;
static_assert(attn_body::ATTN_LDS_BYTES + 16 <= RING_BYTES, "attention scratch fits the ring");

typedef _Float16 h16x2 __attribute__((ext_vector_type(2)));
typedef float f32x16 __attribute__((ext_vector_type(16)));
typedef unsigned u32x2 __attribute__((ext_vector_type(2)));

__device__ __forceinline__ float bf2f(unsigned short b) { return __uint_as_float((unsigned)b << 16); }
__device__ __forceinline__ float bflo(unsigned w) { return __uint_as_float(w << 16); }
__device__ __forceinline__ float bfhi(unsigned w) { return __uint_as_float(w & 0xffff0000u); }
__device__ __forceinline__ h16x2 as_h2(unsigned w) { return __builtin_bit_cast(h16x2, w); }
template <bool HI> __device__ __forceinline__ h16x2 cvt8h(int w) { return __builtin_bit_cast(h16x2, __builtin_amdgcn_cvt_scalef32_pk_f16_fp8(w, 1.0f, HI)); }
__device__ __forceinline__ float gelu_tanh(float x) { const float u = 1.5957691216057308f * (x + 0.044715f * x * x * x); return x / (1.f + __expf(-u)); }
__device__ __forceinline__ float wave_sum(float v) {
#pragma unroll
    for (int o = 1; o < 64; o <<= 1) v += __shfl_xor(v, o);
    return v;
}
__device__ __forceinline__ float wave_max(float v) {
#pragma unroll
    for (int o = 1; o < 64; o <<= 1) v = fmaxf(v, __shfl_xor(v, o));
    return v;
}
template <int N, int S0> __device__ __forceinline__ float bfly_reduce(float (&v)[N], int lane) {
    int s = S0;
#pragma unroll
    for (int cnt = N; cnt > 1; cnt >>= 1) {
        const bool up = (lane & s) != 0;
#pragma unroll
        for (int i = 0; i < cnt / 2; ++i) { const float a = v[i], b = v[i + cnt / 2]; const float send = up ? a : b, keep = up ? b : a; v[i] = keep + __shfl_xor(send, s); }
        s >>= 1;
    }
    float r = v[0];
    for (; s >= 1; s >>= 1) r += __shfl_xor(r, s);
    return r;
}

__device__ __forceinline__ void tr_item(const float* W, int ldw, int srccol, bf16* WT, int K, int dstrow, int k0, LAS float* scr, int lane) {
#pragma unroll 8
    for (int i = 0; i < 32; ++i) { const int kk = 2 * i + (lane >> 5); scr[kk * 33 + (lane & 31)] = W[(size_t)(k0 + kk) * ldw + srccol + (lane & 31)]; }
    LDS_WAIT(); asm volatile("" ::: "memory");
    const int c = lane & 7;
#pragma unroll
    for (int j = 0; j < 4; ++j) { const int n = (lane >> 3) + 8 * j; const LAS float* s = scr + (8 * c) * 33 + n;
        v4u o; o.x = pk2(s[0 * 33], s[1 * 33]); o.y = pk2(s[2 * 33], s[3 * 33]); o.z = pk2(s[4 * 33], s[5 * 33]); o.w = pk2(s[6 * 33], s[7 * 33]);
        *(GAS v4u*)(WT + (size_t)(dstrow + n) * K + k0 + 8 * c) = o; }
    LDS_WAIT(); asm volatile("" ::: "memory");
}
__device__ __forceinline__ void phase_prep(KArgs a, LAS unsigned char* lds, int G, int vcu, int tid, int lane, int wave) {
    unsigned char* ws = a->ws;
    LAS float* scr = (LAS float*)(lds + wave * 16384);
    const int gw = vcu * NWAVES + wave, NGW = G * NWAVES;
    constexpr int I_IN = 2048, I_OUT = 1024, I_WQ = 2048, I_GLU = 64;
    for (int it = gw; it < I_IN + I_OUT + I_WQ + I_GLU; it += NGW) {
        int r = it;
        if (r < I_IN) { const int l = r >> 10, q = r & 1023, kb = q >> 6, nb = q & 63, n0 = nb * 32;
            tr_item(a->in[2] + (size_t)l * DM * INC, INC, n0 + (n0 >= 1536 ? 8 : 0), (bf16*)(ws + WS_WIN) + (size_t)l * 2048 * 1024, 1024, n0, kb * 64, scr, lane); continue; }
        r -= I_IN;
        if (r < I_OUT) { const int l = r >> 9, q = r & 511, kb = q >> 5, nb = q & 31;
            tr_item(a->in[19] + (size_t)l * DM * DM, DM, nb * 32, (bf16*)(ws + WS_WOUT) + (size_t)l * 1024 * 1024, 1024, nb * 32, kb * 64, scr, lane); continue; }
        r -= I_OUT;
        if (r < I_WQ) { const int l = r >> 10, q = r & 1023, kb = q >> 6, nb = q & 63;
            tr_item(a->in[21] + (size_t)l * DM * PQW, PQW, nb * 32, (bf16*)(ws + WS_WQ) + (size_t)l * 2048 * 1024, 1024, nb * 32, kb * 64, scr, lane); continue; }
        r -= I_WQ;
        { const int l = r >> 5, q = r & 31, kb = q >> 3, nb = q & 7;
            tr_item(a->in[16] + (size_t)l * 256 * 256, 256, nb * 32, (bf16*)(ws + WS_WGLU) + (size_t)l * 256 * 256, 256, nb * 32, kb * 64, scr, lane); }
    }
    const size_t gt = (size_t)vcu * NTHR + tid, NGT = (size_t)G * NTHR;
    for (size_t i = gt; i < 2 * 8 * 1024; i += NGT) { const int l = (int)(i >> 13), h = (int)(i >> 10) & 7, k = (int)i & 1023;
        ((float*)(ws + WS_WF))[i] = a->in[2][((size_t)l * DM + k) * INC + 1536 + h]; }
    { const float* src = a->in[22]; bf16* dst = (bf16*)(ws + WS_KEYS);
      for (size_t i = gt; i < (size_t)2 * 8 * 2 * 128 * 128 / 8; i += NGT) { const f32x4 x0 = *(const f32x4*)(src + i * 8), x1 = *(const f32x4*)(src + i * 8 + 4);
          v4u o; o.x = pk2(x0[0], x0[1]); o.y = pk2(x0[2], x0[3]); o.z = pk2(x1[0], x1[1]); o.w = pk2(x1[2], x1[3]); *(v4u*)(dst + i * 8) = o; } }
    { const float* src = a->in[23]; unsigned char* dst = ws + WS_U;
#pragma unroll 1
      for (size_t i = gt; i < (size_t)2 * NEXP * DM / 16; i += NGT) { v4u o;
#pragma unroll
          for (int q = 0; q < 4; ++q) { const f32x4 x = *(const f32x4*)(src + i * 16 + 4 * q) * U8_SCALE;
              const int q0 = (int)__builtin_rintf(fminf(fmaxf(x[0], -127.f), 127.f)), q1 = (int)__builtin_rintf(fminf(fmaxf(x[1], -127.f), 127.f)), q2 = (int)__builtin_rintf(fminf(fmaxf(x[2], -127.f), 127.f)), q3 = (int)__builtin_rintf(fminf(fmaxf(x[3], -127.f), 127.f));
              o[q] = (unsigned)((q0 & 255) | ((q1 & 255) << 8) | ((q2 & 255) << 16) | (q3 << 24)); }
          const size_t r = i >> 6; const unsigned cg = (unsigned)(i & 63), l = (unsigned)(r / NEXP), rl = (unsigned)(r % NEXP);
          *(v4u*)(dst + (size_t)l * NEXP * DM + (size_t)(cg >> 3) * NEXP * 128 + (size_t)rl * 128 + (cg & 7u) * 16u) = o; } }
    { const float* src = a->in[24]; unsigned char* dst = ws + WS_V;
#pragma unroll 1
      for (size_t i = gt; i < (size_t)2 * NEXP * DM / 16; i += NGT) { v4u o;
#pragma unroll
          for (int q = 0; q < 4; ++q) { f32x4 x = *(const f32x4*)(src + i * 16 + 4 * q) * V8_SCALE;
              x[0] = fminf(fmaxf(x[0], -448.f), 448.f); x[1] = fminf(fmaxf(x[1], -448.f), 448.f); x[2] = fminf(fmaxf(x[2], -448.f), 448.f); x[3] = fminf(fmaxf(x[3], -448.f), 448.f);
              int w = 0; w = __builtin_amdgcn_cvt_pk_fp8_f32(x[0], x[1], w, false); w = __builtin_amdgcn_cvt_pk_fp8_f32(x[2], x[3], w, true); o[q] = (unsigned)w; }
          const size_t r = i >> 6; const unsigned cg = (unsigned)(i & 63), l = (unsigned)(r / NEXP), rl = (unsigned)(r % NEXP);
          *(v4u*)(dst + (size_t)l * NEXP * DM + (size_t)(cg >> 3) * NEXP * 128 + (size_t)rl * 128 + (cg & 7u) * 16u) = o; } }
}

template <bool FLOGIT> __device__ __forceinline__ void phase_rownorm(const float* x, const float* g, bf16* XN, const float* WF, const float* fbias, float* CB, int G, int vcu, int lane, int wave, unsigned char* XN8 = nullptr, float* HSC = nullptr) {
    const int gw = vcu * NWAVES + wave, NGW = G * NWAVES;
    f32x4 gv[4];
#pragma unroll
    for (int j = 0; j < 4; ++j) gv[j] = *(const f32x4*)(g + 4 * lane + 256 * j);
    f32x4 vn[2][4];
#define RN_LOAD(rg_) do { _Pragma("unroll") for (int r = 0; r < 2; ++r) { const float* xr = x + (size_t)((rg_) * 2 + r) * DM + 4 * lane; _Pragma("unroll") for (int j = 0; j < 4; ++j) vn[r][j] = *(const f32x4*)(xr + 256 * j); } } while (0)
    if (gw < NTOK / 2) RN_LOAD(gw);
    for (int rg = gw; rg < NTOK / 2; rg += NGW) {
        f32x4 v[2][4];
#pragma unroll
        for (int r = 0; r < 2; ++r)
#pragma unroll
            for (int j = 0; j < 4; ++j) v[r][j] = vn[r][j];
        if (rg + NGW < NTOK / 2) RN_LOAD(rg + NGW);
#pragma unroll
        for (int r = 0; r < 2; ++r) { float s = 0.f;
#pragma unroll
            for (int j = 0; j < 4; ++j) s += (v[r][j][0] * v[r][j][0] + v[r][j][1] * v[r][j][1]) + (v[r][j][2] * v[r][j][2] + v[r][j][3] * v[r][j][3]);
            const float rstd = 1.0f / sqrtf(wave_sum(s) * (1.f / DM) + EPSN);
            bf16* orow = XN + (size_t)(rg * 2 + r) * DM + 4 * lane;
#pragma unroll
            for (int j = 0; j < 4; ++j) { v[r][j] = v[r][j] * rstd * gv[j]; u32x2 w; w.x = pk2(v[r][j][0], v[r][j][1]); w.y = pk2(v[r][j][2], v[r][j][3]); *(u32x2*)(orow + 256 * j) = w; }
            if (!FLOGIT && XN8) { float mx = 0.f;
#pragma unroll
                for (int j = 0; j < 4; ++j) mx = fmaxf(fmaxf(mx, fmaxf(fabsf(v[r][j][0]), fabsf(v[r][j][1]))), fmaxf(fabsf(v[r][j][2]), fabsf(v[r][j][3])));
                mx = fmaxf(wave_max(mx), 1e-20f); const float qs = 127.f / mx;
#pragma unroll
                for (int j = 0; j < 4; ++j) { const int q0 = (int)__builtin_rintf(v[r][j][0] * qs), q1 = (int)__builtin_rintf(v[r][j][1] * qs), q2 = (int)__builtin_rintf(v[r][j][2] * qs), q3 = (int)__builtin_rintf(v[r][j][3] * qs);
                    *(unsigned*)(XN8 + (size_t)(rg * 2 + r) * DM + 4 * lane + 256 * j) = (unsigned)((q0 & 255) | ((q1 & 255) << 8) | ((q2 & 255) << 16) | (q3 << 24)); }
                if (lane == 0) HSC[rg * 2 + r] = mx * (1.f / 127.f); } }
        if (FLOGIT) {
            float acc[16];
#pragma unroll
            for (int i = 0; i < 16; ++i) acc[i] = 0.f;
#pragma unroll
            for (int h = 0; h < 8; ++h)
#pragma unroll
                for (int j = 0; j < 4; ++j) { const f32x4 w = *(const f32x4*)(WF + h * 1024 + 4 * lane + 256 * j);
#pragma unroll
                    for (int r = 0; r < 2; ++r) acc[r * 8 + h] += (v[r][j][0] * w[0] + v[r][j][1] * w[1]) + (v[r][j][2] * w[2] + v[r][j][3] * w[3]); }
            const float tot = bfly_reduce<16, 32>(acc, lane);
            if ((lane & 3) == 0) { const int id = (lane >> 2) & 15, r = id >> 3, h = id & 7; const int row = rg * 2 + r, b = row / SEQ, s = row % SEQ;
                const float z = tot + fbias[h];
                const float ls = fminf(z, 0.f) - __logf(1.f + __expf(-fabsf(z)));
                CB[((size_t)(b * NH + h)) * SEQ + s] = ls * LOG2E; }
        }
    }
}

__device__ __forceinline__ void phase_headnorm(bf16* Q, bf16* K, const float* qg, const float* kg, float* CB, int G, int vcu, int lane, int wave) {
    const int gw = vcu * NWAVES + wave, NGW = G * NWAVES;
    for (int sq = gw; sq < NB * NH; sq += NGW) {
        float* c = CB + (size_t)sq * SEQ; float carry = 0.f;
        for (int it = 0; it < SEQ / 64; ++it) { float v = c[it * 64 + lane];
#pragma unroll
            for (int o = 1; o < 64; o <<= 1) { const float t = __shfl_up(v, o); if (lane >= o) v += t; }
            v += carry; c[it * 64 + lane] = v; carry = __shfl(v, 63); }
    }
    float gq[8], gk[8];
#pragma unroll
    for (int j = 0; j < 8; ++j) { gq[j] = qg[8 * (lane & 7) + j] * (0.125f * LOG2E); gk[j] = kg[8 * (lane & 7) + j]; }
    for (int row0 = gw * 4; row0 < NTOK; row0 += NGW * 4) {
      v4u wl[4][2];
#pragma unroll
      for (int rr = 0; rr < 4; ++rr) { wl[rr][0] = *(const v4u*)(Q + (size_t)(row0 + rr) * AW + 8 * lane); wl[rr][1] = *(const v4u*)(K + (size_t)(row0 + rr) * AW + 8 * lane); }
#pragma unroll
      for (int rr = 0; rr < 4; ++rr) { const int row = row0 + rr;
#pragma unroll
        for (int which = 0; which < 2; ++which) {
            bf16* p = (which ? K : Q) + (size_t)row * AW + 8 * lane;
            const v4u w = wl[rr][which]; float f[8] = {bflo(w.x), bfhi(w.x), bflo(w.y), bfhi(w.y), bflo(w.z), bfhi(w.z), bflo(w.w), bfhi(w.w)};
            float s = 0.f;
#pragma unroll
            for (int j = 0; j < 8; ++j) s += f[j] * f[j];
            s += __shfl_xor(s, 1); s += __shfl_xor(s, 2); s += __shfl_xor(s, 4);
            const float rstd = 1.0f / sqrtf(s * (1.f / 64.f) + EPSN);
#pragma unroll
            for (int j = 0; j < 8; ++j) f[j] = f[j] * rstd * (which ? gk[j] : gq[j]);
            v4u o; o.x = pk2(f[0], f[1]); o.y = pk2(f[2], f[3]); o.z = pk2(f[4], f[5]); o.w = pk2(f[6], f[7]); *(v4u*)p = o;
        }
      }
    }
}

__device__ __forceinline__ void phase_pool(const bf16* PS, const float* pw, const float* pscale, const float* ong, bf16* MG, LAS unsigned char* lds, int G, int bx, int tid, int lane, int wave) {
    LAS float* ut = (LAS float*)lds;
    LAS float* pl = (LAS float*)(lds + 47 * 256 * 4);
    const int ch = tid & 255, half = tid >> 8, g = ch >> 6, w = 2 << g;
    float wcol[64];
#pragma unroll
    for (int c = 0; c < 64; ++c) wcol[c] = pw[(g * 64 + c) * 64 + (ch & 63)];
    const float psc = pscale[ch];
    const f32x4 gn = *(const f32x4*)(ong + 512 + 4 * lane);
    v4u wq[3];
#define POOL_LOAD(tile_) do { const int tok0_ = (tile_) * 32, s0_ = tok0_ % SEQ; _Pragma("unroll") for (int q = 0; q < 3; ++q) { const int idx = tid + q * NTHR, rr = idx >> 5, cq = idx & 31, r = rr - 15; \
        wq[q] = (v4u){0u, 0u, 0u, 0u}; if (idx < 47 * 32 && s0_ + r >= 0) wq[q] = *(const v4u*)(PS + (size_t)(tok0_ + r) * 512 + cq * 8); } } while (0)
    if (bx < NTOK / 32) POOL_LOAD(bx);
    for (int tile = bx; tile < NTOK / 32; tile += G) {
        const int tok0 = tile * 32, s0 = tok0 % SEQ;
#pragma unroll
        for (int q = 0; q < 3; ++q) { const int idx = tid + q * NTHR, rr = idx >> 5, cq = idx & 31; const v4u wv = wq[q];
            if (idx < 47 * 32) { LAS float* d = ut + rr * 256 + cq * 8;
                *(LAS f32x4*)d = (f32x4){bflo(wv.x), bfhi(wv.x), bflo(wv.y), bfhi(wv.y)}; *(LAS f32x4*)(d + 4) = (f32x4){bflo(wv.z), bfhi(wv.z), bflo(wv.w), bfhi(wv.w)}; } }
        if (tile + G < NTOK / 32) POOL_LOAD(tile + G);
        __syncthreads();
        { float s = 0.f; const int rr0 = half * 16 + 15;
            for (int j = 1; j < w; ++j) s += ut[(rr0 - j) * 256 + ch];
#pragma unroll 4
            for (int tt = 0; tt < 16; ++tt) { const int ti = half * 16 + tt, rr = ti + 15, pos = s0 + ti; const float cur = ut[rr * 256 + ch];
                s += cur; const int cnt = (pos + 1 < w) ? pos + 1 : w;
                pl[ti * 256 + ch] = s / (float)cnt - cur; s -= ut[(rr - w + 1) * 256 + ch]; } }
        __syncthreads();
#pragma unroll 1
        for (int tt = 0; tt < 16; ++tt) { const int ti = half * 16 + tt; const LAS f32x4* pr = (const LAS f32x4*)(pl + ti * 256 + g * 64);
            float acc = 0.f;
#pragma unroll
            for (int c4 = 0; c4 < 16; ++c4) { const f32x4 v = pr[c4]; acc += (v[0] * wcol[4 * c4] + v[1] * wcol[4 * c4 + 1]) + (v[2] * wcol[4 * c4 + 2] + v[3] * wcol[4 * c4 + 3]); }
            ut[ti * 256 + ch] = acc * psc; }
        __syncthreads();
#pragma unroll
        for (int q = 0; q < 4; ++q) { const int ti = wave * 4 + q; const f32x4 v = *(const LAS f32x4*)(ut + ti * 256 + 4 * lane);
            const float ss = wave_sum((v[0] * v[0] + v[1] * v[1]) + (v[2] * v[2] + v[3] * v[3]));
            const float rstd = 1.0f / sqrtf(ss * (1.f / 256.f) + EPSN);
            u32x2 o; o.x = pk2(v[0] * rstd * gn[0], v[1] * rstd * gn[1]); o.y = pk2(v[2] * rstd * gn[2], v[3] * rstd * gn[3]);
            *(u32x2*)(MG + (size_t)(tok0 + ti) * DM + 512 + 4 * lane) = o; }
        __syncthreads();
    }
}

template <bool PASS2> __device__ __forceinline__ void phase_s5(KArgs a, int l, const bf16* PS, float* XLOC, bf16* Z, LAS unsigned char* lds, int G, int bx, int lane, int wave) {
    LAS float* Xs = (LAS float*)(lds + wave * (16 * 130 * 4));
    const int p = lane, kq = lane >> 4, ln = lane & 15;
    for (int task = bx; task < NB * 16 * 8; task += G) {
        const int b = task >> 7, g = (task >> 3) & 15, c = (task & 7) * 8 + wave;
        const size_t tok_c = (size_t)b * SEQ + c * 64;
        const float a_re = a->in[8][(l * 16 + g) * 64 + p], a_im = a->in[9][(l * 16 + g) * 64 + p], ldt = a->in[10][l * 16 + g];
        u32x2 uraw[4];
#pragma unroll
        for (int sub = 0; sub < 4; ++sub) uraw[sub] = *(const u32x2*)(PS + (tok_c + sub * 16 + ln) * 512 + 256 + g * 16 + 4 * kq);
        float braw[4][4], biaw[4][4];
#pragma unroll
        for (int q = 0; q < 4; ++q)
#pragma unroll
            for (int ks = 0; ks < 4; ++ks) { const size_t bi = ((size_t)((l * 16 + g) * 64 + 16 * q + ln)) * 16 + 4 * kq + ks; braw[q][ks] = a->in[11][bi]; biaw[q][ks] = a->in[12][bi]; }
        float cfrag[32]; float dsk = 0.f; unsigned short usk[16];
        if (PASS2) {
#pragma unroll
            for (int ks = 0; ks < 32; ++ks) { const int k = 4 * ks + kq, pp = k & 63; const size_t ci = ((size_t)((l * 16 + g) * 16 + ln)) * 64 + pp;
                cfrag[ks] = (ks < 16) ? a->in[13][ci] : -a->in[14][ci]; }
            dsk = a->in[15][l * 256 + g * 16 + ln];
#pragma unroll
            for (int i = 0; i < 16; ++i) usk[i] = PS[(tok_c + (i >> 2) * 16 + 4 * kq + (i & 3)) * 512 + 256 + g * 16 + ln];
        }
        const float dt = expf(ldt);
        float abr, abi, fr, fi;
        { const float xx = a_re * dt, yy = a_im * dt; const float ex = expf(xx); float sn, cs; sincosf(yy, &sn, &cs);
          abr = ex * cs; abi = ex * sn;
          const float sh = sinf(0.5f * yy); const float er = expm1f(xx) * cs - 2.f * sh * sh, ei = abi;
          const float den = a_re * a_re + a_im * a_im; fr = (er * a_re + ei * a_im) / den; fi = (ei * a_re - er * a_im) / den; }
        float bfrag[8][4];
#pragma unroll
        for (int q = 0; q < 4; ++q) { const float frq = __shfl(fr, 16 * q + ln), fiq = __shfl(fi, 16 * q + ln);
#pragma unroll
            for (int ks = 0; ks < 4; ++ks) { bfrag[q][ks] = frq * braw[q][ks] - fiq * biaw[q][ks]; bfrag[4 + q][ks] = frq * biaw[q][ks] + fiq * braw[q][ks]; } }
        float xr = 0.f, xi = 0.f;
        if (PASS2) {
            float pr = abr, pi = abi;
#pragma unroll
            for (int q = 0; q < 6; ++q) { const float nr = pr * pr - pi * pi, ni = 2.f * pr * pi; pr = nr; pi = ni; }
            const float* xl = XLOC + ((size_t)(b * 16 + g) * 64) * 128 + p;
            int j = 0;
#pragma unroll 1
            for (; j + 16 <= c; j += 16) { float lr[16], li[16];
#pragma unroll
                for (int q = 0; q < 16; ++q) { lr[q] = xl[(size_t)(j + q) * 128]; li[q] = xl[(size_t)(j + q) * 128 + 64]; }
#pragma unroll
                for (int q = 0; q < 16; ++q) { const float nr = pr * xr - pi * xi + lr[q], ni = pr * xi + pi * xr + li[q]; xr = nr; xi = ni; } }
            { float lr[16], li[16];
#pragma unroll
                for (int q = 0; q < 16; ++q) { const int jj = (j + q < c) ? j + q : 0; lr[q] = xl[(size_t)jj * 128]; li[q] = xl[(size_t)jj * 128 + 64]; }
#pragma unroll
                for (int q = 0; q < 16; ++q) if (j + q < c) { const float nr = pr * xr - pi * xi + lr[q], ni = pr * xi + pi * xr + li[q]; xr = nr; xi = ni; } }
        }
#pragma unroll
        for (int sub = 0; sub < 4; ++sub) {
            const size_t tokb = tok_c + sub * 16;
            const float ua[4] = {bflo(uraw[sub].x), bfhi(uraw[sub].x), bflo(uraw[sub].y), bfhi(uraw[sub].y)};
#pragma unroll
            for (int nb = 0; nb < 8; ++nb) { f32x4 acc = {0.f, 0.f, 0.f, 0.f};
#pragma unroll
                for (int ks = 0; ks < 4; ++ks) acc = __builtin_amdgcn_mfma_f32_16x16x4f32(ua[ks], bfrag[nb][ks], acc, 0, 0, 0);
#pragma unroll
                for (int r = 0; r < 4; ++r) Xs[(4 * kq + r) * 130 + 16 * nb + ln] = acc[r]; }
            float bur[16], bui[16];
#pragma unroll
            for (int i = 0; i < 16; ++i) { bur[i] = Xs[i * 130 + p]; bui[i] = Xs[i * 130 + 64 + p]; }
#pragma unroll
            for (int i = 0; i < 16; ++i) { const float nr = abr * xr - abi * xi + bur[i], ni = abr * xi + abi * xr + bui[i]; xr = nr; xi = ni;
                if (PASS2) { Xs[i * 130 + p] = xr; Xs[i * 130 + 64 + p] = xi; } }
            if (PASS2) {
                f32x4 y0 = {0.f, 0.f, 0.f, 0.f}, y1 = {0.f, 0.f, 0.f, 0.f};
#pragma unroll
                for (int ks = 0; ks < 32; ks += 2) { y0 = __builtin_amdgcn_mfma_f32_16x16x4f32(Xs[ln * 130 + 4 * ks + kq], cfrag[ks], y0, 0, 0, 0);
                    y1 = __builtin_amdgcn_mfma_f32_16x16x4f32(Xs[ln * 130 + 4 * (ks + 1) + kq], cfrag[ks + 1], y1, 0, 0, 0); }
#pragma unroll
                for (int r = 0; r < 4; ++r) { const size_t tk = tokb + 4 * kq + r; const float uv = bf2f(usk[sub * 4 + r]);
                    const float y = y0[r] + y1[r] + dsk * uv; Z[tk * 256 + g * 16 + ln] = (bf16)f2bf(gelu_tanh(y)); }
            }
        }
        if (!PASS2) { float* xl = XLOC + ((size_t)((b * 16 + g) * 64 + c)) * 128 + p; xl[0] = xr; xl[64] = xi; }
    }
}

__device__ __forceinline__ void phase_glu(const bf16* Z, const bf16* WG, const float* gb, const float* ong, bf16* MG, LAS unsigned char* lds, int G, int bx, int vcu, int tid, int lane, int wave) {
    LAS unsigned char* zt = lds;
    LAS float* ssq = (LAS float*)(lds + 64 * 528);
    LAS float* rs = ssq + 64 * 8;
    const int n = 32 * wave + (lane & 31), hs = lane >> 5;
    const float bn = gb[n], gnn = ong[768 + n];
    for (int tile = bx; tile < NTOK / 64; tile += G) {
        const size_t tok0 = (size_t)tile * 64;
        for (int idx = tid; idx < 64 * 32; idx += NTHR) { const int r = idx >> 5, cq = idx & 31; *(LAS v4u*)(zt + r * 528 + cq * 16) = *(const v4u*)(Z + (tok0 + r) * 256 + cq * 8); }
        __syncthreads();
        f32x16 acc[2]; acc[0] = f32x16{}; acc[1] = f32x16{};
#pragma unroll
        for (int ks = 0; ks < 16; ++ks) { const bf16x8 bw = *(const bf16x8*)(WG + (size_t)n * 256 + ks * 16 + 8 * hs);
#pragma unroll
            for (int mb = 0; mb < 2; ++mb) { const bf16x8 az = *(const LAS bf16x8*)(zt + (mb * 32 + (lane & 31)) * 528 + (ks * 16 + 8 * hs) * 2);
                acc[mb] = __builtin_amdgcn_mfma_f32_32x32x16_bf16(az, bw, acc[mb], 0, 0, 0); } }
        float val[32], sq[32];
#pragma unroll
        for (int mb = 0; mb < 2; ++mb)
#pragma unroll
            for (int r = 0; r < 16; ++r) { const int m = mb * 32 + (r & 3) + 8 * (r >> 2) + 4 * hs; const float z = bf2f(*(const LAS unsigned short*)(zt + m * 528 + n * 2));
                const float v = z / (1.f + __expf(-(acc[mb][r] + bn))); val[mb * 16 + r] = v; sq[mb * 16 + r] = v * v; }
        const float tot = bfly_reduce<32, 16>(sq, lane);
        { const int id = lane & 31, mb = id >> 4, r = id & 15, m = mb * 32 + (r & 3) + 8 * (r >> 2) + 4 * hs; ssq[m * 8 + wave] = tot; }
        __syncthreads();
        if (tid < 64) { float s = 0.f;
#pragma unroll
            for (int w8 = 0; w8 < 8; ++w8) s += ssq[tid * 8 + w8];
            rs[tid] = 1.0f / sqrtf(s * (1.f / 256.f) + EPSN); }
        __syncthreads();
#pragma unroll
        for (int mb = 0; mb < 2; ++mb)
#pragma unroll
            for (int r = 0; r < 16; ++r) { const int m = mb * 32 + (r & 3) + 8 * (r >> 2) + 4 * hs;
                MG[(tok0 + m) * DM + 768 + n] = (bf16)f2bf(val[mb * 16 + r] * rs[m] * gnn); }
        __syncthreads();
    }
    const int gw = vcu * NWAVES + wave, NGW = G * NWAVES;
    float g8[8];
#pragma unroll
    for (int j = 0; j < 8; ++j) g8[j] = ong[8 * lane + j];
    for (int row = gw; row < NTOK; row += NGW) {
        bf16* pp = MG + (size_t)row * DM + 8 * lane;
        const v4u w = *(const v4u*)pp; float f[8] = {bflo(w.x), bfhi(w.x), bflo(w.y), bfhi(w.y), bflo(w.z), bfhi(w.z), bflo(w.w), bfhi(w.w)};
        float s = 0.f;
#pragma unroll
        for (int j = 0; j < 8; ++j) s += f[j] * f[j];
        const float rstd = 1.0f / sqrtf(wave_sum(s) * (1.f / 512.f) + EPSN);
        v4u o; o.x = pk2(f[0] * rstd * g8[0], f[1] * rstd * g8[1]); o.y = pk2(f[2] * rstd * g8[2], f[3] * rstd * g8[3]);
        o.z = pk2(f[4] * rstd * g8[4], f[5] * rstd * g8[5]); o.w = pk2(f[6] * rstd * g8[6], f[7] * rstd * g8[7]); *(v4u*)pp = o;
    }
}

__device__ __forceinline__ void ins16(float (&top)[16], float x) {
#pragma unroll
    for (int i = 15; i >= 1; --i) top[i] = __builtin_amdgcn_fmed3f(top[i - 1], top[i], x);
    top[0] = fmaxf(top[0], x);
}
__device__ __forceinline__ float opq(float x) { asm("" : "+v"(x)); return x; }
__device__ __forceinline__ float tagf(float s, unsigned id, unsigned mask) { return __uint_as_float((__float_as_uint(s) & ~mask) | id); }
__device__ __forceinline__ void phase_select(const bf16* PQ, const bf16* KEYS, int* IDX, float* GATE, LAS unsigned char* lds, int G, int vcu, int tid, int lane, int wave) {
    constexpr int KROW = 272, KEYB = 2 * 128 * KROW;
    LAS unsigned* ids = (LAS unsigned*)(lds + KEYB + wave * 4096);
    const int tl = lane & 31, hs = lane >> 5;
    const float NEG = -__builtin_inff();
    const int nslot = (G >= 8) ? G / 8 : 1;
    for (int h = vcu % 8; h < 8; h += (G >= 8 ? 8 : G)) {
        __syncthreads();
        for (int idx = tid; idx < 2 * 128 * 16; idx += NTHR) { const int row = idx >> 4, cq = idx & 15;
            *(LAS v4u*)(lds + row * KROW + cq * 16) = *(const v4u*)((const char*)(KEYS + (size_t)h * 256 * 128) + (unsigned)(row * 256 + cq * 16)); }
        __syncthreads();
        const int slot = (G >= 8) ? vcu / 8 : 0;
        bf16x8 bq[2][8];
        int tb = slot * 8 + wave;
        if (tb < NTOK / 32) {
#pragma unroll
            for (int ks = 0; ks < 8; ++ks) bq[0][ks] = *(const bf16x8*)(PQ + ((size_t)tb * 32 + tl) * PQW + h * 256 + 8 * hs + ks * 16);
        }
#pragma unroll 1
        for (; tb < NTOK / 32; tb += 8 * nslot) {
            const size_t tok = (size_t)tb * 32 + tl;
            float t1[16], t2[16];
#pragma unroll
            for (int half = 0; half < 2; ++half) {
                { const int ntb = (half == 0) ? tb : tb + 8 * nslot; const int ntbc = (ntb < NTOK / 32) ? ntb : tb;
                  const bf16* qn = PQ + ((size_t)ntbc * 32 + tl) * PQW + h * 256 + (half == 0 ? 128 : 0) + 8 * hs;
#pragma unroll
                  for (int ks = 0; ks < 8; ++ks) bq[half ^ 1][ks] = *(const bf16x8*)(qn + ks * 16); }
                f32x16 acc[4]; acc[0] = f32x16{}; acc[1] = f32x16{}; acc[2] = f32x16{}; acc[3] = f32x16{};
                const LAS unsigned char* kp = lds + (half * 128 + tl) * KROW + 16 * hs;
#pragma unroll
                for (int ks = 0; ks < 8; ++ks)
#pragma unroll
                    for (int kb = 0; kb < 4; ++kb) { const bf16x8 ak = *(const LAS bf16x8*)(kp + kb * 32 * KROW + ks * 32); acc[kb] = __builtin_amdgcn_mfma_f32_32x32x16_bf16(ak, bq[half][ks], acc[kb], 0, 0, 0); }
                float top[16];
#pragma unroll
                for (int i = 0; i < 16; ++i) top[i] = NEG;
#pragma unroll
                for (int kb = 0; kb < 4; ++kb)
#pragma unroll
                    for (int r = 0; r < 16; ++r) ins16(top, tagf(acc[kb][r], (unsigned)(32 * kb + (r & 3) + 8 * (r >> 2) + 4 * hs), 127u));
                float oth[16];
#pragma unroll
                for (int i = 0; i < 16; ++i) oth[i] = __shfl_xor(top[i], 32);
#pragma unroll
                for (int i = 0; i < 16; ++i) ins16(top, oth[i]);
#pragma unroll
                for (int i = 0; i < 16; ++i) { if (half == 0) t1[i] = top[i]; else t2[i] = top[i]; }
            }
#pragma unroll
            for (int i = 0; i < 16; ++i) ids[(tl * 2 + hs) * 16 + i] = __float_as_uint(hs ? opq(t2[i]) : opq(t1[i])) & 127u;
            float best[16];
#pragma unroll
            for (int i = 0; i < 16; ++i) best[i] = NEG;
#define CAND(a0, b0, a1, b1) { const float s0_ = opq(t1[a0] + t2[b0]), s1_ = opq(t1[a1] + t2[b1]); ins16(best, hs ? tagf(s1_, (unsigned)((a1) * 16 + (b1)), 255u) : tagf(s0_, (unsigned)((a0) * 16 + (b0)), 255u)); }
            CAND_LIST
#undef CAND
            { float oth[16];
#pragma unroll
              for (int i = 0; i < 16; ++i) oth[i] = __shfl_xor(best[i], 32);
#pragma unroll
              for (int i = 0; i < 16; ++i) ins16(best, oth[i]); }
            float e[16], den = 0.f;
#pragma unroll
            for (int i = 0; i < 16; ++i) { e[i] = __expf(best[i] - best[0]); den += e[i]; }
            const float rden = 1.f / den;
            int ex[8]; float gt[8];
#pragma unroll
            for (int j = 0; j < 8; ++j) { const float bj = hs ? opq(best[8 + j]) : opq(best[j]); const unsigned id = __float_as_uint(bj) & 255u;
                const unsigned i1 = ids[(tl * 2 + 0) * 16 + (id >> 4)], i2 = ids[(tl * 2 + 1) * 16 + (id & 15u)];
                ex[j] = (int)(i1 * 128u + i2); gt[j] = (hs ? opq(e[8 + j]) : opq(e[j])) * rden; }
            int* ip = IDX + tok * 128 + h * 16 + hs * 8; float* gp = GATE + tok * 128 + h * 16 + hs * 8;
            *(v4u*)ip = (v4u){(unsigned)ex[0], (unsigned)ex[1], (unsigned)ex[2], (unsigned)ex[3]}; *(v4u*)(ip + 4) = (v4u){(unsigned)ex[4], (unsigned)ex[5], (unsigned)ex[6], (unsigned)ex[7]};
            *(f32x4*)gp = (f32x4){gt[0], gt[1], gt[2], gt[3]}; *(f32x4*)(gp + 4) = (f32x4){gt[4], gt[5], gt[6], gt[7]};
        }
    }
}

constexpr int GCH = 32;
constexpr int CW_Q = 8192;
template <int CTRL> __device__ __forceinline__ float dpp_mov(float v) { return __builtin_bit_cast(float, __builtin_amdgcn_update_dpp(0, __builtin_bit_cast(int, v), CTRL, 0xF, 0xF, true)); }
__device__ __forceinline__ float sum8(float s) {
    s += dpp_mov<0xB1>(s); s += dpp_mov<0x4E>(s); s += dpp_mov<0x141>(s); return s;
}
__device__ __forceinline__ void phase_gather_u(const unsigned char* XN8, const int* IDX, const unsigned char* U, float* PART, unsigned* queue, int lane, unsigned imask = 0xffffffffu) {
    const unsigned xcc = xb_xcc_id() & 7u; const int g = lane >> 3, j = lane & 7;
#pragma unroll 1
    for (unsigned sx = 0; sx < 8; ++sx) { const unsigned x = (xcc + sx) & 7u; unsigned* q = queue + x * 64;
        const unsigned char* Ux = U + (size_t)x * NEXP * 128; const unsigned jo = (unsigned)j * 16u, lane4 = (unsigned)lane * 4u; const unsigned char* Hx = XN8 + x * 128 + j * 16; const int* Ig = IDX + 16 * g;
#pragma unroll 1
        for (;;) {
            unsigned c = 0; if (lane == 0) c = __hip_atomic_fetch_add(q, 1u, __ATOMIC_RELAXED, __HIP_MEMORY_SCOPE_AGENT);
            c = (unsigned)__builtin_amdgcn_readfirstlane((int)c); if (c >= (unsigned)(NTOK / GCH)) break;
            const size_t tb = (size_t)c * GCH;
            v4u ix[2][4], hw[2], rw[16];
#define G1_IDX(ib, tok_) do { _Pragma("unroll") for (int q4 = 0; q4 < 4; ++q4) ix[ib][q4] = *(const v4u*)(Ig + (tok_) * 128 + 4 * q4) & imask; } while (0)
#define G1_AUX(ab, tok_) do { hw[ab] = *(const v4u*)(Hx + (tok_) * DM); } while (0)
#define G1_TOKEN(p, tt_) do { G1_AUX((p) ^ 1, tb + (((tt_) + 1 < GCH) ? (tt_) + 1 : (tt_))); \
            const v4u hq_ = hw[p]; int r0 = 0, r1 = 0; \
            _Pragma("unroll") for (int i = 0; i < 16; ++i) { const v4u rv_ = rw[i]; \
                rw[i] = *(const v4u*)(Ux + (ix[(p) ^ 1][i >> 2][i & 3] * 128u + jo)); \
                int s = __builtin_amdgcn_sdot4((int)hq_[0], (int)rv_[0], 0, false); s = __builtin_amdgcn_sdot4((int)hq_[1], (int)rv_[1], s, false); \
                s = __builtin_amdgcn_sdot4((int)hq_[2], (int)rv_[2], s, false); s = __builtin_amdgcn_sdot4((int)hq_[3], (int)rv_[3], s, false); \
                s += __builtin_amdgcn_update_dpp(0, s, 0xB1, 0xF, 0xF, true); s += __builtin_amdgcn_update_dpp(0, s, 0x4E, 0xF, 0xF, true); s += __builtin_amdgcn_update_dpp(0, s, 0x141, 0xF, 0xF, true); \
                if (i < 8) r0 = ((i & 7) == j) ? s : r0; else r1 = ((i & 7) == j) ? s : r1; } \
            float* pp = PART + ((size_t)x * NTOK + tb + (tt_)) * 128; *(float*)((char*)pp + lane4) = (float)r0; *(float*)((char*)(pp + 64) + lane4) = (float)r1; \
            G1_IDX(p, tb + (((tt_) + 2 < GCH) ? (tt_) + 2 : (tt_))); } while (0)
            G1_IDX(0, tb); G1_IDX(1, tb + 1); G1_AUX(0, tb);
#pragma unroll
            for (int i = 0; i < 16; ++i) rw[i] = *(const v4u*)(Ux + (ix[0][i >> 2][i & 3] * 128u + jo));
#pragma unroll 1
            for (int tt = 0; tt < GCH; tt += 2) { G1_TOKEN(0, tt); G1_TOKEN(1, tt + 1); }
#undef G1_IDX
#undef G1_AUX
#undef G1_TOKEN
        }
    }
}
__device__ __forceinline__ void phase_gather_act(const float* PART, const float* GATE, const float* HSC, float* ACT, int G, int vcu, int tid) {
    const size_t gt = (size_t)vcu * NTHR + tid, NGT = (size_t)G * NTHR;
    for (size_t e4 = gt; e4 < (size_t)NTOK * 32; e4 += NGT) { const size_t tok = e4 >> 5; const int p = (int)(e4 & 31) * 4;
        f32x4 s = *(const f32x4*)(PART + e4 * 4);
#pragma unroll
        for (int x = 1; x < 8; ++x) s += *(const f32x4*)(PART + (size_t)x * NTOK * 128 + e4 * 4);
        const int k = (p < 64) ? 16 * (p >> 3) + (p & 7) : 16 * ((p - 64) >> 3) + 8 + (p & 7);
        const f32x4 gv = *(const f32x4*)(GATE + tok * 128 + k);
        f32x4 o;
        const float ds = HSC[tok] * (1.f / U8_SCALE);
#pragma unroll
        for (int i = 0; i < 4; ++i) { const _Float16 ah = (_Float16)(gv[i] * gelu_tanh(s[i] * ds) * (ACT_SCALE / V8_SCALE)); const h16x2 a2 = {ah, ah}; o[i] = __builtin_bit_cast(float, a2); }
        *(f32x4*)(ACT + e4 * 4) = o; }
}
__device__ __forceinline__ void phase_gather_v(const float* ACT, const int* IDX, const unsigned char* V, float* out, unsigned* queue, int lane) {
    const unsigned xcc = xb_xcc_id() & 7u; const int g = lane >> 3, j = lane & 7;
    typedef float f32x2v __attribute__((ext_vector_type(2)));
#pragma unroll 1
    for (unsigned sx = 0; sx < 8; ++sx) { const unsigned x = (xcc + sx) & 7u; unsigned* q = queue + x * 64;
        const unsigned char* Vx = V + (size_t)x * NEXP * 128; const unsigned jo = (unsigned)j * 16u; const int* Ig = IDX + 16 * g; float* Ob = out + x * 128; const unsigned lo = (unsigned)(16 * j + 2 * g) * 4u;
#pragma unroll 1
        for (;;) {
            unsigned c = 0; if (lane == 0) c = __hip_atomic_fetch_add(q, 1u, __ATOMIC_RELAXED, __HIP_MEMORY_SCOPE_AGENT);
            c = (unsigned)__builtin_amdgcn_readfirstlane((int)c); if (c >= (unsigned)(NTOK / GCH)) break;
            const size_t tb = (size_t)c * GCH;
            v4u ix[2][4], rw[16]; float a0[2], a1[2]; f32x2v ov[2]; const int bsel = (lane & ~7) * 4; const unsigned lane4 = (unsigned)lane * 4u;
#define G3_IDX(ib, tok_) do { _Pragma("unroll") for (int q4 = 0; q4 < 4; ++q4) ix[ib][q4] = *(const v4u*)(Ig + (tok_) * 128 + 4 * q4); } while (0)
#define G3_AUX(ab, tok_) do { a0[ab] = *(const float*)((const char*)(ACT + (tok_) * 128) + lane4); a1[ab] = *(const float*)((const char*)(ACT + (tok_) * 128 + 64) + lane4); { unsigned lo_ = lo; asm volatile("" : "+v"(lo_)); ov[ab] = *(const f32x2v*)((const char*)(Ob + (tok_) * DM) + lo_); } } while (0)
#define G3_TOKEN(p, tt_) do { G3_AUX((p) ^ 1, tb + (((tt_) + 1 < GCH) ? (tt_) + 1 : (tt_))); \
            h16x2 hacc[8]; \
            _Pragma("unroll") for (int i = 0; i < 8; ++i) hacc[i] = (h16x2){(_Float16)0.f, (_Float16)0.f}; \
            _Pragma("unroll") for (int i = 0; i < 16; ++i) { const v4u rv_ = rw[i]; \
                rw[i] = *(const v4u*)(Vx + (ix[(p) ^ 1][i >> 2][i & 3] * 128u + jo)); \
                const float a = __builtin_bit_cast(float, __builtin_amdgcn_ds_bpermute(bsel + 4 * (i & 7), __builtin_bit_cast(int, (i < 8) ? a0[p] : a1[p])));   \
                const h16x2 a2 = __builtin_bit_cast(h16x2, a); \
                _Pragma("unroll") for (int q4 = 0; q4 < 4; ++q4) { const int w = (int)rv_[q4]; \
                    hacc[2 * q4] = __builtin_elementwise_fma(cvt8h<false>(w), a2, hacc[2 * q4]); \
                    hacc[2 * q4 + 1] = __builtin_elementwise_fma(cvt8h<true>(w), a2, hacc[2 * q4 + 1]); } } \
            float acc[16]; \
            _Pragma("unroll") for (int i = 0; i < 8; ++i) { acc[2 * i] = (float)hacc[i].x; acc[2 * i + 1] = (float)hacc[i].y; } \
            int s_ = 32; \
            _Pragma("unroll") for (int cnt = 16; cnt > 2; cnt >>= 1) { const bool up = (lane & s_) != 0; \
                _Pragma("unroll") for (int i = 0; i < cnt / 2; ++i) { const float a = acc[i], b = acc[i + cnt / 2]; const float send = up ? a : b, keep = up ? b : a; acc[i] = keep + __shfl_xor(send, s_); } \
                s_ >>= 1; } \
            f32x2v o = ov[p]; o[0] += acc[0] * (1.f / ACT_SCALE); o[1] += acc[1] * (1.f / ACT_SCALE); \
            { unsigned lo_ = lo; asm volatile("" : "+v"(lo_)); *(f32x2v*)((char*)(Ob + (tb + (tt_)) * DM) + lo_) = o; } \
            G3_IDX(p, tb + (((tt_) + 2 < GCH) ? (tt_) + 2 : (tt_))); } while (0)
            G3_IDX(0, tb); G3_IDX(1, tb + 1); G3_AUX(0, tb);
#pragma unroll
            for (int i = 0; i < 16; ++i) rw[i] = *(const v4u*)(Vx + (ix[0][i >> 2][i & 3] * 128u + jo));
#pragma unroll 1
            for (int tt = 0; tt < GCH; tt += 2) { G3_TOKEN(0, tt); G3_TOKEN(1, tt + 1); }
#undef G3_IDX
#undef G3_AUX
#undef G3_TOKEN
        }
    }
}

__device__ __forceinline__ void phase_gather_naive(const bf16* XN, const int* IDX, const float* GATE, const float* U, const float* V, float* out, int G, int vcu, int lane, int wave) {
    const int gw = vcu * NWAVES + wave, NGW = G * NWAVES;
    for (int tok = gw; tok < NTOK; tok += NGW) {
        float hv[16], acc[16];
#pragma unroll
        for (int j = 0; j < 16; ++j) { hv[j] = bf2f(XN[(size_t)tok * DM + lane + 64 * j]); acc[j] = 0.f; }
        for (int k = 0; k < 128; ++k) { const int e = IDX[(size_t)tok * 128 + k]; const float g = GATE[(size_t)tok * 128 + k];
            float s = 0.f;
#pragma unroll
            for (int j = 0; j < 16; ++j) s += hv[j] * U[(size_t)e * DM + lane + 64 * j];
            s = wave_sum(s); const float a = g * gelu_tanh(s);
#pragma unroll
            for (int j = 0; j < 16; ++j) acc[j] += a * V[(size_t)e * DM + lane + 64 * j]; }
#pragma unroll
        for (int j = 0; j < 16; ++j) out[(size_t)tok * DM + lane + 64 * j] += acc[j];
    }
}
constexpr int PH_PER_LAYER = 15, N_PHASES = 1 + 2 * PH_PER_LAYER;
__device__ __forceinline__ KArgs kargs() { KArgs p = (KArgs)__builtin_amdgcn_kernarg_segment_ptr(); asm volatile("" : "+s"(p)); return p; }
__global__ void __launch_bounds__(NTHR, 2) mega_fwd(Args a_unused) {
    extern __shared__ __attribute__((aligned(16))) unsigned char lds_raw[];
    LAS unsigned char* lds = (LAS unsigned char*)lds_raw;
    volatile LAS unsigned* MISC = (volatile LAS unsigned*)(lds + MISC_OFF);
    const int tid0 = threadIdx.x;
    for (int u = tid0; u < (LDS_BYTES - LDSCTL_OFF) / 4; u += NTHR) ((LAS unsigned*)(lds + LDSCTL_OFF))[u] = 0u;
    __syncthreads();
    { const unsigned hw = (unsigned)__builtin_amdgcn_s_getreg((6 << 11) | 4); if ((tid0 & 63) == 0) *(volatile LAS int*)(lds + OTID_LDS_OFF + 4 * (hw & 63u)) = tid0 >> 6; }
    __syncthreads();
    XcdBarrier bar; { KArgs ka = kargs(); unsigned char* ws0 = ka->ws; bar.bar = (unsigned*)(ws0 + WS_CTL) + CW_BAR; bar.x = 0; bar.st = nullptr;
      if (ka->use_bar) bar = xcd_barrier_post((unsigned*)(ws0 + WS_CTL) + CW_BAR, MISC + 8); }
    const int ph_lo = kargs()->ph_lo, ph_hi = kargs()->ph_hi;
#define TLW const int tid = otid(), lane = tid & 63, wave = __builtin_amdgcn_readfirstlane(tid >> 6); (void)tid; (void)lane; (void)wave;
#pragma unroll 1
    for (int pc = ph_lo; pc < ph_hi + (DUP_PH >= 0 ? 1 : 0); ++pc) {
        const int ph = (DUP_PH >= 0 && pc > DUP_PH) ? pc - 1 : pc;
        unsigned long long tph0_ = 0; if (TIME_PH >= 0 && (pc == TIME_PH || TIME_PH == 99)) tph0_ = __builtin_amdgcn_s_memrealtime();
        KArgs a = kargs(); unsigned char* ws = a->ws;
        int G = gridDim.x, bx = blockIdx.x; asm volatile("" : "+s"(G), "+s"(bx)); const int vcu = (G % 8 == 0) ? (bx % 8) * (G / 8) + bx / 8 : bx;
        bf16* const XN = (bf16*)(ws + WS_XN); bf16* const Pq = (bf16*)(ws + WS_P); bf16* const Pk = Pq + (size_t)NTOK * 512; bf16* const Pv = Pk + (size_t)NTOK * 512; bf16* const Ps = Pv + (size_t)NTOK * 512;
        bf16* const MG = (bf16*)(ws + WS_MG); float* const CB = (float*)(ws + WS_CB); float* const XLOC = (float*)(ws + WS_XLOC); bf16* const Z = (bf16*)(ws + WS_Z);
        int* const IDX = (int*)(ws + WS_IDX); float* const GATE = (float*)(ws + WS_GATE);
        if (ph == 0) { TLW if (PH_MASK & 1u) phase_prep(a, lds, G, vcu, tid, lane, wave); }
        else {
            const int l = (ph - 1) / PH_PER_LAYER, sub = (ph - 1) % PH_PER_LAYER;
            const float* xin = (l == 0) ? a->in[0] : a->out;
            switch (sub) {
            case 0: if (PH_MASK & (1u << 1)) { TLW phase_rownorm<true>(xin, a->in[1] + l * DM, XN, (const float*)(ws + WS_WF) + l * 8 * 1024, a->in[3] + l * 8, CB, G, vcu, lane, wave); } break;
            case 1: if (PH_MASK & (1u << 2)) { pg8::Gemm g{XN, (const bf16*)(ws + WS_WIN) + (size_t)l * 2048 * 1024, NTOK, 2048, 1024}; pg8::StaticOrder S; S.init(NTOK, 2048, G, bx);
                pg8::EpiBf16<0> E{Pq, 512, nullptr, 512, (size_t)NTOK * 512, 1.f};
                pg8::gemm_phase<pg8::EpiBf16<0>, pg8::StaticOrder, true, true>(lds, g, S, E); } break;
            case 2: if (PH_MASK & (1u << 3)) { TLW phase_headnorm(Pq, Pk, a->in[4] + l * 64, a->in[5] + l * 64, CB, G, vcu, lane, wave); } break;
            case 5: if (PH_MASK & (1u << 4)) { TLW { const float gq = wave_max(fabsf(a->in[4][l * 64 + lane])), gk = wave_max(fabsf(a->in[5][l * 64 + lane]));
                const float qkb = 8.f * gq * gk * LOG2E * 1.02f + 0.25f;
                const attn_body::AttnTensors AT{(const attn_body::bf16*)Pq, (const attn_body::bf16*)Pk, (const attn_body::bf16*)Pv, (attn_body::bf16*)MG, CB, qkb};
                attn_body::attn_phase_q<ATT_SKIP>((char*)lds_raw, AT, (unsigned*)(ws + WS_CTL) + CW_AQ + l * 512); } } break;
            case 3: if (PH_MASK & (1u << 5)) { TLW phase_pool(Ps, a->in[6] + (size_t)l * 4 * 64 * 64, a->in[7] + l * 256, a->in[18] + l * DM, MG, lds, G, bx, tid, lane, wave); } break;
            case 4: if (PH_MASK & (1u << 6)) { TLW phase_s5<false>(a, l, Ps, XLOC, Z, lds, G, bx, lane, wave); } break;
            case 6: if (PH_MASK & (1u << 7)) { TLW phase_s5<true>(a, l, Ps, XLOC, Z, lds, G, bx, lane, wave); } break;
            case 7: if (PH_MASK & (1u << 8)) { TLW phase_glu(Z, (const bf16*)(ws + WS_WGLU) + (size_t)l * 256 * 256, a->in[17] + l * 256, a->in[18] + l * DM, MG, lds, G, bx, vcu, tid, lane, wave); } break;
            case 8: if (PH_MASK & (1u << 9)) { pg8::Gemm g{MG, (const bf16*)(ws + WS_WOUT) + (size_t)l * 1024 * 1024, NTOK, 1024, 1024}; pg8::StaticOrder S; S.init(NTOK, 1024, G, bx);
                pg8::EpiResF32 E{xin, a->out, DM};
                pg8::gemm_phase<pg8::EpiResF32, pg8::StaticOrder, true, true>(lds, g, S, E); } break;
            case 9: if (PH_MASK & (1u << 10)) { TLW phase_rownorm<false>(a->out, a->in[20] + l * DM, XN, nullptr, nullptr, nullptr, G, vcu, lane, wave, ws + WS_XN8, (float*)(ws + WS_HSC)); } break;
            case 10: if (PH_MASK & (1u << 11)) { pg8::Gemm g{XN, (const bf16*)(ws + WS_WQ) + (size_t)l * 2048 * 1024, NTOK, 2048, 1024}; pg8::StaticOrder S; S.init(NTOK, 2048, G, bx);
                pg8::EpiBf16<0> E{Pq, PQW, nullptr, 0, 0, 1.f};
                pg8::gemm_phase<pg8::EpiBf16<0>, pg8::StaticOrder, true, true>(lds, g, S, E); } break;
            case 11: if (PH_MASK & (1u << 12)) { TLW phase_select(Pq, (const bf16*)(ws + WS_KEYS) + (size_t)l * 8 * 2 * 128 * 128, IDX, GATE, lds, G, vcu, tid, lane, wave); } break;
            case 12: if (PH_MASK & (1u << 13)) { TLW phase_gather_u(ws + WS_XN8, IDX, (const unsigned char*)(ws + WS_U) + (size_t)l * NEXP * DM, (float*)(ws + WS_P), (unsigned*)(ws + WS_CTL) + CW_Q + (l * 2 + 0) * 512 + ((DUP_PH >= 0 && pc == DUP_PH + 1) ? 4096 : 0), lane, (DUP_PH >= 0 && pc == DUP_PH) ? DIAG_IMASK : 0xffffffffu); } break;
            case 13: if (PH_MASK & (1u << 14)) { TLW phase_gather_act((const float*)(ws + WS_P), GATE, (const float*)(ws + WS_HSC), (float*)(ws + WS_Z), G, vcu, tid); } break;
            default: if (PH_MASK & (1u << 15)) { TLW phase_gather_v((const float*)(ws + WS_Z), IDX, (const unsigned char*)(ws + WS_V) + (size_t)l * NEXP * DM, a->out, (unsigned*)(ws + WS_CTL) + CW_Q + (l * 2 + 1) * 512, lane); } break;
            }
        }
        const int subb_ = (ph >= 1) ? (ph - 1) % PH_PER_LAYER : -1;
        if (pc + 1 < ph_hi + (DUP_PH >= 0 ? 1 : 0) && (MK_ONE_LAUNCH == 0 || (subb_ != 3 && subb_ != 4))) { XcdBarrier b2 = bar; asm volatile("" : "+s"(b2.bar)); xcd_barrier(b2);
            if (TIME_PH >= 0 && (pc == TIME_PH || TIME_PH == 99)) { const unsigned long long t1_ = __builtin_amdgcn_s_memrealtime(), te_ = t1_ + TIME_MUL * (t1_ - tph0_); while (__builtin_amdgcn_s_memrealtime() < te_) __builtin_amdgcn_s_sleep(8); } }
    }
}

extern "C" void kernel_launch(void* const* d_in, const int* in_sizes, int n_in, void* d_out, int out_size, void* d_ws, size_t ws_size, hipStream_t stream) {
    static int grid = 0;
    if (grid == 0) {
        if (n_in != 25 || in_sizes[0] != NTOK * DM || out_size != NTOK * DM || ws_size < WS_END) {
            fprintf(stderr, "kernel_launch: unexpected problem: n_in %d in0 %d out %d ws %zu (need %zu); nothing launched\n", n_in, n_in > 0 ? in_sizes[0] : -1, out_size, ws_size, (size_t)WS_END); grid = -1; return; }
        int dev = 0, cus = 0;
        if (hipGetDevice(&dev) != hipSuccess || hipDeviceGetAttribute(&cus, hipDeviceAttributeMultiprocessorCount, dev) != hipSuccess) { fprintf(stderr, "kernel_launch: device query failed\n"); grid = -1; return; }
        if (hipFuncSetAttribute((const void*)mega_fwd, hipFuncAttributeMaxDynamicSharedMemorySize, LDS_BYTES) != hipSuccess) { fprintf(stderr, "kernel_launch: hipFuncSetAttribute failed\n"); grid = -1; return; }
        (void)hipGetLastError();
        grid = cus;
    }
    if (grid < 0) return;
    (void)hipMemsetAsync((char*)d_ws + WS_CTL, 0, CTL_ZERO_BYTES, stream);
    Args a{};
    for (int i = 0; i < 25; ++i) a.in[i] = (const float*)d_in[i];
    a.out = (float*)d_out; a.ws = (unsigned char*)d_ws;
#if MK_ONE_LAUNCH
    a.ph_lo = 0; a.ph_hi = N_PHASES; a.use_bar = 1;
    hipLaunchKernelGGL(mega_fwd, dim3(grid), dim3(NTHR), LDS_BYTES, stream, a);
#else
    for (int ph = 0; ph < N_PHASES; ++ph) { a.ph_lo = ph; a.ph_hi = ph + 1; a.use_bar = 0;
        hipLaunchKernelGGL(mega_fwd, dim3(grid), dim3(NTHR), LDS_BYTES, stream, a); }
#endif
    const hipError_t le = hipPeekAtLastError();
    if (le != hipSuccess) fprintf(stderr, "kernel_launch: launch failed: %s\n", hipGetErrorName(le));
}
```

```cpp
#include <hip/hip_runtime.h>
#include <hip/hip_bf16.h>
#include <hip/hip_fp16.h>
#include <cstdio>
#include <cstdint>
#include <cmath>
#ifndef MK_ONE_LAUNCH
#define MK_ONE_LAUNCH 1
#endif
#ifndef ATT_SKIP
#define ATT_SKIP true
#endif
#ifndef PH_MASK
#define PH_MASK 0xffffffffu
#endif
#define OTID_LDS_OFF (131072 + 1024)
__device__ __forceinline__ int otid() {
    int z = 0; asm volatile("" : "+v"(z)); const int lane = __builtin_amdgcn_mbcnt_hi(-1, __builtin_amdgcn_mbcnt_lo(-1, z));
    const unsigned hw = (unsigned)__builtin_amdgcn_s_getreg((6 << 11) | 4);
    const int wv = *(const volatile __attribute__((address_space(3))) int*)(OTID_LDS_OFF + 4 * (hw & 63u));
    return (__builtin_amdgcn_readfirstlane(wv) << 6) | lane;
}
#ifndef GATHER_NAIVE
#define GATHER_NAIVE 0
#endif
#ifndef DUP_PH
#define DUP_PH (-1)
#endif
#ifndef TIME_PH
#define TIME_PH (-1)
#define TIME_MUL 3
#endif
#ifndef DIAG_IMASK
#define DIAG_IMASK 0xffu
#endif
#ifndef S5_CPROJ_F32
#define S5_CPROJ_F32 1
#endif
namespace pg8 {
#define PG8_LAS __attribute__((address_space(3)))
typedef unsigned short bf16_t;
typedef short bf16x8 __attribute__((ext_vector_type(8)));
typedef float f32x4 __attribute__((ext_vector_type(4)));
typedef unsigned u32x4 __attribute__((ext_vector_type(4)));
constexpr int BM = 256, BK = 64, HALF = 128, HTB = HALF * BK * 2  , STAGE_BYTES = 8 * HTB, NXCD = 8, WGM = 8;

__host__ __device__ __forceinline__ int lds_byte(int r, int c) { const int st = (r >> 4) * 2 + (c >> 5), rr = r & 15, cc = c & 31, ob = rr * 64 + cc * 2; return st * 1024 + (ob ^ (((ob >> 9) & 1) << 5)); }
__host__ __device__ __forceinline__ void stage_rc(int b, int& R, int& C) { const int st = b / 1024, sb = b % 1024, swz = sb ^ (((sb >> 9) & 1) << 5); R = (st >> 1) * 16 + swz / 64; C = (st & 1) * 32 + (swz % 64) / 2; }
__host__ __device__ __forceinline__ int perm32(int rho) { const int n = rho >> 4, i = rho & 15; return 8 * (i >> 2) + 4 * n + (i & 3); }

struct Unit { int pm, pn; };
struct Gemm { const bf16_t* A; const bf16_t* Bt; int M, N, K; };

struct StaticOrder {
    int nM, nN, nwg, G, c;
    __host__ __device__ void init(int M, int N, int G_, int c_) { nM = M / BM; nN = N / BM; nwg = nM * nN; G = G_; c = c_; }
    __host__ __device__ bool next(int i, Unit& u) const {
        const long L = (long)i * G + c; if (L >= nwg) return false;
        int wgid = (int)L; { const int q = nwg / NXCD, r = nwg % NXCD, xcd = wgid % NXCD, off = wgid / NXCD; wgid = (xcd < r ? xcd * (q + 1) : r * (q + 1) + (xcd - r) * q) + off; }
        const int nig = WGM * nN, gid = wgid / nig, fm = gid * WGM, gsz = (nM - fm) < WGM ? (nM - fm) : WGM;
        u.pm = fm + ((wgid % nig) % gsz); u.pn = (wgid % nig) / gsz; return true;
    }
    __device__ __forceinline__ void a_ready(const Unit&) const {}
    __device__ __forceinline__ void done(const Unit&) const {}
};

__device__ __forceinline__ unsigned cvt_pk_bf16(float lo, float hi) { unsigned r; asm volatile("v_cvt_pk_bf16_f32 %0, %1, %2" : "=v"(r) : "v"(lo), "v"(hi)); return r; }
typedef float f32x2 __attribute__((ext_vector_type(2)));
__device__ __forceinline__ f32x2 gelu_pk(f32x2 v) {
    const f32x2 av = __builtin_elementwise_abs(v), d = av * 0.2316418882f + 1.0f;
    f32x2 t; t.x = __builtin_amdgcn_rcpf(d.x); t.y = __builtin_amdgcn_rcpf(d.y);
    f32x2 q = t * 0.5307027145f + (-0.7265760135f); q = q * t + 0.7107068705f; q = q * t + (-0.142248368f); q = q * t + 0.127414796f; q = q * t;
    const f32x2 s = (v * v) * (-0.72134752044f);
    f32x2 e; e.x = __builtin_amdgcn_exp2f(s.x); e.y = __builtin_amdgcn_exp2f(s.y);
    const f32x2 m = v * (q * e), r = v - m;
    f32x2 o; o.x = v.x < 0.f ? m.x : r.x; o.y = v.y < 0.f ? m.y : r.y; return o;
}

template <int ACT  > struct EpiBf16 {
    static constexpr bool PERM = true, AFTER_DRAIN = false; static_assert(ACT == 0 || ACT == 1, "EpiBf16: ACT is 0 (none) or 1 (gelu_pk)");
    bf16_t* O; int ldc; const float* bias; int split_cols; size_t split_stride; float scale0;
    __device__ __forceinline__ void operator()(const f32x4 (&acc)[2][2][4][2], const Unit& u, int wr, int wc, int fr, int fq) const {
        const int row0 = u.pm * BM + wr * 64 + fr; int colt = u.pn * BM; bf16_t* base = O;
        float sc = 1.f; if (split_cols) { const int t = colt / split_cols; base += (size_t)t * split_stride; colt -= t * split_cols; if (t == 0) sc = scale0; }
        const int col0 = colt + wc * 32 + 8 * fq, bcol0 = u.pn * BM + wc * 32 + 8 * fq;
        f32x4 bv[2][2];
#pragma unroll
        for (int bj = 0; bj < 2; ++bj)
#pragma unroll
            for (int n = 0; n < 2; ++n) bv[bj][n] = bias ? *(const f32x4*)(bias + bcol0 + bj * HALF + 4 * n) : (f32x4){0.f, 0.f, 0.f, 0.f};
#pragma unroll
        for (int ai = 0; ai < 2; ++ai)
#pragma unroll
            for (int m = 0; m < 4; ++m) { bf16_t* rowp = base + (size_t)(row0 + ai * HALF + m * 16) * ldc + col0;
#pragma unroll
                for (int bj = 0; bj < 2; ++bj) { f32x4 v0 = acc[ai][bj][m][0] + bv[bj][0], v1 = acc[ai][bj][m][1] + bv[bj][1];
                    if (ACT == 1) { f32x2 a = gelu_pk((f32x2){v0[0], v0[1]}), b = gelu_pk((f32x2){v0[2], v0[3]}), c = gelu_pk((f32x2){v1[0], v1[1]}), d = gelu_pk((f32x2){v1[2], v1[3]});
                        v0 = (f32x4){a.x, a.y, b.x, b.y}; v1 = (f32x4){c.x, c.y, d.x, d.y}; }
                    v0 = v0 * sc; v1 = v1 * sc; u32x4 w; w.x = cvt_pk_bf16(v0[0], v0[1]); w.y = cvt_pk_bf16(v0[2], v0[3]); w.z = cvt_pk_bf16(v1[0], v1[1]); w.w = cvt_pk_bf16(v1[2], v1[3]);
                    *(u32x4*)(rowp + bj * HALF) = w; } }
    }
};
struct EpiResF32 {
    static constexpr bool PERM = false, AFTER_DRAIN = false;
    const float* base; float* out; int ldc;
    __device__ __forceinline__ void operator()(const f32x4 (&acc)[2][2][4][2], const Unit& u, int wr, int wc, int fr, int fq) const {
        const int col0 = u.pn * BM + wc * 32 + 4 * fq;
#pragma unroll
        for (int ai = 0; ai < 2; ++ai)
#pragma unroll
            for (int m = 0; m < 4; ++m) { const size_t off = (size_t)(u.pm * BM + ai * HALF + wr * 64 + m * 16 + fr) * ldc + col0;
#pragma unroll
                for (int bj = 0; bj < 2; ++bj)
#pragma unroll
                    for (int n = 0; n < 2; ++n) { const f32x4 bs = *(const f32x4*)(base + off + bj * HALF + n * 16); *(f32x4*)(out + off + bj * HALF + n * 16) = bs + acc[ai][bj][m][n]; } }
    }
};

struct EpiQKVN {
    static constexpr bool PERM = true, AFTER_DRAIN = false;
    bf16_t* O; size_t split_stride; const float* qg; const float* kg; PG8_LAS float* ex; float eps, qscale;
    __device__ __forceinline__ void operator()(const f32x4 (&acc)[2][2][4][2], const Unit& u, int wr, int wc, int fr, int fq) const {
        const int t = u.pn >> 1, row0 = u.pm * BM + wr * 64 + fr, col0 = (u.pn & 1) * BM + wc * 32 + 8 * fq; bf16_t* base = O + (size_t)t * split_stride;
        float rs[2][4][2];
        f32x4 g0 = {1.f, 1.f, 1.f, 1.f}, g1 = {1.f, 1.f, 1.f, 1.f};
        if (t < 2) {
            int wid = wr * 4 + wc, fro = fr; asm volatile("" : "+v"(fro), "+s"(wid));
#pragma unroll
            for (int ai = 0; ai < 2; ++ai)
#pragma unroll
                for (int m = 0; m < 4; ++m)
#pragma unroll
                    for (int bj = 0; bj < 2; ++bj) { const f32x4 a0 = acc[ai][bj][m][0], a1 = acc[ai][bj][m][1];
                        float s = (a0[0] * a0[0] + a0[1] * a0[1]) + (a0[2] * a0[2] + a0[3] * a0[3]) + (a1[0] * a1[0] + a1[1] * a1[1]) + (a1[2] * a1[2] + a1[3] * a1[3]);
                        s += __shfl_xor(s, 16); s += __shfl_xor(s, 32);
                        if (fq == 0) ex[(((wid * 2 + ai) * 4 + m) * 2 + bj) * 16 + fro] = s; }
            asm volatile("s_waitcnt lgkmcnt(0)\n\ts_barrier" ::: "memory");
            const float* gp = (t == 0 ? qg : kg) + 32 * (wc & 1) + 8 * fq; const float gs = (t == 0) ? qscale : 1.f;
            g0 = *(const f32x4*)gp * gs; g1 = *(const f32x4*)(gp + 4) * gs;
#pragma unroll
            for (int ai = 0; ai < 2; ++ai)
#pragma unroll
                for (int m = 0; m < 4; ++m)
#pragma unroll
                    for (int bj = 0; bj < 2; ++bj) { const float so = ex[(((wid * 2 + ai) * 4 + m) * 2 + bj) * 16 + fro], sp = ex[((((wid ^ 1) * 2 + ai) * 4 + m) * 2 + bj) * 16 + fro]; rs[ai][m][bj] = 1.0f / sqrtf((so + sp) * (1.f / 64.f) + eps); }
        }
#pragma unroll
        for (int ai = 0; ai < 2; ++ai)
#pragma unroll
            for (int m = 0; m < 4; ++m) { bf16_t* rowp = base + (size_t)(row0 + ai * HALF + m * 16) * 512 + col0;
#pragma unroll
                for (int bj = 0; bj < 2; ++bj) { f32x4 v0 = acc[ai][bj][m][0], v1 = acc[ai][bj][m][1];
                    if (t < 2) { const float r = rs[ai][m][bj]; v0 = v0 * r * g0; v1 = v1 * r * g1; }
                    u32x4 w; w.x = cvt_pk_bf16(v0[0], v0[1]); w.y = cvt_pk_bf16(v0[2], v0[3]); w.z = cvt_pk_bf16(v1[0], v1[1]); w.w = cvt_pk_bf16(v1[2], v1[3]);
                    *(u32x4*)(rowp + bj * HALF) = w; } }
    }
};
template <class Epi, class Sched, bool ALIGN_EPI = false, bool SP2 = false>
__device__ __forceinline__ void gemm_phase(PG8_LAS unsigned char* lds, const Gemm g, const Sched& S, const Epi& E) {
    const int tid = otid(), wid = __builtin_amdgcn_readfirstlane(tid >> 6), lane = tid & 63, wr = wid >> 2, wc = wid & 3, fr = lane & 15, fq = lane >> 4;
    const int K = g.K, nt = K / BK;
    unsigned voffA[2], voffB[2];
#pragma unroll
    for (int i = 0; i < 2; ++i) { int R, C; stage_rc(tid * 16 + i * 8192, R, C); const int Rb = Epi::PERM ? ((R & ~31) + perm32(R & 31)) : R;
        voffA[i] = (unsigned)(R * K + C) * 2u; voffB[i] = (unsigned)(Rb * K + C) * 2u; }
    const size_t kstep = (size_t)(BK * 2);
    const size_t hstep = (size_t)HALF * K * 2;
    const size_t tstep = 2 * hstep;
    const unsigned ldsw = (unsigned)wid * 1024u;
    const int aoff = lds_byte(wr * 64 + fr, fq * 8), boff = lds_byte(wc * 32 + fr, fq * 8);
#define PG8_SA(b, h) (((b) * 2 + (h)) * HTB)
#define PG8_SB(b, h) ((4 + (b) * 2 + (h)) * HTB)
#define PG8_STAGE(bufoff, gbase, voff) do { _Pragma("unroll") for (int _i = 0; _i < 2; ++_i) \
        __builtin_amdgcn_global_load_lds((const unsigned*)((const char*)(gbase) + (voff)[_i]), (PG8_LAS unsigned*)(lds + (bufoff) + ldsw + _i * 8192), 16, 0, 0); } while (0)
#define PG8_LDA(dst, b, h) do { _Pragma("unroll") for (int m = 0; m < 4; ++m) _Pragma("unroll") for (int k = 0; k < 2; ++k) dst[m][k] = *(const PG8_LAS bf16x8*)(lds + PG8_SA(b, h) + aoff + m * 2048 + k * 1024); } while (0)
#define PG8_LDB(dst, b, h) do { _Pragma("unroll") for (int n = 0; n < 2; ++n) _Pragma("unroll") for (int k = 0; k < 2; ++k) dst[n][k] = *(const PG8_LAS bf16x8*)(lds + PG8_SB(b, h) + boff + n * 2048 + k * 1024); } while (0)
#define PG8_MMA(ai, bj, At, Bt) do { __builtin_amdgcn_s_setprio(1); _Pragma("unroll") for (int m = 0; m < 4; ++m) _Pragma("unroll") for (int n = 0; n < 2; ++n) _Pragma("unroll") for (int k = 0; k < 2; ++k) \
        acc[ai][bj][m][n] = __builtin_amdgcn_mfma_f32_16x16x32_bf16(Bt[n][k], At[m][k], acc[ai][bj][m][n], 0, 0, 0); __builtin_amdgcn_s_setprio(0); } while (0)
#define PG8_WAIT_V(n) asm volatile("s_waitcnt vmcnt(" #n ")" ::: "memory")
#define PG8_WAIT_L(n) asm volatile("s_waitcnt lgkmcnt(" #n ")" ::: "memory")
#define PG8_BAR __builtin_amdgcn_s_barrier()
#define PG8_SCHED __builtin_amdgcn_sched_barrier(0)
    Unit cur, nxt; int ui = 0;
    if (!S.next(0, cur)) return;
    f32x4 acc[2][2][4][2];
#pragma unroll
    for (int a = 0; a < 2; ++a)
#pragma unroll
        for (int b = 0; b < 2; ++b)
#pragma unroll
            for (int m = 0; m < 4; ++m)
#pragma unroll
                for (int n = 0; n < 2; ++n) acc[a][b][m][n] = (f32x4){0.f, 0.f, 0.f, 0.f};
    bf16x8 At[4][2], B0[2][2], B1[2][2];
    const char* cA = (const char*)g.A + (size_t)cur.pm * tstep; const char* cB = (const char*)g.Bt + (size_t)cur.pn * tstep;
    S.a_ready(cur);
    if constexpr (SP2) {
        PG8_STAGE(PG8_SB(0, 0), cB, voffB); PG8_STAGE(PG8_SB(0, 1), cB + hstep, voffB); PG8_STAGE(PG8_SA(0, 0), cA, voffA); PG8_STAGE(PG8_SA(0, 1), cA + hstep, voffA);
        if (wr == 1) PG8_BAR;
        PG8_WAIT_V(2); PG8_BAR;
        PG8_STAGE(PG8_SB(1, 0), cB + kstep, voffB); PG8_STAGE(PG8_SA(1, 0), cA + kstep, voffA); PG8_STAGE(PG8_SB(1, 1), cB + hstep + kstep, voffB);
        PG8_WAIT_V(6); PG8_BAR;
    } else {
        PG8_STAGE(PG8_SB(0, 0), cB, voffB); PG8_STAGE(PG8_SA(0, 0), cA, voffA); PG8_STAGE(PG8_SB(0, 1), cB + hstep, voffB); PG8_STAGE(PG8_SA(0, 1), cA + hstep, voffA);
        if (wr == 1) PG8_BAR;
        PG8_WAIT_V(4); PG8_BAR;
        PG8_STAGE(PG8_SB(1, 0), cB + kstep, voffB); PG8_STAGE(PG8_SA(1, 0), cA + kstep, voffA); PG8_STAGE(PG8_SB(1, 1), cB + hstep + kstep, voffB);
        PG8_WAIT_V(6); PG8_BAR;
    }
    for (;;) {
        const bool has_next = S.next(ui + 1, nxt);
        const char* nA = has_next ? (const char*)g.A + (size_t)nxt.pm * tstep : cA; const char* nB = has_next ? (const char*)g.Bt + (size_t)nxt.pn * tstep : cB;
        for (int t = 0; t < nt; t += 2) {
            const bool last = (t == nt - 2);
            const char* a1 = cA + (size_t)(t + 1) * kstep;
            const char* a2 = last ? nA : cA + (size_t)(t + 2) * kstep; const char* b2 = last ? nB : cB + (size_t)(t + 2) * kstep;
            const char* a3 = a2 + kstep; const char* b3 = b2 + kstep;
            if (last && has_next) S.a_ready(nxt);
            if constexpr (SP2) {
            PG8_LDB(B0, 0, 0); PG8_LDB(B1, 0, 1); PG8_SCHED; PG8_LDA(At, 0, 0); PG8_STAGE(PG8_SA(1, 1), a1 + hstep, voffA);
            PG8_WAIT_V(8); PG8_WAIT_L(0); PG8_BAR; PG8_MMA(0, 0, At, B0); PG8_MMA(0, 1, At, B1); PG8_BAR; PG8_SCHED;
            PG8_LDA(At, 0, 1); PG8_STAGE(PG8_SB(0, 0), b2, voffB); PG8_STAGE(PG8_SB(0, 1), b2 + hstep, voffB); PG8_STAGE(PG8_SA(0, 0), a2, voffA);
            PG8_WAIT_V(8); PG8_WAIT_L(0); PG8_BAR; PG8_MMA(1, 0, At, B0); PG8_MMA(1, 1, At, B1); PG8_BAR; PG8_SCHED;
            PG8_LDB(B0, 1, 0); PG8_LDB(B1, 1, 1); PG8_SCHED; PG8_LDA(At, 1, 0); PG8_STAGE(PG8_SA(0, 1), a2 + hstep, voffA);
            PG8_WAIT_V(8); PG8_WAIT_L(0); PG8_BAR; PG8_MMA(0, 0, At, B0); PG8_MMA(0, 1, At, B1); PG8_BAR; PG8_SCHED;
            PG8_LDA(At, 1, 1); PG8_STAGE(PG8_SB(1, 0), b3, voffB); PG8_STAGE(PG8_SB(1, 1), b3 + hstep, voffB); PG8_STAGE(PG8_SA(1, 0), a3, voffA);
            PG8_WAIT_V(8); PG8_WAIT_L(0); PG8_BAR; PG8_MMA(1, 0, At, B0); PG8_MMA(1, 1, At, B1); PG8_BAR; PG8_SCHED;
            } else {
            PG8_LDB(B0, 0, 0); PG8_SCHED; PG8_LDA(At, 0, 0); PG8_STAGE(PG8_SA(1, 1), a1 + hstep, voffA);
            PG8_WAIT_L(8); PG8_BAR; PG8_WAIT_L(0); PG8_MMA(0, 0, At, B0); PG8_BAR; PG8_SCHED;
            PG8_LDB(B1, 0, 1); PG8_STAGE(PG8_SB(0, 0), b2, voffB);
            PG8_BAR; PG8_WAIT_L(0); PG8_MMA(0, 1, At, B1); PG8_BAR;
            PG8_LDA(At, 0, 1); PG8_STAGE(PG8_SA(0, 0), a2, voffA);
            PG8_BAR; PG8_WAIT_L(0); PG8_MMA(1, 0, At, B0); PG8_BAR; PG8_SCHED;
            PG8_STAGE(PG8_SB(0, 1), b2 + hstep, voffB);
            PG8_WAIT_V(6); PG8_BAR; PG8_MMA(1, 1, At, B1); PG8_BAR;
            PG8_LDB(B0, 1, 0); PG8_SCHED; PG8_LDA(At, 1, 0); PG8_STAGE(PG8_SA(0, 1), a2 + hstep, voffA);
            PG8_WAIT_L(8); PG8_BAR; PG8_WAIT_L(0); PG8_MMA(0, 0, At, B0); PG8_BAR; PG8_SCHED;
            PG8_LDB(B1, 1, 1); PG8_STAGE(PG8_SB(1, 0), b3, voffB);
            PG8_BAR; PG8_WAIT_L(0); PG8_MMA(0, 1, At, B1); PG8_BAR;
            PG8_LDA(At, 1, 1); PG8_STAGE(PG8_SA(1, 0), a3, voffA);
            PG8_BAR; PG8_WAIT_L(0); PG8_MMA(1, 0, At, B0); PG8_BAR; PG8_SCHED;
            PG8_STAGE(PG8_SB(1, 1), b3 + hstep, voffB);
            PG8_WAIT_V(6); PG8_BAR; PG8_MMA(1, 1, At, B1); PG8_BAR;
            }
        }
        if constexpr (ALIGN_EPI) { if (wr == 0) PG8_BAR; }
        if constexpr (!Epi::AFTER_DRAIN) { E(acc, cur, wr, wc, fr, fq); S.done(cur); }
        if (!has_next) break;
#pragma unroll
        for (int a = 0; a < 2; ++a)
#pragma unroll
            for (int b = 0; b < 2; ++b)
#pragma unroll
                for (int m = 0; m < 4; ++m)
#pragma unroll
                    for (int n = 0; n < 2; ++n) acc[a][b][m][n] = (f32x4){0.f, 0.f, 0.f, 0.f};
        cur = nxt; cA = nA; cB = nB; ++ui;
        if constexpr (ALIGN_EPI) { if (wr == 1) PG8_BAR; }
    }
    PG8_WAIT_V(0);
    if constexpr (!ALIGN_EPI) { if (wr == 0) PG8_BAR; }
    PG8_BAR;
    if constexpr (Epi::AFTER_DRAIN) { E.fused(acc, cur, wr, wc, fr, fq, lds, wid, lane); S.done(cur); }
#undef PG8_SA
#undef PG8_SB
#undef PG8_STAGE
#undef PG8_LDA
#undef PG8_LDB
#undef PG8_MMA
#undef PG8_WAIT_V
#undef PG8_WAIT_L
#undef PG8_BAR
#undef PG8_SCHED
}
}
#include <hip/hip_bf16.h>
#include <cmath>
namespace attn_body {
using bf16=__hip_bfloat16;
using bf16x8=__attribute__((ext_vector_type(8)))short;
using s16x4=__attribute__((ext_vector_type(4)))short;
using f32x16=__attribute__((ext_vector_type(16)))float;
using u32x4=__attribute__((ext_vector_type(4)))unsigned;
using f32x4v=__attribute__((ext_vector_type(4)))float;
constexpr int BATCH=8,NHEAD=8,SEQ=4096,D=64,DM=NHEAD*D,OPITCH=1024;
constexpr int NW=8,QBLK=32,QB=QBLK*NW,KVBLK=64,NQB=SEQ/QB;
constexpr int ATTN_PITCH=DM, ATTN_UNIT_ROWS=QB;
__device__ __forceinline__ int crow(int r,int hi){return (r&3)+8*(r>>2)+4*hi;}
#define SBAR() __builtin_amdgcn_sched_barrier(0)
__device__ __forceinline__ void cmask(f32x16&p0,f32x16&p1,int jb,int qrel,int hi){
  const float NEG=-INFINITY; int kb=64*jb+4*hi;
  #pragma unroll
  for(int r=0;r<16;++r){int kv=kb+(r&3)+8*(r>>2); if(kv>qrel)p0[r]=NEG; if(kv+32>qrel)p1[r]=NEG;}
}

constexpr int NSLOT=3, SLOTB=8192;
constexpr int LDS_K=0, LDS_V=NSLOT*SLOTB, LDS_WS=2*NSLOT*SLOTB, LDS_OST=LDS_WS+NW*64*4, LDS_BYTES=LDS_OST+NW*4096, LDS_BIAS=LDS_BYTES, LDS_TOTAL=LDS_BIAS+SEQ*4;
constexpr float C2=0.125f*1.4426950408889634f;
__device__ __forceinline__ void glds16(const void*sbase,unsigned voff,unsigned lds_dst){unsigned keep;
  asm volatile("s_mov_b32 %0, m0\n\ts_mov_b32 m0, %3\n\ts_nop 0\n\tglobal_load_lds_dwordx4 %1, %2\n\ts_mov_b32 m0, %0":"=&s"(keep):"v"(voff),"s"(sbase),"s"(lds_dst):"memory");}
__device__ __forceinline__ float max3f(float a,float b,float c){float r;asm("v_max3_f32 %0, %1, %2, %3":"=v"(r):"v"(a),"v"(b),"v"(c));return r;}
__device__ __forceinline__ float max2f(float a,float b){float r;asm("v_max_f32_e32 %0, %1, %2":"=v"(r):"v"(a),"v"(b));return r;}
__device__ __forceinline__ float fadd_s(float a,float b){float r;asm("v_add_f32_e32 %0, %1, %2":"=v"(r):"v"(a),"v"(b));return r;}
__device__ __forceinline__ float fsub_s(float a,float b){float r;asm("v_sub_f32_e32 %0, %1, %2":"=v"(r):"v"(a),"v"(b));return r;}
typedef float f32x2_t __attribute__((ext_vector_type(2))); typedef __bf16 bf16x2_t __attribute__((ext_vector_type(2)));
__device__ __forceinline__ unsigned cvtpk_s(float lo,float hi){f32x2_t v={lo,hi};bf16x2_t b=__builtin_convertvector(v,bf16x2_t);return __builtin_bit_cast(unsigned,b);}
#define WAIT_BAR(N) asm volatile("s_waitcnt vmcnt(" #N ") lgkmcnt(0)\n\ts_barrier":::"memory")

__device__ __forceinline__ void qkt(f32x16&p0,f32x16&p1,const __attribute__((address_space(3))) char*kb,const bf16x8*qr){
  #pragma unroll
  for(int d0=0;d0<4;++d0){
    const bf16x8 b0=*(const __attribute__((address_space(3))) bf16x8*)(kb+d0*2048);
    const bf16x8 b1=*(const __attribute__((address_space(3))) bf16x8*)(kb+d0*2048+512);
    p0=__builtin_amdgcn_mfma_f32_32x32x16_bf16(b0,qr[d0],p0,0,0,0);p1=__builtin_amdgcn_mfma_f32_32x32x16_bf16(b1,qr[d0],p1,0,0,0);}
}
typedef __attribute__((address_space(3))) const char* lds_cptr;
typedef short v4i16_t __attribute__((ext_vector_type(4)));
__device__ __forceinline__ void kload8(bf16x8*kf,lds_cptr kp){
  kf[0]=*(const __attribute__((address_space(3))) bf16x8*)(kp);      kf[1]=*(const __attribute__((address_space(3))) bf16x8*)(kp+512);
  kf[2]=*(const __attribute__((address_space(3))) bf16x8*)(kp+2048); kf[3]=*(const __attribute__((address_space(3))) bf16x8*)(kp+2560);
  kf[4]=*(const __attribute__((address_space(3))) bf16x8*)(kp+4096); kf[5]=*(const __attribute__((address_space(3))) bf16x8*)(kp+4608);
  kf[6]=*(const __attribute__((address_space(3))) bf16x8*)(kp+6144); kf[7]=*(const __attribute__((address_space(3))) bf16x8*)(kp+6656);
}
__device__ __forceinline__ void kload2(bf16x8*kf,lds_cptr kp,int j){ kf[2*j]=*(const __attribute__((address_space(3))) bf16x8*)(kp+j*2048); kf[2*j+1]=*(const __attribute__((address_space(3))) bf16x8*)(kp+j*2048+512); }
__device__ __forceinline__ s16x4 vtr(lds_cptr p){ return __builtin_bit_cast(s16x4,__builtin_amdgcn_ds_read_tr16_b64_v4i16((__attribute__((address_space(3))) v4i16_t*)p)); }
__device__ __forceinline__ float rowmax(const f32x16&p0,const f32x16&p1){
  float a=max3f(p0[0],p0[1],p1[0]),b=max3f(p0[2],p0[3],p1[1]);a=max3f(a,p1[2],p1[3]);
  #pragma unroll
  for(int r=4;r<16;r+=4){a=max3f(a,p0[r],p0[r+1]);b=max3f(b,p0[r+2],p0[r+3]);a=max3f(a,p1[r],p1[r+1]);b=max3f(b,p1[r+2],p1[r+3]);}
  const float m=max2f(a,b);
  auto rr=__builtin_amdgcn_permlane32_swap(__float_as_uint(m),__float_as_uint(m),false,false);
  return max2f(__uint_as_float(rr[0]),__uint_as_float(rr[1]));
}
__device__ __forceinline__ void pv(f32x16*o,int vb,bf16x8 pa0,bf16x8 pa1,bf16x8 pa2,bf16x8 pa3){
  #pragma unroll
  for(int d0=0;d0<2;++d0){s16x4 lo[4],hi[4];
    #pragma unroll
    for(int ks=0;ks<4;++ks){
      asm volatile("ds_read_b64_tr_b16 %0,%1 offset:%c2":"=&v"(lo[ks]):"v"(vb),"i"(d0*4096+ks*1024):"memory");
      asm volatile("ds_read_b64_tr_b16 %0,%1 offset:%c2":"=&v"(hi[ks]):"v"(vb),"i"(d0*4096+ks*1024+512):"memory");}
    asm volatile("s_waitcnt lgkmcnt(0)":::"memory");SBAR();
    #define PK(k) (bf16x8){lo[k][0],lo[k][1],lo[k][2],lo[k][3],hi[k][0],hi[k][1],hi[k][2],hi[k][3]}
    o[d0]=__builtin_amdgcn_mfma_f32_32x32x16_bf16(pa0,PK(0),o[d0],0,0,0);
    o[d0]=__builtin_amdgcn_mfma_f32_32x32x16_bf16(pa1,PK(1),o[d0],0,0,0);
    o[d0]=__builtin_amdgcn_mfma_f32_32x32x16_bf16(pa2,PK(2),o[d0],0,0,0);
    o[d0]=__builtin_amdgcn_mfma_f32_32x32x16_bf16(pa3,PK(3),o[d0],0,0,0);
    #undef PK
  }
}

#ifndef ATTN_STORE16
#define ATTN_STORE16(p,v) (*(u32x4*)(p)=(v))
#endif
template<bool SKIP> __device__ __forceinline__ void attn_unit(int b,int h,int qb,const bf16*Q,const bf16*__restrict__ K,const bf16*__restrict__ V,bf16*O,const float*__restrict__ CB,float qkb,char*shm){
  const int tid=otid(),lane=tid&63,r32=lane&31,hi=lane>>5; const int wid=__builtin_amdgcn_readfirstlane(tid>>6);
  const long rowbase=(long)b*SEQ; const int q0=qb*QB;
  const float*cb=CB+(long)(b*NHEAD+h)*SEQ;
  int t0=0;
  if(SKIP){ const int NTf=(q0+QB)/KVBLK; const float thr=2.f*qkb+40.f; const float cq0=cb[q0];
    bool pred=false; if(lane<NTf-4){ pred=(cq0-cb[64*lane+63])<-thr; }
    const unsigned long long mk=__ballot(pred); t0=(int)__builtin_ctzll(~mk); t0&=~1; t0=__builtin_amdgcn_readfirstlane(t0); }
  const int kv0=t0*KVBLK;
  const int NT=(q0+QB)/KVBLK-t0;
  { __attribute__((address_space(3))) float*bl=(__attribute__((address_space(3))) float*)((lds_cptr)shm+LDS_BIAS); const float*cbk=cb+kv0; for(int i=tid;i<NT*KVBLK;i+=NW*64) bl[i]=-*(const float*)((const char*)cbk+(unsigned)(i*4)); }
  const float negm0=*(const float*)((const char*)(cb+q0+wid*QBLK)+(unsigned)((lane&31)*4))-qkb;
  const bf16*Qw=Q+(rowbase+q0+wid*QBLK)*DM+h*D;
  const bf16*Kh=K+(rowbase+kv0)*DM+h*D,*Vh=V+(rowbase+kv0)*DM+h*D;
  const unsigned lds0=(unsigned)(uintptr_t)shm;
  const unsigned koff=(unsigned)(lane*DM+wid*8)*2u;
  const unsigned voff=(unsigned)((16*(wid&3)+(lane>>2))*DM+(wid>>2)*32+(lane&3)*8)*2u;
  const unsigned kdst=lds0+LDS_K+wid*1024, vdst=lds0+LDS_V+wid*1024;
  #define DMA_K(t,slot) glds16(Kh+(long)(t)*KVBLK*DM,koff,(unsigned)__builtin_amdgcn_readfirstlane(kdst+(slot)))
  #define DMA_V(t,slot) glds16(Vh+(long)(t)*KVBLK*DM,voff,(unsigned)__builtin_amdgcn_readfirstlane(vdst+(slot)))
  bf16x8 kf[8];
  const lds_cptr shm3=(lds_cptr)shm; __attribute__((address_space(3))) float*const wsf=(__attribute__((address_space(3))) float*)(shm3+LDS_WS)+wid*64;
  const lds_cptr kp0=shm3+LDS_K+hi*1024+r32*16; const lds_cptr vp0=shm3+LDS_V+((lane>>4)&1)*32+(lane&3)*8+(4*hi+((lane&15)>>2))*64;
  DMA_K(0,0);DMA_V(0,0);DMA_K(1,SLOTB);
  bf16x8 qr[4];
  #pragma unroll
  for(int d0=0;d0<4;++d0)qr[d0]=*reinterpret_cast<const bf16x8*>((const char*)Qw+(unsigned)((r32*DM+d0*16+hi*8)*2));
  float l_reg=0.f;f32x16 o[2];o[0]=f32x16{};o[1]=f32x16{};
  const __attribute__((address_space(3))) char* bl3=(const __attribute__((address_space(3))) char*)shm+LDS_BIAS+hi*16;
  #define BINIT_ALL(P0,P1,t) do{ const __attribute__((address_space(3))) f32x4v* bp_=(const __attribute__((address_space(3))) f32x4v*)(bl3+(t)*256); \
    _Pragma("unroll") for(int g_=0;g_<4;++g_){ const f32x4v x0_=bp_[2*g_], x1_=bp_[8+2*g_]; \
      P0[4*g_]=x0_[0]+negm0;P0[4*g_+1]=x0_[1]+negm0;P0[4*g_+2]=x0_[2]+negm0;P0[4*g_+3]=x0_[3]+negm0; \
      P1[4*g_]=x1_[0]+negm0;P1[4*g_+1]=x1_[1]+negm0;P1[4*g_+2]=x1_[2]+negm0;P1[4*g_+3]=x1_[3]+negm0; } }while(0)
  const int qrel=wid*QBLK+r32;
  #define CMASK(P0,P1,t) do{int jb_=(t)-(NT-4); if(jb_>=0)cmask(P0,P1,jb_,qrel,hi);}while(0)
  f32x16 pA0,pA1,pB0,pB1;
  int sl_prev=0,sl_cur=0,sl_next=SLOTB;
  #define ROT() do{sl_prev=sl_cur;sl_cur=sl_next;sl_next=(sl_next==(NSLOT-1)*SLOTB)?0:sl_next+SLOTB;}while(0)
  DMA_K(2,2*SLOTB);
  WAIT_BAR(3);
  BINIT_ALL(pA0,pA1,0); qkt(pA0,pA1,kp0,qr);asm volatile("s_nop 15\n\ts_nop 7":"+v"(pA0),"+v"(pA1));CMASK(pA0,pA1,0);
  _Pragma("unroll") for(int r=0;r<16;++r){pA0[r]=__builtin_amdgcn_exp2f(pA0[r]);pA1[r]=__builtin_amdgcn_exp2f(pA1[r]);}
  BINIT_ALL(pB0,pB1,1);
  WAIT_BAR(0);
  DMA_K(3,0);DMA_V(1,SLOTB);
  ROT();
  kload8(kf,kp0+sl_cur);
  WAIT_BAR(2);
  s16x4 vlo[8],vhi[8]; u32x4 pw0,pw1,pw2,pw3;
  #define PKW(P,B) cvtpk_s(P[B],P[B+1])
  #define PAF(k) __builtin_bit_cast(bf16x8,pw##k)
  #define VFR(i) (bf16x8){vlo[i][0],vlo[i][1],vlo[i][2],vlo[i][3],vhi[i][0],vhi[i][1],vhi[i][2],vhi[i][3]}
  #define PIN(x) asm volatile("":"+v"(x))
  #define MX3(a,b,c) __builtin_fmaxf(__builtin_fmaxf((a),(b)),(c))
  #define GAPA(MF,A0,A1,A2,A3,W0,W1,PW) do{ MF; sacc+=A0; sacc+=A1; sacc+=A2; sacc+=A3; PIN(sacc); W0; W1; PIN(PW); SBAR(); }while(0)
  #define EX(v) __builtin_amdgcn_exp2f(v)
  #define GAPB(MF,X,B,GL_,P,GI,NI) do{ MF; X[B]=EX(X[B]); X[B+1]=EX(X[B+1]); X[B+2]=EX(X[B+2]); X[B+3]=EX(X[B+3]); PIN(X); \
    if(GL_){ const f32x4v nx_=bpn_[NI]; P[4*(GI)]=bq_[0]+negm0; P[4*(GI)+1]=bq_[1]+negm0; P[4*(GI)+2]=bq_[2]+negm0; P[4*(GI)+3]=bq_[3]+negm0; bq_=nx_; PIN(P); } SBAR(); }while(0)
  #define VRD(i) do{ vlo[i]=vtr(vp_+(((i)>>2)*4096+((i)&3)*1024)); vhi[i]=vtr(vp_+(((i)>>2)*4096+((i)&3)*1024+512)); }while(0)
  #define KRD(G,j) do{ if(G){ kload2(kf,kp0+sl_next,j); SBAR(); } }while(0)
  #define STEP(C0,C1,P0,P1,t,GK,GV,GL) do{ SBAR(); \
    const lds_cptr vp_=vp0+sl_prev; \
    VRD(0); SBAR(); float sacc=(P0[0]+P0[1]); \
    GAPA(C0=__builtin_amdgcn_mfma_f32_32x32x16_bf16(kf[0],qr[0],C0,0,0,0), P0[2],P0[3],P0[4],P0[5],     pw0[0]=PKW(P0,0), pw0[1]=PKW(P0,2), pw0); \
    VRD(4); SBAR(); GAPA(C1=__builtin_amdgcn_mfma_f32_32x32x16_bf16(kf[1],qr[0],C1,0,0,0), P0[6],P0[7],P0[8],P0[9],     pw0[2]=PKW(P0,4), pw0[3]=PKW(P0,6), pw0); \
    VRD(1); SBAR(); GAPA(C0=__builtin_amdgcn_mfma_f32_32x32x16_bf16(kf[2],qr[1],C0,0,0,0),   P0[10],P0[11],P0[12],P0[13], pw1[0]=PKW(P0,8), pw1[1]=PKW(P0,10), pw1); \
    VRD(5); SBAR(); GAPA(C1=__builtin_amdgcn_mfma_f32_32x32x16_bf16(kf[3],qr[1],C1,0,0,0),   P0[14],P0[15],P1[0],P1[1],   pw1[2]=PKW(P0,12),pw1[3]=PKW(P0,14), pw1); \
    VRD(2); SBAR(); GAPA(C0=__builtin_amdgcn_mfma_f32_32x32x16_bf16(kf[4],qr[2],C0,0,0,0),   P1[2],P1[3],P1[4],P1[5],     pw2[0]=PKW(P1,0), pw2[1]=PKW(P1,2), pw2); \
    VRD(6); SBAR(); GAPA(C1=__builtin_amdgcn_mfma_f32_32x32x16_bf16(kf[5],qr[2],C1,0,0,0),   P1[6],P1[7],P1[8],P1[9],     pw2[2]=PKW(P1,4), pw2[3]=PKW(P1,6), pw2); \
    VRD(3); SBAR(); GAPA(C0=__builtin_amdgcn_mfma_f32_32x32x16_bf16(kf[6],qr[3],C0,0,0,0),   P1[10],P1[11],P1[12],P1[13], pw3[0]=PKW(P1,8), pw3[1]=PKW(P1,10), pw3); \
    VRD(7); SBAR(); GAPA(C1=__builtin_amdgcn_mfma_f32_32x32x16_bf16(kf[7],qr[3],C1,0,0,0),   P1[14],P1[15],0.f,0.f,       pw3[2]=PKW(P1,12),pw3[3]=PKW(P1,14), pw3); \
    l_reg+=sacc; \
    if(GK){DMA_K((t)+3,sl_cur);} if(GV){DMA_V((t)+1,sl_next);} \
    CMASK(C0,C1,t); \
    const __attribute__((address_space(3))) f32x4v* bpn_=(const __attribute__((address_space(3))) f32x4v*)(bl3+((t)+1)*256); f32x4v bq_=f32x4v{}; if(GL){bq_=bpn_[0];} \
    SBAR(); \
    GAPB(o[0]=__builtin_amdgcn_mfma_f32_32x32x16_bf16(PAF(0),VFR(0),o[0],0,0,0), C0,0,GL,P0,0,8); \
    GAPB(o[1]=__builtin_amdgcn_mfma_f32_32x32x16_bf16(PAF(0),VFR(4),o[1],0,0,0), C0,4,GL,P1,0,2); \
    KRD(GL,0); GAPB(o[0]=__builtin_amdgcn_mfma_f32_32x32x16_bf16(PAF(1),VFR(1),o[0],0,0,0), C0,8,GL,P0,1,10); \
    KRD(GL,1); GAPB(o[1]=__builtin_amdgcn_mfma_f32_32x32x16_bf16(PAF(1),VFR(5),o[1],0,0,0), C0,12,GL,P1,1,4); \
    KRD(GL,2); GAPB(o[0]=__builtin_amdgcn_mfma_f32_32x32x16_bf16(PAF(2),VFR(2),o[0],0,0,0), C1,0,GL,P0,2,12); \
    KRD(GL,3); GAPB(o[1]=__builtin_amdgcn_mfma_f32_32x32x16_bf16(PAF(2),VFR(6),o[1],0,0,0), C1,4,GL,P1,2,6); \
    GAPB(o[0]=__builtin_amdgcn_mfma_f32_32x32x16_bf16(PAF(3),VFR(3),o[0],0,0,0), C1,8,GL,P0,3,14); \
    GAPB(o[1]=__builtin_amdgcn_mfma_f32_32x32x16_bf16(PAF(3),VFR(7),o[1],0,0,0), C1,12,GL,P1,3,14); \
    }while(0)
  int t=1;
  #undef CMASK
  #define CMASK(P0,P1,t) do{}while(0)
  for(;t+5<NT;t+=2){
    STEP(pB0,pB1,pA0,pA1,t,true,true,true);     WAIT_BAR(2); ROT();
    STEP(pA0,pA1,pB0,pB1,t+1,true,true,true);   WAIT_BAR(2); ROT();
  }
  #undef CMASK
  #define CMASK(P0,P1,t) do{int jb_=(t)-(NT-4); if(jb_>=0)cmask(P0,P1,jb_,qrel,hi);}while(0)
  #define ENDW(tt) do{ if((tt)+3<NT){WAIT_BAR(2);} else if((tt)+2<NT){WAIT_BAR(1);} else {WAIT_BAR(0);} }while(0)
  for(;t+1<NT;t+=2){
    STEP(pB0,pB1,pA0,pA1,t,(t+3<NT),(t+1<NT),(t+1<NT));       ENDW(t);   ROT();
    STEP(pA0,pA1,pB0,pB1,t+1,(t+4<NT),(t+2<NT),(t+2<NT));     ENDW(t+1); ROT();
  }
  STEP(pB0,pB1,pA0,pA1,NT-1,false,false,false);
  { float sacc=pB0[0]+pB0[1]; _Pragma("unroll") for(int r=2;r<16;++r)sacc+=pB0[r]; _Pragma("unroll") for(int r=0;r<16;++r)sacc+=pB1[r]; l_reg+=sacc;
    pw0=(u32x4){PKW(pB0,0),PKW(pB0,2),PKW(pB0,4),PKW(pB0,6)};pw1=(u32x4){PKW(pB0,8),PKW(pB0,10),PKW(pB0,12),PKW(pB0,14)};pw2=(u32x4){PKW(pB1,0),PKW(pB1,2),PKW(pB1,4),PKW(pB1,6)};pw3=(u32x4){PKW(pB1,8),PKW(pB1,10),PKW(pB1,12),PKW(pB1,14)};
    SBAR(); pv(o,(int)(unsigned)(uintptr_t)vp0+sl_cur,PAF(0),PAF(1),PAF(2),PAF(3)); }
  #undef PKW
  #undef PAF
  #undef VFR
  #undef PIN
  #undef MX3
  #undef GAPA
  #undef GAPB
  #undef EX
  #undef VRD
  #undef KRD
  #undef STEP
  #undef ENDW
  {auto rr=__builtin_amdgcn_permlane32_swap(__float_as_uint(l_reg),__float_as_uint(l_reg),false,false);l_reg=__uint_as_float(rr[0])+__uint_as_float(rr[1]);}
  if(hi==0)wsf[32+r32]=l_reg;asm volatile("s_waitcnt lgkmcnt(0)":::"memory");
  float rli[16];
  #pragma unroll
  for(int r=0;r<16;++r)rli[r]=__builtin_amdgcn_rcpf(wsf[32+crow(r,hi)]);
  bf16*Ow=O+(rowbase+q0+wid*QBLK)*OPITCH+h*D;
  { __attribute__((address_space(3))) unsigned short*stg=(__attribute__((address_space(3))) unsigned short*)(shm3+LDS_OST)+wid*2048;
    #pragma unroll
    for(int r=0;r<16;++r){const int orow=crow(r,hi);
      #pragma unroll
      for(int d0=0;d0<2;++d0)stg[orow*64+d0*32+r32]=(unsigned short)(cvtpk_s(o[d0][r]*rli[r],0.f)&0xffffu);}
    asm volatile("s_waitcnt lgkmcnt(0)":::"memory");
    #pragma unroll
    for(int i=0;i<4;++i){const int row=i*8+(lane>>3),ch=lane&7; const u32x4 v=*(const __attribute__((address_space(3))) u32x4*)(stg+row*64+ch*8); ATTN_STORE16((char*)Ow+(unsigned)((row*OPITCH+ch*8)*2),v);} }
  asm volatile("s_waitcnt lgkmcnt(0)\n\ts_barrier":::"memory");
  #undef DMA_K
  #undef DMA_V
  #undef CMASK
  #undef BINIT_ALL
  #undef ROT
}
constexpr int ATTN_LDS_BYTES=LDS_TOTAL;
struct AttnTensors { const bf16* Q; const bf16* K; const bf16* V; bf16* O; const float* CB; float qkb; };
struct AttnUnit { int bh; int qb; };
struct StaticOrder {
  int vcu,G;
  __device__ __forceinline__ explicit StaticOrder(int grid,int block):vcu((grid%8==0)?(block%8)*(grid/8)+block/8:block),G(grid){}
  __device__ __forceinline__ bool next(int i,AttnUnit&u)const{
    if(G==256){ if(i>=4)return false; const int s=vcu&3; u.bh=vcu>>2; u.qb=(i==0)?s:(i==1)?7-s:(i==2)?8+s:15-s; return true; }
    const int id=vcu+i*G; if(id>=BATCH*NHEAD*NQB)return false; u.bh=id/NQB; u.qb=id%NQB; return true; }
};
template<class Sched,bool SKIP> __device__ __forceinline__ void attn_phase(char*lds,const AttnTensors&T,const Sched&S){
  AttnUnit u;
  for(int i=0;S.next(i,u);++i){ attn_unit<SKIP>(u.bh/NHEAD,u.bh%NHEAD,u.qb,T.Q,T.K,T.V,T.O,T.CB,T.qkb,lds); }
}
template<bool SKIP> __device__ __forceinline__ void attn_phase_q(char*lds,const AttnTensors&T,unsigned*queue){
  const int tid=otid();
  __attribute__((address_space(3))) int*slot=(__attribute__((address_space(3))) int*)((lds_cptr)lds+LDS_TOTAL);
  const unsigned xcc=(unsigned)__builtin_amdgcn_s_getreg((3<<11)|20)&7u;
  for(;;){
    if(tid==0){ int got=-1;
      for(unsigned sx=0;sx<8;++sx){ const unsigned x=(xcc+sx)&7u; const unsigned c=__hip_atomic_fetch_add(queue+x*64,1u,__ATOMIC_RELAXED,__HIP_MEMORY_SCOPE_AGENT); if(c<(unsigned)(NHEAD*NQB)){ got=(int)(x*(NHEAD*NQB)+c); break; } }
      *slot=got; }
    asm volatile("s_waitcnt vmcnt(0) lgkmcnt(0)\n\ts_barrier":::"memory");
    const int id=__builtin_amdgcn_readfirstlane(*slot);
    if(id<0)break;
    const int b=id/(NHEAD*NQB), c=id%(NHEAD*NQB), h=c%NHEAD, qb=NQB-1-c/NHEAD;
    attn_unit<SKIP>(b,h,qb,T.Q,T.K,T.V,T.O,T.CB,T.qkb,lds);
  }
}
#undef SBAR
#undef WAIT_BAR
}
#define GAS __attribute__((address_space(1)))
#define LAS __attribute__((address_space(3)))
typedef unsigned short bf16;
typedef unsigned v4u __attribute__((ext_vector_type(4)));
typedef float f32x4 __attribute__((ext_vector_type(4)));
typedef short bf16x8 __attribute__((ext_vector_type(8)));
typedef GAS unsigned gu32;
typedef GAS unsigned long long gu64;
#define RLX_AGENT __ATOMIC_RELAXED, __HIP_MEMORY_SCOPE_AGENT
#define LDS_WAIT() asm volatile("s_waitcnt lgkmcnt(0)" ::: "memory")
#define VM_WAIT() asm volatile("s_waitcnt vmcnt(0)" ::: "memory")
__device__ __forceinline__ unsigned long long rt() { return __builtin_amdgcn_s_memrealtime(); }
__device__ __forceinline__ unsigned f2bf(float f) { unsigned u = __builtin_bit_cast(unsigned, f); return (u + 0x7fffu + ((u >> 16) & 1u)) >> 16; }
__device__ __forceinline__ unsigned pk2(float lo, float hi) { return f2bf(lo) | (f2bf(hi) << 16); }

#define XB_TMO      128
#define XB_XCNT(j)  (256  + 64 * (j))
#define XB_XSUB(j)  (1280 + 64 * (j))
#define XB_XGEN(j)  (2304 + 64 * (j))
#define XB_TOP      3328
#define XB_TOPGEN   3392
#define XCD_BAR_WORDS 3456
#define XB_SPIN_CAP (1u << 18)

__device__ __forceinline__ unsigned xb_ld(unsigned* p)              { return __hip_atomic_load(p, __ATOMIC_RELAXED, __HIP_MEMORY_SCOPE_AGENT); }
__device__ __forceinline__ unsigned xb_add(unsigned* p, unsigned v) { return __hip_atomic_fetch_add(p, v, __ATOMIC_RELAXED, __HIP_MEMORY_SCOPE_AGENT); }
__device__ __forceinline__ unsigned xb_xcc_id() { return (unsigned)__builtin_amdgcn_s_getreg((3 << 11) | 20) & 0xFu; }
#define XB_SPIN(cond, bar) do { unsigned _sp = 0; while (cond) { __builtin_amdgcn_s_sleep(1); \
    if ((++_sp & 255u) == 0u) { if (xb_ld(&(bar)[XB_TMO])) break; if (_sp > XB_SPIN_CAP) { atomicAdd(&(bar)[XB_TMO], 1u); break; } } } } while (0)

struct XcdBarrier {
    unsigned* bar; unsigned x;
    volatile LAS unsigned* st;
};

__device__ __forceinline__ XcdBarrier xcd_barrier_post(unsigned* bar, volatile LAS unsigned* st) {
    XcdBarrier b; b.bar = bar; b.x = xb_xcc_id(); b.st = st;
    if (threadIdx.x == 0) (void)xb_add(&bar[XB_XCNT(b.x)], 1u);
    return b;
}
__device__ __forceinline__ void xcd_barrier_complete(unsigned* bar, unsigned x, unsigned& nloc, unsigned& nx) {
    const unsigned G = gridDim.x * gridDim.y * gridDim.z;
    unsigned sum, cnt, mine, sp = 0u;
    for (;;) {
        sum = 0u; cnt = 0u; mine = 0u;
#pragma unroll
        for (unsigned j = 0; j < 16; ++j) { const unsigned c = xb_ld(&bar[XB_XCNT(j)]); sum += c; cnt += (c > 0u) ? 1u : 0u; mine = (j == x) ? c : mine; }
        if (sum == G) break;
        __builtin_amdgcn_s_sleep(1);
        if ((++sp & 255u) == 0u) { if (xb_ld(&bar[XB_TMO])) break; if (sp > XB_SPIN_CAP) { atomicAdd(&bar[XB_TMO], 1u); break; } }
    }
    nloc = mine > 0u ? mine : 1u; nx = cnt > 0u ? cnt : 1u;
}

__device__ __forceinline__ void xcd_barrier(const XcdBarrier& b) {
    asm volatile("s_waitcnt vmcnt(0)" ::: "memory");
    __syncthreads();
    if (threadIdx.x == 0) {
        unsigned* bar = b.bar;
        __builtin_amdgcn_s_waitcnt(0);
        unsigned nloc = b.st[0], nx = b.st[1];
        if (nloc == 0u) { xcd_barrier_complete(bar, b.x, nloc, nx); b.st[0] = nloc; b.st[1] = nx; }
        const unsigned old = xb_add(&bar[XB_XSUB(b.x)], 1u);
        const unsigned gen = old / nloc;
        if (old + 1u == (gen + 1u) * nloc) {
            __builtin_amdgcn_fence(__ATOMIC_RELEASE, "agent");
            asm volatile("s_waitcnt vmcnt(0)" ::: "memory");
            const unsigned og = xb_add(&bar[XB_TOP], 1u);
            const unsigned tg = og / nx;
            if (og + 1u == (tg + 1u) * nx) xb_add(&bar[XB_TOPGEN], 1u);
            else XB_SPIN(xb_ld(&bar[XB_TOPGEN]) == tg, bar);
            __builtin_amdgcn_fence(__ATOMIC_ACQUIRE, "agent");
            xb_add(&bar[XB_XGEN(b.x)], 1u);
            asm volatile("s_waitcnt vmcnt(0)" ::: "memory");
        } else {
            XB_SPIN(xb_ld(&bar[XB_XGEN(b.x)]) == gen, bar);
            __builtin_amdgcn_fence(__ATOMIC_ACQUIRE, "agent");
            asm volatile("s_waitcnt vmcnt(0)" ::: "memory");
        }
    }
    __syncthreads();
}
struct Args { const float* in[25]; float* out; unsigned char* ws; int ph_lo, ph_hi, use_bar, pad; };
typedef const __attribute__((address_space(4))) Args* KArgs;
#define CAND_LIST CAND(0,0,2,1) CAND(0,1,2,2) CAND(0,2,2,3) CAND(0,3,2,4) CAND(0,4,3,0) CAND(0,5,3,1) CAND(0,6,3,2) CAND(0,7,3,3) CAND(0,8,4,0) CAND(0,9,4,1) CAND(0,10,4,2) CAND(0,11,5,0) CAND(0,12,5,1) CAND(0,13,6,0) CAND(0,14,6,1) CAND(0,15,7,0) CAND(1,0,7,1) CAND(1,1,8,0) CAND(1,2,9,0) CAND(1,3,10,0) CAND(1,4,11,0) CAND(1,5,12,0) CAND(1,6,13,0) CAND(1,7,14,0) CAND(2,0,15,0)
constexpr int NB = 8, SEQ = 4096, DM = 1024, NTOK = NB * SEQ;
constexpr int NH = 8, HD = 64, AW = 512, PWD = 256, SWD = 256, INC = 2056;
constexpr int NEXP = 16384, PQW = 2048;
constexpr float EPSN = 1e-6f, LOG2E = 1.4426950408889634f;
constexpr int NWAVES = 8, NTHR = 512;
constexpr size_t MiB = 1u << 20;
constexpr size_t WS_CTL = 0, CTL_ZERO_BYTES = 1 * MiB;
constexpr size_t WS_WIN = 1 * MiB;
constexpr size_t WS_WOUT = 9 * MiB;
constexpr size_t WS_WQ = 13 * MiB;
constexpr size_t WS_KEYS = 21 * MiB;
constexpr size_t WS_WGLU = 22 * MiB;
constexpr size_t WS_WF = 22 * MiB + 512 * 1024;
constexpr size_t WS_CB = 23 * MiB;
constexpr size_t WS_XLOC = 24 * MiB;
constexpr size_t WS_IDX = 28 * MiB;
constexpr size_t WS_GATE = 44 * MiB;
constexpr size_t WS_Z = 60 * MiB;
constexpr size_t WS_U = 76 * MiB;
constexpr size_t WS_V = 140 * MiB;
constexpr size_t WS_XN8 = 172 * MiB;
constexpr size_t WS_HSC = 22 * MiB + 768 * 1024;
constexpr size_t WS_XN = 204 * MiB;
constexpr size_t WS_P = 268 * MiB;
constexpr size_t WS_MG = 396 * MiB;
constexpr size_t WS_END = 460 * MiB;
constexpr int CW_BAR = 4096, CW_AQ = 20480;
constexpr float U8_SCALE = 768.f, V8_SCALE = 32.f, ACT_SCALE = 64.f;
constexpr int RING_BYTES = 131072, LDSCTL_OFF = RING_BYTES, MISC_OFF = LDSCTL_OFF + 320, EPIX_OFF = LDSCTL_OFF + 4096, LDS_BYTES = 163840;
static_assert(attn_body::ATTN_LDS_BYTES + 16 <= RING_BYTES, "attention scratch fits the ring");

typedef _Float16 h16x2 __attribute__((ext_vector_type(2)));
typedef float f32x16 __attribute__((ext_vector_type(16)));
typedef unsigned u32x2 __attribute__((ext_vector_type(2)));

__device__ __forceinline__ float bf2f(unsigned short b) { return __uint_as_float((unsigned)b << 16); }
__device__ __forceinline__ float bflo(unsigned w) { return __uint_as_float(w << 16); }
__device__ __forceinline__ float bfhi(unsigned w) { return __uint_as_float(w & 0xffff0000u); }
__device__ __forceinline__ h16x2 as_h2(unsigned w) { return __builtin_bit_cast(h16x2, w); }
template <bool HI> __device__ __forceinline__ h16x2 cvt8h(int w) { return __builtin_bit_cast(h16x2, __builtin_amdgcn_cvt_scalef32_pk_f16_fp8(w, 1.0f, HI)); }
__device__ __forceinline__ float gelu_tanh(float x) { const float u = 1.5957691216057308f * (x + 0.044715f * x * x * x); return x / (1.f + __expf(-u)); }
__device__ __forceinline__ float wave_sum(float v) {
#pragma unroll
    for (int o = 1; o < 64; o <<= 1) v += __shfl_xor(v, o);
    return v;
}
__device__ __forceinline__ float wave_max(float v) {
#pragma unroll
    for (int o = 1; o < 64; o <<= 1) v = fmaxf(v, __shfl_xor(v, o));
    return v;
}
template <int N, int S0> __device__ __forceinline__ float bfly_reduce(float (&v)[N], int lane) {
    int s = S0;
#pragma unroll
    for (int cnt = N; cnt > 1; cnt >>= 1) {
        const bool up = (lane & s) != 0;
#pragma unroll
        for (int i = 0; i < cnt / 2; ++i) { const float a = v[i], b = v[i + cnt / 2]; const float send = up ? a : b, keep = up ? b : a; v[i] = keep + __shfl_xor(send, s); }
        s >>= 1;
    }
    float r = v[0];
    for (; s >= 1; s >>= 1) r += __shfl_xor(r, s);
    return r;
}

__device__ __forceinline__ void tr_item(const float* W, int ldw, int srccol, bf16* WT, int K, int dstrow, int k0, LAS float* scr, int lane) {
#pragma unroll 8
    for (int i = 0; i < 32; ++i) { const int kk = 2 * i + (lane >> 5); scr[kk * 33 + (lane & 31)] = W[(size_t)(k0 + kk) * ldw + srccol + (lane & 31)]; }
    LDS_WAIT(); asm volatile("" ::: "memory");
    const int c = lane & 7;
#pragma unroll
    for (int j = 0; j < 4; ++j) { const int n = (lane >> 3) + 8 * j; const LAS float* s = scr + (8 * c) * 33 + n;
        v4u o; o.x = pk2(s[0 * 33], s[1 * 33]); o.y = pk2(s[2 * 33], s[3 * 33]); o.z = pk2(s[4 * 33], s[5 * 33]); o.w = pk2(s[6 * 33], s[7 * 33]);
        *(GAS v4u*)(WT + (size_t)(dstrow + n) * K + k0 + 8 * c) = o; }
    LDS_WAIT(); asm volatile("" ::: "memory");
}
__device__ __forceinline__ void phase_prep(KArgs a, LAS unsigned char* lds, int G, int vcu, int tid, int lane, int wave) {
    unsigned char* ws = a->ws;
    LAS float* scr = (LAS float*)(lds + wave * 16384);
    const int gw = vcu * NWAVES + wave, NGW = G * NWAVES;
    constexpr int I_IN = 2048, I_OUT = 1024, I_WQ = 2048, I_GLU = 64;
    for (int it = gw; it < I_IN + I_OUT + I_WQ + I_GLU; it += NGW) {
        int r = it;
        if (r < I_IN) { const int l = r >> 10, q = r & 1023, kb = q >> 6, nb = q & 63, n0 = nb * 32;
            tr_item(a->in[2] + (size_t)l * DM * INC, INC, n0 + (n0 >= 1536 ? 8 : 0), (bf16*)(ws + WS_WIN) + (size_t)l * 2048 * 1024, 1024, n0, kb * 64, scr, lane); continue; }
        r -= I_IN;
        if (r < I_OUT) { const int l = r >> 9, q = r & 511, kb = q >> 5, nb = q & 31;
            tr_item(a->in[19] + (size_t)l * DM * DM, DM, nb * 32, (bf16*)(ws + WS_WOUT) + (size_t)l * 1024 * 1024, 1024, nb * 32, kb * 64, scr, lane); continue; }
        r -= I_OUT;
        if (r < I_WQ) { const int l = r >> 10, q = r & 1023, kb = q >> 6, nb = q & 63;
            tr_item(a->in[21] + (size_t)l * DM * PQW, PQW, nb * 32, (bf16*)(ws + WS_WQ) + (size_t)l * 2048 * 1024, 1024, nb * 32, kb * 64, scr, lane); continue; }
        r -= I_WQ;
        { const int l = r >> 5, q = r & 31, kb = q >> 3, nb = q & 7;
            tr_item(a->in[16] + (size_t)l * 256 * 256, 256, nb * 32, (bf16*)(ws + WS_WGLU) + (size_t)l * 256 * 256, 256, nb * 32, kb * 64, scr, lane); }
    }
    const size_t gt = (size_t)vcu * NTHR + tid, NGT = (size_t)G * NTHR;
    for (size_t i = gt; i < 2 * 8 * 1024; i += NGT) { const int l = (int)(i >> 13), h = (int)(i >> 10) & 7, k = (int)i & 1023;
        ((float*)(ws + WS_WF))[i] = a->in[2][((size_t)l * DM + k) * INC + 1536 + h]; }
    { const float* src = a->in[22]; bf16* dst = (bf16*)(ws + WS_KEYS);
      for (size_t i = gt; i < (size_t)2 * 8 * 2 * 128 * 128 / 8; i += NGT) { const f32x4 x0 = *(const f32x4*)(src + i * 8), x1 = *(const f32x4*)(src + i * 8 + 4);
          v4u o; o.x = pk2(x0[0], x0[1]); o.y = pk2(x0[2], x0[3]); o.z = pk2(x1[0], x1[1]); o.w = pk2(x1[2], x1[3]); *(v4u*)(dst + i * 8) = o; } }
    { const float* src = a->in[23]; unsigned char* dst = ws + WS_U;
#pragma unroll 1
      for (size_t i = gt; i < (size_t)2 * NEXP * DM / 16; i += NGT) { v4u o;
#pragma unroll
          for (int q = 0; q < 4; ++q) { const f32x4 x = *(const f32x4*)(src + i * 16 + 4 * q) * U8_SCALE;
              const int q0 = (int)__builtin_rintf(fminf(fmaxf(x[0], -127.f), 127.f)), q1 = (int)__builtin_rintf(fminf(fmaxf(x[1], -127.f), 127.f)), q2 = (int)__builtin_rintf(fminf(fmaxf(x[2], -127.f), 127.f)), q3 = (int)__builtin_rintf(fminf(fmaxf(x[3], -127.f), 127.f));
              o[q] = (unsigned)((q0 & 255) | ((q1 & 255) << 8) | ((q2 & 255) << 16) | (q3 << 24)); }
          const size_t r = i >> 6; const unsigned cg = (unsigned)(i & 63), l = (unsigned)(r / NEXP), rl = (unsigned)(r % NEXP);
          *(v4u*)(dst + (size_t)l * NEXP * DM + (size_t)(cg >> 3) * NEXP * 128 + (size_t)rl * 128 + (cg & 7u) * 16u) = o; } }
    { const float* src = a->in[24]; unsigned char* dst = ws + WS_V;
#pragma unroll 1
      for (size_t i = gt; i < (size_t)2 * NEXP * DM / 16; i += NGT) { v4u o;
#pragma unroll
          for (int q = 0; q < 4; ++q) { f32x4 x = *(const f32x4*)(src + i * 16 + 4 * q) * V8_SCALE;
              x[0] = fminf(fmaxf(x[0], -448.f), 448.f); x[1] = fminf(fmaxf(x[1], -448.f), 448.f); x[2] = fminf(fmaxf(x[2], -448.f), 448.f); x[3] = fminf(fmaxf(x[3], -448.f), 448.f);
              int w = 0; w = __builtin_amdgcn_cvt_pk_fp8_f32(x[0], x[1], w, false); w = __builtin_amdgcn_cvt_pk_fp8_f32(x[2], x[3], w, true); o[q] = (unsigned)w; }
          const size_t r = i >> 6; const unsigned cg = (unsigned)(i & 63), l = (unsigned)(r / NEXP), rl = (unsigned)(r % NEXP);
          *(v4u*)(dst + (size_t)l * NEXP * DM + (size_t)(cg >> 3) * NEXP * 128 + (size_t)rl * 128 + (cg & 7u) * 16u) = o; } }
}

template <bool FLOGIT> __device__ __forceinline__ void phase_rownorm(const float* x, const float* g, bf16* XN, const float* WF, const float* fbias, float* CB, int G, int vcu, int lane, int wave, unsigned char* XN8 = nullptr, float* HSC = nullptr) {
    const int gw = vcu * NWAVES + wave, NGW = G * NWAVES;
    f32x4 gv[4];
#pragma unroll
    for (int j = 0; j < 4; ++j) gv[j] = *(const f32x4*)(g + 4 * lane + 256 * j);
    f32x4 vn[2][4];
#define RN_LOAD(rg_) do { _Pragma("unroll") for (int r = 0; r < 2; ++r) { const float* xr = x + (size_t)((rg_) * 2 + r) * DM + 4 * lane; _Pragma("unroll") for (int j = 0; j < 4; ++j) vn[r][j] = *(const f32x4*)(xr + 256 * j); } } while (0)
    if (gw < NTOK / 2) RN_LOAD(gw);
    for (int rg = gw; rg < NTOK / 2; rg += NGW) {
        f32x4 v[2][4];
#pragma unroll
        for (int r = 0; r < 2; ++r)
#pragma unroll
            for (int j = 0; j < 4; ++j) v[r][j] = vn[r][j];
        if (rg + NGW < NTOK / 2) RN_LOAD(rg + NGW);
#pragma unroll
        for (int r = 0; r < 2; ++r) { float s = 0.f;
#pragma unroll
            for (int j = 0; j < 4; ++j) s += (v[r][j][0] * v[r][j][0] + v[r][j][1] * v[r][j][1]) + (v[r][j][2] * v[r][j][2] + v[r][j][3] * v[r][j][3]);
            const float rstd = 1.0f / sqrtf(wave_sum(s) * (1.f / DM) + EPSN);
            bf16* orow = XN + (size_t)(rg * 2 + r) * DM + 4 * lane;
#pragma unroll
            for (int j = 0; j < 4; ++j) { v[r][j] = v[r][j] * rstd * gv[j]; u32x2 w; w.x = pk2(v[r][j][0], v[r][j][1]); w.y = pk2(v[r][j][2], v[r][j][3]); *(u32x2*)(orow + 256 * j) = w; }
            if (!FLOGIT && XN8) { float mx = 0.f;
#pragma unroll
                for (int j = 0; j < 4; ++j) mx = fmaxf(fmaxf(mx, fmaxf(fabsf(v[r][j][0]), fabsf(v[r][j][1]))), fmaxf(fabsf(v[r][j][2]), fabsf(v[r][j][3])));
                mx = fmaxf(wave_max(mx), 1e-20f); const float qs = 127.f / mx;
#pragma unroll
                for (int j = 0; j < 4; ++j) { const int q0 = (int)__builtin_rintf(v[r][j][0] * qs), q1 = (int)__builtin_rintf(v[r][j][1] * qs), q2 = (int)__builtin_rintf(v[r][j][2] * qs), q3 = (int)__builtin_rintf(v[r][j][3] * qs);
                    *(unsigned*)(XN8 + (size_t)(rg * 2 + r) * DM + 4 * lane + 256 * j) = (unsigned)((q0 & 255) | ((q1 & 255) << 8) | ((q2 & 255) << 16) | (q3 << 24)); }
                if (lane == 0) HSC[rg * 2 + r] = mx * (1.f / 127.f); } }
        if (FLOGIT) {
            float acc[16];
#pragma unroll
            for (int i = 0; i < 16; ++i) acc[i] = 0.f;
#pragma unroll
            for (int h = 0; h < 8; ++h)
#pragma unroll
                for (int j = 0; j < 4; ++j) { const f32x4 w = *(const f32x4*)(WF + h * 1024 + 4 * lane + 256 * j);
#pragma unroll
                    for (int r = 0; r < 2; ++r) acc[r * 8 + h] += (v[r][j][0] * w[0] + v[r][j][1] * w[1]) + (v[r][j][2] * w[2] + v[r][j][3] * w[3]); }
            const float tot = bfly_reduce<16, 32>(acc, lane);
            if ((lane & 3) == 0) { const int id = (lane >> 2) & 15, r = id >> 3, h = id & 7; const int row = rg * 2 + r, b = row / SEQ, s = row % SEQ;
                const float z = tot + fbias[h];
                const float ls = fminf(z, 0.f) - __logf(1.f + __expf(-fabsf(z)));
                CB[((size_t)(b * NH + h)) * SEQ + s] = ls * LOG2E; }
        }
    }
}

__device__ __forceinline__ void phase_cumsum(float* c, int lane) {
    float carry = 0.f;
#pragma unroll 1
    for (int it0 = 0; it0 < SEQ / 64; it0 += 16) { float vv[16];
#pragma unroll
        for (int q = 0; q < 16; ++q) vv[q] = c[(it0 + q) * 64 + lane];
#pragma unroll
        for (int q = 0; q < 16; ++q) { float v = vv[q];
#pragma unroll
            for (int o = 1; o < 64; o <<= 1) { const float t = __shfl_up(v, o); if (lane >= o) v += t; }
            v += carry; c[(it0 + q) * 64 + lane] = v; carry = __shfl(v, 63); } }
}

__device__ __forceinline__ void phase_pool(const bf16* PS, const float* pw, const float* pscale, const float* ong, bf16* MG, LAS unsigned char* lds, int G, int bx, int tid, int lane, int wave) {
    LAS float* ut = (LAS float*)lds;
    LAS float* pl = (LAS float*)(lds + 47 * 256 * 4);
    const int ch = tid & 255, half = tid >> 8, g = ch >> 6, w = 2 << g;
    float wcol[64];
#pragma unroll
    for (int c = 0; c < 64; ++c) wcol[c] = pw[(g * 64 + c) * 64 + (ch & 63)];
    const float psc = pscale[ch];
    const f32x4 gn = *(const f32x4*)(ong + 512 + 4 * lane);
    v4u wq[3];
#define POOL_LOAD(tile_) do { const int tok0_ = (tile_) * 32, s0_ = tok0_ % SEQ; _Pragma("unroll") for (int q = 0; q < 3; ++q) { const int idx = tid + q * NTHR, rr = idx >> 5, cq = idx & 31, r = rr - 15; \
        wq[q] = (v4u){0u, 0u, 0u, 0u}; if (idx < 47 * 32 && s0_ + r >= 0) wq[q] = *(const v4u*)(PS + (size_t)(tok0_ + r) * 512 + cq * 8); } } while (0)
    if (bx < NTOK / 32) POOL_LOAD(bx);
    for (int tile = bx; tile < NTOK / 32; tile += G) {
        const int tok0 = tile * 32, s0 = tok0 % SEQ;
#pragma unroll
        for (int q = 0; q < 3; ++q) { const int idx = tid + q * NTHR, rr = idx >> 5, cq = idx & 31; const v4u wv = wq[q];
            if (idx < 47 * 32) { LAS float* d = ut + rr * 256 + cq * 8;
                *(LAS f32x4*)d = (f32x4){bflo(wv.x), bfhi(wv.x), bflo(wv.y), bfhi(wv.y)}; *(LAS f32x4*)(d + 4) = (f32x4){bflo(wv.z), bfhi(wv.z), bflo(wv.w), bfhi(wv.w)}; } }
        if (tile + G < NTOK / 32) POOL_LOAD(tile + G);
        __syncthreads();
        { float s = 0.f; const int rr0 = half * 16 + 15;
            for (int j = 1; j < w; ++j) s += ut[(rr0 - j) * 256 + ch];
#pragma unroll 4
            for (int tt = 0; tt < 16; ++tt) { const int ti = half * 16 + tt, rr = ti + 15, pos = s0 + ti; const float cur = ut[rr * 256 + ch];
                s += cur; const int cnt = (pos + 1 < w) ? pos + 1 : w;
                pl[ti * 256 + ch] = s / (float)cnt - cur; s -= ut[(rr - w + 1) * 256 + ch]; } }
        __syncthreads();
#pragma unroll 1
        for (int tt = 0; tt < 16; ++tt) { const int ti = half * 16 + tt; const LAS f32x4* pr = (const LAS f32x4*)(pl + ti * 256 + g * 64);
            float acc = 0.f;
#pragma unroll
            for (int c4 = 0; c4 < 16; ++c4) { const f32x4 v = pr[c4]; acc += (v[0] * wcol[4 * c4] + v[1] * wcol[4 * c4 + 1]) + (v[2] * wcol[4 * c4 + 2] + v[3] * wcol[4 * c4 + 3]); }
            ut[ti * 256 + ch] = acc * psc; }
        __syncthreads();
#pragma unroll
        for (int q = 0; q < 4; ++q) { const int ti = wave * 4 + q; const f32x4 v = *(const LAS f32x4*)(ut + ti * 256 + 4 * lane);
            const float ss = wave_sum((v[0] * v[0] + v[1] * v[1]) + (v[2] * v[2] + v[3] * v[3]));
            const float rstd = 1.0f / sqrtf(ss * (1.f / 256.f) + EPSN);
            u32x2 o; o.x = pk2(v[0] * rstd * gn[0], v[1] * rstd * gn[1]); o.y = pk2(v[2] * rstd * gn[2], v[3] * rstd * gn[3]);
            *(u32x2*)(MG + (size_t)(tok0 + ti) * DM + 512 + 4 * lane) = o; }
        __syncthreads();
    }
}

template <bool PASS2> __device__ __forceinline__ void phase_s5(KArgs a, int l, const bf16* PS, float* XLOC, bf16* Z, LAS unsigned char* lds, int G, int bx, int lane, int wave) {
    LAS float* Xs = (LAS float*)(lds + wave * (16 * 130 * 4));
    const int p = lane, kq = lane >> 4, ln = lane & 15;
    for (int task = bx; task < NB * 16 * 8; task += G) {
        const int b = task >> 7, g = (task >> 3) & 15, c = (task & 7) * 8 + wave;
        const size_t tok_c = (size_t)b * SEQ + c * 64;
        const float a_re = a->in[8][(l * 16 + g) * 64 + p], a_im = a->in[9][(l * 16 + g) * 64 + p], ldt = a->in[10][l * 16 + g];
        u32x2 uraw[4];
#pragma unroll
        for (int sub = 0; sub < 4; ++sub) uraw[sub] = *(const u32x2*)(PS + (tok_c + sub * 16 + ln) * 512 + 256 + g * 16 + 4 * kq);
        float braw[4][4], biaw[4][4];
#pragma unroll
        for (int q = 0; q < 4; ++q)
#pragma unroll
            for (int ks = 0; ks < 4; ++ks) { const size_t bi = ((size_t)((l * 16 + g) * 64 + 16 * q + ln)) * 16 + 4 * kq + ks; braw[q][ks] = a->in[11][bi]; biaw[q][ks] = a->in[12][bi]; }
        float cfrag[32]; float dsk = 0.f; unsigned short usk[16];
        if (PASS2) {
#pragma unroll
            for (int ks = 0; ks < 32; ++ks) { const int k = 4 * ks + kq, pp = k & 63; const size_t ci = ((size_t)((l * 16 + g) * 16 + ln)) * 64 + pp;
                cfrag[ks] = (ks < 16) ? a->in[13][ci] : -a->in[14][ci]; }
            dsk = a->in[15][l * 256 + g * 16 + ln];
#pragma unroll
            for (int i = 0; i < 16; ++i) usk[i] = PS[(tok_c + (i >> 2) * 16 + 4 * kq + (i & 3)) * 512 + 256 + g * 16 + ln];
        }
        const float dt = expf(ldt);
        float abr, abi, fr, fi;
        { const float xx = a_re * dt, yy = a_im * dt; const float ex = expf(xx); float sn, cs; sincosf(yy, &sn, &cs);
          abr = ex * cs; abi = ex * sn;
          const float sh = sinf(0.5f * yy); const float er = expm1f(xx) * cs - 2.f * sh * sh, ei = abi;
          const float den = a_re * a_re + a_im * a_im; fr = (er * a_re + ei * a_im) / den; fi = (ei * a_re - er * a_im) / den; }
        float bfrag[8][4];
#pragma unroll
        for (int q = 0; q < 4; ++q) { const float frq = __shfl(fr, 16 * q + ln), fiq = __shfl(fi, 16 * q + ln);
#pragma unroll
            for (int ks = 0; ks < 4; ++ks) { bfrag[q][ks] = frq * braw[q][ks] - fiq * biaw[q][ks]; bfrag[4 + q][ks] = frq * biaw[q][ks] + fiq * braw[q][ks]; } }
        float xr = 0.f, xi = 0.f;
        if (PASS2) {
            float pr = abr, pi = abi;
#pragma unroll
            for (int q = 0; q < 6; ++q) { const float nr = pr * pr - pi * pi, ni = 2.f * pr * pi; pr = nr; pi = ni; }
            const float* xl = XLOC + ((size_t)(b * 16 + g) * 64) * 128 + p;
            int j = 0;
#pragma unroll 1
            for (; j + 16 <= c; j += 16) { float lr[16], li[16];
#pragma unroll
                for (int q = 0; q < 16; ++q) { lr[q] = xl[(size_t)(j + q) * 128]; li[q] = xl[(size_t)(j + q) * 128 + 64]; }
#pragma unroll
                for (int q = 0; q < 16; ++q) { const float nr = pr * xr - pi * xi + lr[q], ni = pr * xi + pi * xr + li[q]; xr = nr; xi = ni; } }
            { float lr[16], li[16];
#pragma unroll
                for (int q = 0; q < 16; ++q) { const int jj = (j + q < c) ? j + q : 0; lr[q] = xl[(size_t)jj * 128]; li[q] = xl[(size_t)jj * 128 + 64]; }
#pragma unroll
                for (int q = 0; q < 16; ++q) if (j + q < c) { const float nr = pr * xr - pi * xi + lr[q], ni = pr * xi + pi * xr + li[q]; xr = nr; xi = ni; } }
        }
#pragma unroll
        for (int sub = 0; sub < 4; ++sub) {
            const size_t tokb = tok_c + sub * 16;
            const float ua[4] = {bflo(uraw[sub].x), bfhi(uraw[sub].x), bflo(uraw[sub].y), bfhi(uraw[sub].y)};
#pragma unroll
            for (int nb = 0; nb < 8; ++nb) { f32x4 acc = {0.f, 0.f, 0.f, 0.f};
#pragma unroll
                for (int ks = 0; ks < 4; ++ks) acc = __builtin_amdgcn_mfma_f32_16x16x4f32(ua[ks], bfrag[nb][ks], acc, 0, 0, 0);
#pragma unroll
                for (int r = 0; r < 4; ++r) Xs[(4 * kq + r) * 130 + 16 * nb + ln] = acc[r]; }
            float bur[16], bui[16];
#pragma unroll
            for (int i = 0; i < 16; ++i) { bur[i] = Xs[i * 130 + p]; bui[i] = Xs[i * 130 + 64 + p]; }
#pragma unroll
            for (int i = 0; i < 16; ++i) { const float nr = abr * xr - abi * xi + bur[i], ni = abr * xi + abi * xr + bui[i]; xr = nr; xi = ni;
                if (PASS2) { Xs[i * 130 + p] = xr; Xs[i * 130 + 64 + p] = xi; } }
            if (PASS2) {
                f32x4 y0 = {0.f, 0.f, 0.f, 0.f}, y1 = {0.f, 0.f, 0.f, 0.f};
#pragma unroll
                for (int ks = 0; ks < 32; ks += 2) { y0 = __builtin_amdgcn_mfma_f32_16x16x4f32(Xs[ln * 130 + 4 * ks + kq], cfrag[ks], y0, 0, 0, 0);
                    y1 = __builtin_amdgcn_mfma_f32_16x16x4f32(Xs[ln * 130 + 4 * (ks + 1) + kq], cfrag[ks + 1], y1, 0, 0, 0); }
#pragma unroll
                for (int r = 0; r < 4; ++r) { const size_t tk = tokb + 4 * kq + r; const float uv = bf2f(usk[sub * 4 + r]);
                    const float y = y0[r] + y1[r] + dsk * uv; Z[tk * 256 + g * 16 + ln] = (bf16)f2bf(gelu_tanh(y)); }
            }
        }
        if (!PASS2) { float* xl = XLOC + ((size_t)((b * 16 + g) * 64 + c)) * 128 + p; xl[0] = xr; xl[64] = xi; }
    }
}

__device__ __forceinline__ void phase_glu(const bf16* Z, const bf16* WG, const float* gb, const float* ong, bf16* MG, LAS unsigned char* lds, int G, int bx, int vcu, int tid, int lane, int wave) {
    LAS unsigned char* zt = lds;
    LAS float* ssq = (LAS float*)(lds + 64 * 528);
    LAS float* rs = ssq + 64 * 8;
    const int n = 32 * wave + (lane & 31), hs = lane >> 5;
    const float bn = gb[n], gnn = ong[768 + n];
    for (int tile = bx; tile < NTOK / 64; tile += G) {
        const size_t tok0 = (size_t)tile * 64;
        for (int idx = tid; idx < 64 * 32; idx += NTHR) { const int r = idx >> 5, cq = idx & 31; *(LAS v4u*)(zt + r * 528 + cq * 16) = *(const v4u*)(Z + (tok0 + r) * 256 + cq * 8); }
        __syncthreads();
        f32x16 acc[2]; acc[0] = f32x16{}; acc[1] = f32x16{};
#pragma unroll
        for (int ks = 0; ks < 16; ++ks) { const bf16x8 bw = *(const bf16x8*)(WG + (size_t)n * 256 + ks * 16 + 8 * hs);
#pragma unroll
            for (int mb = 0; mb < 2; ++mb) { const bf16x8 az = *(const LAS bf16x8*)(zt + (mb * 32 + (lane & 31)) * 528 + (ks * 16 + 8 * hs) * 2);
                acc[mb] = __builtin_amdgcn_mfma_f32_32x32x16_bf16(az, bw, acc[mb], 0, 0, 0); } }
        float val[32], sq[32];
#pragma unroll
        for (int mb = 0; mb < 2; ++mb)
#pragma unroll
            for (int r = 0; r < 16; ++r) { const int m = mb * 32 + (r & 3) + 8 * (r >> 2) + 4 * hs; const float z = bf2f(*(const LAS unsigned short*)(zt + m * 528 + n * 2));
                const float v = z / (1.f + __expf(-(acc[mb][r] + bn))); val[mb * 16 + r] = v; sq[mb * 16 + r] = v * v; }
        const float tot = bfly_reduce<32, 16>(sq, lane);
        { const int id = lane & 31, mb = id >> 4, r = id & 15, m = mb * 32 + (r & 3) + 8 * (r >> 2) + 4 * hs; ssq[m * 8 + wave] = tot; }
        __syncthreads();
        if (tid < 64) { float s = 0.f;
#pragma unroll
            for (int w8 = 0; w8 < 8; ++w8) s += ssq[tid * 8 + w8];
            rs[tid] = 1.0f / sqrtf(s * (1.f / 256.f) + EPSN); }
        __syncthreads();
#pragma unroll
        for (int mb = 0; mb < 2; ++mb)
#pragma unroll
            for (int r = 0; r < 16; ++r) { const int m = mb * 32 + (r & 3) + 8 * (r >> 2) + 4 * hs;
                MG[(tok0 + m) * DM + 768 + n] = (bf16)f2bf(val[mb * 16 + r] * rs[m] * gnn); }
        __syncthreads();
    }
    const int gw = vcu * NWAVES + wave, NGW = G * NWAVES;
    float g8[8];
#pragma unroll
    for (int j = 0; j < 8; ++j) g8[j] = ong[8 * lane + j];
    for (int row = gw; row < NTOK; row += NGW) {
        bf16* pp = MG + (size_t)row * DM + 8 * lane;
        const v4u w = *(const v4u*)pp; float f[8] = {bflo(w.x), bfhi(w.x), bflo(w.y), bfhi(w.y), bflo(w.z), bfhi(w.z), bflo(w.w), bfhi(w.w)};
        float s = 0.f;
#pragma unroll
        for (int j = 0; j < 8; ++j) s += f[j] * f[j];
        const float rstd = 1.0f / sqrtf(wave_sum(s) * (1.f / 512.f) + EPSN);
        v4u o; o.x = pk2(f[0] * rstd * g8[0], f[1] * rstd * g8[1]); o.y = pk2(f[2] * rstd * g8[2], f[3] * rstd * g8[3]);
        o.z = pk2(f[4] * rstd * g8[4], f[5] * rstd * g8[5]); o.w = pk2(f[6] * rstd * g8[6], f[7] * rstd * g8[7]); *(v4u*)pp = o;
    }
}

__device__ __forceinline__ void ins16(float (&top)[16], float x) {
#pragma unroll
    for (int i = 15; i >= 1; --i) top[i] = __builtin_amdgcn_fmed3f(top[i - 1], top[i], x);
    top[0] = fmaxf(top[0], x);
}
__device__ __forceinline__ float opq(float x) { asm("" : "+v"(x)); return x; }
__device__ __forceinline__ float tagf(float s, unsigned id, unsigned mask) { return __uint_as_float((__float_as_uint(s) & ~mask) | id); }
__device__ __forceinline__ void phase_select(const bf16* PQ, const bf16* KEYS, int* IDX, float* GATE, LAS unsigned char* lds, int G, int vcu, int tid, int lane, int wave) {
    constexpr int KROW = 272, KEYB = 2 * 128 * KROW;
    LAS unsigned* ids = (LAS unsigned*)(lds + KEYB + wave * 4096);
    const int tl = lane & 31, hs = lane >> 5;
    const float NEG = -__builtin_inff();
    const int nslot = (G >= 8) ? G / 8 : 1;
    for (int h = vcu % 8; h < 8; h += (G >= 8 ? 8 : G)) {
        __syncthreads();
        for (int idx = tid; idx < 2 * 128 * 16; idx += NTHR) { const int row = idx >> 4, cq = idx & 15;
            *(LAS v4u*)(lds + row * KROW + cq * 16) = *(const v4u*)((const char*)(KEYS + (size_t)h * 256 * 128) + (unsigned)(row * 256 + cq * 16)); }
        __syncthreads();
        const int slot = (G >= 8) ? vcu / 8 : 0;
        bf16x8 bq[2][8];
        int tb = slot * 8 + wave;
        if (tb < NTOK / 32) {
#pragma unroll
            for (int ks = 0; ks < 8; ++ks) bq[0][ks] = *(const bf16x8*)(PQ + ((size_t)tb * 32 + tl) * PQW + h * 256 + 8 * hs + ks * 16);
        }
#pragma unroll 1
        for (; tb < NTOK / 32; tb += 8 * nslot) {
            const size_t tok = (size_t)tb * 32 + tl;
            float t1[16], t2[16];
#pragma unroll
            for (int half = 0; half < 2; ++half) {
                { const int ntb = (half == 0) ? tb : tb + 8 * nslot; const int ntbc = (ntb < NTOK / 32) ? ntb : tb;
                  const bf16* qn = PQ + ((size_t)ntbc * 32 + tl) * PQW + h * 256 + (half == 0 ? 128 : 0) + 8 * hs;
#pragma unroll
                  for (int ks = 0; ks < 8; ++ks) bq[half ^ 1][ks] = *(const bf16x8*)(qn + ks * 16); }
                f32x16 acc[4]; acc[0] = f32x16{}; acc[1] = f32x16{}; acc[2] = f32x16{}; acc[3] = f32x16{};
                const LAS unsigned char* kp = lds + (half * 128 + tl) * KROW + 16 * hs;
#pragma unroll
                for (int ks = 0; ks < 8; ++ks)
#pragma unroll
                    for (int kb = 0; kb < 4; ++kb) { const bf16x8 ak = *(const LAS bf16x8*)(kp + kb * 32 * KROW + ks * 32); acc[kb] = __builtin_amdgcn_mfma_f32_32x32x16_bf16(ak, bq[half][ks], acc[kb], 0, 0, 0); }
                float top[16];
#pragma unroll
                for (int i = 0; i < 16; ++i) top[i] = NEG;
#pragma unroll
                for (int kb = 0; kb < 4; ++kb)
#pragma unroll
                    for (int r = 0; r < 16; ++r) ins16(top, tagf(acc[kb][r], (unsigned)(32 * kb + (r & 3) + 8 * (r >> 2) + 4 * hs), 127u));
                float oth[16];
#pragma unroll
                for (int i = 0; i < 16; ++i) oth[i] = __shfl_xor(top[i], 32);
#pragma unroll
                for (int i = 0; i < 16; ++i) ins16(top, oth[i]);
#pragma unroll
                for (int i = 0; i < 16; ++i) { if (half == 0) t1[i] = top[i]; else t2[i] = top[i]; }
            }
#pragma unroll
            for (int i = 0; i < 16; ++i) ids[(tl * 2 + hs) * 16 + i] = __float_as_uint(hs ? opq(t2[i]) : opq(t1[i])) & 127u;
            float best[16];
#pragma unroll
            for (int i = 0; i < 16; ++i) best[i] = NEG;
#define CAND(a0, b0, a1, b1) { const float s0_ = opq(t1[a0] + t2[b0]), s1_ = opq(t1[a1] + t2[b1]); ins16(best, hs ? tagf(s1_, (unsigned)((a1) * 16 + (b1)), 255u) : tagf(s0_, (unsigned)((a0) * 16 + (b0)), 255u)); }
            CAND_LIST
#undef CAND
            { float oth[16];
#pragma unroll
              for (int i = 0; i < 16; ++i) oth[i] = __shfl_xor(best[i], 32);
#pragma unroll
              for (int i = 0; i < 16; ++i) ins16(best, oth[i]); }
            float e[16], den = 0.f;
#pragma unroll
            for (int i = 0; i < 16; ++i) { e[i] = __expf(best[i] - best[0]); den += e[i]; }
            const float rden = 1.f / den;
            int ex[8]; float gt[8];
#pragma unroll
            for (int j = 0; j < 8; ++j) { const float bj = hs ? opq(best[8 + j]) : opq(best[j]); const unsigned id = __float_as_uint(bj) & 255u;
                const unsigned i1 = ids[(tl * 2 + 0) * 16 + (id >> 4)], i2 = ids[(tl * 2 + 1) * 16 + (id & 15u)];
                ex[j] = (int)(i1 * 128u + i2); gt[j] = (hs ? opq(e[8 + j]) : opq(e[j])) * rden; }
            int* ip = IDX + tok * 128 + h * 16 + hs * 8; float* gp = GATE + tok * 128 + h * 16 + hs * 8;
            *(v4u*)ip = (v4u){(unsigned)ex[0], (unsigned)ex[1], (unsigned)ex[2], (unsigned)ex[3]}; *(v4u*)(ip + 4) = (v4u){(unsigned)ex[4], (unsigned)ex[5], (unsigned)ex[6], (unsigned)ex[7]};
            *(f32x4*)gp = (f32x4){gt[0], gt[1], gt[2], gt[3]}; *(f32x4*)(gp + 4) = (f32x4){gt[4], gt[5], gt[6], gt[7]};
        }
    }
}

constexpr int GCH = 32;
constexpr int CW_Q = 8192;
template <int CTRL> __device__ __forceinline__ float dpp_mov(float v) { return __builtin_bit_cast(float, __builtin_amdgcn_update_dpp(0, __builtin_bit_cast(int, v), CTRL, 0xF, 0xF, true)); }
__device__ __forceinline__ float sum8(float s) {
    s += dpp_mov<0xB1>(s); s += dpp_mov<0x4E>(s); s += dpp_mov<0x141>(s); return s;
}
__device__ __forceinline__ void phase_gather_u(const unsigned char* XN8, const int* IDX, const unsigned char* U, float* PART, unsigned* queue, int lane, unsigned imask = 0xffffffffu) {
    const unsigned xcc = xb_xcc_id() & 7u; const int g = lane >> 3, j = lane & 7;
#pragma unroll 1
    for (unsigned sx = 0; sx < 8; ++sx) { const unsigned x = (xcc + sx) & 7u; unsigned* q = queue + x * 64;
        const unsigned char* Ux = U + (size_t)x * NEXP * 128; const unsigned jo = (unsigned)j * 16u, lane4 = (unsigned)lane * 4u; const unsigned char* Hx = XN8 + x * 128 + j * 16; const int* Ig = IDX + 16 * g;
#pragma unroll 1
        for (;;) {
            unsigned c = 0; if (lane == 0) c = __hip_atomic_fetch_add(q, 1u, __ATOMIC_RELAXED, __HIP_MEMORY_SCOPE_AGENT);
            c = (unsigned)__builtin_amdgcn_readfirstlane((int)c); if (c >= (unsigned)(NTOK / GCH)) break;
            const size_t tb = (size_t)c * GCH;
            v4u ix[2][4], hw[2], rw[16];
#define G1_IDX(ib, tok_) do { _Pragma("unroll") for (int q4 = 0; q4 < 4; ++q4) ix[ib][q4] = *(const v4u*)(Ig + (tok_) * 128 + 4 * q4) & imask; } while (0)
#define G1_AUX(ab, tok_) do { hw[ab] = *(const v4u*)(Hx + (tok_) * DM); } while (0)
#define G1_TOKEN(p, tt_) do { G1_AUX((p) ^ 1, tb + (((tt_) + 1 < GCH) ? (tt_) + 1 : (tt_))); \
            const v4u hq_ = hw[p]; int r0 = 0, r1 = 0; \
            _Pragma("unroll") for (int i = 0; i < 16; ++i) { const v4u rv_ = rw[i]; \
                rw[i] = *(const v4u*)(Ux + (ix[(p) ^ 1][i >> 2][i & 3] * 128u + jo)); \
                int s = __builtin_amdgcn_sdot4((int)hq_[0], (int)rv_[0], 0, false); s = __builtin_amdgcn_sdot4((int)hq_[1], (int)rv_[1], s, false); \
                s = __builtin_amdgcn_sdot4((int)hq_[2], (int)rv_[2], s, false); s = __builtin_amdgcn_sdot4((int)hq_[3], (int)rv_[3], s, false); \
                s += __builtin_amdgcn_update_dpp(0, s, 0xB1, 0xF, 0xF, true); s += __builtin_amdgcn_update_dpp(0, s, 0x4E, 0xF, 0xF, true); s += __builtin_amdgcn_update_dpp(0, s, 0x141, 0xF, 0xF, true); \
                if (i < 8) r0 = ((i & 7) == j) ? s : r0; else r1 = ((i & 7) == j) ? s : r1; } \
            float* pp = PART + ((size_t)x * NTOK + tb + (tt_)) * 128; *(float*)((char*)pp + lane4) = (float)r0; *(float*)((char*)(pp + 64) + lane4) = (float)r1; \
            G1_IDX(p, tb + (((tt_) + 2 < GCH) ? (tt_) + 2 : (tt_))); } while (0)
            G1_IDX(0, tb); G1_IDX(1, tb + 1); G1_AUX(0, tb);
#pragma unroll
            for (int i = 0; i < 16; ++i) rw[i] = *(const v4u*)(Ux + (ix[0][i >> 2][i & 3] * 128u + jo));
#pragma unroll 1
            for (int tt = 0; tt < GCH; tt += 2) { G1_TOKEN(0, tt); G1_TOKEN(1, tt + 1); }
#undef G1_IDX
#undef G1_AUX
#undef G1_TOKEN
        }
    }
}
__device__ __forceinline__ void phase_gather_act(const float* PART, const float* GATE, const float* HSC, float* ACT, int G, int vcu, int tid) {
    const size_t gt = (size_t)vcu * NTHR + tid, NGT = (size_t)G * NTHR;
    for (size_t e4 = gt; e4 < (size_t)NTOK * 32; e4 += NGT) { const size_t tok = e4 >> 5; const int p = (int)(e4 & 31) * 4;
        f32x4 s = *(const f32x4*)(PART + e4 * 4);
#pragma unroll
        for (int x = 1; x < 8; ++x) s += *(const f32x4*)(PART + (size_t)x * NTOK * 128 + e4 * 4);
        const int k = (p < 64) ? 16 * (p >> 3) + (p & 7) : 16 * ((p - 64) >> 3) + 8 + (p & 7);
        const f32x4 gv = *(const f32x4*)(GATE + tok * 128 + k);
        f32x4 o;
        const float ds = HSC[tok] * (1.f / U8_SCALE);
#pragma unroll
        for (int i = 0; i < 4; ++i) { const _Float16 ah = (_Float16)(gv[i] * gelu_tanh(s[i] * ds) * (ACT_SCALE / V8_SCALE)); const h16x2 a2 = {ah, ah}; o[i] = __builtin_bit_cast(float, a2); }
        *(f32x4*)(ACT + e4 * 4) = o; }
}
__device__ __forceinline__ void phase_gather_v(const float* ACT, const int* IDX, const unsigned char* V, float* out, unsigned* queue, int lane) {
    const unsigned xcc = xb_xcc_id() & 7u; const int g = lane >> 3, j = lane & 7;
    typedef float f32x2v __attribute__((ext_vector_type(2)));
#pragma unroll 1
    for (unsigned sx = 0; sx < 8; ++sx) { const unsigned x = (xcc + sx) & 7u; unsigned* q = queue + x * 64;
        const unsigned char* Vx = V + (size_t)x * NEXP * 128; const unsigned jo = (unsigned)j * 16u; const int* Ig = IDX + 16 * g; float* Ob = out + x * 128; const unsigned lo = (unsigned)(16 * j + 2 * g) * 4u;
#pragma unroll 1
        for (;;) {
            unsigned c = 0; if (lane == 0) c = __hip_atomic_fetch_add(q, 1u, __ATOMIC_RELAXED, __HIP_MEMORY_SCOPE_AGENT);
            c = (unsigned)__builtin_amdgcn_readfirstlane((int)c); if (c >= (unsigned)(NTOK / GCH)) break;
            const size_t tb = (size_t)c * GCH;
            v4u ix[2][4], rw[16]; float a0[2], a1[2]; f32x2v ov[2]; const int bsel = (lane & ~7) * 4; const unsigned lane4 = (unsigned)lane * 4u;
#define G3_IDX(ib, tok_) do { _Pragma("unroll") for (int q4 = 0; q4 < 4; ++q4) ix[ib][q4] = *(const v4u*)(Ig + (tok_) * 128 + 4 * q4); } while (0)
#define G3_AUX(ab, tok_) do { a0[ab] = *(const float*)((const char*)(ACT + (tok_) * 128) + lane4); a1[ab] = *(const float*)((const char*)(ACT + (tok_) * 128 + 64) + lane4); { unsigned lo_ = lo; asm volatile("" : "+v"(lo_)); ov[ab] = *(const f32x2v*)((const char*)(Ob + (tok_) * DM) + lo_); } } while (0)
#define G3_TOKEN(p, tt_) do { G3_AUX((p) ^ 1, tb + (((tt_) + 1 < GCH) ? (tt_) + 1 : (tt_))); \
            h16x2 hacc[8]; \
            _Pragma("unroll") for (int i = 0; i < 8; ++i) hacc[i] = (h16x2){(_Float16)0.f, (_Float16)0.f}; \
            _Pragma("unroll") for (int i = 0; i < 16; ++i) { const v4u rv_ = rw[i]; \
                rw[i] = *(const v4u*)(Vx + (ix[(p) ^ 1][i >> 2][i & 3] * 128u + jo)); \
                const float a = __builtin_bit_cast(float, __builtin_amdgcn_ds_bpermute(bsel + 4 * (i & 7), __builtin_bit_cast(int, (i < 8) ? a0[p] : a1[p])));   \
                const h16x2 a2 = __builtin_bit_cast(h16x2, a); \
                _Pragma("unroll") for (int q4 = 0; q4 < 4; ++q4) { const int w = (int)rv_[q4]; \
                    hacc[2 * q4] = __builtin_elementwise_fma(cvt8h<false>(w), a2, hacc[2 * q4]); \
                    hacc[2 * q4 + 1] = __builtin_elementwise_fma(cvt8h<true>(w), a2, hacc[2 * q4 + 1]); } } \
            float acc[16]; \
            _Pragma("unroll") for (int i = 0; i < 8; ++i) { acc[2 * i] = (float)hacc[i].x; acc[2 * i + 1] = (float)hacc[i].y; } \
            int s_ = 32; \
            _Pragma("unroll") for (int cnt = 16; cnt > 2; cnt >>= 1) { const bool up = (lane & s_) != 0; \
                _Pragma("unroll") for (int i = 0; i < cnt / 2; ++i) { const float a = acc[i], b = acc[i + cnt / 2]; const float send = up ? a : b, keep = up ? b : a; acc[i] = keep + __shfl_xor(send, s_); } \
                s_ >>= 1; } \
            f32x2v o = ov[p]; o[0] += acc[0] * (1.f / ACT_SCALE); o[1] += acc[1] * (1.f / ACT_SCALE); \
            { unsigned lo_ = lo; asm volatile("" : "+v"(lo_)); *(f32x2v*)((char*)(Ob + (tb + (tt_)) * DM) + lo_) = o; } \
            G3_IDX(p, tb + (((tt_) + 2 < GCH) ? (tt_) + 2 : (tt_))); } while (0)
            G3_IDX(0, tb); G3_IDX(1, tb + 1); G3_AUX(0, tb);
#pragma unroll
            for (int i = 0; i < 16; ++i) rw[i] = *(const v4u*)(Vx + (ix[0][i >> 2][i & 3] * 128u + jo));
#pragma unroll 1
            for (int tt = 0; tt < GCH; tt += 2) { G3_TOKEN(0, tt); G3_TOKEN(1, tt + 1); }
#undef G3_IDX
#undef G3_AUX
#undef G3_TOKEN
        }
    }
}

__device__ __forceinline__ void phase_gather_naive(const bf16* XN, const int* IDX, const float* GATE, const float* U, const float* V, float* out, int G, int vcu, int lane, int wave) {
    const int gw = vcu * NWAVES + wave, NGW = G * NWAVES;
    for (int tok = gw; tok < NTOK; tok += NGW) {
        float hv[16], acc[16];
#pragma unroll
        for (int j = 0; j < 16; ++j) { hv[j] = bf2f(XN[(size_t)tok * DM + lane + 64 * j]); acc[j] = 0.f; }
        for (int k = 0; k < 128; ++k) { const int e = IDX[(size_t)tok * 128 + k]; const float g = GATE[(size_t)tok * 128 + k];
            float s = 0.f;
#pragma unroll
            for (int j = 0; j < 16; ++j) s += hv[j] * U[(size_t)e * DM + lane + 64 * j];
            s = wave_sum(s); const float a = g * gelu_tanh(s);
#pragma unroll
            for (int j = 0; j < 16; ++j) acc[j] += a * V[(size_t)e * DM + lane + 64 * j]; }
#pragma unroll
        for (int j = 0; j < 16; ++j) out[(size_t)tok * DM + lane + 64 * j] += acc[j];
    }
}
constexpr int PH_PER_LAYER = 15, N_PHASES = 1 + 2 * PH_PER_LAYER;
__device__ __forceinline__ KArgs kargs() { KArgs p = (KArgs)__builtin_amdgcn_kernarg_segment_ptr(); asm volatile("" : "+s"(p)); return p; }
__global__ void __launch_bounds__(NTHR, 2) mega_fwd(Args a_unused) {
    extern __shared__ __attribute__((aligned(16))) unsigned char lds_raw[];
    LAS unsigned char* lds = (LAS unsigned char*)lds_raw;
    volatile LAS unsigned* MISC = (volatile LAS unsigned*)(lds + MISC_OFF);
    const int tid0 = threadIdx.x;
    for (int u = tid0; u < (LDS_BYTES - LDSCTL_OFF) / 4; u += NTHR) ((LAS unsigned*)(lds + LDSCTL_OFF))[u] = 0u;
    __syncthreads();
    { const unsigned hw = (unsigned)__builtin_amdgcn_s_getreg((6 << 11) | 4); if ((tid0 & 63) == 0) *(volatile LAS int*)(lds + OTID_LDS_OFF + 4 * (hw & 63u)) = tid0 >> 6; }
    __syncthreads();
    XcdBarrier bar; { KArgs ka = kargs(); unsigned char* ws0 = ka->ws; bar.bar = (unsigned*)(ws0 + WS_CTL) + CW_BAR; bar.x = 0; bar.st = nullptr;
      if (ka->use_bar) bar = xcd_barrier_post((unsigned*)(ws0 + WS_CTL) + CW_BAR, MISC + 8); }
    const int ph_lo = kargs()->ph_lo, ph_hi = kargs()->ph_hi;
#define TLW const int tid = otid(), lane = tid & 63, wave = __builtin_amdgcn_readfirstlane(tid >> 6); (void)tid; (void)lane; (void)wave;
#pragma unroll 1
    for (int pc = ph_lo; pc < ph_hi + (DUP_PH >= 0 ? 1 : 0); ++pc) {
        const int ph = (DUP_PH >= 0 && pc > DUP_PH) ? pc - 1 : pc;
        unsigned long long tph0_ = 0; if (TIME_PH >= 0 && (pc == TIME_PH || TIME_PH == 99)) tph0_ = __builtin_amdgcn_s_memrealtime();
        KArgs a = kargs(); unsigned char* ws = a->ws;
        int G = gridDim.x, bx = blockIdx.x; asm volatile("" : "+s"(G), "+s"(bx)); const int vcu = (G % 8 == 0) ? (bx % 8) * (G / 8) + bx / 8 : bx;
        bf16* const XN = (bf16*)(ws + WS_XN); bf16* const Pq = (bf16*)(ws + WS_P); bf16* const Pk = Pq + (size_t)NTOK * 512; bf16* const Pv = Pk + (size_t)NTOK * 512; bf16* const Ps = Pv + (size_t)NTOK * 512;
        bf16* const MG = (bf16*)(ws + WS_MG); float* const CB = (float*)(ws + WS_CB); float* const XLOC = (float*)(ws + WS_XLOC); bf16* const Z = (bf16*)(ws + WS_Z);
        int* const IDX = (int*)(ws + WS_IDX); float* const GATE = (float*)(ws + WS_GATE);
        if (ph == 0) { TLW if (PH_MASK & 1u) phase_prep(a, lds, G, vcu, tid, lane, wave); }
        else {
            const int l = (ph - 1) / PH_PER_LAYER, sub = (ph - 1) % PH_PER_LAYER;
            const float* xin = (l == 0) ? a->in[0] : a->out;
            switch (sub) {
            case 0: if (PH_MASK & (1u << 1)) { TLW phase_rownorm<true>(xin, a->in[1] + l * DM, XN, (const float*)(ws + WS_WF) + l * 8 * 1024, a->in[3] + l * 8, CB, G, vcu, lane, wave); } break;
            case 1: if (PH_MASK & (1u << 2)) { TLW
                { float* CBm = CB; const int gw_ = vcu * NWAVES + wave; if (gw_ < NB * NH) phase_cumsum(CBm + (size_t)gw_ * SEQ, lane); }
                pg8::Gemm g{XN, (const bf16*)(ws + WS_WIN) + (size_t)l * 2048 * 1024, NTOK, 2048, 1024}; pg8::StaticOrder S; S.init(NTOK, 2048, G, bx);
                pg8::EpiQKVN E{Pq, (size_t)NTOK * 512, a->in[4] + l * 64, a->in[5] + l * 64, (PG8_LAS float*)(lds + EPIX_OFF), EPSN, 0.125f * LOG2E};
                pg8::gemm_phase<pg8::EpiQKVN, pg8::StaticOrder, true, true>(lds, g, S, E); } break;
            case 2: break;
            case 5: if (PH_MASK & (1u << 4)) { TLW { const float gq = wave_max(fabsf(a->in[4][l * 64 + lane])), gk = wave_max(fabsf(a->in[5][l * 64 + lane]));
                const float qkb = 8.f * gq * gk * LOG2E * 1.02f + 0.25f;
                const attn_body::AttnTensors AT{(const attn_body::bf16*)Pq, (const attn_body::bf16*)Pk, (const attn_body::bf16*)Pv, (attn_body::bf16*)MG, CB, qkb};
                attn_body::attn_phase_q<ATT_SKIP>((char*)lds_raw, AT, (unsigned*)(ws + WS_CTL) + CW_AQ + l * 512); } } break;
            case 3: if (PH_MASK & (1u << 5)) { TLW phase_pool(Ps, a->in[6] + (size_t)l * 4 * 64 * 64, a->in[7] + l * 256, a->in[18] + l * DM, MG, lds, G, bx, tid, lane, wave); } break;
            case 4: if (PH_MASK & (1u << 6)) { TLW phase_s5<false>(a, l, Ps, XLOC, Z, lds, G, bx, lane, wave); } break;
            case 6: if (PH_MASK & (1u << 7)) { TLW phase_s5<true>(a, l, Ps, XLOC, Z, lds, G, bx, lane, wave); } break;
            case 7: if (PH_MASK & (1u << 8)) { TLW phase_glu(Z, (const bf16*)(ws + WS_WGLU) + (size_t)l * 256 * 256, a->in[17] + l * 256, a->in[18] + l * DM, MG, lds, G, bx, vcu, tid, lane, wave); } break;
            case 8: if (PH_MASK & (1u << 9)) { pg8::Gemm g{MG, (const bf16*)(ws + WS_WOUT) + (size_t)l * 1024 * 1024, NTOK, 1024, 1024}; pg8::StaticOrder S; S.init(NTOK, 1024, G, bx);
                pg8::EpiResF32 E{xin, a->out, DM};
                pg8::gemm_phase<pg8::EpiResF32, pg8::StaticOrder, true, true>(lds, g, S, E); } break;
            case 9: if (PH_MASK & (1u << 10)) { TLW phase_rownorm<false>(a->out, a->in[20] + l * DM, XN, nullptr, nullptr, nullptr, G, vcu, lane, wave, ws + WS_XN8, (float*)(ws + WS_HSC)); } break;
            case 10: if (PH_MASK & (1u << 11)) { pg8::Gemm g{XN, (const bf16*)(ws + WS_WQ) + (size_t)l * 2048 * 1024, NTOK, 2048, 1024}; pg8::StaticOrder S; S.init(NTOK, 2048, G, bx);
                pg8::EpiBf16<0> E{Pq, PQW, nullptr, 0, 0, 1.f};
                pg8::gemm_phase<pg8::EpiBf16<0>, pg8::StaticOrder, true, true>(lds, g, S, E); } break;
            case 11: if (PH_MASK & (1u << 12)) { TLW phase_select(Pq, (const bf16*)(ws + WS_KEYS) + (size_t)l * 8 * 2 * 128 * 128, IDX, GATE, lds, G, vcu, tid, lane, wave); } break;
            case 12: if (PH_MASK & (1u << 13)) { TLW phase_gather_u(ws + WS_XN8, IDX, (const unsigned char*)(ws + WS_U) + (size_t)l * NEXP * DM, (float*)(ws + WS_P), (unsigned*)(ws + WS_CTL) + CW_Q + (l * 2 + 0) * 512 + ((DUP_PH >= 0 && pc == DUP_PH + 1) ? 4096 : 0), lane, (DUP_PH >= 0 && pc == DUP_PH) ? DIAG_IMASK : 0xffffffffu); } break;
            case 13: if (PH_MASK & (1u << 14)) { TLW phase_gather_act((const float*)(ws + WS_P), GATE, (const float*)(ws + WS_HSC), (float*)(ws + WS_Z), G, vcu, tid); } break;
            default: if (PH_MASK & (1u << 15)) { TLW phase_gather_v((const float*)(ws + WS_Z), IDX, (const unsigned char*)(ws + WS_V) + (size_t)l * NEXP * DM, a->out, (unsigned*)(ws + WS_CTL) + CW_Q + (l * 2 + 1) * 512, lane); } break;
            }
        }
        const int subb_ = (ph >= 1) ? (ph - 1) % PH_PER_LAYER : -1;
        if (pc + 1 < ph_hi + (DUP_PH >= 0 ? 1 : 0) && (MK_ONE_LAUNCH == 0 || (subb_ != 2 && subb_ != 3 && subb_ != 4))) { XcdBarrier b2 = bar; asm volatile("" : "+s"(b2.bar)); xcd_barrier(b2);
            if (TIME_PH >= 0 && (pc == TIME_PH || TIME_PH == 99)) { const unsigned long long t1_ = __builtin_amdgcn_s_memrealtime(), te_ = t1_ + TIME_MUL * (t1_ - tph0_); while (__builtin_amdgcn_s_memrealtime() < te_) __builtin_amdgcn_s_sleep(8); } }
    }
}

extern "C" void kernel_launch(void* const* d_in, const int* in_sizes, int n_in, void* d_out, int out_size, void* d_ws, size_t ws_size, hipStream_t stream) {
    static int grid = 0;
    if (grid == 0) {
        if (n_in != 25 || in_sizes[0] != NTOK * DM || out_size != NTOK * DM || ws_size < WS_END) {
            fprintf(stderr, "kernel_launch: unexpected problem: n_in %d in0 %d out %d ws %zu (need %zu); nothing launched\n", n_in, n_in > 0 ? in_sizes[0] : -1, out_size, ws_size, (size_t)WS_END); grid = -1; return; }
        int dev = 0, cus = 0;
        if (hipGetDevice(&dev) != hipSuccess || hipDeviceGetAttribute(&cus, hipDeviceAttributeMultiprocessorCount, dev) != hipSuccess) { fprintf(stderr, "kernel_launch: device query failed\n"); grid = -1; return; }
        if (hipFuncSetAttribute((const void*)mega_fwd, hipFuncAttributeMaxDynamicSharedMemorySize, LDS_BYTES) != hipSuccess) { fprintf(stderr, "kernel_launch: hipFuncSetAttribute failed\n"); grid = -1; return; }
        (void)hipGetLastError();
        grid = cus;
    }
    if (grid < 0) return;
    (void)hipMemsetAsync((char*)d_ws + WS_CTL, 0, CTL_ZERO_BYTES, stream);
    Args a{};
    for (int i = 0; i < 25; ++i) a.in[i] = (const float*)d_in[i];
    a.out = (float*)d_out; a.ws = (unsigned char*)d_ws;
#if MK_ONE_LAUNCH
    a.ph_lo = 0; a.ph_hi = N_PHASES; a.use_bar = 1;
    hipLaunchKernelGGL(mega_fwd, dim3(grid), dim3(NTHR), LDS_BYTES, stream, a);
#else
    for (int ph = 0; ph < N_PHASES; ++ph) { a.ph_lo = ph; a.ph_hi = ph + 1; a.use_bar = 0;
        hipLaunchKernelGGL(mega_fwd, dim3(grid), dim3(NTHR), LDS_BYTES, stream, a); }
#endif
    const hipError_t le = hipPeekAtLastError();
    if (le != hipSuccess) fprintf(stderr, "kernel_launch: launch failed: %s\n", hipGetErrorName(le));
}
```

```cpp
#include <hip/hip_runtime.h>
#include <hip/hip_bf16.h>
#include <hip/hip_fp16.h>
#include <cstdio>
#include <cstdint>
#include <cmath>
#ifndef MK_ONE_LAUNCH
#define MK_ONE_LAUNCH 1
#endif
#ifndef ATT_SKIP
#define ATT_SKIP true
#endif
#ifndef PH_MASK
#define PH_MASK 0xffffffffu
#endif
#define OTID_LDS_OFF (131072 + 1024)
__device__ __forceinline__ int otid() {
    int z = 0; asm volatile("" : "+v"(z)); const int lane = __builtin_amdgcn_mbcnt_hi(-1, __builtin_amdgcn_mbcnt_lo(-1, z));
    const unsigned hw = (unsigned)__builtin_amdgcn_s_getreg((6 << 11) | 4);
    const int wv = *(const volatile __attribute__((address_space(3))) int*)(OTID_LDS_OFF + 4 * (hw & 63u));
    return (__builtin_amdgcn_readfirstlane(wv) << 6) | lane;
}
#ifndef GATHER_NAIVE
#define GATHER_NAIVE 0
#endif
#ifndef DUP_PH
#define DUP_PH (-1)
#endif
#ifndef TIME_PH
#define TIME_PH (-1)
#define TIME_MUL 3
#endif
#ifndef DIAG_IMASK
#define DIAG_IMASK 0xffu
#endif
#ifndef S5_CPROJ_F32
#define S5_CPROJ_F32 1
#endif
namespace pg8 {
#define PG8_LAS __attribute__((address_space(3)))
typedef unsigned short bf16_t;
typedef short bf16x8 __attribute__((ext_vector_type(8)));
typedef float f32x4 __attribute__((ext_vector_type(4)));
typedef unsigned u32x4 __attribute__((ext_vector_type(4)));
constexpr int BM = 256, BK = 64, HALF = 128, HTB = HALF * BK * 2  , STAGE_BYTES = 8 * HTB, NXCD = 8, WGM = 8;

__host__ __device__ __forceinline__ int lds_byte(int r, int c) { const int st = (r >> 4) * 2 + (c >> 5), rr = r & 15, cc = c & 31, ob = rr * 64 + cc * 2; return st * 1024 + (ob ^ (((ob >> 9) & 1) << 5)); }
__host__ __device__ __forceinline__ void stage_rc(int b, int& R, int& C) { const int st = b / 1024, sb = b % 1024, swz = sb ^ (((sb >> 9) & 1) << 5); R = (st >> 1) * 16 + swz / 64; C = (st & 1) * 32 + (swz % 64) / 2; }
__host__ __device__ __forceinline__ int perm32(int rho) { const int n = rho >> 4, i = rho & 15; return 8 * (i >> 2) + 4 * n + (i & 3); }

struct Unit { int pm, pn; };
struct Gemm { const bf16_t* A; const bf16_t* Bt; int M, N, K; };

struct StaticOrder {
    int nM, nN, nwg, G, c;
    __host__ __device__ void init(int M, int N, int G_, int c_) { nM = M / BM; nN = N / BM; nwg = nM * nN; G = G_; c = c_; }
    __host__ __device__ bool next(int i, Unit& u) const {
        const long L = (long)i * G + c; if (L >= nwg) return false;
        int wgid = (int)L; { const int q = nwg / NXCD, r = nwg % NXCD, xcd = wgid % NXCD, off = wgid / NXCD; wgid = (xcd < r ? xcd * (q + 1) : r * (q + 1) + (xcd - r) * q) + off; }
        const int nig = WGM * nN, gid = wgid / nig, fm = gid * WGM, gsz = (nM - fm) < WGM ? (nM - fm) : WGM;
        u.pm = fm + ((wgid % nig) % gsz); u.pn = (wgid % nig) / gsz; return true;
    }
    __device__ __forceinline__ void a_ready(const Unit&) const {}
    __device__ __forceinline__ void done(const Unit&) const {}
};

__device__ __forceinline__ unsigned cvt_pk_bf16(float lo, float hi) { unsigned r; asm volatile("v_cvt_pk_bf16_f32 %0, %1, %2" : "=v"(r) : "v"(lo), "v"(hi)); return r; }
typedef float f32x2 __attribute__((ext_vector_type(2)));
__device__ __forceinline__ f32x2 gelu_pk(f32x2 v) {
    const f32x2 av = __builtin_elementwise_abs(v), d = av * 0.2316418882f + 1.0f;
    f32x2 t; t.x = __builtin_amdgcn_rcpf(d.x); t.y = __builtin_amdgcn_rcpf(d.y);
    f32x2 q = t * 0.5307027145f + (-0.7265760135f); q = q * t + 0.7107068705f; q = q * t + (-0.142248368f); q = q * t + 0.127414796f; q = q * t;
    const f32x2 s = (v * v) * (-0.72134752044f);
    f32x2 e; e.x = __builtin_amdgcn_exp2f(s.x); e.y = __builtin_amdgcn_exp2f(s.y);
    const f32x2 m = v * (q * e), r = v - m;
    f32x2 o; o.x = v.x < 0.f ? m.x : r.x; o.y = v.y < 0.f ? m.y : r.y; return o;
}

template <int ACT  > struct EpiBf16 {
    static constexpr bool PERM = true, AFTER_DRAIN = false; static_assert(ACT == 0 || ACT == 1, "EpiBf16: ACT is 0 (none) or 1 (gelu_pk)");
    bf16_t* O; int ldc; const float* bias; int split_cols; size_t split_stride; float scale0;
    __device__ __forceinline__ void operator()(const f32x4 (&acc)[2][2][4][2], const Unit& u, int wr, int wc, int fr, int fq) const {
        const int row0 = u.pm * BM + wr * 64 + fr; int colt = u.pn * BM; bf16_t* base = O;
        float sc = 1.f; if (split_cols) { const int t = colt / split_cols; base += (size_t)t * split_stride; colt -= t * split_cols; if (t == 0) sc = scale0; }
        const int col0 = colt + wc * 32 + 8 * fq, bcol0 = u.pn * BM + wc * 32 + 8 * fq;
        f32x4 bv[2][2];
#pragma unroll
        for (int bj = 0; bj < 2; ++bj)
#pragma unroll
            for (int n = 0; n < 2; ++n) bv[bj][n] = bias ? *(const f32x4*)(bias + bcol0 + bj * HALF + 4 * n) : (f32x4){0.f, 0.f, 0.f, 0.f};
#pragma unroll
        for (int ai = 0; ai < 2; ++ai)
#pragma unroll
            for (int m = 0; m < 4; ++m) { bf16_t* rowp = base + (size_t)(row0 + ai * HALF + m * 16) * ldc + col0;
#pragma unroll
                for (int bj = 0; bj < 2; ++bj) { f32x4 v0 = acc[ai][bj][m][0] + bv[bj][0], v1 = acc[ai][bj][m][1] + bv[bj][1];
                    if (ACT == 1) { f32x2 a = gelu_pk((f32x2){v0[0], v0[1]}), b = gelu_pk((f32x2){v0[2], v0[3]}), c = gelu_pk((f32x2){v1[0], v1[1]}), d = gelu_pk((f32x2){v1[2], v1[3]});
                        v0 = (f32x4){a.x, a.y, b.x, b.y}; v1 = (f32x4){c.x, c.y, d.x, d.y}; }
                    v0 = v0 * sc; v1 = v1 * sc; u32x4 w; w.x = cvt_pk_bf16(v0[0], v0[1]); w.y = cvt_pk_bf16(v0[2], v0[3]); w.z = cvt_pk_bf16(v1[0], v1[1]); w.w = cvt_pk_bf16(v1[2], v1[3]);
                    *(u32x4*)(rowp + bj * HALF) = w; } }
    }
};
struct EpiResF32 {
    static constexpr bool PERM = false, AFTER_DRAIN = false;
    const float* base; float* out; int ldc;
    __device__ __forceinline__ void operator()(const f32x4 (&acc)[2][2][4][2], const Unit& u, int wr, int wc, int fr, int fq) const {
        const int col0 = u.pn * BM + wc * 32 + 4 * fq;
#pragma unroll
        for (int ai = 0; ai < 2; ++ai)
#pragma unroll
            for (int m = 0; m < 4; ++m) { const size_t off = (size_t)(u.pm * BM + ai * HALF + wr * 64 + m * 16 + fr) * ldc + col0;
#pragma unroll
                for (int bj = 0; bj < 2; ++bj)
#pragma unroll
                    for (int n = 0; n < 2; ++n) { const f32x4 bs = *(const f32x4*)(base + off + bj * HALF + n * 16); *(f32x4*)(out + off + bj * HALF + n * 16) = bs + acc[ai][bj][m][n]; } }
    }
};

struct EpiQKVN {
    static constexpr bool PERM = true, AFTER_DRAIN = false;
    bf16_t* O; size_t split_stride; const float* qg; const float* kg; PG8_LAS float* ex; float eps, qscale;
    __device__ __forceinline__ void operator()(const f32x4 (&acc)[2][2][4][2], const Unit& u, int wr, int wc, int fr, int fq) const {
        const int t = u.pn >> 1, row0 = u.pm * BM + wr * 64 + fr, col0 = (u.pn & 1) * BM + wc * 32 + 8 * fq; bf16_t* base = O + (size_t)t * split_stride;
        float rs[2][4][2];
        f32x4 g0 = {1.f, 1.f, 1.f, 1.f}, g1 = {1.f, 1.f, 1.f, 1.f};
        if (t < 2) {
            int wid = wr * 4 + wc, fro = fr; asm volatile("" : "+v"(fro), "+s"(wid));
#pragma unroll
            for (int ai = 0; ai < 2; ++ai)
#pragma unroll
                for (int m = 0; m < 4; ++m)
#pragma unroll
                    for (int bj = 0; bj < 2; ++bj) { const f32x4 a0 = acc[ai][bj][m][0], a1 = acc[ai][bj][m][1];
                        float s = (a0[0] * a0[0] + a0[1] * a0[1]) + (a0[2] * a0[2] + a0[3] * a0[3]) + (a1[0] * a1[0] + a1[1] * a1[1]) + (a1[2] * a1[2] + a1[3] * a1[3]);
                        s += __shfl_xor(s, 16); s += __shfl_xor(s, 32);
                        if (fq == 0) ex[(((wid * 2 + ai) * 4 + m) * 2 + bj) * 16 + fro] = s; }
            asm volatile("s_waitcnt lgkmcnt(0)\n\ts_barrier" ::: "memory");
            const float* gp = (t == 0 ? qg : kg) + 32 * (wc & 1) + 8 * fq; const float gs = (t == 0) ? qscale : 1.f;
            g0 = *(const f32x4*)gp * gs; g1 = *(const f32x4*)(gp + 4) * gs;
#pragma unroll
            for (int ai = 0; ai < 2; ++ai)
#pragma unroll
                for (int m = 0; m < 4; ++m)
#pragma unroll
                    for (int bj = 0; bj < 2; ++bj) { const float so = ex[(((wid * 2 + ai) * 4 + m) * 2 + bj) * 16 + fro], sp = ex[((((wid ^ 1) * 2 + ai) * 4 + m) * 2 + bj) * 16 + fro]; rs[ai][m][bj] = 1.0f / sqrtf((so + sp) * (1.f / 64.f) + eps); }
        }
#pragma unroll
        for (int ai = 0; ai < 2; ++ai)
#pragma unroll
            for (int m = 0; m < 4; ++m) { bf16_t* rowp = base + (size_t)(row0 + ai * HALF + m * 16) * 512 + col0;
#pragma unroll
                for (int bj = 0; bj < 2; ++bj) { f32x4 v0 = acc[ai][bj][m][0], v1 = acc[ai][bj][m][1];
                    if (t < 2) { const float r = rs[ai][m][bj]; v0 = v0 * r * g0; v1 = v1 * r * g1; }
                    u32x4 w; w.x = cvt_pk_bf16(v0[0], v0[1]); w.y = cvt_pk_bf16(v0[2], v0[3]); w.z = cvt_pk_bf16(v1[0], v1[1]); w.w = cvt_pk_bf16(v1[2], v1[3]);
                    *(u32x4*)(rowp + bj * HALF) = w; } }
    }
};
template <class Epi, class Sched, bool ALIGN_EPI = false, bool SP2 = false>
__device__ __forceinline__ void gemm_phase(PG8_LAS unsigned char* lds, const Gemm g, const Sched& S, const Epi& E) {
    const int tid = otid(), wid = __builtin_amdgcn_readfirstlane(tid >> 6), lane = tid & 63, wr = wid >> 2, wc = wid & 3, fr = lane & 15, fq = lane >> 4;
    const int K = g.K, nt = K / BK;
    unsigned voffA[2], voffB[2];
#pragma unroll
    for (int i = 0; i < 2; ++i) { int R, C; stage_rc(tid * 16 + i * 8192, R, C); const int Rb = Epi::PERM ? ((R & ~31) + perm32(R & 31)) : R;
        voffA[i] = (unsigned)(R * K + C) * 2u; voffB[i] = (unsigned)(Rb * K + C) * 2u; }
    const size_t kstep = (size_t)(BK * 2);
    const size_t hstep = (size_t)HALF * K * 2;
    const size_t tstep = 2 * hstep;
    const unsigned ldsw = (unsigned)wid * 1024u;
    const int aoff = lds_byte(wr * 64 + fr, fq * 8), boff = lds_byte(wc * 32 + fr, fq * 8);
#define PG8_SA(b, h) (((b) * 2 + (h)) * HTB)
#define PG8_SB(b, h) ((4 + (b) * 2 + (h)) * HTB)
#define PG8_STAGE(bufoff, gbase, voff) do { _Pragma("unroll") for (int _i = 0; _i < 2; ++_i) \
        __builtin_amdgcn_global_load_lds((const unsigned*)((const char*)(gbase) + (voff)[_i]), (PG8_LAS unsigned*)(lds + (bufoff) + ldsw + _i * 8192), 16, 0, 0); } while (0)
#define PG8_LDA(dst, b, h) do { _Pragma("unroll") for (int m = 0; m < 4; ++m) _Pragma("unroll") for (int k = 0; k < 2; ++k) dst[m][k] = *(const PG8_LAS bf16x8*)(lds + PG8_SA(b, h) + aoff + m * 2048 + k * 1024); } while (0)
#define PG8_LDB(dst, b, h) do { _Pragma("unroll") for (int n = 0; n < 2; ++n) _Pragma("unroll") for (int k = 0; k < 2; ++k) dst[n][k] = *(const PG8_LAS bf16x8*)(lds + PG8_SB(b, h) + boff + n * 2048 + k * 1024); } while (0)
#define PG8_MMA(ai, bj, At, Bt) do { __builtin_amdgcn_s_setprio(1); _Pragma("unroll") for (int m = 0; m < 4; ++m) _Pragma("unroll") for (int n = 0; n < 2; ++n) _Pragma("unroll") for (int k = 0; k < 2; ++k) \
        acc[ai][bj][m][n] = __builtin_amdgcn_mfma_f32_16x16x32_bf16(Bt[n][k], At[m][k], acc[ai][bj][m][n], 0, 0, 0); __builtin_amdgcn_s_setprio(0); } while (0)
#define PG8_WAIT_V(n) asm volatile("s_waitcnt vmcnt(" #n ")" ::: "memory")
#define PG8_WAIT_L(n) asm volatile("s_waitcnt lgkmcnt(" #n ")" ::: "memory")
#define PG8_BAR __builtin_amdgcn_s_barrier()
#define PG8_SCHED __builtin_amdgcn_sched_barrier(0)
    Unit cur, nxt; int ui = 0;
    if (!S.next(0, cur)) return;
    f32x4 acc[2][2][4][2];
#pragma unroll
    for (int a = 0; a < 2; ++a)
#pragma unroll
        for (int b = 0; b < 2; ++b)
#pragma unroll
            for (int m = 0; m < 4; ++m)
#pragma unroll
                for (int n = 0; n < 2; ++n) acc[a][b][m][n] = (f32x4){0.f, 0.f, 0.f, 0.f};
    bf16x8 At[4][2], B0[2][2], B1[2][2];
    const char* cA = (const char*)g.A + (size_t)cur.pm * tstep; const char* cB = (const char*)g.Bt + (size_t)cur.pn * tstep;
    S.a_ready(cur);
    if constexpr (SP2) {
        PG8_STAGE(PG8_SB(0, 0), cB, voffB); PG8_STAGE(PG8_SB(0, 1), cB + hstep, voffB); PG8_STAGE(PG8_SA(0, 0), cA, voffA); PG8_STAGE(PG8_SA(0, 1), cA + hstep, voffA);
        if (wr == 1) PG8_BAR;
        PG8_WAIT_V(2); PG8_BAR;
        PG8_STAGE(PG8_SB(1, 0), cB + kstep, voffB); PG8_STAGE(PG8_SA(1, 0), cA + kstep, voffA); PG8_STAGE(PG8_SB(1, 1), cB + hstep + kstep, voffB);
        PG8_WAIT_V(6); PG8_BAR;
    } else {
        PG8_STAGE(PG8_SB(0, 0), cB, voffB); PG8_STAGE(PG8_SA(0, 0), cA, voffA); PG8_STAGE(PG8_SB(0, 1), cB + hstep, voffB); PG8_STAGE(PG8_SA(0, 1), cA + hstep, voffA);
        if (wr == 1) PG8_BAR;
        PG8_WAIT_V(4); PG8_BAR;
        PG8_STAGE(PG8_SB(1, 0), cB + kstep, voffB); PG8_STAGE(PG8_SA(1, 0), cA + kstep, voffA); PG8_STAGE(PG8_SB(1, 1), cB + hstep + kstep, voffB);
        PG8_WAIT_V(6); PG8_BAR;
    }
    for (;;) {
        const bool has_next = S.next(ui + 1, nxt);
        const char* nA = has_next ? (const char*)g.A + (size_t)nxt.pm * tstep : cA; const char* nB = has_next ? (const char*)g.Bt + (size_t)nxt.pn * tstep : cB;
        for (int t = 0; t < nt; t += 2) {
            const bool last = (t == nt - 2);
            const char* a1 = cA + (size_t)(t + 1) * kstep;
            const char* a2 = last ? nA : cA + (size_t)(t + 2) * kstep; const char* b2 = last ? nB : cB + (size_t)(t + 2) * kstep;
            const char* a3 = a2 + kstep; const char* b3 = b2 + kstep;
            if (last && has_next) S.a_ready(nxt);
            if constexpr (SP2) {
            PG8_LDB(B0, 0, 0); PG8_LDB(B1, 0, 1); PG8_SCHED; PG8_LDA(At, 0, 0); PG8_STAGE(PG8_SA(1, 1), a1 + hstep, voffA);
            PG8_WAIT_V(8); PG8_WAIT_L(0); PG8_BAR; PG8_MMA(0, 0, At, B0); PG8_MMA(0, 1, At, B1); PG8_BAR; PG8_SCHED;
            PG8_LDA(At, 0, 1); PG8_STAGE(PG8_SB(0, 0), b2, voffB); PG8_STAGE(PG8_SB(0, 1), b2 + hstep, voffB); PG8_STAGE(PG8_SA(0, 0), a2, voffA);
            PG8_WAIT_V(8); PG8_WAIT_L(0); PG8_BAR; PG8_MMA(1, 0, At, B0); PG8_MMA(1, 1, At, B1); PG8_BAR; PG8_SCHED;
            PG8_LDB(B0, 1, 0); PG8_LDB(B1, 1, 1); PG8_SCHED; PG8_LDA(At, 1, 0); PG8_STAGE(PG8_SA(0, 1), a2 + hstep, voffA);
            PG8_WAIT_V(8); PG8_WAIT_L(0); PG8_BAR; PG8_MMA(0, 0, At, B0); PG8_MMA(0, 1, At, B1); PG8_BAR; PG8_SCHED;
            PG8_LDA(At, 1, 1); PG8_STAGE(PG8_SB(1, 0), b3, voffB); PG8_STAGE(PG8_SB(1, 1), b3 + hstep, voffB); PG8_STAGE(PG8_SA(1, 0), a3, voffA);
            PG8_WAIT_V(8); PG8_WAIT_L(0); PG8_BAR; PG8_MMA(1, 0, At, B0); PG8_MMA(1, 1, At, B1); PG8_BAR; PG8_SCHED;
            } else {
            PG8_LDB(B0, 0, 0); PG8_SCHED; PG8_LDA(At, 0, 0); PG8_STAGE(PG8_SA(1, 1), a1 + hstep, voffA);
            PG8_WAIT_L(8); PG8_BAR; PG8_WAIT_L(0); PG8_MMA(0, 0, At, B0); PG8_BAR; PG8_SCHED;
            PG8_LDB(B1, 0, 1); PG8_STAGE(PG8_SB(0, 0), b2, voffB);
            PG8_BAR; PG8_WAIT_L(0); PG8_MMA(0, 1, At, B1); PG8_BAR;
            PG8_LDA(At, 0, 1); PG8_STAGE(PG8_SA(0, 0), a2, voffA);
            PG8_BAR; PG8_WAIT_L(0); PG8_MMA(1, 0, At, B0); PG8_BAR; PG8_SCHED;
            PG8_STAGE(PG8_SB(0, 1), b2 + hstep, voffB);
            PG8_WAIT_V(6); PG8_BAR; PG8_MMA(1, 1, At, B1); PG8_BAR;
            PG8_LDB(B0, 1, 0); PG8_SCHED; PG8_LDA(At, 1, 0); PG8_STAGE(PG8_SA(0, 1), a2 + hstep, voffA);
            PG8_WAIT_L(8); PG8_BAR; PG8_WAIT_L(0); PG8_MMA(0, 0, At, B0); PG8_BAR; PG8_SCHED;
            PG8_LDB(B1, 1, 1); PG8_STAGE(PG8_SB(1, 0), b3, voffB);
            PG8_BAR; PG8_WAIT_L(0); PG8_MMA(0, 1, At, B1); PG8_BAR;
            PG8_LDA(At, 1, 1); PG8_STAGE(PG8_SA(1, 0), a3, voffA);
            PG8_BAR; PG8_WAIT_L(0); PG8_MMA(1, 0, At, B0); PG8_BAR; PG8_SCHED;
            PG8_STAGE(PG8_SB(1, 1), b3 + hstep, voffB);
            PG8_WAIT_V(6); PG8_BAR; PG8_MMA(1, 1, At, B1); PG8_BAR;
            }
        }
        if constexpr (ALIGN_EPI) { if (wr == 0) PG8_BAR; }
        if constexpr (!Epi::AFTER_DRAIN) { E(acc, cur, wr, wc, fr, fq); S.done(cur); }
        if (!has_next) break;
#pragma unroll
        for (int a = 0; a < 2; ++a)
#pragma unroll
            for (int b = 0; b < 2; ++b)
#pragma unroll
                for (int m = 0; m < 4; ++m)
#pragma unroll
                    for (int n = 0; n < 2; ++n) acc[a][b][m][n] = (f32x4){0.f, 0.f, 0.f, 0.f};
        cur = nxt; cA = nA; cB = nB; ++ui;
        if constexpr (ALIGN_EPI) { if (wr == 1) PG8_BAR; }
    }
    PG8_WAIT_V(0);
    if constexpr (!ALIGN_EPI) { if (wr == 0) PG8_BAR; }
    PG8_BAR;
    if constexpr (Epi::AFTER_DRAIN) { E.fused(acc, cur, wr, wc, fr, fq, lds, wid, lane); S.done(cur); }
#undef PG8_SA
#undef PG8_SB
#undef PG8_STAGE
#undef PG8_LDA
#undef PG8_LDB
#undef PG8_MMA
#undef PG8_WAIT_V
#undef PG8_WAIT_L
#undef PG8_BAR
#undef PG8_SCHED
}
}
#include <hip/hip_bf16.h>
#include <cmath>
namespace attn_body {
using bf16=__hip_bfloat16;
using bf16x8=__attribute__((ext_vector_type(8)))short;
using s16x4=__attribute__((ext_vector_type(4)))short;
using f32x16=__attribute__((ext_vector_type(16)))float;
using u32x4=__attribute__((ext_vector_type(4)))unsigned;
using f32x4v=__attribute__((ext_vector_type(4)))float;
constexpr int BATCH=8,NHEAD=8,SEQ=4096,D=64,DM=NHEAD*D,OPITCH=1024;
constexpr int NW=8,QBLK=32,QB=QBLK*NW,KVBLK=64,NQB=SEQ/QB;
constexpr int ATTN_PITCH=DM, ATTN_UNIT_ROWS=QB;
__device__ __forceinline__ int crow(int r,int hi){return (r&3)+8*(r>>2)+4*hi;}
#define SBAR() __builtin_amdgcn_sched_barrier(0)
__device__ __forceinline__ void cmask(f32x16&p0,f32x16&p1,int jb,int qrel,int hi){
  const float NEG=-INFINITY; int kb=64*jb+4*hi;
  #pragma unroll
  for(int r=0;r<16;++r){int kv=kb+(r&3)+8*(r>>2); if(kv>qrel)p0[r]=NEG; if(kv+32>qrel)p1[r]=NEG;}
}

constexpr int NSLOT=3, SLOTB=8192;
constexpr int LDS_K=0, LDS_V=NSLOT*SLOTB, LDS_WS=2*NSLOT*SLOTB, LDS_OST=LDS_WS+NW*64*4, LDS_BYTES=LDS_OST+NW*4096, LDS_BIAS=LDS_BYTES, LDS_TOTAL=LDS_BIAS+SEQ*4;
constexpr float C2=0.125f*1.4426950408889634f;
__device__ __forceinline__ void glds16(const void*sbase,unsigned voff,unsigned lds_dst){unsigned keep;
  asm volatile("s_mov_b32 %0, m0\n\ts_mov_b32 m0, %3\n\ts_nop 0\n\tglobal_load_lds_dwordx4 %1, %2\n\ts_mov_b32 m0, %0":"=&s"(keep):"v"(voff),"s"(sbase),"s"(lds_dst):"memory");}
__device__ __forceinline__ float max3f(float a,float b,float c){float r;asm("v_max3_f32 %0, %1, %2, %3":"=v"(r):"v"(a),"v"(b),"v"(c));return r;}
__device__ __forceinline__ float max2f(float a,float b){float r;asm("v_max_f32_e32 %0, %1, %2":"=v"(r):"v"(a),"v"(b));return r;}
__device__ __forceinline__ float fadd_s(float a,float b){float r;asm("v_add_f32_e32 %0, %1, %2":"=v"(r):"v"(a),"v"(b));return r;}
__device__ __forceinline__ float fsub_s(float a,float b){float r;asm("v_sub_f32_e32 %0, %1, %2":"=v"(r):"v"(a),"v"(b));return r;}
typedef float f32x2_t __attribute__((ext_vector_type(2))); typedef __bf16 bf16x2_t __attribute__((ext_vector_type(2)));
__device__ __forceinline__ unsigned cvtpk_s(float lo,float hi){f32x2_t v={lo,hi};bf16x2_t b=__builtin_convertvector(v,bf16x2_t);return __builtin_bit_cast(unsigned,b);}
#define WAIT_BAR(N) asm volatile("s_waitcnt vmcnt(" #N ") lgkmcnt(0)\n\ts_barrier":::"memory")

__device__ __forceinline__ void qkt(f32x16&p0,f32x16&p1,const __attribute__((address_space(3))) char*kb,const bf16x8*qr){
  #pragma unroll
  for(int d0=0;d0<4;++d0){
    const bf16x8 b0=*(const __attribute__((address_space(3))) bf16x8*)(kb+d0*2048);
    const bf16x8 b1=*(const __attribute__((address_space(3))) bf16x8*)(kb+d0*2048+512);
    p0=__builtin_amdgcn_mfma_f32_32x32x16_bf16(b0,qr[d0],p0,0,0,0);p1=__builtin_amdgcn_mfma_f32_32x32x16_bf16(b1,qr[d0],p1,0,0,0);}
}
typedef __attribute__((address_space(3))) const char* lds_cptr;
typedef short v4i16_t __attribute__((ext_vector_type(4)));
__device__ __forceinline__ void kload8(bf16x8*kf,lds_cptr kp){
  kf[0]=*(const __attribute__((address_space(3))) bf16x8*)(kp);      kf[1]=*(const __attribute__((address_space(3))) bf16x8*)(kp+512);
  kf[2]=*(const __attribute__((address_space(3))) bf16x8*)(kp+2048); kf[3]=*(const __attribute__((address_space(3))) bf16x8*)(kp+2560);
  kf[4]=*(const __attribute__((address_space(3))) bf16x8*)(kp+4096); kf[5]=*(const __attribute__((address_space(3))) bf16x8*)(kp+4608);
  kf[6]=*(const __attribute__((address_space(3))) bf16x8*)(kp+6144); kf[7]=*(const __attribute__((address_space(3))) bf16x8*)(kp+6656);
}
__device__ __forceinline__ void kload2(bf16x8*kf,lds_cptr kp,int j){ kf[2*j]=*(const __attribute__((address_space(3))) bf16x8*)(kp+j*2048); kf[2*j+1]=*(const __attribute__((address_space(3))) bf16x8*)(kp+j*2048+512); }
__device__ __forceinline__ s16x4 vtr(lds_cptr p){ return __builtin_bit_cast(s16x4,__builtin_amdgcn_ds_read_tr16_b64_v4i16((__attribute__((address_space(3))) v4i16_t*)p)); }
__device__ __forceinline__ float rowmax(const f32x16&p0,const f32x16&p1){
  float a=max3f(p0[0],p0[1],p1[0]),b=max3f(p0[2],p0[3],p1[1]);a=max3f(a,p1[2],p1[3]);
  #pragma unroll
  for(int r=4;r<16;r+=4){a=max3f(a,p0[r],p0[r+1]);b=max3f(b,p0[r+2],p0[r+3]);a=max3f(a,p1[r],p1[r+1]);b=max3f(b,p1[r+2],p1[r+3]);}
  const float m=max2f(a,b);
  auto rr=__builtin_amdgcn_permlane32_swap(__float_as_uint(m),__float_as_uint(m),false,false);
  return max2f(__uint_as_float(rr[0]),__uint_as_float(rr[1]));
}
__device__ __forceinline__ void pv(f32x16*o,int vb,bf16x8 pa0,bf16x8 pa1,bf16x8 pa2,bf16x8 pa3){
  #pragma unroll
  for(int d0=0;d0<2;++d0){s16x4 lo[4],hi[4];
    #pragma unroll
    for(int ks=0;ks<4;++ks){
      asm volatile("ds_read_b64_tr_b16 %0,%1 offset:%c2":"=&v"(lo[ks]):"v"(vb),"i"(d0*4096+ks*1024):"memory");
      asm volatile("ds_read_b64_tr_b16 %0,%1 offset:%c2":"=&v"(hi[ks]):"v"(vb),"i"(d0*4096+ks*1024+512):"memory");}
    asm volatile("s_waitcnt lgkmcnt(0)":::"memory");SBAR();
    #define PK(k) (bf16x8){lo[k][0],lo[k][1],lo[k][2],lo[k][3],hi[k][0],hi[k][1],hi[k][2],hi[k][3]}
    o[d0]=__builtin_amdgcn_mfma_f32_32x32x16_bf16(pa0,PK(0),o[d0],0,0,0);
    o[d0]=__builtin_amdgcn_mfma_f32_32x32x16_bf16(pa1,PK(1),o[d0],0,0,0);
    o[d0]=__builtin_amdgcn_mfma_f32_32x32x16_bf16(pa2,PK(2),o[d0],0,0,0);
    o[d0]=__builtin_amdgcn_mfma_f32_32x32x16_bf16(pa3,PK(3),o[d0],0,0,0);
    #undef PK
  }
}

#ifndef ATTN_STORE16
#define ATTN_STORE16(p,v) (*(u32x4*)(p)=(v))
#endif
template<bool SKIP> __device__ __forceinline__ void attn_unit(int b,int h,int qb,const bf16*Q,const bf16*__restrict__ K,const bf16*__restrict__ V,bf16*O,const float*__restrict__ CB,float qkb,char*shm){
  const int tid=otid(),lane=tid&63,r32=lane&31,hi=lane>>5; const int wid=__builtin_amdgcn_readfirstlane(tid>>6);
  const long rowbase=(long)b*SEQ; const int q0=qb*QB;
  const float*cb=CB+(long)(b*NHEAD+h)*SEQ;
  int t0=0;
  if(SKIP){ const int NTf=(q0+QB)/KVBLK; const float thr=2.f*qkb+40.f; const float cq0=cb[q0];
    bool pred=false; if(lane<NTf-4){ pred=(cq0-cb[64*lane+63])<-thr; }
    const unsigned long long mk=__ballot(pred); t0=(int)__builtin_ctzll(~mk); t0&=~1; t0=__builtin_amdgcn_readfirstlane(t0); }
  const int kv0=t0*KVBLK;
  const int NT=(q0+QB)/KVBLK-t0;
  { __attribute__((address_space(3))) float*bl=(__attribute__((address_space(3))) float*)((lds_cptr)shm+LDS_BIAS); const float*cbk=cb+kv0; for(int i=tid;i<NT*KVBLK;i+=NW*64) bl[i]=-*(const float*)((const char*)cbk+(unsigned)(i*4)); }
  const float negm0=*(const float*)((const char*)(cb+q0+wid*QBLK)+(unsigned)((lane&31)*4))-qkb;
  const bf16*Qw=Q+(rowbase+q0+wid*QBLK)*DM+h*D;
  const bf16*Kh=K+(rowbase+kv0)*DM+h*D,*Vh=V+(rowbase+kv0)*DM+h*D;
  const unsigned lds0=(unsigned)(uintptr_t)shm;
  const unsigned koff=(unsigned)(lane*DM+wid*8)*2u;
  const unsigned voff=(unsigned)((16*(wid&3)+(lane>>2))*DM+(wid>>2)*32+(lane&3)*8)*2u;
  const unsigned kdst=lds0+LDS_K+wid*1024, vdst=lds0+LDS_V+wid*1024;
  #define DMA_K(t,slot) glds16(Kh+(long)(t)*KVBLK*DM,koff,(unsigned)__builtin_amdgcn_readfirstlane(kdst+(slot)))
  #define DMA_V(t,slot) glds16(Vh+(long)(t)*KVBLK*DM,voff,(unsigned)__builtin_amdgcn_readfirstlane(vdst+(slot)))
  bf16x8 kf[8];
  const lds_cptr shm3=(lds_cptr)shm; __attribute__((address_space(3))) float*const wsf=(__attribute__((address_space(3))) float*)(shm3+LDS_WS)+wid*64;
  const lds_cptr kp0=shm3+LDS_K+hi*1024+r32*16; const lds_cptr vp0=shm3+LDS_V+((lane>>4)&1)*32+(lane&3)*8+(4*hi+((lane&15)>>2))*64;
  DMA_K(0,0);DMA_V(0,0);DMA_K(1,SLOTB);
  bf16x8 qr[4];
  #pragma unroll
  for(int d0=0;d0<4;++d0)qr[d0]=*reinterpret_cast<const bf16x8*>((const char*)Qw+(unsigned)((r32*DM+d0*16+hi*8)*2));
  float l_reg=0.f;f32x16 o[2];o[0]=f32x16{};o[1]=f32x16{};
  const __attribute__((address_space(3))) char* bl3=(const __attribute__((address_space(3))) char*)shm+LDS_BIAS+hi*16;
  #define BINIT_ALL(P0,P1,t) do{ const __attribute__((address_space(3))) f32x4v* bp_=(const __attribute__((address_space(3))) f32x4v*)(bl3+(t)*256); \
    _Pragma("unroll") for(int g_=0;g_<4;++g_){ const f32x4v x0_=bp_[2*g_], x1_=bp_[8+2*g_]; \
      P0[4*g_]=x0_[0]+negm0;P0[4*g_+1]=x0_[1]+negm0;P0[4*g_+2]=x0_[2]+negm0;P0[4*g_+3]=x0_[3]+negm0; \
      P1[4*g_]=x1_[0]+negm0;P1[4*g_+1]=x1_[1]+negm0;P1[4*g_+2]=x1_[2]+negm0;P1[4*g_+3]=x1_[3]+negm0; } }while(0)
  const int qrel=wid*QBLK+r32;
  #define CMASK(P0,P1,t) do{int jb_=(t)-(NT-4); if(jb_>=0)cmask(P0,P1,jb_,qrel,hi);}while(0)
  f32x16 pA0,pA1,pB0,pB1;
  int sl_prev=0,sl_cur=0,sl_next=SLOTB;
  #define ROT() do{sl_prev=sl_cur;sl_cur=sl_next;sl_next=(sl_next==(NSLOT-1)*SLOTB)?0:sl_next+SLOTB;}while(0)
  DMA_K(2,2*SLOTB);
  WAIT_BAR(3);
  BINIT_ALL(pA0,pA1,0); qkt(pA0,pA1,kp0,qr);asm volatile("s_nop 15\n\ts_nop 7":"+v"(pA0),"+v"(pA1));CMASK(pA0,pA1,0);
  _Pragma("unroll") for(int r=0;r<16;++r){pA0[r]=__builtin_amdgcn_exp2f(pA0[r]);pA1[r]=__builtin_amdgcn_exp2f(pA1[r]);}
  BINIT_ALL(pB0,pB1,1);
  WAIT_BAR(0);
  DMA_K(3,0);DMA_V(1,SLOTB);
  ROT();
  kload8(kf,kp0+sl_cur);
  WAIT_BAR(2);
  s16x4 vlo[8],vhi[8]; u32x4 pw0,pw1,pw2,pw3;
  #define PKW(P,B) cvtpk_s(P[B],P[B+1])
  #define PAF(k) __builtin_bit_cast(bf16x8,pw##k)
  #define VFR(i) (bf16x8){vlo[i][0],vlo[i][1],vlo[i][2],vlo[i][3],vhi[i][0],vhi[i][1],vhi[i][2],vhi[i][3]}
  #define PIN(x) asm volatile("":"+v"(x))
  #define MX3(a,b,c) __builtin_fmaxf(__builtin_fmaxf((a),(b)),(c))
  #define GAPA(MF,A0,A1,A2,A3,W0,W1,PW) do{ MF; sacc+=A0; sacc+=A1; sacc+=A2; sacc+=A3; PIN(sacc); W0; W1; PIN(PW); SBAR(); }while(0)
  #define EX(v) __builtin_amdgcn_exp2f(v)
  #define GAPB(MF,X,B,GL_,P,GI,NI) do{ MF; X[B]=EX(X[B]); X[B+1]=EX(X[B+1]); X[B+2]=EX(X[B+2]); X[B+3]=EX(X[B+3]); PIN(X); \
    if(GL_){ const f32x4v nx_=bpn_[NI]; P[4*(GI)]=bq_[0]+negm0; P[4*(GI)+1]=bq_[1]+negm0; P[4*(GI)+2]=bq_[2]+negm0; P[4*(GI)+3]=bq_[3]+negm0; bq_=nx_; PIN(P); } SBAR(); }while(0)
  #define VRD(i) do{ vlo[i]=vtr(vp_+(((i)>>2)*4096+((i)&3)*1024)); vhi[i]=vtr(vp_+(((i)>>2)*4096+((i)&3)*1024+512)); }while(0)
  #define KRD(G,j) do{ if(G){ kload2(kf,kp0+sl_next,j); SBAR(); } }while(0)
  #define STEP(C0,C1,P0,P1,t,GK,GV,GL) do{ SBAR(); \
    const lds_cptr vp_=vp0+sl_prev; \
    VRD(0); SBAR(); float sacc=(P0[0]+P0[1]); \
    GAPA(C0=__builtin_amdgcn_mfma_f32_32x32x16_bf16(kf[0],qr[0],C0,0,0,0), P0[2],P0[3],P0[4],P0[5],     pw0[0]=PKW(P0,0), pw0[1]=PKW(P0,2), pw0); \
    VRD(4); SBAR(); GAPA(C1=__builtin_amdgcn_mfma_f32_32x32x16_bf16(kf[1],qr[0],C1,0,0,0), P0[6],P0[7],P0[8],P0[9],     pw0[2]=PKW(P0,4), pw0[3]=PKW(P0,6), pw0); \
    VRD(1); SBAR(); GAPA(C0=__builtin_amdgcn_mfma_f32_32x32x16_bf16(kf[2],qr[1],C0,0,0,0),   P0[10],P0[11],P0[12],P0[13], pw1[0]=PKW(P0,8), pw1[1]=PKW(P0,10), pw1); \
    VRD(5); SBAR(); GAPA(C1=__builtin_amdgcn_mfma_f32_32x32x16_bf16(kf[3],qr[1],C1,0,0,0),   P0[14],P0[15],P1[0],P1[1],   pw1[2]=PKW(P0,12),pw1[3]=PKW(P0,14), pw1); \
    VRD(2); SBAR(); GAPA(C0=__builtin_amdgcn_mfma_f32_32x32x16_bf16(kf[4],qr[2],C0,0,0,0),   P1[2],P1[3],P1[4],P1[5],     pw2[0]=PKW(P1,0), pw2[1]=PKW(P1,2), pw2); \
    VRD(6); SBAR(); GAPA(C1=__builtin_amdgcn_mfma_f32_32x32x16_bf16(kf[5],qr[2],C1,0,0,0),   P1[6],P1[7],P1[8],P1[9],     pw2[2]=PKW(P1,4), pw2[3]=PKW(P1,6), pw2); \
    VRD(3); SBAR(); GAPA(C0=__builtin_amdgcn_mfma_f32_32x32x16_bf16(kf[6],qr[3],C0,0,0,0),   P1[10],P1[11],P1[12],P1[13], pw3[0]=PKW(P1,8), pw3[1]=PKW(P1,10), pw3); \
    VRD(7); SBAR(); GAPA(C1=__builtin_amdgcn_mfma_f32_32x32x16_bf16(kf[7],qr[3],C1,0,0,0),   P1[14],P1[15],0.f,0.f,       pw3[2]=PKW(P1,12),pw3[3]=PKW(P1,14), pw3); \
    l_reg+=sacc; \
    if(GK){DMA_K((t)+3,sl_cur);} if(GV){DMA_V((t)+1,sl_next);} \
    CMASK(C0,C1,t); \
    const __attribute__((address_space(3))) f32x4v* bpn_=(const __attribute__((address_space(3))) f32x4v*)(bl3+((t)+1)*256); f32x4v bq_=f32x4v{}; if(GL){bq_=bpn_[0];} \
    SBAR(); \
    GAPB(o[0]=__builtin_amdgcn_mfma_f32_32x32x16_bf16(PAF(0),VFR(0),o[0],0,0,0), C0,0,GL,P0,0,8); \
    GAPB(o[1]=__builtin_amdgcn_mfma_f32_32x32x16_bf16(PAF(0),VFR(4),o[1],0,0,0), C0,4,GL,P1,0,2); \
    KRD(GL,0); GAPB(o[0]=__builtin_amdgcn_mfma_f32_32x32x16_bf16(PAF(1),VFR(1),o[0],0,0,0), C0,8,GL,P0,1,10); \
    KRD(GL,1); GAPB(o[1]=__builtin_amdgcn_mfma_f32_32x32x16_bf16(PAF(1),VFR(5),o[1],0,0,0), C0,12,GL,P1,1,4); \
    KRD(GL,2); GAPB(o[0]=__builtin_amdgcn_mfma_f32_32x32x16_bf16(PAF(2),VFR(2),o[0],0,0,0), C1,0,GL,P0,2,12); \
    KRD(GL,3); GAPB(o[1]=__builtin_amdgcn_mfma_f32_32x32x16_bf16(PAF(2),VFR(6),o[1],0,0,0), C1,4,GL,P1,2,6); \
    GAPB(o[0]=__builtin_amdgcn_mfma_f32_32x32x16_bf16(PAF(3),VFR(3),o[0],0,0,0), C1,8,GL,P0,3,14); \
    GAPB(o[1]=__builtin_amdgcn_mfma_f32_32x32x16_bf16(PAF(3),VFR(7),o[1],0,0,0), C1,12,GL,P1,3,14); \
    }while(0)
  int t=1;
  #undef CMASK
  #define CMASK(P0,P1,t) do{}while(0)
  for(;t+5<NT;t+=2){
    STEP(pB0,pB1,pA0,pA1,t,true,true,true);     WAIT_BAR(2); ROT();
    STEP(pA0,pA1,pB0,pB1,t+1,true,true,true);   WAIT_BAR(2); ROT();
  }
  #undef CMASK
  #define CMASK(P0,P1,t) do{int jb_=(t)-(NT-4); if(jb_>=0)cmask(P0,P1,jb_,qrel,hi);}while(0)
  #define ENDW(tt) do{ if((tt)+3<NT){WAIT_BAR(2);} else if((tt)+2<NT){WAIT_BAR(1);} else {WAIT_BAR(0);} }while(0)
  for(;t+1<NT;t+=2){
    STEP(pB0,pB1,pA0,pA1,t,(t+3<NT),(t+1<NT),(t+1<NT));       ENDW(t);   ROT();
    STEP(pA0,pA1,pB0,pB1,t+1,(t+4<NT),(t+2<NT),(t+2<NT));     ENDW(t+1); ROT();
  }
  STEP(pB0,pB1,pA0,pA1,NT-1,false,false,false);
  { float sacc=pB0[0]+pB0[1]; _Pragma("unroll") for(int r=2;r<16;++r)sacc+=pB0[r]; _Pragma("unroll") for(int r=0;r<16;++r)sacc+=pB1[r]; l_reg+=sacc;
    pw0=(u32x4){PKW(pB0,0),PKW(pB0,2),PKW(pB0,4),PKW(pB0,6)};pw1=(u32x4){PKW(pB0,8),PKW(pB0,10),PKW(pB0,12),PKW(pB0,14)};pw2=(u32x4){PKW(pB1,0),PKW(pB1,2),PKW(pB1,4),PKW(pB1,6)};pw3=(u32x4){PKW(pB1,8),PKW(pB1,10),PKW(pB1,12),PKW(pB1,14)};
    SBAR(); pv(o,(int)(unsigned)(uintptr_t)vp0+sl_cur,PAF(0),PAF(1),PAF(2),PAF(3)); }
  #undef PKW
  #undef PAF
  #undef VFR
  #undef PIN
  #undef MX3
  #undef GAPA
  #undef GAPB
  #undef EX
  #undef VRD
  #undef KRD
  #undef STEP
  #undef ENDW
  {auto rr=__builtin_amdgcn_permlane32_swap(__float_as_uint(l_reg),__float_as_uint(l_reg),false,false);l_reg=__uint_as_float(rr[0])+__uint_as_float(rr[1]);}
  if(hi==0)wsf[32+r32]=l_reg;asm volatile("s_waitcnt lgkmcnt(0)":::"memory");
  float rli[16];
  #pragma unroll
  for(int r=0;r<16;++r)rli[r]=__builtin_amdgcn_rcpf(wsf[32+crow(r,hi)]);
  bf16*Ow=O+(rowbase+q0+wid*QBLK)*OPITCH+h*D;
  { __attribute__((address_space(3))) unsigned short*stg=(__attribute__((address_space(3))) unsigned short*)(shm3+LDS_OST)+wid*2048;
    #pragma unroll
    for(int r=0;r<16;++r){const int orow=crow(r,hi);
      #pragma unroll
      for(int d0=0;d0<2;++d0)stg[orow*64+d0*32+r32]=(unsigned short)(cvtpk_s(o[d0][r]*rli[r],0.f)&0xffffu);}
    asm volatile("s_waitcnt lgkmcnt(0)":::"memory");
    #pragma unroll
    for(int i=0;i<4;++i){const int row=i*8+(lane>>3),ch=lane&7; const u32x4 v=*(const __attribute__((address_space(3))) u32x4*)(stg+row*64+ch*8); ATTN_STORE16((char*)Ow+(unsigned)((row*OPITCH+ch*8)*2),v);} }
  asm volatile("s_waitcnt lgkmcnt(0)\n\ts_barrier":::"memory");
  #undef DMA_K
  #undef DMA_V
  #undef CMASK
  #undef BINIT_ALL
  #undef ROT
}
constexpr int ATTN_LDS_BYTES=LDS_TOTAL;
struct AttnTensors { const bf16* Q; const bf16* K; const bf16* V; bf16* O; const float* CB; float qkb; };
struct AttnUnit { int bh; int qb; };
struct StaticOrder {
  int vcu,G;
  __device__ __forceinline__ explicit StaticOrder(int grid,int block):vcu((grid%8==0)?(block%8)*(grid/8)+block/8:block),G(grid){}
  __device__ __forceinline__ bool next(int i,AttnUnit&u)const{
    if(G==256){ if(i>=4)return false; const int s=vcu&3; u.bh=vcu>>2; u.qb=(i==0)?s:(i==1)?7-s:(i==2)?8+s:15-s; return true; }
    const int id=vcu+i*G; if(id>=BATCH*NHEAD*NQB)return false; u.bh=id/NQB; u.qb=id%NQB; return true; }
};
template<class Sched,bool SKIP> __device__ __forceinline__ void attn_phase(char*lds,const AttnTensors&T,const Sched&S){
  AttnUnit u;
  for(int i=0;S.next(i,u);++i){ attn_unit<SKIP>(u.bh/NHEAD,u.bh%NHEAD,u.qb,T.Q,T.K,T.V,T.O,T.CB,T.qkb,lds); }
}
template<bool SKIP> __device__ __forceinline__ void attn_phase_q(char*lds,const AttnTensors&T,unsigned*queue){
  const int tid=otid();
  __attribute__((address_space(3))) int*slot=(__attribute__((address_space(3))) int*)((lds_cptr)lds+LDS_TOTAL);
  const unsigned xcc=(unsigned)__builtin_amdgcn_s_getreg((3<<11)|20)&7u;
  for(;;){
    if(tid==0){ int got=-1;
      for(unsigned sx=0;sx<8;++sx){ const unsigned x=(xcc+sx)&7u; const unsigned c=__hip_atomic_fetch_add(queue+x*64,1u,__ATOMIC_RELAXED,__HIP_MEMORY_SCOPE_AGENT); if(c<(unsigned)(NHEAD*NQB)){ got=(int)(x*(NHEAD*NQB)+c); break; } }
      *slot=got; }
    asm volatile("s_waitcnt vmcnt(0) lgkmcnt(0)\n\ts_barrier":::"memory");
    const int id=__builtin_amdgcn_readfirstlane(*slot);
    if(id<0)break;
    const int b=id/(NHEAD*NQB), c=id%(NHEAD*NQB), h=c%NHEAD, qb=NQB-1-c/NHEAD;
    attn_unit<SKIP>(b,h,qb,T.Q,T.K,T.V,T.O,T.CB,T.qkb,lds);
  }
}
#undef SBAR
#undef WAIT_BAR
}
#define GAS __attribute__((address_space(1)))
#define LAS __attribute__((address_space(3)))
typedef unsigned short bf16;
typedef unsigned v4u __attribute__((ext_vector_type(4)));
typedef float f32x4 __attribute__((ext_vector_type(4)));
typedef short bf16x8 __attribute__((ext_vector_type(8)));
typedef GAS unsigned gu32;
typedef GAS unsigned long long gu64;
#define RLX_AGENT __ATOMIC_RELAXED, __HIP_MEMORY_SCOPE_AGENT
#define LDS_WAIT() asm volatile("s_waitcnt lgkmcnt(0)" ::: "memory")
#define VM_WAIT() asm volatile("s_waitcnt vmcnt(0)" ::: "memory")
__device__ __forceinline__ unsigned long long rt() { return __builtin_amdgcn_s_memrealtime(); }
__device__ __forceinline__ unsigned f2bf(float f) { unsigned u = __builtin_bit_cast(unsigned, f); return (u + 0x7fffu + ((u >> 16) & 1u)) >> 16; }
__device__ __forceinline__ unsigned pk2(float lo, float hi) { return f2bf(lo) | (f2bf(hi) << 16); }

#define XB_TMO      128
#define XB_XCNT(j)  (256  + 64 * (j))
#define XB_XSUB(j)  (1280 + 64 * (j))
#define XB_XGEN(j)  (2304 + 64 * (j))
#define XB_TOP      3328
#define XB_TOPGEN   3392
#define XCD_BAR_WORDS 3456
#define XB_SPIN_CAP (1u << 18)

__device__ __forceinline__ unsigned xb_ld(unsigned* p)              { return __hip_atomic_load(p, __ATOMIC_RELAXED, __HIP_MEMORY_SCOPE_AGENT); }
__device__ __forceinline__ unsigned xb_add(unsigned* p, unsigned v) { return __hip_atomic_fetch_add(p, v, __ATOMIC_RELAXED, __HIP_MEMORY_SCOPE_AGENT); }
__device__ __forceinline__ unsigned xb_xcc_id() { return (unsigned)__builtin_amdgcn_s_getreg((3 << 11) | 20) & 0xFu; }
#define XB_SPIN(cond, bar) do { unsigned _sp = 0; while (cond) { __builtin_amdgcn_s_sleep(1); \
    if ((++_sp & 255u) == 0u) { if (xb_ld(&(bar)[XB_TMO])) break; if (_sp > XB_SPIN_CAP) { atomicAdd(&(bar)[XB_TMO], 1u); break; } } } } while (0)

struct XcdBarrier {
    unsigned* bar; unsigned x;
    volatile LAS unsigned* st;
};

__device__ __forceinline__ XcdBarrier xcd_barrier_post(unsigned* bar, volatile LAS unsigned* st) {
    XcdBarrier b; b.bar = bar; b.x = xb_xcc_id(); b.st = st;
    if (threadIdx.x == 0) (void)xb_add(&bar[XB_XCNT(b.x)], 1u);
    return b;
}
__device__ __forceinline__ void xcd_barrier_complete(unsigned* bar, unsigned x, unsigned& nloc, unsigned& nx) {
    const unsigned G = gridDim.x * gridDim.y * gridDim.z;
    unsigned sum, cnt, mine, sp = 0u;
    for (;;) {
        sum = 0u; cnt = 0u; mine = 0u;
#pragma unroll
        for (unsigned j = 0; j < 16; ++j) { const unsigned c = xb_ld(&bar[XB_XCNT(j)]); sum += c; cnt += (c > 0u) ? 1u : 0u; mine = (j == x) ? c : mine; }
        if (sum == G) break;
        __builtin_amdgcn_s_sleep(1);
        if ((++sp & 255u) == 0u) { if (xb_ld(&bar[XB_TMO])) break; if (sp > XB_SPIN_CAP) { atomicAdd(&bar[XB_TMO], 1u); break; } }
    }
    nloc = mine > 0u ? mine : 1u; nx = cnt > 0u ? cnt : 1u;
}

__device__ __forceinline__ void xcd_barrier(const XcdBarrier& b) {
    asm volatile("s_waitcnt vmcnt(0)" ::: "memory");
    __syncthreads();
    if (threadIdx.x == 0) {
        unsigned* bar = b.bar;
        __builtin_amdgcn_s_waitcnt(0);
        unsigned nloc = b.st[0], nx = b.st[1];
        if (nloc == 0u) { xcd_barrier_complete(bar, b.x, nloc, nx); b.st[0] = nloc; b.st[1] = nx; }
        const unsigned old = xb_add(&bar[XB_XSUB(b.x)], 1u);
        const unsigned gen = old / nloc;
        if (old + 1u == (gen + 1u) * nloc) {
            __builtin_amdgcn_fence(__ATOMIC_RELEASE, "agent");
            asm volatile("s_waitcnt vmcnt(0)" ::: "memory");
            const unsigned og = xb_add(&bar[XB_TOP], 1u);
            const unsigned tg = og / nx;
            if (og + 1u == (tg + 1u) * nx) xb_add(&bar[XB_TOPGEN], 1u);
            else XB_SPIN(xb_ld(&bar[XB_TOPGEN]) == tg, bar);
            __builtin_amdgcn_fence(__ATOMIC_ACQUIRE, "agent");
            xb_add(&bar[XB_XGEN(b.x)], 1u);
            asm volatile("s_waitcnt vmcnt(0)" ::: "memory");
        } else {
            XB_SPIN(xb_ld(&bar[XB_XGEN(b.x)]) == gen, bar);
            __builtin_amdgcn_fence(__ATOMIC_ACQUIRE, "agent");
            asm volatile("s_waitcnt vmcnt(0)" ::: "memory");
        }
    }
    __syncthreads();
}
struct Args { const float* in[25]; float* out; unsigned char* ws; int ph_lo, ph_hi, use_bar, pad; };
typedef const __attribute__((address_space(4))) Args* KArgs;
#define CAND_LIST CAND(0,0,2,1) CAND(0,1,2,2) CAND(0,2,2,3) CAND(0,3,2,4) CAND(0,4,3,0) CAND(0,5,3,1) CAND(0,6,3,2) CAND(0,7,3,3) CAND(0,8,4,0) CAND(0,9,4,1) CAND(0,10,4,2) CAND(0,11,5,0) CAND(0,12,5,1) CAND(0,13,6,0) CAND(0,14,6,1) CAND(0,15,7,0) CAND(1,0,7,1) CAND(1,1,8,0) CAND(1,2,9,0) CAND(1,3,10,0) CAND(1,4,11,0) CAND(1,5,12,0) CAND(1,6,13,0) CAND(1,7,14,0) CAND(2,0,15,0)
constexpr int NB = 8, SEQ = 4096, DM = 1024, NTOK = NB * SEQ;
constexpr int NH = 8, HD = 64, AW = 512, PWD = 256, SWD = 256, INC = 2056;
constexpr int NEXP = 16384, PQW = 2048;
constexpr float EPSN = 1e-6f, LOG2E = 1.4426950408889634f;
constexpr int NWAVES = 8, NTHR = 512;
constexpr size_t MiB = 1u << 20;
constexpr size_t WS_CTL = 0, CTL_ZERO_BYTES = 1 * MiB;
constexpr size_t WS_WIN = 1 * MiB;
constexpr size_t WS_WOUT = 9 * MiB;
constexpr size_t WS_WQ = 13 * MiB;
constexpr size_t WS_KEYS = 21 * MiB;
constexpr size_t WS_WGLU = 22 * MiB;
constexpr size_t WS_WF = 22 * MiB + 512 * 1024;
constexpr size_t WS_CB = 23 * MiB;
constexpr size_t WS_XLOC = 24 * MiB;
constexpr size_t WS_IDX = 28 * MiB;
constexpr size_t WS_GATE = 44 * MiB;
constexpr size_t WS_Z = 60 * MiB;
constexpr size_t WS_U = 76 * MiB;
constexpr size_t WS_V = 140 * MiB;
constexpr size_t WS_XN8 = 172 * MiB;
constexpr size_t WS_HSC = 22 * MiB + 768 * 1024;
constexpr size_t WS_XN = 204 * MiB;
constexpr size_t WS_P = 268 * MiB;
constexpr size_t WS_MG = 396 * MiB;
constexpr size_t WS_END = 460 * MiB;
constexpr int CW_BAR = 4096, CW_AQ = 20480;
constexpr float U8_SCALE = 768.f, V8_SCALE = 32.f, ACT_SCALE = 64.f;
constexpr int RING_BYTES = 131072, LDSCTL_OFF = RING_BYTES, MISC_OFF = LDSCTL_OFF + 320, EPIX_OFF = LDSCTL_OFF + 4096, LDS_BYTES = 163840;
static_assert(attn_body::ATTN_LDS_BYTES + 16 <= RING_BYTES, "attention scratch fits the ring");

typedef _Float16 h16x2 __attribute__((ext_vector_type(2)));
typedef float f32x16 __attribute__((ext_vector_type(16)));
typedef unsigned u32x2 __attribute__((ext_vector_type(2)));

__device__ __forceinline__ float bf2f(unsigned short b) { return __uint_as_float((unsigned)b << 16); }
__device__ __forceinline__ float bflo(unsigned w) { return __uint_as_float(w << 16); }
__device__ __forceinline__ float bfhi(unsigned w) { return __uint_as_float(w & 0xffff0000u); }
__device__ __forceinline__ h16x2 as_h2(unsigned w) { return __builtin_bit_cast(h16x2, w); }
template <bool HI> __device__ __forceinline__ h16x2 cvt8h(int w) { return __builtin_bit_cast(h16x2, __builtin_amdgcn_cvt_scalef32_pk_f16_fp8(w, 1.0f, HI)); }
__device__ __forceinline__ float gelu_tanh(float x) { const float u = 1.5957691216057308f * (x + 0.044715f * x * x * x); return x / (1.f + __expf(-u)); }
__device__ __forceinline__ float wave_sum(float v) {
#pragma unroll
    for (int o = 1; o < 64; o <<= 1) v += __shfl_xor(v, o);
    return v;
}
__device__ __forceinline__ float wave_max(float v) {
#pragma unroll
    for (int o = 1; o < 64; o <<= 1) v = fmaxf(v, __shfl_xor(v, o));
    return v;
}
template <int N, int S0> __device__ __forceinline__ float bfly_reduce(float (&v)[N], int lane) {
    int s = S0;
#pragma unroll
    for (int cnt = N; cnt > 1; cnt >>= 1) {
        const bool up = (lane & s) != 0;
#pragma unroll
        for (int i = 0; i < cnt / 2; ++i) { const float a = v[i], b = v[i + cnt / 2]; const float send = up ? a : b, keep = up ? b : a; v[i] = keep + __shfl_xor(send, s); }
        s >>= 1;
    }
    float r = v[0];
    for (; s >= 1; s >>= 1) r += __shfl_xor(r, s);
    return r;
}

__device__ __forceinline__ void tr_item(const float* W, int ldw, int srccol, bf16* WT, int K, int dstrow, int k0, LAS float* scr, int lane) {
#pragma unroll 8
    for (int i = 0; i < 32; ++i) { const int kk = 2 * i + (lane >> 5); scr[kk * 33 + (lane & 31)] = W[(size_t)(k0 + kk) * ldw + srccol + (lane & 31)]; }
    LDS_WAIT(); asm volatile("" ::: "memory");
    const int c = lane & 7;
#pragma unroll
    for (int j = 0; j < 4; ++j) { const int n = (lane >> 3) + 8 * j; const LAS float* s = scr + (8 * c) * 33 + n;
        v4u o; o.x = pk2(s[0 * 33], s[1 * 33]); o.y = pk2(s[2 * 33], s[3 * 33]); o.z = pk2(s[4 * 33], s[5 * 33]); o.w = pk2(s[6 * 33], s[7 * 33]);
        *(GAS v4u*)(WT + (size_t)(dstrow + n) * K + k0 + 8 * c) = o; }
    LDS_WAIT(); asm volatile("" ::: "memory");
}
__device__ __forceinline__ void phase_prep(KArgs a, LAS unsigned char* lds, int G, int vcu, int tid, int lane, int wave) {
    unsigned char* ws = a->ws;
    LAS float* scr = (LAS float*)(lds + wave * 16384);
    const int gw = vcu * NWAVES + wave, NGW = G * NWAVES;
    constexpr int I_IN = 2048, I_OUT = 1024, I_WQ = 2048, I_GLU = 64;
    for (int it = gw; it < I_IN + I_OUT + I_WQ + I_GLU; it += NGW) {
        int r = it;
        if (r < I_IN) { const int l = r >> 10, q = r & 1023, kb = q >> 6, nb = q & 63, n0 = nb * 32;
            tr_item(a->in[2] + (size_t)l * DM * INC, INC, n0 + (n0 >= 1536 ? 8 : 0), (bf16*)(ws + WS_WIN) + (size_t)l * 2048 * 1024, 1024, n0, kb * 64, scr, lane); continue; }
        r -= I_IN;
        if (r < I_OUT) { const int l = r >> 9, q = r & 511, kb = q >> 5, nb = q & 31;
            tr_item(a->in[19] + (size_t)l * DM * DM, DM, nb * 32, (bf16*)(ws + WS_WOUT) + (size_t)l * 1024 * 1024, 1024, nb * 32, kb * 64, scr, lane); continue; }
        r -= I_OUT;
        if (r < I_WQ) { const int l = r >> 10, q = r & 1023, kb = q >> 6, nb = q & 63;
            tr_item(a->in[21] + (size_t)l * DM * PQW, PQW, nb * 32, (bf16*)(ws + WS_WQ) + (size_t)l * 2048 * 1024, 1024, nb * 32, kb * 64, scr, lane); continue; }
        r -= I_WQ;
        { const int l = r >> 5, q = r & 31, kb = q >> 3, nb = q & 7;
            tr_item(a->in[16] + (size_t)l * 256 * 256, 256, nb * 32, (bf16*)(ws + WS_WGLU) + (size_t)l * 256 * 256, 256, nb * 32, kb * 64, scr, lane); }
    }
    const size_t gt = (size_t)vcu * NTHR + tid, NGT = (size_t)G * NTHR;
    for (size_t i = gt; i < 2 * 8 * 1024; i += NGT) { const int l = (int)(i >> 13), h = (int)(i >> 10) & 7, k = (int)i & 1023;
        ((float*)(ws + WS_WF))[i] = a->in[2][((size_t)l * DM + k) * INC + 1536 + h]; }
    { const float* src = a->in[22]; bf16* dst = (bf16*)(ws + WS_KEYS);
      for (size_t i = gt; i < (size_t)2 * 8 * 2 * 128 * 128 / 8; i += NGT) { const f32x4 x0 = *(const f32x4*)(src + i * 8), x1 = *(const f32x4*)(src + i * 8 + 4);
          v4u o; o.x = pk2(x0[0], x0[1]); o.y = pk2(x0[2], x0[3]); o.z = pk2(x1[0], x1[1]); o.w = pk2(x1[2], x1[3]); *(v4u*)(dst + i * 8) = o; } }
    { const float* src = a->in[23]; unsigned char* dst = ws + WS_U;
#pragma unroll 1
      for (size_t i = gt; i < (size_t)2 * NEXP * DM / 16; i += NGT) { v4u o;
#pragma unroll
          for (int q = 0; q < 4; ++q) { const f32x4 x = *(const f32x4*)(src + i * 16 + 4 * q) * U8_SCALE;
              const int q0 = (int)__builtin_rintf(fminf(fmaxf(x[0], -127.f), 127.f)), q1 = (int)__builtin_rintf(fminf(fmaxf(x[1], -127.f), 127.f)), q2 = (int)__builtin_rintf(fminf(fmaxf(x[2], -127.f), 127.f)), q3 = (int)__builtin_rintf(fminf(fmaxf(x[3], -127.f), 127.f));
              o[q] = (unsigned)((q0 & 255) | ((q1 & 255) << 8) | ((q2 & 255) << 16) | (q3 << 24)); }
          const size_t r = i >> 6; const unsigned cg = (unsigned)(i & 63), l = (unsigned)(r / NEXP), rl = (unsigned)(r % NEXP);
          *(v4u*)(dst + (size_t)l * NEXP * DM + (size_t)(cg >> 3) * NEXP * 128 + (size_t)rl * 128 + (cg & 7u) * 16u) = o; } }
    { const float* src = a->in[24]; unsigned char* dst = ws + WS_V;
#pragma unroll 1
      for (size_t i = gt; i < (size_t)2 * NEXP * DM / 16; i += NGT) { v4u o;
#pragma unroll
          for (int q = 0; q < 4; ++q) { f32x4 x = *(const f32x4*)(src + i * 16 + 4 * q) * V8_SCALE;
              x[0] = fminf(fmaxf(x[0], -448.f), 448.f); x[1] = fminf(fmaxf(x[1], -448.f), 448.f); x[2] = fminf(fmaxf(x[2], -448.f), 448.f); x[3] = fminf(fmaxf(x[3], -448.f), 448.f);
              int w = 0; w = __builtin_amdgcn_cvt_pk_fp8_f32(x[0], x[1], w, false); w = __builtin_amdgcn_cvt_pk_fp8_f32(x[2], x[3], w, true); o[q] = (unsigned)w; }
          const size_t r = i >> 6; const unsigned cg = (unsigned)(i & 63), l = (unsigned)(r / NEXP), rl = (unsigned)(r % NEXP);
          *(v4u*)(dst + (size_t)l * NEXP * DM + (size_t)(cg >> 3) * NEXP * 128 + (size_t)rl * 128 + (cg & 7u) * 16u) = o; } }
}

template <bool FLOGIT> __device__ __forceinline__ void phase_rownorm(const float* x, const float* g, bf16* XN, const float* WF, const float* fbias, float* CB, int G, int vcu, int lane, int wave, unsigned char* XN8 = nullptr, float* HSC = nullptr) {
    const int gw = vcu * NWAVES + wave, NGW = G * NWAVES;
    f32x4 gv[4];
#pragma unroll
    for (int j = 0; j < 4; ++j) gv[j] = *(const f32x4*)(g + 4 * lane + 256 * j);
    f32x4 vn[2][4];
#define RN_LOAD(rg_) do { _Pragma("unroll") for (int r = 0; r < 2; ++r) { const float* xr = x + (size_t)((rg_) * 2 + r) * DM + 4 * lane; _Pragma("unroll") for (int j = 0; j < 4; ++j) vn[r][j] = *(const f32x4*)(xr + 256 * j); } } while (0)
    if (gw < NTOK / 2) RN_LOAD(gw);
    for (int rg = gw; rg < NTOK / 2; rg += NGW) {
        f32x4 v[2][4];
#pragma unroll
        for (int r = 0; r < 2; ++r)
#pragma unroll
            for (int j = 0; j < 4; ++j) v[r][j] = vn[r][j];
        if (rg + NGW < NTOK / 2) RN_LOAD(rg + NGW);
#pragma unroll
        for (int r = 0; r < 2; ++r) { float s = 0.f;
#pragma unroll
            for (int j = 0; j < 4; ++j) s += (v[r][j][0] * v[r][j][0] + v[r][j][1] * v[r][j][1]) + (v[r][j][2] * v[r][j][2] + v[r][j][3] * v[r][j][3]);
            const float rstd = 1.0f / sqrtf(wave_sum(s) * (1.f / DM) + EPSN);
            bf16* orow = XN + (size_t)(rg * 2 + r) * DM + 4 * lane;
#pragma unroll
            for (int j = 0; j < 4; ++j) { v[r][j] = v[r][j] * rstd * gv[j]; u32x2 w; w.x = pk2(v[r][j][0], v[r][j][1]); w.y = pk2(v[r][j][2], v[r][j][3]); *(u32x2*)(orow + 256 * j) = w; }
            if (!FLOGIT && XN8) { float mx = 0.f;
#pragma unroll
                for (int j = 0; j < 4; ++j) mx = fmaxf(fmaxf(mx, fmaxf(fabsf(v[r][j][0]), fabsf(v[r][j][1]))), fmaxf(fabsf(v[r][j][2]), fabsf(v[r][j][3])));
                mx = fmaxf(wave_max(mx), 1e-20f); const float qs = 127.f / mx;
#pragma unroll
                for (int j = 0; j < 4; ++j) { const int q0 = (int)__builtin_rintf(v[r][j][0] * qs), q1 = (int)__builtin_rintf(v[r][j][1] * qs), q2 = (int)__builtin_rintf(v[r][j][2] * qs), q3 = (int)__builtin_rintf(v[r][j][3] * qs);
                    *(unsigned*)(XN8 + (size_t)(rg * 2 + r) * DM + 4 * lane + 256 * j) = (unsigned)((q0 & 255) | ((q1 & 255) << 8) | ((q2 & 255) << 16) | (q3 << 24)); }
                if (lane == 0) HSC[rg * 2 + r] = mx * (1.f / 127.f); } }
        if (FLOGIT) {
            float acc[16];
#pragma unroll
            for (int i = 0; i < 16; ++i) acc[i] = 0.f;
#pragma unroll
            for (int h = 0; h < 8; ++h)
#pragma unroll
                for (int j = 0; j < 4; ++j) { const f32x4 w = *(const f32x4*)(WF + h * 1024 + 4 * lane + 256 * j);
#pragma unroll
                    for (int r = 0; r < 2; ++r) acc[r * 8 + h] += (v[r][j][0] * w[0] + v[r][j][1] * w[1]) + (v[r][j][2] * w[2] + v[r][j][3] * w[3]); }
            const float tot = bfly_reduce<16, 32>(acc, lane);
            if ((lane & 3) == 0) { const int id = (lane >> 2) & 15, r = id >> 3, h = id & 7; const int row = rg * 2 + r, b = row / SEQ, s = row % SEQ;
                const float z = tot + fbias[h];
                const float ls = fminf(z, 0.f) - __logf(1.f + __expf(-fabsf(z)));
                CB[((size_t)(b * NH + h)) * SEQ + s] = ls * LOG2E; }
        }
    }
}

__device__ __forceinline__ void phase_cumsum(float* c, int lane) {
    float carry = 0.f;
#pragma unroll 1
    for (int it0 = 0; it0 < SEQ / 64; it0 += 16) { float vv[16];
#pragma unroll
        for (int q = 0; q < 16; ++q) vv[q] = c[(it0 + q) * 64 + lane];
#pragma unroll
        for (int q = 0; q < 16; ++q) { float v = vv[q];
#pragma unroll
            for (int o = 1; o < 64; o <<= 1) { const float t = __shfl_up(v, o); if (lane >= o) v += t; }
            v += carry; c[(it0 + q) * 64 + lane] = v; carry = __shfl(v, 63); } }
}

__device__ __forceinline__ void phase_pool(const bf16* PS, const float* pw, const float* pscale, const float* ong, bf16* MG, LAS unsigned char* lds, int G, int bx, int tid, int lane, int wave) {
    LAS float* ut = (LAS float*)lds;
    LAS float* pl = (LAS float*)(lds + 47 * 256 * 4);
    const int ch = tid & 255, half = tid >> 8, g = ch >> 6, w = 2 << g;
    float wcol[64];
#pragma unroll
    for (int c = 0; c < 64; ++c) wcol[c] = pw[(g * 64 + c) * 64 + (ch & 63)];
    const float psc = pscale[ch];
    const f32x4 gn = *(const f32x4*)(ong + 512 + 4 * lane);
    v4u wq[3];
#define POOL_LOAD(tile_) do { const int tok0_ = (tile_) * 32, s0_ = tok0_ % SEQ; _Pragma("unroll") for (int q = 0; q < 3; ++q) { const int idx = tid + q * NTHR, rr = idx >> 5, cq = idx & 31, r = rr - 15; \
        wq[q] = (v4u){0u, 0u, 0u, 0u}; if (idx < 47 * 32 && s0_ + r >= 0) wq[q] = *(const v4u*)(PS + (size_t)(tok0_ + r) * 512 + cq * 8); } } while (0)
    if (bx < NTOK / 32) POOL_LOAD(bx);
    for (int tile = bx; tile < NTOK / 32; tile += G) {
        const int tok0 = tile * 32, s0 = tok0 % SEQ;
#pragma unroll
        for (int q = 0; q < 3; ++q) { const int idx = tid + q * NTHR, rr = idx >> 5, cq = idx & 31; const v4u wv = wq[q];
            if (idx < 47 * 32) { LAS float* d = ut + rr * 256 + cq * 8;
                *(LAS f32x4*)d = (f32x4){bflo(wv.x), bfhi(wv.x), bflo(wv.y), bfhi(wv.y)}; *(LAS f32x4*)(d + 4) = (f32x4){bflo(wv.z), bfhi(wv.z), bflo(wv.w), bfhi(wv.w)}; } }
        if (tile + G < NTOK / 32) POOL_LOAD(tile + G);
        __syncthreads();
        { float s = 0.f; const int rr0 = half * 16 + 15;
            for (int j = 1; j < w; ++j) s += ut[(rr0 - j) * 256 + ch];
#pragma unroll 4
            for (int tt = 0; tt < 16; ++tt) { const int ti = half * 16 + tt, rr = ti + 15, pos = s0 + ti; const float cur = ut[rr * 256 + ch];
                s += cur; const int cnt = (pos + 1 < w) ? pos + 1 : w;
                pl[ti * 256 + ch] = s / (float)cnt - cur; s -= ut[(rr - w + 1) * 256 + ch]; } }
        __syncthreads();
#pragma unroll 1
        for (int tt = 0; tt < 16; ++tt) { const int ti = half * 16 + tt; const LAS f32x4* pr = (const LAS f32x4*)(pl + ti * 256 + g * 64);
            float acc = 0.f;
#pragma unroll
            for (int c4 = 0; c4 < 16; ++c4) { const f32x4 v = pr[c4]; acc += (v[0] * wcol[4 * c4] + v[1] * wcol[4 * c4 + 1]) + (v[2] * wcol[4 * c4 + 2] + v[3] * wcol[4 * c4 + 3]); }
            ut[ti * 256 + ch] = acc * psc; }
        __syncthreads();
#pragma unroll
        for (int q = 0; q < 4; ++q) { const int ti = wave * 4 + q; const f32x4 v = *(const LAS f32x4*)(ut + ti * 256 + 4 * lane);
            const float ss = wave_sum((v[0] * v[0] + v[1] * v[1]) + (v[2] * v[2] + v[3] * v[3]));
            const float rstd = 1.0f / sqrtf(ss * (1.f / 256.f) + EPSN);
            u32x2 o; o.x = pk2(v[0] * rstd * gn[0], v[1] * rstd * gn[1]); o.y = pk2(v[2] * rstd * gn[2], v[3] * rstd * gn[3]);
            *(u32x2*)(MG + (size_t)(tok0 + ti) * DM + 512 + 4 * lane) = o; }
        __syncthreads();
    }
}

template <bool PASS2> __device__ __forceinline__ void phase_s5(KArgs a, int l, const bf16* PS, float* XLOC, bf16* Z, LAS unsigned char* lds, int G, int bx, int lane, int wave) {
    LAS float* Xs = (LAS float*)(lds + wave * (16 * 130 * 4));
    const int p = lane, kq = lane >> 4, ln = lane & 15;
    for (int task = bx; task < NB * 16 * 8; task += G) {
        const int b = task >> 7, g = (task >> 3) & 15, c = (task & 7) * 8 + wave;
        const size_t tok_c = (size_t)b * SEQ + c * 64;
        const float a_re = a->in[8][(l * 16 + g) * 64 + p], a_im = a->in[9][(l * 16 + g) * 64 + p], ldt = a->in[10][l * 16 + g];
        u32x2 uraw[4];
#pragma unroll
        for (int sub = 0; sub < 4; ++sub) uraw[sub] = *(const u32x2*)(PS + (tok_c + sub * 16 + ln) * 512 + 256 + g * 16 + 4 * kq);
        float braw[4][4], biaw[4][4];
#pragma unroll
        for (int q = 0; q < 4; ++q)
#pragma unroll
            for (int ks = 0; ks < 4; ++ks) { const size_t bi = ((size_t)((l * 16 + g) * 64 + 16 * q + ln)) * 16 + 4 * kq + ks; braw[q][ks] = a->in[11][bi]; biaw[q][ks] = a->in[12][bi]; }
        float cfrag[32]; float dsk = 0.f; unsigned short usk[16];
        if (PASS2) {
#pragma unroll
            for (int ks = 0; ks < 32; ++ks) { const int k = 4 * ks + kq, pp = k & 63; const size_t ci = ((size_t)((l * 16 + g) * 16 + ln)) * 64 + pp;
                cfrag[ks] = (ks < 16) ? a->in[13][ci] : -a->in[14][ci]; }
            dsk = a->in[15][l * 256 + g * 16 + ln];
#pragma unroll
            for (int i = 0; i < 16; ++i) usk[i] = PS[(tok_c + (i >> 2) * 16 + 4 * kq + (i & 3)) * 512 + 256 + g * 16 + ln];
        }
        const float dt = expf(ldt);
        float abr, abi, fr, fi;
        { const float xx = a_re * dt, yy = a_im * dt; const float ex = expf(xx); float sn, cs; sincosf(yy, &sn, &cs);
          abr = ex * cs; abi = ex * sn;
          const float sh = sinf(0.5f * yy); const float er = expm1f(xx) * cs - 2.f * sh * sh, ei = abi;
          const float den = a_re * a_re + a_im * a_im; fr = (er * a_re + ei * a_im) / den; fi = (ei * a_re - er * a_im) / den; }
        float bfrag[8][4];
#pragma unroll
        for (int q = 0; q < 4; ++q) { const float frq = __shfl(fr, 16 * q + ln), fiq = __shfl(fi, 16 * q + ln);
#pragma unroll
            for (int ks = 0; ks < 4; ++ks) { bfrag[q][ks] = frq * braw[q][ks] - fiq * biaw[q][ks]; bfrag[4 + q][ks] = frq * biaw[q][ks] + fiq * braw[q][ks]; } }
        float xr = 0.f, xi = 0.f;
        if (PASS2) {
            float pr = abr, pi = abi;
#pragma unroll
            for (int q = 0; q < 6; ++q) { const float nr = pr * pr - pi * pi, ni = 2.f * pr * pi; pr = nr; pi = ni; }
            const float* xl = XLOC + ((size_t)(b * 16 + g) * 64) * 128 + p;
            int j = 0;
#pragma unroll 1
            for (; j + 16 <= c; j += 16) { float lr[16], li[16];
#pragma unroll
                for (int q = 0; q < 16; ++q) { lr[q] = xl[(size_t)(j + q) * 128]; li[q] = xl[(size_t)(j + q) * 128 + 64]; }
#pragma unroll
                for (int q = 0; q < 16; ++q) { const float nr = pr * xr - pi * xi + lr[q], ni = pr * xi + pi * xr + li[q]; xr = nr; xi = ni; } }
            { float lr[16], li[16];
#pragma unroll
                for (int q = 0; q < 16; ++q) { const int jj = (j + q < c) ? j + q : 0; lr[q] = xl[(size_t)jj * 128]; li[q] = xl[(size_t)jj * 128 + 64]; }
#pragma unroll
                for (int q = 0; q < 16; ++q) if (j + q < c) { const float nr = pr * xr - pi * xi + lr[q], ni = pr * xi + pi * xr + li[q]; xr = nr; xi = ni; } }
        }
#pragma unroll
        for (int sub = 0; sub < 4; ++sub) {
            const size_t tokb = tok_c + sub * 16;
            const float ua[4] = {bflo(uraw[sub].x), bfhi(uraw[sub].x), bflo(uraw[sub].y), bfhi(uraw[sub].y)};
#pragma unroll
            for (int nb = 0; nb < 8; ++nb) { f32x4 acc = {0.f, 0.f, 0.f, 0.f};
#pragma unroll
                for (int ks = 0; ks < 4; ++ks) acc = __builtin_amdgcn_mfma_f32_16x16x4f32(ua[ks], bfrag[nb][ks], acc, 0, 0, 0);
#pragma unroll
                for (int r = 0; r < 4; ++r) Xs[(4 * kq + r) * 130 + 16 * nb + ln] = acc[r]; }
            float bur[16], bui[16];
#pragma unroll
            for (int i = 0; i < 16; ++i) { bur[i] = Xs[i * 130 + p]; bui[i] = Xs[i * 130 + 64 + p]; }
#pragma unroll
            for (int i = 0; i < 16; ++i) { const float nr = abr * xr - abi * xi + bur[i], ni = abr * xi + abi * xr + bui[i]; xr = nr; xi = ni;
                if (PASS2) { Xs[i * 130 + p] = xr; Xs[i * 130 + 64 + p] = xi; } }
            if (PASS2) {
                f32x4 y0 = {0.f, 0.f, 0.f, 0.f}, y1 = {0.f, 0.f, 0.f, 0.f};
#pragma unroll
                for (int ks = 0; ks < 32; ks += 2) { y0 = __builtin_amdgcn_mfma_f32_16x16x4f32(Xs[ln * 130 + 4 * ks + kq], cfrag[ks], y0, 0, 0, 0);
                    y1 = __builtin_amdgcn_mfma_f32_16x16x4f32(Xs[ln * 130 + 4 * (ks + 1) + kq], cfrag[ks + 1], y1, 0, 0, 0); }
#pragma unroll
                for (int r = 0; r < 4; ++r) { const size_t tk = tokb + 4 * kq + r; const float uv = bf2f(usk[sub * 4 + r]);
                    const float y = y0[r] + y1[r] + dsk * uv; Z[tk * 256 + g * 16 + ln] = (bf16)f2bf(gelu_tanh(y)); }
            }
        }
        if (!PASS2) { float* xl = XLOC + ((size_t)((b * 16 + g) * 64 + c)) * 128 + p; xl[0] = xr; xl[64] = xi; }
    }
}

__device__ __forceinline__ void phase_glu(const bf16* Z, const bf16* WG, const float* gb, const float* ong, bf16* MG, LAS unsigned char* lds, int G, int bx, int vcu, int tid, int lane, int wave) {
    LAS unsigned char* zt = lds;
    LAS float* ssq = (LAS float*)(lds + 64 * 528);
    LAS float* rs = ssq + 64 * 8;
    const int n = 32 * wave + (lane & 31), hs = lane >> 5;
    const float bn = gb[n], gnn = ong[768 + n];
    for (int tile = bx; tile < NTOK / 64; tile += G) {
        const size_t tok0 = (size_t)tile * 64;
        for (int idx = tid; idx < 64 * 32; idx += NTHR) { const int r = idx >> 5, cq = idx & 31; *(LAS v4u*)(zt + r * 528 + cq * 16) = *(const v4u*)(Z + (tok0 + r) * 256 + cq * 8); }
        __syncthreads();
        f32x16 acc[2]; acc[0] = f32x16{}; acc[1] = f32x16{};
#pragma unroll
        for (int ks = 0; ks < 16; ++ks) { const bf16x8 bw = *(const bf16x8*)(WG + (size_t)n * 256 + ks * 16 + 8 * hs);
#pragma unroll
            for (int mb = 0; mb < 2; ++mb) { const bf16x8 az = *(const LAS bf16x8*)(zt + (mb * 32 + (lane & 31)) * 528 + (ks * 16 + 8 * hs) * 2);
                acc[mb] = __builtin_amdgcn_mfma_f32_32x32x16_bf16(az, bw, acc[mb], 0, 0, 0); } }
        float val[32], sq[32];
#pragma unroll
        for (int mb = 0; mb < 2; ++mb)
#pragma unroll
            for (int r = 0; r < 16; ++r) { const int m = mb * 32 + (r & 3) + 8 * (r >> 2) + 4 * hs; const float z = bf2f(*(const LAS unsigned short*)(zt + m * 528 + n * 2));
                const float v = z / (1.f + __expf(-(acc[mb][r] + bn))); val[mb * 16 + r] = v; sq[mb * 16 + r] = v * v; }
        const float tot = bfly_reduce<32, 16>(sq, lane);
        { const int id = lane & 31, mb = id >> 4, r = id & 15, m = mb * 32 + (r & 3) + 8 * (r >> 2) + 4 * hs; ssq[m * 8 + wave] = tot; }
        __syncthreads();
        if (tid < 64) { float s = 0.f;
#pragma unroll
            for (int w8 = 0; w8 < 8; ++w8) s += ssq[tid * 8 + w8];
            rs[tid] = 1.0f / sqrtf(s * (1.f / 256.f) + EPSN); }
        __syncthreads();
#pragma unroll
        for (int mb = 0; mb < 2; ++mb)
#pragma unroll
            for (int r = 0; r < 16; ++r) { const int m = mb * 32 + (r & 3) + 8 * (r >> 2) + 4 * hs;
                MG[(tok0 + m) * DM + 768 + n] = (bf16)f2bf(val[mb * 16 + r] * rs[m] * gnn); }
        __syncthreads();
    }
    const int gw = vcu * NWAVES + wave, NGW = G * NWAVES;
    float g8[8];
#pragma unroll
    for (int j = 0; j < 8; ++j) g8[j] = ong[8 * lane + j];
    for (int row = gw; row < NTOK; row += NGW) {
        bf16* pp = MG + (size_t)row * DM + 8 * lane;
        const v4u w = *(const v4u*)pp; float f[8] = {bflo(w.x), bfhi(w.x), bflo(w.y), bfhi(w.y), bflo(w.z), bfhi(w.z), bflo(w.w), bfhi(w.w)};
        float s = 0.f;
#pragma unroll
        for (int j = 0; j < 8; ++j) s += f[j] * f[j];
        const float rstd = 1.0f / sqrtf(wave_sum(s) * (1.f / 512.f) + EPSN);
        v4u o; o.x = pk2(f[0] * rstd * g8[0], f[1] * rstd * g8[1]); o.y = pk2(f[2] * rstd * g8[2], f[3] * rstd * g8[3]);
        o.z = pk2(f[4] * rstd * g8[4], f[5] * rstd * g8[5]); o.w = pk2(f[6] * rstd * g8[6], f[7] * rstd * g8[7]); *(v4u*)pp = o;
    }
}

__device__ __forceinline__ void ins16(float (&top)[16], float x) {
#pragma unroll
    for (int i = 15; i >= 1; --i) top[i] = __builtin_amdgcn_fmed3f(top[i - 1], top[i], x);
    top[0] = fmaxf(top[0], x);
}
__device__ __forceinline__ float opq(float x) { asm("" : "+v"(x)); return x; }
__device__ __forceinline__ float tagf(float s, unsigned id, unsigned mask) { return __uint_as_float((__float_as_uint(s) & ~mask) | id); }
__device__ __forceinline__ void phase_select(const bf16* PQ, const bf16* KEYS, int* IDX, float* GATE, LAS unsigned char* lds, int G, int vcu, int tid, int lane, int wave) {
    constexpr int KROW = 272, KEYB = 2 * 128 * KROW;
    LAS unsigned* ids = (LAS unsigned*)(lds + KEYB + wave * 4096);
    const int tl = lane & 31, hs = lane >> 5;
    const float NEG = -__builtin_inff();
    const int nslot = (G >= 8) ? G / 8 : 1;
    for (int h = vcu % 8; h < 8; h += (G >= 8 ? 8 : G)) {
        __syncthreads();
        for (int idx = tid; idx < 2 * 128 * 16; idx += NTHR) { const int row = idx >> 4, cq = idx & 15;
            *(LAS v4u*)(lds + row * KROW + cq * 16) = *(const v4u*)((const char*)(KEYS + (size_t)h * 256 * 128) + (unsigned)(row * 256 + cq * 16)); }
        __syncthreads();
        const int slot = (G >= 8) ? vcu / 8 : 0;
        bf16x8 bq[2][8];
        int tb = slot * 8 + wave;
        if (tb < NTOK / 32) {
#pragma unroll
            for (int ks = 0; ks < 8; ++ks) bq[0][ks] = *(const bf16x8*)(PQ + ((size_t)tb * 32 + tl) * PQW + h * 256 + 8 * hs + ks * 16);
        }
#pragma unroll 1
        for (; tb < NTOK / 32; tb += 8 * nslot) {
            const size_t tok = (size_t)tb * 32 + tl;
            float t1[16], t2[16];
#pragma unroll
            for (int half = 0; half < 2; ++half) {
                { const int ntb = (half == 0) ? tb : tb + 8 * nslot; const int ntbc = (ntb < NTOK / 32) ? ntb : tb;
                  const bf16* qn = PQ + ((size_t)ntbc * 32 + tl) * PQW + h * 256 + (half == 0 ? 128 : 0) + 8 * hs;
#pragma unroll
                  for (int ks = 0; ks < 8; ++ks) bq[half ^ 1][ks] = *(const bf16x8*)(qn + ks * 16); }
                f32x16 acc[4]; acc[0] = f32x16{}; acc[1] = f32x16{}; acc[2] = f32x16{}; acc[3] = f32x16{};
                const LAS unsigned char* kp = lds + (half * 128 + tl) * KROW + 16 * hs;
#pragma unroll
                for (int ks = 0; ks < 8; ++ks)
#pragma unroll
                    for (int kb = 0; kb < 4; ++kb) { const bf16x8 ak = *(const LAS bf16x8*)(kp + kb * 32 * KROW + ks * 32); acc[kb] = __builtin_amdgcn_mfma_f32_32x32x16_bf16(ak, bq[half][ks], acc[kb], 0, 0, 0); }
                float top[16];
#pragma unroll
                for (int i = 0; i < 16; ++i) top[i] = NEG;
#pragma unroll
                for (int kb = 0; kb < 4; ++kb)
#pragma unroll
                    for (int r = 0; r < 16; ++r) ins16(top, tagf(acc[kb][r], (unsigned)(32 * kb + (r & 3) + 8 * (r >> 2) + 4 * hs), 127u));
                float oth[16];
#pragma unroll
                for (int i = 0; i < 16; ++i) oth[i] = __shfl_xor(top[i], 32);
#pragma unroll
                for (int i = 0; i < 16; ++i) ins16(top, oth[i]);
#pragma unroll
                for (int i = 0; i < 16; ++i) { if (half == 0) t1[i] = top[i]; else t2[i] = top[i]; }
            }
#pragma unroll
            for (int i = 0; i < 16; ++i) ids[(tl * 2 + hs) * 16 + i] = __float_as_uint(hs ? opq(t2[i]) : opq(t1[i])) & 127u;
            float best[16];
#pragma unroll
            for (int i = 0; i < 16; ++i) best[i] = NEG;
#define CAND(a0, b0, a1, b1) { const float s0_ = opq(t1[a0] + t2[b0]), s1_ = opq(t1[a1] + t2[b1]); ins16(best, hs ? tagf(s1_, (unsigned)((a1) * 16 + (b1)), 255u) : tagf(s0_, (unsigned)((a0) * 16 + (b0)), 255u)); }
            CAND_LIST
#undef CAND
            { float oth[16];
#pragma unroll
              for (int i = 0; i < 16; ++i) oth[i] = __shfl_xor(best[i], 32);
#pragma unroll
              for (int i = 0; i < 16; ++i) ins16(best, oth[i]); }
            float e[16], den = 0.f;
#pragma unroll
            for (int i = 0; i < 16; ++i) { e[i] = __expf(best[i] - best[0]); den += e[i]; }
            const float rden = 1.f / den;
            int ex[8]; float gt[8];
#pragma unroll
            for (int j = 0; j < 8; ++j) { const float bj = hs ? opq(best[8 + j]) : opq(best[j]); const unsigned id = __float_as_uint(bj) & 255u;
                const unsigned i1 = ids[(tl * 2 + 0) * 16 + (id >> 4)], i2 = ids[(tl * 2 + 1) * 16 + (id & 15u)];
                ex[j] = (int)(i1 * 128u + i2); gt[j] = (hs ? opq(e[8 + j]) : opq(e[j])) * rden; }
            int* ip = IDX + tok * 128 + h * 16 + hs * 8; float* gp = GATE + tok * 128 + h * 16 + hs * 8;
            *(v4u*)ip = (v4u){(unsigned)ex[0], (unsigned)ex[1], (unsigned)ex[2], (unsigned)ex[3]}; *(v4u*)(ip + 4) = (v4u){(unsigned)ex[4], (unsigned)ex[5], (unsigned)ex[6], (unsigned)ex[7]};
            *(f32x4*)gp = (f32x4){gt[0], gt[1], gt[2], gt[3]}; *(f32x4*)(gp + 4) = (f32x4){gt[4], gt[5], gt[6], gt[7]};
        }
    }
}

constexpr int GCH = 32;
constexpr int CW_Q = 8192;
template <int CTRL> __device__ __forceinline__ float dpp_mov(float v) { return __builtin_bit_cast(float, __builtin_amdgcn_update_dpp(0, __builtin_bit_cast(int, v), CTRL, 0xF, 0xF, true)); }
__device__ __forceinline__ float sum8(float s) {
    s += dpp_mov<0xB1>(s); s += dpp_mov<0x4E>(s); s += dpp_mov<0x141>(s); return s;
}
__device__ __forceinline__ void phase_gather_u(const unsigned char* XN8, const int* IDX, const unsigned char* U, float* PART, unsigned* queue, int lane, unsigned imask = 0xffffffffu) {
    const unsigned xcc = xb_xcc_id() & 7u; const int g = lane >> 3, j = lane & 7;
#pragma unroll 1
    for (unsigned sx = 0; sx < 8; ++sx) { const unsigned x = (xcc + sx) & 7u; unsigned* q = queue + x * 64;
        const unsigned char* Ux = U + (size_t)x * NEXP * 128; const unsigned jo = (unsigned)j * 16u, lane4 = (unsigned)lane * 4u; const unsigned char* Hx = XN8 + x * 128 + j * 16; const int* Ig = IDX + 16 * g;
#pragma unroll 1
        for (;;) {
            unsigned c = 0; if (lane == 0) c = __hip_atomic_fetch_add(q, 1u, __ATOMIC_RELAXED, __HIP_MEMORY_SCOPE_AGENT);
            c = (unsigned)__builtin_amdgcn_readfirstlane((int)c); if (c >= (unsigned)(NTOK / GCH)) break;
            const size_t tb = (size_t)c * GCH;
            v4u ix[2][4], hw[2], rw[16];
#define G1_IDX(ib, tok_) do { _Pragma("unroll") for (int q4 = 0; q4 < 4; ++q4) ix[ib][q4] = *(const v4u*)(Ig + (tok_) * 128 + 4 * q4) & imask; } while (0)
#define G1_AUX(ab, tok_) do { hw[ab] = *(const v4u*)(Hx + (tok_) * DM); } while (0)
#define G1_TOKEN(p, tt_) do { G1_AUX((p) ^ 1, tb + (((tt_) + 1 < GCH) ? (tt_) + 1 : (tt_))); \
            const v4u hq_ = hw[p]; int r0 = 0, r1 = 0; \
            _Pragma("unroll") for (int i = 0; i < 16; ++i) { const v4u rv_ = rw[i]; \
                rw[i] = *(const v4u*)(Ux + (ix[(p) ^ 1][i >> 2][i & 3] * 128u + jo)); \
                int s = __builtin_amdgcn_sdot4((int)hq_[0], (int)rv_[0], 0, false); s = __builtin_amdgcn_sdot4((int)hq_[1], (int)rv_[1], s, false); \
                s = __builtin_amdgcn_sdot4((int)hq_[2], (int)rv_[2], s, false); s = __builtin_amdgcn_sdot4((int)hq_[3], (int)rv_[3], s, false); \
                s += __builtin_amdgcn_update_dpp(0, s, 0xB1, 0xF, 0xF, true); s += __builtin_amdgcn_update_dpp(0, s, 0x4E, 0xF, 0xF, true); s += __builtin_amdgcn_update_dpp(0, s, 0x141, 0xF, 0xF, true); \
                if (i < 8) r0 = ((i & 7) == j) ? s : r0; else r1 = ((i & 7) == j) ? s : r1; } \
            unsigned* pp = (unsigned*)PART + ((size_t)x * NTOK + tb + (tt_)) * 64; *(unsigned*)((char*)pp + lane4) = pk2((float)r0, (float)r1);     \
            G1_IDX(p, tb + (((tt_) + 2 < GCH) ? (tt_) + 2 : (tt_))); } while (0)
            G1_IDX(0, tb); G1_IDX(1, tb + 1); G1_AUX(0, tb);
#pragma unroll
            for (int i = 0; i < 16; ++i) rw[i] = *(const v4u*)(Ux + (ix[0][i >> 2][i & 3] * 128u + jo));
#pragma unroll 1
            for (int tt = 0; tt < GCH; tt += 2) { G1_TOKEN(0, tt); G1_TOKEN(1, tt + 1); }
#undef G1_IDX
#undef G1_AUX
#undef G1_TOKEN
        }
    }
}
__device__ __forceinline__ void phase_gather_act(const float* PART, const float* GATE, const float* HSC, float* ACT, int G, int vcu, int tid) {
    const size_t gt = (size_t)vcu * NTHR + tid, NGT = (size_t)G * NTHR;
    for (size_t e4 = gt; e4 < (size_t)NTOK * 32; e4 += NGT) { const size_t tok = e4 >> 5; const int p = (int)(e4 & 31) * 4;
        f32x4 s = {0.f, 0.f, 0.f, 0.f};
#pragma unroll
        for (int x = 0; x < 8; ++x) { const v4u w = *(const v4u*)((const unsigned*)PART + ((size_t)x * NTOK + tok) * 64 + (p & 63));
            if (p < 64) { s[0] += bflo(w.x); s[1] += bflo(w.y); s[2] += bflo(w.z); s[3] += bflo(w.w); } else { s[0] += bfhi(w.x); s[1] += bfhi(w.y); s[2] += bfhi(w.z); s[3] += bfhi(w.w); } }
        const int k = (p < 64) ? 16 * (p >> 3) + (p & 7) : 16 * ((p - 64) >> 3) + 8 + (p & 7);
        const f32x4 gv = *(const f32x4*)(GATE + tok * 128 + k);
        f32x4 o;
        const float ds = HSC[tok] * (1.f / U8_SCALE);
#pragma unroll
        for (int i = 0; i < 4; ++i) { const _Float16 ah = (_Float16)(gv[i] * gelu_tanh(s[i] * ds) * (ACT_SCALE / V8_SCALE)); const h16x2 a2 = {ah, ah}; o[i] = __builtin_bit_cast(float, a2); }
        *(f32x4*)(ACT + e4 * 4) = o; }
}
__device__ __forceinline__ void phase_gather_v(const float* ACT, const int* IDX, const unsigned char* V, float* out, unsigned* queue, int lane) {
    const unsigned xcc = xb_xcc_id() & 7u; const int g = lane >> 3, j = lane & 7;
    typedef float f32x2v __attribute__((ext_vector_type(2)));
#pragma unroll 1
    for (unsigned sx = 0; sx < 8; ++sx) { const unsigned x = (xcc + sx) & 7u; unsigned* q = queue + x * 64;
        const unsigned char* Vx = V + (size_t)x * NEXP * 128; const unsigned jo = (unsigned)j * 16u; const int* Ig = IDX + 16 * g; float* Ob = out + x * 128; const unsigned lo = (unsigned)(16 * j + 2 * g) * 4u;
#pragma unroll 1
        for (;;) {
            unsigned c = 0; if (lane == 0) c = __hip_atomic_fetch_add(q, 1u, __ATOMIC_RELAXED, __HIP_MEMORY_SCOPE_AGENT);
            c = (unsigned)__builtin_amdgcn_readfirstlane((int)c); if (c >= (unsigned)(NTOK / GCH)) break;
            const size_t tb = (size_t)c * GCH;
            v4u ix[2][4], rw[16]; float a0[2], a1[2]; f32x2v ov[2]; const int bsel = (lane & ~7) * 4; const unsigned lane4 = (unsigned)lane * 4u;
#define G3_IDX(ib, tok_) do { _Pragma("unroll") for (int q4 = 0; q4 < 4; ++q4) ix[ib][q4] = *(const v4u*)(Ig + (tok_) * 128 + 4 * q4); } while (0)
#define G3_AUX(ab, tok_) do { a0[ab] = *(const float*)((const char*)(ACT + (tok_) * 128) + lane4); a1[ab] = *(const float*)((const char*)(ACT + (tok_) * 128 + 64) + lane4); { unsigned lo_ = lo; asm volatile("" : "+v"(lo_)); ov[ab] = *(const f32x2v*)((const char*)(Ob + (tok_) * DM) + lo_); } } while (0)
#define G3_TOKEN(p, tt_) do { G3_AUX((p) ^ 1, tb + (((tt_) + 1 < GCH) ? (tt_) + 1 : (tt_))); \
            h16x2 hacc[8]; \
            _Pragma("unroll") for (int i = 0; i < 8; ++i) hacc[i] = (h16x2){(_Float16)0.f, (_Float16)0.f}; \
            _Pragma("unroll") for (int i = 0; i < 16; ++i) { const v4u rv_ = rw[i]; \
                rw[i] = *(const v4u*)(Vx + (ix[(p) ^ 1][i >> 2][i & 3] * 128u + jo)); \
                const float a = __builtin_bit_cast(float, __builtin_amdgcn_ds_bpermute(bsel + 4 * (i & 7), __builtin_bit_cast(int, (i < 8) ? a0[p] : a1[p])));   \
                const h16x2 a2 = __builtin_bit_cast(h16x2, a); \
                _Pragma("unroll") for (int q4 = 0; q4 < 4; ++q4) { const int w = (int)rv_[q4]; \
                    hacc[2 * q4] = __builtin_elementwise_fma(cvt8h<false>(w), a2, hacc[2 * q4]); \
                    hacc[2 * q4 + 1] = __builtin_elementwise_fma(cvt8h<true>(w), a2, hacc[2 * q4 + 1]); } } \
            float acc[16]; \
            _Pragma("unroll") for (int i = 0; i < 8; ++i) { acc[2 * i] = (float)hacc[i].x; acc[2 * i + 1] = (float)hacc[i].y; } \
            int s_ = 32; \
            _Pragma("unroll") for (int cnt = 16; cnt > 2; cnt >>= 1) { const bool up = (lane & s_) != 0; \
                _Pragma("unroll") for (int i = 0; i < cnt / 2; ++i) { const float a = acc[i], b = acc[i + cnt / 2]; const float send = up ? a : b, keep = up ? b : a; acc[i] = keep + __shfl_xor(send, s_); } \
                s_ >>= 1; } \
            f32x2v o = ov[p]; o[0] += acc[0] * (1.f / ACT_SCALE); o[1] += acc[1] * (1.f / ACT_SCALE); \
            { unsigned lo_ = lo; asm volatile("" : "+v"(lo_)); *(f32x2v*)((char*)(Ob + (tb + (tt_)) * DM) + lo_) = o; } \
            G3_IDX(p, tb + (((tt_) + 2 < GCH) ? (tt_) + 2 : (tt_))); } while (0)
            G3_IDX(0, tb); G3_IDX(1, tb + 1); G3_AUX(0, tb);
#pragma unroll
            for (int i = 0; i < 16; ++i) rw[i] = *(const v4u*)(Vx + (ix[0][i >> 2][i & 3] * 128u + jo));
#pragma unroll 1
            for (int tt = 0; tt < GCH; tt += 2) { G3_TOKEN(0, tt); G3_TOKEN(1, tt + 1); }
#undef G3_IDX
#undef G3_AUX
#undef G3_TOKEN
        }
    }
}

__device__ __forceinline__ void phase_gather_naive(const bf16* XN, const int* IDX, const float* GATE, const float* U, const float* V, float* out, int G, int vcu, int lane, int wave) {
    const int gw = vcu * NWAVES + wave, NGW = G * NWAVES;
    for (int tok = gw; tok < NTOK; tok += NGW) {
        float hv[16], acc[16];
#pragma unroll
        for (int j = 0; j < 16; ++j) { hv[j] = bf2f(XN[(size_t)tok * DM + lane + 64 * j]); acc[j] = 0.f; }
        for (int k = 0; k < 128; ++k) { const int e = IDX[(size_t)tok * 128 + k]; const float g = GATE[(size_t)tok * 128 + k];
            float s = 0.f;
#pragma unroll
            for (int j = 0; j < 16; ++j) s += hv[j] * U[(size_t)e * DM + lane + 64 * j];
            s = wave_sum(s); const float a = g * gelu_tanh(s);
#pragma unroll
            for (int j = 0; j < 16; ++j) acc[j] += a * V[(size_t)e * DM + lane + 64 * j]; }
#pragma unroll
        for (int j = 0; j < 16; ++j) out[(size_t)tok * DM + lane + 64 * j] += acc[j];
    }
}
constexpr int PH_PER_LAYER = 15, N_PHASES = 1 + 2 * PH_PER_LAYER;
__device__ __forceinline__ KArgs kargs() { KArgs p = (KArgs)__builtin_amdgcn_kernarg_segment_ptr(); asm volatile("" : "+s"(p)); return p; }
__global__ void __launch_bounds__(NTHR, 2) mega_fwd(Args a_unused) {
    extern __shared__ __attribute__((aligned(16))) unsigned char lds_raw[];
    LAS unsigned char* lds = (LAS unsigned char*)lds_raw;
    volatile LAS unsigned* MISC = (volatile LAS unsigned*)(lds + MISC_OFF);
    const int tid0 = threadIdx.x;
    for (int u = tid0; u < (LDS_BYTES - LDSCTL_OFF) / 4; u += NTHR) ((LAS unsigned*)(lds + LDSCTL_OFF))[u] = 0u;
    __syncthreads();
    { const unsigned hw = (unsigned)__builtin_amdgcn_s_getreg((6 << 11) | 4); if ((tid0 & 63) == 0) *(volatile LAS int*)(lds + OTID_LDS_OFF + 4 * (hw & 63u)) = tid0 >> 6; }
    __syncthreads();
    XcdBarrier bar; { KArgs ka = kargs(); unsigned char* ws0 = ka->ws; bar.bar = (unsigned*)(ws0 + WS_CTL) + CW_BAR; bar.x = 0; bar.st = nullptr;
      if (ka->use_bar) bar = xcd_barrier_post((unsigned*)(ws0 + WS_CTL) + CW_BAR, MISC + 8); }
    const int ph_lo = kargs()->ph_lo, ph_hi = kargs()->ph_hi;
#define TLW const int tid = otid(), lane = tid & 63, wave = __builtin_amdgcn_readfirstlane(tid >> 6); (void)tid; (void)lane; (void)wave;
#pragma unroll 1
    for (int pc = ph_lo; pc < ph_hi + (DUP_PH >= 0 ? 1 : 0); ++pc) {
        const int ph = (DUP_PH >= 0 && pc > DUP_PH) ? pc - 1 : pc;
        unsigned long long tph0_ = 0; if (TIME_PH >= 0 && (pc == TIME_PH || TIME_PH == 99)) tph0_ = __builtin_amdgcn_s_memrealtime();
        KArgs a = kargs(); unsigned char* ws = a->ws;
        int G = gridDim.x, bx = blockIdx.x; asm volatile("" : "+s"(G), "+s"(bx)); const int vcu = (G % 8 == 0) ? (bx % 8) * (G / 8) + bx / 8 : bx;
        bf16* const XN = (bf16*)(ws + WS_XN); bf16* const Pq = (bf16*)(ws + WS_P); bf16* const Pk = Pq + (size_t)NTOK * 512; bf16* const Pv = Pk + (size_t)NTOK * 512; bf16* const Ps = Pv + (size_t)NTOK * 512;
        bf16* const MG = (bf16*)(ws + WS_MG); float* const CB = (float*)(ws + WS_CB); float* const XLOC = (float*)(ws + WS_XLOC); bf16* const Z = (bf16*)(ws + WS_Z);
        int* const IDX = (int*)(ws + WS_IDX); float* const GATE = (float*)(ws + WS_GATE);
        if (ph == 0) { TLW if (PH_MASK & 1u) phase_prep(a, lds, G, vcu, tid, lane, wave); }
        else {
            const int l = (ph - 1) / PH_PER_LAYER, sub = (ph - 1) % PH_PER_LAYER;
            const float* xin = (l == 0) ? a->in[0] : a->out;
            switch (sub) {
            case 0: if (PH_MASK & (1u << 1)) { TLW phase_rownorm<true>(xin, a->in[1] + l * DM, XN, (const float*)(ws + WS_WF) + l * 8 * 1024, a->in[3] + l * 8, CB, G, vcu, lane, wave); } break;
            case 1: if (PH_MASK & (1u << 2)) { TLW
                { float* CBm = CB; const int gw_ = vcu * NWAVES + wave; if (gw_ < NB * NH) phase_cumsum(CBm + (size_t)gw_ * SEQ, lane); }
                pg8::Gemm g{XN, (const bf16*)(ws + WS_WIN) + (size_t)l * 2048 * 1024, NTOK, 2048, 1024}; pg8::StaticOrder S; S.init(NTOK, 2048, G, bx);
                pg8::EpiQKVN E{Pq, (size_t)NTOK * 512, a->in[4] + l * 64, a->in[5] + l * 64, (PG8_LAS float*)(lds + EPIX_OFF), EPSN, 0.125f * LOG2E};
                pg8::gemm_phase<pg8::EpiQKVN, pg8::StaticOrder, true, true>(lds, g, S, E); } break;
            case 2: break;
            case 5: if (PH_MASK & (1u << 4)) { TLW { const float gq = wave_max(fabsf(a->in[4][l * 64 + lane])), gk = wave_max(fabsf(a->in[5][l * 64 + lane]));
                const float qkb = 8.f * gq * gk * LOG2E * 1.02f + 0.25f;
                const attn_body::AttnTensors AT{(const attn_body::bf16*)Pq, (const attn_body::bf16*)Pk, (const attn_body::bf16*)Pv, (attn_body::bf16*)MG, CB, qkb};
                attn_body::attn_phase_q<ATT_SKIP>((char*)lds_raw, AT, (unsigned*)(ws + WS_CTL) + CW_AQ + l * 512); } } break;
            case 3: if (PH_MASK & (1u << 5)) { TLW phase_pool(Ps, a->in[6] + (size_t)l * 4 * 64 * 64, a->in[7] + l * 256, a->in[18] + l * DM, MG, lds, G, bx, tid, lane, wave); } break;
            case 4: if (PH_MASK & (1u << 6)) { TLW phase_s5<false>(a, l, Ps, XLOC, Z, lds, G, bx, lane, wave); } break;
            case 6: if (PH_MASK & (1u << 7)) { TLW phase_s5<true>(a, l, Ps, XLOC, Z, lds, G, bx, lane, wave); } break;
            case 7: if (PH_MASK & (1u << 8)) { TLW phase_glu(Z, (const bf16*)(ws + WS_WGLU) + (size_t)l * 256 * 256, a->in[17] + l * 256, a->in[18] + l * DM, MG, lds, G, bx, vcu, tid, lane, wave); } break;
            case 8: if (PH_MASK & (1u << 9)) { pg8::Gemm g{MG, (const bf16*)(ws + WS_WOUT) + (size_t)l * 1024 * 1024, NTOK, 1024, 1024}; pg8::StaticOrder S; S.init(NTOK, 1024, G, bx);
                pg8::EpiResF32 E{xin, a->out, DM};
                pg8::gemm_phase<pg8::EpiResF32, pg8::StaticOrder, true, true>(lds, g, S, E); } break;
            case 9: if (PH_MASK & (1u << 10)) { TLW phase_rownorm<false>(a->out, a->in[20] + l * DM, XN, nullptr, nullptr, nullptr, G, vcu, lane, wave, ws + WS_XN8, (float*)(ws + WS_HSC)); } break;
            case 10: if (PH_MASK & (1u << 11)) { pg8::Gemm g{XN, (const bf16*)(ws + WS_WQ) + (size_t)l * 2048 * 1024, NTOK, 2048, 1024}; pg8::StaticOrder S; S.init(NTOK, 2048, G, bx);
                pg8::EpiBf16<0> E{Pq, PQW, nullptr, 0, 0, 1.f};
                pg8::gemm_phase<pg8::EpiBf16<0>, pg8::StaticOrder, true, true>(lds, g, S, E); } break;
            case 11: if (PH_MASK & (1u << 12)) { TLW phase_select(Pq, (const bf16*)(ws + WS_KEYS) + (size_t)l * 8 * 2 * 128 * 128, IDX, GATE, lds, G, vcu, tid, lane, wave); } break;
            case 12: if (PH_MASK & (1u << 13)) { TLW phase_gather_u(ws + WS_XN8, IDX, (const unsigned char*)(ws + WS_U) + (size_t)l * NEXP * DM, (float*)(ws + WS_P), (unsigned*)(ws + WS_CTL) + CW_Q + (l * 2 + 0) * 512 + ((DUP_PH >= 0 && pc == DUP_PH + 1) ? 4096 : 0), lane, (DUP_PH >= 0 && pc == DUP_PH) ? DIAG_IMASK : 0xffffffffu); } break;
            case 13: if (PH_MASK & (1u << 14)) { TLW phase_gather_act((const float*)(ws + WS_P), GATE, (const float*)(ws + WS_HSC), (float*)(ws + WS_Z), G, vcu, tid); } break;
            default: if (PH_MASK & (1u << 15)) { TLW phase_gather_v((const float*)(ws + WS_Z), IDX, (const unsigned char*)(ws + WS_V) + (size_t)l * NEXP * DM, a->out, (unsigned*)(ws + WS_CTL) + CW_Q + (l * 2 + 1) * 512, lane); } break;
            }
        }
        const int subb_ = (ph >= 1) ? (ph - 1) % PH_PER_LAYER : -1;
        if (pc + 1 < ph_hi + (DUP_PH >= 0 ? 1 : 0) && (MK_ONE_LAUNCH == 0 || (subb_ != 2 && subb_ != 3 && subb_ != 4))) { XcdBarrier b2 = bar; asm volatile("" : "+s"(b2.bar)); xcd_barrier(b2);
            if (TIME_PH >= 0 && (pc == TIME_PH || TIME_PH == 99)) { const unsigned long long t1_ = __builtin_amdgcn_s_memrealtime(), te_ = t1_ + TIME_MUL * (t1_ - tph0_); while (__builtin_amdgcn_s_memrealtime() < te_) __builtin_amdgcn_s_sleep(8); } }
    }
}

extern "C" void kernel_launch(void* const* d_in, const int* in_sizes, int n_in, void* d_out, int out_size, void* d_ws, size_t ws_size, hipStream_t stream) {
    static int grid = 0;
    if (grid == 0) {
        if (n_in != 25 || in_sizes[0] != NTOK * DM || out_size != NTOK * DM || ws_size < WS_END) {
            fprintf(stderr, "kernel_launch: unexpected problem: n_in %d in0 %d out %d ws %zu (need %zu); nothing launched\n", n_in, n_in > 0 ? in_sizes[0] : -1, out_size, ws_size, (size_t)WS_END); grid = -1; return; }
        int dev = 0, cus = 0;
        if (hipGetDevice(&dev) != hipSuccess || hipDeviceGetAttribute(&cus, hipDeviceAttributeMultiprocessorCount, dev) != hipSuccess) { fprintf(stderr, "kernel_launch: device query failed\n"); grid = -1; return; }
        if (hipFuncSetAttribute((const void*)mega_fwd, hipFuncAttributeMaxDynamicSharedMemorySize, LDS_BYTES) != hipSuccess) { fprintf(stderr, "kernel_launch: hipFuncSetAttribute failed\n"); grid = -1; return; }
        (void)hipGetLastError();
        grid = cus;
    }
    if (grid < 0) return;
    (void)hipMemsetAsync((char*)d_ws + WS_CTL, 0, CTL_ZERO_BYTES, stream);
    Args a{};
    for (int i = 0; i < 25; ++i) a.in[i] = (const float*)d_in[i];
    a.out = (float*)d_out; a.ws = (unsigned char*)d_ws;
#if MK_ONE_LAUNCH
    a.ph_lo = 0; a.ph_hi = N_PHASES; a.use_bar = 1;
    hipLaunchKernelGGL(mega_fwd, dim3(grid), dim3(NTHR), LDS_BYTES, stream, a);
#else
    for (int ph = 0; ph < N_PHASES; ++ph) { a.ph_lo = ph; a.ph_hi = ph + 1; a.use_bar = 0;
        hipLaunchKernelGGL(mega_fwd, dim3(grid), dim3(NTHR), LDS_BYTES, stream, a); }
#endif
    const hipError_t le = hipPeekAtLastError();
    if (le != hipSuccess) fprintf(stderr, "kernel_launch: launch failed: %s\n", hipGetErrorName(le));
}
```

```cpp
#include <hip/hip_runtime.h>
#include <hip/hip_bf16.h>
#include <hip/hip_fp16.h>
#include <cstdio>
#include <cstdint>
#include <cmath>
#ifndef MK_ONE_LAUNCH
#define MK_ONE_LAUNCH 1
#endif
#ifndef ATT_SKIP
#define ATT_SKIP true
#endif
#ifndef PH_MASK
#define PH_MASK 0xffffffffu
#endif
#define OTID_LDS_OFF (131072 + 1024)
__device__ __forceinline__ int otid() {
    int z = 0; asm volatile("" : "+v"(z)); const int lane = __builtin_amdgcn_mbcnt_hi(-1, __builtin_amdgcn_mbcnt_lo(-1, z));
    const unsigned hw = (unsigned)__builtin_amdgcn_s_getreg((6 << 11) | 4);
    const int wv = *(const volatile __attribute__((address_space(3))) int*)(OTID_LDS_OFF + 4 * (hw & 63u));
    return (__builtin_amdgcn_readfirstlane(wv) << 6) | lane;
}
#ifndef GATHER_NAIVE
#define GATHER_NAIVE 0
#endif
#ifndef DUP_PH
#define DUP_PH (-1)
#endif
#ifndef TIME_PH
#define TIME_PH (-1)
#define TIME_MUL 3
#endif
#ifndef DIAG_IMASK
#define DIAG_IMASK 0xffu
#endif
#ifndef S5_CPROJ_F32
#define S5_CPROJ_F32 1
#endif
namespace pg8 {
#define PG8_LAS __attribute__((address_space(3)))
typedef unsigned short bf16_t;
typedef short bf16x8 __attribute__((ext_vector_type(8)));
typedef float f32x4 __attribute__((ext_vector_type(4)));
typedef unsigned u32x4 __attribute__((ext_vector_type(4)));
constexpr int BM = 256, BK = 64, HALF = 128, HTB = HALF * BK * 2  , STAGE_BYTES = 8 * HTB, NXCD = 8, WGM = 8;

__host__ __device__ __forceinline__ int lds_byte(int r, int c) { const int st = (r >> 4) * 2 + (c >> 5), rr = r & 15, cc = c & 31, ob = rr * 64 + cc * 2; return st * 1024 + (ob ^ (((ob >> 9) & 1) << 5)); }
__host__ __device__ __forceinline__ void stage_rc(int b, int& R, int& C) { const int st = b / 1024, sb = b % 1024, swz = sb ^ (((sb >> 9) & 1) << 5); R = (st >> 1) * 16 + swz / 64; C = (st & 1) * 32 + (swz % 64) / 2; }
__host__ __device__ __forceinline__ int perm32(int rho) { const int n = rho >> 4, i = rho & 15; return 8 * (i >> 2) + 4 * n + (i & 3); }

struct Unit { int pm, pn; };
struct Gemm { const bf16_t* A; const bf16_t* Bt; int M, N, K; };

struct StaticOrder {
    int nM, nN, nwg, G, c;
    __host__ __device__ void init(int M, int N, int G_, int c_) { nM = M / BM; nN = N / BM; nwg = nM * nN; G = G_; c = c_; }
    __host__ __device__ bool next(int i, Unit& u) const {
        const long L = (long)i * G + c; if (L >= nwg) return false;
        int wgid = (int)L; { const int q = nwg / NXCD, r = nwg % NXCD, xcd = wgid % NXCD, off = wgid / NXCD; wgid = (xcd < r ? xcd * (q + 1) : r * (q + 1) + (xcd - r) * q) + off; }
        const int nig = WGM * nN, gid = wgid / nig, fm = gid * WGM, gsz = (nM - fm) < WGM ? (nM - fm) : WGM;
        u.pm = fm + ((wgid % nig) % gsz); u.pn = (wgid % nig) / gsz; return true;
    }
    __device__ __forceinline__ void a_ready(const Unit&) const {}
    __device__ __forceinline__ void done(const Unit&) const {}
};

__device__ __forceinline__ unsigned cvt_pk_bf16(float lo, float hi) { unsigned r; asm volatile("v_cvt_pk_bf16_f32 %0, %1, %2" : "=v"(r) : "v"(lo), "v"(hi)); return r; }
typedef float f32x2 __attribute__((ext_vector_type(2)));
__device__ __forceinline__ f32x2 gelu_pk(f32x2 v) {
    const f32x2 av = __builtin_elementwise_abs(v), d = av * 0.2316418882f + 1.0f;
    f32x2 t; t.x = __builtin_amdgcn_rcpf(d.x); t.y = __builtin_amdgcn_rcpf(d.y);
    f32x2 q = t * 0.5307027145f + (-0.7265760135f); q = q * t + 0.7107068705f; q = q * t + (-0.142248368f); q = q * t + 0.127414796f; q = q * t;
    const f32x2 s = (v * v) * (-0.72134752044f);
    f32x2 e; e.x = __builtin_amdgcn_exp2f(s.x); e.y = __builtin_amdgcn_exp2f(s.y);
    const f32x2 m = v * (q * e), r = v - m;
    f32x2 o; o.x = v.x < 0.f ? m.x : r.x; o.y = v.y < 0.f ? m.y : r.y; return o;
}

template <int ACT  > struct EpiBf16 {
    static constexpr bool PERM = true, AFTER_DRAIN = false; static_assert(ACT == 0 || ACT == 1, "EpiBf16: ACT is 0 (none) or 1 (gelu_pk)");
    bf16_t* O; int ldc; const float* bias; int split_cols; size_t split_stride; float scale0;
    __device__ __forceinline__ void operator()(const f32x4 (&acc)[2][2][4][2], const Unit& u, int wr, int wc, int fr, int fq) const {
        const int row0 = u.pm * BM + wr * 64 + fr; int colt = u.pn * BM; bf16_t* base = O;
        float sc = 1.f; if (split_cols) { const int t = colt / split_cols; base += (size_t)t * split_stride; colt -= t * split_cols; if (t == 0) sc = scale0; }
        const int col0 = colt + wc * 32 + 8 * fq, bcol0 = u.pn * BM + wc * 32 + 8 * fq;
        f32x4 bv[2][2];
#pragma unroll
        for (int bj = 0; bj < 2; ++bj)
#pragma unroll
            for (int n = 0; n < 2; ++n) bv[bj][n] = bias ? *(const f32x4*)(bias + bcol0 + bj * HALF + 4 * n) : (f32x4){0.f, 0.f, 0.f, 0.f};
#pragma unroll
        for (int ai = 0; ai < 2; ++ai)
#pragma unroll
            for (int m = 0; m < 4; ++m) { bf16_t* rowp = base + (size_t)(row0 + ai * HALF + m * 16) * ldc + col0;
#pragma unroll
                for (int bj = 0; bj < 2; ++bj) { f32x4 v0 = acc[ai][bj][m][0] + bv[bj][0], v1 = acc[ai][bj][m][1] + bv[bj][1];
                    if (ACT == 1) { f32x2 a = gelu_pk((f32x2){v0[0], v0[1]}), b = gelu_pk((f32x2){v0[2], v0[3]}), c = gelu_pk((f32x2){v1[0], v1[1]}), d = gelu_pk((f32x2){v1[2], v1[3]});
                        v0 = (f32x4){a.x, a.y, b.x, b.y}; v1 = (f32x4){c.x, c.y, d.x, d.y}; }
                    v0 = v0 * sc; v1 = v1 * sc; u32x4 w; w.x = cvt_pk_bf16(v0[0], v0[1]); w.y = cvt_pk_bf16(v0[2], v0[3]); w.z = cvt_pk_bf16(v1[0], v1[1]); w.w = cvt_pk_bf16(v1[2], v1[3]);
                    *(u32x4*)(rowp + bj * HALF) = w; } }
    }
};
struct EpiResF32 {
    static constexpr bool PERM = false, AFTER_DRAIN = false;
    const float* base; float* out; int ldc;
    __device__ __forceinline__ void operator()(const f32x4 (&acc)[2][2][4][2], const Unit& u, int wr, int wc, int fr, int fq) const {
        const int col0 = u.pn * BM + wc * 32 + 4 * fq;
#pragma unroll
        for (int ai = 0; ai < 2; ++ai)
#pragma unroll
            for (int m = 0; m < 4; ++m) { const size_t off = (size_t)(u.pm * BM + ai * HALF + wr * 64 + m * 16 + fr) * ldc + col0;
#pragma unroll
                for (int bj = 0; bj < 2; ++bj)
#pragma unroll
                    for (int n = 0; n < 2; ++n) { const f32x4 bs = *(const f32x4*)(base + off + bj * HALF + n * 16); *(f32x4*)(out + off + bj * HALF + n * 16) = bs + acc[ai][bj][m][n]; } }
    }
};

struct EpiQKVN {
    static constexpr bool PERM = true, AFTER_DRAIN = false;
    bf16_t* O; size_t split_stride; const float* qg; const float* kg; PG8_LAS float* ex; float eps, qscale;
    __device__ __forceinline__ void operator()(const f32x4 (&acc)[2][2][4][2], const Unit& u, int wr, int wc, int fr, int fq) const {
        const int t = u.pn >> 1, row0 = u.pm * BM + wr * 64 + fr, col0 = (u.pn & 1) * BM + wc * 32 + 8 * fq; bf16_t* base = O + (size_t)t * split_stride;
        float rs[2][4][2];
        f32x4 g0 = {1.f, 1.f, 1.f, 1.f}, g1 = {1.f, 1.f, 1.f, 1.f};
        if (t < 2) {
            int wid = wr * 4 + wc, fro = fr; asm volatile("" : "+v"(fro), "+s"(wid));
#pragma unroll
            for (int ai = 0; ai < 2; ++ai)
#pragma unroll
                for (int m = 0; m < 4; ++m)
#pragma unroll
                    for (int bj = 0; bj < 2; ++bj) { const f32x4 a0 = acc[ai][bj][m][0], a1 = acc[ai][bj][m][1];
                        float s = (a0[0] * a0[0] + a0[1] * a0[1]) + (a0[2] * a0[2] + a0[3] * a0[3]) + (a1[0] * a1[0] + a1[1] * a1[1]) + (a1[2] * a1[2] + a1[3] * a1[3]);
                        s += __shfl_xor(s, 16); s += __shfl_xor(s, 32);
                        if (fq == 0) ex[(((wid * 2 + ai) * 4 + m) * 2 + bj) * 16 + fro] = s; }
            asm volatile("s_waitcnt lgkmcnt(0)\n\ts_barrier" ::: "memory");
            const float* gp = (t == 0 ? qg : kg) + 32 * (wc & 1) + 8 * fq; const float gs = (t == 0) ? qscale : 1.f;
            g0 = *(const f32x4*)gp * gs; g1 = *(const f32x4*)(gp + 4) * gs;
#pragma unroll
            for (int ai = 0; ai < 2; ++ai)
#pragma unroll
                for (int m = 0; m < 4; ++m)
#pragma unroll
                    for (int bj = 0; bj < 2; ++bj) { const float so = ex[(((wid * 2 + ai) * 4 + m) * 2 + bj) * 16 + fro], sp = ex[((((wid ^ 1) * 2 + ai) * 4 + m) * 2 + bj) * 16 + fro]; rs[ai][m][bj] = 1.0f / sqrtf((so + sp) * (1.f / 64.f) + eps); }
        }
#pragma unroll
        for (int ai = 0; ai < 2; ++ai)
#pragma unroll
            for (int m = 0; m < 4; ++m) { bf16_t* rowp = base + (size_t)(row0 + ai * HALF + m * 16) * 512 + col0;
#pragma unroll
                for (int bj = 0; bj < 2; ++bj) { f32x4 v0 = acc[ai][bj][m][0], v1 = acc[ai][bj][m][1];
                    if (t < 2) { const float r = rs[ai][m][bj]; v0 = v0 * r * g0; v1 = v1 * r * g1; }
                    u32x4 w; w.x = cvt_pk_bf16(v0[0], v0[1]); w.y = cvt_pk_bf16(v0[2], v0[3]); w.z = cvt_pk_bf16(v1[0], v1[1]); w.w = cvt_pk_bf16(v1[2], v1[3]);
                    *(u32x4*)(rowp + bj * HALF) = w; } }
    }
};
template <class Epi, class Sched, bool ALIGN_EPI = false, bool SP2 = false>
__device__ __forceinline__ void gemm_phase(PG8_LAS unsigned char* lds, const Gemm g, const Sched& S, const Epi& E) {
    const int tid = otid(), wid = __builtin_amdgcn_readfirstlane(tid >> 6), lane = tid & 63, wr = wid >> 2, wc = wid & 3, fr = lane & 15, fq = lane >> 4;
    const int K = g.K, nt = K / BK;
    unsigned voffA[2], voffB[2];
#pragma unroll
    for (int i = 0; i < 2; ++i) { int R, C; stage_rc(tid * 16 + i * 8192, R, C); const int Rb = Epi::PERM ? ((R & ~31) + perm32(R & 31)) : R;
        voffA[i] = (unsigned)(R * K + C) * 2u; voffB[i] = (unsigned)(Rb * K + C) * 2u; }
    const size_t kstep = (size_t)(BK * 2);
    const size_t hstep = (size_t)HALF * K * 2;
    const size_t tstep = 2 * hstep;
    const unsigned ldsw = (unsigned)wid * 1024u;
    const int aoff = lds_byte(wr * 64 + fr, fq * 8), boff = lds_byte(wc * 32 + fr, fq * 8);
#define PG8_SA(b, h) (((b) * 2 + (h)) * HTB)
#define PG8_SB(b, h) ((4 + (b) * 2 + (h)) * HTB)
#define PG8_STAGE(bufoff, gbase, voff) do { _Pragma("unroll") for (int _i = 0; _i < 2; ++_i) \
        __builtin_amdgcn_global_load_lds((const unsigned*)((const char*)(gbase) + (voff)[_i]), (PG8_LAS unsigned*)(lds + (bufoff) + ldsw + _i * 8192), 16, 0, 0); } while (0)
#define PG8_LDA(dst, b, h) do { _Pragma("unroll") for (int m = 0; m < 4; ++m) _Pragma("unroll") for (int k = 0; k < 2; ++k) dst[m][k] = *(const PG8_LAS bf16x8*)(lds + PG8_SA(b, h) + aoff + m * 2048 + k * 1024); } while (0)
#define PG8_LDB(dst, b, h) do { _Pragma("unroll") for (int n = 0; n < 2; ++n) _Pragma("unroll") for (int k = 0; k < 2; ++k) dst[n][k] = *(const PG8_LAS bf16x8*)(lds + PG8_SB(b, h) + boff + n * 2048 + k * 1024); } while (0)
#define PG8_MMA(ai, bj, At, Bt) do { __builtin_amdgcn_s_setprio(1); _Pragma("unroll") for (int m = 0; m < 4; ++m) _Pragma("unroll") for (int n = 0; n < 2; ++n) _Pragma("unroll") for (int k = 0; k < 2; ++k) \
        acc[ai][bj][m][n] = __builtin_amdgcn_mfma_f32_16x16x32_bf16(Bt[n][k], At[m][k], acc[ai][bj][m][n], 0, 0, 0); __builtin_amdgcn_s_setprio(0); } while (0)
#define PG8_WAIT_V(n) asm volatile("s_waitcnt vmcnt(" #n ")" ::: "memory")
#define PG8_WAIT_L(n) asm volatile("s_waitcnt lgkmcnt(" #n ")" ::: "memory")
#define PG8_BAR __builtin_amdgcn_s_barrier()
#define PG8_SCHED __builtin_amdgcn_sched_barrier(0)
    Unit cur, nxt; int ui = 0;
    if (!S.next(0, cur)) return;
    f32x4 acc[2][2][4][2];
#pragma unroll
    for (int a = 0; a < 2; ++a)
#pragma unroll
        for (int b = 0; b < 2; ++b)
#pragma unroll
            for (int m = 0; m < 4; ++m)
#pragma unroll
                for (int n = 0; n < 2; ++n) acc[a][b][m][n] = (f32x4){0.f, 0.f, 0.f, 0.f};
    bf16x8 At[4][2], B0[2][2], B1[2][2];
    const char* cA = (const char*)g.A + (size_t)cur.pm * tstep; const char* cB = (const char*)g.Bt + (size_t)cur.pn * tstep;
    S.a_ready(cur);
    if constexpr (SP2) {
        PG8_STAGE(PG8_SB(0, 0), cB, voffB); PG8_STAGE(PG8_SB(0, 1), cB + hstep, voffB); PG8_STAGE(PG8_SA(0, 0), cA, voffA); PG8_STAGE(PG8_SA(0, 1), cA + hstep, voffA);
        if (wr == 1) PG8_BAR;
        PG8_WAIT_V(2); PG8_BAR;
        PG8_STAGE(PG8_SB(1, 0), cB + kstep, voffB); PG8_STAGE(PG8_SA(1, 0), cA + kstep, voffA); PG8_STAGE(PG8_SB(1, 1), cB + hstep + kstep, voffB);
        PG8_WAIT_V(6); PG8_BAR;
    } else {
        PG8_STAGE(PG8_SB(0, 0), cB, voffB); PG8_STAGE(PG8_SA(0, 0), cA, voffA); PG8_STAGE(PG8_SB(0, 1), cB + hstep, voffB); PG8_STAGE(PG8_SA(0, 1), cA + hstep, voffA);
        if (wr == 1) PG8_BAR;
        PG8_WAIT_V(4); PG8_BAR;
        PG8_STAGE(PG8_SB(1, 0), cB + kstep, voffB); PG8_STAGE(PG8_SA(1, 0), cA + kstep, voffA); PG8_STAGE(PG8_SB(1, 1), cB + hstep + kstep, voffB);
        PG8_WAIT_V(6); PG8_BAR;
    }
    for (;;) {
        const bool has_next = S.next(ui + 1, nxt);
        const char* nA = has_next ? (const char*)g.A + (size_t)nxt.pm * tstep : cA; const char* nB = has_next ? (const char*)g.Bt + (size_t)nxt.pn * tstep : cB;
        for (int t = 0; t < nt; t += 2) {
            const bool last = (t == nt - 2);
            const char* a1 = cA + (size_t)(t + 1) * kstep;
            const char* a2 = last ? nA : cA + (size_t)(t + 2) * kstep; const char* b2 = last ? nB : cB + (size_t)(t + 2) * kstep;
            const char* a3 = a2 + kstep; const char* b3 = b2 + kstep;
            if (last && has_next) S.a_ready(nxt);
            if constexpr (SP2) {
            PG8_LDB(B0, 0, 0); PG8_LDB(B1, 0, 1); PG8_SCHED; PG8_LDA(At, 0, 0); PG8_STAGE(PG8_SA(1, 1), a1 + hstep, voffA);
            PG8_WAIT_V(8); PG8_WAIT_L(0); PG8_BAR; PG8_MMA(0, 0, At, B0); PG8_MMA(0, 1, At, B1); PG8_BAR; PG8_SCHED;
            PG8_LDA(At, 0, 1); PG8_STAGE(PG8_SB(0, 0), b2, voffB); PG8_STAGE(PG8_SB(0, 1), b2 + hstep, voffB); PG8_STAGE(PG8_SA(0, 0), a2, voffA);
            PG8_WAIT_V(8); PG8_WAIT_L(0); PG8_BAR; PG8_MMA(1, 0, At, B0); PG8_MMA(1, 1, At, B1); PG8_BAR; PG8_SCHED;
            PG8_LDB(B0, 1, 0); PG8_LDB(B1, 1, 1); PG8_SCHED; PG8_LDA(At, 1, 0); PG8_STAGE(PG8_SA(0, 1), a2 + hstep, voffA);
            PG8_WAIT_V(8); PG8_WAIT_L(0); PG8_BAR; PG8_MMA(0, 0, At, B0); PG8_MMA(0, 1, At, B1); PG8_BAR; PG8_SCHED;
            PG8_LDA(At, 1, 1); PG8_STAGE(PG8_SB(1, 0), b3, voffB); PG8_STAGE(PG8_SB(1, 1), b3 + hstep, voffB); PG8_STAGE(PG8_SA(1, 0), a3, voffA);
            PG8_WAIT_V(8); PG8_WAIT_L(0); PG8_BAR; PG8_MMA(1, 0, At, B0); PG8_MMA(1, 1, At, B1); PG8_BAR; PG8_SCHED;
            } else {
            PG8_LDB(B0, 0, 0); PG8_SCHED; PG8_LDA(At, 0, 0); PG8_STAGE(PG8_SA(1, 1), a1 + hstep, voffA);
            PG8_WAIT_L(8); PG8_BAR; PG8_WAIT_L(0); PG8_MMA(0, 0, At, B0); PG8_BAR; PG8_SCHED;
            PG8_LDB(B1, 0, 1); PG8_STAGE(PG8_SB(0, 0), b2, voffB);
            PG8_BAR; PG8_WAIT_L(0); PG8_MMA(0, 1, At, B1); PG8_BAR;
            PG8_LDA(At, 0, 1); PG8_STAGE(PG8_SA(0, 0), a2, voffA);
            PG8_BAR; PG8_WAIT_L(0); PG8_MMA(1, 0, At, B0); PG8_BAR; PG8_SCHED;
            PG8_STAGE(PG8_SB(0, 1), b2 + hstep, voffB);
            PG8_WAIT_V(6); PG8_BAR; PG8_MMA(1, 1, At, B1); PG8_BAR;
            PG8_LDB(B0, 1, 0); PG8_SCHED; PG8_LDA(At, 1, 0); PG8_STAGE(PG8_SA(0, 1), a2 + hstep, voffA);
            PG8_WAIT_L(8); PG8_BAR; PG8_WAIT_L(0); PG8_MMA(0, 0, At, B0); PG8_BAR; PG8_SCHED;
            PG8_LDB(B1, 1, 1); PG8_STAGE(PG8_SB(1, 0), b3, voffB);
            PG8_BAR; PG8_WAIT_L(0); PG8_MMA(0, 1, At, B1); PG8_BAR;
            PG8_LDA(At, 1, 1); PG8_STAGE(PG8_SA(1, 0), a3, voffA);
            PG8_BAR; PG8_WAIT_L(0); PG8_MMA(1, 0, At, B0); PG8_BAR; PG8_SCHED;
            PG8_STAGE(PG8_SB(1, 1), b3 + hstep, voffB);
            PG8_WAIT_V(6); PG8_BAR; PG8_MMA(1, 1, At, B1); PG8_BAR;
            }
        }
        if constexpr (ALIGN_EPI) { if (wr == 0) PG8_BAR; }
        if constexpr (!Epi::AFTER_DRAIN) { E(acc, cur, wr, wc, fr, fq); S.done(cur); }
        if (!has_next) break;
#pragma unroll
        for (int a = 0; a < 2; ++a)
#pragma unroll
            for (int b = 0; b < 2; ++b)
#pragma unroll
                for (int m = 0; m < 4; ++m)
#pragma unroll
                    for (int n = 0; n < 2; ++n) acc[a][b][m][n] = (f32x4){0.f, 0.f, 0.f, 0.f};
        cur = nxt; cA = nA; cB = nB; ++ui;
        if constexpr (ALIGN_EPI) { if (wr == 1) PG8_BAR; }
    }
    PG8_WAIT_V(0);
    if constexpr (!ALIGN_EPI) { if (wr == 0) PG8_BAR; }
    PG8_BAR;
    if constexpr (Epi::AFTER_DRAIN) { E.fused(acc, cur, wr, wc, fr, fq, lds, wid, lane); S.done(cur); }
#undef PG8_SA
#undef PG8_SB
#undef PG8_STAGE
#undef PG8_LDA
#undef PG8_LDB
#undef PG8_MMA
#undef PG8_WAIT_V
#undef PG8_WAIT_L
#undef PG8_BAR
#undef PG8_SCHED
}
}
#include <hip/hip_bf16.h>
#include <cmath>
namespace attn_body {
using bf16=__hip_bfloat16;
using bf16x8=__attribute__((ext_vector_type(8)))short;
using s16x4=__attribute__((ext_vector_type(4)))short;
using f32x16=__attribute__((ext_vector_type(16)))float;
using u32x4=__attribute__((ext_vector_type(4)))unsigned;
using f32x4v=__attribute__((ext_vector_type(4)))float;
constexpr int BATCH=8,NHEAD=8,SEQ=4096,D=64,DM=NHEAD*D,OPITCH=1024;
constexpr int NW=8,QBLK=32,QB=QBLK*NW,KVBLK=64,NQB=SEQ/QB;
constexpr int ATTN_PITCH=DM, ATTN_UNIT_ROWS=QB;
__device__ __forceinline__ int crow(int r,int hi){return (r&3)+8*(r>>2)+4*hi;}
#define SBAR() __builtin_amdgcn_sched_barrier(0)
__device__ __forceinline__ void cmask(f32x16&p0,f32x16&p1,int jb,int qrel,int hi){
  const float NEG=-INFINITY; int kb=64*jb+4*hi;
  #pragma unroll
  for(int r=0;r<16;++r){int kv=kb+(r&3)+8*(r>>2); if(kv>qrel)p0[r]=NEG; if(kv+32>qrel)p1[r]=NEG;}
}

constexpr int NSLOT=3, SLOTB=8192;
constexpr int LDS_K=0, LDS_V=NSLOT*SLOTB, LDS_WS=2*NSLOT*SLOTB, LDS_OST=LDS_WS+NW*64*4, LDS_BYTES=LDS_OST+NW*4096, LDS_BIAS=LDS_BYTES, LDS_TOTAL=LDS_BIAS+SEQ*4;
constexpr float C2=0.125f*1.4426950408889634f;
__device__ __forceinline__ void glds16(const void*sbase,unsigned voff,unsigned lds_dst){unsigned keep;
  asm volatile("s_mov_b32 %0, m0\n\ts_mov_b32 m0, %3\n\ts_nop 0\n\tglobal_load_lds_dwordx4 %1, %2\n\ts_mov_b32 m0, %0":"=&s"(keep):"v"(voff),"s"(sbase),"s"(lds_dst):"memory");}
__device__ __forceinline__ float max3f(float a,float b,float c){float r;asm("v_max3_f32 %0, %1, %2, %3":"=v"(r):"v"(a),"v"(b),"v"(c));return r;}
__device__ __forceinline__ float max2f(float a,float b){float r;asm("v_max_f32_e32 %0, %1, %2":"=v"(r):"v"(a),"v"(b));return r;}
__device__ __forceinline__ float fadd_s(float a,float b){float r;asm("v_add_f32_e32 %0, %1, %2":"=v"(r):"v"(a),"v"(b));return r;}
__device__ __forceinline__ float fsub_s(float a,float b){float r;asm("v_sub_f32_e32 %0, %1, %2":"=v"(r):"v"(a),"v"(b));return r;}
typedef float f32x2_t __attribute__((ext_vector_type(2))); typedef __bf16 bf16x2_t __attribute__((ext_vector_type(2)));
__device__ __forceinline__ unsigned cvtpk_s(float lo,float hi){f32x2_t v={lo,hi};bf16x2_t b=__builtin_convertvector(v,bf16x2_t);return __builtin_bit_cast(unsigned,b);}
#define WAIT_BAR(N) asm volatile("s_waitcnt vmcnt(" #N ") lgkmcnt(0)\n\ts_barrier":::"memory")

__device__ __forceinline__ void qkt(f32x16&p0,f32x16&p1,const __attribute__((address_space(3))) char*kb,const bf16x8*qr){
  #pragma unroll
  for(int d0=0;d0<4;++d0){
    const bf16x8 b0=*(const __attribute__((address_space(3))) bf16x8*)(kb+d0*2048);
    const bf16x8 b1=*(const __attribute__((address_space(3))) bf16x8*)(kb+d0*2048+512);
    p0=__builtin_amdgcn_mfma_f32_32x32x16_bf16(b0,qr[d0],p0,0,0,0);p1=__builtin_amdgcn_mfma_f32_32x32x16_bf16(b1,qr[d0],p1,0,0,0);}
}
typedef __attribute__((address_space(3))) const char* lds_cptr;
typedef short v4i16_t __attribute__((ext_vector_type(4)));
__device__ __forceinline__ void kload8(bf16x8*kf,lds_cptr kp){
  kf[0]=*(const __attribute__((address_space(3))) bf16x8*)(kp);      kf[1]=*(const __attribute__((address_space(3))) bf16x8*)(kp+512);
  kf[2]=*(const __attribute__((address_space(3))) bf16x8*)(kp+2048); kf[3]=*(const __attribute__((address_space(3))) bf16x8*)(kp+2560);
  kf[4]=*(const __attribute__((address_space(3))) bf16x8*)(kp+4096); kf[5]=*(const __attribute__((address_space(3))) bf16x8*)(kp+4608);
  kf[6]=*(const __attribute__((address_space(3))) bf16x8*)(kp+6144); kf[7]=*(const __attribute__((address_space(3))) bf16x8*)(kp+6656);
}
__device__ __forceinline__ void kload2(bf16x8*kf,lds_cptr kp,int j){ kf[2*j]=*(const __attribute__((address_space(3))) bf16x8*)(kp+j*2048); kf[2*j+1]=*(const __attribute__((address_space(3))) bf16x8*)(kp+j*2048+512); }
__device__ __forceinline__ s16x4 vtr(lds_cptr p){ return __builtin_bit_cast(s16x4,__builtin_amdgcn_ds_read_tr16_b64_v4i16((__attribute__((address_space(3))) v4i16_t*)p)); }
__device__ __forceinline__ float rowmax(const f32x16&p0,const f32x16&p1){
  float a=max3f(p0[0],p0[1],p1[0]),b=max3f(p0[2],p0[3],p1[1]);a=max3f(a,p1[2],p1[3]);
  #pragma unroll
  for(int r=4;r<16;r+=4){a=max3f(a,p0[r],p0[r+1]);b=max3f(b,p0[r+2],p0[r+3]);a=max3f(a,p1[r],p1[r+1]);b=max3f(b,p1[r+2],p1[r+3]);}
  const float m=max2f(a,b);
  auto rr=__builtin_amdgcn_permlane32_swap(__float_as_uint(m),__float_as_uint(m),false,false);
  return max2f(__uint_as_float(rr[0]),__uint_as_float(rr[1]));
}
__device__ __forceinline__ void pv(f32x16*o,int vb,bf16x8 pa0,bf16x8 pa1,bf16x8 pa2,bf16x8 pa3){
  #pragma unroll
  for(int d0=0;d0<2;++d0){s16x4 lo[4],hi[4];
    #pragma unroll
    for(int ks=0;ks<4;++ks){
      asm volatile("ds_read_b64_tr_b16 %0,%1 offset:%c2":"=&v"(lo[ks]):"v"(vb),"i"(d0*4096+ks*1024):"memory");
      asm volatile("ds_read_b64_tr_b16 %0,%1 offset:%c2":"=&v"(hi[ks]):"v"(vb),"i"(d0*4096+ks*1024+512):"memory");}
    asm volatile("s_waitcnt lgkmcnt(0)":::"memory");SBAR();
    #define PK(k) (bf16x8){lo[k][0],lo[k][1],lo[k][2],lo[k][3],hi[k][0],hi[k][1],hi[k][2],hi[k][3]}
    o[d0]=__builtin_amdgcn_mfma_f32_32x32x16_bf16(pa0,PK(0),o[d0],0,0,0);
    o[d0]=__builtin_amdgcn_mfma_f32_32x32x16_bf16(pa1,PK(1),o[d0],0,0,0);
    o[d0]=__builtin_amdgcn_mfma_f32_32x32x16_bf16(pa2,PK(2),o[d0],0,0,0);
    o[d0]=__builtin_amdgcn_mfma_f32_32x32x16_bf16(pa3,PK(3),o[d0],0,0,0);
    #undef PK
  }
}

#ifndef ATTN_STORE16
#define ATTN_STORE16(p,v) (*(u32x4*)(p)=(v))
#endif
template<bool SKIP> __device__ __forceinline__ void attn_unit(int b,int h,int qb,const bf16*Q,const bf16*__restrict__ K,const bf16*__restrict__ V,bf16*O,const float*__restrict__ CB,float qkb,char*shm){
  const int tid=otid(),lane=tid&63,r32=lane&31,hi=lane>>5; const int wid=__builtin_amdgcn_readfirstlane(tid>>6);
  const long rowbase=(long)b*SEQ; const int q0=qb*QB;
  const float*cb=CB+(long)(b*NHEAD+h)*SEQ;
  int t0=0;
  if(SKIP){ const int NTf=(q0+QB)/KVBLK; const float thr=2.f*qkb+40.f; const float cq0=cb[q0];
    bool pred=false; if(lane<NTf-4){ pred=(cq0-cb[64*lane+63])<-thr; }
    const unsigned long long mk=__ballot(pred); t0=(int)__builtin_ctzll(~mk); t0&=~1; t0=__builtin_amdgcn_readfirstlane(t0); }
  const int kv0=t0*KVBLK;
  const int NT=(q0+QB)/KVBLK-t0;
  { __attribute__((address_space(3))) float*bl=(__attribute__((address_space(3))) float*)((lds_cptr)shm+LDS_BIAS); const float*cbk=cb+kv0; for(int i=tid;i<NT*KVBLK;i+=NW*64) bl[i]=-*(const float*)((const char*)cbk+(unsigned)(i*4)); }
  const float negm0=*(const float*)((const char*)(cb+q0+wid*QBLK)+(unsigned)((lane&31)*4))-qkb;
  const bf16*Qw=Q+(rowbase+q0+wid*QBLK)*DM+h*D;
  const bf16*Kh=K+(rowbase+kv0)*DM+h*D,*Vh=V+(rowbase+kv0)*DM+h*D;
  const unsigned lds0=(unsigned)(uintptr_t)shm;
  const unsigned koff=(unsigned)(lane*DM+wid*8)*2u;
  const unsigned voff=(unsigned)((16*(wid&3)+(lane>>2))*DM+(wid>>2)*32+(lane&3)*8)*2u;
  const unsigned kdst=lds0+LDS_K+wid*1024, vdst=lds0+LDS_V+wid*1024;
  #define DMA_K(t,slot) glds16(Kh+(long)(t)*KVBLK*DM,koff,(unsigned)__builtin_amdgcn_readfirstlane(kdst+(slot)))
  #define DMA_V(t,slot) glds16(Vh+(long)(t)*KVBLK*DM,voff,(unsigned)__builtin_amdgcn_readfirstlane(vdst+(slot)))
  bf16x8 kf[8];
  const lds_cptr shm3=(lds_cptr)shm; __attribute__((address_space(3))) float*const wsf=(__attribute__((address_space(3))) float*)(shm3+LDS_WS)+wid*64;
  const lds_cptr kp0=shm3+LDS_K+hi*1024+r32*16; const lds_cptr vp0=shm3+LDS_V+((lane>>4)&1)*32+(lane&3)*8+(4*hi+((lane&15)>>2))*64;
  DMA_K(0,0);DMA_V(0,0);DMA_K(1,SLOTB);
  bf16x8 qr[4];
  #pragma unroll
  for(int d0=0;d0<4;++d0)qr[d0]=*reinterpret_cast<const bf16x8*>((const char*)Qw+(unsigned)((r32*DM+d0*16+hi*8)*2));
  float l_reg=0.f;f32x16 o[2];o[0]=f32x16{};o[1]=f32x16{};
  const __attribute__((address_space(3))) char* bl3=(const __attribute__((address_space(3))) char*)shm+LDS_BIAS+hi*16;
  #define BINIT_ALL(P0,P1,t) do{ const __attribute__((address_space(3))) f32x4v* bp_=(const __attribute__((address_space(3))) f32x4v*)(bl3+(t)*256); \
    _Pragma("unroll") for(int g_=0;g_<4;++g_){ const f32x4v x0_=bp_[2*g_], x1_=bp_[8+2*g_]; \
      P0[4*g_]=x0_[0]+negm0;P0[4*g_+1]=x0_[1]+negm0;P0[4*g_+2]=x0_[2]+negm0;P0[4*g_+3]=x0_[3]+negm0; \
      P1[4*g_]=x1_[0]+negm0;P1[4*g_+1]=x1_[1]+negm0;P1[4*g_+2]=x1_[2]+negm0;P1[4*g_+3]=x1_[3]+negm0; } }while(0)
  const int qrel=wid*QBLK+r32;
  #define CMASK(P0,P1,t) do{int jb_=(t)-(NT-4); if(jb_>=0)cmask(P0,P1,jb_,qrel,hi);}while(0)
  f32x16 pA0,pA1,pB0,pB1;
  int sl_prev=0,sl_cur=0,sl_next=SLOTB;
  #define ROT() do{sl_prev=sl_cur;sl_cur=sl_next;sl_next=(sl_next==(NSLOT-1)*SLOTB)?0:sl_next+SLOTB;}while(0)
  DMA_K(2,2*SLOTB);
  WAIT_BAR(3);
  BINIT_ALL(pA0,pA1,0); qkt(pA0,pA1,kp0,qr);asm volatile("s_nop 15\n\ts_nop 7":"+v"(pA0),"+v"(pA1));CMASK(pA0,pA1,0);
  _Pragma("unroll") for(int r=0;r<16;++r){pA0[r]=__builtin_amdgcn_exp2f(pA0[r]);pA1[r]=__builtin_amdgcn_exp2f(pA1[r]);}
  BINIT_ALL(pB0,pB1,1);
  WAIT_BAR(0);
  DMA_K(3,0);DMA_V(1,SLOTB);
  ROT();
  kload8(kf,kp0+sl_cur);
  WAIT_BAR(2);
  s16x4 vlo[8],vhi[8]; u32x4 pw0,pw1,pw2,pw3;
  #define PKW(P,B) cvtpk_s(P[B],P[B+1])
  #define PAF(k) __builtin_bit_cast(bf16x8,pw##k)
  #define VFR(i) (bf16x8){vlo[i][0],vlo[i][1],vlo[i][2],vlo[i][3],vhi[i][0],vhi[i][1],vhi[i][2],vhi[i][3]}
  #define PIN(x) asm volatile("":"+v"(x))
  #define MX3(a,b,c) __builtin_fmaxf(__builtin_fmaxf((a),(b)),(c))
  #define GAPA(MF,A0,A1,A2,A3,W0,W1,PW) do{ MF; sacc+=A0; sacc+=A1; sacc+=A2; sacc+=A3; PIN(sacc); W0; W1; PIN(PW); SBAR(); }while(0)
  #define EX(v) __builtin_amdgcn_exp2f(v)
  #define GAPB(MF,X,B,GL_,P,GI,NI) do{ MF; X[B]=EX(X[B]); X[B+1]=EX(X[B+1]); X[B+2]=EX(X[B+2]); X[B+3]=EX(X[B+3]); PIN(X); \
    if(GL_){ const f32x4v nx_=bpn_[NI]; P[4*(GI)]=bq_[0]+negm0; P[4*(GI)+1]=bq_[1]+negm0; P[4*(GI)+2]=bq_[2]+negm0; P[4*(GI)+3]=bq_[3]+negm0; bq_=nx_; PIN(P); } SBAR(); }while(0)
  #define VRD(i) do{ vlo[i]=vtr(vp_+(((i)>>2)*4096+((i)&3)*1024)); vhi[i]=vtr(vp_+(((i)>>2)*4096+((i)&3)*1024+512)); }while(0)
  #define KRD(G,j) do{ if(G){ kload2(kf,kp0+sl_next,j); SBAR(); } }while(0)
  #define STEP(C0,C1,P0,P1,t,GK,GV,GL) do{ SBAR(); \
    const lds_cptr vp_=vp0+sl_prev; \
    VRD(0); SBAR(); float sacc=(P0[0]+P0[1]); \
    GAPA(C0=__builtin_amdgcn_mfma_f32_32x32x16_bf16(kf[0],qr[0],C0,0,0,0), P0[2],P0[3],P0[4],P0[5],     pw0[0]=PKW(P0,0), pw0[1]=PKW(P0,2), pw0); \
    VRD(4); SBAR(); GAPA(C1=__builtin_amdgcn_mfma_f32_32x32x16_bf16(kf[1],qr[0],C1,0,0,0), P0[6],P0[7],P0[8],P0[9],     pw0[2]=PKW(P0,4), pw0[3]=PKW(P0,6), pw0); \
    VRD(1); SBAR(); GAPA(C0=__builtin_amdgcn_mfma_f32_32x32x16_bf16(kf[2],qr[1],C0,0,0,0),   P0[10],P0[11],P0[12],P0[13], pw1[0]=PKW(P0,8), pw1[1]=PKW(P0,10), pw1); \
    VRD(5); SBAR(); GAPA(C1=__builtin_amdgcn_mfma_f32_32x32x16_bf16(kf[3],qr[1],C1,0,0,0),   P0[14],P0[15],P1[0],P1[1],   pw1[2]=PKW(P0,12),pw1[3]=PKW(P0,14), pw1); \
    VRD(2); SBAR(); GAPA(C0=__builtin_amdgcn_mfma_f32_32x32x16_bf16(kf[4],qr[2],C0,0,0,0),   P1[2],P1[3],P1[4],P1[5],     pw2[0]=PKW(P1,0), pw2[1]=PKW(P1,2), pw2); \
    VRD(6); SBAR(); GAPA(C1=__builtin_amdgcn_mfma_f32_32x32x16_bf16(kf[5],qr[2],C1,0,0,0),   P1[6],P1[7],P1[8],P1[9],     pw2[2]=PKW(P1,4), pw2[3]=PKW(P1,6), pw2); \
    VRD(3); SBAR(); GAPA(C0=__builtin_amdgcn_mfma_f32_32x32x16_bf16(kf[6],qr[3],C0,0,0,0),   P1[10],P1[11],P1[12],P1[13], pw3[0]=PKW(P1,8), pw3[1]=PKW(P1,10), pw3); \
    VRD(7); SBAR(); GAPA(C1=__builtin_amdgcn_mfma_f32_32x32x16_bf16(kf[7],qr[3],C1,0,0,0),   P1[14],P1[15],0.f,0.f,       pw3[2]=PKW(P1,12),pw3[3]=PKW(P1,14), pw3); \
    l_reg+=sacc; \
    if(GK){DMA_K((t)+3,sl_cur);} if(GV){DMA_V((t)+1,sl_next);} \
    CMASK(C0,C1,t); \
    const __attribute__((address_space(3))) f32x4v* bpn_=(const __attribute__((address_space(3))) f32x4v*)(bl3+((t)+1)*256); f32x4v bq_=f32x4v{}; if(GL){bq_=bpn_[0];} \
    SBAR(); \
    GAPB(o[0]=__builtin_amdgcn_mfma_f32_32x32x16_bf16(PAF(0),VFR(0),o[0],0,0,0), C0,0,GL,P0,0,8); \
    GAPB(o[1]=__builtin_amdgcn_mfma_f32_32x32x16_bf16(PAF(0),VFR(4),o[1],0,0,0), C0,4,GL,P1,0,2); \
    KRD(GL,0); GAPB(o[0]=__builtin_amdgcn_mfma_f32_32x32x16_bf16(PAF(1),VFR(1),o[0],0,0,0), C0,8,GL,P0,1,10); \
    KRD(GL,1); GAPB(o[1]=__builtin_amdgcn_mfma_f32_32x32x16_bf16(PAF(1),VFR(5),o[1],0,0,0), C0,12,GL,P1,1,4); \
    KRD(GL,2); GAPB(o[0]=__builtin_amdgcn_mfma_f32_32x32x16_bf16(PAF(2),VFR(2),o[0],0,0,0), C1,0,GL,P0,2,12); \
    KRD(GL,3); GAPB(o[1]=__builtin_amdgcn_mfma_f32_32x32x16_bf16(PAF(2),VFR(6),o[1],0,0,0), C1,4,GL,P1,2,6); \
    GAPB(o[0]=__builtin_amdgcn_mfma_f32_32x32x16_bf16(PAF(3),VFR(3),o[0],0,0,0), C1,8,GL,P0,3,14); \
    GAPB(o[1]=__builtin_amdgcn_mfma_f32_32x32x16_bf16(PAF(3),VFR(7),o[1],0,0,0), C1,12,GL,P1,3,14); \
    }while(0)
  int t=1;
  #undef CMASK
  #define CMASK(P0,P1,t) do{}while(0)
  for(;t+5<NT;t+=2){
    STEP(pB0,pB1,pA0,pA1,t,true,true,true);     WAIT_BAR(2); ROT();
    STEP(pA0,pA1,pB0,pB1,t+1,true,true,true);   WAIT_BAR(2); ROT();
  }
  #undef CMASK
  #define CMASK(P0,P1,t) do{int jb_=(t)-(NT-4); if(jb_>=0)cmask(P0,P1,jb_,qrel,hi);}while(0)
  #define ENDW(tt) do{ if((tt)+3<NT){WAIT_BAR(2);} else if((tt)+2<NT){WAIT_BAR(1);} else {WAIT_BAR(0);} }while(0)
  for(;t+1<NT;t+=2){
    STEP(pB0,pB1,pA0,pA1,t,(t+3<NT),(t+1<NT),(t+1<NT));       ENDW(t);   ROT();
    STEP(pA0,pA1,pB0,pB1,t+1,(t+4<NT),(t+2<NT),(t+2<NT));     ENDW(t+1); ROT();
  }
  STEP(pB0,pB1,pA0,pA1,NT-1,false,false,false);
  { float sacc=pB0[0]+pB0[1]; _Pragma("unroll") for(int r=2;r<16;++r)sacc+=pB0[r]; _Pragma("unroll") for(int r=0;r<16;++r)sacc+=pB1[r]; l_reg+=sacc;
    pw0=(u32x4){PKW(pB0,0),PKW(pB0,2),PKW(pB0,4),PKW(pB0,6)};pw1=(u32x4){PKW(pB0,8),PKW(pB0,10),PKW(pB0,12),PKW(pB0,14)};pw2=(u32x4){PKW(pB1,0),PKW(pB1,2),PKW(pB1,4),PKW(pB1,6)};pw3=(u32x4){PKW(pB1,8),PKW(pB1,10),PKW(pB1,12),PKW(pB1,14)};
    SBAR(); pv(o,(int)(unsigned)(uintptr_t)vp0+sl_cur,PAF(0),PAF(1),PAF(2),PAF(3)); }
  #undef PKW
  #undef PAF
  #undef VFR
  #undef PIN
  #undef MX3
  #undef GAPA
  #undef GAPB
  #undef EX
  #undef VRD
  #undef KRD
  #undef STEP
  #undef ENDW
  {auto rr=__builtin_amdgcn_permlane32_swap(__float_as_uint(l_reg),__float_as_uint(l_reg),false,false);l_reg=__uint_as_float(rr[0])+__uint_as_float(rr[1]);}
  if(hi==0)wsf[32+r32]=l_reg;asm volatile("s_waitcnt lgkmcnt(0)":::"memory");
  float rli[16];
  #pragma unroll
  for(int r=0;r<16;++r)rli[r]=__builtin_amdgcn_rcpf(wsf[32+crow(r,hi)]);
  bf16*Ow=O+(rowbase+q0+wid*QBLK)*OPITCH+h*D;
  { __attribute__((address_space(3))) unsigned short*stg=(__attribute__((address_space(3))) unsigned short*)(shm3+LDS_OST)+wid*2048;
    #pragma unroll
    for(int r=0;r<16;++r){const int orow=crow(r,hi);
      #pragma unroll
      for(int d0=0;d0<2;++d0)stg[orow*64+d0*32+r32]=(unsigned short)(cvtpk_s(o[d0][r]*rli[r],0.f)&0xffffu);}
    asm volatile("s_waitcnt lgkmcnt(0)":::"memory");
    #pragma unroll
    for(int i=0;i<4;++i){const int row=i*8+(lane>>3),ch=lane&7; const u32x4 v=*(const __attribute__((address_space(3))) u32x4*)(stg+row*64+ch*8); ATTN_STORE16((char*)Ow+(unsigned)((row*OPITCH+ch*8)*2),v);} }
  asm volatile("s_waitcnt lgkmcnt(0)\n\ts_barrier":::"memory");
  #undef DMA_K
  #undef DMA_V
  #undef CMASK
  #undef BINIT_ALL
  #undef ROT
}
constexpr int ATTN_LDS_BYTES=LDS_TOTAL;
struct AttnTensors { const bf16* Q; const bf16* K; const bf16* V; bf16* O; const float* CB; float qkb; };
struct AttnUnit { int bh; int qb; };
struct StaticOrder {
  int vcu,G;
  __device__ __forceinline__ explicit StaticOrder(int grid,int block):vcu((grid%8==0)?(block%8)*(grid/8)+block/8:block),G(grid){}
  __device__ __forceinline__ bool next(int i,AttnUnit&u)const{
    if(G==256){ if(i>=4)return false; const int s=vcu&3; u.bh=vcu>>2; u.qb=(i==0)?s:(i==1)?7-s:(i==2)?8+s:15-s; return true; }
    const int id=vcu+i*G; if(id>=BATCH*NHEAD*NQB)return false; u.bh=id/NQB; u.qb=id%NQB; return true; }
};
template<class Sched,bool SKIP> __device__ __forceinline__ void attn_phase(char*lds,const AttnTensors&T,const Sched&S){
  AttnUnit u;
  for(int i=0;S.next(i,u);++i){ attn_unit<SKIP>(u.bh/NHEAD,u.bh%NHEAD,u.qb,T.Q,T.K,T.V,T.O,T.CB,T.qkb,lds); }
}
template<bool SKIP> __device__ __forceinline__ void attn_phase_q(char*lds,const AttnTensors&T,unsigned*queue){
  const int tid=otid();
  __attribute__((address_space(3))) int*slot=(__attribute__((address_space(3))) int*)((lds_cptr)lds+LDS_TOTAL);
  const unsigned xcc=(unsigned)__builtin_amdgcn_s_getreg((3<<11)|20)&7u;
  for(;;){
    if(tid==0){ int got=-1;
      for(unsigned sx=0;sx<8;++sx){ const unsigned x=(xcc+sx)&7u; const unsigned c=__hip_atomic_fetch_add(queue+x*64,1u,__ATOMIC_RELAXED,__HIP_MEMORY_SCOPE_AGENT); if(c<(unsigned)(NHEAD*NQB)){ got=(int)(x*(NHEAD*NQB)+c); break; } }
      *slot=got; }
    asm volatile("s_waitcnt vmcnt(0) lgkmcnt(0)\n\ts_barrier":::"memory");
    const int id=__builtin_amdgcn_readfirstlane(*slot);
    if(id<0)break;
    const int b=id/(NHEAD*NQB), c=id%(NHEAD*NQB), h=c%NHEAD, qb=NQB-1-c/NHEAD;
    attn_unit<SKIP>(b,h,qb,T.Q,T.K,T.V,T.O,T.CB,T.qkb,lds);
  }
}
#undef SBAR
#undef WAIT_BAR
}
#define GAS __attribute__((address_space(1)))
#define LAS __attribute__((address_space(3)))
typedef unsigned short bf16;
typedef unsigned v4u __attribute__((ext_vector_type(4)));
typedef float f32x4 __attribute__((ext_vector_type(4)));
typedef short bf16x8 __attribute__((ext_vector_type(8)));
typedef GAS unsigned gu32;
typedef GAS unsigned long long gu64;
#define RLX_AGENT __ATOMIC_RELAXED, __HIP_MEMORY_SCOPE_AGENT
#define LDS_WAIT() asm volatile("s_waitcnt lgkmcnt(0)" ::: "memory")
#define VM_WAIT() asm volatile("s_waitcnt vmcnt(0)" ::: "memory")
__device__ __forceinline__ unsigned long long rt() { return __builtin_amdgcn_s_memrealtime(); }
__device__ __forceinline__ unsigned f2bf(float f) { unsigned u = __builtin_bit_cast(unsigned, f); return (u + 0x7fffu + ((u >> 16) & 1u)) >> 16; }
__device__ __forceinline__ unsigned pk2(float lo, float hi) { return f2bf(lo) | (f2bf(hi) << 16); }

#define XB_TMO      128
#define XB_XCNT(j)  (256  + 64 * (j))
#define XB_XSUB(j)  (1280 + 64 * (j))
#define XB_XGEN(j)  (2304 + 64 * (j))
#define XB_TOP      3328
#define XB_TOPGEN   3392
#define XCD_BAR_WORDS 3456
#define XB_SPIN_CAP (1u << 18)

__device__ __forceinline__ unsigned xb_ld(unsigned* p)              { return __hip_atomic_load(p, __ATOMIC_RELAXED, __HIP_MEMORY_SCOPE_AGENT); }
__device__ __forceinline__ unsigned xb_add(unsigned* p, unsigned v) { return __hip_atomic_fetch_add(p, v, __ATOMIC_RELAXED, __HIP_MEMORY_SCOPE_AGENT); }
__device__ __forceinline__ unsigned xb_xcc_id() { return (unsigned)__builtin_amdgcn_s_getreg((3 << 11) | 20) & 0xFu; }
#define XB_SPIN(cond, bar) do { unsigned _sp = 0; while (cond) { __builtin_amdgcn_s_sleep(1); \
    if ((++_sp & 255u) == 0u) { if (xb_ld(&(bar)[XB_TMO])) break; if (_sp > XB_SPIN_CAP) { atomicAdd(&(bar)[XB_TMO], 1u); break; } } } } while (0)

struct XcdBarrier {
    unsigned* bar; unsigned x;
    volatile LAS unsigned* st;
};

__device__ __forceinline__ XcdBarrier xcd_barrier_post(unsigned* bar, volatile LAS unsigned* st) {
    XcdBarrier b; b.bar = bar; b.x = xb_xcc_id(); b.st = st;
    if (threadIdx.x == 0) (void)xb_add(&bar[XB_XCNT(b.x)], 1u);
    return b;
}
__device__ __forceinline__ void xcd_barrier_complete(unsigned* bar, unsigned x, unsigned& nloc, unsigned& nx) {
    const unsigned G = gridDim.x * gridDim.y * gridDim.z;
    unsigned sum, cnt, mine, sp = 0u;
    for (;;) {
        sum = 0u; cnt = 0u; mine = 0u;
#pragma unroll
        for (unsigned j = 0; j < 16; ++j) { const unsigned c = xb_ld(&bar[XB_XCNT(j)]); sum += c; cnt += (c > 0u) ? 1u : 0u; mine = (j == x) ? c : mine; }
        if (sum == G) break;
        __builtin_amdgcn_s_sleep(1);
        if ((++sp & 255u) == 0u) { if (xb_ld(&bar[XB_TMO])) break; if (sp > XB_SPIN_CAP) { atomicAdd(&bar[XB_TMO], 1u); break; } }
    }
    nloc = mine > 0u ? mine : 1u; nx = cnt > 0u ? cnt : 1u;
}

__device__ __forceinline__ void xcd_barrier(const XcdBarrier& b) {
    asm volatile("s_waitcnt vmcnt(0)" ::: "memory");
    __syncthreads();
    if (threadIdx.x == 0) {
        unsigned* bar = b.bar;
        __builtin_amdgcn_s_waitcnt(0);
        unsigned nloc = b.st[0], nx = b.st[1];
        if (nloc == 0u) { xcd_barrier_complete(bar, b.x, nloc, nx); b.st[0] = nloc; b.st[1] = nx; }
        const unsigned old = xb_add(&bar[XB_XSUB(b.x)], 1u);
        const unsigned gen = old / nloc;
        if (old + 1u == (gen + 1u) * nloc) {
            __builtin_amdgcn_fence(__ATOMIC_RELEASE, "agent");
            asm volatile("s_waitcnt vmcnt(0)" ::: "memory");
            const unsigned og = xb_add(&bar[XB_TOP], 1u);
            const unsigned tg = og / nx;
            if (og + 1u == (tg + 1u) * nx) xb_add(&bar[XB_TOPGEN], 1u);
            else XB_SPIN(xb_ld(&bar[XB_TOPGEN]) == tg, bar);
            __builtin_amdgcn_fence(__ATOMIC_ACQUIRE, "agent");
            xb_add(&bar[XB_XGEN(b.x)], 1u);
            asm volatile("s_waitcnt vmcnt(0)" ::: "memory");
        } else {
            XB_SPIN(xb_ld(&bar[XB_XGEN(b.x)]) == gen, bar);
            __builtin_amdgcn_fence(__ATOMIC_ACQUIRE, "agent");
            asm volatile("s_waitcnt vmcnt(0)" ::: "memory");
        }
    }
    __syncthreads();
}
struct Args { const float* in[25]; float* out; unsigned char* ws; int ph_lo, ph_hi, use_bar, pad; };
typedef const __attribute__((address_space(4))) Args* KArgs;
#define CAND_LIST CAND(0,0,2,1) CAND(0,1,2,2) CAND(0,2,2,3) CAND(0,3,2,4) CAND(0,4,3,0) CAND(0,5,3,1) CAND(0,6,3,2) CAND(0,7,3,3) CAND(0,8,4,0) CAND(0,9,4,1) CAND(0,10,4,2) CAND(0,11,5,0) CAND(0,12,5,1) CAND(0,13,6,0) CAND(0,14,6,1) CAND(0,15,7,0) CAND(1,0,7,1) CAND(1,1,8,0) CAND(1,2,9,0) CAND(1,3,10,0) CAND(1,4,11,0) CAND(1,5,12,0) CAND(1,6,13,0) CAND(1,7,14,0) CAND(2,0,15,0)
constexpr int NB = 8, SEQ = 4096, DM = 1024, NTOK = NB * SEQ;
constexpr int NH = 8, HD = 64, AW = 512, PWD = 256, SWD = 256, INC = 2056;
constexpr int NEXP = 16384, PQW = 2048;
constexpr float EPSN = 1e-6f, LOG2E = 1.4426950408889634f;
constexpr int NWAVES = 8, NTHR = 512;
constexpr size_t MiB = 1u << 20;
constexpr size_t WS_CTL = 0, CTL_ZERO_BYTES = 1 * MiB;
constexpr size_t WS_WIN = 1 * MiB;
constexpr size_t WS_WOUT = 9 * MiB;
constexpr size_t WS_WQ = 13 * MiB;
constexpr size_t WS_KEYS = 21 * MiB;
constexpr size_t WS_WGLU = 22 * MiB;
constexpr size_t WS_WF = 22 * MiB + 512 * 1024;
constexpr size_t WS_CB = 23 * MiB;
constexpr size_t WS_XLOC = 24 * MiB;
constexpr size_t WS_IDX = 28 * MiB;
constexpr size_t WS_GATE = 44 * MiB;
constexpr size_t WS_Z = 60 * MiB;
constexpr size_t WS_U = 76 * MiB;
constexpr size_t WS_V = 140 * MiB;
constexpr size_t WS_XN8 = 172 * MiB;
constexpr size_t WS_HSC = 22 * MiB + 768 * 1024;
constexpr size_t WS_XN = 204 * MiB;
constexpr size_t WS_P = 268 * MiB;
constexpr size_t WS_MG = 396 * MiB;
constexpr size_t WS_END = 460 * MiB;
constexpr int CW_BAR = 4096, CW_AQ = 20480;
constexpr float U8_SCALE = 768.f, V8_SCALE = 32.f, ACT_SCALE = 64.f;
constexpr int RING_BYTES = 131072, LDSCTL_OFF = RING_BYTES, MISC_OFF = LDSCTL_OFF + 320, EPIX_OFF = LDSCTL_OFF + 4096, LDS_BYTES = 163840;
static_assert(attn_body::ATTN_LDS_BYTES + 16 <= RING_BYTES, "attention scratch fits the ring");

typedef _Float16 h16x2 __attribute__((ext_vector_type(2)));
typedef float f32x16 __attribute__((ext_vector_type(16)));
typedef unsigned u32x2 __attribute__((ext_vector_type(2)));

__device__ __forceinline__ float bf2f(unsigned short b) { return __uint_as_float((unsigned)b << 16); }
__device__ __forceinline__ float bflo(unsigned w) { return __uint_as_float(w << 16); }
__device__ __forceinline__ float bfhi(unsigned w) { return __uint_as_float(w & 0xffff0000u); }
__device__ __forceinline__ h16x2 as_h2(unsigned w) { return __builtin_bit_cast(h16x2, w); }
template <bool HI> __device__ __forceinline__ h16x2 cvt8h(int w) { return __builtin_bit_cast(h16x2, __builtin_amdgcn_cvt_scalef32_pk_f16_fp8(w, 1.0f, HI)); }
__device__ __forceinline__ float gelu_tanh(float x) { const float u = 1.5957691216057308f * (x + 0.044715f * x * x * x); return x / (1.f + __expf(-u)); }
__device__ __forceinline__ float wave_sum(float v) {
#pragma unroll
    for (int o = 1; o < 64; o <<= 1) v += __shfl_xor(v, o);
    return v;
}
__device__ __forceinline__ float wave_max(float v) {
#pragma unroll
    for (int o = 1; o < 64; o <<= 1) v = fmaxf(v, __shfl_xor(v, o));
    return v;
}
template <int N, int S0> __device__ __forceinline__ float bfly_reduce(float (&v)[N], int lane) {
    int s = S0;
#pragma unroll
    for (int cnt = N; cnt > 1; cnt >>= 1) {
        const bool up = (lane & s) != 0;
#pragma unroll
        for (int i = 0; i < cnt / 2; ++i) { const float a = v[i], b = v[i + cnt / 2]; const float send = up ? a : b, keep = up ? b : a; v[i] = keep + __shfl_xor(send, s); }
        s >>= 1;
    }
    float r = v[0];
    for (; s >= 1; s >>= 1) r += __shfl_xor(r, s);
    return r;
}

__device__ __forceinline__ void tr_item(const float* W, int ldw, int srccol, bf16* WT, int K, int dstrow, int k0, LAS float* scr, int lane) {
#pragma unroll 8
    for (int i = 0; i < 32; ++i) { const int kk = 2 * i + (lane >> 5); scr[kk * 33 + (lane & 31)] = W[(size_t)(k0 + kk) * ldw + srccol + (lane & 31)]; }
    LDS_WAIT(); asm volatile("" ::: "memory");
    const int c = lane & 7;
#pragma unroll
    for (int j = 0; j < 4; ++j) { const int n = (lane >> 3) + 8 * j; const LAS float* s = scr + (8 * c) * 33 + n;
        v4u o; o.x = pk2(s[0 * 33], s[1 * 33]); o.y = pk2(s[2 * 33], s[3 * 33]); o.z = pk2(s[4 * 33], s[5 * 33]); o.w = pk2(s[6 * 33], s[7 * 33]);
        *(GAS v4u*)(WT + (size_t)(dstrow + n) * K + k0 + 8 * c) = o; }
    LDS_WAIT(); asm volatile("" ::: "memory");
}
__device__ __forceinline__ void phase_prep(KArgs a, LAS unsigned char* lds, int G, int vcu, int tid, int lane, int wave) {
    unsigned char* ws = a->ws;
    LAS float* scr = (LAS float*)(lds + wave * 16384);
    const int gw = vcu * NWAVES + wave, NGW = G * NWAVES;
    constexpr int I_IN = 2048, I_OUT = 1024, I_WQ = 2048, I_GLU = 64;
    for (int it = gw; it < I_IN + I_OUT + I_WQ + I_GLU; it += NGW) {
        int r = it;
        if (r < I_IN) { const int l = r >> 10, q = r & 1023, kb = q >> 6, nb = q & 63, n0 = nb * 32;
            tr_item(a->in[2] + (size_t)l * DM * INC, INC, n0 + (n0 >= 1536 ? 8 : 0), (bf16*)(ws + WS_WIN) + (size_t)l * 2048 * 1024, 1024, n0, kb * 64, scr, lane); continue; }
        r -= I_IN;
        if (r < I_OUT) { const int l = r >> 9, q = r & 511, kb = q >> 5, nb = q & 31;
            tr_item(a->in[19] + (size_t)l * DM * DM, DM, nb * 32, (bf16*)(ws + WS_WOUT) + (size_t)l * 1024 * 1024, 1024, nb * 32, kb * 64, scr, lane); continue; }
        r -= I_OUT;
        if (r < I_WQ) { const int l = r >> 10, q = r & 1023, kb = q >> 6, nb = q & 63;
            tr_item(a->in[21] + (size_t)l * DM * PQW, PQW, nb * 32, (bf16*)(ws + WS_WQ) + (size_t)l * 2048 * 1024, 1024, nb * 32, kb * 64, scr, lane); continue; }
        r -= I_WQ;
        { const int l = r >> 5, q = r & 31, kb = q >> 3, nb = q & 7;
            tr_item(a->in[16] + (size_t)l * 256 * 256, 256, nb * 32, (bf16*)(ws + WS_WGLU) + (size_t)l * 256 * 256, 256, nb * 32, kb * 64, scr, lane); }
    }
    const size_t gt = (size_t)vcu * NTHR + tid, NGT = (size_t)G * NTHR;
    for (size_t i = gt; i < 2 * 8 * 1024; i += NGT) { const int l = (int)(i >> 13), h = (int)(i >> 10) & 7, k = (int)i & 1023;
        ((float*)(ws + WS_WF))[i] = a->in[2][((size_t)l * DM + k) * INC + 1536 + h]; }
    { const float* src = a->in[22]; bf16* dst = (bf16*)(ws + WS_KEYS);
      for (size_t i = gt; i < (size_t)2 * 8 * 2 * 128 * 128 / 8; i += NGT) { const f32x4 x0 = *(const f32x4*)(src + i * 8), x1 = *(const f32x4*)(src + i * 8 + 4);
          v4u o; o.x = pk2(x0[0], x0[1]); o.y = pk2(x0[2], x0[3]); o.z = pk2(x1[0], x1[1]); o.w = pk2(x1[2], x1[3]); *(v4u*)(dst + i * 8) = o; } }
    { const float* src = a->in[23]; unsigned char* dst = ws + WS_U;
#pragma unroll 1
      for (size_t i = gt; i < (size_t)2 * NEXP * DM / 16; i += NGT) { v4u o;
#pragma unroll
          for (int q = 0; q < 4; ++q) { const f32x4 x = *(const f32x4*)(src + i * 16 + 4 * q) * U8_SCALE;
              const int q0 = (int)__builtin_rintf(fminf(fmaxf(x[0], -127.f), 127.f)), q1 = (int)__builtin_rintf(fminf(fmaxf(x[1], -127.f), 127.f)), q2 = (int)__builtin_rintf(fminf(fmaxf(x[2], -127.f), 127.f)), q3 = (int)__builtin_rintf(fminf(fmaxf(x[3], -127.f), 127.f));
              o[q] = (unsigned)((q0 & 255) | ((q1 & 255) << 8) | ((q2 & 255) << 16) | (q3 << 24)); }
          const size_t r = i >> 6; const unsigned cg = (unsigned)(i & 63), l = (unsigned)(r / NEXP), rl = (unsigned)(r % NEXP);
          *(v4u*)(dst + (size_t)l * NEXP * DM + (size_t)(cg >> 3) * NEXP * 128 + (size_t)rl * 128 + (cg & 7u) * 16u) = o; } }
    { const float* src = a->in[24]; unsigned char* dst = ws + WS_V;
#pragma unroll 1
      for (size_t i = gt; i < (size_t)2 * NEXP * DM / 16; i += NGT) { v4u o;
#pragma unroll
          for (int q = 0; q < 4; ++q) { f32x4 x = *(const f32x4*)(src + i * 16 + 4 * q) * V8_SCALE;
              x[0] = fminf(fmaxf(x[0], -448.f), 448.f); x[1] = fminf(fmaxf(x[1], -448.f), 448.f); x[2] = fminf(fmaxf(x[2], -448.f), 448.f); x[3] = fminf(fmaxf(x[3], -448.f), 448.f);
              int w = 0; w = __builtin_amdgcn_cvt_pk_fp8_f32(x[0], x[1], w, false); w = __builtin_amdgcn_cvt_pk_fp8_f32(x[2], x[3], w, true); o[q] = (unsigned)w; }
          const size_t r = i >> 6; const unsigned cg = (unsigned)(i & 63), l = (unsigned)(r / NEXP), rl = (unsigned)(r % NEXP);
          *(v4u*)(dst + (size_t)l * NEXP * DM + (size_t)(cg >> 3) * NEXP * 128 + (size_t)rl * 128 + (cg & 7u) * 16u) = o; } }
}

template <bool FLOGIT> __device__ __forceinline__ void phase_rownorm(const float* x, const float* g, bf16* XN, const float* WF, const float* fbias, float* CB, int G, int vcu, int lane, int wave, unsigned char* XN8 = nullptr, float* HSC = nullptr) {
    const int gw = vcu * NWAVES + wave, NGW = G * NWAVES;
    f32x4 gv[4];
#pragma unroll
    for (int j = 0; j < 4; ++j) gv[j] = *(const f32x4*)(g + 4 * lane + 256 * j);
    f32x4 vn[2][4];
#define RN_LOAD(rg_) do { _Pragma("unroll") for (int r = 0; r < 2; ++r) { const float* xr = x + (size_t)((rg_) * 2 + r) * DM + 4 * lane; _Pragma("unroll") for (int j = 0; j < 4; ++j) vn[r][j] = *(const f32x4*)(xr + 256 * j); } } while (0)
    if (gw < NTOK / 2) RN_LOAD(gw);
    for (int rg = gw; rg < NTOK / 2; rg += NGW) {
        f32x4 v[2][4];
#pragma unroll
        for (int r = 0; r < 2; ++r)
#pragma unroll
            for (int j = 0; j < 4; ++j) v[r][j] = vn[r][j];
        if (rg + NGW < NTOK / 2) RN_LOAD(rg + NGW);
#pragma unroll
        for (int r = 0; r < 2; ++r) { float s = 0.f;
#pragma unroll
            for (int j = 0; j < 4; ++j) s += (v[r][j][0] * v[r][j][0] + v[r][j][1] * v[r][j][1]) + (v[r][j][2] * v[r][j][2] + v[r][j][3] * v[r][j][3]);
            const float rstd = 1.0f / sqrtf(wave_sum(s) * (1.f / DM) + EPSN);
            bf16* orow = XN + (size_t)(rg * 2 + r) * DM + 4 * lane;
#pragma unroll
            for (int j = 0; j < 4; ++j) { v[r][j] = v[r][j] * rstd * gv[j]; u32x2 w; w.x = pk2(v[r][j][0], v[r][j][1]); w.y = pk2(v[r][j][2], v[r][j][3]); *(u32x2*)(orow + 256 * j) = w; }
            if (!FLOGIT && XN8) { float mx = 0.f;
#pragma unroll
                for (int j = 0; j < 4; ++j) mx = fmaxf(fmaxf(mx, fmaxf(fabsf(v[r][j][0]), fabsf(v[r][j][1]))), fmaxf(fabsf(v[r][j][2]), fabsf(v[r][j][3])));
                mx = fmaxf(wave_max(mx), 1e-20f); const float qs = 127.f / mx;
#pragma unroll
                for (int j = 0; j < 4; ++j) { const int q0 = (int)__builtin_rintf(v[r][j][0] * qs), q1 = (int)__builtin_rintf(v[r][j][1] * qs), q2 = (int)__builtin_rintf(v[r][j][2] * qs), q3 = (int)__builtin_rintf(v[r][j][3] * qs);
                    *(unsigned*)(XN8 + (size_t)(rg * 2 + r) * DM + 4 * lane + 256 * j) = (unsigned)((q0 & 255) | ((q1 & 255) << 8) | ((q2 & 255) << 16) | (q3 << 24)); }
                if (lane == 0) HSC[rg * 2 + r] = mx * (1.f / 127.f); } }
        if (FLOGIT) {
            float acc[16];
#pragma unroll
            for (int i = 0; i < 16; ++i) acc[i] = 0.f;
#pragma unroll
            for (int h = 0; h < 8; ++h)
#pragma unroll
                for (int j = 0; j < 4; ++j) { const f32x4 w = *(const f32x4*)(WF + h * 1024 + 4 * lane + 256 * j);
#pragma unroll
                    for (int r = 0; r < 2; ++r) acc[r * 8 + h] += (v[r][j][0] * w[0] + v[r][j][1] * w[1]) + (v[r][j][2] * w[2] + v[r][j][3] * w[3]); }
            const float tot = bfly_reduce<16, 32>(acc, lane);
            if ((lane & 3) == 0) { const int id = (lane >> 2) & 15, r = id >> 3, h = id & 7; const int row = rg * 2 + r, b = row / SEQ, s = row % SEQ;
                const float z = tot + fbias[h];
                const float ls = fminf(z, 0.f) - __logf(1.f + __expf(-fabsf(z)));
                CB[((size_t)(b * NH + h)) * SEQ + s] = ls * LOG2E; }
        }
    }
}

__device__ __forceinline__ void phase_cumsum(float* c, int lane) {
    float carry = 0.f;
#pragma unroll 1
    for (int it0 = 0; it0 < SEQ / 64; it0 += 16) { float vv[16];
#pragma unroll
        for (int q = 0; q < 16; ++q) vv[q] = c[(it0 + q) * 64 + lane];
#pragma unroll
        for (int q = 0; q < 16; ++q) { float v = vv[q];
#pragma unroll
            for (int o = 1; o < 64; o <<= 1) { const float t = __shfl_up(v, o); if (lane >= o) v += t; }
            v += carry; c[(it0 + q) * 64 + lane] = v; carry = __shfl(v, 63); } }
}

__device__ __forceinline__ void phase_pool(const bf16* PS, const float* pw, const float* pscale, const float* ong, bf16* MG, LAS unsigned char* lds, int G, int bx, int tid, int lane, int wave) {
    LAS float* ut = (LAS float*)lds;
    LAS float* pl = (LAS float*)(lds + 47 * 256 * 4);
    const int ch = tid & 255, half = tid >> 8, g = ch >> 6, w = 2 << g;
    float wcol[64];
#pragma unroll
    for (int c = 0; c < 64; ++c) wcol[c] = pw[(g * 64 + c) * 64 + (ch & 63)];
    const float psc = pscale[ch];
    const f32x4 gn = *(const f32x4*)(ong + 512 + 4 * lane);
    v4u wq[3];
#define POOL_LOAD(tile_) do { const int tok0_ = (tile_) * 32, s0_ = tok0_ % SEQ; _Pragma("unroll") for (int q = 0; q < 3; ++q) { const int idx = tid + q * NTHR, rr = idx >> 5, cq = idx & 31, r = rr - 15; \
        wq[q] = (v4u){0u, 0u, 0u, 0u}; if (idx < 47 * 32 && s0_ + r >= 0) wq[q] = *(const v4u*)(PS + (size_t)(tok0_ + r) * 512 + cq * 8); } } while (0)
    if (bx < NTOK / 32) POOL_LOAD(bx);
    for (int tile = bx; tile < NTOK / 32; tile += G) {
        const int tok0 = tile * 32, s0 = tok0 % SEQ;
#pragma unroll
        for (int q = 0; q < 3; ++q) { const int idx = tid + q * NTHR, rr = idx >> 5, cq = idx & 31; const v4u wv = wq[q];
            if (idx < 47 * 32) { LAS float* d = ut + rr * 256 + cq * 8;
                *(LAS f32x4*)d = (f32x4){bflo(wv.x), bfhi(wv.x), bflo(wv.y), bfhi(wv.y)}; *(LAS f32x4*)(d + 4) = (f32x4){bflo(wv.z), bfhi(wv.z), bflo(wv.w), bfhi(wv.w)}; } }
        if (tile + G < NTOK / 32) POOL_LOAD(tile + G);
        __syncthreads();
        { float s = 0.f; const int rr0 = half * 16 + 15;
            for (int j = 1; j < w; ++j) s += ut[(rr0 - j) * 256 + ch];
#pragma unroll 4
            for (int tt = 0; tt < 16; ++tt) { const int ti = half * 16 + tt, rr = ti + 15, pos = s0 + ti; const float cur = ut[rr * 256 + ch];
                s += cur; const int cnt = (pos + 1 < w) ? pos + 1 : w;
                pl[ti * 256 + ch] = s / (float)cnt - cur; s -= ut[(rr - w + 1) * 256 + ch]; } }
        __syncthreads();
#pragma unroll 1
        for (int tt = 0; tt < 16; ++tt) { const int ti = half * 16 + tt; const LAS f32x4* pr = (const LAS f32x4*)(pl + ti * 256 + g * 64);
            float acc = 0.f;
#pragma unroll
            for (int c4 = 0; c4 < 16; ++c4) { const f32x4 v = pr[c4]; acc += (v[0] * wcol[4 * c4] + v[1] * wcol[4 * c4 + 1]) + (v[2] * wcol[4 * c4 + 2] + v[3] * wcol[4 * c4 + 3]); }
            ut[ti * 256 + ch] = acc * psc; }
        __syncthreads();
#pragma unroll
        for (int q = 0; q < 4; ++q) { const int ti = wave * 4 + q; const f32x4 v = *(const LAS f32x4*)(ut + ti * 256 + 4 * lane);
            const float ss = wave_sum((v[0] * v[0] + v[1] * v[1]) + (v[2] * v[2] + v[3] * v[3]));
            const float rstd = 1.0f / sqrtf(ss * (1.f / 256.f) + EPSN);
            u32x2 o; o.x = pk2(v[0] * rstd * gn[0], v[1] * rstd * gn[1]); o.y = pk2(v[2] * rstd * gn[2], v[3] * rstd * gn[3]);
            *(u32x2*)(MG + (size_t)(tok0 + ti) * DM + 512 + 4 * lane) = o; }
        __syncthreads();
    }
}

template <bool PASS2> __device__ __forceinline__ void phase_s5(KArgs a, int l, const bf16* PS, float* XLOC, bf16* Z, LAS unsigned char* lds, int G, int bx, int lane, int wave) {
    LAS float* Xs = (LAS float*)(lds + wave * (16 * 130 * 4));
    const int p = lane, kq = lane >> 4, ln = lane & 15;
    for (int task = bx; task < NB * 16 * 8; task += G) {
        const int b = task >> 7, g = (task >> 3) & 15, c = (task & 7) * 8 + wave;
        const size_t tok_c = (size_t)b * SEQ + c * 64;
        const float a_re = a->in[8][(l * 16 + g) * 64 + p], a_im = a->in[9][(l * 16 + g) * 64 + p], ldt = a->in[10][l * 16 + g];
        u32x2 uraw[4];
#pragma unroll
        for (int sub = 0; sub < 4; ++sub) uraw[sub] = *(const u32x2*)(PS + (tok_c + sub * 16 + ln) * 512 + 256 + g * 16 + 4 * kq);
        float braw[4][4], biaw[4][4];
#pragma unroll
        for (int q = 0; q < 4; ++q)
#pragma unroll
            for (int ks = 0; ks < 4; ++ks) { const size_t bi = ((size_t)((l * 16 + g) * 64 + 16 * q + ln)) * 16 + 4 * kq + ks; braw[q][ks] = a->in[11][bi]; biaw[q][ks] = a->in[12][bi]; }
        float cfrag[32]; float dsk = 0.f; unsigned short usk[16];
        if (PASS2) {
#pragma unroll
            for (int ks = 0; ks < 32; ++ks) { const int k = 4 * ks + kq, pp = k & 63; const size_t ci = ((size_t)((l * 16 + g) * 16 + ln)) * 64 + pp;
                cfrag[ks] = (ks < 16) ? a->in[13][ci] : -a->in[14][ci]; }
            dsk = a->in[15][l * 256 + g * 16 + ln];
#pragma unroll
            for (int i = 0; i < 16; ++i) usk[i] = PS[(tok_c + (i >> 2) * 16 + 4 * kq + (i & 3)) * 512 + 256 + g * 16 + ln];
        }
        const float dt = expf(ldt);
        float abr, abi, fr, fi;
        { const float xx = a_re * dt, yy = a_im * dt; const float ex = expf(xx); float sn, cs; sincosf(yy, &sn, &cs);
          abr = ex * cs; abi = ex * sn;
          const float sh = sinf(0.5f * yy); const float er = expm1f(xx) * cs - 2.f * sh * sh, ei = abi;
          const float den = a_re * a_re + a_im * a_im; fr = (er * a_re + ei * a_im) / den; fi = (ei * a_re - er * a_im) / den; }
        float bfrag[8][4];
#pragma unroll
        for (int q = 0; q < 4; ++q) { const float frq = __shfl(fr, 16 * q + ln), fiq = __shfl(fi, 16 * q + ln);
#pragma unroll
            for (int ks = 0; ks < 4; ++ks) { bfrag[q][ks] = frq * braw[q][ks] - fiq * biaw[q][ks]; bfrag[4 + q][ks] = frq * biaw[q][ks] + fiq * braw[q][ks]; } }
        float xr = 0.f, xi = 0.f;
        if (PASS2) {
            float pr = abr, pi = abi;
#pragma unroll
            for (int q = 0; q < 6; ++q) { const float nr = pr * pr - pi * pi, ni = 2.f * pr * pi; pr = nr; pi = ni; }
            const float* xl = XLOC + ((size_t)(b * 16 + g) * 64) * 128 + p;
            int j = 0;
#pragma unroll 1
            for (; j + 16 <= c; j += 16) { float lr[16], li[16];
#pragma unroll
                for (int q = 0; q < 16; ++q) { lr[q] = xl[(size_t)(j + q) * 128]; li[q] = xl[(size_t)(j + q) * 128 + 64]; }
#pragma unroll
                for (int q = 0; q < 16; ++q) { const float nr = pr * xr - pi * xi + lr[q], ni = pr * xi + pi * xr + li[q]; xr = nr; xi = ni; } }
            { float lr[16], li[16];
#pragma unroll
                for (int q = 0; q < 16; ++q) { const int jj = (j + q < c) ? j + q : 0; lr[q] = xl[(size_t)jj * 128]; li[q] = xl[(size_t)jj * 128 + 64]; }
#pragma unroll
                for (int q = 0; q < 16; ++q) if (j + q < c) { const float nr = pr * xr - pi * xi + lr[q], ni = pr * xi + pi * xr + li[q]; xr = nr; xi = ni; } }
        }
#pragma unroll
        for (int sub = 0; sub < 4; ++sub) {
            const size_t tokb = tok_c + sub * 16;
            const float ua[4] = {bflo(uraw[sub].x), bfhi(uraw[sub].x), bflo(uraw[sub].y), bfhi(uraw[sub].y)};
#pragma unroll
            for (int nb = 0; nb < 8; ++nb) { f32x4 acc = {0.f, 0.f, 0.f, 0.f};
#pragma unroll
                for (int ks = 0; ks < 4; ++ks) acc = __builtin_amdgcn_mfma_f32_16x16x4f32(ua[ks], bfrag[nb][ks], acc, 0, 0, 0);
#pragma unroll
                for (int r = 0; r < 4; ++r) Xs[(4 * kq + r) * 130 + 16 * nb + ln] = acc[r]; }
            float bur[16], bui[16];
#pragma unroll
            for (int i = 0; i < 16; ++i) { bur[i] = Xs[i * 130 + p]; bui[i] = Xs[i * 130 + 64 + p]; }
#pragma unroll
            for (int i = 0; i < 16; ++i) { const float nr = abr * xr - abi * xi + bur[i], ni = abr * xi + abi * xr + bui[i]; xr = nr; xi = ni;
                if (PASS2) { Xs[i * 130 + p] = xr; Xs[i * 130 + 64 + p] = xi; } }
            if (PASS2) {
                f32x4 y0 = {0.f, 0.f, 0.f, 0.f}, y1 = {0.f, 0.f, 0.f, 0.f};
#pragma unroll
                for (int ks = 0; ks < 32; ks += 2) { y0 = __builtin_amdgcn_mfma_f32_16x16x4f32(Xs[ln * 130 + 4 * ks + kq], cfrag[ks], y0, 0, 0, 0);
                    y1 = __builtin_amdgcn_mfma_f32_16x16x4f32(Xs[ln * 130 + 4 * (ks + 1) + kq], cfrag[ks + 1], y1, 0, 0, 0); }
#pragma unroll
                for (int r = 0; r < 4; ++r) { const size_t tk = tokb + 4 * kq + r; const float uv = bf2f(usk[sub * 4 + r]);
                    const float y = y0[r] + y1[r] + dsk * uv; Z[tk * 256 + g * 16 + ln] = (bf16)f2bf(gelu_tanh(y)); }
            }
        }
        if (!PASS2) { float* xl = XLOC + ((size_t)((b * 16 + g) * 64 + c)) * 128 + p; xl[0] = xr; xl[64] = xi; }
    }
}

__device__ __forceinline__ void phase_glu(const bf16* Z, const bf16* WG, const float* gb, const float* ong, bf16* MG, LAS unsigned char* lds, int G, int bx, int vcu, int tid, int lane, int wave) {
    LAS unsigned char* zt = lds;
    LAS float* ssq = (LAS float*)(lds + 64 * 528);
    LAS float* rs = ssq + 64 * 8;
    const int n = 32 * wave + (lane & 31), hs = lane >> 5;
    const float bn = gb[n], gnn = ong[768 + n];
    for (int tile = bx; tile < NTOK / 64; tile += G) {
        const size_t tok0 = (size_t)tile * 64;
        for (int idx = tid; idx < 64 * 32; idx += NTHR) { const int r = idx >> 5, cq = idx & 31; *(LAS v4u*)(zt + r * 528 + cq * 16) = *(const v4u*)(Z + (tok0 + r) * 256 + cq * 8); }
        __syncthreads();
        f32x16 acc[2]; acc[0] = f32x16{}; acc[1] = f32x16{};
#pragma unroll
        for (int ks = 0; ks < 16; ++ks) { const bf16x8 bw = *(const bf16x8*)(WG + (size_t)n * 256 + ks * 16 + 8 * hs);
#pragma unroll
            for (int mb = 0; mb < 2; ++mb) { const bf16x8 az = *(const LAS bf16x8*)(zt + (mb * 32 + (lane & 31)) * 528 + (ks * 16 + 8 * hs) * 2);
                acc[mb] = __builtin_amdgcn_mfma_f32_32x32x16_bf16(az, bw, acc[mb], 0, 0, 0); } }
        float val[32], sq[32];
#pragma unroll
        for (int mb = 0; mb < 2; ++mb)
#pragma unroll
            for (int r = 0; r < 16; ++r) { const int m = mb * 32 + (r & 3) + 8 * (r >> 2) + 4 * hs; const float z = bf2f(*(const LAS unsigned short*)(zt + m * 528 + n * 2));
                const float v = z / (1.f + __expf(-(acc[mb][r] + bn))); val[mb * 16 + r] = v; sq[mb * 16 + r] = v * v; }
        const float tot = bfly_reduce<32, 16>(sq, lane);
        { const int id = lane & 31, mb = id >> 4, r = id & 15, m = mb * 32 + (r & 3) + 8 * (r >> 2) + 4 * hs; ssq[m * 8 + wave] = tot; }
        __syncthreads();
        if (tid < 64) { float s = 0.f;
#pragma unroll
            for (int w8 = 0; w8 < 8; ++w8) s += ssq[tid * 8 + w8];
            rs[tid] = 1.0f / sqrtf(s * (1.f / 256.f) + EPSN); }
        __syncthreads();
#pragma unroll
        for (int mb = 0; mb < 2; ++mb)
#pragma unroll
            for (int r = 0; r < 16; ++r) { const int m = mb * 32 + (r & 3) + 8 * (r >> 2) + 4 * hs;
                MG[(tok0 + m) * DM + 768 + n] = (bf16)f2bf(val[mb * 16 + r] * rs[m] * gnn); }
        __syncthreads();
    }
    const int gw = vcu * NWAVES + wave, NGW = G * NWAVES;
    float g8[8];
#pragma unroll
    for (int j = 0; j < 8; ++j) g8[j] = ong[8 * lane + j];
    for (int row = gw; row < NTOK; row += NGW) {
        bf16* pp = MG + (size_t)row * DM + 8 * lane;
        const v4u w = *(const v4u*)pp; float f[8] = {bflo(w.x), bfhi(w.x), bflo(w.y), bfhi(w.y), bflo(w.z), bfhi(w.z), bflo(w.w), bfhi(w.w)};
        float s = 0.f;
#pragma unroll
        for (int j = 0; j < 8; ++j) s += f[j] * f[j];
        const float rstd = 1.0f / sqrtf(wave_sum(s) * (1.f / 512.f) + EPSN);
        v4u o; o.x = pk2(f[0] * rstd * g8[0], f[1] * rstd * g8[1]); o.y = pk2(f[2] * rstd * g8[2], f[3] * rstd * g8[3]);
        o.z = pk2(f[4] * rstd * g8[4], f[5] * rstd * g8[5]); o.w = pk2(f[6] * rstd * g8[6], f[7] * rstd * g8[7]); *(v4u*)pp = o;
    }
}

__device__ __forceinline__ void ins16(float (&top)[16], float x) {
#pragma unroll
    for (int i = 15; i >= 1; --i) top[i] = __builtin_amdgcn_fmed3f(top[i - 1], top[i], x);
    top[0] = fmaxf(top[0], x);
}
__device__ __forceinline__ float opq(float x) { asm("" : "+v"(x)); return x; }
__device__ __forceinline__ float tagf(float s, unsigned id, unsigned mask) { return __uint_as_float((__float_as_uint(s) & ~mask) | id); }
__device__ __forceinline__ void phase_select(const bf16* PQ, const bf16* KEYS, int* IDX, float* GATE, LAS unsigned char* lds, int G, int vcu, int tid, int lane, int wave) {
    constexpr int KROW = 272, KEYB = 2 * 128 * KROW;
    LAS unsigned* ids = (LAS unsigned*)(lds + KEYB + wave * 4096);
    const int tl = lane & 31, hs = lane >> 5;
    const float NEG = -__builtin_inff();
    const int nslot = (G >= 8) ? G / 8 : 1;
    for (int h = vcu % 8; h < 8; h += (G >= 8 ? 8 : G)) {
        __syncthreads();
        for (int idx = tid; idx < 2 * 128 * 16; idx += NTHR) { const int row = idx >> 4, cq = idx & 15;
            *(LAS v4u*)(lds + row * KROW + cq * 16) = *(const v4u*)((const char*)(KEYS + (size_t)h * 256 * 128) + (unsigned)(row * 256 + cq * 16)); }
        __syncthreads();
        const int slot = (G >= 8) ? vcu / 8 : 0;
        bf16x8 bq[2][8];
        int tb = slot * 8 + wave;
        if (tb < NTOK / 32) {
#pragma unroll
            for (int ks = 0; ks < 8; ++ks) bq[0][ks] = *(const bf16x8*)(PQ + ((size_t)tb * 32 + tl) * PQW + h * 256 + 8 * hs + ks * 16);
        }
#pragma unroll 1
        for (; tb < NTOK / 32; tb += 8 * nslot) {
            const size_t tok = (size_t)tb * 32 + tl;
            float t1[16], t2[16];
#pragma unroll
            for (int half = 0; half < 2; ++half) {
                { const int ntb = (half == 0) ? tb : tb + 8 * nslot; const int ntbc = (ntb < NTOK / 32) ? ntb : tb;
                  const bf16* qn = PQ + ((size_t)ntbc * 32 + tl) * PQW + h * 256 + (half == 0 ? 128 : 0) + 8 * hs;
#pragma unroll
                  for (int ks = 0; ks < 8; ++ks) bq[half ^ 1][ks] = *(const bf16x8*)(qn + ks * 16); }
                f32x16 acc[4]; acc[0] = f32x16{}; acc[1] = f32x16{}; acc[2] = f32x16{}; acc[3] = f32x16{};
                const LAS unsigned char* kp = lds + (half * 128 + tl) * KROW + 16 * hs;
#pragma unroll
                for (int ks = 0; ks < 8; ++ks)
#pragma unroll
                    for (int kb = 0; kb < 4; ++kb) { const bf16x8 ak = *(const LAS bf16x8*)(kp + kb * 32 * KROW + ks * 32); acc[kb] = __builtin_amdgcn_mfma_f32_32x32x16_bf16(ak, bq[half][ks], acc[kb], 0, 0, 0); }
                float top[16];
#pragma unroll
                for (int i = 0; i < 16; ++i) top[i] = NEG;
#pragma unroll
                for (int kb = 0; kb < 4; ++kb)
#pragma unroll
                    for (int r = 0; r < 16; ++r) ins16(top, tagf(acc[kb][r], (unsigned)(32 * kb + (r & 3) + 8 * (r >> 2) + 4 * hs), 127u));
                float oth[16];
#pragma unroll
                for (int i = 0; i < 16; ++i) oth[i] = __shfl_xor(top[i], 32);
#pragma unroll
                for (int i = 0; i < 16; ++i) ins16(top, oth[i]);
#pragma unroll
                for (int i = 0; i < 16; ++i) { if (half == 0) t1[i] = top[i]; else t2[i] = top[i]; }
            }
#pragma unroll
            for (int i = 0; i < 16; ++i) ids[(tl * 2 + hs) * 16 + i] = __float_as_uint(hs ? opq(t2[i]) : opq(t1[i])) & 127u;
            float best[16];
#pragma unroll
            for (int i = 0; i < 16; ++i) best[i] = NEG;
#define CAND(a0, b0, a1, b1) { const float s0_ = opq(t1[a0] + t2[b0]), s1_ = opq(t1[a1] + t2[b1]); ins16(best, hs ? tagf(s1_, (unsigned)((a1) * 16 + (b1)), 255u) : tagf(s0_, (unsigned)((a0) * 16 + (b0)), 255u)); }
            CAND_LIST
#undef CAND
            { float oth[16];
#pragma unroll
              for (int i = 0; i < 16; ++i) oth[i] = __shfl_xor(best[i], 32);
#pragma unroll
              for (int i = 0; i < 16; ++i) ins16(best, oth[i]); }
            float e[16], den = 0.f;
#pragma unroll
            for (int i = 0; i < 16; ++i) { e[i] = __expf(best[i] - best[0]); den += e[i]; }
            const float rden = 1.f / den;
            int ex[8]; float gt[8];
#pragma unroll
            for (int j = 0; j < 8; ++j) { const float bj = hs ? opq(best[8 + j]) : opq(best[j]); const unsigned id = __float_as_uint(bj) & 255u;
                const unsigned i1 = ids[(tl * 2 + 0) * 16 + (id >> 4)], i2 = ids[(tl * 2 + 1) * 16 + (id & 15u)];
                ex[j] = (int)(i1 * 128u + i2); gt[j] = (hs ? opq(e[8 + j]) : opq(e[j])) * rden; }
            int* ip = IDX + tok * 128 + h * 16 + hs * 8; float* gp = GATE + tok * 128 + h * 16 + hs * 8;
            *(v4u*)ip = (v4u){(unsigned)ex[0], (unsigned)ex[1], (unsigned)ex[2], (unsigned)ex[3]}; *(v4u*)(ip + 4) = (v4u){(unsigned)ex[4], (unsigned)ex[5], (unsigned)ex[6], (unsigned)ex[7]};
            *(f32x4*)gp = (f32x4){gt[0], gt[1], gt[2], gt[3]}; *(f32x4*)(gp + 4) = (f32x4){gt[4], gt[5], gt[6], gt[7]};
        }
    }
}

constexpr int GCH = 64;
constexpr int CW_Q = 8192;
template <int CTRL> __device__ __forceinline__ float dpp_mov(float v) { return __builtin_bit_cast(float, __builtin_amdgcn_update_dpp(0, __builtin_bit_cast(int, v), CTRL, 0xF, 0xF, true)); }
__device__ __forceinline__ float sum8(float s) {
    s += dpp_mov<0xB1>(s); s += dpp_mov<0x4E>(s); s += dpp_mov<0x141>(s); return s;
}
__device__ __forceinline__ void phase_gather_u(const unsigned char* XN8, const int* IDX, const unsigned char* U, float* PART, unsigned* queue, int lane, unsigned imask = 0xffffffffu) {
    const unsigned xcc = xb_xcc_id() & 7u; const int g = lane >> 3, j = lane & 7;
#pragma unroll 1
    for (unsigned sx = 0; sx < 8; ++sx) { const unsigned x = (xcc + sx) & 7u; unsigned* q = queue + x * 64;
        const unsigned char* Ux = U + (size_t)x * NEXP * 128; const unsigned jo = (unsigned)j * 16u, lane4 = (unsigned)lane * 4u; const unsigned char* Hx = XN8 + x * 128 + j * 16; const int* Ig = IDX + 16 * g;
#pragma unroll 1
        for (;;) {
            unsigned c = 0; if (lane == 0) c = __hip_atomic_fetch_add(q, 1u, __ATOMIC_RELAXED, __HIP_MEMORY_SCOPE_AGENT);
            c = (unsigned)__builtin_amdgcn_readfirstlane((int)c); if (c >= (unsigned)(NTOK / GCH)) break;
            const size_t tb = (size_t)c * GCH;
            v4u ix[2][4], hw[2], rw[16];
#define G1_IDX(ib, tok_) do { _Pragma("unroll") for (int q4 = 0; q4 < 4; ++q4) ix[ib][q4] = *(const v4u*)(Ig + (tok_) * 128 + 4 * q4) & imask; } while (0)
#define G1_AUX(ab, tok_) do { hw[ab] = *(const v4u*)(Hx + (tok_) * DM); } while (0)
#define G1_TOKEN(p, tt_) do { G1_AUX((p) ^ 1, tb + (((tt_) + 1 < GCH) ? (tt_) + 1 : (tt_))); \
            const v4u hq_ = hw[p]; int r0 = 0, r1 = 0; \
            _Pragma("unroll") for (int i = 0; i < 16; ++i) { const v4u rv_ = rw[i]; \
                rw[i] = *(const v4u*)(Ux + (ix[(p) ^ 1][i >> 2][i & 3] * 128u + jo)); \
                int s = __builtin_amdgcn_sdot4((int)hq_[0], (int)rv_[0], 0, false); s = __builtin_amdgcn_sdot4((int)hq_[1], (int)rv_[1], s, false); \
                s = __builtin_amdgcn_sdot4((int)hq_[2], (int)rv_[2], s, false); s = __builtin_amdgcn_sdot4((int)hq_[3], (int)rv_[3], s, false); \
                s += __builtin_amdgcn_update_dpp(0, s, 0xB1, 0xF, 0xF, true); s += __builtin_amdgcn_update_dpp(0, s, 0x4E, 0xF, 0xF, true); s += __builtin_amdgcn_update_dpp(0, s, 0x141, 0xF, 0xF, true); \
                if (i < 8) r0 = ((i & 7) == j) ? s : r0; else r1 = ((i & 7) == j) ? s : r1; } \
            unsigned* pp = (unsigned*)PART + ((size_t)x * NTOK + tb + (tt_)) * 64; *(unsigned*)((char*)pp + lane4) = pk2((float)r0, (float)r1);     \
            G1_IDX(p, tb + (((tt_) + 2 < GCH) ? (tt_) + 2 : (tt_))); } while (0)
            G1_IDX(0, tb); G1_IDX(1, tb + 1); G1_AUX(0, tb);
#pragma unroll
            for (int i = 0; i < 16; ++i) rw[i] = *(const v4u*)(Ux + (ix[0][i >> 2][i & 3] * 128u + jo));
#pragma unroll 1
            for (int tt = 0; tt < GCH; tt += 2) { G1_TOKEN(0, tt); G1_TOKEN(1, tt + 1); }
#undef G1_IDX
#undef G1_AUX
#undef G1_TOKEN
        }
    }
}
__device__ __forceinline__ void phase_gather_act(const float* PART, const float* GATE, const float* HSC, float* ACT, int G, int vcu, int tid) {
    const size_t gt = (size_t)vcu * NTHR + tid, NGT = (size_t)G * NTHR;
    for (size_t e4 = gt; e4 < (size_t)NTOK * 32; e4 += NGT) { const size_t tok = e4 >> 5; const int p = (int)(e4 & 31) * 4;
        f32x4 s = {0.f, 0.f, 0.f, 0.f};
#pragma unroll
        for (int x = 0; x < 8; ++x) { const v4u w = *(const v4u*)((const unsigned*)PART + ((size_t)x * NTOK + tok) * 64 + (p & 63));
            if (p < 64) { s[0] += bflo(w.x); s[1] += bflo(w.y); s[2] += bflo(w.z); s[3] += bflo(w.w); } else { s[0] += bfhi(w.x); s[1] += bfhi(w.y); s[2] += bfhi(w.z); s[3] += bfhi(w.w); } }
        const int k = (p < 64) ? 16 * (p >> 3) + (p & 7) : 16 * ((p - 64) >> 3) + 8 + (p & 7);
        const f32x4 gv = *(const f32x4*)(GATE + tok * 128 + k);
        f32x4 o;
        const float ds = HSC[tok] * (1.f / U8_SCALE);
#pragma unroll
        for (int i = 0; i < 4; ++i) { const _Float16 ah = (_Float16)(gv[i] * gelu_tanh(s[i] * ds) * (ACT_SCALE / V8_SCALE)); const h16x2 a2 = {ah, ah}; o[i] = __builtin_bit_cast(float, a2); }
        *(f32x4*)(ACT + e4 * 4) = o; }
}
__device__ __forceinline__ void phase_gather_v(const float* ACT, const int* IDX, const unsigned char* V, float* out, unsigned* queue, int lane) {
    const unsigned xcc = xb_xcc_id() & 7u; const int g = lane >> 3, j = lane & 7;
    typedef float f32x2v __attribute__((ext_vector_type(2)));
#pragma unroll 1
    for (unsigned sx = 0; sx < 8; ++sx) { const unsigned x = (xcc + sx) & 7u; unsigned* q = queue + x * 64;
        const unsigned char* Vx = V + (size_t)x * NEXP * 128; const unsigned jo = (unsigned)j * 16u; const int* Ig = IDX + 16 * g; float* Ob = out + x * 128; const unsigned lo = (unsigned)(16 * j + 2 * g) * 4u;
#pragma unroll 1
        for (;;) {
            unsigned c = 0; if (lane == 0) c = __hip_atomic_fetch_add(q, 1u, __ATOMIC_RELAXED, __HIP_MEMORY_SCOPE_AGENT);
            c = (unsigned)__builtin_amdgcn_readfirstlane((int)c); if (c >= (unsigned)(NTOK / GCH)) break;
            const size_t tb = (size_t)c * GCH;
            v4u ix[2][4], rw[16]; float a0[2], a1[2]; f32x2v ov[2]; const int bsel = (lane & ~7) * 4; const unsigned lane4 = (unsigned)lane * 4u;
#define G3_IDX(ib, tok_) do { _Pragma("unroll") for (int q4 = 0; q4 < 4; ++q4) ix[ib][q4] = *(const v4u*)(Ig + (tok_) * 128 + 4 * q4); } while (0)
#define G3_AUX(ab, tok_) do { a0[ab] = *(const float*)((const char*)(ACT + (tok_) * 128) + lane4); a1[ab] = *(const float*)((const char*)(ACT + (tok_) * 128 + 64) + lane4); { unsigned lo_ = lo; asm volatile("" : "+v"(lo_)); ov[ab] = *(const f32x2v*)((const char*)(Ob + (tok_) * DM) + lo_); } } while (0)
#define G3_TOKEN(p, tt_) do { G3_AUX((p) ^ 1, tb + (((tt_) + 1 < GCH) ? (tt_) + 1 : (tt_))); \
            h16x2 hacc[8]; \
            _Pragma("unroll") for (int i = 0; i < 8; ++i) hacc[i] = (h16x2){(_Float16)0.f, (_Float16)0.f}; \
            _Pragma("unroll") for (int i = 0; i < 16; ++i) { const v4u rv_ = rw[i]; \
                rw[i] = *(const v4u*)(Vx + (ix[(p) ^ 1][i >> 2][i & 3] * 128u + jo)); \
                const float a = __builtin_bit_cast(float, __builtin_amdgcn_ds_bpermute(bsel + 4 * (i & 7), __builtin_bit_cast(int, (i < 8) ? a0[p] : a1[p])));   \
                const h16x2 a2 = __builtin_bit_cast(h16x2, a); \
                _Pragma("unroll") for (int q4 = 0; q4 < 4; ++q4) { const int w = (int)rv_[q4]; \
                    hacc[2 * q4] = __builtin_elementwise_fma(cvt8h<false>(w), a2, hacc[2 * q4]); \
                    hacc[2 * q4 + 1] = __builtin_elementwise_fma(cvt8h<true>(w), a2, hacc[2 * q4 + 1]); } } \
            float acc[16]; \
            _Pragma("unroll") for (int i = 0; i < 8; ++i) { acc[2 * i] = (float)hacc[i].x; acc[2 * i + 1] = (float)hacc[i].y; } \
            int s_ = 32; \
            _Pragma("unroll") for (int cnt = 16; cnt > 2; cnt >>= 1) { const bool up = (lane & s_) != 0; \
                _Pragma("unroll") for (int i = 0; i < cnt / 2; ++i) { const float a = acc[i], b = acc[i + cnt / 2]; const float send = up ? a : b, keep = up ? b : a; acc[i] = keep + __shfl_xor(send, s_); } \
                s_ >>= 1; } \
            f32x2v o = ov[p]; o[0] += acc[0] * (1.f / ACT_SCALE); o[1] += acc[1] * (1.f / ACT_SCALE); \
            { unsigned lo_ = lo; asm volatile("" : "+v"(lo_)); *(f32x2v*)((char*)(Ob + (tb + (tt_)) * DM) + lo_) = o; } \
            G3_IDX(p, tb + (((tt_) + 2 < GCH) ? (tt_) + 2 : (tt_))); } while (0)
            G3_IDX(0, tb); G3_IDX(1, tb + 1); G3_AUX(0, tb);
#pragma unroll
            for (int i = 0; i < 16; ++i) rw[i] = *(const v4u*)(Vx + (ix[0][i >> 2][i & 3] * 128u + jo));
#pragma unroll 1
            for (int tt = 0; tt < GCH; tt += 2) { G3_TOKEN(0, tt); G3_TOKEN(1, tt + 1); }
#undef G3_IDX
#undef G3_AUX
#undef G3_TOKEN
        }
    }
}

__device__ __forceinline__ void phase_gather_naive(const bf16* XN, const int* IDX, const float* GATE, const float* U, const float* V, float* out, int G, int vcu, int lane, int wave) {
    const int gw = vcu * NWAVES + wave, NGW = G * NWAVES;
    for (int tok = gw; tok < NTOK; tok += NGW) {
        float hv[16], acc[16];
#pragma unroll
        for (int j = 0; j < 16; ++j) { hv[j] = bf2f(XN[(size_t)tok * DM + lane + 64 * j]); acc[j] = 0.f; }
        for (int k = 0; k < 128; ++k) { const int e = IDX[(size_t)tok * 128 + k]; const float g = GATE[(size_t)tok * 128 + k];
            float s = 0.f;
#pragma unroll
            for (int j = 0; j < 16; ++j) s += hv[j] * U[(size_t)e * DM + lane + 64 * j];
            s = wave_sum(s); const float a = g * gelu_tanh(s);
#pragma unroll
            for (int j = 0; j < 16; ++j) acc[j] += a * V[(size_t)e * DM + lane + 64 * j]; }
#pragma unroll
        for (int j = 0; j < 16; ++j) out[(size_t)tok * DM + lane + 64 * j] += acc[j];
    }
}
constexpr int PH_PER_LAYER = 15, N_PHASES = 1 + 2 * PH_PER_LAYER;
__device__ __forceinline__ KArgs kargs() { KArgs p = (KArgs)__builtin_amdgcn_kernarg_segment_ptr(); asm volatile("" : "+s"(p)); return p; }
__global__ void __launch_bounds__(NTHR, 2) mega_fwd(Args a_unused) {
    extern __shared__ __attribute__((aligned(16))) unsigned char lds_raw[];
    LAS unsigned char* lds = (LAS unsigned char*)lds_raw;
    volatile LAS unsigned* MISC = (volatile LAS unsigned*)(lds + MISC_OFF);
    const int tid0 = threadIdx.x;
    for (int u = tid0; u < (LDS_BYTES - LDSCTL_OFF) / 4; u += NTHR) ((LAS unsigned*)(lds + LDSCTL_OFF))[u] = 0u;
    __syncthreads();
    { const unsigned hw = (unsigned)__builtin_amdgcn_s_getreg((6 << 11) | 4); if ((tid0 & 63) == 0) *(volatile LAS int*)(lds + OTID_LDS_OFF + 4 * (hw & 63u)) = tid0 >> 6; }
    __syncthreads();
    XcdBarrier bar; { KArgs ka = kargs(); unsigned char* ws0 = ka->ws; bar.bar = (unsigned*)(ws0 + WS_CTL) + CW_BAR; bar.x = 0; bar.st = nullptr;
      if (ka->use_bar) bar = xcd_barrier_post((unsigned*)(ws0 + WS_CTL) + CW_BAR, MISC + 8); }
    const int ph_lo = kargs()->ph_lo, ph_hi = kargs()->ph_hi;
#define TLW const int tid = otid(), lane = tid & 63, wave = __builtin_amdgcn_readfirstlane(tid >> 6); (void)tid; (void)lane; (void)wave;
#pragma unroll 1
    for (int pc = ph_lo; pc < ph_hi + (DUP_PH >= 0 ? 1 : 0); ++pc) {
        const int ph = (DUP_PH >= 0 && pc > DUP_PH) ? pc - 1 : pc;
        unsigned long long tph0_ = 0; if (TIME_PH >= 0 && (pc == TIME_PH || TIME_PH == 99)) tph0_ = __builtin_amdgcn_s_memrealtime();
        KArgs a = kargs(); unsigned char* ws = a->ws;
        int G = gridDim.x, bx = blockIdx.x; asm volatile("" : "+s"(G), "+s"(bx)); const int vcu = (G % 8 == 0) ? (bx % 8) * (G / 8) + bx / 8 : bx;
        bf16* const XN = (bf16*)(ws + WS_XN); bf16* const Pq = (bf16*)(ws + WS_P); bf16* const Pk = Pq + (size_t)NTOK * 512; bf16* const Pv = Pk + (size_t)NTOK * 512; bf16* const Ps = Pv + (size_t)NTOK * 512;
        bf16* const MG = (bf16*)(ws + WS_MG); float* const CB = (float*)(ws + WS_CB); float* const XLOC = (float*)(ws + WS_XLOC); bf16* const Z = (bf16*)(ws + WS_Z);
        int* const IDX = (int*)(ws + WS_IDX); float* const GATE = (float*)(ws + WS_GATE);
        if (ph == 0) { TLW if (PH_MASK & 1u) phase_prep(a, lds, G, vcu, tid, lane, wave); }
        else {
            const int l = (ph - 1) / PH_PER_LAYER, sub = (ph - 1) % PH_PER_LAYER;
            const float* xin = (l == 0) ? a->in[0] : a->out;
            switch (sub) {
            case 0: if (PH_MASK & (1u << 1)) { TLW phase_rownorm<true>(xin, a->in[1] + l * DM, XN, (const float*)(ws + WS_WF) + l * 8 * 1024, a->in[3] + l * 8, CB, G, vcu, lane, wave); } break;
            case 1: if (PH_MASK & (1u << 2)) { TLW
                { float* CBm = CB; const int gw_ = vcu * NWAVES + wave; if (gw_ < NB * NH) phase_cumsum(CBm + (size_t)gw_ * SEQ, lane); }
                pg8::Gemm g{XN, (const bf16*)(ws + WS_WIN) + (size_t)l * 2048 * 1024, NTOK, 2048, 1024}; pg8::StaticOrder S; S.init(NTOK, 2048, G, bx);
                pg8::EpiQKVN E{Pq, (size_t)NTOK * 512, a->in[4] + l * 64, a->in[5] + l * 64, (PG8_LAS float*)(lds + EPIX_OFF), EPSN, 0.125f * LOG2E};
                pg8::gemm_phase<pg8::EpiQKVN, pg8::StaticOrder, true, true>(lds, g, S, E); } break;
            case 2: break;
            case 5: if (PH_MASK & (1u << 4)) { TLW { const float gq = wave_max(fabsf(a->in[4][l * 64 + lane])), gk = wave_max(fabsf(a->in[5][l * 64 + lane]));
                const float qkb = 8.f * gq * gk * LOG2E * 1.02f + 0.25f;
                const attn_body::AttnTensors AT{(const attn_body::bf16*)Pq, (const attn_body::bf16*)Pk, (const attn_body::bf16*)Pv, (attn_body::bf16*)MG, CB, qkb};
                attn_body::attn_phase_q<ATT_SKIP>((char*)lds_raw, AT, (unsigned*)(ws + WS_CTL) + CW_AQ + l * 512); } } break;
            case 3: if (PH_MASK & (1u << 5)) { TLW phase_pool(Ps, a->in[6] + (size_t)l * 4 * 64 * 64, a->in[7] + l * 256, a->in[18] + l * DM, MG, lds, G, bx, tid, lane, wave); } break;
            case 4: if (PH_MASK & (1u << 6)) { TLW phase_s5<false>(a, l, Ps, XLOC, Z, lds, G, bx, lane, wave); } break;
            case 6: if (PH_MASK & (1u << 7)) { TLW phase_s5<true>(a, l, Ps, XLOC, Z, lds, G, bx, lane, wave); } break;
            case 7: if (PH_MASK & (1u << 8)) { TLW phase_glu(Z, (const bf16*)(ws + WS_WGLU) + (size_t)l * 256 * 256, a->in[17] + l * 256, a->in[18] + l * DM, MG, lds, G, bx, vcu, tid, lane, wave); } break;
            case 8: if (PH_MASK & (1u << 9)) { pg8::Gemm g{MG, (const bf16*)(ws + WS_WOUT) + (size_t)l * 1024 * 1024, NTOK, 1024, 1024}; pg8::StaticOrder S; S.init(NTOK, 1024, G, bx);
                pg8::EpiResF32 E{xin, a->out, DM};
                pg8::gemm_phase<pg8::EpiResF32, pg8::StaticOrder, true, true>(lds, g, S, E); } break;
            case 9: if (PH_MASK & (1u << 10)) { TLW phase_rownorm<false>(a->out, a->in[20] + l * DM, XN, nullptr, nullptr, nullptr, G, vcu, lane, wave, ws + WS_XN8, (float*)(ws + WS_HSC)); } break;
            case 10: if (PH_MASK & (1u << 11)) { pg8::Gemm g{XN, (const bf16*)(ws + WS_WQ) + (size_t)l * 2048 * 1024, NTOK, 2048, 1024}; pg8::StaticOrder S; S.init(NTOK, 2048, G, bx);
                pg8::EpiBf16<0> E{Pq, PQW, nullptr, 0, 0, 1.f};
                pg8::gemm_phase<pg8::EpiBf16<0>, pg8::StaticOrder, true, true>(lds, g, S, E); } break;
            case 11: if (PH_MASK & (1u << 12)) { TLW phase_select(Pq, (const bf16*)(ws + WS_KEYS) + (size_t)l * 8 * 2 * 128 * 128, IDX, GATE, lds, G, vcu, tid, lane, wave); } break;
            case 12: if (PH_MASK & (1u << 13)) { TLW phase_gather_u(ws + WS_XN8, IDX, (const unsigned char*)(ws + WS_U) + (size_t)l * NEXP * DM, (float*)(ws + WS_P), (unsigned*)(ws + WS_CTL) + CW_Q + (l * 2 + 0) * 512 + ((DUP_PH >= 0 && pc == DUP_PH + 1) ? 4096 : 0), lane, (DUP_PH >= 0 && pc == DUP_PH) ? DIAG_IMASK : 0xffffffffu); } break;
            case 13: if (PH_MASK & (1u << 14)) { TLW phase_gather_act((const float*)(ws + WS_P), GATE, (const float*)(ws + WS_HSC), (float*)(ws + WS_Z), G, vcu, tid); } break;
            default: if (PH_MASK & (1u << 15)) { TLW phase_gather_v((const float*)(ws + WS_Z), IDX, (const unsigned char*)(ws + WS_V) + (size_t)l * NEXP * DM, a->out, (unsigned*)(ws + WS_CTL) + CW_Q + (l * 2 + 1) * 512, lane); } break;
            }
        }
        const int subb_ = (ph >= 1) ? (ph - 1) % PH_PER_LAYER : -1;
        if (pc + 1 < ph_hi + (DUP_PH >= 0 ? 1 : 0) && (MK_ONE_LAUNCH == 0 || (subb_ != 2 && subb_ != 3 && subb_ != 4))) { XcdBarrier b2 = bar; asm volatile("" : "+s"(b2.bar)); xcd_barrier(b2);
            if (TIME_PH >= 0 && (pc == TIME_PH || TIME_PH == 99)) { const unsigned long long t1_ = __builtin_amdgcn_s_memrealtime(), te_ = t1_ + TIME_MUL * (t1_ - tph0_); while (__builtin_amdgcn_s_memrealtime() < te_) __builtin_amdgcn_s_sleep(8); } }
    }
}

extern "C" void kernel_launch(void* const* d_in, const int* in_sizes, int n_in, void* d_out, int out_size, void* d_ws, size_t ws_size, hipStream_t stream) {
    static int grid = 0;
    if (grid == 0) {
        if (n_in != 25 || in_sizes[0] != NTOK * DM || out_size != NTOK * DM || ws_size < WS_END) {
            fprintf(stderr, "kernel_launch: unexpected problem: n_in %d in0 %d out %d ws %zu (need %zu); nothing launched\n", n_in, n_in > 0 ? in_sizes[0] : -1, out_size, ws_size, (size_t)WS_END); grid = -1; return; }
        int dev = 0, cus = 0;
        if (hipGetDevice(&dev) != hipSuccess || hipDeviceGetAttribute(&cus, hipDeviceAttributeMultiprocessorCount, dev) != hipSuccess) { fprintf(stderr, "kernel_launch: device query failed\n"); grid = -1; return; }
        if (hipFuncSetAttribute((const void*)mega_fwd, hipFuncAttributeMaxDynamicSharedMemorySize, LDS_BYTES) != hipSuccess) { fprintf(stderr, "kernel_launch: hipFuncSetAttribute failed\n"); grid = -1; return; }
        (void)hipGetLastError();
        grid = cus;
    }
    if (grid < 0) return;
    (void)hipMemsetAsync((char*)d_ws + WS_CTL, 0, CTL_ZERO_BYTES, stream);
    Args a{};
    for (int i = 0; i < 25; ++i) a.in[i] = (const float*)d_in[i];
    a.out = (float*)d_out; a.ws = (unsigned char*)d_ws;
#if MK_ONE_LAUNCH
    a.ph_lo = 0; a.ph_hi = N_PHASES; a.use_bar = 1;
    hipLaunchKernelGGL(mega_fwd, dim3(grid), dim3(NTHR), LDS_BYTES, stream, a);
#else
    for (int ph = 0; ph < N_PHASES; ++ph) { a.ph_lo = ph; a.ph_hi = ph + 1; a.use_bar = 0;
        hipLaunchKernelGGL(mega_fwd, dim3(grid), dim3(NTHR), LDS_BYTES, stream, a); }
#endif
    const hipError_t le = hipPeekAtLastError();
    if (le != hipSuccess) fprintf(stderr, "kernel_launch: launch failed: %s\n", hipGetErrorName(le));
}
```

```cpp
#include <hip/hip_runtime.h>
#include <hip/hip_bf16.h>
#include <hip/hip_fp16.h>
#include <cstdio>
#include <cstdint>
#include <cmath>
#ifndef MK_ONE_LAUNCH
#define MK_ONE_LAUNCH 1
#endif
#ifndef ATT_SKIP
#define ATT_SKIP true
#endif
#ifndef PH_MASK
#define PH_MASK 0xffffffffu
#endif
#define OTID_LDS_OFF (131072 + 1024)
__device__ __forceinline__ int otid() {
    int z = 0; asm volatile("" : "+v"(z)); const int lane = __builtin_amdgcn_mbcnt_hi(-1, __builtin_amdgcn_mbcnt_lo(-1, z));
    const unsigned hw = (unsigned)__builtin_amdgcn_s_getreg((6 << 11) | 4);
    const int wv = *(const volatile __attribute__((address_space(3))) int*)(OTID_LDS_OFF + 4 * (hw & 63u));
    return (__builtin_amdgcn_readfirstlane(wv) << 6) | lane;
}
#ifndef GATHER_NAIVE
#define GATHER_NAIVE 0
#endif
#ifndef DUP_PH
#define DUP_PH (-1)
#endif
#ifndef TIME_PH
#define TIME_PH (-1)
#define TIME_MUL 3
#endif
#ifndef DIAG_IMASK
#define DIAG_IMASK 0xffu
#endif
#ifndef S5_CPROJ_F32
#define S5_CPROJ_F32 1
#endif
namespace pg8 {
#define PG8_LAS __attribute__((address_space(3)))
typedef unsigned short bf16_t;
typedef short bf16x8 __attribute__((ext_vector_type(8)));
typedef float f32x4 __attribute__((ext_vector_type(4)));
typedef unsigned u32x4 __attribute__((ext_vector_type(4)));
constexpr int BM = 256, BK = 64, HALF = 128, HTB = HALF * BK * 2  , STAGE_BYTES = 8 * HTB, NXCD = 8, WGM = 8;

__host__ __device__ __forceinline__ int lds_byte(int r, int c) { const int st = (r >> 4) * 2 + (c >> 5), rr = r & 15, cc = c & 31, ob = rr * 64 + cc * 2; return st * 1024 + (ob ^ (((ob >> 9) & 1) << 5)); }
__host__ __device__ __forceinline__ void stage_rc(int b, int& R, int& C) { const int st = b / 1024, sb = b % 1024, swz = sb ^ (((sb >> 9) & 1) << 5); R = (st >> 1) * 16 + swz / 64; C = (st & 1) * 32 + (swz % 64) / 2; }
__host__ __device__ __forceinline__ int perm32(int rho) { const int n = rho >> 4, i = rho & 15; return 8 * (i >> 2) + 4 * n + (i & 3); }

struct Unit { int pm, pn; };
struct Gemm { const bf16_t* A; const bf16_t* Bt; int M, N, K; };

struct StaticOrder {
    int nM, nN, nwg, G, c;
    __host__ __device__ void init(int M, int N, int G_, int c_) { nM = M / BM; nN = N / BM; nwg = nM * nN; G = G_; c = c_; }
    __host__ __device__ bool next(int i, Unit& u) const {
        const long L = (long)i * G + c; if (L >= nwg) return false;
        int wgid = (int)L; { const int q = nwg / NXCD, r = nwg % NXCD, xcd = wgid % NXCD, off = wgid / NXCD; wgid = (xcd < r ? xcd * (q + 1) : r * (q + 1) + (xcd - r) * q) + off; }
        const int nig = WGM * nN, gid = wgid / nig, fm = gid * WGM, gsz = (nM - fm) < WGM ? (nM - fm) : WGM;
        u.pm = fm + ((wgid % nig) % gsz); u.pn = (wgid % nig) / gsz; return true;
    }
    __device__ __forceinline__ void a_ready(const Unit&) const {}
    __device__ __forceinline__ void done(const Unit&) const {}
};

__device__ __forceinline__ unsigned cvt_pk_bf16(float lo, float hi) { unsigned r; asm volatile("v_cvt_pk_bf16_f32 %0, %1, %2" : "=v"(r) : "v"(lo), "v"(hi)); return r; }
typedef float f32x2 __attribute__((ext_vector_type(2)));
__device__ __forceinline__ f32x2 gelu_pk(f32x2 v) {
    const f32x2 av = __builtin_elementwise_abs(v), d = av * 0.2316418882f + 1.0f;
    f32x2 t; t.x = __builtin_amdgcn_rcpf(d.x); t.y = __builtin_amdgcn_rcpf(d.y);
    f32x2 q = t * 0.5307027145f + (-0.7265760135f); q = q * t + 0.7107068705f; q = q * t + (-0.142248368f); q = q * t + 0.127414796f; q = q * t;
    const f32x2 s = (v * v) * (-0.72134752044f);
    f32x2 e; e.x = __builtin_amdgcn_exp2f(s.x); e.y = __builtin_amdgcn_exp2f(s.y);
    const f32x2 m = v * (q * e), r = v - m;
    f32x2 o; o.x = v.x < 0.f ? m.x : r.x; o.y = v.y < 0.f ? m.y : r.y; return o;
}

template <int ACT  > struct EpiBf16 {
    static constexpr bool PERM = true, AFTER_DRAIN = false; static_assert(ACT == 0 || ACT == 1, "EpiBf16: ACT is 0 (none) or 1 (gelu_pk)");
    bf16_t* O; int ldc; const float* bias; int split_cols; size_t split_stride; float scale0;
    __device__ __forceinline__ void operator()(const f32x4 (&acc)[2][2][4][2], const Unit& u, int wr, int wc, int fr, int fq) const {
        const int row0 = u.pm * BM + wr * 64 + fr; int colt = u.pn * BM; bf16_t* base = O;
        float sc = 1.f; if (split_cols) { const int t = colt / split_cols; base += (size_t)t * split_stride; colt -= t * split_cols; if (t == 0) sc = scale0; }
        const int col0 = colt + wc * 32 + 8 * fq, bcol0 = u.pn * BM + wc * 32 + 8 * fq;
        f32x4 bv[2][2];
#pragma unroll
        for (int bj = 0; bj < 2; ++bj)
#pragma unroll
            for (int n = 0; n < 2; ++n) bv[bj][n] = bias ? *(const f32x4*)(bias + bcol0 + bj * HALF + 4 * n) : (f32x4){0.f, 0.f, 0.f, 0.f};
#pragma unroll
        for (int ai = 0; ai < 2; ++ai)
#pragma unroll
            for (int m = 0; m < 4; ++m) { bf16_t* rowp = base + (size_t)(row0 + ai * HALF + m * 16) * ldc + col0;
#pragma unroll
                for (int bj = 0; bj < 2; ++bj) { f32x4 v0 = acc[ai][bj][m][0] + bv[bj][0], v1 = acc[ai][bj][m][1] + bv[bj][1];
                    if (ACT == 1) { f32x2 a = gelu_pk((f32x2){v0[0], v0[1]}), b = gelu_pk((f32x2){v0[2], v0[3]}), c = gelu_pk((f32x2){v1[0], v1[1]}), d = gelu_pk((f32x2){v1[2], v1[3]});
                        v0 = (f32x4){a.x, a.y, b.x, b.y}; v1 = (f32x4){c.x, c.y, d.x, d.y}; }
                    v0 = v0 * sc; v1 = v1 * sc; u32x4 w; w.x = cvt_pk_bf16(v0[0], v0[1]); w.y = cvt_pk_bf16(v0[2], v0[3]); w.z = cvt_pk_bf16(v1[0], v1[1]); w.w = cvt_pk_bf16(v1[2], v1[3]);
                    *(u32x4*)(rowp + bj * HALF) = w; } }
    }
};
struct EpiResF32 {
    static constexpr bool PERM = false, AFTER_DRAIN = false;
    const float* base; float* out; int ldc;
    __device__ __forceinline__ void operator()(const f32x4 (&acc)[2][2][4][2], const Unit& u, int wr, int wc, int fr, int fq) const {
        const int col0 = u.pn * BM + wc * 32 + 4 * fq;
#pragma unroll
        for (int ai = 0; ai < 2; ++ai)
#pragma unroll
            for (int m = 0; m < 4; ++m) { const size_t off = (size_t)(u.pm * BM + ai * HALF + wr * 64 + m * 16 + fr) * ldc + col0;
#pragma unroll
                for (int bj = 0; bj < 2; ++bj)
#pragma unroll
                    for (int n = 0; n < 2; ++n) { const f32x4 bs = *(const f32x4*)(base + off + bj * HALF + n * 16); *(f32x4*)(out + off + bj * HALF + n * 16) = bs + acc[ai][bj][m][n]; } }
    }
};

struct EpiQKVN {
    static constexpr bool PERM = true, AFTER_DRAIN = false;
    bf16_t* O; size_t split_stride; const float* qg; const float* kg; PG8_LAS float* ex; float eps, qscale;
    __device__ __forceinline__ void operator()(const f32x4 (&acc)[2][2][4][2], const Unit& u, int wr, int wc, int fr, int fq) const {
        const int t = u.pn >> 1, row0 = u.pm * BM + wr * 64 + fr, col0 = (u.pn & 1) * BM + wc * 32 + 8 * fq; bf16_t* base = O + (size_t)t * split_stride;
        float rs[2][4][2];
        f32x4 g0 = {1.f, 1.f, 1.f, 1.f}, g1 = {1.f, 1.f, 1.f, 1.f};
        if (t < 2) {
            int wid = wr * 4 + wc, fro = fr; asm volatile("" : "+v"(fro), "+s"(wid));
#pragma unroll
            for (int ai = 0; ai < 2; ++ai)
#pragma unroll
                for (int m = 0; m < 4; ++m)
#pragma unroll
                    for (int bj = 0; bj < 2; ++bj) { const f32x4 a0 = acc[ai][bj][m][0], a1 = acc[ai][bj][m][1];
                        float s = (a0[0] * a0[0] + a0[1] * a0[1]) + (a0[2] * a0[2] + a0[3] * a0[3]) + (a1[0] * a1[0] + a1[1] * a1[1]) + (a1[2] * a1[2] + a1[3] * a1[3]);
                        s += __shfl_xor(s, 16); s += __shfl_xor(s, 32);
                        if (fq == 0) ex[(((wid * 2 + ai) * 4 + m) * 2 + bj) * 16 + fro] = s; }
            asm volatile("s_waitcnt lgkmcnt(0)\n\ts_barrier" ::: "memory");
            const float* gp = (t == 0 ? qg : kg) + 32 * (wc & 1) + 8 * fq; const float gs = (t == 0) ? qscale : 1.f;
            g0 = *(const f32x4*)gp * gs; g1 = *(const f32x4*)(gp + 4) * gs;
#pragma unroll
            for (int ai = 0; ai < 2; ++ai)
#pragma unroll
                for (int m = 0; m < 4; ++m)
#pragma unroll
                    for (int bj = 0; bj < 2; ++bj) { const float so = ex[(((wid * 2 + ai) * 4 + m) * 2 + bj) * 16 + fro], sp = ex[((((wid ^ 1) * 2 + ai) * 4 + m) * 2 + bj) * 16 + fro]; rs[ai][m][bj] = 1.0f / sqrtf((so + sp) * (1.f / 64.f) + eps); }
        }
#pragma unroll
        for (int ai = 0; ai < 2; ++ai)
#pragma unroll
            for (int m = 0; m < 4; ++m) { bf16_t* rowp = base + (size_t)(row0 + ai * HALF + m * 16) * 512 + col0;
#pragma unroll
                for (int bj = 0; bj < 2; ++bj) { f32x4 v0 = acc[ai][bj][m][0], v1 = acc[ai][bj][m][1];
                    if (t < 2) { const float r = rs[ai][m][bj]; v0 = v0 * r * g0; v1 = v1 * r * g1; }
                    u32x4 w; w.x = cvt_pk_bf16(v0[0], v0[1]); w.y = cvt_pk_bf16(v0[2], v0[3]); w.z = cvt_pk_bf16(v1[0], v1[1]); w.w = cvt_pk_bf16(v1[2], v1[3]);
                    *(u32x4*)(rowp + bj * HALF) = w; } }
    }
};
template <class Epi, class Sched, bool ALIGN_EPI = false, bool SP2 = false>
__device__ __forceinline__ void gemm_phase(PG8_LAS unsigned char* lds, const Gemm g, const Sched& S, const Epi& E) {
    const int tid = otid(), wid = __builtin_amdgcn_readfirstlane(tid >> 6), lane = tid & 63, wr = wid >> 2, wc = wid & 3, fr = lane & 15, fq = lane >> 4;
    const int K = g.K, nt = K / BK;
    unsigned voffA[2], voffB[2];
#pragma unroll
    for (int i = 0; i < 2; ++i) { int R, C; stage_rc(tid * 16 + i * 8192, R, C); const int Rb = Epi::PERM ? ((R & ~31) + perm32(R & 31)) : R;
        voffA[i] = (unsigned)(R * K + C) * 2u; voffB[i] = (unsigned)(Rb * K + C) * 2u; }
    const size_t kstep = (size_t)(BK * 2);
    const size_t hstep = (size_t)HALF * K * 2;
    const size_t tstep = 2 * hstep;
    const unsigned ldsw = (unsigned)wid * 1024u;
    const int aoff = lds_byte(wr * 64 + fr, fq * 8), boff = lds_byte(wc * 32 + fr, fq * 8);
#define PG8_SA(b, h) (((b) * 2 + (h)) * HTB)
#define PG8_SB(b, h) ((4 + (b) * 2 + (h)) * HTB)
#define PG8_STAGE(bufoff, gbase, voff) do { _Pragma("unroll") for (int _i = 0; _i < 2; ++_i) \
        __builtin_amdgcn_global_load_lds((const unsigned*)((const char*)(gbase) + (voff)[_i]), (PG8_LAS unsigned*)(lds + (bufoff) + ldsw + _i * 8192), 16, 0, 0); } while (0)
#define PG8_LDA(dst, b, h) do { _Pragma("unroll") for (int m = 0; m < 4; ++m) _Pragma("unroll") for (int k = 0; k < 2; ++k) dst[m][k] = *(const PG8_LAS bf16x8*)(lds + PG8_SA(b, h) + aoff + m * 2048 + k * 1024); } while (0)
#define PG8_LDB(dst, b, h) do { _Pragma("unroll") for (int n = 0; n < 2; ++n) _Pragma("unroll") for (int k = 0; k < 2; ++k) dst[n][k] = *(const PG8_LAS bf16x8*)(lds + PG8_SB(b, h) + boff + n * 2048 + k * 1024); } while (0)
#define PG8_MMA(ai, bj, At, Bt) do { __builtin_amdgcn_s_setprio(1); _Pragma("unroll") for (int m = 0; m < 4; ++m) _Pragma("unroll") for (int n = 0; n < 2; ++n) _Pragma("unroll") for (int k = 0; k < 2; ++k) \
        acc[ai][bj][m][n] = __builtin_amdgcn_mfma_f32_16x16x32_bf16(Bt[n][k], At[m][k], acc[ai][bj][m][n], 0, 0, 0); __builtin_amdgcn_s_setprio(0); } while (0)
#define PG8_WAIT_V(n) asm volatile("s_waitcnt vmcnt(" #n ")" ::: "memory")
#define PG8_WAIT_L(n) asm volatile("s_waitcnt lgkmcnt(" #n ")" ::: "memory")
#define PG8_BAR __builtin_amdgcn_s_barrier()
#define PG8_SCHED __builtin_amdgcn_sched_barrier(0)
    Unit cur, nxt; int ui = 0;
    if (!S.next(0, cur)) return;
    f32x4 acc[2][2][4][2];
#pragma unroll
    for (int a = 0; a < 2; ++a)
#pragma unroll
        for (int b = 0; b < 2; ++b)
#pragma unroll
            for (int m = 0; m < 4; ++m)
#pragma unroll
                for (int n = 0; n < 2; ++n) acc[a][b][m][n] = (f32x4){0.f, 0.f, 0.f, 0.f};
    bf16x8 At[4][2], B0[2][2], B1[2][2];
    const char* cA = (const char*)g.A + (size_t)cur.pm * tstep; const char* cB = (const char*)g.Bt + (size_t)cur.pn * tstep;
    S.a_ready(cur);
    if constexpr (SP2) {
        PG8_STAGE(PG8_SB(0, 0), cB, voffB); PG8_STAGE(PG8_SB(0, 1), cB + hstep, voffB); PG8_STAGE(PG8_SA(0, 0), cA, voffA); PG8_STAGE(PG8_SA(0, 1), cA + hstep, voffA);
        if (wr == 1) PG8_BAR;
        PG8_WAIT_V(2); PG8_BAR;
        PG8_STAGE(PG8_SB(1, 0), cB + kstep, voffB); PG8_STAGE(PG8_SA(1, 0), cA + kstep, voffA); PG8_STAGE(PG8_SB(1, 1), cB + hstep + kstep, voffB);
        PG8_WAIT_V(6); PG8_BAR;
    } else {
        PG8_STAGE(PG8_SB(0, 0), cB, voffB); PG8_STAGE(PG8_SA(0, 0), cA, voffA); PG8_STAGE(PG8_SB(0, 1), cB + hstep, voffB); PG8_STAGE(PG8_SA(0, 1), cA + hstep, voffA);
        if (wr == 1) PG8_BAR;
        PG8_WAIT_V(4); PG8_BAR;
        PG8_STAGE(PG8_SB(1, 0), cB + kstep, voffB); PG8_STAGE(PG8_SA(1, 0), cA + kstep, voffA); PG8_STAGE(PG8_SB(1, 1), cB + hstep + kstep, voffB);
        PG8_WAIT_V(6); PG8_BAR;
    }
    for (;;) {
        const bool has_next = S.next(ui + 1, nxt);
        const char* nA = has_next ? (const char*)g.A + (size_t)nxt.pm * tstep : cA; const char* nB = has_next ? (const char*)g.Bt + (size_t)nxt.pn * tstep : cB;
        for (int t = 0; t < nt; t += 2) {
            const bool last = (t == nt - 2);
            const char* a1 = cA + (size_t)(t + 1) * kstep;
            const char* a2 = last ? nA : cA + (size_t)(t + 2) * kstep; const char* b2 = last ? nB : cB + (size_t)(t + 2) * kstep;
            const char* a3 = a2 + kstep; const char* b3 = b2 + kstep;
            if (last && has_next) S.a_ready(nxt);
            if constexpr (SP2) {
            PG8_LDB(B0, 0, 0); PG8_LDB(B1, 0, 1); PG8_SCHED; PG8_LDA(At, 0, 0); PG8_STAGE(PG8_SA(1, 1), a1 + hstep, voffA);
            PG8_WAIT_V(8); PG8_WAIT_L(0); PG8_BAR; PG8_MMA(0, 0, At, B0); PG8_MMA(0, 1, At, B1); PG8_BAR; PG8_SCHED;
            PG8_LDA(At, 0, 1); PG8_STAGE(PG8_SB(0, 0), b2, voffB); PG8_STAGE(PG8_SB(0, 1), b2 + hstep, voffB); PG8_STAGE(PG8_SA(0, 0), a2, voffA);
            PG8_WAIT_V(8); PG8_WAIT_L(0); PG8_BAR; PG8_MMA(1, 0, At, B0); PG8_MMA(1, 1, At, B1); PG8_BAR; PG8_SCHED;
            PG8_LDB(B0, 1, 0); PG8_LDB(B1, 1, 1); PG8_SCHED; PG8_LDA(At, 1, 0); PG8_STAGE(PG8_SA(0, 1), a2 + hstep, voffA);
            PG8_WAIT_V(8); PG8_WAIT_L(0); PG8_BAR; PG8_MMA(0, 0, At, B0); PG8_MMA(0, 1, At, B1); PG8_BAR; PG8_SCHED;
            PG8_LDA(At, 1, 1); PG8_STAGE(PG8_SB(1, 0), b3, voffB); PG8_STAGE(PG8_SB(1, 1), b3 + hstep, voffB); PG8_STAGE(PG8_SA(1, 0), a3, voffA);
            PG8_WAIT_V(8); PG8_WAIT_L(0); PG8_BAR; PG8_MMA(1, 0, At, B0); PG8_MMA(1, 1, At, B1); PG8_BAR; PG8_SCHED;
            } else {
            PG8_LDB(B0, 0, 0); PG8_SCHED; PG8_LDA(At, 0, 0); PG8_STAGE(PG8_SA(1, 1), a1 + hstep, voffA);
            PG8_WAIT_L(8); PG8_BAR; PG8_WAIT_L(0); PG8_MMA(0, 0, At, B0); PG8_BAR; PG8_SCHED;
            PG8_LDB(B1, 0, 1); PG8_STAGE(PG8_SB(0, 0), b2, voffB);
            PG8_BAR; PG8_WAIT_L(0); PG8_MMA(0, 1, At, B1); PG8_BAR;
            PG8_LDA(At, 0, 1); PG8_STAGE(PG8_SA(0, 0), a2, voffA);
            PG8_BAR; PG8_WAIT_L(0); PG8_MMA(1, 0, At, B0); PG8_BAR; PG8_SCHED;
            PG8_STAGE(PG8_SB(0, 1), b2 + hstep, voffB);
            PG8_WAIT_V(6); PG8_BAR; PG8_MMA(1, 1, At, B1); PG8_BAR;
            PG8_LDB(B0, 1, 0); PG8_SCHED; PG8_LDA(At, 1, 0); PG8_STAGE(PG8_SA(0, 1), a2 + hstep, voffA);
            PG8_WAIT_L(8); PG8_BAR; PG8_WAIT_L(0); PG8_MMA(0, 0, At, B0); PG8_BAR; PG8_SCHED;
            PG8_LDB(B1, 1, 1); PG8_STAGE(PG8_SB(1, 0), b3, voffB);
            PG8_BAR; PG8_WAIT_L(0); PG8_MMA(0, 1, At, B1); PG8_BAR;
            PG8_LDA(At, 1, 1); PG8_STAGE(PG8_SA(1, 0), a3, voffA);
            PG8_BAR; PG8_WAIT_L(0); PG8_MMA(1, 0, At, B0); PG8_BAR; PG8_SCHED;
            PG8_STAGE(PG8_SB(1, 1), b3 + hstep, voffB);
            PG8_WAIT_V(6); PG8_BAR; PG8_MMA(1, 1, At, B1); PG8_BAR;
            }
        }
        if constexpr (ALIGN_EPI) { if (wr == 0) PG8_BAR; }
        if constexpr (!Epi::AFTER_DRAIN) { E(acc, cur, wr, wc, fr, fq); S.done(cur); }
        if (!has_next) break;
#pragma unroll
        for (int a = 0; a < 2; ++a)
#pragma unroll
            for (int b = 0; b < 2; ++b)
#pragma unroll
                for (int m = 0; m < 4; ++m)
#pragma unroll
                    for (int n = 0; n < 2; ++n) acc[a][b][m][n] = (f32x4){0.f, 0.f, 0.f, 0.f};
        cur = nxt; cA = nA; cB = nB; ++ui;
        if constexpr (ALIGN_EPI) { if (wr == 1) PG8_BAR; }
    }
    PG8_WAIT_V(0);
    if constexpr (!ALIGN_EPI) { if (wr == 0) PG8_BAR; }
    PG8_BAR;
    if constexpr (Epi::AFTER_DRAIN) { E.fused(acc, cur, wr, wc, fr, fq, lds, wid, lane); S.done(cur); }
#undef PG8_SA
#undef PG8_SB
#undef PG8_STAGE
#undef PG8_LDA
#undef PG8_LDB
#undef PG8_MMA
#undef PG8_WAIT_V
#undef PG8_WAIT_L
#undef PG8_BAR
#undef PG8_SCHED
}
}
#include <hip/hip_bf16.h>
#include <cmath>
namespace attn_body {
using bf16=__hip_bfloat16;
using bf16x8=__attribute__((ext_vector_type(8)))short;
using s16x4=__attribute__((ext_vector_type(4)))short;
using f32x16=__attribute__((ext_vector_type(16)))float;
using u32x4=__attribute__((ext_vector_type(4)))unsigned;
using f32x4v=__attribute__((ext_vector_type(4)))float;
constexpr int BATCH=8,NHEAD=8,SEQ=4096,D=64,DM=NHEAD*D,OPITCH=1024;
constexpr int NW=8,QBLK=32,QB=QBLK*NW,KVBLK=64,NQB=SEQ/QB;
constexpr int ATTN_PITCH=DM, ATTN_UNIT_ROWS=QB;
__device__ __forceinline__ int crow(int r,int hi){return (r&3)+8*(r>>2)+4*hi;}
#define SBAR() __builtin_amdgcn_sched_barrier(0)
__device__ __forceinline__ void cmask(f32x16&p0,f32x16&p1,int jb,int qrel,int hi){
  const float NEG=-INFINITY; int kb=64*jb+4*hi;
  #pragma unroll
  for(int r=0;r<16;++r){int kv=kb+(r&3)+8*(r>>2); if(kv>qrel)p0[r]=NEG; if(kv+32>qrel)p1[r]=NEG;}
}

constexpr int NSLOT=3, SLOTB=8192;
constexpr int LDS_K=0, LDS_V=NSLOT*SLOTB, LDS_WS=2*NSLOT*SLOTB, LDS_OST=LDS_WS+NW*64*4, LDS_BYTES=LDS_OST+NW*4096, LDS_BIAS=LDS_BYTES, LDS_TOTAL=LDS_BIAS+SEQ*4;
constexpr float C2=0.125f*1.4426950408889634f;
__device__ __forceinline__ void glds16(const void*sbase,unsigned voff,unsigned lds_dst){unsigned keep;
  asm volatile("s_mov_b32 %0, m0\n\ts_mov_b32 m0, %3\n\ts_nop 0\n\tglobal_load_lds_dwordx4 %1, %2\n\ts_mov_b32 m0, %0":"=&s"(keep):"v"(voff),"s"(sbase),"s"(lds_dst):"memory");}
__device__ __forceinline__ float max3f(float a,float b,float c){float r;asm("v_max3_f32 %0, %1, %2, %3":"=v"(r):"v"(a),"v"(b),"v"(c));return r;}
__device__ __forceinline__ float max2f(float a,float b){float r;asm("v_max_f32_e32 %0, %1, %2":"=v"(r):"v"(a),"v"(b));return r;}
__device__ __forceinline__ float fadd_s(float a,float b){float r;asm("v_add_f32_e32 %0, %1, %2":"=v"(r):"v"(a),"v"(b));return r;}
__device__ __forceinline__ float fsub_s(float a,float b){float r;asm("v_sub_f32_e32 %0, %1, %2":"=v"(r):"v"(a),"v"(b));return r;}
typedef float f32x2_t __attribute__((ext_vector_type(2))); typedef __bf16 bf16x2_t __attribute__((ext_vector_type(2)));
__device__ __forceinline__ unsigned cvtpk_s(float lo,float hi){f32x2_t v={lo,hi};bf16x2_t b=__builtin_convertvector(v,bf16x2_t);return __builtin_bit_cast(unsigned,b);}
#define WAIT_BAR(N) asm volatile("s_waitcnt vmcnt(" #N ") lgkmcnt(0)\n\ts_barrier":::"memory")

__device__ __forceinline__ void qkt(f32x16&p0,f32x16&p1,const __attribute__((address_space(3))) char*kb,const bf16x8*qr){
  #pragma unroll
  for(int d0=0;d0<4;++d0){
    const bf16x8 b0=*(const __attribute__((address_space(3))) bf16x8*)(kb+d0*2048);
    const bf16x8 b1=*(const __attribute__((address_space(3))) bf16x8*)(kb+d0*2048+512);
    p0=__builtin_amdgcn_mfma_f32_32x32x16_bf16(b0,qr[d0],p0,0,0,0);p1=__builtin_amdgcn_mfma_f32_32x32x16_bf16(b1,qr[d0],p1,0,0,0);}
}
typedef __attribute__((address_space(3))) const char* lds_cptr;
typedef short v4i16_t __attribute__((ext_vector_type(4)));
__device__ __forceinline__ void kload8(bf16x8*kf,lds_cptr kp){
  kf[0]=*(const __attribute__((address_space(3))) bf16x8*)(kp);      kf[1]=*(const __attribute__((address_space(3))) bf16x8*)(kp+512);
  kf[2]=*(const __attribute__((address_space(3))) bf16x8*)(kp+2048); kf[3]=*(const __attribute__((address_space(3))) bf16x8*)(kp+2560);
  kf[4]=*(const __attribute__((address_space(3))) bf16x8*)(kp+4096); kf[5]=*(const __attribute__((address_space(3))) bf16x8*)(kp+4608);
  kf[6]=*(const __attribute__((address_space(3))) bf16x8*)(kp+6144); kf[7]=*(const __attribute__((address_space(3))) bf16x8*)(kp+6656);
}
__device__ __forceinline__ void kload2(bf16x8*kf,lds_cptr kp,int j){ kf[2*j]=*(const __attribute__((address_space(3))) bf16x8*)(kp+j*2048); kf[2*j+1]=*(const __attribute__((address_space(3))) bf16x8*)(kp+j*2048+512); }
__device__ __forceinline__ s16x4 vtr(lds_cptr p){ return __builtin_bit_cast(s16x4,__builtin_amdgcn_ds_read_tr16_b64_v4i16((__attribute__((address_space(3))) v4i16_t*)p)); }
__device__ __forceinline__ float rowmax(const f32x16&p0,const f32x16&p1){
  float a=max3f(p0[0],p0[1],p1[0]),b=max3f(p0[2],p0[3],p1[1]);a=max3f(a,p1[2],p1[3]);
  #pragma unroll
  for(int r=4;r<16;r+=4){a=max3f(a,p0[r],p0[r+1]);b=max3f(b,p0[r+2],p0[r+3]);a=max3f(a,p1[r],p1[r+1]);b=max3f(b,p1[r+2],p1[r+3]);}
  const float m=max2f(a,b);
  auto rr=__builtin_amdgcn_permlane32_swap(__float_as_uint(m),__float_as_uint(m),false,false);
  return max2f(__uint_as_float(rr[0]),__uint_as_float(rr[1]));
}
__device__ __forceinline__ void pv(f32x16*o,int vb,bf16x8 pa0,bf16x8 pa1,bf16x8 pa2,bf16x8 pa3){
  #pragma unroll
  for(int d0=0;d0<2;++d0){s16x4 lo[4],hi[4];
    #pragma unroll
    for(int ks=0;ks<4;++ks){
      asm volatile("ds_read_b64_tr_b16 %0,%1 offset:%c2":"=&v"(lo[ks]):"v"(vb),"i"(d0*4096+ks*1024):"memory");
      asm volatile("ds_read_b64_tr_b16 %0,%1 offset:%c2":"=&v"(hi[ks]):"v"(vb),"i"(d0*4096+ks*1024+512):"memory");}
    asm volatile("s_waitcnt lgkmcnt(0)":::"memory");SBAR();
    #define PK(k) (bf16x8){lo[k][0],lo[k][1],lo[k][2],lo[k][3],hi[k][0],hi[k][1],hi[k][2],hi[k][3]}
    o[d0]=__builtin_amdgcn_mfma_f32_32x32x16_bf16(pa0,PK(0),o[d0],0,0,0);
    o[d0]=__builtin_amdgcn_mfma_f32_32x32x16_bf16(pa1,PK(1),o[d0],0,0,0);
    o[d0]=__builtin_amdgcn_mfma_f32_32x32x16_bf16(pa2,PK(2),o[d0],0,0,0);
    o[d0]=__builtin_amdgcn_mfma_f32_32x32x16_bf16(pa3,PK(3),o[d0],0,0,0);
    #undef PK
  }
}

#ifndef ATTN_STORE16
#define ATTN_STORE16(p,v) (*(u32x4*)(p)=(v))
#endif
template<bool SKIP> __device__ __forceinline__ void attn_unit(int b,int h,int qb,const bf16*Q,const bf16*__restrict__ K,const bf16*__restrict__ V,bf16*O,const float*__restrict__ CB,float qkb,char*shm){
  const int tid=otid(),lane=tid&63,r32=lane&31,hi=lane>>5; const int wid=__builtin_amdgcn_readfirstlane(tid>>6);
  const long rowbase=(long)b*SEQ; const int q0=qb*QB;
  const float*cb=CB+(long)(b*NHEAD+h)*SEQ;
  int t0=0;
  if(SKIP){ const int NTf=(q0+QB)/KVBLK; const float thr=2.f*qkb+40.f; const float cq0=cb[q0];
    bool pred=false; if(lane<NTf-4){ pred=(cq0-cb[64*lane+63])<-thr; }
    const unsigned long long mk=__ballot(pred); t0=(int)__builtin_ctzll(~mk); t0&=~1; t0=__builtin_amdgcn_readfirstlane(t0); }
  const int kv0=t0*KVBLK;
  const int NT=(q0+QB)/KVBLK-t0;
  { __attribute__((address_space(3))) float*bl=(__attribute__((address_space(3))) float*)((lds_cptr)shm+LDS_BIAS); const float*cbk=cb+kv0; for(int i=tid;i<NT*KVBLK;i+=NW*64) bl[i]=-*(const float*)((const char*)cbk+(unsigned)(i*4)); }
  const float negm0=*(const float*)((const char*)(cb+q0+wid*QBLK)+(unsigned)((lane&31)*4))-qkb;
  const bf16*Qw=Q+(rowbase+q0+wid*QBLK)*DM+h*D;
  const bf16*Kh=K+(rowbase+kv0)*DM+h*D,*Vh=V+(rowbase+kv0)*DM+h*D;
  const unsigned lds0=(unsigned)(uintptr_t)shm;
  const unsigned koff=(unsigned)(lane*DM+wid*8)*2u;
  const unsigned voff=(unsigned)((16*(wid&3)+(lane>>2))*DM+(wid>>2)*32+(lane&3)*8)*2u;
  const unsigned kdst=lds0+LDS_K+wid*1024, vdst=lds0+LDS_V+wid*1024;
  #define DMA_K(t,slot) glds16(Kh+(long)(t)*KVBLK*DM,koff,(unsigned)__builtin_amdgcn_readfirstlane(kdst+(slot)))
  #define DMA_V(t,slot) glds16(Vh+(long)(t)*KVBLK*DM,voff,(unsigned)__builtin_amdgcn_readfirstlane(vdst+(slot)))
  bf16x8 kf[8];
  const lds_cptr shm3=(lds_cptr)shm; __attribute__((address_space(3))) float*const wsf=(__attribute__((address_space(3))) float*)(shm3+LDS_WS)+wid*64;
  const lds_cptr kp0=shm3+LDS_K+hi*1024+r32*16; const lds_cptr vp0=shm3+LDS_V+((lane>>4)&1)*32+(lane&3)*8+(4*hi+((lane&15)>>2))*64;
  DMA_K(0,0);DMA_V(0,0);DMA_K(1,SLOTB);
  bf16x8 qr[4];
  #pragma unroll
  for(int d0=0;d0<4;++d0)qr[d0]=*reinterpret_cast<const bf16x8*>((const char*)Qw+(unsigned)((r32*DM+d0*16+hi*8)*2));
  float l_reg=0.f;f32x16 o[2];o[0]=f32x16{};o[1]=f32x16{};
  const __attribute__((address_space(3))) char* bl3=(const __attribute__((address_space(3))) char*)shm+LDS_BIAS+hi*16;
  #define BINIT_ALL(P0,P1,t) do{ const __attribute__((address_space(3))) f32x4v* bp_=(const __attribute__((address_space(3))) f32x4v*)(bl3+(t)*256); \
    _Pragma("unroll") for(int g_=0;g_<4;++g_){ const f32x4v x0_=bp_[2*g_], x1_=bp_[8+2*g_]; \
      P0[4*g_]=x0_[0]+negm0;P0[4*g_+1]=x0_[1]+negm0;P0[4*g_+2]=x0_[2]+negm0;P0[4*g_+3]=x0_[3]+negm0; \
      P1[4*g_]=x1_[0]+negm0;P1[4*g_+1]=x1_[1]+negm0;P1[4*g_+2]=x1_[2]+negm0;P1[4*g_+3]=x1_[3]+negm0; } }while(0)
  const int qrel=wid*QBLK+r32;
  #define CMASK(P0,P1,t) do{int jb_=(t)-(NT-4); if(jb_>=0)cmask(P0,P1,jb_,qrel,hi);}while(0)
  f32x16 pA0,pA1,pB0,pB1;
  int sl_prev=0,sl_cur=0,sl_next=SLOTB;
  #define ROT() do{sl_prev=sl_cur;sl_cur=sl_next;sl_next=(sl_next==(NSLOT-1)*SLOTB)?0:sl_next+SLOTB;}while(0)
  DMA_K(2,2*SLOTB);
  WAIT_BAR(3);
  BINIT_ALL(pA0,pA1,0); qkt(pA0,pA1,kp0,qr);asm volatile("s_nop 15\n\ts_nop 7":"+v"(pA0),"+v"(pA1));CMASK(pA0,pA1,0);
  _Pragma("unroll") for(int r=0;r<16;++r){pA0[r]=__builtin_amdgcn_exp2f(pA0[r]);pA1[r]=__builtin_amdgcn_exp2f(pA1[r]);}
  BINIT_ALL(pB0,pB1,1);
  WAIT_BAR(0);
  DMA_K(3,0);DMA_V(1,SLOTB);
  ROT();
  kload8(kf,kp0+sl_cur);
  WAIT_BAR(2);
  s16x4 vlo[8],vhi[8]; u32x4 pw0,pw1,pw2,pw3;
  #define PKW(P,B) cvtpk_s(P[B],P[B+1])
  #define PAF(k) __builtin_bit_cast(bf16x8,pw##k)
  #define VFR(i) (bf16x8){vlo[i][0],vlo[i][1],vlo[i][2],vlo[i][3],vhi[i][0],vhi[i][1],vhi[i][2],vhi[i][3]}
  #define PIN(x) asm volatile("":"+v"(x))
  #define MX3(a,b,c) __builtin_fmaxf(__builtin_fmaxf((a),(b)),(c))
  #define GAPA(MF,A0,A1,A2,A3,W0,W1,PW) do{ MF; sacc+=A0; sacc+=A1; sacc+=A2; sacc+=A3; PIN(sacc); W0; W1; PIN(PW); SBAR(); }while(0)
  #define EX(v) __builtin_amdgcn_exp2f(v)
  #define GAPB(MF,X,B,GL_,P,GI,NI) do{ MF; X[B]=EX(X[B]); X[B+1]=EX(X[B+1]); X[B+2]=EX(X[B+2]); X[B+3]=EX(X[B+3]); PIN(X); \
    if(GL_){ const f32x4v nx_=bpn_[NI]; P[4*(GI)]=bq_[0]+negm0; P[4*(GI)+1]=bq_[1]+negm0; P[4*(GI)+2]=bq_[2]+negm0; P[4*(GI)+3]=bq_[3]+negm0; bq_=nx_; PIN(P); } SBAR(); }while(0)
  #define VRD(i) do{ vlo[i]=vtr(vp_+(((i)>>2)*4096+((i)&3)*1024)); vhi[i]=vtr(vp_+(((i)>>2)*4096+((i)&3)*1024+512)); }while(0)
  #define KRD(G,j) do{ if(G){ kload2(kf,kp0+sl_next,j); SBAR(); } }while(0)
  #define STEP(C0,C1,P0,P1,t,GK,GV,GL) do{ SBAR(); \
    const lds_cptr vp_=vp0+sl_prev; \
    VRD(0); SBAR(); float sacc=(P0[0]+P0[1]); \
    GAPA(C0=__builtin_amdgcn_mfma_f32_32x32x16_bf16(kf[0],qr[0],C0,0,0,0), P0[2],P0[3],P0[4],P0[5],     pw0[0]=PKW(P0,0), pw0[1]=PKW(P0,2), pw0); \
    VRD(4); SBAR(); GAPA(C1=__builtin_amdgcn_mfma_f32_32x32x16_bf16(kf[1],qr[0],C1,0,0,0), P0[6],P0[7],P0[8],P0[9],     pw0[2]=PKW(P0,4), pw0[3]=PKW(P0,6), pw0); \
    VRD(1); SBAR(); GAPA(C0=__builtin_amdgcn_mfma_f32_32x32x16_bf16(kf[2],qr[1],C0,0,0,0),   P0[10],P0[11],P0[12],P0[13], pw1[0]=PKW(P0,8), pw1[1]=PKW(P0,10), pw1); \
    VRD(5); SBAR(); GAPA(C1=__builtin_amdgcn_mfma_f32_32x32x16_bf16(kf[3],qr[1],C1,0,0,0),   P0[14],P0[15],P1[0],P1[1],   pw1[2]=PKW(P0,12),pw1[3]=PKW(P0,14), pw1); \
    VRD(2); SBAR(); GAPA(C0=__builtin_amdgcn_mfma_f32_32x32x16_bf16(kf[4],qr[2],C0,0,0,0),   P1[2],P1[3],P1[4],P1[5],     pw2[0]=PKW(P1,0), pw2[1]=PKW(P1,2), pw2); \
    VRD(6); SBAR(); GAPA(C1=__builtin_amdgcn_mfma_f32_32x32x16_bf16(kf[5],qr[2],C1,0,0,0),   P1[6],P1[7],P1[8],P1[9],     pw2[2]=PKW(P1,4), pw2[3]=PKW(P1,6), pw2); \
    VRD(3); SBAR(); GAPA(C0=__builtin_amdgcn_mfma_f32_32x32x16_bf16(kf[6],qr[3],C0,0,0,0),   P1[10],P1[11],P1[12],P1[13], pw3[0]=PKW(P1,8), pw3[1]=PKW(P1,10), pw3); \
    VRD(7); SBAR(); GAPA(C1=__builtin_amdgcn_mfma_f32_32x32x16_bf16(kf[7],qr[3],C1,0,0,0),   P1[14],P1[15],0.f,0.f,       pw3[2]=PKW(P1,12),pw3[3]=PKW(P1,14), pw3); \
    l_reg+=sacc; \
    if(GK){DMA_K((t)+3,sl_cur);} if(GV){DMA_V((t)+1,sl_next);} \
    CMASK(C0,C1,t); \
    const __attribute__((address_space(3))) f32x4v* bpn_=(const __attribute__((address_space(3))) f32x4v*)(bl3+((t)+1)*256); f32x4v bq_=f32x4v{}; if(GL){bq_=bpn_[0];} \
    SBAR(); \
    GAPB(o[0]=__builtin_amdgcn_mfma_f32_32x32x16_bf16(PAF(0),VFR(0),o[0],0,0,0), C0,0,GL,P0,0,8); \
    GAPB(o[1]=__builtin_amdgcn_mfma_f32_32x32x16_bf16(PAF(0),VFR(4),o[1],0,0,0), C0,4,GL,P1,0,2); \
    KRD(GL,0); GAPB(o[0]=__builtin_amdgcn_mfma_f32_32x32x16_bf16(PAF(1),VFR(1),o[0],0,0,0), C0,8,GL,P0,1,10); \
    KRD(GL,1); GAPB(o[1]=__builtin_amdgcn_mfma_f32_32x32x16_bf16(PAF(1),VFR(5),o[1],0,0,0), C0,12,GL,P1,1,4); \
    KRD(GL,2); GAPB(o[0]=__builtin_amdgcn_mfma_f32_32x32x16_bf16(PAF(2),VFR(2),o[0],0,0,0), C1,0,GL,P0,2,12); \
    KRD(GL,3); GAPB(o[1]=__builtin_amdgcn_mfma_f32_32x32x16_bf16(PAF(2),VFR(6),o[1],0,0,0), C1,4,GL,P1,2,6); \
    GAPB(o[0]=__builtin_amdgcn_mfma_f32_32x32x16_bf16(PAF(3),VFR(3),o[0],0,0,0), C1,8,GL,P0,3,14); \
    GAPB(o[1]=__builtin_amdgcn_mfma_f32_32x32x16_bf16(PAF(3),VFR(7),o[1],0,0,0), C1,12,GL,P1,3,14); \
    }while(0)
  int t=1;
  #undef CMASK
  #define CMASK(P0,P1,t) do{}while(0)
  for(;t+5<NT;t+=2){
    STEP(pB0,pB1,pA0,pA1,t,true,true,true);     WAIT_BAR(2); ROT();
    STEP(pA0,pA1,pB0,pB1,t+1,true,true,true);   WAIT_BAR(2); ROT();
  }
  #undef CMASK
  #define CMASK(P0,P1,t) do{int jb_=(t)-(NT-4); if(jb_>=0)cmask(P0,P1,jb_,qrel,hi);}while(0)
  #define ENDW(tt) do{ if((tt)+3<NT){WAIT_BAR(2);} else if((tt)+2<NT){WAIT_BAR(1);} else {WAIT_BAR(0);} }while(0)
  for(;t+1<NT;t+=2){
    STEP(pB0,pB1,pA0,pA1,t,(t+3<NT),(t+1<NT),(t+1<NT));       ENDW(t);   ROT();
    STEP(pA0,pA1,pB0,pB1,t+1,(t+4<NT),(t+2<NT),(t+2<NT));     ENDW(t+1); ROT();
  }
  STEP(pB0,pB1,pA0,pA1,NT-1,false,false,false);
  { float sacc=pB0[0]+pB0[1]; _Pragma("unroll") for(int r=2;r<16;++r)sacc+=pB0[r]; _Pragma("unroll") for(int r=0;r<16;++r)sacc+=pB1[r]; l_reg+=sacc;
    pw0=(u32x4){PKW(pB0,0),PKW(pB0,2),PKW(pB0,4),PKW(pB0,6)};pw1=(u32x4){PKW(pB0,8),PKW(pB0,10),PKW(pB0,12),PKW(pB0,14)};pw2=(u32x4){PKW(pB1,0),PKW(pB1,2),PKW(pB1,4),PKW(pB1,6)};pw3=(u32x4){PKW(pB1,8),PKW(pB1,10),PKW(pB1,12),PKW(pB1,14)};
    SBAR(); pv(o,(int)(unsigned)(uintptr_t)vp0+sl_cur,PAF(0),PAF(1),PAF(2),PAF(3)); }
  #undef PKW
  #undef PAF
  #undef VFR
  #undef PIN
  #undef MX3
  #undef GAPA
  #undef GAPB
  #undef EX
  #undef VRD
  #undef KRD
  #undef STEP
  #undef ENDW
  {auto rr=__builtin_amdgcn_permlane32_swap(__float_as_uint(l_reg),__float_as_uint(l_reg),false,false);l_reg=__uint_as_float(rr[0])+__uint_as_float(rr[1]);}
  if(hi==0)wsf[32+r32]=l_reg;asm volatile("s_waitcnt lgkmcnt(0)":::"memory");
  float rli[16];
  #pragma unroll
  for(int r=0;r<16;++r)rli[r]=__builtin_amdgcn_rcpf(wsf[32+crow(r,hi)]);
  bf16*Ow=O+(rowbase+q0+wid*QBLK)*OPITCH+h*D;
  { __attribute__((address_space(3))) unsigned short*stg=(__attribute__((address_space(3))) unsigned short*)(shm3+LDS_OST)+wid*2048;
    #pragma unroll
    for(int r=0;r<16;++r){const int orow=crow(r,hi);
      #pragma unroll
      for(int d0=0;d0<2;++d0)stg[orow*64+d0*32+r32]=(unsigned short)(cvtpk_s(o[d0][r]*rli[r],0.f)&0xffffu);}
    asm volatile("s_waitcnt lgkmcnt(0)":::"memory");
    #pragma unroll
    for(int i=0;i<4;++i){const int row=i*8+(lane>>3),ch=lane&7; const u32x4 v=*(const __attribute__((address_space(3))) u32x4*)(stg+row*64+ch*8); ATTN_STORE16((char*)Ow+(unsigned)((row*OPITCH+ch*8)*2),v);} }
  asm volatile("s_waitcnt lgkmcnt(0)\n\ts_barrier":::"memory");
  #undef DMA_K
  #undef DMA_V
  #undef CMASK
  #undef BINIT_ALL
  #undef ROT
}
constexpr int ATTN_LDS_BYTES=LDS_TOTAL;
struct AttnTensors { const bf16* Q; const bf16* K; const bf16* V; bf16* O; const float* CB; float qkb; };
struct AttnUnit { int bh; int qb; };
struct StaticOrder {
  int vcu,G;
  __device__ __forceinline__ explicit StaticOrder(int grid,int block):vcu((grid%8==0)?(block%8)*(grid/8)+block/8:block),G(grid){}
  __device__ __forceinline__ bool next(int i,AttnUnit&u)const{
    if(G==256){ if(i>=4)return false; const int s=vcu&3; u.bh=vcu>>2; u.qb=(i==0)?s:(i==1)?7-s:(i==2)?8+s:15-s; return true; }
    const int id=vcu+i*G; if(id>=BATCH*NHEAD*NQB)return false; u.bh=id/NQB; u.qb=id%NQB; return true; }
};
template<class Sched,bool SKIP> __device__ __forceinline__ void attn_phase(char*lds,const AttnTensors&T,const Sched&S){
  AttnUnit u;
  for(int i=0;S.next(i,u);++i){ attn_unit<SKIP>(u.bh/NHEAD,u.bh%NHEAD,u.qb,T.Q,T.K,T.V,T.O,T.CB,T.qkb,lds); }
}
template<bool SKIP> __device__ __forceinline__ void attn_phase_q(char*lds,const AttnTensors&T,unsigned*queue){
  const int tid=otid();
  __attribute__((address_space(3))) int*slot=(__attribute__((address_space(3))) int*)((lds_cptr)lds+LDS_TOTAL);
  const unsigned xcc=(unsigned)__builtin_amdgcn_s_getreg((3<<11)|20)&7u;
  for(;;){
    if(tid==0){ int got=-1;
      for(unsigned sx=0;sx<8;++sx){ const unsigned x=(xcc+sx)&7u; const unsigned c=__hip_atomic_fetch_add(queue+x*64,1u,__ATOMIC_RELAXED,__HIP_MEMORY_SCOPE_AGENT); if(c<(unsigned)(NHEAD*NQB)){ got=(int)(x*(NHEAD*NQB)+c); break; } }
      *slot=got; }
    asm volatile("s_waitcnt vmcnt(0) lgkmcnt(0)\n\ts_barrier":::"memory");
    const int id=__builtin_amdgcn_readfirstlane(*slot);
    if(id<0)break;
    const int b=id/(NHEAD*NQB), c=id%(NHEAD*NQB), h=c%NHEAD, qb=NQB-1-c/NHEAD;
    attn_unit<SKIP>(b,h,qb,T.Q,T.K,T.V,T.O,T.CB,T.qkb,lds);
  }
}
#undef SBAR
#undef WAIT_BAR
}
#define GAS __attribute__((address_space(1)))
#define LAS __attribute__((address_space(3)))
typedef unsigned short bf16;
typedef unsigned v4u __attribute__((ext_vector_type(4)));
typedef float f32x4 __attribute__((ext_vector_type(4)));
typedef short bf16x8 __attribute__((ext_vector_type(8)));
typedef GAS unsigned gu32;
typedef GAS unsigned long long gu64;
#define RLX_AGENT __ATOMIC_RELAXED, __HIP_MEMORY_SCOPE_AGENT
#define LDS_WAIT() asm volatile("s_waitcnt lgkmcnt(0)" ::: "memory")
#define VM_WAIT() asm volatile("s_waitcnt vmcnt(0)" ::: "memory")
__device__ __forceinline__ unsigned long long rt() { return __builtin_amdgcn_s_memrealtime(); }
__device__ __forceinline__ unsigned f2bf(float f) { unsigned u = __builtin_bit_cast(unsigned, f); return (u + 0x7fffu + ((u >> 16) & 1u)) >> 16; }
__device__ __forceinline__ unsigned pk2(float lo, float hi) { return f2bf(lo) | (f2bf(hi) << 16); }

#define XB_TMO      128
#define XB_XCNT(j)  (256  + 64 * (j))
#define XB_XSUB(j)  (1280 + 64 * (j))
#define XB_XGEN(j)  (2304 + 64 * (j))
#define XB_TOP      3328
#define XB_TOPGEN   3392
#define XCD_BAR_WORDS 3456
#define XB_SPIN_CAP (1u << 18)

__device__ __forceinline__ unsigned xb_ld(unsigned* p)              { return __hip_atomic_load(p, __ATOMIC_RELAXED, __HIP_MEMORY_SCOPE_AGENT); }
__device__ __forceinline__ unsigned xb_add(unsigned* p, unsigned v) { return __hip_atomic_fetch_add(p, v, __ATOMIC_RELAXED, __HIP_MEMORY_SCOPE_AGENT); }
__device__ __forceinline__ unsigned xb_xcc_id() { return (unsigned)__builtin_amdgcn_s_getreg((3 << 11) | 20) & 0xFu; }
#define XB_SPIN(cond, bar) do { unsigned _sp = 0; while (cond) { __builtin_amdgcn_s_sleep(1); \
    if ((++_sp & 255u) == 0u) { if (xb_ld(&(bar)[XB_TMO])) break; if (_sp > XB_SPIN_CAP) { atomicAdd(&(bar)[XB_TMO], 1u); break; } } } } while (0)

struct XcdBarrier {
    unsigned* bar; unsigned x;
    volatile LAS unsigned* st;
};

__device__ __forceinline__ XcdBarrier xcd_barrier_post(unsigned* bar, volatile LAS unsigned* st) {
    XcdBarrier b; b.bar = bar; b.x = xb_xcc_id(); b.st = st;
    if (threadIdx.x == 0) (void)xb_add(&bar[XB_XCNT(b.x)], 1u);
    return b;
}
__device__ __forceinline__ void xcd_barrier_complete(unsigned* bar, unsigned x, unsigned& nloc, unsigned& nx) {
    const unsigned G = gridDim.x * gridDim.y * gridDim.z;
    unsigned sum, cnt, mine, sp = 0u;
    for (;;) {
        sum = 0u; cnt = 0u; mine = 0u;
#pragma unroll
        for (unsigned j = 0; j < 16; ++j) { const unsigned c = xb_ld(&bar[XB_XCNT(j)]); sum += c; cnt += (c > 0u) ? 1u : 0u; mine = (j == x) ? c : mine; }
        if (sum == G) break;
        __builtin_amdgcn_s_sleep(1);
        if ((++sp & 255u) == 0u) { if (xb_ld(&bar[XB_TMO])) break; if (sp > XB_SPIN_CAP) { atomicAdd(&bar[XB_TMO], 1u); break; } }
    }
    nloc = mine > 0u ? mine : 1u; nx = cnt > 0u ? cnt : 1u;
}

__device__ __forceinline__ void xcd_barrier(const XcdBarrier& b) {
    asm volatile("s_waitcnt vmcnt(0)" ::: "memory");
    __syncthreads();
    if (threadIdx.x == 0) {
        unsigned* bar = b.bar;
        __builtin_amdgcn_s_waitcnt(0);
        unsigned nloc = b.st[0], nx = b.st[1];
        if (nloc == 0u) { xcd_barrier_complete(bar, b.x, nloc, nx); b.st[0] = nloc; b.st[1] = nx; }
        const unsigned old = xb_add(&bar[XB_XSUB(b.x)], 1u);
        const unsigned gen = old / nloc;
        if (old + 1u == (gen + 1u) * nloc) {
            __builtin_amdgcn_fence(__ATOMIC_RELEASE, "agent");
            asm volatile("s_waitcnt vmcnt(0)" ::: "memory");
            const unsigned og = xb_add(&bar[XB_TOP], 1u);
            const unsigned tg = og / nx;
            if (og + 1u == (tg + 1u) * nx) xb_add(&bar[XB_TOPGEN], 1u);
            else XB_SPIN(xb_ld(&bar[XB_TOPGEN]) == tg, bar);
            __builtin_amdgcn_fence(__ATOMIC_ACQUIRE, "agent");
            xb_add(&bar[XB_XGEN(b.x)], 1u);
            asm volatile("s_waitcnt vmcnt(0)" ::: "memory");
        } else {
            XB_SPIN(xb_ld(&bar[XB_XGEN(b.x)]) == gen, bar);
            __builtin_amdgcn_fence(__ATOMIC_ACQUIRE, "agent");
            asm volatile("s_waitcnt vmcnt(0)" ::: "memory");
        }
    }
    __syncthreads();
}
struct Args { const float* in[25]; float* out; unsigned char* ws; int ph_lo, ph_hi, use_bar, pad; };
typedef const __attribute__((address_space(4))) Args* KArgs;
#define CAND_LIST CAND(0,0,2,1) CAND(0,1,2,2) CAND(0,2,2,3) CAND(0,3,2,4) CAND(0,4,3,0) CAND(0,5,3,1) CAND(0,6,3,2) CAND(0,7,3,3) CAND(0,8,4,0) CAND(0,9,4,1) CAND(0,10,4,2) CAND(0,11,5,0) CAND(0,12,5,1) CAND(0,13,6,0) CAND(0,14,6,1) CAND(0,15,7,0) CAND(1,0,7,1) CAND(1,1,8,0) CAND(1,2,9,0) CAND(1,3,10,0) CAND(1,4,11,0) CAND(1,5,12,0) CAND(1,6,13,0) CAND(1,7,14,0) CAND(2,0,15,0)
constexpr int NB = 8, SEQ = 4096, DM = 1024, NTOK = NB * SEQ;
constexpr int NH = 8, HD = 64, AW = 512, PWD = 256, SWD = 256, INC = 2056;
constexpr int NEXP = 16384, PQW = 2048;
constexpr float EPSN = 1e-6f, LOG2E = 1.4426950408889634f;
constexpr int NWAVES = 8, NTHR = 512;
constexpr size_t MiB = 1u << 20;
constexpr size_t WS_CTL = 0, CTL_ZERO_BYTES = 1 * MiB;
constexpr size_t WS_WIN = 1 * MiB;
constexpr size_t WS_WOUT = 9 * MiB;
constexpr size_t WS_WQ = 13 * MiB;
constexpr size_t WS_KEYS = 21 * MiB;
constexpr size_t WS_WGLU = 22 * MiB;
constexpr size_t WS_WF = 22 * MiB + 512 * 1024;
constexpr size_t WS_CB = 23 * MiB;
constexpr size_t WS_XLOC = 24 * MiB;
constexpr size_t WS_IDX = 28 * MiB;
constexpr size_t WS_GATE = 44 * MiB;
constexpr size_t WS_Z = 60 * MiB;
constexpr size_t WS_U = 76 * MiB;
constexpr size_t WS_V = 140 * MiB;
constexpr size_t WS_XN8 = 172 * MiB;
constexpr size_t WS_HSC = 22 * MiB + 768 * 1024;
constexpr size_t WS_XN = 204 * MiB;
constexpr size_t WS_P = 268 * MiB;
constexpr size_t WS_MG = 396 * MiB;
constexpr size_t WS_END = 460 * MiB;
constexpr int CW_BAR = 4096, CW_AQ = 20480;
constexpr float U8_SCALE = 768.f, V8_SCALE = 32.f, ACT_SCALE = 64.f;
constexpr int RING_BYTES = 131072, LDSCTL_OFF = RING_BYTES, MISC_OFF = LDSCTL_OFF + 320, EPIX_OFF = LDSCTL_OFF + 4096, LDS_BYTES = 163840;
static_assert(attn_body::ATTN_LDS_BYTES + 16 <= RING_BYTES, "attention scratch fits the ring");

typedef _Float16 h16x2 __attribute__((ext_vector_type(2)));
typedef float f32x16 __attribute__((ext_vector_type(16)));
typedef unsigned u32x2 __attribute__((ext_vector_type(2)));

__device__ __forceinline__ float bf2f(unsigned short b) { return __uint_as_float((unsigned)b << 16); }
__device__ __forceinline__ float bflo(unsigned w) { return __uint_as_float(w << 16); }
__device__ __forceinline__ float bfhi(unsigned w) { return __uint_as_float(w & 0xffff0000u); }
__device__ __forceinline__ h16x2 as_h2(unsigned w) { return __builtin_bit_cast(h16x2, w); }
template <bool HI> __device__ __forceinline__ h16x2 cvt8h(int w) { return __builtin_bit_cast(h16x2, __builtin_amdgcn_cvt_scalef32_pk_f16_fp8(w, 1.0f, HI)); }
__device__ __forceinline__ float gelu_tanh(float x) { const float u = 1.5957691216057308f * (x + 0.044715f * x * x * x); return x / (1.f + __expf(-u)); }
__device__ __forceinline__ float wave_sum(float v) {
#pragma unroll
    for (int o = 1; o < 64; o <<= 1) v += __shfl_xor(v, o);
    return v;
}
__device__ __forceinline__ float wave_max(float v) {
#pragma unroll
    for (int o = 1; o < 64; o <<= 1) v = fmaxf(v, __shfl_xor(v, o));
    return v;
}
template <int N, int S0> __device__ __forceinline__ float bfly_reduce(float (&v)[N], int lane) {
    int s = S0;
#pragma unroll
    for (int cnt = N; cnt > 1; cnt >>= 1) {
        const bool up = (lane & s) != 0;
#pragma unroll
        for (int i = 0; i < cnt / 2; ++i) { const float a = v[i], b = v[i + cnt / 2]; const float send = up ? a : b, keep = up ? b : a; v[i] = keep + __shfl_xor(send, s); }
        s >>= 1;
    }
    float r = v[0];
    for (; s >= 1; s >>= 1) r += __shfl_xor(r, s);
    return r;
}

__device__ __forceinline__ void tr_item(const float* W, int ldw, int srccol, bf16* WT, int K, int dstrow, int k0, LAS float* scr, int lane) {
#pragma unroll 8
    for (int i = 0; i < 32; ++i) { const int kk = 2 * i + (lane >> 5); scr[kk * 33 + (lane & 31)] = W[(size_t)(k0 + kk) * ldw + srccol + (lane & 31)]; }
    LDS_WAIT(); asm volatile("" ::: "memory");
    const int c = lane & 7;
#pragma unroll
    for (int j = 0; j < 4; ++j) { const int n = (lane >> 3) + 8 * j; const LAS float* s = scr + (8 * c) * 33 + n;
        v4u o; o.x = pk2(s[0 * 33], s[1 * 33]); o.y = pk2(s[2 * 33], s[3 * 33]); o.z = pk2(s[4 * 33], s[5 * 33]); o.w = pk2(s[6 * 33], s[7 * 33]);
        *(GAS v4u*)(WT + (size_t)(dstrow + n) * K + k0 + 8 * c) = o; }
    LDS_WAIT(); asm volatile("" ::: "memory");
}
__device__ __forceinline__ void phase_prep(KArgs a, LAS unsigned char* lds, int G, int vcu, int tid, int lane, int wave) {
    unsigned char* ws = a->ws;
    LAS float* scr = (LAS float*)(lds + wave * 16384);
    const int gw = vcu * NWAVES + wave, NGW = G * NWAVES;
    constexpr int I_IN = 2048, I_OUT = 1024, I_WQ = 2048, I_GLU = 64;
    for (int it = gw; it < I_IN + I_OUT + I_WQ + I_GLU; it += NGW) {
        int r = it;
        if (r < I_IN) { const int l = r >> 10, q = r & 1023, kb = q >> 6, nb = q & 63, n0 = nb * 32;
            tr_item(a->in[2] + (size_t)l * DM * INC, INC, n0 + (n0 >= 1536 ? 8 : 0), (bf16*)(ws + WS_WIN) + (size_t)l * 2048 * 1024, 1024, n0, kb * 64, scr, lane); continue; }
        r -= I_IN;
        if (r < I_OUT) { const int l = r >> 9, q = r & 511, kb = q >> 5, nb = q & 31;
            tr_item(a->in[19] + (size_t)l * DM * DM, DM, nb * 32, (bf16*)(ws + WS_WOUT) + (size_t)l * 1024 * 1024, 1024, nb * 32, kb * 64, scr, lane); continue; }
        r -= I_OUT;
        if (r < I_WQ) { const int l = r >> 10, q = r & 1023, kb = q >> 6, nb = q & 63;
            tr_item(a->in[21] + (size_t)l * DM * PQW, PQW, nb * 32, (bf16*)(ws + WS_WQ) + (size_t)l * 2048 * 1024, 1024, nb * 32, kb * 64, scr, lane); continue; }
        r -= I_WQ;
        { const int l = r >> 5, q = r & 31, kb = q >> 3, nb = q & 7;
            tr_item(a->in[16] + (size_t)l * 256 * 256, 256, nb * 32, (bf16*)(ws + WS_WGLU) + (size_t)l * 256 * 256, 256, nb * 32, kb * 64, scr, lane); }
    }
    const size_t gt = (size_t)vcu * NTHR + tid, NGT = (size_t)G * NTHR;
    for (size_t i = gt; i < 2 * 8 * 1024; i += NGT) { const int l = (int)(i >> 13), h = (int)(i >> 10) & 7, k = (int)i & 1023;
        ((float*)(ws + WS_WF))[i] = a->in[2][((size_t)l * DM + k) * INC + 1536 + h]; }
    { const float* src = a->in[22]; bf16* dst = (bf16*)(ws + WS_KEYS);
      for (size_t i = gt; i < (size_t)2 * 8 * 2 * 128 * 128 / 8; i += NGT) { const f32x4 x0 = *(const f32x4*)(src + i * 8), x1 = *(const f32x4*)(src + i * 8 + 4);
          v4u o; o.x = pk2(x0[0], x0[1]); o.y = pk2(x0[2], x0[3]); o.z = pk2(x1[0], x1[1]); o.w = pk2(x1[2], x1[3]); *(v4u*)(dst + i * 8) = o; } }
    { const float* src = a->in[23]; unsigned char* dst = ws + WS_U;
#pragma unroll 1
      for (size_t i = gt; i < (size_t)2 * NEXP * DM / 16; i += NGT) { v4u o;
#pragma unroll
          for (int q = 0; q < 4; ++q) { const f32x4 x = *(const f32x4*)(src + i * 16 + 4 * q) * U8_SCALE;
              const int q0 = (int)__builtin_rintf(fminf(fmaxf(x[0], -127.f), 127.f)), q1 = (int)__builtin_rintf(fminf(fmaxf(x[1], -127.f), 127.f)), q2 = (int)__builtin_rintf(fminf(fmaxf(x[2], -127.f), 127.f)), q3 = (int)__builtin_rintf(fminf(fmaxf(x[3], -127.f), 127.f));
              o[q] = (unsigned)((q0 & 255) | ((q1 & 255) << 8) | ((q2 & 255) << 16) | (q3 << 24)); }
          const size_t r = i >> 6; const unsigned cg = (unsigned)(i & 63), l = (unsigned)(r / NEXP), rl = (unsigned)(r % NEXP);
          *(v4u*)(dst + (size_t)l * NEXP * DM + (size_t)(cg >> 3) * NEXP * 128 + (size_t)rl * 128 + (cg & 7u) * 16u) = o; } }
    { const float* src = a->in[24]; unsigned char* dst = ws + WS_V;
#pragma unroll 1
      for (size_t i = gt; i < (size_t)2 * NEXP * DM / 16; i += NGT) { v4u o;
#pragma unroll
          for (int q = 0; q < 4; ++q) { f32x4 x = *(const f32x4*)(src + i * 16 + 4 * q) * V8_SCALE;
              x[0] = fminf(fmaxf(x[0], -448.f), 448.f); x[1] = fminf(fmaxf(x[1], -448.f), 448.f); x[2] = fminf(fmaxf(x[2], -448.f), 448.f); x[3] = fminf(fmaxf(x[3], -448.f), 448.f);
              int w = 0; w = __builtin_amdgcn_cvt_pk_fp8_f32(x[0], x[1], w, false); w = __builtin_amdgcn_cvt_pk_fp8_f32(x[2], x[3], w, true); o[q] = (unsigned)w; }
          const size_t r = i >> 6; const unsigned cg = (unsigned)(i & 63), l = (unsigned)(r / NEXP), rl = (unsigned)(r % NEXP);
          *(v4u*)(dst + (size_t)l * NEXP * DM + (size_t)(cg >> 3) * NEXP * 128 + (size_t)rl * 128 + (cg & 7u) * 16u) = o; } }
}

template <bool FLOGIT> __device__ __forceinline__ void phase_rownorm(const float* x, const float* g, bf16* XN, const float* WF, const float* fbias, float* CB, int G, int vcu, int lane, int wave, unsigned char* XN8 = nullptr, float* HSC = nullptr) {
    const int gw = vcu * NWAVES + wave, NGW = G * NWAVES;
    f32x4 gv[4];
#pragma unroll
    for (int j = 0; j < 4; ++j) gv[j] = *(const f32x4*)(g + 4 * lane + 256 * j);
    f32x4 vn[2][4];
#define RN_LOAD(rg_) do { _Pragma("unroll") for (int r = 0; r < 2; ++r) { const float* xr = x + (size_t)((rg_) * 2 + r) * DM + 4 * lane; _Pragma("unroll") for (int j = 0; j < 4; ++j) vn[r][j] = *(const f32x4*)(xr + 256 * j); } } while (0)
    if (gw < NTOK / 2) RN_LOAD(gw);
    for (int rg = gw; rg < NTOK / 2; rg += NGW) {
        f32x4 v[2][4];
#pragma unroll
        for (int r = 0; r < 2; ++r)
#pragma unroll
            for (int j = 0; j < 4; ++j) v[r][j] = vn[r][j];
        if (rg + NGW < NTOK / 2) RN_LOAD(rg + NGW);
#pragma unroll
        for (int r = 0; r < 2; ++r) { float s = 0.f;
#pragma unroll
            for (int j = 0; j < 4; ++j) s += (v[r][j][0] * v[r][j][0] + v[r][j][1] * v[r][j][1]) + (v[r][j][2] * v[r][j][2] + v[r][j][3] * v[r][j][3]);
            const float rstd = 1.0f / sqrtf(wave_sum(s) * (1.f / DM) + EPSN);
            bf16* orow = XN + (size_t)(rg * 2 + r) * DM + 4 * lane;
#pragma unroll
            for (int j = 0; j < 4; ++j) { v[r][j] = v[r][j] * rstd * gv[j]; u32x2 w; w.x = pk2(v[r][j][0], v[r][j][1]); w.y = pk2(v[r][j][2], v[r][j][3]); *(u32x2*)(orow + 256 * j) = w; }
            if (!FLOGIT && XN8) { float mx = 0.f;
#pragma unroll
                for (int j = 0; j < 4; ++j) mx = fmaxf(fmaxf(mx, fmaxf(fabsf(v[r][j][0]), fabsf(v[r][j][1]))), fmaxf(fabsf(v[r][j][2]), fabsf(v[r][j][3])));
                mx = fmaxf(wave_max(mx), 1e-20f); const float qs = 127.f / mx;
#pragma unroll
                for (int j = 0; j < 4; ++j) { const int q0 = (int)__builtin_rintf(v[r][j][0] * qs), q1 = (int)__builtin_rintf(v[r][j][1] * qs), q2 = (int)__builtin_rintf(v[r][j][2] * qs), q3 = (int)__builtin_rintf(v[r][j][3] * qs);
                    *(unsigned*)(XN8 + (size_t)(rg * 2 + r) * DM + 4 * lane + 256 * j) = (unsigned)((q0 & 255) | ((q1 & 255) << 8) | ((q2 & 255) << 16) | (q3 << 24)); }
                if (lane == 0) HSC[rg * 2 + r] = mx * (1.f / 127.f); } }
        if (FLOGIT) {
            float acc[16];
#pragma unroll
            for (int i = 0; i < 16; ++i) acc[i] = 0.f;
#pragma unroll
            for (int h = 0; h < 8; ++h)
#pragma unroll
                for (int j = 0; j < 4; ++j) { const f32x4 w = *(const f32x4*)(WF + h * 1024 + 4 * lane + 256 * j);
#pragma unroll
                    for (int r = 0; r < 2; ++r) acc[r * 8 + h] += (v[r][j][0] * w[0] + v[r][j][1] * w[1]) + (v[r][j][2] * w[2] + v[r][j][3] * w[3]); }
            const float tot = bfly_reduce<16, 32>(acc, lane);
            if ((lane & 3) == 0) { const int id = (lane >> 2) & 15, r = id >> 3, h = id & 7; const int row = rg * 2 + r, b = row / SEQ, s = row % SEQ;
                const float z = tot + fbias[h];
                const float ls = fminf(z, 0.f) - __logf(1.f + __expf(-fabsf(z)));
                CB[((size_t)(b * NH + h)) * SEQ + s] = ls * LOG2E; }
        }
    }
}

__device__ __forceinline__ void phase_cumsum(float* c, int lane) {
    float carry = 0.f;
#pragma unroll 1
    for (int it0 = 0; it0 < SEQ / 64; it0 += 16) { float vv[16];
#pragma unroll
        for (int q = 0; q < 16; ++q) vv[q] = c[(it0 + q) * 64 + lane];
#pragma unroll
        for (int q = 0; q < 16; ++q) { float v = vv[q];
#pragma unroll
            for (int o = 1; o < 64; o <<= 1) { const float t = __shfl_up(v, o); if (lane >= o) v += t; }
            v += carry; c[(it0 + q) * 64 + lane] = v; carry = __shfl(v, 63); } }
}

__device__ __forceinline__ void phase_pool(const bf16* PS, const float* pw, const float* pscale, const float* ong, bf16* MG, LAS unsigned char* lds, int G, int bx, int tid, int lane, int wave) {
    LAS float* ut = (LAS float*)lds;
    LAS float* pl = (LAS float*)(lds + 47 * 256 * 4);
    const int ch = tid & 255, half = tid >> 8, g = ch >> 6, w = 2 << g;
    float wcol[64];
#pragma unroll
    for (int c = 0; c < 64; ++c) wcol[c] = pw[(g * 64 + c) * 64 + (ch & 63)];
    const float psc = pscale[ch];
    const f32x4 gn = *(const f32x4*)(ong + 512 + 4 * lane);
    v4u wq[3];
#define POOL_LOAD(tile_) do { const int tok0_ = (tile_) * 32, s0_ = tok0_ % SEQ; _Pragma("unroll") for (int q = 0; q < 3; ++q) { const int idx = tid + q * NTHR, rr = idx >> 5, cq = idx & 31, r = rr - 15; \
        wq[q] = (v4u){0u, 0u, 0u, 0u}; if (idx < 47 * 32 && s0_ + r >= 0) wq[q] = *(const v4u*)(PS + (size_t)(tok0_ + r) * 512 + cq * 8); } } while (0)
    if (bx < NTOK / 32) POOL_LOAD(bx);
    for (int tile = bx; tile < NTOK / 32; tile += G) {
        const int tok0 = tile * 32, s0 = tok0 % SEQ;
#pragma unroll
        for (int q = 0; q < 3; ++q) { const int idx = tid + q * NTHR, rr = idx >> 5, cq = idx & 31; const v4u wv = wq[q];
            if (idx < 47 * 32) { LAS float* d = ut + rr * 256 + cq * 8;
                *(LAS f32x4*)d = (f32x4){bflo(wv.x), bfhi(wv.x), bflo(wv.y), bfhi(wv.y)}; *(LAS f32x4*)(d + 4) = (f32x4){bflo(wv.z), bfhi(wv.z), bflo(wv.w), bfhi(wv.w)}; } }
        if (tile + G < NTOK / 32) POOL_LOAD(tile + G);
        __syncthreads();
        { float s = 0.f; const int rr0 = half * 16 + 15;
            for (int j = 1; j < w; ++j) s += ut[(rr0 - j) * 256 + ch];
#pragma unroll 4
            for (int tt = 0; tt < 16; ++tt) { const int ti = half * 16 + tt, rr = ti + 15, pos = s0 + ti; const float cur = ut[rr * 256 + ch];
                s += cur; const int cnt = (pos + 1 < w) ? pos + 1 : w;
                pl[ti * 256 + ch] = s / (float)cnt - cur; s -= ut[(rr - w + 1) * 256 + ch]; } }
        __syncthreads();
#pragma unroll 1
        for (int tt = 0; tt < 16; ++tt) { const int ti = half * 16 + tt; const LAS f32x4* pr = (const LAS f32x4*)(pl + ti * 256 + g * 64);
            float acc = 0.f;
#pragma unroll
            for (int c4 = 0; c4 < 16; ++c4) { const f32x4 v = pr[c4]; acc += (v[0] * wcol[4 * c4] + v[1] * wcol[4 * c4 + 1]) + (v[2] * wcol[4 * c4 + 2] + v[3] * wcol[4 * c4 + 3]); }
            ut[ti * 256 + ch] = acc * psc; }
        __syncthreads();
#pragma unroll
        for (int q = 0; q < 4; ++q) { const int ti = wave * 4 + q; const f32x4 v = *(const LAS f32x4*)(ut + ti * 256 + 4 * lane);
            const float ss = wave_sum((v[0] * v[0] + v[1] * v[1]) + (v[2] * v[2] + v[3] * v[3]));
            const float rstd = 1.0f / sqrtf(ss * (1.f / 256.f) + EPSN);
            u32x2 o; o.x = pk2(v[0] * rstd * gn[0], v[1] * rstd * gn[1]); o.y = pk2(v[2] * rstd * gn[2], v[3] * rstd * gn[3]);
            *(u32x2*)(MG + (size_t)(tok0 + ti) * DM + 512 + 4 * lane) = o; }
        __syncthreads();
    }
}

template <bool PASS2> __device__ __forceinline__ void phase_s5(KArgs a, int l, const bf16* PS, float* XLOC, bf16* Z, LAS unsigned char* lds, int G, int bx, int lane, int wave) {
    constexpr int XST = 132;
    LAS float* Xs = (LAS float*)(lds + wave * (16 * XST * 4));
    const int p = lane, kq = lane >> 4, ln = lane & 15;
    for (int task = bx; task < NB * 16 * 8; task += G) {
        const int b = task >> 7, g = (task >> 3) & 15, c = (task & 7) * 8 + wave;
        const size_t tok_c = (size_t)b * SEQ + c * 64;
        const float a_re = a->in[8][(l * 16 + g) * 64 + p], a_im = a->in[9][(l * 16 + g) * 64 + p], ldt = a->in[10][l * 16 + g];
        u32x2 uraw[4];
#pragma unroll
        for (int sub = 0; sub < 4; ++sub) uraw[sub] = *(const u32x2*)(PS + (tok_c + sub * 16 + ln) * 512 + 256 + g * 16 + 4 * kq);
        float braw[4][4], biaw[4][4];
#pragma unroll
        for (int q = 0; q < 4; ++q)
#pragma unroll
            for (int ks = 0; ks < 4; ++ks) { const size_t bi = ((size_t)((l * 16 + g) * 64 + 16 * q + ln)) * 16 + 4 * kq + ks; braw[q][ks] = a->in[11][bi]; biaw[q][ks] = a->in[12][bi]; }
        bf16x8 cfrag[4]; float dsk = 0.f; unsigned short usk[16];
        if (PASS2) {
#pragma unroll
            for (int s4 = 0; s4 < 4; ++s4) { float cv[8];
#pragma unroll
                for (int j = 0; j < 8; ++j) { const int k = 32 * s4 + 8 * kq + j, pp = k & 63; const size_t ci = ((size_t)((l * 16 + g) * 16 + ln)) * 64 + pp; cv[j] = (s4 < 2) ? a->in[13][ci] : -a->in[14][ci]; }
                const v4u pk = {pk2(cv[0], cv[1]), pk2(cv[2], cv[3]), pk2(cv[4], cv[5]), pk2(cv[6], cv[7])}; cfrag[s4] = __builtin_bit_cast(bf16x8, pk); }
            dsk = a->in[15][l * 256 + g * 16 + ln];
#pragma unroll
            for (int i = 0; i < 16; ++i) usk[i] = PS[(tok_c + (i >> 2) * 16 + 4 * kq + (i & 3)) * 512 + 256 + g * 16 + ln];
        }
        const float dt = expf(ldt);
        float abr, abi, fr, fi;
        { const float xx = a_re * dt, yy = a_im * dt; const float ex = expf(xx); float sn, cs; sincosf(yy, &sn, &cs);
          abr = ex * cs; abi = ex * sn;
          const float sh = sinf(0.5f * yy); const float er = expm1f(xx) * cs - 2.f * sh * sh, ei = abi;
          const float den = a_re * a_re + a_im * a_im; fr = (er * a_re + ei * a_im) / den; fi = (ei * a_re - er * a_im) / den; }
        float bfrag[8][4];
#pragma unroll
        for (int q = 0; q < 4; ++q) { const float frq = __shfl(fr, 16 * q + ln), fiq = __shfl(fi, 16 * q + ln);
#pragma unroll
            for (int ks = 0; ks < 4; ++ks) { bfrag[q][ks] = frq * braw[q][ks] - fiq * biaw[q][ks]; bfrag[4 + q][ks] = frq * biaw[q][ks] + fiq * braw[q][ks]; } }
        float xr = 0.f, xi = 0.f;
        if (PASS2) {
            float pr = abr, pi = abi;
#pragma unroll
            for (int q = 0; q < 6; ++q) { const float nr = pr * pr - pi * pi, ni = 2.f * pr * pi; pr = nr; pi = ni; }
            const float* xl = XLOC + ((size_t)(b * 16 + g) * 64) * 128 + p;
            int j = 0;
#pragma unroll 1
            for (; j + 16 <= c; j += 16) { float lr[16], li[16];
#pragma unroll
                for (int q = 0; q < 16; ++q) { lr[q] = xl[(size_t)(j + q) * 128]; li[q] = xl[(size_t)(j + q) * 128 + 64]; }
#pragma unroll
                for (int q = 0; q < 16; ++q) { const float nr = pr * xr - pi * xi + lr[q], ni = pr * xi + pi * xr + li[q]; xr = nr; xi = ni; } }
            { float lr[16], li[16];
#pragma unroll
                for (int q = 0; q < 16; ++q) { const int jj = (j + q < c) ? j + q : 0; lr[q] = xl[(size_t)jj * 128]; li[q] = xl[(size_t)jj * 128 + 64]; }
#pragma unroll
                for (int q = 0; q < 16; ++q) if (j + q < c) { const float nr = pr * xr - pi * xi + lr[q], ni = pr * xi + pi * xr + li[q]; xr = nr; xi = ni; } }
        }
#pragma unroll
        for (int sub = 0; sub < 4; ++sub) {
            const size_t tokb = tok_c + sub * 16;
            const float ua[4] = {bflo(uraw[sub].x), bfhi(uraw[sub].x), bflo(uraw[sub].y), bfhi(uraw[sub].y)};
#pragma unroll
            for (int nb = 0; nb < 8; ++nb) { f32x4 acc = {0.f, 0.f, 0.f, 0.f};
#pragma unroll
                for (int ks = 0; ks < 4; ++ks) acc = __builtin_amdgcn_mfma_f32_16x16x4f32(ua[ks], bfrag[nb][ks], acc, 0, 0, 0);
#pragma unroll
                for (int r = 0; r < 4; ++r) Xs[(4 * kq + r) * XST + 16 * nb + ln] = acc[r]; }
            float bur[16], bui[16];
#pragma unroll
            for (int i = 0; i < 16; ++i) { bur[i] = Xs[i * XST + p]; bui[i] = Xs[i * XST + 64 + p]; }
#pragma unroll
            for (int i = 0; i < 16; ++i) { const float nr = abr * xr - abi * xi + bur[i], ni = abr * xi + abi * xr + bui[i]; xr = nr; xi = ni;
                if (PASS2) { Xs[i * XST + p] = xr; Xs[i * XST + 64 + p] = xi; } }
            if (PASS2) {
                f32x4 y0 = {0.f, 0.f, 0.f, 0.f};
                asm volatile("" ::: "memory");
#pragma unroll
                for (int s4 = 0; s4 < 4; ++s4) { const f32x4 x0 = *(const LAS f32x4*)(Xs + ln * XST + 32 * s4 + 8 * kq), x1 = *(const LAS f32x4*)(Xs + ln * XST + 32 * s4 + 8 * kq + 4);
                    const v4u pk = {pk2(x0[0], x0[1]), pk2(x0[2], x0[3]), pk2(x1[0], x1[1]), pk2(x1[2], x1[3])};
                    y0 = __builtin_amdgcn_mfma_f32_16x16x32_bf16(__builtin_bit_cast(bf16x8, pk), cfrag[s4], y0, 0, 0, 0); }
                asm volatile("" ::: "memory");
#pragma unroll
                for (int r = 0; r < 4; ++r) { const size_t tk = tokb + 4 * kq + r; const float uv = bf2f(usk[sub * 4 + r]);
                    const float y = y0[r] + dsk * uv; Z[tk * 256 + g * 16 + ln] = (bf16)f2bf(gelu_tanh(y)); }
            }
        }
        if (!PASS2) { float* xl = XLOC + ((size_t)((b * 16 + g) * 64 + c)) * 128 + p; xl[0] = xr; xl[64] = xi; }
    }
}

__device__ __forceinline__ void phase_glu(const bf16* Z, const bf16* WG, const float* gb, const float* ong, bf16* MG, LAS unsigned char* lds, int G, int bx, int vcu, int tid, int lane, int wave) {
    LAS unsigned char* zt = lds;
    LAS float* ssq = (LAS float*)(lds + 64 * 528);
    LAS float* rs = ssq + 64 * 8;
    const int n = 32 * wave + (lane & 31), hs = lane >> 5;
    const float bn = gb[n], gnn = ong[768 + n];
    for (int tile = bx; tile < NTOK / 64; tile += G) {
        const size_t tok0 = (size_t)tile * 64;
        for (int idx = tid; idx < 64 * 32; idx += NTHR) { const int r = idx >> 5, cq = idx & 31; *(LAS v4u*)(zt + r * 528 + cq * 16) = *(const v4u*)(Z + (tok0 + r) * 256 + cq * 8); }
        __syncthreads();
        f32x16 acc[2]; acc[0] = f32x16{}; acc[1] = f32x16{};
#pragma unroll
        for (int ks = 0; ks < 16; ++ks) { const bf16x8 bw = *(const bf16x8*)(WG + (size_t)n * 256 + ks * 16 + 8 * hs);
#pragma unroll
            for (int mb = 0; mb < 2; ++mb) { const bf16x8 az = *(const LAS bf16x8*)(zt + (mb * 32 + (lane & 31)) * 528 + (ks * 16 + 8 * hs) * 2);
                acc[mb] = __builtin_amdgcn_mfma_f32_32x32x16_bf16(az, bw, acc[mb], 0, 0, 0); } }
        float val[32], sq[32];
#pragma unroll
        for (int mb = 0; mb < 2; ++mb)
#pragma unroll
            for (int r = 0; r < 16; ++r) { const int m = mb * 32 + (r & 3) + 8 * (r >> 2) + 4 * hs; const float z = bf2f(*(const LAS unsigned short*)(zt + m * 528 + n * 2));
                const float v = z / (1.f + __expf(-(acc[mb][r] + bn))); val[mb * 16 + r] = v; sq[mb * 16 + r] = v * v; }
        const float tot = bfly_reduce<32, 16>(sq, lane);
        { const int id = lane & 31, mb = id >> 4, r = id & 15, m = mb * 32 + (r & 3) + 8 * (r >> 2) + 4 * hs; ssq[m * 8 + wave] = tot; }
        __syncthreads();
        if (tid < 64) { float s = 0.f;
#pragma unroll
            for (int w8 = 0; w8 < 8; ++w8) s += ssq[tid * 8 + w8];
            rs[tid] = 1.0f / sqrtf(s * (1.f / 256.f) + EPSN); }
        __syncthreads();
#pragma unroll
        for (int mb = 0; mb < 2; ++mb)
#pragma unroll
            for (int r = 0; r < 16; ++r) { const int m = mb * 32 + (r & 3) + 8 * (r >> 2) + 4 * hs;
                MG[(tok0 + m) * DM + 768 + n] = (bf16)f2bf(val[mb * 16 + r] * rs[m] * gnn); }
        __syncthreads();
    }
    const int gw = vcu * NWAVES + wave, NGW = G * NWAVES;
    float g8[8];
#pragma unroll
    for (int j = 0; j < 8; ++j) g8[j] = ong[8 * lane + j];
    for (int row = gw; row < NTOK; row += NGW) {
        bf16* pp = MG + (size_t)row * DM + 8 * lane;
        const v4u w = *(const v4u*)pp; float f[8] = {bflo(w.x), bfhi(w.x), bflo(w.y), bfhi(w.y), bflo(w.z), bfhi(w.z), bflo(w.w), bfhi(w.w)};
        float s = 0.f;
#pragma unroll
        for (int j = 0; j < 8; ++j) s += f[j] * f[j];
        const float rstd = 1.0f / sqrtf(wave_sum(s) * (1.f / 512.f) + EPSN);
        v4u o; o.x = pk2(f[0] * rstd * g8[0], f[1] * rstd * g8[1]); o.y = pk2(f[2] * rstd * g8[2], f[3] * rstd * g8[3]);
        o.z = pk2(f[4] * rstd * g8[4], f[5] * rstd * g8[5]); o.w = pk2(f[6] * rstd * g8[6], f[7] * rstd * g8[7]); *(v4u*)pp = o;
    }
}

__device__ __forceinline__ void ins16(float (&top)[16], float x) {
#pragma unroll
    for (int i = 15; i >= 1; --i) top[i] = __builtin_amdgcn_fmed3f(top[i - 1], top[i], x);
    top[0] = fmaxf(top[0], x);
}
__device__ __forceinline__ float opq(float x) { asm("" : "+v"(x)); return x; }
__device__ __forceinline__ float tagf(float s, unsigned id, unsigned mask) { return __uint_as_float((__float_as_uint(s) & ~mask) | id); }
__device__ __forceinline__ void phase_select(const bf16* PQ, const bf16* KEYS, int* IDX, float* GATE, LAS unsigned char* lds, int G, int vcu, int tid, int lane, int wave) {
    constexpr int KROW = 272, KEYB = 2 * 128 * KROW;
    LAS unsigned* ids = (LAS unsigned*)(lds + KEYB + wave * 4096);
    const int tl = lane & 31, hs = lane >> 5;
    const float NEG = -__builtin_inff();
    const int nslot = (G >= 8) ? G / 8 : 1;
    for (int h = vcu % 8; h < 8; h += (G >= 8 ? 8 : G)) {
        __syncthreads();
        for (int idx = tid; idx < 2 * 128 * 16; idx += NTHR) { const int row = idx >> 4, cq = idx & 15;
            *(LAS v4u*)(lds + row * KROW + cq * 16) = *(const v4u*)((const char*)(KEYS + (size_t)h * 256 * 128) + (unsigned)(row * 256 + cq * 16)); }
        __syncthreads();
        const int slot = (G >= 8) ? vcu / 8 : 0;
        bf16x8 bq[2][8];
        int tb = slot * 8 + wave;
        if (tb < NTOK / 32) {
#pragma unroll
            for (int ks = 0; ks < 8; ++ks) bq[0][ks] = *(const bf16x8*)(PQ + ((size_t)tb * 32 + tl) * PQW + h * 256 + 8 * hs + ks * 16);
        }
#pragma unroll 1
        for (; tb < NTOK / 32; tb += 8 * nslot) {
            const size_t tok = (size_t)tb * 32 + tl;
            float t1[16], t2[16];
#pragma unroll
            for (int half = 0; half < 2; ++half) {
                { const int ntb = (half == 0) ? tb : tb + 8 * nslot; const int ntbc = (ntb < NTOK / 32) ? ntb : tb;
                  const bf16* qn = PQ + ((size_t)ntbc * 32 + tl) * PQW + h * 256 + (half == 0 ? 128 : 0) + 8 * hs;
#pragma unroll
                  for (int ks = 0; ks < 8; ++ks) bq[half ^ 1][ks] = *(const bf16x8*)(qn + ks * 16); }
                f32x16 acc[4]; acc[0] = f32x16{}; acc[1] = f32x16{}; acc[2] = f32x16{}; acc[3] = f32x16{};
                const LAS unsigned char* kp = lds + (half * 128 + tl) * KROW + 16 * hs;
#pragma unroll
                for (int ks = 0; ks < 8; ++ks)
#pragma unroll
                    for (int kb = 0; kb < 4; ++kb) { const bf16x8 ak = *(const LAS bf16x8*)(kp + kb * 32 * KROW + ks * 32); acc[kb] = __builtin_amdgcn_mfma_f32_32x32x16_bf16(ak, bq[half][ks], acc[kb], 0, 0, 0); }
                float top[16];
#pragma unroll
                for (int i = 0; i < 16; ++i) top[i] = NEG;
#pragma unroll
                for (int kb = 0; kb < 4; ++kb)
#pragma unroll
                    for (int r = 0; r < 16; ++r) ins16(top, tagf(acc[kb][r], (unsigned)(32 * kb + (r & 3) + 8 * (r >> 2) + 4 * hs), 127u));
                float oth[16];
#pragma unroll
                for (int i = 0; i < 16; ++i) oth[i] = __shfl_xor(top[i], 32);
#pragma unroll
                for (int i = 0; i < 16; ++i) ins16(top, oth[i]);
#pragma unroll
                for (int i = 0; i < 16; ++i) { if (half == 0) t1[i] = top[i]; else t2[i] = top[i]; }
            }
#pragma unroll
            for (int i = 0; i < 16; ++i) ids[(tl * 2 + hs) * 16 + i] = __float_as_uint(hs ? opq(t2[i]) : opq(t1[i])) & 127u;
            float best[16];
#pragma unroll
            for (int i = 0; i < 16; ++i) best[i] = NEG;
#define CAND(a0, b0, a1, b1) { const float s0_ = opq(t1[a0] + t2[b0]), s1_ = opq(t1[a1] + t2[b1]); ins16(best, hs ? tagf(s1_, (unsigned)((a1) * 16 + (b1)), 255u) : tagf(s0_, (unsigned)((a0) * 16 + (b0)), 255u)); }
            CAND_LIST
#undef CAND
            { float oth[16];
#pragma unroll
              for (int i = 0; i < 16; ++i) oth[i] = __shfl_xor(best[i], 32);
#pragma unroll
              for (int i = 0; i < 16; ++i) ins16(best, oth[i]); }
            float e[16], den = 0.f;
#pragma unroll
            for (int i = 0; i < 16; ++i) { e[i] = __expf(best[i] - best[0]); den += e[i]; }
            const float rden = 1.f / den;
            int ex[8]; float gt[8];
#pragma unroll
            for (int j = 0; j < 8; ++j) { const float bj = hs ? opq(best[8 + j]) : opq(best[j]); const unsigned id = __float_as_uint(bj) & 255u;
                const unsigned i1 = ids[(tl * 2 + 0) * 16 + (id >> 4)], i2 = ids[(tl * 2 + 1) * 16 + (id & 15u)];
                ex[j] = (int)(i1 * 128u + i2); gt[j] = (hs ? opq(e[8 + j]) : opq(e[j])) * rden; }
            int* ip = IDX + tok * 128 + h * 16 + hs * 8; float* gp = GATE + tok * 128 + h * 16 + hs * 8;
            *(v4u*)ip = (v4u){(unsigned)ex[0], (unsigned)ex[1], (unsigned)ex[2], (unsigned)ex[3]}; *(v4u*)(ip + 4) = (v4u){(unsigned)ex[4], (unsigned)ex[5], (unsigned)ex[6], (unsigned)ex[7]};
            *(f32x4*)gp = (f32x4){gt[0], gt[1], gt[2], gt[3]}; *(f32x4*)(gp + 4) = (f32x4){gt[4], gt[5], gt[6], gt[7]};
        }
    }
}

constexpr int GCH = 64;
constexpr int CW_Q = 8192;
template <int CTRL> __device__ __forceinline__ float dpp_mov(float v) { return __builtin_bit_cast(float, __builtin_amdgcn_update_dpp(0, __builtin_bit_cast(int, v), CTRL, 0xF, 0xF, true)); }
__device__ __forceinline__ float sum8(float s) {
    s += dpp_mov<0xB1>(s); s += dpp_mov<0x4E>(s); s += dpp_mov<0x141>(s); return s;
}
__device__ __forceinline__ void phase_gather_u(const unsigned char* XN8, const int* IDX, const unsigned char* U, float* PART, unsigned* queue, int lane, unsigned imask = 0xffffffffu) {
    const unsigned xcc = xb_xcc_id() & 7u; const int g = lane >> 3, j = lane & 7;
#pragma unroll 1
    for (unsigned sx = 0; sx < 8; ++sx) { const unsigned x = (xcc + sx) & 7u; unsigned* q = queue + x * 64;
        const unsigned char* Ux = U + (size_t)x * NEXP * 128; const unsigned jo = (unsigned)j * 16u, lane4 = (unsigned)lane * 4u; const unsigned char* Hx = XN8 + x * 128 + j * 16; const int* Ig = IDX + 16 * g;
#pragma unroll 1
        for (;;) {
            unsigned c = 0; if (lane == 0) c = __hip_atomic_fetch_add(q, 1u, __ATOMIC_RELAXED, __HIP_MEMORY_SCOPE_AGENT);
            c = (unsigned)__builtin_amdgcn_readfirstlane((int)c); if (c >= (unsigned)(NTOK / GCH)) break;
            const size_t tb = (size_t)c * GCH;
            v4u ix[2][4], hw[2], rw[16];
#define G1_IDX(ib, tok_) do { _Pragma("unroll") for (int q4 = 0; q4 < 4; ++q4) ix[ib][q4] = *(const v4u*)(Ig + (tok_) * 128 + 4 * q4) & imask; } while (0)
#define G1_AUX(ab, tok_) do { hw[ab] = *(const v4u*)(Hx + (tok_) * DM); } while (0)
#define G1_TOKEN(p, tt_) do { G1_AUX((p) ^ 1, tb + (((tt_) + 1 < GCH) ? (tt_) + 1 : (tt_))); \
            const v4u hq_ = hw[p]; int r0 = 0, r1 = 0; \
            _Pragma("unroll") for (int i = 0; i < 16; ++i) { const v4u rv_ = rw[i]; \
                rw[i] = *(const v4u*)(Ux + (ix[(p) ^ 1][i >> 2][i & 3] * 128u + jo)); \
                int s = __builtin_amdgcn_sdot4((int)hq_[0], (int)rv_[0], 0, false); s = __builtin_amdgcn_sdot4((int)hq_[1], (int)rv_[1], s, false); \
                s = __builtin_amdgcn_sdot4((int)hq_[2], (int)rv_[2], s, false); s = __builtin_amdgcn_sdot4((int)hq_[3], (int)rv_[3], s, false); \
                s += __builtin_amdgcn_update_dpp(0, s, 0xB1, 0xF, 0xF, true); s += __builtin_amdgcn_update_dpp(0, s, 0x4E, 0xF, 0xF, true); s += __builtin_amdgcn_update_dpp(0, s, 0x141, 0xF, 0xF, true); \
                if (i < 8) r0 = ((i & 7) == j) ? s : r0; else r1 = ((i & 7) == j) ? s : r1; } \
            unsigned* pp = (unsigned*)PART + ((size_t)x * NTOK + tb + (tt_)) * 64; *(unsigned*)((char*)pp + lane4) = pk2((float)r0, (float)r1);     \
            G1_IDX(p, tb + (((tt_) + 2 < GCH) ? (tt_) + 2 : (tt_))); } while (0)
            G1_IDX(0, tb); G1_IDX(1, tb + 1); G1_AUX(0, tb);
#pragma unroll
            for (int i = 0; i < 16; ++i) rw[i] = *(const v4u*)(Ux + (ix[0][i >> 2][i & 3] * 128u + jo));
#pragma unroll 1
            for (int tt = 0; tt < GCH; tt += 2) { G1_TOKEN(0, tt); G1_TOKEN(1, tt + 1); }
#undef G1_IDX
#undef G1_AUX
#undef G1_TOKEN
        }
    }
}
__device__ __forceinline__ void phase_gather_act(const float* PART, const float* GATE, const float* HSC, float* ACT, int G, int vcu, int tid) {
    const size_t gt = (size_t)vcu * NTHR + tid, NGT = (size_t)G * NTHR;
    for (size_t e4 = gt; e4 < (size_t)NTOK * 32; e4 += NGT) { const size_t tok = e4 >> 5; const int p = (int)(e4 & 31) * 4;
        f32x4 s = {0.f, 0.f, 0.f, 0.f};
#pragma unroll
        for (int x = 0; x < 8; ++x) { const v4u w = *(const v4u*)((const unsigned*)PART + ((size_t)x * NTOK + tok) * 64 + (p & 63));
            if (p < 64) { s[0] += bflo(w.x); s[1] += bflo(w.y); s[2] += bflo(w.z); s[3] += bflo(w.w); } else { s[0] += bfhi(w.x); s[1] += bfhi(w.y); s[2] += bfhi(w.z); s[3] += bfhi(w.w); } }
        const int k = (p < 64) ? 16 * (p >> 3) + (p & 7) : 16 * ((p - 64) >> 3) + 8 + (p & 7);
        const f32x4 gv = *(const f32x4*)(GATE + tok * 128 + k);
        f32x4 o;
        const float ds = HSC[tok] * (1.f / U8_SCALE);
#pragma unroll
        for (int i = 0; i < 4; ++i) { const _Float16 ah = (_Float16)(gv[i] * gelu_tanh(s[i] * ds) * (ACT_SCALE / V8_SCALE)); const h16x2 a2 = {ah, ah}; o[i] = __builtin_bit_cast(float, a2); }
        *(f32x4*)(ACT + e4 * 4) = o; }
}
__device__ __forceinline__ void phase_gather_v(const float* ACT, const int* IDX, const unsigned char* V, float* out, unsigned* queue, int lane) {
    const unsigned xcc = xb_xcc_id() & 7u; const int g = lane >> 3, j = lane & 7;
    typedef float f32x2v __attribute__((ext_vector_type(2)));
#pragma unroll 1
    for (unsigned sx = 0; sx < 8; ++sx) { const unsigned x = (xcc + sx) & 7u; unsigned* q = queue + x * 64;
        const unsigned char* Vx = V + (size_t)x * NEXP * 128; const unsigned jo = (unsigned)j * 16u; const int* Ig = IDX + 16 * g; float* Ob = out + x * 128; const unsigned lo = (unsigned)(16 * j + 2 * g) * 4u;
#pragma unroll 1
        for (;;) {
            unsigned c = 0; if (lane == 0) c = __hip_atomic_fetch_add(q, 1u, __ATOMIC_RELAXED, __HIP_MEMORY_SCOPE_AGENT);
            c = (unsigned)__builtin_amdgcn_readfirstlane((int)c); if (c >= (unsigned)(NTOK / GCH)) break;
            const size_t tb = (size_t)c * GCH;
            v4u ix[2][4], rw[16]; float a0[2], a1[2]; f32x2v ov[2]; const int bsel = (lane & ~7) * 4; const unsigned lane4 = (unsigned)lane * 4u;
#define G3_IDX(ib, tok_) do { _Pragma("unroll") for (int q4 = 0; q4 < 4; ++q4) ix[ib][q4] = *(const v4u*)(Ig + (tok_) * 128 + 4 * q4); } while (0)
#define G3_AUX(ab, tok_) do { a0[ab] = *(const float*)((const char*)(ACT + (tok_) * 128) + lane4); a1[ab] = *(const float*)((const char*)(ACT + (tok_) * 128 + 64) + lane4); { unsigned lo_ = lo; asm volatile("" : "+v"(lo_)); ov[ab] = *(const f32x2v*)((const char*)(Ob + (tok_) * DM) + lo_); } } while (0)
#define G3_TOKEN(p, tt_) do { G3_AUX((p) ^ 1, tb + (((tt_) + 1 < GCH) ? (tt_) + 1 : (tt_))); \
            h16x2 hacc[8]; \
            _Pragma("unroll") for (int i = 0; i < 8; ++i) hacc[i] = (h16x2){(_Float16)0.f, (_Float16)0.f}; \
            _Pragma("unroll") for (int i = 0; i < 16; ++i) { const v4u rv_ = rw[i]; \
                rw[i] = *(const v4u*)(Vx + (ix[(p) ^ 1][i >> 2][i & 3] * 128u + jo)); \
                const float a = __builtin_bit_cast(float, __builtin_amdgcn_ds_bpermute(bsel + 4 * (i & 7), __builtin_bit_cast(int, (i < 8) ? a0[p] : a1[p])));   \
                const h16x2 a2 = __builtin_bit_cast(h16x2, a); \
                _Pragma("unroll") for (int q4 = 0; q4 < 4; ++q4) { const int w = (int)rv_[q4]; \
                    hacc[2 * q4] = __builtin_elementwise_fma(cvt8h<false>(w), a2, hacc[2 * q4]); \
                    hacc[2 * q4 + 1] = __builtin_elementwise_fma(cvt8h<true>(w), a2, hacc[2 * q4 + 1]); } } \
            float acc[16]; \
            _Pragma("unroll") for (int i = 0; i < 8; ++i) { acc[2 * i] = (float)hacc[i].x; acc[2 * i + 1] = (float)hacc[i].y; } \
            int s_ = 32; \
            _Pragma("unroll") for (int cnt = 16; cnt > 2; cnt >>= 1) { const bool up = (lane & s_) != 0; \
                _Pragma("unroll") for (int i = 0; i < cnt / 2; ++i) { const float a = acc[i], b = acc[i + cnt / 2]; const float send = up ? a : b, keep = up ? b : a; acc[i] = keep + __shfl_xor(send, s_); } \
                s_ >>= 1; } \
            f32x2v o = ov[p]; o[0] += acc[0] * (1.f / ACT_SCALE); o[1] += acc[1] * (1.f / ACT_SCALE); \
            { unsigned lo_ = lo; asm volatile("" : "+v"(lo_)); *(f32x2v*)((char*)(Ob + (tb + (tt_)) * DM) + lo_) = o; } \
            G3_IDX(p, tb + (((tt_) + 2 < GCH) ? (tt_) + 2 : (tt_))); } while (0)
            G3_IDX(0, tb); G3_IDX(1, tb + 1); G3_AUX(0, tb);
#pragma unroll
            for (int i = 0; i < 16; ++i) rw[i] = *(const v4u*)(Vx + (ix[0][i >> 2][i & 3] * 128u + jo));
#pragma unroll 1
            for (int tt = 0; tt < GCH; tt += 2) { G3_TOKEN(0, tt); G3_TOKEN(1, tt + 1); }
#undef G3_IDX
#undef G3_AUX
#undef G3_TOKEN
        }
    }
}

__device__ __forceinline__ void phase_gather_naive(const bf16* XN, const int* IDX, const float* GATE, const float* U, const float* V, float* out, int G, int vcu, int lane, int wave) {
    const int gw = vcu * NWAVES + wave, NGW = G * NWAVES;
    for (int tok = gw; tok < NTOK; tok += NGW) {
        float hv[16], acc[16];
#pragma unroll
        for (int j = 0; j < 16; ++j) { hv[j] = bf2f(XN[(size_t)tok * DM + lane + 64 * j]); acc[j] = 0.f; }
        for (int k = 0; k < 128; ++k) { const int e = IDX[(size_t)tok * 128 + k]; const float g = GATE[(size_t)tok * 128 + k];
            float s = 0.f;
#pragma unroll
            for (int j = 0; j < 16; ++j) s += hv[j] * U[(size_t)e * DM + lane + 64 * j];
            s = wave_sum(s); const float a = g * gelu_tanh(s);
#pragma unroll
            for (int j = 0; j < 16; ++j) acc[j] += a * V[(size_t)e * DM + lane + 64 * j]; }
#pragma unroll
        for (int j = 0; j < 16; ++j) out[(size_t)tok * DM + lane + 64 * j] += acc[j];
    }
}
constexpr int PH_PER_LAYER = 15, N_PHASES = 1 + 2 * PH_PER_LAYER;
__device__ __forceinline__ KArgs kargs() { KArgs p = (KArgs)__builtin_amdgcn_kernarg_segment_ptr(); asm volatile("" : "+s"(p)); return p; }
__global__ void __launch_bounds__(NTHR, 2) mega_fwd(Args a_unused) {
    extern __shared__ __attribute__((aligned(16))) unsigned char lds_raw[];
    LAS unsigned char* lds = (LAS unsigned char*)lds_raw;
    volatile LAS unsigned* MISC = (volatile LAS unsigned*)(lds + MISC_OFF);
    const int tid0 = threadIdx.x;
    for (int u = tid0; u < (LDS_BYTES - LDSCTL_OFF) / 4; u += NTHR) ((LAS unsigned*)(lds + LDSCTL_OFF))[u] = 0u;
    __syncthreads();
    { const unsigned hw = (unsigned)__builtin_amdgcn_s_getreg((6 << 11) | 4); if ((tid0 & 63) == 0) *(volatile LAS int*)(lds + OTID_LDS_OFF + 4 * (hw & 63u)) = tid0 >> 6; }
    __syncthreads();
    XcdBarrier bar; { KArgs ka = kargs(); unsigned char* ws0 = ka->ws; bar.bar = (unsigned*)(ws0 + WS_CTL) + CW_BAR; bar.x = 0; bar.st = nullptr;
      if (ka->use_bar) bar = xcd_barrier_post((unsigned*)(ws0 + WS_CTL) + CW_BAR, MISC + 8); }
    const int ph_lo = kargs()->ph_lo, ph_hi = kargs()->ph_hi;
#define TLW const int tid = otid(), lane = tid & 63, wave = __builtin_amdgcn_readfirstlane(tid >> 6); (void)tid; (void)lane; (void)wave;
#pragma unroll 1
    for (int pc = ph_lo; pc < ph_hi + (DUP_PH >= 0 ? 1 : 0); ++pc) {
        const int ph = (DUP_PH >= 0 && pc > DUP_PH) ? pc - 1 : pc;
        unsigned long long tph0_ = 0; if (TIME_PH >= 0 && (pc == TIME_PH || TIME_PH == 99)) tph0_ = __builtin_amdgcn_s_memrealtime();
        KArgs a = kargs(); unsigned char* ws = a->ws;
        int G = gridDim.x, bx = blockIdx.x; asm volatile("" : "+s"(G), "+s"(bx)); const int vcu = (G % 8 == 0) ? (bx % 8) * (G / 8) + bx / 8 : bx;
        bf16* const XN = (bf16*)(ws + WS_XN); bf16* const Pq = (bf16*)(ws + WS_P); bf16* const Pk = Pq + (size_t)NTOK * 512; bf16* const Pv = Pk + (size_t)NTOK * 512; bf16* const Ps = Pv + (size_t)NTOK * 512;
        bf16* const MG = (bf16*)(ws + WS_MG); float* const CB = (float*)(ws + WS_CB); float* const XLOC = (float*)(ws + WS_XLOC); bf16* const Z = (bf16*)(ws + WS_Z);
        int* const IDX = (int*)(ws + WS_IDX); float* const GATE = (float*)(ws + WS_GATE);
        if (ph == 0) { TLW if (PH_MASK & 1u) phase_prep(a, lds, G, vcu, tid, lane, wave); }
        else {
            const int l = (ph - 1) / PH_PER_LAYER, sub = (ph - 1) % PH_PER_LAYER;
            const float* xin = (l == 0) ? a->in[0] : a->out;
            switch (sub) {
            case 0: if (PH_MASK & (1u << 1)) { TLW phase_rownorm<true>(xin, a->in[1] + l * DM, XN, (const float*)(ws + WS_WF) + l * 8 * 1024, a->in[3] + l * 8, CB, G, vcu, lane, wave); } break;
            case 1: if (PH_MASK & (1u << 2)) { TLW
                { float* CBm = CB; const int gw_ = vcu * NWAVES + wave; if (gw_ < NB * NH) phase_cumsum(CBm + (size_t)gw_ * SEQ, lane); }
                pg8::Gemm g{XN, (const bf16*)(ws + WS_WIN) + (size_t)l * 2048 * 1024, NTOK, 2048, 1024}; pg8::StaticOrder S; S.init(NTOK, 2048, G, bx);
                pg8::EpiQKVN E{Pq, (size_t)NTOK * 512, a->in[4] + l * 64, a->in[5] + l * 64, (PG8_LAS float*)(lds + EPIX_OFF), EPSN, 0.125f * LOG2E};
                pg8::gemm_phase<pg8::EpiQKVN, pg8::StaticOrder, true, true>(lds, g, S, E); } break;
            case 2: break;
            case 5: if (PH_MASK & (1u << 4)) { TLW { const float gq = wave_max(fabsf(a->in[4][l * 64 + lane])), gk = wave_max(fabsf(a->in[5][l * 64 + lane]));
                const float qkb = 8.f * gq * gk * LOG2E * 1.02f + 0.25f;
                const attn_body::AttnTensors AT{(const attn_body::bf16*)Pq, (const attn_body::bf16*)Pk, (const attn_body::bf16*)Pv, (attn_body::bf16*)MG, CB, qkb};
                attn_body::attn_phase_q<ATT_SKIP>((char*)lds_raw, AT, (unsigned*)(ws + WS_CTL) + CW_AQ + l * 512); } } break;
            case 3: if (PH_MASK & (1u << 5)) { TLW phase_pool(Ps, a->in[6] + (size_t)l * 4 * 64 * 64, a->in[7] + l * 256, a->in[18] + l * DM, MG, lds, G, bx, tid, lane, wave); } break;
            case 4: if (PH_MASK & (1u << 6)) { TLW phase_s5<false>(a, l, Ps, XLOC, Z, lds, G, bx, lane, wave); } break;
            case 6: if (PH_MASK & (1u << 7)) { TLW phase_s5<true>(a, l, Ps, XLOC, Z, lds, G, bx, lane, wave); } break;
            case 7: if (PH_MASK & (1u << 8)) { TLW phase_glu(Z, (const bf16*)(ws + WS_WGLU) + (size_t)l * 256 * 256, a->in[17] + l * 256, a->in[18] + l * DM, MG, lds, G, bx, vcu, tid, lane, wave); } break;
            case 8: if (PH_MASK & (1u << 9)) { pg8::Gemm g{MG, (const bf16*)(ws + WS_WOUT) + (size_t)l * 1024 * 1024, NTOK, 1024, 1024}; pg8::StaticOrder S; S.init(NTOK, 1024, G, bx);
                pg8::EpiResF32 E{xin, a->out, DM};
                pg8::gemm_phase<pg8::EpiResF32, pg8::StaticOrder, true, true>(lds, g, S, E); } break;
            case 9: if (PH_MASK & (1u << 10)) { TLW phase_rownorm<false>(a->out, a->in[20] + l * DM, XN, nullptr, nullptr, nullptr, G, vcu, lane, wave, ws + WS_XN8, (float*)(ws + WS_HSC)); } break;
            case 10: if (PH_MASK & (1u << 11)) { pg8::Gemm g{XN, (const bf16*)(ws + WS_WQ) + (size_t)l * 2048 * 1024, NTOK, 2048, 1024}; pg8::StaticOrder S; S.init(NTOK, 2048, G, bx);
                pg8::EpiBf16<0> E{Pq, PQW, nullptr, 0, 0, 1.f};
                pg8::gemm_phase<pg8::EpiBf16<0>, pg8::StaticOrder, true, true>(lds, g, S, E); } break;
            case 11: if (PH_MASK & (1u << 12)) { TLW phase_select(Pq, (const bf16*)(ws + WS_KEYS) + (size_t)l * 8 * 2 * 128 * 128, IDX, GATE, lds, G, vcu, tid, lane, wave); } break;
            case 12: if (PH_MASK & (1u << 13)) { TLW phase_gather_u(ws + WS_XN8, IDX, (const unsigned char*)(ws + WS_U) + (size_t)l * NEXP * DM, (float*)(ws + WS_P), (unsigned*)(ws + WS_CTL) + CW_Q + (l * 2 + 0) * 512 + ((DUP_PH >= 0 && pc == DUP_PH + 1) ? 4096 : 0), lane, (DUP_PH >= 0 && pc == DUP_PH) ? DIAG_IMASK : 0xffffffffu); } break;
            case 13: if (PH_MASK & (1u << 14)) { TLW phase_gather_act((const float*)(ws + WS_P), GATE, (const float*)(ws + WS_HSC), (float*)(ws + WS_Z), G, vcu, tid); } break;
            default: if (PH_MASK & (1u << 15)) { TLW phase_gather_v((const float*)(ws + WS_Z), IDX, (const unsigned char*)(ws + WS_V) + (size_t)l * NEXP * DM, a->out, (unsigned*)(ws + WS_CTL) + CW_Q + (l * 2 + 1) * 512, lane); } break;
            }
        }
        const int subb_ = (ph >= 1) ? (ph - 1) % PH_PER_LAYER : -1;
        if (pc + 1 < ph_hi + (DUP_PH >= 0 ? 1 : 0) && (MK_ONE_LAUNCH == 0 || (subb_ != 2 && subb_ != 3 && subb_ != 4))) { XcdBarrier b2 = bar; asm volatile("" : "+s"(b2.bar)); xcd_barrier(b2);
            if (TIME_PH >= 0 && (pc == TIME_PH || TIME_PH == 99)) { const unsigned long long t1_ = __builtin_amdgcn_s_memrealtime(), te_ = t1_ + TIME_MUL * (t1_ - tph0_); while (__builtin_amdgcn_s_memrealtime() < te_) __builtin_amdgcn_s_sleep(8); } }
    }
}

extern "C" void kernel_launch(void* const* d_in, const int* in_sizes, int n_in, void* d_out, int out_size, void* d_ws, size_t ws_size, hipStream_t stream) {
    static int grid = 0;
    if (grid == 0) {
        if (n_in != 25 || in_sizes[0] != NTOK * DM || out_size != NTOK * DM || ws_size < WS_END) {
            fprintf(stderr, "kernel_launch: unexpected problem: n_in %d in0 %d out %d ws %zu (need %zu); nothing launched\n", n_in, n_in > 0 ? in_sizes[0] : -1, out_size, ws_size, (size_t)WS_END); grid = -1; return; }
        int dev = 0, cus = 0;
        if (hipGetDevice(&dev) != hipSuccess || hipDeviceGetAttribute(&cus, hipDeviceAttributeMultiprocessorCount, dev) != hipSuccess) { fprintf(stderr, "kernel_launch: device query failed\n"); grid = -1; return; }
        if (hipFuncSetAttribute((const void*)mega_fwd, hipFuncAttributeMaxDynamicSharedMemorySize, LDS_BYTES) != hipSuccess) { fprintf(stderr, "kernel_launch: hipFuncSetAttribute failed\n"); grid = -1; return; }
        (void)hipGetLastError();
        grid = cus;
    }
    if (grid < 0) return;
    (void)hipMemsetAsync((char*)d_ws + WS_CTL, 0, CTL_ZERO_BYTES, stream);
    Args a{};
    for (int i = 0; i < 25; ++i) a.in[i] = (const float*)d_in[i];
    a.out = (float*)d_out; a.ws = (unsigned char*)d_ws;
#if MK_ONE_LAUNCH
    a.ph_lo = 0; a.ph_hi = N_PHASES; a.use_bar = 1;
    hipLaunchKernelGGL(mega_fwd, dim3(grid), dim3(NTHR), LDS_BYTES, stream, a);
#else
    for (int ph = 0; ph < N_PHASES; ++ph) { a.ph_lo = ph; a.ph_hi = ph + 1; a.use_bar = 0;
        hipLaunchKernelGGL(mega_fwd, dim3(grid), dim3(NTHR), LDS_BYTES, stream, a); }
#endif
    const hipError_t le = hipPeekAtLastError();
    if (le != hipSuccess) fprintf(stderr, "kernel_launch: launch failed: %s\n", hipGetErrorName(le));
}
```

```cpp
#include <hip/hip_runtime.h>
#include <hip/hip_bf16.h>
#include <hip/hip_fp16.h>
#include <cstdio>
#include <cstdint>
#include <cmath>
#ifndef MK_ONE_LAUNCH
#define MK_ONE_LAUNCH 1
#endif
#ifndef ATT_SKIP
#define ATT_SKIP true
#endif
#ifndef PH_MASK
#define PH_MASK 0xffffffffu
#endif
#define OTID_LDS_OFF (131072 + 1024)
__device__ __forceinline__ int otid() {
    int z = 0; asm volatile("" : "+v"(z)); const int lane = __builtin_amdgcn_mbcnt_hi(-1, __builtin_amdgcn_mbcnt_lo(-1, z));
    const unsigned hw = (unsigned)__builtin_amdgcn_s_getreg((6 << 11) | 4);
    const int wv = *(const volatile __attribute__((address_space(3))) int*)(OTID_LDS_OFF + 4 * (hw & 63u));
    return (__builtin_amdgcn_readfirstlane(wv) << 6) | lane;
}
#ifndef GATHER_NAIVE
#define GATHER_NAIVE 0
#endif
#ifndef DUP_PH
#define DUP_PH (-1)
#endif
#ifndef TIME_PH
#define TIME_PH (-1)
#define TIME_MUL 3
#endif
#ifndef DIAG_IMASK
#define DIAG_IMASK 0xffu
#endif
#ifndef S5_CPROJ_F32
#define S5_CPROJ_F32 1
#endif
namespace pg8 {
#define PG8_LAS __attribute__((address_space(3)))
typedef unsigned short bf16_t;
typedef short bf16x8 __attribute__((ext_vector_type(8)));
typedef float f32x4 __attribute__((ext_vector_type(4)));
typedef unsigned u32x4 __attribute__((ext_vector_type(4)));
constexpr int BM = 256, BK = 64, HALF = 128, HTB = HALF * BK * 2  , STAGE_BYTES = 8 * HTB, NXCD = 8, WGM = 8;

__host__ __device__ __forceinline__ int lds_byte(int r, int c) { const int st = (r >> 4) * 2 + (c >> 5), rr = r & 15, cc = c & 31, ob = rr * 64 + cc * 2; return st * 1024 + (ob ^ (((ob >> 9) & 1) << 5)); }
__host__ __device__ __forceinline__ void stage_rc(int b, int& R, int& C) { const int st = b / 1024, sb = b % 1024, swz = sb ^ (((sb >> 9) & 1) << 5); R = (st >> 1) * 16 + swz / 64; C = (st & 1) * 32 + (swz % 64) / 2; }
__host__ __device__ __forceinline__ int perm32(int rho) { const int n = rho >> 4, i = rho & 15; return 8 * (i >> 2) + 4 * n + (i & 3); }

struct Unit { int pm, pn; };
struct Gemm { const bf16_t* A; const bf16_t* Bt; int M, N, K; };

struct StaticOrder {
    int nM, nN, nwg, G, c;
    __host__ __device__ void init(int M, int N, int G_, int c_) { nM = M / BM; nN = N / BM; nwg = nM * nN; G = G_; c = c_; }
    __host__ __device__ bool next(int i, Unit& u) const {
        const long L = (long)i * G + c; if (L >= nwg) return false;
        int wgid = (int)L; { const int q = nwg / NXCD, r = nwg % NXCD, xcd = wgid % NXCD, off = wgid / NXCD; wgid = (xcd < r ? xcd * (q + 1) : r * (q + 1) + (xcd - r) * q) + off; }
        const int nig = WGM * nN, gid = wgid / nig, fm = gid * WGM, gsz = (nM - fm) < WGM ? (nM - fm) : WGM;
        u.pm = fm + ((wgid % nig) % gsz); u.pn = (wgid % nig) / gsz; return true;
    }
    __device__ __forceinline__ void a_ready(const Unit&) const {}
    __device__ __forceinline__ void done(const Unit&) const {}
};

__device__ __forceinline__ unsigned cvt_pk_bf16(float lo, float hi) { unsigned r; asm volatile("v_cvt_pk_bf16_f32 %0, %1, %2" : "=v"(r) : "v"(lo), "v"(hi)); return r; }
typedef float f32x2 __attribute__((ext_vector_type(2)));
__device__ __forceinline__ f32x2 gelu_pk(f32x2 v) {
    const f32x2 av = __builtin_elementwise_abs(v), d = av * 0.2316418882f + 1.0f;
    f32x2 t; t.x = __builtin_amdgcn_rcpf(d.x); t.y = __builtin_amdgcn_rcpf(d.y);
    f32x2 q = t * 0.5307027145f + (-0.7265760135f); q = q * t + 0.7107068705f; q = q * t + (-0.142248368f); q = q * t + 0.127414796f; q = q * t;
    const f32x2 s = (v * v) * (-0.72134752044f);
    f32x2 e; e.x = __builtin_amdgcn_exp2f(s.x); e.y = __builtin_amdgcn_exp2f(s.y);
    const f32x2 m = v * (q * e), r = v - m;
    f32x2 o; o.x = v.x < 0.f ? m.x : r.x; o.y = v.y < 0.f ? m.y : r.y; return o;
}

template <int ACT  > struct EpiBf16 {
    static constexpr bool PERM = true, AFTER_DRAIN = false; static_assert(ACT == 0 || ACT == 1, "EpiBf16: ACT is 0 (none) or 1 (gelu_pk)");
    bf16_t* O; int ldc; const float* bias; int split_cols; size_t split_stride; float scale0;
    __device__ __forceinline__ void operator()(const f32x4 (&acc)[2][2][4][2], const Unit& u, int wr, int wc, int fr, int fq) const {
        const int row0 = u.pm * BM + wr * 64 + fr; int colt = u.pn * BM; bf16_t* base = O;
        float sc = 1.f; if (split_cols) { const int t = colt / split_cols; base += (size_t)t * split_stride; colt -= t * split_cols; if (t == 0) sc = scale0; }
        const int col0 = colt + wc * 32 + 8 * fq, bcol0 = u.pn * BM + wc * 32 + 8 * fq;
        f32x4 bv[2][2];
#pragma unroll
        for (int bj = 0; bj < 2; ++bj)
#pragma unroll
            for (int n = 0; n < 2; ++n) bv[bj][n] = bias ? *(const f32x4*)(bias + bcol0 + bj * HALF + 4 * n) : (f32x4){0.f, 0.f, 0.f, 0.f};
#pragma unroll
        for (int ai = 0; ai < 2; ++ai)
#pragma unroll
            for (int m = 0; m < 4; ++m) { bf16_t* rowp = base + (size_t)(row0 + ai * HALF + m * 16) * ldc + col0;
#pragma unroll
                for (int bj = 0; bj < 2; ++bj) { f32x4 v0 = acc[ai][bj][m][0] + bv[bj][0], v1 = acc[ai][bj][m][1] + bv[bj][1];
                    if (ACT == 1) { f32x2 a = gelu_pk((f32x2){v0[0], v0[1]}), b = gelu_pk((f32x2){v0[2], v0[3]}), c = gelu_pk((f32x2){v1[0], v1[1]}), d = gelu_pk((f32x2){v1[2], v1[3]});
                        v0 = (f32x4){a.x, a.y, b.x, b.y}; v1 = (f32x4){c.x, c.y, d.x, d.y}; }
                    v0 = v0 * sc; v1 = v1 * sc; u32x4 w; w.x = cvt_pk_bf16(v0[0], v0[1]); w.y = cvt_pk_bf16(v0[2], v0[3]); w.z = cvt_pk_bf16(v1[0], v1[1]); w.w = cvt_pk_bf16(v1[2], v1[3]);
                    *(u32x4*)(rowp + bj * HALF) = w; } }
    }
};
struct EpiResF32 {
    static constexpr bool PERM = false, AFTER_DRAIN = false;
    const float* base; float* out; int ldc;
    __device__ __forceinline__ void operator()(const f32x4 (&acc)[2][2][4][2], const Unit& u, int wr, int wc, int fr, int fq) const {
        const int col0 = u.pn * BM + wc * 32 + 4 * fq;
#pragma unroll
        for (int ai = 0; ai < 2; ++ai)
#pragma unroll
            for (int m = 0; m < 4; ++m) { const size_t off = (size_t)(u.pm * BM + ai * HALF + wr * 64 + m * 16 + fr) * ldc + col0;
#pragma unroll
                for (int bj = 0; bj < 2; ++bj)
#pragma unroll
                    for (int n = 0; n < 2; ++n) { const f32x4 bs = *(const f32x4*)(base + off + bj * HALF + n * 16); *(f32x4*)(out + off + bj * HALF + n * 16) = bs + acc[ai][bj][m][n]; } }
    }
};

struct EpiQKVN {
    static constexpr bool PERM = true, AFTER_DRAIN = false;
    bf16_t* O; size_t split_stride; const float* qg; const float* kg; PG8_LAS float* ex; float eps, qscale;
    __device__ __forceinline__ void operator()(const f32x4 (&acc)[2][2][4][2], const Unit& u, int wr, int wc, int fr, int fq) const {
        const int t = u.pn >> 1, row0 = u.pm * BM + wr * 64 + fr, col0 = (u.pn & 1) * BM + wc * 32 + 8 * fq; bf16_t* base = O + (size_t)t * split_stride;
        float rs[2][4][2];
        f32x4 g0 = {1.f, 1.f, 1.f, 1.f}, g1 = {1.f, 1.f, 1.f, 1.f};
        if (t < 2) {
            int wid = wr * 4 + wc, fro = fr; asm volatile("" : "+v"(fro), "+s"(wid));
#pragma unroll
            for (int ai = 0; ai < 2; ++ai)
#pragma unroll
                for (int m = 0; m < 4; ++m)
#pragma unroll
                    for (int bj = 0; bj < 2; ++bj) { const f32x4 a0 = acc[ai][bj][m][0], a1 = acc[ai][bj][m][1];
                        float s = (a0[0] * a0[0] + a0[1] * a0[1]) + (a0[2] * a0[2] + a0[3] * a0[3]) + (a1[0] * a1[0] + a1[1] * a1[1]) + (a1[2] * a1[2] + a1[3] * a1[3]);
                        s += __shfl_xor(s, 16); s += __shfl_xor(s, 32);
                        if (fq == 0) ex[(((wid * 2 + ai) * 4 + m) * 2 + bj) * 16 + fro] = s; }
            asm volatile("s_waitcnt lgkmcnt(0)\n\ts_barrier" ::: "memory");
            const float* gp = (t == 0 ? qg : kg) + 32 * (wc & 1) + 8 * fq; const float gs = (t == 0) ? qscale : 1.f;
            g0 = *(const f32x4*)gp * gs; g1 = *(const f32x4*)(gp + 4) * gs;
#pragma unroll
            for (int ai = 0; ai < 2; ++ai)
#pragma unroll
                for (int m = 0; m < 4; ++m)
#pragma unroll
                    for (int bj = 0; bj < 2; ++bj) { const float so = ex[(((wid * 2 + ai) * 4 + m) * 2 + bj) * 16 + fro], sp = ex[((((wid ^ 1) * 2 + ai) * 4 + m) * 2 + bj) * 16 + fro]; rs[ai][m][bj] = 1.0f / sqrtf((so + sp) * (1.f / 64.f) + eps); }
        }
#pragma unroll
        for (int ai = 0; ai < 2; ++ai)
#pragma unroll
            for (int m = 0; m < 4; ++m) { bf16_t* rowp = base + (size_t)(row0 + ai * HALF + m * 16) * 512 + col0;
#pragma unroll
                for (int bj = 0; bj < 2; ++bj) { f32x4 v0 = acc[ai][bj][m][0], v1 = acc[ai][bj][m][1];
                    if (t < 2) { const float r = rs[ai][m][bj]; v0 = v0 * r * g0; v1 = v1 * r * g1; }
                    u32x4 w; w.x = cvt_pk_bf16(v0[0], v0[1]); w.y = cvt_pk_bf16(v0[2], v0[3]); w.z = cvt_pk_bf16(v1[0], v1[1]); w.w = cvt_pk_bf16(v1[2], v1[3]);
                    *(u32x4*)(rowp + bj * HALF) = w; } }
    }
};
template <class Epi, class Sched, bool ALIGN_EPI = false, bool SP2 = false>
__device__ __forceinline__ void gemm_phase(PG8_LAS unsigned char* lds, const Gemm g, const Sched& S, const Epi& E) {
    const int tid = otid(), wid = __builtin_amdgcn_readfirstlane(tid >> 6), lane = tid & 63, wr = wid >> 2, wc = wid & 3, fr = lane & 15, fq = lane >> 4;
    const int K = g.K, nt = K / BK;
    unsigned voffA[2], voffB[2];
#pragma unroll
    for (int i = 0; i < 2; ++i) { int R, C; stage_rc(tid * 16 + i * 8192, R, C); const int Rb = Epi::PERM ? ((R & ~31) + perm32(R & 31)) : R;
        voffA[i] = (unsigned)(R * K + C) * 2u; voffB[i] = (unsigned)(Rb * K + C) * 2u; }
    const size_t kstep = (size_t)(BK * 2);
    const size_t hstep = (size_t)HALF * K * 2;
    const size_t tstep = 2 * hstep;
    const unsigned ldsw = (unsigned)wid * 1024u;
    const int aoff = lds_byte(wr * 64 + fr, fq * 8), boff = lds_byte(wc * 32 + fr, fq * 8);
#define PG8_SA(b, h) (((b) * 2 + (h)) * HTB)
#define PG8_SB(b, h) ((4 + (b) * 2 + (h)) * HTB)
#define PG8_STAGE(bufoff, gbase, voff) do { _Pragma("unroll") for (int _i = 0; _i < 2; ++_i) \
        __builtin_amdgcn_global_load_lds((const unsigned*)((const char*)(gbase) + (voff)[_i]), (PG8_LAS unsigned*)(lds + (bufoff) + ldsw + _i * 8192), 16, 0, 0); } while (0)
#define PG8_LDA(dst, b, h) do { _Pragma("unroll") for (int m = 0; m < 4; ++m) _Pragma("unroll") for (int k = 0; k < 2; ++k) dst[m][k] = *(const PG8_LAS bf16x8*)(lds + PG8_SA(b, h) + aoff + m * 2048 + k * 1024); } while (0)
#define PG8_LDB(dst, b, h) do { _Pragma("unroll") for (int n = 0; n < 2; ++n) _Pragma("unroll") for (int k = 0; k < 2; ++k) dst[n][k] = *(const PG8_LAS bf16x8*)(lds + PG8_SB(b, h) + boff + n * 2048 + k * 1024); } while (0)
#define PG8_MMA(ai, bj, At, Bt) do { __builtin_amdgcn_s_setprio(1); _Pragma("unroll") for (int m = 0; m < 4; ++m) _Pragma("unroll") for (int n = 0; n < 2; ++n) _Pragma("unroll") for (int k = 0; k < 2; ++k) \
        acc[ai][bj][m][n] = __builtin_amdgcn_mfma_f32_16x16x32_bf16(Bt[n][k], At[m][k], acc[ai][bj][m][n], 0, 0, 0); __builtin_amdgcn_s_setprio(0); } while (0)
#define PG8_WAIT_V(n) asm volatile("s_waitcnt vmcnt(" #n ")" ::: "memory")
#define PG8_WAIT_L(n) asm volatile("s_waitcnt lgkmcnt(" #n ")" ::: "memory")
#define PG8_BAR __builtin_amdgcn_s_barrier()
#define PG8_SCHED __builtin_amdgcn_sched_barrier(0)
    Unit cur, nxt; int ui = 0;
    if (!S.next(0, cur)) return;
    f32x4 acc[2][2][4][2];
#pragma unroll
    for (int a = 0; a < 2; ++a)
#pragma unroll
        for (int b = 0; b < 2; ++b)
#pragma unroll
            for (int m = 0; m < 4; ++m)
#pragma unroll
                for (int n = 0; n < 2; ++n) acc[a][b][m][n] = (f32x4){0.f, 0.f, 0.f, 0.f};
    bf16x8 At[4][2], B0[2][2], B1[2][2];
    const char* cA = (const char*)g.A + (size_t)cur.pm * tstep; const char* cB = (const char*)g.Bt + (size_t)cur.pn * tstep;
    S.a_ready(cur);
    if constexpr (SP2) {
        PG8_STAGE(PG8_SB(0, 0), cB, voffB); PG8_STAGE(PG8_SB(0, 1), cB + hstep, voffB); PG8_STAGE(PG8_SA(0, 0), cA, voffA); PG8_STAGE(PG8_SA(0, 1), cA + hstep, voffA);
        if (wr == 1) PG8_BAR;
        PG8_WAIT_V(2); PG8_BAR;
        PG8_STAGE(PG8_SB(1, 0), cB + kstep, voffB); PG8_STAGE(PG8_SA(1, 0), cA + kstep, voffA); PG8_STAGE(PG8_SB(1, 1), cB + hstep + kstep, voffB);
        PG8_WAIT_V(6); PG8_BAR;
    } else {
        PG8_STAGE(PG8_SB(0, 0), cB, voffB); PG8_STAGE(PG8_SA(0, 0), cA, voffA); PG8_STAGE(PG8_SB(0, 1), cB + hstep, voffB); PG8_STAGE(PG8_SA(0, 1), cA + hstep, voffA);
        if (wr == 1) PG8_BAR;
        PG8_WAIT_V(4); PG8_BAR;
        PG8_STAGE(PG8_SB(1, 0), cB + kstep, voffB); PG8_STAGE(PG8_SA(1, 0), cA + kstep, voffA); PG8_STAGE(PG8_SB(1, 1), cB + hstep + kstep, voffB);
        PG8_WAIT_V(6); PG8_BAR;
    }
    for (;;) {
        const bool has_next = S.next(ui + 1, nxt);
        const char* nA = has_next ? (const char*)g.A + (size_t)nxt.pm * tstep : cA; const char* nB = has_next ? (const char*)g.Bt + (size_t)nxt.pn * tstep : cB;
        for (int t = 0; t < nt; t += 2) {
            const bool last = (t == nt - 2);
            const char* a1 = cA + (size_t)(t + 1) * kstep;
            const char* a2 = last ? nA : cA + (size_t)(t + 2) * kstep; const char* b2 = last ? nB : cB + (size_t)(t + 2) * kstep;
            const char* a3 = a2 + kstep; const char* b3 = b2 + kstep;
            if (last && has_next) S.a_ready(nxt);
            if constexpr (SP2) {
            PG8_LDB(B0, 0, 0); PG8_LDB(B1, 0, 1); PG8_SCHED; PG8_LDA(At, 0, 0); PG8_STAGE(PG8_SA(1, 1), a1 + hstep, voffA);
            PG8_WAIT_V(8); PG8_WAIT_L(0); PG8_BAR; PG8_MMA(0, 0, At, B0); PG8_MMA(0, 1, At, B1); PG8_BAR; PG8_SCHED;
            PG8_LDA(At, 0, 1); PG8_STAGE(PG8_SB(0, 0), b2, voffB); PG8_STAGE(PG8_SB(0, 1), b2 + hstep, voffB); PG8_STAGE(PG8_SA(0, 0), a2, voffA);
            PG8_WAIT_V(8); PG8_WAIT_L(0); PG8_BAR; PG8_MMA(1, 0, At, B0); PG8_MMA(1, 1, At, B1); PG8_BAR; PG8_SCHED;
            PG8_LDB(B0, 1, 0); PG8_LDB(B1, 1, 1); PG8_SCHED; PG8_LDA(At, 1, 0); PG8_STAGE(PG8_SA(0, 1), a2 + hstep, voffA);
            PG8_WAIT_V(8); PG8_WAIT_L(0); PG8_BAR; PG8_MMA(0, 0, At, B0); PG8_MMA(0, 1, At, B1); PG8_BAR; PG8_SCHED;
            PG8_LDA(At, 1, 1); PG8_STAGE(PG8_SB(1, 0), b3, voffB); PG8_STAGE(PG8_SB(1, 1), b3 + hstep, voffB); PG8_STAGE(PG8_SA(1, 0), a3, voffA);
            PG8_WAIT_V(8); PG8_WAIT_L(0); PG8_BAR; PG8_MMA(1, 0, At, B0); PG8_MMA(1, 1, At, B1); PG8_BAR; PG8_SCHED;
            } else {
            PG8_LDB(B0, 0, 0); PG8_SCHED; PG8_LDA(At, 0, 0); PG8_STAGE(PG8_SA(1, 1), a1 + hstep, voffA);
            PG8_WAIT_L(8); PG8_BAR; PG8_WAIT_L(0); PG8_MMA(0, 0, At, B0); PG8_BAR; PG8_SCHED;
            PG8_LDB(B1, 0, 1); PG8_STAGE(PG8_SB(0, 0), b2, voffB);
            PG8_BAR; PG8_WAIT_L(0); PG8_MMA(0, 1, At, B1); PG8_BAR;
            PG8_LDA(At, 0, 1); PG8_STAGE(PG8_SA(0, 0), a2, voffA);
            PG8_BAR; PG8_WAIT_L(0); PG8_MMA(1, 0, At, B0); PG8_BAR; PG8_SCHED;
            PG8_STAGE(PG8_SB(0, 1), b2 + hstep, voffB);
            PG8_WAIT_V(6); PG8_BAR; PG8_MMA(1, 1, At, B1); PG8_BAR;
            PG8_LDB(B0, 1, 0); PG8_SCHED; PG8_LDA(At, 1, 0); PG8_STAGE(PG8_SA(0, 1), a2 + hstep, voffA);
            PG8_WAIT_L(8); PG8_BAR; PG8_WAIT_L(0); PG8_MMA(0, 0, At, B0); PG8_BAR; PG8_SCHED;
            PG8_LDB(B1, 1, 1); PG8_STAGE(PG8_SB(1, 0), b3, voffB);
            PG8_BAR; PG8_WAIT_L(0); PG8_MMA(0, 1, At, B1); PG8_BAR;
            PG8_LDA(At, 1, 1); PG8_STAGE(PG8_SA(1, 0), a3, voffA);
            PG8_BAR; PG8_WAIT_L(0); PG8_MMA(1, 0, At, B0); PG8_BAR; PG8_SCHED;
            PG8_STAGE(PG8_SB(1, 1), b3 + hstep, voffB);
            PG8_WAIT_V(6); PG8_BAR; PG8_MMA(1, 1, At, B1); PG8_BAR;
            }
        }
        if constexpr (ALIGN_EPI) { if (wr == 0) PG8_BAR; }
        if constexpr (!Epi::AFTER_DRAIN) { E(acc, cur, wr, wc, fr, fq); S.done(cur); }
        if (!has_next) break;
#pragma unroll
        for (int a = 0; a < 2; ++a)
#pragma unroll
            for (int b = 0; b < 2; ++b)
#pragma unroll
                for (int m = 0; m < 4; ++m)
#pragma unroll
                    for (int n = 0; n < 2; ++n) acc[a][b][m][n] = (f32x4){0.f, 0.f, 0.f, 0.f};
        cur = nxt; cA = nA; cB = nB; ++ui;
        if constexpr (ALIGN_EPI) { if (wr == 1) PG8_BAR; }
    }
    PG8_WAIT_V(0);
    if constexpr (!ALIGN_EPI) { if (wr == 0) PG8_BAR; }
    PG8_BAR;
    if constexpr (Epi::AFTER_DRAIN) { E.fused(acc, cur, wr, wc, fr, fq, lds, wid, lane); S.done(cur); }
#undef PG8_SA
#undef PG8_SB
#undef PG8_STAGE
#undef PG8_LDA
#undef PG8_LDB
#undef PG8_MMA
#undef PG8_WAIT_V
#undef PG8_WAIT_L
#undef PG8_BAR
#undef PG8_SCHED
}
}
#include <hip/hip_bf16.h>
#include <cmath>
namespace attn_body {
using bf16=__hip_bfloat16;
using bf16x8=__attribute__((ext_vector_type(8)))short;
using s16x4=__attribute__((ext_vector_type(4)))short;
using f32x16=__attribute__((ext_vector_type(16)))float;
using u32x4=__attribute__((ext_vector_type(4)))unsigned;
using f32x4v=__attribute__((ext_vector_type(4)))float;
constexpr int BATCH=8,NHEAD=8,SEQ=4096,D=64,DM=NHEAD*D,OPITCH=1024;
constexpr int NW=8,QBLK=32,QB=QBLK*NW,KVBLK=64,NQB=SEQ/QB;
constexpr int ATTN_PITCH=DM, ATTN_UNIT_ROWS=QB;
__device__ __forceinline__ int crow(int r,int hi){return (r&3)+8*(r>>2)+4*hi;}
#define SBAR() __builtin_amdgcn_sched_barrier(0)
__device__ __forceinline__ void cmask(f32x16&p0,f32x16&p1,int jb,int qrel,int hi){
  const float NEG=-INFINITY; int kb=64*jb+4*hi;
  #pragma unroll
  for(int r=0;r<16;++r){int kv=kb+(r&3)+8*(r>>2); if(kv>qrel)p0[r]=NEG; if(kv+32>qrel)p1[r]=NEG;}
}

constexpr int NSLOT=3, SLOTB=8192;
constexpr int LDS_K=0, LDS_V=NSLOT*SLOTB, LDS_WS=2*NSLOT*SLOTB, LDS_OST=LDS_WS+NW*64*4, LDS_BYTES=LDS_OST+NW*4096, LDS_BIAS=LDS_BYTES, LDS_TOTAL=LDS_BIAS+SEQ*4;
constexpr float C2=0.125f*1.4426950408889634f;
__device__ __forceinline__ void glds16(const void*sbase,unsigned voff,unsigned lds_dst){unsigned keep;
  asm volatile("s_mov_b32 %0, m0\n\ts_mov_b32 m0, %3\n\ts_nop 0\n\tglobal_load_lds_dwordx4 %1, %2\n\ts_mov_b32 m0, %0":"=&s"(keep):"v"(voff),"s"(sbase),"s"(lds_dst):"memory");}
__device__ __forceinline__ float max3f(float a,float b,float c){float r;asm("v_max3_f32 %0, %1, %2, %3":"=v"(r):"v"(a),"v"(b),"v"(c));return r;}
__device__ __forceinline__ float max2f(float a,float b){float r;asm("v_max_f32_e32 %0, %1, %2":"=v"(r):"v"(a),"v"(b));return r;}
__device__ __forceinline__ float fadd_s(float a,float b){float r;asm("v_add_f32_e32 %0, %1, %2":"=v"(r):"v"(a),"v"(b));return r;}
__device__ __forceinline__ float fsub_s(float a,float b){float r;asm("v_sub_f32_e32 %0, %1, %2":"=v"(r):"v"(a),"v"(b));return r;}
typedef float f32x2_t __attribute__((ext_vector_type(2))); typedef __bf16 bf16x2_t __attribute__((ext_vector_type(2)));
__device__ __forceinline__ unsigned cvtpk_s(float lo,float hi){f32x2_t v={lo,hi};bf16x2_t b=__builtin_convertvector(v,bf16x2_t);return __builtin_bit_cast(unsigned,b);}
#define WAIT_BAR(N) asm volatile("s_waitcnt vmcnt(" #N ") lgkmcnt(0)\n\ts_barrier":::"memory")

__device__ __forceinline__ void qkt(f32x16&p0,f32x16&p1,const __attribute__((address_space(3))) char*kb,const bf16x8*qr){
  #pragma unroll
  for(int d0=0;d0<4;++d0){
    const bf16x8 b0=*(const __attribute__((address_space(3))) bf16x8*)(kb+d0*2048);
    const bf16x8 b1=*(const __attribute__((address_space(3))) bf16x8*)(kb+d0*2048+512);
    p0=__builtin_amdgcn_mfma_f32_32x32x16_bf16(b0,qr[d0],p0,0,0,0);p1=__builtin_amdgcn_mfma_f32_32x32x16_bf16(b1,qr[d0],p1,0,0,0);}
}
typedef __attribute__((address_space(3))) const char* lds_cptr;
typedef short v4i16_t __attribute__((ext_vector_type(4)));
__device__ __forceinline__ void kload8(bf16x8*kf,lds_cptr kp){
  kf[0]=*(const __attribute__((address_space(3))) bf16x8*)(kp);      kf[1]=*(const __attribute__((address_space(3))) bf16x8*)(kp+512);
  kf[2]=*(const __attribute__((address_space(3))) bf16x8*)(kp+2048); kf[3]=*(const __attribute__((address_space(3))) bf16x8*)(kp+2560);
  kf[4]=*(const __attribute__((address_space(3))) bf16x8*)(kp+4096); kf[5]=*(const __attribute__((address_space(3))) bf16x8*)(kp+4608);
  kf[6]=*(const __attribute__((address_space(3))) bf16x8*)(kp+6144); kf[7]=*(const __attribute__((address_space(3))) bf16x8*)(kp+6656);
}
__device__ __forceinline__ void kload2(bf16x8*kf,lds_cptr kp,int j){ kf[2*j]=*(const __attribute__((address_space(3))) bf16x8*)(kp+j*2048); kf[2*j+1]=*(const __attribute__((address_space(3))) bf16x8*)(kp+j*2048+512); }
__device__ __forceinline__ s16x4 vtr(lds_cptr p){ return __builtin_bit_cast(s16x4,__builtin_amdgcn_ds_read_tr16_b64_v4i16((__attribute__((address_space(3))) v4i16_t*)p)); }
__device__ __forceinline__ float rowmax(const f32x16&p0,const f32x16&p1){
  float a=max3f(p0[0],p0[1],p1[0]),b=max3f(p0[2],p0[3],p1[1]);a=max3f(a,p1[2],p1[3]);
  #pragma unroll
  for(int r=4;r<16;r+=4){a=max3f(a,p0[r],p0[r+1]);b=max3f(b,p0[r+2],p0[r+3]);a=max3f(a,p1[r],p1[r+1]);b=max3f(b,p1[r+2],p1[r+3]);}
  const float m=max2f(a,b);
  auto rr=__builtin_amdgcn_permlane32_swap(__float_as_uint(m),__float_as_uint(m),false,false);
  return max2f(__uint_as_float(rr[0]),__uint_as_float(rr[1]));
}
__device__ __forceinline__ void pv(f32x16*o,int vb,bf16x8 pa0,bf16x8 pa1,bf16x8 pa2,bf16x8 pa3){
  #pragma unroll
  for(int d0=0;d0<2;++d0){s16x4 lo[4],hi[4];
    #pragma unroll
    for(int ks=0;ks<4;++ks){
      asm volatile("ds_read_b64_tr_b16 %0,%1 offset:%c2":"=&v"(lo[ks]):"v"(vb),"i"(d0*4096+ks*1024):"memory");
      asm volatile("ds_read_b64_tr_b16 %0,%1 offset:%c2":"=&v"(hi[ks]):"v"(vb),"i"(d0*4096+ks*1024+512):"memory");}
    asm volatile("s_waitcnt lgkmcnt(0)":::"memory");SBAR();
    #define PK(k) (bf16x8){lo[k][0],lo[k][1],lo[k][2],lo[k][3],hi[k][0],hi[k][1],hi[k][2],hi[k][3]}
    o[d0]=__builtin_amdgcn_mfma_f32_32x32x16_bf16(pa0,PK(0),o[d0],0,0,0);
    o[d0]=__builtin_amdgcn_mfma_f32_32x32x16_bf16(pa1,PK(1),o[d0],0,0,0);
    o[d0]=__builtin_amdgcn_mfma_f32_32x32x16_bf16(pa2,PK(2),o[d0],0,0,0);
    o[d0]=__builtin_amdgcn_mfma_f32_32x32x16_bf16(pa3,PK(3),o[d0],0,0,0);
    #undef PK
  }
}

#ifndef ATTN_STORE16
#define ATTN_STORE16(p,v) (*(u32x4*)(p)=(v))
#endif
template<bool SKIP> __device__ __forceinline__ void attn_unit(int b,int h,int qb,const bf16*Q,const bf16*__restrict__ K,const bf16*__restrict__ V,bf16*O,const float*__restrict__ CB,float qkb,char*shm){
  const int tid=otid(),lane=tid&63,r32=lane&31,hi=lane>>5; const int wid=__builtin_amdgcn_readfirstlane(tid>>6);
  const long rowbase=(long)b*SEQ; const int q0=qb*QB;
  const float*cb=CB+(long)(b*NHEAD+h)*SEQ;
  int t0=0;
  if(SKIP){ const int NTf=(q0+QB)/KVBLK; const float thr=2.f*qkb+40.f; const float cq0=cb[q0];
    bool pred=false; if(lane<NTf-4){ pred=(cq0-cb[64*lane+63])<-thr; }
    const unsigned long long mk=__ballot(pred); t0=(int)__builtin_ctzll(~mk); t0&=~1; t0=__builtin_amdgcn_readfirstlane(t0); }
  const int kv0=t0*KVBLK;
  const int NT=(q0+QB)/KVBLK-t0;
  { __attribute__((address_space(3))) float*bl=(__attribute__((address_space(3))) float*)((lds_cptr)shm+LDS_BIAS); const float*cbk=cb+kv0; for(int i=tid;i<NT*KVBLK;i+=NW*64) bl[i]=-*(const float*)((const char*)cbk+(unsigned)(i*4)); }
  const float negm0=*(const float*)((const char*)(cb+q0+wid*QBLK)+(unsigned)((lane&31)*4))-qkb;
  const bf16*Qw=Q+(rowbase+q0+wid*QBLK)*DM+h*D;
  const bf16*Kh=K+(rowbase+kv0)*DM+h*D,*Vh=V+(rowbase+kv0)*DM+h*D;
  const unsigned lds0=(unsigned)(uintptr_t)shm;
  const unsigned koff=(unsigned)(lane*DM+wid*8)*2u;
  const unsigned voff=(unsigned)((16*(wid&3)+(lane>>2))*DM+(wid>>2)*32+(lane&3)*8)*2u;
  const unsigned kdst=lds0+LDS_K+wid*1024, vdst=lds0+LDS_V+wid*1024;
  #define DMA_K(t,slot) glds16(Kh+(long)(t)*KVBLK*DM,koff,(unsigned)__builtin_amdgcn_readfirstlane(kdst+(slot)))
  #define DMA_V(t,slot) glds16(Vh+(long)(t)*KVBLK*DM,voff,(unsigned)__builtin_amdgcn_readfirstlane(vdst+(slot)))
  bf16x8 kf[8];
  const lds_cptr shm3=(lds_cptr)shm; __attribute__((address_space(3))) float*const wsf=(__attribute__((address_space(3))) float*)(shm3+LDS_WS)+wid*64;
  const lds_cptr kp0=shm3+LDS_K+hi*1024+r32*16; const lds_cptr vp0=shm3+LDS_V+((lane>>4)&1)*32+(lane&3)*8+(4*hi+((lane&15)>>2))*64;
  DMA_K(0,0);DMA_V(0,0);DMA_K(1,SLOTB);
  bf16x8 qr[4];
  #pragma unroll
  for(int d0=0;d0<4;++d0)qr[d0]=*reinterpret_cast<const bf16x8*>((const char*)Qw+(unsigned)((r32*DM+d0*16+hi*8)*2));
  float l_reg=0.f;f32x16 o[2];o[0]=f32x16{};o[1]=f32x16{};
  const __attribute__((address_space(3))) char* bl3=(const __attribute__((address_space(3))) char*)shm+LDS_BIAS+hi*16;
  #define BINIT_ALL(P0,P1,t) do{ const __attribute__((address_space(3))) f32x4v* bp_=(const __attribute__((address_space(3))) f32x4v*)(bl3+(t)*256); \
    _Pragma("unroll") for(int g_=0;g_<4;++g_){ const f32x4v x0_=bp_[2*g_], x1_=bp_[8+2*g_]; \
      P0[4*g_]=x0_[0]+negm0;P0[4*g_+1]=x0_[1]+negm0;P0[4*g_+2]=x0_[2]+negm0;P0[4*g_+3]=x0_[3]+negm0; \
      P1[4*g_]=x1_[0]+negm0;P1[4*g_+1]=x1_[1]+negm0;P1[4*g_+2]=x1_[2]+negm0;P1[4*g_+3]=x1_[3]+negm0; } }while(0)
  const int qrel=wid*QBLK+r32;
  #define CMASK(P0,P1,t) do{int jb_=(t)-(NT-4); if(jb_>=0)cmask(P0,P1,jb_,qrel,hi);}while(0)
  f32x16 pA0,pA1,pB0,pB1;
  int sl_prev=0,sl_cur=0,sl_next=SLOTB;
  #define ROT() do{sl_prev=sl_cur;sl_cur=sl_next;sl_next=(sl_next==(NSLOT-1)*SLOTB)?0:sl_next+SLOTB;}while(0)
  DMA_K(2,2*SLOTB);
  WAIT_BAR(3);
  BINIT_ALL(pA0,pA1,0); qkt(pA0,pA1,kp0,qr);asm volatile("s_nop 15\n\ts_nop 7":"+v"(pA0),"+v"(pA1));CMASK(pA0,pA1,0);
  _Pragma("unroll") for(int r=0;r<16;++r){pA0[r]=__builtin_amdgcn_exp2f(pA0[r]);pA1[r]=__builtin_amdgcn_exp2f(pA1[r]);}
  BINIT_ALL(pB0,pB1,1);
  WAIT_BAR(0);
  DMA_K(3,0);DMA_V(1,SLOTB);
  ROT();
  kload8(kf,kp0+sl_cur);
  WAIT_BAR(2);
  s16x4 vlo[8],vhi[8]; u32x4 pw0,pw1,pw2,pw3;
  #define PKW(P,B) cvtpk_s(P[B],P[B+1])
  #define PAF(k) __builtin_bit_cast(bf16x8,pw##k)
  #define VFR(i) (bf16x8){vlo[i][0],vlo[i][1],vlo[i][2],vlo[i][3],vhi[i][0],vhi[i][1],vhi[i][2],vhi[i][3]}
  #define PIN(x) asm volatile("":"+v"(x))
  #define MX3(a,b,c) __builtin_fmaxf(__builtin_fmaxf((a),(b)),(c))
  #define GAPA(MF,A0,A1,A2,A3,W0,W1,PW) do{ MF; sacc+=A0; sacc+=A1; sacc+=A2; sacc+=A3; PIN(sacc); W0; W1; PIN(PW); SBAR(); }while(0)
  #define EX(v) __builtin_amdgcn_exp2f(v)
  #define GAPB(MF,X,B,GL_,P,GI,NI) do{ MF; X[B]=EX(X[B]); X[B+1]=EX(X[B+1]); X[B+2]=EX(X[B+2]); X[B+3]=EX(X[B+3]); PIN(X); \
    if(GL_){ const f32x4v nx_=bpn_[NI]; P[4*(GI)]=bq_[0]+negm0; P[4*(GI)+1]=bq_[1]+negm0; P[4*(GI)+2]=bq_[2]+negm0; P[4*(GI)+3]=bq_[3]+negm0; bq_=nx_; PIN(P); } SBAR(); }while(0)
  #define VRD(i) do{ vlo[i]=vtr(vp_+(((i)>>2)*4096+((i)&3)*1024)); vhi[i]=vtr(vp_+(((i)>>2)*4096+((i)&3)*1024+512)); }while(0)
  #define KRD(G,j) do{ if(G){ kload2(kf,kp0+sl_next,j); SBAR(); } }while(0)
  #define STEP(C0,C1,P0,P1,t,GK,GV,GL) do{ SBAR(); \
    const lds_cptr vp_=vp0+sl_prev; \
    VRD(0); SBAR(); float sacc=(P0[0]+P0[1]); \
    GAPA(C0=__builtin_amdgcn_mfma_f32_32x32x16_bf16(kf[0],qr[0],C0,0,0,0), P0[2],P0[3],P0[4],P0[5],     pw0[0]=PKW(P0,0), pw0[1]=PKW(P0,2), pw0); \
    VRD(4); SBAR(); GAPA(C1=__builtin_amdgcn_mfma_f32_32x32x16_bf16(kf[1],qr[0],C1,0,0,0), P0[6],P0[7],P0[8],P0[9],     pw0[2]=PKW(P0,4), pw0[3]=PKW(P0,6), pw0); \
    VRD(1); SBAR(); GAPA(C0=__builtin_amdgcn_mfma_f32_32x32x16_bf16(kf[2],qr[1],C0,0,0,0),   P0[10],P0[11],P0[12],P0[13], pw1[0]=PKW(P0,8), pw1[1]=PKW(P0,10), pw1); \
    VRD(5); SBAR(); GAPA(C1=__builtin_amdgcn_mfma_f32_32x32x16_bf16(kf[3],qr[1],C1,0,0,0),   P0[14],P0[15],P1[0],P1[1],   pw1[2]=PKW(P0,12),pw1[3]=PKW(P0,14), pw1); \
    VRD(2); SBAR(); GAPA(C0=__builtin_amdgcn_mfma_f32_32x32x16_bf16(kf[4],qr[2],C0,0,0,0),   P1[2],P1[3],P1[4],P1[5],     pw2[0]=PKW(P1,0), pw2[1]=PKW(P1,2), pw2); \
    VRD(6); SBAR(); GAPA(C1=__builtin_amdgcn_mfma_f32_32x32x16_bf16(kf[5],qr[2],C1,0,0,0),   P1[6],P1[7],P1[8],P1[9],     pw2[2]=PKW(P1,4), pw2[3]=PKW(P1,6), pw2); \
    VRD(3); SBAR(); GAPA(C0=__builtin_amdgcn_mfma_f32_32x32x16_bf16(kf[6],qr[3],C0,0,0,0),   P1[10],P1[11],P1[12],P1[13], pw3[0]=PKW(P1,8), pw3[1]=PKW(P1,10), pw3); \
    VRD(7); SBAR(); GAPA(C1=__builtin_amdgcn_mfma_f32_32x32x16_bf16(kf[7],qr[3],C1,0,0,0),   P1[14],P1[15],0.f,0.f,       pw3[2]=PKW(P1,12),pw3[3]=PKW(P1,14), pw3); \
    l_reg+=sacc; \
    if(GK){DMA_K((t)+3,sl_cur);} if(GV){DMA_V((t)+1,sl_next);} \
    CMASK(C0,C1,t); \
    const __attribute__((address_space(3))) f32x4v* bpn_=(const __attribute__((address_space(3))) f32x4v*)(bl3+((t)+1)*256); f32x4v bq_=f32x4v{}; if(GL){bq_=bpn_[0];} \
    SBAR(); \
    GAPB(o[0]=__builtin_amdgcn_mfma_f32_32x32x16_bf16(PAF(0),VFR(0),o[0],0,0,0), C0,0,GL,P0,0,8); \
    GAPB(o[1]=__builtin_amdgcn_mfma_f32_32x32x16_bf16(PAF(0),VFR(4),o[1],0,0,0), C0,4,GL,P1,0,2); \
    KRD(GL,0); GAPB(o[0]=__builtin_amdgcn_mfma_f32_32x32x16_bf16(PAF(1),VFR(1),o[0],0,0,0), C0,8,GL,P0,1,10); \
    KRD(GL,1); GAPB(o[1]=__builtin_amdgcn_mfma_f32_32x32x16_bf16(PAF(1),VFR(5),o[1],0,0,0), C0,12,GL,P1,1,4); \
    KRD(GL,2); GAPB(o[0]=__builtin_amdgcn_mfma_f32_32x32x16_bf16(PAF(2),VFR(2),o[0],0,0,0), C1,0,GL,P0,2,12); \
    KRD(GL,3); GAPB(o[1]=__builtin_amdgcn_mfma_f32_32x32x16_bf16(PAF(2),VFR(6),o[1],0,0,0), C1,4,GL,P1,2,6); \
    GAPB(o[0]=__builtin_amdgcn_mfma_f32_32x32x16_bf16(PAF(3),VFR(3),o[0],0,0,0), C1,8,GL,P0,3,14); \
    GAPB(o[1]=__builtin_amdgcn_mfma_f32_32x32x16_bf16(PAF(3),VFR(7),o[1],0,0,0), C1,12,GL,P1,3,14); \
    }while(0)
  int t=1;
  #undef CMASK
  #define CMASK(P0,P1,t) do{}while(0)
  for(;t+5<NT;t+=2){
    STEP(pB0,pB1,pA0,pA1,t,true,true,true);     WAIT_BAR(2); ROT();
    STEP(pA0,pA1,pB0,pB1,t+1,true,true,true);   WAIT_BAR(2); ROT();
  }
  #undef CMASK
  #define CMASK(P0,P1,t) do{int jb_=(t)-(NT-4); if(jb_>=0)cmask(P0,P1,jb_,qrel,hi);}while(0)
  #define ENDW(tt) do{ if((tt)+3<NT){WAIT_BAR(2);} else if((tt)+2<NT){WAIT_BAR(1);} else {WAIT_BAR(0);} }while(0)
  for(;t+1<NT;t+=2){
    STEP(pB0,pB1,pA0,pA1,t,(t+3<NT),(t+1<NT),(t+1<NT));       ENDW(t);   ROT();
    STEP(pA0,pA1,pB0,pB1,t+1,(t+4<NT),(t+2<NT),(t+2<NT));     ENDW(t+1); ROT();
  }
  STEP(pB0,pB1,pA0,pA1,NT-1,false,false,false);
  { float sacc=pB0[0]+pB0[1]; _Pragma("unroll") for(int r=2;r<16;++r)sacc+=pB0[r]; _Pragma("unroll") for(int r=0;r<16;++r)sacc+=pB1[r]; l_reg+=sacc;
    pw0=(u32x4){PKW(pB0,0),PKW(pB0,2),PKW(pB0,4),PKW(pB0,6)};pw1=(u32x4){PKW(pB0,8),PKW(pB0,10),PKW(pB0,12),PKW(pB0,14)};pw2=(u32x4){PKW(pB1,0),PKW(pB1,2),PKW(pB1,4),PKW(pB1,6)};pw3=(u32x4){PKW(pB1,8),PKW(pB1,10),PKW(pB1,12),PKW(pB1,14)};
    SBAR(); pv(o,(int)(unsigned)(uintptr_t)vp0+sl_cur,PAF(0),PAF(1),PAF(2),PAF(3)); }
  #undef PKW
  #undef PAF
  #undef VFR
  #undef PIN
  #undef MX3
  #undef GAPA
  #undef GAPB
  #undef EX
  #undef VRD
  #undef KRD
  #undef STEP
  #undef ENDW
  {auto rr=__builtin_amdgcn_permlane32_swap(__float_as_uint(l_reg),__float_as_uint(l_reg),false,false);l_reg=__uint_as_float(rr[0])+__uint_as_float(rr[1]);}
  if(hi==0)wsf[32+r32]=l_reg;asm volatile("s_waitcnt lgkmcnt(0)":::"memory");
  float rli[16];
  #pragma unroll
  for(int r=0;r<16;++r)rli[r]=__builtin_amdgcn_rcpf(wsf[32+crow(r,hi)]);
  bf16*Ow=O+(rowbase+q0+wid*QBLK)*OPITCH+h*D;
  { __attribute__((address_space(3))) unsigned short*stg=(__attribute__((address_space(3))) unsigned short*)(shm3+LDS_OST)+wid*2048;
    #pragma unroll
    for(int r=0;r<16;++r){const int orow=crow(r,hi);
      #pragma unroll
      for(int d0=0;d0<2;++d0)stg[orow*64+d0*32+r32]=(unsigned short)(cvtpk_s(o[d0][r]*rli[r],0.f)&0xffffu);}
    asm volatile("s_waitcnt lgkmcnt(0)":::"memory");
    #pragma unroll
    for(int i=0;i<4;++i){const int row=i*8+(lane>>3),ch=lane&7; const u32x4 v=*(const __attribute__((address_space(3))) u32x4*)(stg+row*64+ch*8); ATTN_STORE16((char*)Ow+(unsigned)((row*OPITCH+ch*8)*2),v);} }
  asm volatile("s_waitcnt lgkmcnt(0)\n\ts_barrier":::"memory");
  #undef DMA_K
  #undef DMA_V
  #undef CMASK
  #undef BINIT_ALL
  #undef ROT
}
constexpr int ATTN_LDS_BYTES=LDS_TOTAL;
struct AttnTensors { const bf16* Q; const bf16* K; const bf16* V; bf16* O; const float* CB; float qkb; };
struct AttnUnit { int bh; int qb; };
struct StaticOrder {
  int vcu,G;
  __device__ __forceinline__ explicit StaticOrder(int grid,int block):vcu((grid%8==0)?(block%8)*(grid/8)+block/8:block),G(grid){}
  __device__ __forceinline__ bool next(int i,AttnUnit&u)const{
    if(G==256){ if(i>=4)return false; const int s=vcu&3; u.bh=vcu>>2; u.qb=(i==0)?s:(i==1)?7-s:(i==2)?8+s:15-s; return true; }
    const int id=vcu+i*G; if(id>=BATCH*NHEAD*NQB)return false; u.bh=id/NQB; u.qb=id%NQB; return true; }
};
template<class Sched,bool SKIP> __device__ __forceinline__ void attn_phase(char*lds,const AttnTensors&T,const Sched&S){
  AttnUnit u;
  for(int i=0;S.next(i,u);++i){ attn_unit<SKIP>(u.bh/NHEAD,u.bh%NHEAD,u.qb,T.Q,T.K,T.V,T.O,T.CB,T.qkb,lds); }
}
template<bool SKIP> __device__ __forceinline__ void attn_phase_q(char*lds,const AttnTensors&T,unsigned*queue){
  const int tid=otid();
  __attribute__((address_space(3))) int*slot=(__attribute__((address_space(3))) int*)((lds_cptr)lds+LDS_TOTAL);
  const unsigned xcc=(unsigned)__builtin_amdgcn_s_getreg((3<<11)|20)&7u;
  for(;;){
    if(tid==0){ int got=-1;
      for(unsigned sx=0;sx<8;++sx){ const unsigned x=(xcc+sx)&7u; const unsigned c=__hip_atomic_fetch_add(queue+x*64,1u,__ATOMIC_RELAXED,__HIP_MEMORY_SCOPE_AGENT); if(c<(unsigned)(NHEAD*NQB)){ got=(int)(x*(NHEAD*NQB)+c); break; } }
      *slot=got; }
    asm volatile("s_waitcnt vmcnt(0) lgkmcnt(0)\n\ts_barrier":::"memory");
    const int id=__builtin_amdgcn_readfirstlane(*slot);
    if(id<0)break;
    const int b=id/(NHEAD*NQB), c=id%(NHEAD*NQB), h=c%NHEAD, qb=NQB-1-c/NHEAD;
    attn_unit<SKIP>(b,h,qb,T.Q,T.K,T.V,T.O,T.CB,T.qkb,lds);
  }
}
#undef SBAR
#undef WAIT_BAR
}
#define GAS __attribute__((address_space(1)))
#define LAS __attribute__((address_space(3)))
typedef unsigned short bf16;
typedef unsigned v4u __attribute__((ext_vector_type(4)));
typedef float f32x4 __attribute__((ext_vector_type(4)));
typedef short bf16x8 __attribute__((ext_vector_type(8)));
typedef GAS unsigned gu32;
typedef GAS unsigned long long gu64;
#define RLX_AGENT __ATOMIC_RELAXED, __HIP_MEMORY_SCOPE_AGENT
#define LDS_WAIT() asm volatile("s_waitcnt lgkmcnt(0)" ::: "memory")
#define VM_WAIT() asm volatile("s_waitcnt vmcnt(0)" ::: "memory")
__device__ __forceinline__ unsigned long long rt() { return __builtin_amdgcn_s_memrealtime(); }
__device__ __forceinline__ unsigned f2bf(float f) { unsigned u = __builtin_bit_cast(unsigned, f); return (u + 0x7fffu + ((u >> 16) & 1u)) >> 16; }
__device__ __forceinline__ unsigned pk2(float lo, float hi) { return f2bf(lo) | (f2bf(hi) << 16); }

#define XB_TMO      128
#define XB_XCNT(j)  (256  + 64 * (j))
#define XB_XSUB(j)  (1280 + 64 * (j))
#define XB_XGEN(j)  (2304 + 64 * (j))
#define XB_TOP      3328
#define XB_TOPGEN   3392
#define XCD_BAR_WORDS 3456
#define XB_SPIN_CAP (1u << 18)

__device__ __forceinline__ unsigned xb_ld(unsigned* p)              { return __hip_atomic_load(p, __ATOMIC_RELAXED, __HIP_MEMORY_SCOPE_AGENT); }
__device__ __forceinline__ unsigned xb_add(unsigned* p, unsigned v) { return __hip_atomic_fetch_add(p, v, __ATOMIC_RELAXED, __HIP_MEMORY_SCOPE_AGENT); }
__device__ __forceinline__ unsigned xb_xcc_id() { return (unsigned)__builtin_amdgcn_s_getreg((3 << 11) | 20) & 0xFu; }
#define XB_SPIN(cond, bar) do { unsigned _sp = 0; while (cond) { __builtin_amdgcn_s_sleep(1); \
    if ((++_sp & 255u) == 0u) { if (xb_ld(&(bar)[XB_TMO])) break; if (_sp > XB_SPIN_CAP) { atomicAdd(&(bar)[XB_TMO], 1u); break; } } } } while (0)

struct XcdBarrier {
    unsigned* bar; unsigned x;
    volatile LAS unsigned* st;
};

__device__ __forceinline__ XcdBarrier xcd_barrier_post(unsigned* bar, volatile LAS unsigned* st) {
    XcdBarrier b; b.bar = bar; b.x = xb_xcc_id(); b.st = st;
    if (threadIdx.x == 0) (void)xb_add(&bar[XB_XCNT(b.x)], 1u);
    return b;
}
__device__ __forceinline__ void xcd_barrier_complete(unsigned* bar, unsigned x, unsigned& nloc, unsigned& nx) {
    const unsigned G = gridDim.x * gridDim.y * gridDim.z;
    unsigned sum, cnt, mine, sp = 0u;
    for (;;) {
        sum = 0u; cnt = 0u; mine = 0u;
#pragma unroll
        for (unsigned j = 0; j < 16; ++j) { const unsigned c = xb_ld(&bar[XB_XCNT(j)]); sum += c; cnt += (c > 0u) ? 1u : 0u; mine = (j == x) ? c : mine; }
        if (sum == G) break;
        __builtin_amdgcn_s_sleep(1);
        if ((++sp & 255u) == 0u) { if (xb_ld(&bar[XB_TMO])) break; if (sp > XB_SPIN_CAP) { atomicAdd(&bar[XB_TMO], 1u); break; } }
    }
    nloc = mine > 0u ? mine : 1u; nx = cnt > 0u ? cnt : 1u;
}

__device__ __forceinline__ void xcd_barrier(const XcdBarrier& b) {
    asm volatile("s_waitcnt vmcnt(0)" ::: "memory");
    __syncthreads();
    if (threadIdx.x == 0) {
        unsigned* bar = b.bar;
        __builtin_amdgcn_s_waitcnt(0);
        unsigned nloc = b.st[0], nx = b.st[1];
        if (nloc == 0u) { xcd_barrier_complete(bar, b.x, nloc, nx); b.st[0] = nloc; b.st[1] = nx; }
        const unsigned old = xb_add(&bar[XB_XSUB(b.x)], 1u);
        const unsigned gen = old / nloc;
        if (old + 1u == (gen + 1u) * nloc) {
            __builtin_amdgcn_fence(__ATOMIC_RELEASE, "agent");
            asm volatile("s_waitcnt vmcnt(0)" ::: "memory");
            const unsigned og = xb_add(&bar[XB_TOP], 1u);
            const unsigned tg = og / nx;
            if (og + 1u == (tg + 1u) * nx) xb_add(&bar[XB_TOPGEN], 1u);
            else XB_SPIN(xb_ld(&bar[XB_TOPGEN]) == tg, bar);
            __builtin_amdgcn_fence(__ATOMIC_ACQUIRE, "agent");
            xb_add(&bar[XB_XGEN(b.x)], 1u);
            asm volatile("s_waitcnt vmcnt(0)" ::: "memory");
        } else {
            XB_SPIN(xb_ld(&bar[XB_XGEN(b.x)]) == gen, bar);
            __builtin_amdgcn_fence(__ATOMIC_ACQUIRE, "agent");
            asm volatile("s_waitcnt vmcnt(0)" ::: "memory");
        }
    }
    __syncthreads();
}
struct Args { const float* in[25]; float* out; unsigned char* ws; int ph_lo, ph_hi, use_bar, pad; };
typedef const __attribute__((address_space(4))) Args* KArgs;
#define CAND_LIST CAND(0,0,2,1) CAND(0,1,2,2) CAND(0,2,2,3) CAND(0,3,2,4) CAND(0,4,3,0) CAND(0,5,3,1) CAND(0,6,3,2) CAND(0,7,3,3) CAND(0,8,4,0) CAND(0,9,4,1) CAND(0,10,4,2) CAND(0,11,5,0) CAND(0,12,5,1) CAND(0,13,6,0) CAND(0,14,6,1) CAND(0,15,7,0) CAND(1,0,7,1) CAND(1,1,8,0) CAND(1,2,9,0) CAND(1,3,10,0) CAND(1,4,11,0) CAND(1,5,12,0) CAND(1,6,13,0) CAND(1,7,14,0) CAND(2,0,15,0)
__device__ __forceinline__ void sort16_desc(float (&a)[16]) {
    { const float h_ = fmaxf(a[0], a[1]), l_ = fminf(a[0], a[1]); a[0] = h_; a[1] = l_; }
    { const float h_ = fmaxf(a[2], a[3]), l_ = fminf(a[2], a[3]); a[2] = h_; a[3] = l_; }
    { const float h_ = fmaxf(a[0], a[2]), l_ = fminf(a[0], a[2]); a[0] = h_; a[2] = l_; }
    { const float h_ = fmaxf(a[1], a[3]), l_ = fminf(a[1], a[3]); a[1] = h_; a[3] = l_; }
    { const float h_ = fmaxf(a[1], a[2]), l_ = fminf(a[1], a[2]); a[1] = h_; a[2] = l_; }
    { const float h_ = fmaxf(a[4], a[5]), l_ = fminf(a[4], a[5]); a[4] = h_; a[5] = l_; }
    { const float h_ = fmaxf(a[6], a[7]), l_ = fminf(a[6], a[7]); a[6] = h_; a[7] = l_; }
    { const float h_ = fmaxf(a[4], a[6]), l_ = fminf(a[4], a[6]); a[4] = h_; a[6] = l_; }
    { const float h_ = fmaxf(a[5], a[7]), l_ = fminf(a[5], a[7]); a[5] = h_; a[7] = l_; }
    { const float h_ = fmaxf(a[5], a[6]), l_ = fminf(a[5], a[6]); a[5] = h_; a[6] = l_; }
    { const float h_ = fmaxf(a[0], a[4]), l_ = fminf(a[0], a[4]); a[0] = h_; a[4] = l_; }
    { const float h_ = fmaxf(a[2], a[6]), l_ = fminf(a[2], a[6]); a[2] = h_; a[6] = l_; }
    { const float h_ = fmaxf(a[2], a[4]), l_ = fminf(a[2], a[4]); a[2] = h_; a[4] = l_; }
    { const float h_ = fmaxf(a[1], a[5]), l_ = fminf(a[1], a[5]); a[1] = h_; a[5] = l_; }
    { const float h_ = fmaxf(a[3], a[7]), l_ = fminf(a[3], a[7]); a[3] = h_; a[7] = l_; }
    { const float h_ = fmaxf(a[3], a[5]), l_ = fminf(a[3], a[5]); a[3] = h_; a[5] = l_; }
    { const float h_ = fmaxf(a[1], a[2]), l_ = fminf(a[1], a[2]); a[1] = h_; a[2] = l_; }
    { const float h_ = fmaxf(a[3], a[4]), l_ = fminf(a[3], a[4]); a[3] = h_; a[4] = l_; }
    { const float h_ = fmaxf(a[5], a[6]), l_ = fminf(a[5], a[6]); a[5] = h_; a[6] = l_; }
    { const float h_ = fmaxf(a[8], a[9]), l_ = fminf(a[8], a[9]); a[8] = h_; a[9] = l_; }
    { const float h_ = fmaxf(a[10], a[11]), l_ = fminf(a[10], a[11]); a[10] = h_; a[11] = l_; }
    { const float h_ = fmaxf(a[8], a[10]), l_ = fminf(a[8], a[10]); a[8] = h_; a[10] = l_; }
    { const float h_ = fmaxf(a[9], a[11]), l_ = fminf(a[9], a[11]); a[9] = h_; a[11] = l_; }
    { const float h_ = fmaxf(a[9], a[10]), l_ = fminf(a[9], a[10]); a[9] = h_; a[10] = l_; }
    { const float h_ = fmaxf(a[12], a[13]), l_ = fminf(a[12], a[13]); a[12] = h_; a[13] = l_; }
    { const float h_ = fmaxf(a[14], a[15]), l_ = fminf(a[14], a[15]); a[14] = h_; a[15] = l_; }
    { const float h_ = fmaxf(a[12], a[14]), l_ = fminf(a[12], a[14]); a[12] = h_; a[14] = l_; }
    { const float h_ = fmaxf(a[13], a[15]), l_ = fminf(a[13], a[15]); a[13] = h_; a[15] = l_; }
    { const float h_ = fmaxf(a[13], a[14]), l_ = fminf(a[13], a[14]); a[13] = h_; a[14] = l_; }
    { const float h_ = fmaxf(a[8], a[12]), l_ = fminf(a[8], a[12]); a[8] = h_; a[12] = l_; }
    { const float h_ = fmaxf(a[10], a[14]), l_ = fminf(a[10], a[14]); a[10] = h_; a[14] = l_; }
    { const float h_ = fmaxf(a[10], a[12]), l_ = fminf(a[10], a[12]); a[10] = h_; a[12] = l_; }
    { const float h_ = fmaxf(a[9], a[13]), l_ = fminf(a[9], a[13]); a[9] = h_; a[13] = l_; }
    { const float h_ = fmaxf(a[11], a[15]), l_ = fminf(a[11], a[15]); a[11] = h_; a[15] = l_; }
    { const float h_ = fmaxf(a[11], a[13]), l_ = fminf(a[11], a[13]); a[11] = h_; a[13] = l_; }
    { const float h_ = fmaxf(a[9], a[10]), l_ = fminf(a[9], a[10]); a[9] = h_; a[10] = l_; }
    { const float h_ = fmaxf(a[11], a[12]), l_ = fminf(a[11], a[12]); a[11] = h_; a[12] = l_; }
    { const float h_ = fmaxf(a[13], a[14]), l_ = fminf(a[13], a[14]); a[13] = h_; a[14] = l_; }
    { const float h_ = fmaxf(a[0], a[8]), l_ = fminf(a[0], a[8]); a[0] = h_; a[8] = l_; }
    { const float h_ = fmaxf(a[4], a[12]), l_ = fminf(a[4], a[12]); a[4] = h_; a[12] = l_; }
    { const float h_ = fmaxf(a[4], a[8]), l_ = fminf(a[4], a[8]); a[4] = h_; a[8] = l_; }
    { const float h_ = fmaxf(a[2], a[10]), l_ = fminf(a[2], a[10]); a[2] = h_; a[10] = l_; }
    { const float h_ = fmaxf(a[6], a[14]), l_ = fminf(a[6], a[14]); a[6] = h_; a[14] = l_; }
    { const float h_ = fmaxf(a[6], a[10]), l_ = fminf(a[6], a[10]); a[6] = h_; a[10] = l_; }
    { const float h_ = fmaxf(a[2], a[4]), l_ = fminf(a[2], a[4]); a[2] = h_; a[4] = l_; }
    { const float h_ = fmaxf(a[6], a[8]), l_ = fminf(a[6], a[8]); a[6] = h_; a[8] = l_; }
    { const float h_ = fmaxf(a[10], a[12]), l_ = fminf(a[10], a[12]); a[10] = h_; a[12] = l_; }
    { const float h_ = fmaxf(a[1], a[9]), l_ = fminf(a[1], a[9]); a[1] = h_; a[9] = l_; }
    { const float h_ = fmaxf(a[5], a[13]), l_ = fminf(a[5], a[13]); a[5] = h_; a[13] = l_; }
    { const float h_ = fmaxf(a[5], a[9]), l_ = fminf(a[5], a[9]); a[5] = h_; a[9] = l_; }
    { const float h_ = fmaxf(a[3], a[11]), l_ = fminf(a[3], a[11]); a[3] = h_; a[11] = l_; }
    { const float h_ = fmaxf(a[7], a[15]), l_ = fminf(a[7], a[15]); a[7] = h_; a[15] = l_; }
    { const float h_ = fmaxf(a[7], a[11]), l_ = fminf(a[7], a[11]); a[7] = h_; a[11] = l_; }
    { const float h_ = fmaxf(a[3], a[5]), l_ = fminf(a[3], a[5]); a[3] = h_; a[5] = l_; }
    { const float h_ = fmaxf(a[7], a[9]), l_ = fminf(a[7], a[9]); a[7] = h_; a[9] = l_; }
    { const float h_ = fmaxf(a[11], a[13]), l_ = fminf(a[11], a[13]); a[11] = h_; a[13] = l_; }
    { const float h_ = fmaxf(a[1], a[2]), l_ = fminf(a[1], a[2]); a[1] = h_; a[2] = l_; }
    { const float h_ = fmaxf(a[3], a[4]), l_ = fminf(a[3], a[4]); a[3] = h_; a[4] = l_; }
    { const float h_ = fmaxf(a[5], a[6]), l_ = fminf(a[5], a[6]); a[5] = h_; a[6] = l_; }
    { const float h_ = fmaxf(a[7], a[8]), l_ = fminf(a[7], a[8]); a[7] = h_; a[8] = l_; }
    { const float h_ = fmaxf(a[9], a[10]), l_ = fminf(a[9], a[10]); a[9] = h_; a[10] = l_; }
    { const float h_ = fmaxf(a[11], a[12]), l_ = fminf(a[11], a[12]); a[11] = h_; a[12] = l_; }
    { const float h_ = fmaxf(a[13], a[14]), l_ = fminf(a[13], a[14]); a[13] = h_; a[14] = l_; }
}
__device__ __forceinline__ void merge16_desc(float (&a)[16], const float (&b)[16]) {
    a[0] = fmaxf(a[0], b[15]);
    a[1] = fmaxf(a[1], b[14]);
    a[2] = fmaxf(a[2], b[13]);
    a[3] = fmaxf(a[3], b[12]);
    a[4] = fmaxf(a[4], b[11]);
    a[5] = fmaxf(a[5], b[10]);
    a[6] = fmaxf(a[6], b[9]);
    a[7] = fmaxf(a[7], b[8]);
    a[8] = fmaxf(a[8], b[7]);
    a[9] = fmaxf(a[9], b[6]);
    a[10] = fmaxf(a[10], b[5]);
    a[11] = fmaxf(a[11], b[4]);
    a[12] = fmaxf(a[12], b[3]);
    a[13] = fmaxf(a[13], b[2]);
    a[14] = fmaxf(a[14], b[1]);
    a[15] = fmaxf(a[15], b[0]);
    { const float h_ = fmaxf(a[0], a[8]), l_ = fminf(a[0], a[8]); a[0] = h_; a[8] = l_; }
    { const float h_ = fmaxf(a[1], a[9]), l_ = fminf(a[1], a[9]); a[1] = h_; a[9] = l_; }
    { const float h_ = fmaxf(a[2], a[10]), l_ = fminf(a[2], a[10]); a[2] = h_; a[10] = l_; }
    { const float h_ = fmaxf(a[3], a[11]), l_ = fminf(a[3], a[11]); a[3] = h_; a[11] = l_; }
    { const float h_ = fmaxf(a[4], a[12]), l_ = fminf(a[4], a[12]); a[4] = h_; a[12] = l_; }
    { const float h_ = fmaxf(a[5], a[13]), l_ = fminf(a[5], a[13]); a[5] = h_; a[13] = l_; }
    { const float h_ = fmaxf(a[6], a[14]), l_ = fminf(a[6], a[14]); a[6] = h_; a[14] = l_; }
    { const float h_ = fmaxf(a[7], a[15]), l_ = fminf(a[7], a[15]); a[7] = h_; a[15] = l_; }
    { const float h_ = fmaxf(a[0], a[4]), l_ = fminf(a[0], a[4]); a[0] = h_; a[4] = l_; }
    { const float h_ = fmaxf(a[1], a[5]), l_ = fminf(a[1], a[5]); a[1] = h_; a[5] = l_; }
    { const float h_ = fmaxf(a[2], a[6]), l_ = fminf(a[2], a[6]); a[2] = h_; a[6] = l_; }
    { const float h_ = fmaxf(a[3], a[7]), l_ = fminf(a[3], a[7]); a[3] = h_; a[7] = l_; }
    { const float h_ = fmaxf(a[8], a[12]), l_ = fminf(a[8], a[12]); a[8] = h_; a[12] = l_; }
    { const float h_ = fmaxf(a[9], a[13]), l_ = fminf(a[9], a[13]); a[9] = h_; a[13] = l_; }
    { const float h_ = fmaxf(a[10], a[14]), l_ = fminf(a[10], a[14]); a[10] = h_; a[14] = l_; }
    { const float h_ = fmaxf(a[11], a[15]), l_ = fminf(a[11], a[15]); a[11] = h_; a[15] = l_; }
    { const float h_ = fmaxf(a[0], a[2]), l_ = fminf(a[0], a[2]); a[0] = h_; a[2] = l_; }
    { const float h_ = fmaxf(a[1], a[3]), l_ = fminf(a[1], a[3]); a[1] = h_; a[3] = l_; }
    { const float h_ = fmaxf(a[4], a[6]), l_ = fminf(a[4], a[6]); a[4] = h_; a[6] = l_; }
    { const float h_ = fmaxf(a[5], a[7]), l_ = fminf(a[5], a[7]); a[5] = h_; a[7] = l_; }
    { const float h_ = fmaxf(a[8], a[10]), l_ = fminf(a[8], a[10]); a[8] = h_; a[10] = l_; }
    { const float h_ = fmaxf(a[9], a[11]), l_ = fminf(a[9], a[11]); a[9] = h_; a[11] = l_; }
    { const float h_ = fmaxf(a[12], a[14]), l_ = fminf(a[12], a[14]); a[12] = h_; a[14] = l_; }
    { const float h_ = fmaxf(a[13], a[15]), l_ = fminf(a[13], a[15]); a[13] = h_; a[15] = l_; }
    { const float h_ = fmaxf(a[0], a[1]), l_ = fminf(a[0], a[1]); a[0] = h_; a[1] = l_; }
    { const float h_ = fmaxf(a[2], a[3]), l_ = fminf(a[2], a[3]); a[2] = h_; a[3] = l_; }
    { const float h_ = fmaxf(a[4], a[5]), l_ = fminf(a[4], a[5]); a[4] = h_; a[5] = l_; }
    { const float h_ = fmaxf(a[6], a[7]), l_ = fminf(a[6], a[7]); a[6] = h_; a[7] = l_; }
    { const float h_ = fmaxf(a[8], a[9]), l_ = fminf(a[8], a[9]); a[8] = h_; a[9] = l_; }
    { const float h_ = fmaxf(a[10], a[11]), l_ = fminf(a[10], a[11]); a[10] = h_; a[11] = l_; }
    { const float h_ = fmaxf(a[12], a[13]), l_ = fminf(a[12], a[13]); a[12] = h_; a[13] = l_; }
    { const float h_ = fmaxf(a[14], a[15]), l_ = fminf(a[14], a[15]); a[14] = h_; a[15] = l_; }
}
constexpr int NB = 8, SEQ = 4096, DM = 1024, NTOK = NB * SEQ;
constexpr int NH = 8, HD = 64, AW = 512, PWD = 256, SWD = 256, INC = 2056;
constexpr int NEXP = 16384, PQW = 2048;
constexpr float EPSN = 1e-6f, LOG2E = 1.4426950408889634f;
constexpr int NWAVES = 8, NTHR = 512;
constexpr size_t MiB = 1u << 20;
constexpr size_t WS_CTL = 0, CTL_ZERO_BYTES = 1 * MiB;
constexpr size_t WS_WIN = 1 * MiB;
constexpr size_t WS_WOUT = 9 * MiB;
constexpr size_t WS_WQ = 13 * MiB;
constexpr size_t WS_KEYS = 21 * MiB;
constexpr size_t WS_WGLU = 22 * MiB;
constexpr size_t WS_WF = 22 * MiB + 512 * 1024;
constexpr size_t WS_CB = 23 * MiB;
constexpr size_t WS_XLOC = 24 * MiB;
constexpr size_t WS_IDX = 28 * MiB;
constexpr size_t WS_GATE = 44 * MiB;
constexpr size_t WS_Z = 60 * MiB;
constexpr size_t WS_U = 76 * MiB;
constexpr size_t WS_V = 140 * MiB;
constexpr size_t WS_XN8 = 172 * MiB;
constexpr size_t WS_HSC = 22 * MiB + 768 * 1024;
constexpr size_t WS_XN = 204 * MiB;
constexpr size_t WS_P = 268 * MiB;
constexpr size_t WS_MG = 396 * MiB;
constexpr size_t WS_END = 460 * MiB;
constexpr int CW_BAR = 4096, CW_AQ = 20480;
constexpr float U8_SCALE = 768.f, V8_SCALE = 32.f, ACT_SCALE = 64.f;
constexpr int RING_BYTES = 131072, LDSCTL_OFF = RING_BYTES, MISC_OFF = LDSCTL_OFF + 320, EPIX_OFF = LDSCTL_OFF + 4096, LDS_BYTES = 163840;
static_assert(attn_body::ATTN_LDS_BYTES + 16 <= RING_BYTES, "attention scratch fits the ring");

typedef _Float16 h16x2 __attribute__((ext_vector_type(2)));
typedef float f32x16 __attribute__((ext_vector_type(16)));
typedef unsigned u32x2 __attribute__((ext_vector_type(2)));

__device__ __forceinline__ float bf2f(unsigned short b) { return __uint_as_float((unsigned)b << 16); }
__device__ __forceinline__ float bflo(unsigned w) { return __uint_as_float(w << 16); }
__device__ __forceinline__ float bfhi(unsigned w) { return __uint_as_float(w & 0xffff0000u); }
__device__ __forceinline__ h16x2 as_h2(unsigned w) { return __builtin_bit_cast(h16x2, w); }
template <bool HI> __device__ __forceinline__ h16x2 cvt8h(int w) { return __builtin_bit_cast(h16x2, __builtin_amdgcn_cvt_scalef32_pk_f16_fp8(w, 1.0f, HI)); }
__device__ __forceinline__ float gelu_tanh(float x) { const float u = 1.5957691216057308f * (x + 0.044715f * x * x * x); return x / (1.f + __expf(-u)); }
__device__ __forceinline__ float wave_sum(float v) {
#pragma unroll
    for (int o = 1; o < 64; o <<= 1) v += __shfl_xor(v, o);
    return v;
}
__device__ __forceinline__ float wave_max(float v) {
#pragma unroll
    for (int o = 1; o < 64; o <<= 1) v = fmaxf(v, __shfl_xor(v, o));
    return v;
}
template <int N, int S0> __device__ __forceinline__ float bfly_reduce(float (&v)[N], int lane) {
    int s = S0;
#pragma unroll
    for (int cnt = N; cnt > 1; cnt >>= 1) {
        const bool up = (lane & s) != 0;
#pragma unroll
        for (int i = 0; i < cnt / 2; ++i) { const float a = v[i], b = v[i + cnt / 2]; const float send = up ? a : b, keep = up ? b : a; v[i] = keep + __shfl_xor(send, s); }
        s >>= 1;
    }
    float r = v[0];
    for (; s >= 1; s >>= 1) r += __shfl_xor(r, s);
    return r;
}

__device__ __forceinline__ void tr_item(const float* W, int ldw, int srccol, bf16* WT, int K, int dstrow, int k0, LAS float* scr, int lane) {
#pragma unroll 8
    for (int i = 0; i < 32; ++i) { const int kk = 2 * i + (lane >> 5); scr[kk * 33 + (lane & 31)] = W[(size_t)(k0 + kk) * ldw + srccol + (lane & 31)]; }
    LDS_WAIT(); asm volatile("" ::: "memory");
    const int c = lane & 7;
#pragma unroll
    for (int j = 0; j < 4; ++j) { const int n = (lane >> 3) + 8 * j; const LAS float* s = scr + (8 * c) * 33 + n;
        v4u o; o.x = pk2(s[0 * 33], s[1 * 33]); o.y = pk2(s[2 * 33], s[3 * 33]); o.z = pk2(s[4 * 33], s[5 * 33]); o.w = pk2(s[6 * 33], s[7 * 33]);
        *(GAS v4u*)(WT + (size_t)(dstrow + n) * K + k0 + 8 * c) = o; }
    LDS_WAIT(); asm volatile("" ::: "memory");
}
__device__ __forceinline__ void phase_prep(KArgs a, LAS unsigned char* lds, int G, int vcu, int tid, int lane, int wave) {
    unsigned char* ws = a->ws;
    LAS float* scr = (LAS float*)(lds + wave * 16384);
    const int gw = vcu * NWAVES + wave, NGW = G * NWAVES;
    constexpr int I_IN = 2048, I_OUT = 1024, I_WQ = 2048, I_GLU = 64;
    for (int it = gw; it < I_IN + I_OUT + I_WQ + I_GLU; it += NGW) {
        int r = it;
        if (r < I_IN) { const int l = r >> 10, q = r & 1023, kb = q >> 6, nb = q & 63, n0 = nb * 32;
            tr_item(a->in[2] + (size_t)l * DM * INC, INC, n0 + (n0 >= 1536 ? 8 : 0), (bf16*)(ws + WS_WIN) + (size_t)l * 2048 * 1024, 1024, n0, kb * 64, scr, lane); continue; }
        r -= I_IN;
        if (r < I_OUT) { const int l = r >> 9, q = r & 511, kb = q >> 5, nb = q & 31;
            tr_item(a->in[19] + (size_t)l * DM * DM, DM, nb * 32, (bf16*)(ws + WS_WOUT) + (size_t)l * 1024 * 1024, 1024, nb * 32, kb * 64, scr, lane); continue; }
        r -= I_OUT;
        if (r < I_WQ) { const int l = r >> 10, q = r & 1023, kb = q >> 6, nb = q & 63;
            tr_item(a->in[21] + (size_t)l * DM * PQW, PQW, nb * 32, (bf16*)(ws + WS_WQ) + (size_t)l * 2048 * 1024, 1024, nb * 32, kb * 64, scr, lane); continue; }
        r -= I_WQ;
        { const int l = r >> 5, q = r & 31, kb = q >> 3, nb = q & 7;
            tr_item(a->in[16] + (size_t)l * 256 * 256, 256, nb * 32, (bf16*)(ws + WS_WGLU) + (size_t)l * 256 * 256, 256, nb * 32, kb * 64, scr, lane); }
    }
    const size_t gt = (size_t)vcu * NTHR + tid, NGT = (size_t)G * NTHR;
    for (size_t i = gt; i < 2 * 8 * 1024; i += NGT) { const int l = (int)(i >> 13), h = (int)(i >> 10) & 7, k = (int)i & 1023;
        ((float*)(ws + WS_WF))[i] = a->in[2][((size_t)l * DM + k) * INC + 1536 + h]; }
    { const float* src = a->in[22]; bf16* dst = (bf16*)(ws + WS_KEYS);
      for (size_t i = gt; i < (size_t)2 * 8 * 2 * 128 * 128 / 8; i += NGT) { const f32x4 x0 = *(const f32x4*)(src + i * 8), x1 = *(const f32x4*)(src + i * 8 + 4);
          v4u o; o.x = pk2(x0[0], x0[1]); o.y = pk2(x0[2], x0[3]); o.z = pk2(x1[0], x1[1]); o.w = pk2(x1[2], x1[3]); *(v4u*)(dst + i * 8) = o; } }
    { const float* src = a->in[23]; unsigned char* dst = ws + WS_U;
#pragma unroll 1
      for (size_t i = gt; i < (size_t)2 * NEXP * DM / 16; i += NGT) { v4u o;
#pragma unroll
          for (int q = 0; q < 4; ++q) { const f32x4 x = *(const f32x4*)(src + i * 16 + 4 * q) * U8_SCALE;
              const int q0 = (int)__builtin_rintf(fminf(fmaxf(x[0], -127.f), 127.f)), q1 = (int)__builtin_rintf(fminf(fmaxf(x[1], -127.f), 127.f)), q2 = (int)__builtin_rintf(fminf(fmaxf(x[2], -127.f), 127.f)), q3 = (int)__builtin_rintf(fminf(fmaxf(x[3], -127.f), 127.f));
              o[q] = (unsigned)((q0 & 255) | ((q1 & 255) << 8) | ((q2 & 255) << 16) | (q3 << 24)); }
          const size_t r = i >> 6; const unsigned cg = (unsigned)(i & 63), l = (unsigned)(r / NEXP), rl = (unsigned)(r % NEXP);
          *(v4u*)(dst + (size_t)l * NEXP * DM + (size_t)(cg >> 3) * NEXP * 128 + (size_t)rl * 128 + (cg & 7u) * 16u) = o; } }
    { const float* src = a->in[24]; unsigned char* dst = ws + WS_V;
#pragma unroll 1
      for (size_t i = gt; i < (size_t)2 * NEXP * DM / 16; i += NGT) { v4u o;
#pragma unroll
          for (int q = 0; q < 4; ++q) { f32x4 x = *(const f32x4*)(src + i * 16 + 4 * q) * V8_SCALE;
              x[0] = fminf(fmaxf(x[0], -448.f), 448.f); x[1] = fminf(fmaxf(x[1], -448.f), 448.f); x[2] = fminf(fmaxf(x[2], -448.f), 448.f); x[3] = fminf(fmaxf(x[3], -448.f), 448.f);
              int w = 0; w = __builtin_amdgcn_cvt_pk_fp8_f32(x[0], x[1], w, false); w = __builtin_amdgcn_cvt_pk_fp8_f32(x[2], x[3], w, true); o[q] = (unsigned)w; }
          const size_t r = i >> 6; const unsigned cg = (unsigned)(i & 63), l = (unsigned)(r / NEXP), rl = (unsigned)(r % NEXP);
          *(v4u*)(dst + (size_t)l * NEXP * DM + (size_t)(cg >> 3) * NEXP * 128 + (size_t)rl * 128 + (cg & 7u) * 16u) = o; } }
}

template <bool FLOGIT> __device__ __forceinline__ void phase_rownorm(const float* x, const float* g, bf16* XN, const float* WF, const float* fbias, float* CB, int G, int vcu, int lane, int wave, unsigned char* XN8 = nullptr, float* HSC = nullptr) {
    const int gw = vcu * NWAVES + wave, NGW = G * NWAVES;
    f32x4 gv[4];
#pragma unroll
    for (int j = 0; j < 4; ++j) gv[j] = *(const f32x4*)(g + 4 * lane + 256 * j);
    f32x4 vn[2][4];
#define RN_LOAD(rg_) do { _Pragma("unroll") for (int r = 0; r < 2; ++r) { const float* xr = x + (size_t)((rg_) * 2 + r) * DM + 4 * lane; _Pragma("unroll") for (int j = 0; j < 4; ++j) vn[r][j] = *(const f32x4*)(xr + 256 * j); } } while (0)
    if (gw < NTOK / 2) RN_LOAD(gw);
    for (int rg = gw; rg < NTOK / 2; rg += NGW) {
        f32x4 v[2][4];
#pragma unroll
        for (int r = 0; r < 2; ++r)
#pragma unroll
            for (int j = 0; j < 4; ++j) v[r][j] = vn[r][j];
        if (rg + NGW < NTOK / 2) RN_LOAD(rg + NGW);
#pragma unroll
        for (int r = 0; r < 2; ++r) { float s = 0.f;
#pragma unroll
            for (int j = 0; j < 4; ++j) s += (v[r][j][0] * v[r][j][0] + v[r][j][1] * v[r][j][1]) + (v[r][j][2] * v[r][j][2] + v[r][j][3] * v[r][j][3]);
            const float rstd = 1.0f / sqrtf(wave_sum(s) * (1.f / DM) + EPSN);
            bf16* orow = XN + (size_t)(rg * 2 + r) * DM + 4 * lane;
#pragma unroll
            for (int j = 0; j < 4; ++j) { v[r][j] = v[r][j] * rstd * gv[j]; u32x2 w; w.x = pk2(v[r][j][0], v[r][j][1]); w.y = pk2(v[r][j][2], v[r][j][3]); *(u32x2*)(orow + 256 * j) = w; }
            if (!FLOGIT && XN8) { float mx = 0.f;
#pragma unroll
                for (int j = 0; j < 4; ++j) mx = fmaxf(fmaxf(mx, fmaxf(fabsf(v[r][j][0]), fabsf(v[r][j][1]))), fmaxf(fabsf(v[r][j][2]), fabsf(v[r][j][3])));
                mx = fmaxf(wave_max(mx), 1e-20f); const float qs = 127.f / mx;
#pragma unroll
                for (int j = 0; j < 4; ++j) { const int q0 = (int)__builtin_rintf(v[r][j][0] * qs), q1 = (int)__builtin_rintf(v[r][j][1] * qs), q2 = (int)__builtin_rintf(v[r][j][2] * qs), q3 = (int)__builtin_rintf(v[r][j][3] * qs);
                    *(unsigned*)(XN8 + (size_t)(rg * 2 + r) * DM + 4 * lane + 256 * j) = (unsigned)((q0 & 255) | ((q1 & 255) << 8) | ((q2 & 255) << 16) | (q3 << 24)); }
                if (lane == 0) HSC[rg * 2 + r] = mx * (1.f / 127.f); } }
        if (FLOGIT) {
            float acc[16];
#pragma unroll
            for (int i = 0; i < 16; ++i) acc[i] = 0.f;
#pragma unroll
            for (int h = 0; h < 8; ++h)
#pragma unroll
                for (int j = 0; j < 4; ++j) { const f32x4 w = *(const f32x4*)(WF + h * 1024 + 4 * lane + 256 * j);
#pragma unroll
                    for (int r = 0; r < 2; ++r) acc[r * 8 + h] += (v[r][j][0] * w[0] + v[r][j][1] * w[1]) + (v[r][j][2] * w[2] + v[r][j][3] * w[3]); }
            const float tot = bfly_reduce<16, 32>(acc, lane);
            if ((lane & 3) == 0) { const int id = (lane >> 2) & 15, r = id >> 3, h = id & 7; const int row = rg * 2 + r, b = row / SEQ, s = row % SEQ;
                const float z = tot + fbias[h];
                const float ls = fminf(z, 0.f) - __logf(1.f + __expf(-fabsf(z)));
                CB[((size_t)(b * NH + h)) * SEQ + s] = ls * LOG2E; }
        }
    }
}

__device__ __forceinline__ void phase_cumsum(float* c, int lane) {
    float carry = 0.f;
#pragma unroll 1
    for (int it0 = 0; it0 < SEQ / 64; it0 += 16) { float vv[16];
#pragma unroll
        for (int q = 0; q < 16; ++q) vv[q] = c[(it0 + q) * 64 + lane];
#pragma unroll
        for (int q = 0; q < 16; ++q) { float v = vv[q];
#pragma unroll
            for (int o = 1; o < 64; o <<= 1) { const float t = __shfl_up(v, o); if (lane >= o) v += t; }
            v += carry; c[(it0 + q) * 64 + lane] = v; carry = __shfl(v, 63); } }
}

__device__ __forceinline__ void phase_pool(const bf16* PS, const float* pw, const float* pscale, const float* ong, bf16* MG, LAS unsigned char* lds, int G, int bx, int tid, int lane, int wave) {
    LAS float* ut = (LAS float*)lds;
    LAS float* pl = (LAS float*)(lds + 47 * 256 * 4);
    const int ch = tid & 255, half = tid >> 8, g = ch >> 6, w = 2 << g;
    float wcol[64];
#pragma unroll
    for (int c = 0; c < 64; ++c) wcol[c] = pw[(g * 64 + c) * 64 + (ch & 63)];
    const float psc = pscale[ch];
    const f32x4 gn = *(const f32x4*)(ong + 512 + 4 * lane);
    v4u wq[3];
#define POOL_LOAD(tile_) do { const int tok0_ = (tile_) * 32, s0_ = tok0_ % SEQ; _Pragma("unroll") for (int q = 0; q < 3; ++q) { const int idx = tid + q * NTHR, rr = idx >> 5, cq = idx & 31, r = rr - 15; \
        wq[q] = (v4u){0u, 0u, 0u, 0u}; if (idx < 47 * 32 && s0_ + r >= 0) wq[q] = *(const v4u*)(PS + (size_t)(tok0_ + r) * 512 + cq * 8); } } while (0)
    if (bx < NTOK / 32) POOL_LOAD(bx);
    for (int tile = bx; tile < NTOK / 32; tile += G) {
        const int tok0 = tile * 32, s0 = tok0 % SEQ;
#pragma unroll
        for (int q = 0; q < 3; ++q) { const int idx = tid + q * NTHR, rr = idx >> 5, cq = idx & 31; const v4u wv = wq[q];
            if (idx < 47 * 32) { LAS float* d = ut + rr * 256 + cq * 8;
                *(LAS f32x4*)d = (f32x4){bflo(wv.x), bfhi(wv.x), bflo(wv.y), bfhi(wv.y)}; *(LAS f32x4*)(d + 4) = (f32x4){bflo(wv.z), bfhi(wv.z), bflo(wv.w), bfhi(wv.w)}; } }
        if (tile + G < NTOK / 32) POOL_LOAD(tile + G);
        __syncthreads();
        { float s = 0.f; const int rr0 = half * 16 + 15;
            for (int j = 1; j < w; ++j) s += ut[(rr0 - j) * 256 + ch];
#pragma unroll 4
            for (int tt = 0; tt < 16; ++tt) { const int ti = half * 16 + tt, rr = ti + 15, pos = s0 + ti; const float cur = ut[rr * 256 + ch];
                s += cur; const int cnt = (pos + 1 < w) ? pos + 1 : w;
                pl[ti * 256 + ch] = s / (float)cnt - cur; s -= ut[(rr - w + 1) * 256 + ch]; } }
        __syncthreads();
#pragma unroll 1
        for (int tt = 0; tt < 16; ++tt) { const int ti = half * 16 + tt; const LAS f32x4* pr = (const LAS f32x4*)(pl + ti * 256 + g * 64);
            float acc = 0.f;
#pragma unroll
            for (int c4 = 0; c4 < 16; ++c4) { const f32x4 v = pr[c4]; acc += (v[0] * wcol[4 * c4] + v[1] * wcol[4 * c4 + 1]) + (v[2] * wcol[4 * c4 + 2] + v[3] * wcol[4 * c4 + 3]); }
            ut[ti * 256 + ch] = acc * psc; }
        __syncthreads();
#pragma unroll
        for (int q = 0; q < 4; ++q) { const int ti = wave * 4 + q; const f32x4 v = *(const LAS f32x4*)(ut + ti * 256 + 4 * lane);
            const float ss = wave_sum((v[0] * v[0] + v[1] * v[1]) + (v[2] * v[2] + v[3] * v[3]));
            const float rstd = 1.0f / sqrtf(ss * (1.f / 256.f) + EPSN);
            u32x2 o; o.x = pk2(v[0] * rstd * gn[0], v[1] * rstd * gn[1]); o.y = pk2(v[2] * rstd * gn[2], v[3] * rstd * gn[3]);
            *(u32x2*)(MG + (size_t)(tok0 + ti) * DM + 512 + 4 * lane) = o; }
        __syncthreads();
    }
}

template <bool PASS2> __device__ __forceinline__ void phase_s5(KArgs a, int l, const bf16* PS, float* XLOC, bf16* Z, LAS unsigned char* lds, int G, int bx, int lane, int wave) {
    constexpr int XST = 132;
    LAS float* Xs = (LAS float*)(lds + wave * (16 * XST * 4));
    const int p = lane, kq = lane >> 4, ln = lane & 15;
    for (int task = bx; task < NB * 16 * 8; task += G) {
        const int b = task >> 7, g = (task >> 3) & 15, c = (task & 7) * 8 + wave;
        const size_t tok_c = (size_t)b * SEQ + c * 64;
        const float a_re = a->in[8][(l * 16 + g) * 64 + p], a_im = a->in[9][(l * 16 + g) * 64 + p], ldt = a->in[10][l * 16 + g];
        u32x2 uraw[4];
#pragma unroll
        for (int sub = 0; sub < 4; ++sub) uraw[sub] = *(const u32x2*)(PS + (tok_c + sub * 16 + ln) * 512 + 256 + g * 16 + 4 * kq);
        float braw[4][4], biaw[4][4];
#pragma unroll
        for (int q = 0; q < 4; ++q)
#pragma unroll
            for (int ks = 0; ks < 4; ++ks) { const size_t bi = ((size_t)((l * 16 + g) * 64 + 16 * q + ln)) * 16 + 4 * kq + ks; braw[q][ks] = a->in[11][bi]; biaw[q][ks] = a->in[12][bi]; }
        bf16x8 cfrag[4]; float dsk = 0.f; unsigned short usk[16];
        if (PASS2) {
#pragma unroll
            for (int s4 = 0; s4 < 4; ++s4) { float cv[8];
#pragma unroll
                for (int j = 0; j < 8; ++j) { const int k = 32 * s4 + 8 * kq + j, pp = k & 63; const size_t ci = ((size_t)((l * 16 + g) * 16 + ln)) * 64 + pp; cv[j] = (s4 < 2) ? a->in[13][ci] : -a->in[14][ci]; }
                const v4u pk = {pk2(cv[0], cv[1]), pk2(cv[2], cv[3]), pk2(cv[4], cv[5]), pk2(cv[6], cv[7])}; cfrag[s4] = __builtin_bit_cast(bf16x8, pk); }
            dsk = a->in[15][l * 256 + g * 16 + ln];
#pragma unroll
            for (int i = 0; i < 16; ++i) usk[i] = PS[(tok_c + (i >> 2) * 16 + 4 * kq + (i & 3)) * 512 + 256 + g * 16 + ln];
        }
        const float dt = expf(ldt);
        float abr, abi, fr, fi;
        { const float xx = a_re * dt, yy = a_im * dt; const float ex = expf(xx); float sn, cs; sincosf(yy, &sn, &cs);
          abr = ex * cs; abi = ex * sn;
          const float sh = sinf(0.5f * yy); const float er = expm1f(xx) * cs - 2.f * sh * sh, ei = abi;
          const float den = a_re * a_re + a_im * a_im; fr = (er * a_re + ei * a_im) / den; fi = (ei * a_re - er * a_im) / den; }
        float bfrag[8][4];
#pragma unroll
        for (int q = 0; q < 4; ++q) { const float frq = __shfl(fr, 16 * q + ln), fiq = __shfl(fi, 16 * q + ln);
#pragma unroll
            for (int ks = 0; ks < 4; ++ks) { bfrag[q][ks] = frq * braw[q][ks] - fiq * biaw[q][ks]; bfrag[4 + q][ks] = frq * biaw[q][ks] + fiq * braw[q][ks]; } }
        float xr = 0.f, xi = 0.f;
        if (PASS2) {
            float pr = abr, pi = abi;
#pragma unroll
            for (int q = 0; q < 6; ++q) { const float nr = pr * pr - pi * pi, ni = 2.f * pr * pi; pr = nr; pi = ni; }
            const float* xl = XLOC + ((size_t)(b * 16 + g) * 64) * 128 + p;
            int j = 0;
#pragma unroll 1
            for (; j + 16 <= c; j += 16) { float lr[16], li[16];
#pragma unroll
                for (int q = 0; q < 16; ++q) { lr[q] = xl[(size_t)(j + q) * 128]; li[q] = xl[(size_t)(j + q) * 128 + 64]; }
#pragma unroll
                for (int q = 0; q < 16; ++q) { const float nr = pr * xr - pi * xi + lr[q], ni = pr * xi + pi * xr + li[q]; xr = nr; xi = ni; } }
            { float lr[16], li[16];
#pragma unroll
                for (int q = 0; q < 16; ++q) { const int jj = (j + q < c) ? j + q : 0; lr[q] = xl[(size_t)jj * 128]; li[q] = xl[(size_t)jj * 128 + 64]; }
#pragma unroll
                for (int q = 0; q < 16; ++q) if (j + q < c) { const float nr = pr * xr - pi * xi + lr[q], ni = pr * xi + pi * xr + li[q]; xr = nr; xi = ni; } }
        }
#pragma unroll
        for (int sub = 0; sub < 4; ++sub) {
            const size_t tokb = tok_c + sub * 16;
            const float ua[4] = {bflo(uraw[sub].x), bfhi(uraw[sub].x), bflo(uraw[sub].y), bfhi(uraw[sub].y)};
#pragma unroll
            for (int nb = 0; nb < 8; ++nb) { f32x4 acc = {0.f, 0.f, 0.f, 0.f};
#pragma unroll
                for (int ks = 0; ks < 4; ++ks) acc = __builtin_amdgcn_mfma_f32_16x16x4f32(ua[ks], bfrag[nb][ks], acc, 0, 0, 0);
#pragma unroll
                for (int r = 0; r < 4; ++r) Xs[(4 * kq + r) * XST + 16 * nb + ln] = acc[r]; }
            float bur[16], bui[16];
#pragma unroll
            for (int i = 0; i < 16; ++i) { bur[i] = Xs[i * XST + p]; bui[i] = Xs[i * XST + 64 + p]; }
#pragma unroll
            for (int i = 0; i < 16; ++i) { const float nr = abr * xr - abi * xi + bur[i], ni = abr * xi + abi * xr + bui[i]; xr = nr; xi = ni;
                if (PASS2) { Xs[i * XST + p] = xr; Xs[i * XST + 64 + p] = xi; } }
            if (PASS2) {
                f32x4 y0 = {0.f, 0.f, 0.f, 0.f};
                asm volatile("" ::: "memory");
#pragma unroll
                for (int s4 = 0; s4 < 4; ++s4) { const f32x4 x0 = *(const LAS f32x4*)(Xs + ln * XST + 32 * s4 + 8 * kq), x1 = *(const LAS f32x4*)(Xs + ln * XST + 32 * s4 + 8 * kq + 4);
                    const v4u pk = {pk2(x0[0], x0[1]), pk2(x0[2], x0[3]), pk2(x1[0], x1[1]), pk2(x1[2], x1[3])};
                    y0 = __builtin_amdgcn_mfma_f32_16x16x32_bf16(__builtin_bit_cast(bf16x8, pk), cfrag[s4], y0, 0, 0, 0); }
                asm volatile("" ::: "memory");
#pragma unroll
                for (int r = 0; r < 4; ++r) { const size_t tk = tokb + 4 * kq + r; const float uv = bf2f(usk[sub * 4 + r]);
                    const float y = y0[r] + dsk * uv; Z[tk * 256 + g * 16 + ln] = (bf16)f2bf(gelu_tanh(y)); }
            }
        }
        if (!PASS2) { float* xl = XLOC + ((size_t)((b * 16 + g) * 64 + c)) * 128 + p; xl[0] = xr; xl[64] = xi; }
    }
}

__device__ __forceinline__ void phase_glu(const bf16* Z, const bf16* WG, const float* gb, const float* ong, bf16* MG, LAS unsigned char* lds, int G, int bx, int vcu, int tid, int lane, int wave) {
    LAS unsigned char* zt = lds;
    LAS float* ssq = (LAS float*)(lds + 64 * 528);
    LAS float* rs = ssq + 64 * 8;
    const int n = 32 * wave + (lane & 31), hs = lane >> 5;
    const float bn = gb[n], gnn = ong[768 + n];
    for (int tile = bx; tile < NTOK / 64; tile += G) {
        const size_t tok0 = (size_t)tile * 64;
        for (int idx = tid; idx < 64 * 32; idx += NTHR) { const int r = idx >> 5, cq = idx & 31; *(LAS v4u*)(zt + r * 528 + cq * 16) = *(const v4u*)(Z + (tok0 + r) * 256 + cq * 8); }
        __syncthreads();
        f32x16 acc[2]; acc[0] = f32x16{}; acc[1] = f32x16{};
#pragma unroll
        for (int ks = 0; ks < 16; ++ks) { const bf16x8 bw = *(const bf16x8*)(WG + (size_t)n * 256 + ks * 16 + 8 * hs);
#pragma unroll
            for (int mb = 0; mb < 2; ++mb) { const bf16x8 az = *(const LAS bf16x8*)(zt + (mb * 32 + (lane & 31)) * 528 + (ks * 16 + 8 * hs) * 2);
                acc[mb] = __builtin_amdgcn_mfma_f32_32x32x16_bf16(az, bw, acc[mb], 0, 0, 0); } }
        float val[32], sq[32];
#pragma unroll
        for (int mb = 0; mb < 2; ++mb)
#pragma unroll
            for (int r = 0; r < 16; ++r) { const int m = mb * 32 + (r & 3) + 8 * (r >> 2) + 4 * hs; const float z = bf2f(*(const LAS unsigned short*)(zt + m * 528 + n * 2));
                const float v = z / (1.f + __expf(-(acc[mb][r] + bn))); val[mb * 16 + r] = v; sq[mb * 16 + r] = v * v; }
        const float tot = bfly_reduce<32, 16>(sq, lane);
        { const int id = lane & 31, mb = id >> 4, r = id & 15, m = mb * 32 + (r & 3) + 8 * (r >> 2) + 4 * hs; ssq[m * 8 + wave] = tot; }
        __syncthreads();
        if (tid < 64) { float s = 0.f;
#pragma unroll
            for (int w8 = 0; w8 < 8; ++w8) s += ssq[tid * 8 + w8];
            rs[tid] = 1.0f / sqrtf(s * (1.f / 256.f) + EPSN); }
        __syncthreads();
#pragma unroll
        for (int mb = 0; mb < 2; ++mb)
#pragma unroll
            for (int r = 0; r < 16; ++r) { const int m = mb * 32 + (r & 3) + 8 * (r >> 2) + 4 * hs;
                MG[(tok0 + m) * DM + 768 + n] = (bf16)f2bf(val[mb * 16 + r] * rs[m] * gnn); }
        __syncthreads();
    }
    const int gw = vcu * NWAVES + wave, NGW = G * NWAVES;
    float g8[8];
#pragma unroll
    for (int j = 0; j < 8; ++j) g8[j] = ong[8 * lane + j];
    for (int row = gw; row < NTOK; row += NGW) {
        bf16* pp = MG + (size_t)row * DM + 8 * lane;
        const v4u w = *(const v4u*)pp; float f[8] = {bflo(w.x), bfhi(w.x), bflo(w.y), bfhi(w.y), bflo(w.z), bfhi(w.z), bflo(w.w), bfhi(w.w)};
        float s = 0.f;
#pragma unroll
        for (int j = 0; j < 8; ++j) s += f[j] * f[j];
        const float rstd = 1.0f / sqrtf(wave_sum(s) * (1.f / 512.f) + EPSN);
        v4u o; o.x = pk2(f[0] * rstd * g8[0], f[1] * rstd * g8[1]); o.y = pk2(f[2] * rstd * g8[2], f[3] * rstd * g8[3]);
        o.z = pk2(f[4] * rstd * g8[4], f[5] * rstd * g8[5]); o.w = pk2(f[6] * rstd * g8[6], f[7] * rstd * g8[7]); *(v4u*)pp = o;
    }
}

__device__ __forceinline__ void ins16(float (&top)[16], float x) {
#pragma unroll
    for (int i = 15; i >= 1; --i) top[i] = __builtin_amdgcn_fmed3f(top[i - 1], top[i], x);
    top[0] = fmaxf(top[0], x);
}
__device__ __forceinline__ float opq(float x) { asm("" : "+v"(x)); return x; }
__device__ __forceinline__ float tagf(float s, unsigned id, unsigned mask) { return __uint_as_float((__float_as_uint(s) & ~mask) | id); }
__device__ __forceinline__ void phase_select(const bf16* PQ, const bf16* KEYS, int* IDX, float* GATE, LAS unsigned char* lds, int G, int vcu, int tid, int lane, int wave) {
    constexpr int KROW = 272, KEYB = 2 * 128 * KROW;
    LAS unsigned* ids = (LAS unsigned*)(lds + KEYB + wave * 4096);
    const int tl = lane & 31, hs = lane >> 5;
    const float NEG = -__builtin_inff();
    const int nslot = (G >= 8) ? G / 8 : 1;
    for (int h = vcu % 8; h < 8; h += (G >= 8 ? 8 : G)) {
        __syncthreads();
        for (int idx = tid; idx < 2 * 128 * 16; idx += NTHR) { const int row = idx >> 4, cq = idx & 15;
            *(LAS v4u*)(lds + row * KROW + cq * 16) = *(const v4u*)((const char*)(KEYS + (size_t)h * 256 * 128) + (unsigned)(row * 256 + cq * 16)); }
        __syncthreads();
        const int slot = (G >= 8) ? vcu / 8 : 0;
        bf16x8 bq[2][8];
        int tb = slot * 8 + wave;
        if (tb < NTOK / 32) {
#pragma unroll
            for (int ks = 0; ks < 8; ++ks) bq[0][ks] = *(const bf16x8*)((const char*)(PQ + (size_t)tb * 32 * PQW + h * 256) + (unsigned)((tl * PQW + 8 * hs + ks * 16) * 2));
        }
#pragma unroll 1
        for (; tb < NTOK / 32; tb += 8 * nslot) {
            const size_t tok = (size_t)tb * 32 + tl;
            float t1[16], t2[16];
#pragma unroll
            for (int half = 0; half < 2; ++half) {
                { const int ntb = (half == 0) ? tb : tb + 8 * nslot; const int ntbc = (ntb < NTOK / 32) ? ntb : tb;
                  const bf16* qn = PQ + (size_t)ntbc * 32 * PQW + h * 256 + (half == 0 ? 128 : 0);
#pragma unroll
                  for (int ks = 0; ks < 8; ++ks) bq[half ^ 1][ks] = *(const bf16x8*)((const char*)qn + (unsigned)((tl * PQW + 8 * hs + ks * 16) * 2)); }
                f32x16 acc[4]; acc[0] = f32x16{}; acc[1] = f32x16{}; acc[2] = f32x16{}; acc[3] = f32x16{};
                const LAS unsigned char* kp = lds + (half * 128 + tl) * KROW + 16 * hs;
#pragma unroll
                for (int ks = 0; ks < 8; ++ks)
#pragma unroll
                    for (int kb = 0; kb < 4; ++kb) { const bf16x8 ak = *(const LAS bf16x8*)(kp + kb * 32 * KROW + ks * 32); acc[kb] = __builtin_amdgcn_mfma_f32_32x32x16_bf16(ak, bq[half][ks], acc[kb], 0, 0, 0); }
                float top[16], tb_[16], tc_[16], td_[16];
#pragma unroll
                for (int r = 0; r < 16; ++r) { const unsigned id = (unsigned)((r & 3) + 8 * (r >> 2) + 4 * hs);
                    top[r] = tagf(acc[0][r], id, 127u); tb_[r] = tagf(acc[1][r], 32u + id, 127u); tc_[r] = tagf(acc[2][r], 64u + id, 127u); td_[r] = tagf(acc[3][r], 96u + id, 127u); }
                sort16_desc(top); sort16_desc(tb_); sort16_desc(tc_); sort16_desc(td_);
                merge16_desc(top, tb_); merge16_desc(tc_, td_); merge16_desc(top, tc_);
                float oth[16];
#pragma unroll
                for (int i = 0; i < 16; ++i) oth[i] = __shfl_xor(top[i], 32);
                merge16_desc(top, oth);
#pragma unroll
                for (int i = 0; i < 16; ++i) { if (half == 0) t1[i] = top[i]; else t2[i] = top[i]; }
            }
#pragma unroll
            for (int i = 0; i < 16; ++i) ids[(tl * 2 + hs) * 16 + i] = __float_as_uint(hs ? opq(t2[i]) : opq(t1[i])) & 127u;
            float best[16];
#pragma unroll
            for (int i = 0; i < 16; ++i) best[i] = NEG;
#define CAND(a0, b0, a1, b1) { const float s0_ = opq(t1[a0] + t2[b0]), s1_ = opq(t1[a1] + t2[b1]); ins16(best, hs ? tagf(s1_, (unsigned)((a1) * 16 + (b1)), 255u) : tagf(s0_, (unsigned)((a0) * 16 + (b0)), 255u)); }
            CAND_LIST
#undef CAND
            { float oth[16];
#pragma unroll
              for (int i = 0; i < 16; ++i) oth[i] = __shfl_xor(best[i], 32);
              merge16_desc(best, oth); }
            float e[16], den = 0.f;
#pragma unroll
            for (int i = 0; i < 16; ++i) { e[i] = __expf(best[i] - best[0]); den += e[i]; }
            const float rden = 1.f / den;
            int ex[8]; float gt[8];
#pragma unroll
            for (int j = 0; j < 8; ++j) { const float bj = hs ? opq(best[8 + j]) : opq(best[j]); const unsigned id = __float_as_uint(bj) & 255u;
                const unsigned i1 = ids[(tl * 2 + 0) * 16 + (id >> 4)], i2 = ids[(tl * 2 + 1) * 16 + (id & 15u)];
                ex[j] = (int)(i1 * 128u + i2); gt[j] = (hs ? opq(e[8 + j]) : opq(e[j])) * rden; }
            int* ip = IDX + tok * 128 + h * 16 + hs * 8; float* gp = GATE + tok * 128 + h * 16 + hs * 8;
            *(v4u*)ip = (v4u){(unsigned)ex[0], (unsigned)ex[1], (unsigned)ex[2], (unsigned)ex[3]}; *(v4u*)(ip + 4) = (v4u){(unsigned)ex[4], (unsigned)ex[5], (unsigned)ex[6], (unsigned)ex[7]};
            *(f32x4*)gp = (f32x4){gt[0], gt[1], gt[2], gt[3]}; *(f32x4*)(gp + 4) = (f32x4){gt[4], gt[5], gt[6], gt[7]};
        }
    }
}

constexpr int GCH = 64;
constexpr int CW_Q = 8192;
template <int CTRL> __device__ __forceinline__ float dpp_mov(float v) { return __builtin_bit_cast(float, __builtin_amdgcn_update_dpp(0, __builtin_bit_cast(int, v), CTRL, 0xF, 0xF, true)); }
__device__ __forceinline__ float sum8(float s) {
    s += dpp_mov<0xB1>(s); s += dpp_mov<0x4E>(s); s += dpp_mov<0x141>(s); return s;
}
__device__ __forceinline__ void phase_gather_u(const unsigned char* XN8, const int* IDX, const unsigned char* U, float* PART, unsigned* queue, int lane, unsigned imask = 0xffffffffu) {
    const unsigned xcc = xb_xcc_id() & 7u; const int g = lane >> 3, j = lane & 7;
#pragma unroll 1
    for (unsigned sx = 0; sx < 8; ++sx) { const unsigned x = (xcc + sx) & 7u; unsigned* q = queue + x * 64;
        const unsigned char* Ux = U + (size_t)x * NEXP * 128; const unsigned jo = (unsigned)j * 16u, lane4 = (unsigned)lane * 4u; const unsigned char* Hx = XN8 + x * 128 + j * 16; const int* Ig = IDX + 16 * g;
#pragma unroll 1
        for (;;) {
            unsigned c = 0; if (lane == 0) c = __hip_atomic_fetch_add(q, 1u, __ATOMIC_RELAXED, __HIP_MEMORY_SCOPE_AGENT);
            c = (unsigned)__builtin_amdgcn_readfirstlane((int)c); if (c >= (unsigned)(NTOK / GCH)) break;
            const size_t tb = (size_t)c * GCH;
            v4u ix[2][4], hw[2], rw[16];
#define G1_IDX(ib, tok_) do { _Pragma("unroll") for (int q4 = 0; q4 < 4; ++q4) ix[ib][q4] = *(const v4u*)(Ig + (tok_) * 128 + 4 * q4) & imask; } while (0)
#define G1_AUX(ab, tok_) do { hw[ab] = *(const v4u*)(Hx + (tok_) * DM); } while (0)
#define G1_TOKEN(p, tt_) do { G1_AUX((p) ^ 1, tb + (((tt_) + 1 < GCH) ? (tt_) + 1 : (tt_))); \
            const v4u hq_ = hw[p]; int r0 = 0, r1 = 0; \
            _Pragma("unroll") for (int i = 0; i < 16; ++i) { const v4u rv_ = rw[i]; \
                rw[i] = *(const v4u*)(Ux + (ix[(p) ^ 1][i >> 2][i & 3] * 128u + jo)); \
                int s = __builtin_amdgcn_sdot4((int)hq_[0], (int)rv_[0], 0, false); s = __builtin_amdgcn_sdot4((int)hq_[1], (int)rv_[1], s, false); \
                s = __builtin_amdgcn_sdot4((int)hq_[2], (int)rv_[2], s, false); s = __builtin_amdgcn_sdot4((int)hq_[3], (int)rv_[3], s, false); \
                s += __builtin_amdgcn_update_dpp(0, s, 0xB1, 0xF, 0xF, true); s += __builtin_amdgcn_update_dpp(0, s, 0x4E, 0xF, 0xF, true); s += __builtin_amdgcn_update_dpp(0, s, 0x141, 0xF, 0xF, true); \
                if (i < 8) r0 = ((i & 7) == j) ? s : r0; else r1 = ((i & 7) == j) ? s : r1; } \
            unsigned* pp = (unsigned*)PART + ((size_t)x * NTOK + tb + (tt_)) * 64; *(unsigned*)((char*)pp + lane4) = pk2((float)r0, (float)r1);     \
            G1_IDX(p, tb + (((tt_) + 2 < GCH) ? (tt_) + 2 : (tt_))); } while (0)
            G1_IDX(0, tb); G1_IDX(1, tb + 1); G1_AUX(0, tb);
#pragma unroll
            for (int i = 0; i < 16; ++i) rw[i] = *(const v4u*)(Ux + (ix[0][i >> 2][i & 3] * 128u + jo));
#pragma unroll 1
            for (int tt = 0; tt < GCH; tt += 2) { G1_TOKEN(0, tt); G1_TOKEN(1, tt + 1); }
#undef G1_IDX
#undef G1_AUX
#undef G1_TOKEN
        }
    }
}
__device__ __forceinline__ void phase_gather_act(const float* PART, const float* GATE, const float* HSC, float* ACT, int G, int vcu, int tid) {
    const size_t gt = (size_t)vcu * NTHR + tid, NGT = (size_t)G * NTHR;
    for (size_t e4 = gt; e4 < (size_t)NTOK * 32; e4 += NGT) { const size_t tok = e4 >> 5; const int p = (int)(e4 & 31) * 4;
        f32x4 s = {0.f, 0.f, 0.f, 0.f};
#pragma unroll
        for (int x = 0; x < 8; ++x) { const v4u w = *(const v4u*)((const unsigned*)PART + ((size_t)x * NTOK + tok) * 64 + (p & 63));
            if (p < 64) { s[0] += bflo(w.x); s[1] += bflo(w.y); s[2] += bflo(w.z); s[3] += bflo(w.w); } else { s[0] += bfhi(w.x); s[1] += bfhi(w.y); s[2] += bfhi(w.z); s[3] += bfhi(w.w); } }
        const int k = (p < 64) ? 16 * (p >> 3) + (p & 7) : 16 * ((p - 64) >> 3) + 8 + (p & 7);
        const f32x4 gv = *(const f32x4*)(GATE + tok * 128 + k);
        f32x4 o;
        const float ds = HSC[tok] * (1.f / U8_SCALE);
#pragma unroll
        for (int i = 0; i < 4; ++i) { const _Float16 ah = (_Float16)(gv[i] * gelu_tanh(s[i] * ds) * (ACT_SCALE / V8_SCALE)); const h16x2 a2 = {ah, ah}; o[i] = __builtin_bit_cast(float, a2); }
        *(f32x4*)(ACT + e4 * 4) = o; }
}
__device__ __forceinline__ void phase_gather_v(const float* ACT, const int* IDX, const unsigned char* V, float* out, unsigned* queue, int lane) {
    const unsigned xcc = xb_xcc_id() & 7u; const int g = lane >> 3, j = lane & 7;
    typedef float f32x2v __attribute__((ext_vector_type(2)));
#pragma unroll 1
    for (unsigned sx = 0; sx < 8; ++sx) { const unsigned x = (xcc + sx) & 7u; unsigned* q = queue + x * 64;
        const unsigned char* Vx = V + (size_t)x * NEXP * 128; const unsigned jo = (unsigned)j * 16u; const int* Ig = IDX + 16 * g; float* Ob = out + x * 128; const unsigned lo = (unsigned)(16 * j + 2 * g) * 4u;
#pragma unroll 1
        for (;;) {
            unsigned c = 0; if (lane == 0) c = __hip_atomic_fetch_add(q, 1u, __ATOMIC_RELAXED, __HIP_MEMORY_SCOPE_AGENT);
            c = (unsigned)__builtin_amdgcn_readfirstlane((int)c); if (c >= (unsigned)(NTOK / GCH)) break;
            const size_t tb = (size_t)c * GCH;
            v4u ix[2][4], rw[16]; float a0[2], a1[2]; f32x2v ov[2]; const int bsel = (lane & ~7) * 4; const unsigned lane4 = (unsigned)lane * 4u;
#define G3_IDX(ib, tok_) do { _Pragma("unroll") for (int q4 = 0; q4 < 4; ++q4) ix[ib][q4] = *(const v4u*)(Ig + (tok_) * 128 + 4 * q4); } while (0)
#define G3_AUX(ab, tok_) do { a0[ab] = *(const float*)((const char*)(ACT + (tok_) * 128) + lane4); a1[ab] = *(const float*)((const char*)(ACT + (tok_) * 128 + 64) + lane4); { unsigned lo_ = lo; asm volatile("" : "+v"(lo_)); ov[ab] = *(const f32x2v*)((const char*)(Ob + (tok_) * DM) + lo_); } } while (0)
#define G3_TOKEN(p, tt_) do { G3_AUX((p) ^ 1, tb + (((tt_) + 1 < GCH) ? (tt_) + 1 : (tt_))); \
            h16x2 hacc[8]; \
            _Pragma("unroll") for (int i = 0; i < 8; ++i) hacc[i] = (h16x2){(_Float16)0.f, (_Float16)0.f}; \
            _Pragma("unroll") for (int i = 0; i < 16; ++i) { const v4u rv_ = rw[i]; \
                rw[i] = *(const v4u*)(Vx + (ix[(p) ^ 1][i >> 2][i & 3] * 128u + jo)); \
                const float a = __builtin_bit_cast(float, __builtin_amdgcn_ds_bpermute(bsel + 4 * (i & 7), __builtin_bit_cast(int, (i < 8) ? a0[p] : a1[p])));   \
                const h16x2 a2 = __builtin_bit_cast(h16x2, a); \
                _Pragma("unroll") for (int q4 = 0; q4 < 4; ++q4) { const int w = (int)rv_[q4]; \
                    hacc[2 * q4] = __builtin_elementwise_fma(cvt8h<false>(w), a2, hacc[2 * q4]); \
                    hacc[2 * q4 + 1] = __builtin_elementwise_fma(cvt8h<true>(w), a2, hacc[2 * q4 + 1]); } } \
            float acc[16]; \
            _Pragma("unroll") for (int i = 0; i < 8; ++i) { acc[2 * i] = (float)hacc[i].x; acc[2 * i + 1] = (float)hacc[i].y; } \
            int s_ = 32; \
            _Pragma("unroll") for (int cnt = 16; cnt > 2; cnt >>= 1) { const bool up = (lane & s_) != 0; \
                _Pragma("unroll") for (int i = 0; i < cnt / 2; ++i) { const float a = acc[i], b = acc[i + cnt / 2]; const float send = up ? a : b, keep = up ? b : a; acc[i] = keep + __shfl_xor(send, s_); } \
                s_ >>= 1; } \
            f32x2v o = ov[p]; o[0] += acc[0] * (1.f / ACT_SCALE); o[1] += acc[1] * (1.f / ACT_SCALE); \
            { unsigned lo_ = lo; asm volatile("" : "+v"(lo_)); *(f32x2v*)((char*)(Ob + (tb + (tt_)) * DM) + lo_) = o; } \
            G3_IDX(p, tb + (((tt_) + 2 < GCH) ? (tt_) + 2 : (tt_))); } while (0)
            G3_IDX(0, tb); G3_IDX(1, tb + 1); G3_AUX(0, tb);
#pragma unroll
            for (int i = 0; i < 16; ++i) rw[i] = *(const v4u*)(Vx + (ix[0][i >> 2][i & 3] * 128u + jo));
#pragma unroll 1
            for (int tt = 0; tt < GCH; tt += 2) { G3_TOKEN(0, tt); G3_TOKEN(1, tt + 1); }
#undef G3_IDX
#undef G3_AUX
#undef G3_TOKEN
        }
    }
}

__device__ __forceinline__ void phase_gather_naive(const bf16* XN, const int* IDX, const float* GATE, const float* U, const float* V, float* out, int G, int vcu, int lane, int wave) {
    const int gw = vcu * NWAVES + wave, NGW = G * NWAVES;
    for (int tok = gw; tok < NTOK; tok += NGW) {
        float hv[16], acc[16];
#pragma unroll
        for (int j = 0; j < 16; ++j) { hv[j] = bf2f(XN[(size_t)tok * DM + lane + 64 * j]); acc[j] = 0.f; }
        for (int k = 0; k < 128; ++k) { const int e = IDX[(size_t)tok * 128 + k]; const float g = GATE[(size_t)tok * 128 + k];
            float s = 0.f;
#pragma unroll
            for (int j = 0; j < 16; ++j) s += hv[j] * U[(size_t)e * DM + lane + 64 * j];
            s = wave_sum(s); const float a = g * gelu_tanh(s);
#pragma unroll
            for (int j = 0; j < 16; ++j) acc[j] += a * V[(size_t)e * DM + lane + 64 * j]; }
#pragma unroll
        for (int j = 0; j < 16; ++j) out[(size_t)tok * DM + lane + 64 * j] += acc[j];
    }
}
constexpr int PH_PER_LAYER = 15, N_PHASES = 1 + 2 * PH_PER_LAYER;
__device__ __forceinline__ KArgs kargs() { KArgs p = (KArgs)__builtin_amdgcn_kernarg_segment_ptr(); asm volatile("" : "+s"(p)); return p; }
__global__ void __launch_bounds__(NTHR, 2) mega_fwd(Args a_unused) {
    extern __shared__ __attribute__((aligned(16))) unsigned char lds_raw[];
    LAS unsigned char* lds = (LAS unsigned char*)lds_raw;
    volatile LAS unsigned* MISC = (volatile LAS unsigned*)(lds + MISC_OFF);
    const int tid0 = threadIdx.x;
    for (int u = tid0; u < (LDS_BYTES - LDSCTL_OFF) / 4; u += NTHR) ((LAS unsigned*)(lds + LDSCTL_OFF))[u] = 0u;
    __syncthreads();
    { const unsigned hw = (unsigned)__builtin_amdgcn_s_getreg((6 << 11) | 4); if ((tid0 & 63) == 0) *(volatile LAS int*)(lds + OTID_LDS_OFF + 4 * (hw & 63u)) = tid0 >> 6; }
    __syncthreads();
    XcdBarrier bar; { KArgs ka = kargs(); unsigned char* ws0 = ka->ws; bar.bar = (unsigned*)(ws0 + WS_CTL) + CW_BAR; bar.x = 0; bar.st = nullptr;
      if (ka->use_bar) bar = xcd_barrier_post((unsigned*)(ws0 + WS_CTL) + CW_BAR, MISC + 8); }
    const int ph_lo = kargs()->ph_lo, ph_hi = kargs()->ph_hi;
#define TLW const int tid = otid(), lane = tid & 63, wave = __builtin_amdgcn_readfirstlane(tid >> 6); (void)tid; (void)lane; (void)wave;
#pragma unroll 1
    for (int pc = ph_lo; pc < ph_hi + (DUP_PH >= 0 ? 1 : 0); ++pc) {
        const int ph = (DUP_PH >= 0 && pc > DUP_PH) ? pc - 1 : pc;
        unsigned long long tph0_ = 0; if (TIME_PH >= 0 && (pc == TIME_PH || TIME_PH == 99)) tph0_ = __builtin_amdgcn_s_memrealtime();
        KArgs a = kargs(); unsigned char* ws = a->ws;
        int G = gridDim.x, bx = blockIdx.x; asm volatile("" : "+s"(G), "+s"(bx)); const int vcu = (G % 8 == 0) ? (bx % 8) * (G / 8) + bx / 8 : bx;
        bf16* const XN = (bf16*)(ws + WS_XN); bf16* const Pq = (bf16*)(ws + WS_P); bf16* const Pk = Pq + (size_t)NTOK * 512; bf16* const Pv = Pk + (size_t)NTOK * 512; bf16* const Ps = Pv + (size_t)NTOK * 512;
        bf16* const MG = (bf16*)(ws + WS_MG); float* const CB = (float*)(ws + WS_CB); float* const XLOC = (float*)(ws + WS_XLOC); bf16* const Z = (bf16*)(ws + WS_Z);
        int* const IDX = (int*)(ws + WS_IDX); float* const GATE = (float*)(ws + WS_GATE);
        if (ph == 0) { TLW if (PH_MASK & 1u) phase_prep(a, lds, G, vcu, tid, lane, wave); }
        else {
            const int l = (ph - 1) / PH_PER_LAYER, sub = (ph - 1) % PH_PER_LAYER;
            const float* xin = (l == 0) ? a->in[0] : a->out;
            switch (sub) {
            case 0: if (PH_MASK & (1u << 1)) { TLW phase_rownorm<true>(xin, a->in[1] + l * DM, XN, (const float*)(ws + WS_WF) + l * 8 * 1024, a->in[3] + l * 8, CB, G, vcu, lane, wave); } break;
            case 1: if (PH_MASK & (1u << 2)) { TLW
                { float* CBm = CB; const int gw_ = vcu * NWAVES + wave; if (gw_ < NB * NH) phase_cumsum(CBm + (size_t)gw_ * SEQ, lane); }
                pg8::Gemm g{XN, (const bf16*)(ws + WS_WIN) + (size_t)l * 2048 * 1024, NTOK, 2048, 1024}; pg8::StaticOrder S; S.init(NTOK, 2048, G, bx);
                pg8::EpiQKVN E{Pq, (size_t)NTOK * 512, a->in[4] + l * 64, a->in[5] + l * 64, (PG8_LAS float*)(lds + EPIX_OFF), EPSN, 0.125f * LOG2E};
                pg8::gemm_phase<pg8::EpiQKVN, pg8::StaticOrder, true, true>(lds, g, S, E); } break;
            case 2: break;
            case 5: if (PH_MASK & (1u << 4)) { TLW { const float gq = wave_max(fabsf(a->in[4][l * 64 + lane])), gk = wave_max(fabsf(a->in[5][l * 64 + lane]));
                const float qkb = 8.f * gq * gk * LOG2E * 1.02f + 0.25f;
                const attn_body::AttnTensors AT{(const attn_body::bf16*)Pq, (const attn_body::bf16*)Pk, (const attn_body::bf16*)Pv, (attn_body::bf16*)MG, CB, qkb};
                attn_body::attn_phase_q<ATT_SKIP>((char*)lds_raw, AT, (unsigned*)(ws + WS_CTL) + CW_AQ + l * 512); } } break;
            case 3: if (PH_MASK & (1u << 5)) { TLW phase_pool(Ps, a->in[6] + (size_t)l * 4 * 64 * 64, a->in[7] + l * 256, a->in[18] + l * DM, MG, lds, G, bx, tid, lane, wave); } break;
            case 4: if (PH_MASK & (1u << 6)) { TLW phase_s5<false>(a, l, Ps, XLOC, Z, lds, G, bx, lane, wave); } break;
            case 6: if (PH_MASK & (1u << 7)) { TLW phase_s5<true>(a, l, Ps, XLOC, Z, lds, G, bx, lane, wave); } break;
            case 7: if (PH_MASK & (1u << 8)) { TLW phase_glu(Z, (const bf16*)(ws + WS_WGLU) + (size_t)l * 256 * 256, a->in[17] + l * 256, a->in[18] + l * DM, MG, lds, G, bx, vcu, tid, lane, wave); } break;
            case 8: if (PH_MASK & (1u << 9)) { pg8::Gemm g{MG, (const bf16*)(ws + WS_WOUT) + (size_t)l * 1024 * 1024, NTOK, 1024, 1024}; pg8::StaticOrder S; S.init(NTOK, 1024, G, bx);
                pg8::EpiResF32 E{xin, a->out, DM};
                pg8::gemm_phase<pg8::EpiResF32, pg8::StaticOrder, true, true>(lds, g, S, E); } break;
            case 9: if (PH_MASK & (1u << 10)) { TLW phase_rownorm<false>(a->out, a->in[20] + l * DM, XN, nullptr, nullptr, nullptr, G, vcu, lane, wave, ws + WS_XN8, (float*)(ws + WS_HSC)); } break;
            case 10: if (PH_MASK & (1u << 11)) { pg8::Gemm g{XN, (const bf16*)(ws + WS_WQ) + (size_t)l * 2048 * 1024, NTOK, 2048, 1024}; pg8::StaticOrder S; S.init(NTOK, 2048, G, bx);
                pg8::EpiBf16<0> E{Pq, PQW, nullptr, 0, 0, 1.f};
                pg8::gemm_phase<pg8::EpiBf16<0>, pg8::StaticOrder, true, true>(lds, g, S, E); } break;
            case 11: if (PH_MASK & (1u << 12)) { TLW phase_select(Pq, (const bf16*)(ws + WS_KEYS) + (size_t)l * 8 * 2 * 128 * 128, IDX, GATE, lds, G, vcu, tid, lane, wave); } break;
            case 12: if (PH_MASK & (1u << 13)) { TLW phase_gather_u(ws + WS_XN8, IDX, (const unsigned char*)(ws + WS_U) + (size_t)l * NEXP * DM, (float*)(ws + WS_P), (unsigned*)(ws + WS_CTL) + CW_Q + (l * 2 + 0) * 512 + ((DUP_PH >= 0 && pc == DUP_PH + 1) ? 4096 : 0), lane, (DUP_PH >= 0 && pc == DUP_PH) ? DIAG_IMASK : 0xffffffffu); } break;
            case 13: if (PH_MASK & (1u << 14)) { TLW phase_gather_act((const float*)(ws + WS_P), GATE, (const float*)(ws + WS_HSC), (float*)(ws + WS_Z), G, vcu, tid); } break;
            default: if (PH_MASK & (1u << 15)) { TLW phase_gather_v((const float*)(ws + WS_Z), IDX, (const unsigned char*)(ws + WS_V) + (size_t)l * NEXP * DM, a->out, (unsigned*)(ws + WS_CTL) + CW_Q + (l * 2 + 1) * 512, lane); } break;
            }
        }
        const int subb_ = (ph >= 1) ? (ph - 1) % PH_PER_LAYER : -1;
        if (pc + 1 < ph_hi + (DUP_PH >= 0 ? 1 : 0) && (MK_ONE_LAUNCH == 0 || (subb_ != 2 && subb_ != 3 && subb_ != 4))) { XcdBarrier b2 = bar; asm volatile("" : "+s"(b2.bar)); xcd_barrier(b2);
            if (TIME_PH >= 0 && (pc == TIME_PH || TIME_PH == 99)) { const unsigned long long t1_ = __builtin_amdgcn_s_memrealtime(), te_ = t1_ + TIME_MUL * (t1_ - tph0_); while (__builtin_amdgcn_s_memrealtime() < te_) __builtin_amdgcn_s_sleep(8); } }
    }
}

extern "C" void kernel_launch(void* const* d_in, const int* in_sizes, int n_in, void* d_out, int out_size, void* d_ws, size_t ws_size, hipStream_t stream) {
    static int grid = 0;
    if (grid == 0) {
        if (n_in != 25 || in_sizes[0] != NTOK * DM || out_size != NTOK * DM || ws_size < WS_END) {
            fprintf(stderr, "kernel_launch: unexpected problem: n_in %d in0 %d out %d ws %zu (need %zu); nothing launched\n", n_in, n_in > 0 ? in_sizes[0] : -1, out_size, ws_size, (size_t)WS_END); grid = -1; return; }
        int dev = 0, cus = 0;
        if (hipGetDevice(&dev) != hipSuccess || hipDeviceGetAttribute(&cus, hipDeviceAttributeMultiprocessorCount, dev) != hipSuccess) { fprintf(stderr, "kernel_launch: device query failed\n"); grid = -1; return; }
        if (hipFuncSetAttribute((const void*)mega_fwd, hipFuncAttributeMaxDynamicSharedMemorySize, LDS_BYTES) != hipSuccess) { fprintf(stderr, "kernel_launch: hipFuncSetAttribute failed\n"); grid = -1; return; }
        (void)hipGetLastError();
        grid = cus;
    }
    if (grid < 0) return;
    (void)hipMemsetAsync((char*)d_ws + WS_CTL, 0, CTL_ZERO_BYTES, stream);
    Args a{};
    for (int i = 0; i < 25; ++i) a.in[i] = (const float*)d_in[i];
    a.out = (float*)d_out; a.ws = (unsigned char*)d_ws;
#if MK_ONE_LAUNCH
    a.ph_lo = 0; a.ph_hi = N_PHASES; a.use_bar = 1;
    hipLaunchKernelGGL(mega_fwd, dim3(grid), dim3(NTHR), LDS_BYTES, stream, a);
#else
    for (int ph = 0; ph < N_PHASES; ++ph) { a.ph_lo = ph; a.ph_hi = ph + 1; a.use_bar = 0;
        hipLaunchKernelGGL(mega_fwd, dim3(grid), dim3(NTHR), LDS_BYTES, stream, a); }
#endif
    const hipError_t le = hipPeekAtLastError();
    if (le != hipSuccess) fprintf(stderr, "kernel_launch: launch failed: %s\n", hipGetErrorName(le));
}
```

```cpp
#include <hip/hip_runtime.h>
#include <hip/hip_bf16.h>
#include <hip/hip_fp16.h>
#include <cstdio>
#include <cstdint>
#include <cmath>
#ifndef MK_ONE_LAUNCH
#define MK_ONE_LAUNCH 1
#endif
#ifndef ATT_SKIP
#define ATT_SKIP true
#endif
#ifndef PH_MASK
#define PH_MASK 0xffffffffu
#endif
#define OTID_LDS_OFF (131072 + 1024)
__device__ __forceinline__ int otid() {
    int z = 0; asm volatile("" : "+v"(z)); const int lane = __builtin_amdgcn_mbcnt_hi(-1, __builtin_amdgcn_mbcnt_lo(-1, z));
    const unsigned hw = (unsigned)__builtin_amdgcn_s_getreg((6 << 11) | 4);
    const int wv = *(const volatile __attribute__((address_space(3))) int*)(OTID_LDS_OFF + 4 * (hw & 63u));
    return (__builtin_amdgcn_readfirstlane(wv) << 6) | lane;
}
#ifndef GATHER_NAIVE
#define GATHER_NAIVE 0
#endif
#ifndef DUP_PH
#define DUP_PH (-1)
#endif
#ifndef TIME_PH
#define TIME_PH (-1)
#define TIME_MUL 3
#endif
#ifndef GV_MAIN
#define GV_MAIN 8
#endif
#ifndef GV_VAR
#define GV_VAR 0
#endif
#ifndef DIAG_IMASK
#define DIAG_IMASK 0xffu
#endif
#ifndef S5_CPROJ_F32
#define S5_CPROJ_F32 1
#endif
namespace pg8 {
#define PG8_LAS __attribute__((address_space(3)))
typedef unsigned short bf16_t;
typedef short bf16x8 __attribute__((ext_vector_type(8)));
typedef float f32x4 __attribute__((ext_vector_type(4)));
typedef unsigned u32x4 __attribute__((ext_vector_type(4)));
constexpr int BM = 256, BK = 64, HALF = 128, HTB = HALF * BK * 2  , STAGE_BYTES = 8 * HTB, NXCD = 8, WGM = 8;

__host__ __device__ __forceinline__ int lds_byte(int r, int c) { const int st = (r >> 4) * 2 + (c >> 5), rr = r & 15, cc = c & 31, ob = rr * 64 + cc * 2; return st * 1024 + (ob ^ (((ob >> 9) & 1) << 5)); }
__host__ __device__ __forceinline__ void stage_rc(int b, int& R, int& C) { const int st = b / 1024, sb = b % 1024, swz = sb ^ (((sb >> 9) & 1) << 5); R = (st >> 1) * 16 + swz / 64; C = (st & 1) * 32 + (swz % 64) / 2; }
__host__ __device__ __forceinline__ int perm32(int rho) { const int n = rho >> 4, i = rho & 15; return 8 * (i >> 2) + 4 * n + (i & 3); }

struct Unit { int pm, pn; };
struct Gemm { const bf16_t* A; const bf16_t* Bt; int M, N, K; };

struct StaticOrder {
    int nM, nN, nwg, G, c;
    __host__ __device__ void init(int M, int N, int G_, int c_) { nM = M / BM; nN = N / BM; nwg = nM * nN; G = G_; c = c_; }
    __host__ __device__ bool next(int i, Unit& u) const {
        const long L = (long)i * G + c; if (L >= nwg) return false;
        int wgid = (int)L; { const int q = nwg / NXCD, r = nwg % NXCD, xcd = wgid % NXCD, off = wgid / NXCD; wgid = (xcd < r ? xcd * (q + 1) : r * (q + 1) + (xcd - r) * q) + off; }
        const int nig = WGM * nN, gid = wgid / nig, fm = gid * WGM, gsz = (nM - fm) < WGM ? (nM - fm) : WGM;
        u.pm = fm + ((wgid % nig) % gsz); u.pn = (wgid % nig) / gsz; return true;
    }
    __device__ __forceinline__ void a_ready(const Unit&) const {}
    __device__ __forceinline__ void done(const Unit&) const {}
};

__device__ __forceinline__ unsigned cvt_pk_bf16(float lo, float hi) { unsigned r; asm volatile("v_cvt_pk_bf16_f32 %0, %1, %2" : "=v"(r) : "v"(lo), "v"(hi)); return r; }
typedef float f32x2 __attribute__((ext_vector_type(2)));
__device__ __forceinline__ f32x2 gelu_pk(f32x2 v) {
    const f32x2 av = __builtin_elementwise_abs(v), d = av * 0.2316418882f + 1.0f;
    f32x2 t; t.x = __builtin_amdgcn_rcpf(d.x); t.y = __builtin_amdgcn_rcpf(d.y);
    f32x2 q = t * 0.5307027145f + (-0.7265760135f); q = q * t + 0.7107068705f; q = q * t + (-0.142248368f); q = q * t + 0.127414796f; q = q * t;
    const f32x2 s = (v * v) * (-0.72134752044f);
    f32x2 e; e.x = __builtin_amdgcn_exp2f(s.x); e.y = __builtin_amdgcn_exp2f(s.y);
    const f32x2 m = v * (q * e), r = v - m;
    f32x2 o; o.x = v.x < 0.f ? m.x : r.x; o.y = v.y < 0.f ? m.y : r.y; return o;
}

template <int ACT  > struct EpiBf16 {
    static constexpr bool PERM = true, AFTER_DRAIN = false; static_assert(ACT == 0 || ACT == 1, "EpiBf16: ACT is 0 (none) or 1 (gelu_pk)");
    bf16_t* O; int ldc; const float* bias; int split_cols; size_t split_stride; float scale0;
    __device__ __forceinline__ void operator()(const f32x4 (&acc)[2][2][4][2], const Unit& u, int wr, int wc, int fr, int fq) const {
        const int row0 = u.pm * BM + wr * 64 + fr; int colt = u.pn * BM; bf16_t* base = O;
        float sc = 1.f; if (split_cols) { const int t = colt / split_cols; base += (size_t)t * split_stride; colt -= t * split_cols; if (t == 0) sc = scale0; }
        const int col0 = colt + wc * 32 + 8 * fq, bcol0 = u.pn * BM + wc * 32 + 8 * fq;
        f32x4 bv[2][2];
#pragma unroll
        for (int bj = 0; bj < 2; ++bj)
#pragma unroll
            for (int n = 0; n < 2; ++n) bv[bj][n] = bias ? *(const f32x4*)(bias + bcol0 + bj * HALF + 4 * n) : (f32x4){0.f, 0.f, 0.f, 0.f};
#pragma unroll
        for (int ai = 0; ai < 2; ++ai)
#pragma unroll
            for (int m = 0; m < 4; ++m) { bf16_t* rowp = base + (size_t)(row0 + ai * HALF + m * 16) * ldc + col0;
#pragma unroll
                for (int bj = 0; bj < 2; ++bj) { f32x4 v0 = acc[ai][bj][m][0] + bv[bj][0], v1 = acc[ai][bj][m][1] + bv[bj][1];
                    if (ACT == 1) { f32x2 a = gelu_pk((f32x2){v0[0], v0[1]}), b = gelu_pk((f32x2){v0[2], v0[3]}), c = gelu_pk((f32x2){v1[0], v1[1]}), d = gelu_pk((f32x2){v1[2], v1[3]});
                        v0 = (f32x4){a.x, a.y, b.x, b.y}; v1 = (f32x4){c.x, c.y, d.x, d.y}; }
                    v0 = v0 * sc; v1 = v1 * sc; u32x4 w; w.x = cvt_pk_bf16(v0[0], v0[1]); w.y = cvt_pk_bf16(v0[2], v0[3]); w.z = cvt_pk_bf16(v1[0], v1[1]); w.w = cvt_pk_bf16(v1[2], v1[3]);
                    *(u32x4*)(rowp + bj * HALF) = w; } }
    }
};
struct EpiResF32 {
    static constexpr bool PERM = false, AFTER_DRAIN = false;
    const float* base; float* out; int ldc;
    __device__ __forceinline__ void operator()(const f32x4 (&acc)[2][2][4][2], const Unit& u, int wr, int wc, int fr, int fq) const {
        const int col0 = u.pn * BM + wc * 32 + 4 * fq;
#pragma unroll
        for (int ai = 0; ai < 2; ++ai)
#pragma unroll
            for (int m = 0; m < 4; ++m) { const size_t off = (size_t)(u.pm * BM + ai * HALF + wr * 64 + m * 16 + fr) * ldc + col0;
#pragma unroll
                for (int bj = 0; bj < 2; ++bj)
#pragma unroll
                    for (int n = 0; n < 2; ++n) { const f32x4 bs = *(const f32x4*)(base + off + bj * HALF + n * 16); *(f32x4*)(out + off + bj * HALF + n * 16) = bs + acc[ai][bj][m][n]; } }
    }
};

struct EpiQKVN {
    static constexpr bool PERM = true, AFTER_DRAIN = false;
    bf16_t* O; size_t split_stride; const float* qg; const float* kg; PG8_LAS float* ex; float eps, qscale;
    __device__ __forceinline__ void operator()(const f32x4 (&acc)[2][2][4][2], const Unit& u, int wr, int wc, int fr, int fq) const {
        const int t = u.pn >> 1, row0 = u.pm * BM + wr * 64 + fr, col0 = (u.pn & 1) * BM + wc * 32 + 8 * fq; bf16_t* base = O + (size_t)t * split_stride;
        float rs[2][4][2];
        f32x4 g0 = {1.f, 1.f, 1.f, 1.f}, g1 = {1.f, 1.f, 1.f, 1.f};
        if (t < 2) {
            int wid = wr * 4 + wc, fro = fr; asm volatile("" : "+v"(fro), "+s"(wid));
#pragma unroll
            for (int ai = 0; ai < 2; ++ai)
#pragma unroll
                for (int m = 0; m < 4; ++m)
#pragma unroll
                    for (int bj = 0; bj < 2; ++bj) { const f32x4 a0 = acc[ai][bj][m][0], a1 = acc[ai][bj][m][1];
                        float s = (a0[0] * a0[0] + a0[1] * a0[1]) + (a0[2] * a0[2] + a0[3] * a0[3]) + (a1[0] * a1[0] + a1[1] * a1[1]) + (a1[2] * a1[2] + a1[3] * a1[3]);
                        s += __shfl_xor(s, 16); s += __shfl_xor(s, 32);
                        if (fq == 0) ex[(((wid * 2 + ai) * 4 + m) * 2 + bj) * 16 + fro] = s; }
            asm volatile("s_waitcnt lgkmcnt(0)\n\ts_barrier" ::: "memory");
            const float* gp = (t == 0 ? qg : kg) + 32 * (wc & 1) + 8 * fq; const float gs = (t == 0) ? qscale : 1.f;
            g0 = *(const f32x4*)gp * gs; g1 = *(const f32x4*)(gp + 4) * gs;
#pragma unroll
            for (int ai = 0; ai < 2; ++ai)
#pragma unroll
                for (int m = 0; m < 4; ++m)
#pragma unroll
                    for (int bj = 0; bj < 2; ++bj) { const float so = ex[(((wid * 2 + ai) * 4 + m) * 2 + bj) * 16 + fro], sp = ex[((((wid ^ 1) * 2 + ai) * 4 + m) * 2 + bj) * 16 + fro]; rs[ai][m][bj] = 1.0f / sqrtf((so + sp) * (1.f / 64.f) + eps); }
        }
#pragma unroll
        for (int ai = 0; ai < 2; ++ai)
#pragma unroll
            for (int m = 0; m < 4; ++m) { bf16_t* rowp = base + (size_t)(row0 + ai * HALF + m * 16) * 512 + col0;
#pragma unroll
                for (int bj = 0; bj < 2; ++bj) { f32x4 v0 = acc[ai][bj][m][0], v1 = acc[ai][bj][m][1];
                    if (t < 2) { const float r = rs[ai][m][bj]; v0 = v0 * r * g0; v1 = v1 * r * g1; }
                    u32x4 w; w.x = cvt_pk_bf16(v0[0], v0[1]); w.y = cvt_pk_bf16(v0[2], v0[3]); w.z = cvt_pk_bf16(v1[0], v1[1]); w.w = cvt_pk_bf16(v1[2], v1[3]);
                    *(u32x4*)(rowp + bj * HALF) = w; } }
    }
};
template <class Epi, class Sched, bool ALIGN_EPI = false, bool SP2 = false>
__device__ __forceinline__ void gemm_phase(PG8_LAS unsigned char* lds, const Gemm g, const Sched& S, const Epi& E) {
    const int tid = otid(), wid = __builtin_amdgcn_readfirstlane(tid >> 6), lane = tid & 63, wr = wid >> 2, wc = wid & 3, fr = lane & 15, fq = lane >> 4;
    const int K = g.K, nt = K / BK;
    unsigned voffA[2], voffB[2];
#pragma unroll
    for (int i = 0; i < 2; ++i) { int R, C; stage_rc(tid * 16 + i * 8192, R, C); const int Rb = Epi::PERM ? ((R & ~31) + perm32(R & 31)) : R;
        voffA[i] = (unsigned)(R * K + C) * 2u; voffB[i] = (unsigned)(Rb * K + C) * 2u; }
    const size_t kstep = (size_t)(BK * 2);
    const size_t hstep = (size_t)HALF * K * 2;
    const size_t tstep = 2 * hstep;
    const unsigned ldsw = (unsigned)wid * 1024u;
    const int aoff = lds_byte(wr * 64 + fr, fq * 8), boff = lds_byte(wc * 32 + fr, fq * 8);
#define PG8_SA(b, h) (((b) * 2 + (h)) * HTB)
#define PG8_SB(b, h) ((4 + (b) * 2 + (h)) * HTB)
#define PG8_STAGE(bufoff, gbase, voff) do { _Pragma("unroll") for (int _i = 0; _i < 2; ++_i) \
        __builtin_amdgcn_global_load_lds((const unsigned*)((const char*)(gbase) + (voff)[_i]), (PG8_LAS unsigned*)(lds + (bufoff) + ldsw + _i * 8192), 16, 0, 0); } while (0)
#define PG8_LDA(dst, b, h) do { _Pragma("unroll") for (int m = 0; m < 4; ++m) _Pragma("unroll") for (int k = 0; k < 2; ++k) dst[m][k] = *(const PG8_LAS bf16x8*)(lds + PG8_SA(b, h) + aoff + m * 2048 + k * 1024); } while (0)
#define PG8_LDB(dst, b, h) do { _Pragma("unroll") for (int n = 0; n < 2; ++n) _Pragma("unroll") for (int k = 0; k < 2; ++k) dst[n][k] = *(const PG8_LAS bf16x8*)(lds + PG8_SB(b, h) + boff + n * 2048 + k * 1024); } while (0)
#define PG8_MMA(ai, bj, At, Bt) do { __builtin_amdgcn_s_setprio(1); _Pragma("unroll") for (int m = 0; m < 4; ++m) _Pragma("unroll") for (int n = 0; n < 2; ++n) _Pragma("unroll") for (int k = 0; k < 2; ++k) \
        acc[ai][bj][m][n] = __builtin_amdgcn_mfma_f32_16x16x32_bf16(Bt[n][k], At[m][k], acc[ai][bj][m][n], 0, 0, 0); __builtin_amdgcn_s_setprio(0); } while (0)
#define PG8_WAIT_V(n) asm volatile("s_waitcnt vmcnt(" #n ")" ::: "memory")
#define PG8_WAIT_L(n) asm volatile("s_waitcnt lgkmcnt(" #n ")" ::: "memory")
#define PG8_BAR __builtin_amdgcn_s_barrier()
#define PG8_SCHED __builtin_amdgcn_sched_barrier(0)
    Unit cur, nxt; int ui = 0;
    if (!S.next(0, cur)) return;
    f32x4 acc[2][2][4][2];
#pragma unroll
    for (int a = 0; a < 2; ++a)
#pragma unroll
        for (int b = 0; b < 2; ++b)
#pragma unroll
            for (int m = 0; m < 4; ++m)
#pragma unroll
                for (int n = 0; n < 2; ++n) acc[a][b][m][n] = (f32x4){0.f, 0.f, 0.f, 0.f};
    bf16x8 At[4][2], B0[2][2], B1[2][2];
    const char* cA = (const char*)g.A + (size_t)cur.pm * tstep; const char* cB = (const char*)g.Bt + (size_t)cur.pn * tstep;
    S.a_ready(cur);
    if constexpr (SP2) {
        PG8_STAGE(PG8_SB(0, 0), cB, voffB); PG8_STAGE(PG8_SB(0, 1), cB + hstep, voffB); PG8_STAGE(PG8_SA(0, 0), cA, voffA); PG8_STAGE(PG8_SA(0, 1), cA + hstep, voffA);
        if (wr == 1) PG8_BAR;
        PG8_WAIT_V(2); PG8_BAR;
        PG8_STAGE(PG8_SB(1, 0), cB + kstep, voffB); PG8_STAGE(PG8_SA(1, 0), cA + kstep, voffA); PG8_STAGE(PG8_SB(1, 1), cB + hstep + kstep, voffB);
        PG8_WAIT_V(6); PG8_BAR;
    } else {
        PG8_STAGE(PG8_SB(0, 0), cB, voffB); PG8_STAGE(PG8_SA(0, 0), cA, voffA); PG8_STAGE(PG8_SB(0, 1), cB + hstep, voffB); PG8_STAGE(PG8_SA(0, 1), cA + hstep, voffA);
        if (wr == 1) PG8_BAR;
        PG8_WAIT_V(4); PG8_BAR;
        PG8_STAGE(PG8_SB(1, 0), cB + kstep, voffB); PG8_STAGE(PG8_SA(1, 0), cA + kstep, voffA); PG8_STAGE(PG8_SB(1, 1), cB + hstep + kstep, voffB);
        PG8_WAIT_V(6); PG8_BAR;
    }
    for (;;) {
        const bool has_next = S.next(ui + 1, nxt);
        const char* nA = has_next ? (const char*)g.A + (size_t)nxt.pm * tstep : cA; const char* nB = has_next ? (const char*)g.Bt + (size_t)nxt.pn * tstep : cB;
        for (int t = 0; t < nt; t += 2) {
            const bool last = (t == nt - 2);
            const char* a1 = cA + (size_t)(t + 1) * kstep;
            const char* a2 = last ? nA : cA + (size_t)(t + 2) * kstep; const char* b2 = last ? nB : cB + (size_t)(t + 2) * kstep;
            const char* a3 = a2 + kstep; const char* b3 = b2 + kstep;
            if (last && has_next) S.a_ready(nxt);
            if constexpr (SP2) {
            PG8_LDB(B0, 0, 0); PG8_LDB(B1, 0, 1); PG8_SCHED; PG8_LDA(At, 0, 0); PG8_STAGE(PG8_SA(1, 1), a1 + hstep, voffA);
            PG8_WAIT_V(8); PG8_WAIT_L(0); PG8_BAR; PG8_MMA(0, 0, At, B0); PG8_MMA(0, 1, At, B1); PG8_BAR; PG8_SCHED;
            PG8_LDA(At, 0, 1); PG8_STAGE(PG8_SB(0, 0), b2, voffB); PG8_STAGE(PG8_SB(0, 1), b2 + hstep, voffB); PG8_STAGE(PG8_SA(0, 0), a2, voffA);
            PG8_WAIT_V(8); PG8_WAIT_L(0); PG8_BAR; PG8_MMA(1, 0, At, B0); PG8_MMA(1, 1, At, B1); PG8_BAR; PG8_SCHED;
            PG8_LDB(B0, 1, 0); PG8_LDB(B1, 1, 1); PG8_SCHED; PG8_LDA(At, 1, 0); PG8_STAGE(PG8_SA(0, 1), a2 + hstep, voffA);
            PG8_WAIT_V(8); PG8_WAIT_L(0); PG8_BAR; PG8_MMA(0, 0, At, B0); PG8_MMA(0, 1, At, B1); PG8_BAR; PG8_SCHED;
            PG8_LDA(At, 1, 1); PG8_STAGE(PG8_SB(1, 0), b3, voffB); PG8_STAGE(PG8_SB(1, 1), b3 + hstep, voffB); PG8_STAGE(PG8_SA(1, 0), a3, voffA);
            PG8_WAIT_V(8); PG8_WAIT_L(0); PG8_BAR; PG8_MMA(1, 0, At, B0); PG8_MMA(1, 1, At, B1); PG8_BAR; PG8_SCHED;
            } else {
            PG8_LDB(B0, 0, 0); PG8_SCHED; PG8_LDA(At, 0, 0); PG8_STAGE(PG8_SA(1, 1), a1 + hstep, voffA);
            PG8_WAIT_L(8); PG8_BAR; PG8_WAIT_L(0); PG8_MMA(0, 0, At, B0); PG8_BAR; PG8_SCHED;
            PG8_LDB(B1, 0, 1); PG8_STAGE(PG8_SB(0, 0), b2, voffB);
            PG8_BAR; PG8_WAIT_L(0); PG8_MMA(0, 1, At, B1); PG8_BAR;
            PG8_LDA(At, 0, 1); PG8_STAGE(PG8_SA(0, 0), a2, voffA);
            PG8_BAR; PG8_WAIT_L(0); PG8_MMA(1, 0, At, B0); PG8_BAR; PG8_SCHED;
            PG8_STAGE(PG8_SB(0, 1), b2 + hstep, voffB);
            PG8_WAIT_V(6); PG8_BAR; PG8_MMA(1, 1, At, B1); PG8_BAR;
            PG8_LDB(B0, 1, 0); PG8_SCHED; PG8_LDA(At, 1, 0); PG8_STAGE(PG8_SA(0, 1), a2 + hstep, voffA);
            PG8_WAIT_L(8); PG8_BAR; PG8_WAIT_L(0); PG8_MMA(0, 0, At, B0); PG8_BAR; PG8_SCHED;
            PG8_LDB(B1, 1, 1); PG8_STAGE(PG8_SB(1, 0), b3, voffB);
            PG8_BAR; PG8_WAIT_L(0); PG8_MMA(0, 1, At, B1); PG8_BAR;
            PG8_LDA(At, 1, 1); PG8_STAGE(PG8_SA(1, 0), a3, voffA);
            PG8_BAR; PG8_WAIT_L(0); PG8_MMA(1, 0, At, B0); PG8_BAR; PG8_SCHED;
            PG8_STAGE(PG8_SB(1, 1), b3 + hstep, voffB);
            PG8_WAIT_V(6); PG8_BAR; PG8_MMA(1, 1, At, B1); PG8_BAR;
            }
        }
        if constexpr (ALIGN_EPI) { if (wr == 0) PG8_BAR; }
        if constexpr (!Epi::AFTER_DRAIN) { E(acc, cur, wr, wc, fr, fq); S.done(cur); }
        if (!has_next) break;
#pragma unroll
        for (int a = 0; a < 2; ++a)
#pragma unroll
            for (int b = 0; b < 2; ++b)
#pragma unroll
                for (int m = 0; m < 4; ++m)
#pragma unroll
                    for (int n = 0; n < 2; ++n) acc[a][b][m][n] = (f32x4){0.f, 0.f, 0.f, 0.f};
        cur = nxt; cA = nA; cB = nB; ++ui;
        if constexpr (ALIGN_EPI) { if (wr == 1) PG8_BAR; }
    }
    PG8_WAIT_V(0);
    if constexpr (!ALIGN_EPI) { if (wr == 0) PG8_BAR; }
    PG8_BAR;
    if constexpr (Epi::AFTER_DRAIN) { E.fused(acc, cur, wr, wc, fr, fq, lds, wid, lane); S.done(cur); }
#undef PG8_SA
#undef PG8_SB
#undef PG8_STAGE
#undef PG8_LDA
#undef PG8_LDB
#undef PG8_MMA
#undef PG8_WAIT_V
#undef PG8_WAIT_L
#undef PG8_BAR
#undef PG8_SCHED
}
}
#include <hip/hip_bf16.h>
#include <cmath>
namespace attn_body {
using bf16=__hip_bfloat16;
using bf16x8=__attribute__((ext_vector_type(8)))short;
using s16x4=__attribute__((ext_vector_type(4)))short;
using f32x16=__attribute__((ext_vector_type(16)))float;
using u32x4=__attribute__((ext_vector_type(4)))unsigned;
using f32x4v=__attribute__((ext_vector_type(4)))float;
constexpr int BATCH=8,NHEAD=8,SEQ=4096,D=64,DM=NHEAD*D,OPITCH=1024;
constexpr int NW=8,QBLK=32,QB=QBLK*NW,KVBLK=64,NQB=SEQ/QB;
constexpr int ATTN_PITCH=DM, ATTN_UNIT_ROWS=QB;
__device__ __forceinline__ int crow(int r,int hi){return (r&3)+8*(r>>2)+4*hi;}
#define SBAR() __builtin_amdgcn_sched_barrier(0)
__device__ __forceinline__ void cmask(f32x16&p0,f32x16&p1,int jb,int qrel,int hi){
  const float NEG=-INFINITY; int kb=64*jb+4*hi;
  #pragma unroll
  for(int r=0;r<16;++r){int kv=kb+(r&3)+8*(r>>2); if(kv>qrel)p0[r]=NEG; if(kv+32>qrel)p1[r]=NEG;}
}

constexpr int NSLOT=3, SLOTB=8192;
constexpr int LDS_K=0, LDS_V=NSLOT*SLOTB, LDS_WS=2*NSLOT*SLOTB, LDS_OST=LDS_WS+NW*64*4, LDS_BYTES=LDS_OST+NW*4096, LDS_BIAS=LDS_BYTES, LDS_TOTAL=LDS_BIAS+SEQ*4;
constexpr float C2=0.125f*1.4426950408889634f;
__device__ __forceinline__ void glds16(const void*sbase,unsigned voff,unsigned lds_dst){unsigned keep;
  asm volatile("s_mov_b32 %0, m0\n\ts_mov_b32 m0, %3\n\ts_nop 0\n\tglobal_load_lds_dwordx4 %1, %2\n\ts_mov_b32 m0, %0":"=&s"(keep):"v"(voff),"s"(sbase),"s"(lds_dst):"memory");}
__device__ __forceinline__ float max3f(float a,float b,float c){float r;asm("v_max3_f32 %0, %1, %2, %3":"=v"(r):"v"(a),"v"(b),"v"(c));return r;}
__device__ __forceinline__ float max2f(float a,float b){float r;asm("v_max_f32_e32 %0, %1, %2":"=v"(r):"v"(a),"v"(b));return r;}
__device__ __forceinline__ float fadd_s(float a,float b){float r;asm("v_add_f32_e32 %0, %1, %2":"=v"(r):"v"(a),"v"(b));return r;}
__device__ __forceinline__ float fsub_s(float a,float b){float r;asm("v_sub_f32_e32 %0, %1, %2":"=v"(r):"v"(a),"v"(b));return r;}
typedef float f32x2_t __attribute__((ext_vector_type(2))); typedef __bf16 bf16x2_t __attribute__((ext_vector_type(2)));
__device__ __forceinline__ unsigned cvtpk_s(float lo,float hi){f32x2_t v={lo,hi};bf16x2_t b=__builtin_convertvector(v,bf16x2_t);return __builtin_bit_cast(unsigned,b);}
#define WAIT_BAR(N) asm volatile("s_waitcnt vmcnt(" #N ") lgkmcnt(0)\n\ts_barrier":::"memory")

__device__ __forceinline__ void qkt(f32x16&p0,f32x16&p1,const __attribute__((address_space(3))) char*kb,const bf16x8*qr){
  #pragma unroll
  for(int d0=0;d0<4;++d0){
    const bf16x8 b0=*(const __attribute__((address_space(3))) bf16x8*)(kb+d0*2048);
    const bf16x8 b1=*(const __attribute__((address_space(3))) bf16x8*)(kb+d0*2048+512);
    p0=__builtin_amdgcn_mfma_f32_32x32x16_bf16(b0,qr[d0],p0,0,0,0);p1=__builtin_amdgcn_mfma_f32_32x32x16_bf16(b1,qr[d0],p1,0,0,0);}
}
typedef __attribute__((address_space(3))) const char* lds_cptr;
typedef short v4i16_t __attribute__((ext_vector_type(4)));
__device__ __forceinline__ void kload8(bf16x8*kf,lds_cptr kp){
  kf[0]=*(const __attribute__((address_space(3))) bf16x8*)(kp);      kf[1]=*(const __attribute__((address_space(3))) bf16x8*)(kp+512);
  kf[2]=*(const __attribute__((address_space(3))) bf16x8*)(kp+2048); kf[3]=*(const __attribute__((address_space(3))) bf16x8*)(kp+2560);
  kf[4]=*(const __attribute__((address_space(3))) bf16x8*)(kp+4096); kf[5]=*(const __attribute__((address_space(3))) bf16x8*)(kp+4608);
  kf[6]=*(const __attribute__((address_space(3))) bf16x8*)(kp+6144); kf[7]=*(const __attribute__((address_space(3))) bf16x8*)(kp+6656);
}
__device__ __forceinline__ void kload2(bf16x8*kf,lds_cptr kp,int j){ kf[2*j]=*(const __attribute__((address_space(3))) bf16x8*)(kp+j*2048); kf[2*j+1]=*(const __attribute__((address_space(3))) bf16x8*)(kp+j*2048+512); }
__device__ __forceinline__ s16x4 vtr(lds_cptr p){ return __builtin_bit_cast(s16x4,__builtin_amdgcn_ds_read_tr16_b64_v4i16((__attribute__((address_space(3))) v4i16_t*)p)); }
__device__ __forceinline__ float rowmax(const f32x16&p0,const f32x16&p1){
  float a=max3f(p0[0],p0[1],p1[0]),b=max3f(p0[2],p0[3],p1[1]);a=max3f(a,p1[2],p1[3]);
  #pragma unroll
  for(int r=4;r<16;r+=4){a=max3f(a,p0[r],p0[r+1]);b=max3f(b,p0[r+2],p0[r+3]);a=max3f(a,p1[r],p1[r+1]);b=max3f(b,p1[r+2],p1[r+3]);}
  const float m=max2f(a,b);
  auto rr=__builtin_amdgcn_permlane32_swap(__float_as_uint(m),__float_as_uint(m),false,false);
  return max2f(__uint_as_float(rr[0]),__uint_as_float(rr[1]));
}
__device__ __forceinline__ void pv(f32x16*o,int vb,bf16x8 pa0,bf16x8 pa1,bf16x8 pa2,bf16x8 pa3){
  #pragma unroll
  for(int d0=0;d0<2;++d0){s16x4 lo[4],hi[4];
    #pragma unroll
    for(int ks=0;ks<4;++ks){
      asm volatile("ds_read_b64_tr_b16 %0,%1 offset:%c2":"=&v"(lo[ks]):"v"(vb),"i"(d0*4096+ks*1024):"memory");
      asm volatile("ds_read_b64_tr_b16 %0,%1 offset:%c2":"=&v"(hi[ks]):"v"(vb),"i"(d0*4096+ks*1024+512):"memory");}
    asm volatile("s_waitcnt lgkmcnt(0)":::"memory");SBAR();
    #define PK(k) (bf16x8){lo[k][0],lo[k][1],lo[k][2],lo[k][3],hi[k][0],hi[k][1],hi[k][2],hi[k][3]}
    o[d0]=__builtin_amdgcn_mfma_f32_32x32x16_bf16(pa0,PK(0),o[d0],0,0,0);
    o[d0]=__builtin_amdgcn_mfma_f32_32x32x16_bf16(pa1,PK(1),o[d0],0,0,0);
    o[d0]=__builtin_amdgcn_mfma_f32_32x32x16_bf16(pa2,PK(2),o[d0],0,0,0);
    o[d0]=__builtin_amdgcn_mfma_f32_32x32x16_bf16(pa3,PK(3),o[d0],0,0,0);
    #undef PK
  }
}

#ifndef ATTN_STORE16
#define ATTN_STORE16(p,v) (*(u32x4*)(p)=(v))
#endif
template<bool SKIP> __device__ __forceinline__ void attn_unit(int b,int h,int qb,const bf16*Q,const bf16*__restrict__ K,const bf16*__restrict__ V,bf16*O,const float*__restrict__ CB,float qkb,char*shm){
  const int tid=otid(),lane=tid&63,r32=lane&31,hi=lane>>5; const int wid=__builtin_amdgcn_readfirstlane(tid>>6);
  const long rowbase=(long)b*SEQ; const int q0=qb*QB;
  const float*cb=CB+(long)(b*NHEAD+h)*SEQ;
  int t0=0;
  if(SKIP){ const int NTf=(q0+QB)/KVBLK; const float thr=2.f*qkb+40.f; const float cq0=cb[q0];
    bool pred=false; if(lane<NTf-4){ pred=(cq0-cb[64*lane+63])<-thr; }
    const unsigned long long mk=__ballot(pred); t0=(int)__builtin_ctzll(~mk); t0&=~1; t0=__builtin_amdgcn_readfirstlane(t0); }
  const int kv0=t0*KVBLK;
  const int NT=(q0+QB)/KVBLK-t0;
  { __attribute__((address_space(3))) float*bl=(__attribute__((address_space(3))) float*)((lds_cptr)shm+LDS_BIAS); const float*cbk=cb+kv0; for(int i=tid;i<NT*KVBLK;i+=NW*64) bl[i]=-*(const float*)((const char*)cbk+(unsigned)(i*4)); }
  const float negm0=*(const float*)((const char*)(cb+q0+wid*QBLK)+(unsigned)((lane&31)*4))-qkb;
  const bf16*Qw=Q+(rowbase+q0+wid*QBLK)*DM+h*D;
  const bf16*Kh=K+(rowbase+kv0)*DM+h*D,*Vh=V+(rowbase+kv0)*DM+h*D;
  const unsigned lds0=(unsigned)(uintptr_t)shm;
  const unsigned koff=(unsigned)(lane*DM+wid*8)*2u;
  const unsigned voff=(unsigned)((16*(wid&3)+(lane>>2))*DM+(wid>>2)*32+(lane&3)*8)*2u;
  const unsigned kdst=lds0+LDS_K+wid*1024, vdst=lds0+LDS_V+wid*1024;
  #define DMA_K(t,slot) glds16(Kh+(long)(t)*KVBLK*DM,koff,(unsigned)__builtin_amdgcn_readfirstlane(kdst+(slot)))
  #define DMA_V(t,slot) glds16(Vh+(long)(t)*KVBLK*DM,voff,(unsigned)__builtin_amdgcn_readfirstlane(vdst+(slot)))
  bf16x8 kf[8];
  const lds_cptr shm3=(lds_cptr)shm; __attribute__((address_space(3))) float*const wsf=(__attribute__((address_space(3))) float*)(shm3+LDS_WS)+wid*64;
  const lds_cptr kp0=shm3+LDS_K+hi*1024+r32*16; const lds_cptr vp0=shm3+LDS_V+((lane>>4)&1)*32+(lane&3)*8+(4*hi+((lane&15)>>2))*64;
  DMA_K(0,0);DMA_V(0,0);DMA_K(1,SLOTB);
  bf16x8 qr[4];
  #pragma unroll
  for(int d0=0;d0<4;++d0)qr[d0]=*reinterpret_cast<const bf16x8*>((const char*)Qw+(unsigned)((r32*DM+d0*16+hi*8)*2));
  float l_reg=0.f;f32x16 o[2];o[0]=f32x16{};o[1]=f32x16{};
  const __attribute__((address_space(3))) char* bl3=(const __attribute__((address_space(3))) char*)shm+LDS_BIAS+hi*16;
  #define BINIT_ALL(P0,P1,t) do{ const __attribute__((address_space(3))) f32x4v* bp_=(const __attribute__((address_space(3))) f32x4v*)(bl3+(t)*256); \
    _Pragma("unroll") for(int g_=0;g_<4;++g_){ const f32x4v x0_=bp_[2*g_], x1_=bp_[8+2*g_]; \
      P0[4*g_]=x0_[0]+negm0;P0[4*g_+1]=x0_[1]+negm0;P0[4*g_+2]=x0_[2]+negm0;P0[4*g_+3]=x0_[3]+negm0; \
      P1[4*g_]=x1_[0]+negm0;P1[4*g_+1]=x1_[1]+negm0;P1[4*g_+2]=x1_[2]+negm0;P1[4*g_+3]=x1_[3]+negm0; } }while(0)
  const int qrel=wid*QBLK+r32;
  #define CMASK(P0,P1,t) do{int jb_=(t)-(NT-4); if(jb_>=0)cmask(P0,P1,jb_,qrel,hi);}while(0)
  f32x16 pA0,pA1,pB0,pB1;
  int sl_prev=0,sl_cur=0,sl_next=SLOTB;
  #define ROT() do{sl_prev=sl_cur;sl_cur=sl_next;sl_next=(sl_next==(NSLOT-1)*SLOTB)?0:sl_next+SLOTB;}while(0)
  DMA_K(2,2*SLOTB);
  WAIT_BAR(3);
  BINIT_ALL(pA0,pA1,0); qkt(pA0,pA1,kp0,qr);asm volatile("s_nop 15\n\ts_nop 7":"+v"(pA0),"+v"(pA1));CMASK(pA0,pA1,0);
  _Pragma("unroll") for(int r=0;r<16;++r){pA0[r]=__builtin_amdgcn_exp2f(pA0[r]);pA1[r]=__builtin_amdgcn_exp2f(pA1[r]);}
  BINIT_ALL(pB0,pB1,1);
  WAIT_BAR(0);
  DMA_K(3,0);DMA_V(1,SLOTB);
  ROT();
  kload8(kf,kp0+sl_cur);
  WAIT_BAR(2);
  s16x4 vlo[8],vhi[8]; u32x4 pw0,pw1,pw2,pw3;
  #define PKW(P,B) cvtpk_s(P[B],P[B+1])
  #define PAF(k) __builtin_bit_cast(bf16x8,pw##k)
  #define VFR(i) (bf16x8){vlo[i][0],vlo[i][1],vlo[i][2],vlo[i][3],vhi[i][0],vhi[i][1],vhi[i][2],vhi[i][3]}
  #define PIN(x) asm volatile("":"+v"(x))
  #define MX3(a,b,c) __builtin_fmaxf(__builtin_fmaxf((a),(b)),(c))
  #define GAPA(MF,A0,A1,A2,A3,W0,W1,PW) do{ MF; sacc+=A0; sacc+=A1; sacc+=A2; sacc+=A3; PIN(sacc); W0; W1; PIN(PW); SBAR(); }while(0)
  #define EX(v) __builtin_amdgcn_exp2f(v)
  #define GAPB(MF,X,B,GL_,P,GI,NI) do{ MF; X[B]=EX(X[B]); X[B+1]=EX(X[B+1]); X[B+2]=EX(X[B+2]); X[B+3]=EX(X[B+3]); PIN(X); \
    if(GL_){ const f32x4v nx_=bpn_[NI]; P[4*(GI)]=bq_[0]+negm0; P[4*(GI)+1]=bq_[1]+negm0; P[4*(GI)+2]=bq_[2]+negm0; P[4*(GI)+3]=bq_[3]+negm0; bq_=nx_; PIN(P); } SBAR(); }while(0)
  #define VRD(i) do{ vlo[i]=vtr(vp_+(((i)>>2)*4096+((i)&3)*1024)); vhi[i]=vtr(vp_+(((i)>>2)*4096+((i)&3)*1024+512)); }while(0)
  #define KRD(G,j) do{ if(G){ kload2(kf,kp0+sl_next,j); SBAR(); } }while(0)
  #define STEP(C0,C1,P0,P1,t,GK,GV,GL) do{ SBAR(); \
    const lds_cptr vp_=vp0+sl_prev; \
    VRD(0); SBAR(); float sacc=(P0[0]+P0[1]); \
    GAPA(C0=__builtin_amdgcn_mfma_f32_32x32x16_bf16(kf[0],qr[0],C0,0,0,0), P0[2],P0[3],P0[4],P0[5],     pw0[0]=PKW(P0,0), pw0[1]=PKW(P0,2), pw0); \
    VRD(4); SBAR(); GAPA(C1=__builtin_amdgcn_mfma_f32_32x32x16_bf16(kf[1],qr[0],C1,0,0,0), P0[6],P0[7],P0[8],P0[9],     pw0[2]=PKW(P0,4), pw0[3]=PKW(P0,6), pw0); \
    VRD(1); SBAR(); GAPA(C0=__builtin_amdgcn_mfma_f32_32x32x16_bf16(kf[2],qr[1],C0,0,0,0),   P0[10],P0[11],P0[12],P0[13], pw1[0]=PKW(P0,8), pw1[1]=PKW(P0,10), pw1); \
    VRD(5); SBAR(); GAPA(C1=__builtin_amdgcn_mfma_f32_32x32x16_bf16(kf[3],qr[1],C1,0,0,0),   P0[14],P0[15],P1[0],P1[1],   pw1[2]=PKW(P0,12),pw1[3]=PKW(P0,14), pw1); \
    VRD(2); SBAR(); GAPA(C0=__builtin_amdgcn_mfma_f32_32x32x16_bf16(kf[4],qr[2],C0,0,0,0),   P1[2],P1[3],P1[4],P1[5],     pw2[0]=PKW(P1,0), pw2[1]=PKW(P1,2), pw2); \
    VRD(6); SBAR(); GAPA(C1=__builtin_amdgcn_mfma_f32_32x32x16_bf16(kf[5],qr[2],C1,0,0,0),   P1[6],P1[7],P1[8],P1[9],     pw2[2]=PKW(P1,4), pw2[3]=PKW(P1,6), pw2); \
    VRD(3); SBAR(); GAPA(C0=__builtin_amdgcn_mfma_f32_32x32x16_bf16(kf[6],qr[3],C0,0,0,0),   P1[10],P1[11],P1[12],P1[13], pw3[0]=PKW(P1,8), pw3[1]=PKW(P1,10), pw3); \
    VRD(7); SBAR(); GAPA(C1=__builtin_amdgcn_mfma_f32_32x32x16_bf16(kf[7],qr[3],C1,0,0,0),   P1[14],P1[15],0.f,0.f,       pw3[2]=PKW(P1,12),pw3[3]=PKW(P1,14), pw3); \
    l_reg+=sacc; \
    if(GK){DMA_K((t)+3,sl_cur);} if(GV){DMA_V((t)+1,sl_next);} \
    CMASK(C0,C1,t); \
    const __attribute__((address_space(3))) f32x4v* bpn_=(const __attribute__((address_space(3))) f32x4v*)(bl3+((t)+1)*256); f32x4v bq_=f32x4v{}; if(GL){bq_=bpn_[0];} \
    SBAR(); \
    GAPB(o[0]=__builtin_amdgcn_mfma_f32_32x32x16_bf16(PAF(0),VFR(0),o[0],0,0,0), C0,0,GL,P0,0,8); \
    GAPB(o[1]=__builtin_amdgcn_mfma_f32_32x32x16_bf16(PAF(0),VFR(4),o[1],0,0,0), C0,4,GL,P1,0,2); \
    KRD(GL,0); GAPB(o[0]=__builtin_amdgcn_mfma_f32_32x32x16_bf16(PAF(1),VFR(1),o[0],0,0,0), C0,8,GL,P0,1,10); \
    KRD(GL,1); GAPB(o[1]=__builtin_amdgcn_mfma_f32_32x32x16_bf16(PAF(1),VFR(5),o[1],0,0,0), C0,12,GL,P1,1,4); \
    KRD(GL,2); GAPB(o[0]=__builtin_amdgcn_mfma_f32_32x32x16_bf16(PAF(2),VFR(2),o[0],0,0,0), C1,0,GL,P0,2,12); \
    KRD(GL,3); GAPB(o[1]=__builtin_amdgcn_mfma_f32_32x32x16_bf16(PAF(2),VFR(6),o[1],0,0,0), C1,4,GL,P1,2,6); \
    GAPB(o[0]=__builtin_amdgcn_mfma_f32_32x32x16_bf16(PAF(3),VFR(3),o[0],0,0,0), C1,8,GL,P0,3,14); \
    GAPB(o[1]=__builtin_amdgcn_mfma_f32_32x32x16_bf16(PAF(3),VFR(7),o[1],0,0,0), C1,12,GL,P1,3,14); \
    }while(0)
  int t=1;
  #undef CMASK
  #define CMASK(P0,P1,t) do{}while(0)
  for(;t+5<NT;t+=2){
    STEP(pB0,pB1,pA0,pA1,t,true,true,true);     WAIT_BAR(2); ROT();
    STEP(pA0,pA1,pB0,pB1,t+1,true,true,true);   WAIT_BAR(2); ROT();
  }
  #undef CMASK
  #define CMASK(P0,P1,t) do{int jb_=(t)-(NT-4); if(jb_>=0)cmask(P0,P1,jb_,qrel,hi);}while(0)
  #define ENDW(tt) do{ if((tt)+3<NT){WAIT_BAR(2);} else if((tt)+2<NT){WAIT_BAR(1);} else {WAIT_BAR(0);} }while(0)
  for(;t+1<NT;t+=2){
    STEP(pB0,pB1,pA0,pA1,t,(t+3<NT),(t+1<NT),(t+1<NT));       ENDW(t);   ROT();
    STEP(pA0,pA1,pB0,pB1,t+1,(t+4<NT),(t+2<NT),(t+2<NT));     ENDW(t+1); ROT();
  }
  STEP(pB0,pB1,pA0,pA1,NT-1,false,false,false);
  { float sacc=pB0[0]+pB0[1]; _Pragma("unroll") for(int r=2;r<16;++r)sacc+=pB0[r]; _Pragma("unroll") for(int r=0;r<16;++r)sacc+=pB1[r]; l_reg+=sacc;
    pw0=(u32x4){PKW(pB0,0),PKW(pB0,2),PKW(pB0,4),PKW(pB0,6)};pw1=(u32x4){PKW(pB0,8),PKW(pB0,10),PKW(pB0,12),PKW(pB0,14)};pw2=(u32x4){PKW(pB1,0),PKW(pB1,2),PKW(pB1,4),PKW(pB1,6)};pw3=(u32x4){PKW(pB1,8),PKW(pB1,10),PKW(pB1,12),PKW(pB1,14)};
    SBAR(); pv(o,(int)(unsigned)(uintptr_t)vp0+sl_cur,PAF(0),PAF(1),PAF(2),PAF(3)); }
  #undef PKW
  #undef PAF
  #undef VFR
  #undef PIN
  #undef MX3
  #undef GAPA
  #undef GAPB
  #undef EX
  #undef VRD
  #undef KRD
  #undef STEP
  #undef ENDW
  {auto rr=__builtin_amdgcn_permlane32_swap(__float_as_uint(l_reg),__float_as_uint(l_reg),false,false);l_reg=__uint_as_float(rr[0])+__uint_as_float(rr[1]);}
  if(hi==0)wsf[32+r32]=l_reg;asm volatile("s_waitcnt lgkmcnt(0)":::"memory");
  float rli[16];
  #pragma unroll
  for(int r=0;r<16;++r)rli[r]=__builtin_amdgcn_rcpf(wsf[32+crow(r,hi)]);
  bf16*Ow=O+(rowbase+q0+wid*QBLK)*OPITCH+h*D;
  { __attribute__((address_space(3))) unsigned short*stg=(__attribute__((address_space(3))) unsigned short*)(shm3+LDS_OST)+wid*2048;
    #pragma unroll
    for(int r=0;r<16;++r){const int orow=crow(r,hi);
      #pragma unroll
      for(int d0=0;d0<2;++d0)stg[orow*64+d0*32+r32]=(unsigned short)(cvtpk_s(o[d0][r]*rli[r],0.f)&0xffffu);}
    asm volatile("s_waitcnt lgkmcnt(0)":::"memory");
    #pragma unroll
    for(int i=0;i<4;++i){const int row=i*8+(lane>>3),ch=lane&7; const u32x4 v=*(const __attribute__((address_space(3))) u32x4*)(stg+row*64+ch*8); ATTN_STORE16((char*)Ow+(unsigned)((row*OPITCH+ch*8)*2),v);} }
  asm volatile("s_waitcnt lgkmcnt(0)\n\ts_barrier":::"memory");
  #undef DMA_K
  #undef DMA_V
  #undef CMASK
  #undef BINIT_ALL
  #undef ROT
}
constexpr int ATTN_LDS_BYTES=LDS_TOTAL;
struct AttnTensors { const bf16* Q; const bf16* K; const bf16* V; bf16* O; const float* CB; float qkb; };
struct AttnUnit { int bh; int qb; };
struct StaticOrder {
  int vcu,G;
  __device__ __forceinline__ explicit StaticOrder(int grid,int block):vcu((grid%8==0)?(block%8)*(grid/8)+block/8:block),G(grid){}
  __device__ __forceinline__ bool next(int i,AttnUnit&u)const{
    if(G==256){ if(i>=4)return false; const int s=vcu&3; u.bh=vcu>>2; u.qb=(i==0)?s:(i==1)?7-s:(i==2)?8+s:15-s; return true; }
    const int id=vcu+i*G; if(id>=BATCH*NHEAD*NQB)return false; u.bh=id/NQB; u.qb=id%NQB; return true; }
};
template<class Sched,bool SKIP> __device__ __forceinline__ void attn_phase(char*lds,const AttnTensors&T,const Sched&S){
  AttnUnit u;
  for(int i=0;S.next(i,u);++i){ attn_unit<SKIP>(u.bh/NHEAD,u.bh%NHEAD,u.qb,T.Q,T.K,T.V,T.O,T.CB,T.qkb,lds); }
}
template<bool SKIP> __device__ __forceinline__ void attn_phase_q(char*lds,const AttnTensors&T,unsigned*queue){
  const int tid=otid();
  __attribute__((address_space(3))) int*slot=(__attribute__((address_space(3))) int*)((lds_cptr)lds+LDS_TOTAL);
  const unsigned xcc=(unsigned)__builtin_amdgcn_s_getreg((3<<11)|20)&7u;
  for(;;){
    if(tid==0){ int got=-1;
      for(unsigned sx=0;sx<8;++sx){ const unsigned x=(xcc+sx)&7u; const unsigned c=__hip_atomic_fetch_add(queue+x*64,1u,__ATOMIC_RELAXED,__HIP_MEMORY_SCOPE_AGENT); if(c<(unsigned)(NHEAD*NQB)){ got=(int)(x*(NHEAD*NQB)+c); break; } }
      *slot=got; }
    asm volatile("s_waitcnt vmcnt(0) lgkmcnt(0)\n\ts_barrier":::"memory");
    const int id=__builtin_amdgcn_readfirstlane(*slot);
    if(id<0)break;
    const int b=id/(NHEAD*NQB), c=id%(NHEAD*NQB), h=c%NHEAD, qb=NQB-1-c/NHEAD;
    attn_unit<SKIP>(b,h,qb,T.Q,T.K,T.V,T.O,T.CB,T.qkb,lds);
  }
}
#undef SBAR
#undef WAIT_BAR
}
#define GAS __attribute__((address_space(1)))
#define LAS __attribute__((address_space(3)))
typedef unsigned short bf16;
typedef unsigned v4u __attribute__((ext_vector_type(4)));
typedef float f32x4 __attribute__((ext_vector_type(4)));
typedef short bf16x8 __attribute__((ext_vector_type(8)));
typedef GAS unsigned gu32;
typedef GAS unsigned long long gu64;
#define RLX_AGENT __ATOMIC_RELAXED, __HIP_MEMORY_SCOPE_AGENT
#define LDS_WAIT() asm volatile("s_waitcnt lgkmcnt(0)" ::: "memory")
#define VM_WAIT() asm volatile("s_waitcnt vmcnt(0)" ::: "memory")
__device__ __forceinline__ unsigned long long rt() { return __builtin_amdgcn_s_memrealtime(); }
__device__ __forceinline__ unsigned f2bf(float f) { unsigned u = __builtin_bit_cast(unsigned, f); return (u + 0x7fffu + ((u >> 16) & 1u)) >> 16; }
__device__ __forceinline__ unsigned pk2(float lo, float hi) { return f2bf(lo) | (f2bf(hi) << 16); }

#define XB_TMO      128
#define XB_XCNT(j)  (256  + 64 * (j))
#define XB_XSUB(j)  (1280 + 64 * (j))
#define XB_XGEN(j)  (2304 + 64 * (j))
#define XB_TOP      3328
#define XB_TOPGEN   3392
#define XCD_BAR_WORDS 3456
#define XB_SPIN_CAP (1u << 18)

__device__ __forceinline__ unsigned xb_ld(unsigned* p)              { return __hip_atomic_load(p, __ATOMIC_RELAXED, __HIP_MEMORY_SCOPE_AGENT); }
__device__ __forceinline__ unsigned xb_add(unsigned* p, unsigned v) { return __hip_atomic_fetch_add(p, v, __ATOMIC_RELAXED, __HIP_MEMORY_SCOPE_AGENT); }
__device__ __forceinline__ unsigned xb_xcc_id() { return (unsigned)__builtin_amdgcn_s_getreg((3 << 11) | 20) & 0xFu; }
#define XB_SPIN(cond, bar) do { unsigned _sp = 0; while (cond) { __builtin_amdgcn_s_sleep(1); \
    if ((++_sp & 255u) == 0u) { if (xb_ld(&(bar)[XB_TMO])) break; if (_sp > XB_SPIN_CAP) { atomicAdd(&(bar)[XB_TMO], 1u); break; } } } } while (0)

struct XcdBarrier {
    unsigned* bar; unsigned x;
    volatile LAS unsigned* st;
};

__device__ __forceinline__ XcdBarrier xcd_barrier_post(unsigned* bar, volatile LAS unsigned* st) {
    XcdBarrier b; b.bar = bar; b.x = xb_xcc_id(); b.st = st;
    if (threadIdx.x == 0) (void)xb_add(&bar[XB_XCNT(b.x)], 1u);
    return b;
}
__device__ __forceinline__ void xcd_barrier_complete(unsigned* bar, unsigned x, unsigned& nloc, unsigned& nx) {
    const unsigned G = gridDim.x * gridDim.y * gridDim.z;
    unsigned sum, cnt, mine, sp = 0u;
    for (;;) {
        sum = 0u; cnt = 0u; mine = 0u;
#pragma unroll
        for (unsigned j = 0; j < 16; ++j) { const unsigned c = xb_ld(&bar[XB_XCNT(j)]); sum += c; cnt += (c > 0u) ? 1u : 0u; mine = (j == x) ? c : mine; }
        if (sum == G) break;
        __builtin_amdgcn_s_sleep(1);
        if ((++sp & 255u) == 0u) { if (xb_ld(&bar[XB_TMO])) break; if (sp > XB_SPIN_CAP) { atomicAdd(&bar[XB_TMO], 1u); break; } }
    }
    nloc = mine > 0u ? mine : 1u; nx = cnt > 0u ? cnt : 1u;
}

__device__ __forceinline__ void xcd_barrier(const XcdBarrier& b) {
    asm volatile("s_waitcnt vmcnt(0)" ::: "memory");
    __syncthreads();
    if (threadIdx.x == 0) {
        unsigned* bar = b.bar;
        __builtin_amdgcn_s_waitcnt(0);
        unsigned nloc = b.st[0], nx = b.st[1];
        if (nloc == 0u) { xcd_barrier_complete(bar, b.x, nloc, nx); b.st[0] = nloc; b.st[1] = nx; }
        const unsigned old = xb_add(&bar[XB_XSUB(b.x)], 1u);
        const unsigned gen = old / nloc;
        if (old + 1u == (gen + 1u) * nloc) {
            __builtin_amdgcn_fence(__ATOMIC_RELEASE, "agent");
            asm volatile("s_waitcnt vmcnt(0)" ::: "memory");
            const unsigned og = xb_add(&bar[XB_TOP], 1u);
            const unsigned tg = og / nx;
            if (og + 1u == (tg + 1u) * nx) xb_add(&bar[XB_TOPGEN], 1u);
            else XB_SPIN(xb_ld(&bar[XB_TOPGEN]) == tg, bar);
            __builtin_amdgcn_fence(__ATOMIC_ACQUIRE, "agent");
            xb_add(&bar[XB_XGEN(b.x)], 1u);
            asm volatile("s_waitcnt vmcnt(0)" ::: "memory");
        } else {
            XB_SPIN(xb_ld(&bar[XB_XGEN(b.x)]) == gen, bar);
            __builtin_amdgcn_fence(__ATOMIC_ACQUIRE, "agent");
            asm volatile("s_waitcnt vmcnt(0)" ::: "memory");
        }
    }
    __syncthreads();
}
struct Args { const float* in[25]; float* out; unsigned char* ws; int ph_lo, ph_hi, use_bar, pad; };
typedef const __attribute__((address_space(4))) Args* KArgs;
#define CAND_LIST CAND(0,0,2,1) CAND(0,1,2,2) CAND(0,2,2,3) CAND(0,3,2,4) CAND(0,4,3,0) CAND(0,5,3,1) CAND(0,6,3,2) CAND(0,7,3,3) CAND(0,8,4,0) CAND(0,9,4,1) CAND(0,10,4,2) CAND(0,11,5,0) CAND(0,12,5,1) CAND(0,13,6,0) CAND(0,14,6,1) CAND(0,15,7,0) CAND(1,0,7,1) CAND(1,1,8,0) CAND(1,2,9,0) CAND(1,3,10,0) CAND(1,4,11,0) CAND(1,5,12,0) CAND(1,6,13,0) CAND(1,7,14,0) CAND(2,0,15,0)
__device__ __forceinline__ void sort16_desc(float (&a)[16]) {
    { const float h_ = fmaxf(a[0], a[1]), l_ = fminf(a[0], a[1]); a[0] = h_; a[1] = l_; }
    { const float h_ = fmaxf(a[2], a[3]), l_ = fminf(a[2], a[3]); a[2] = h_; a[3] = l_; }
    { const float h_ = fmaxf(a[0], a[2]), l_ = fminf(a[0], a[2]); a[0] = h_; a[2] = l_; }
    { const float h_ = fmaxf(a[1], a[3]), l_ = fminf(a[1], a[3]); a[1] = h_; a[3] = l_; }
    { const float h_ = fmaxf(a[1], a[2]), l_ = fminf(a[1], a[2]); a[1] = h_; a[2] = l_; }
    { const float h_ = fmaxf(a[4], a[5]), l_ = fminf(a[4], a[5]); a[4] = h_; a[5] = l_; }
    { const float h_ = fmaxf(a[6], a[7]), l_ = fminf(a[6], a[7]); a[6] = h_; a[7] = l_; }
    { const float h_ = fmaxf(a[4], a[6]), l_ = fminf(a[4], a[6]); a[4] = h_; a[6] = l_; }
    { const float h_ = fmaxf(a[5], a[7]), l_ = fminf(a[5], a[7]); a[5] = h_; a[7] = l_; }
    { const float h_ = fmaxf(a[5], a[6]), l_ = fminf(a[5], a[6]); a[5] = h_; a[6] = l_; }
    { const float h_ = fmaxf(a[0], a[4]), l_ = fminf(a[0], a[4]); a[0] = h_; a[4] = l_; }
    { const float h_ = fmaxf(a[2], a[6]), l_ = fminf(a[2], a[6]); a[2] = h_; a[6] = l_; }
    { const float h_ = fmaxf(a[2], a[4]), l_ = fminf(a[2], a[4]); a[2] = h_; a[4] = l_; }
    { const float h_ = fmaxf(a[1], a[5]), l_ = fminf(a[1], a[5]); a[1] = h_; a[5] = l_; }
    { const float h_ = fmaxf(a[3], a[7]), l_ = fminf(a[3], a[7]); a[3] = h_; a[7] = l_; }
    { const float h_ = fmaxf(a[3], a[5]), l_ = fminf(a[3], a[5]); a[3] = h_; a[5] = l_; }
    { const float h_ = fmaxf(a[1], a[2]), l_ = fminf(a[1], a[2]); a[1] = h_; a[2] = l_; }
    { const float h_ = fmaxf(a[3], a[4]), l_ = fminf(a[3], a[4]); a[3] = h_; a[4] = l_; }
    { const float h_ = fmaxf(a[5], a[6]), l_ = fminf(a[5], a[6]); a[5] = h_; a[6] = l_; }
    { const float h_ = fmaxf(a[8], a[9]), l_ = fminf(a[8], a[9]); a[8] = h_; a[9] = l_; }
    { const float h_ = fmaxf(a[10], a[11]), l_ = fminf(a[10], a[11]); a[10] = h_; a[11] = l_; }
    { const float h_ = fmaxf(a[8], a[10]), l_ = fminf(a[8], a[10]); a[8] = h_; a[10] = l_; }
    { const float h_ = fmaxf(a[9], a[11]), l_ = fminf(a[9], a[11]); a[9] = h_; a[11] = l_; }
    { const float h_ = fmaxf(a[9], a[10]), l_ = fminf(a[9], a[10]); a[9] = h_; a[10] = l_; }
    { const float h_ = fmaxf(a[12], a[13]), l_ = fminf(a[12], a[13]); a[12] = h_; a[13] = l_; }
    { const float h_ = fmaxf(a[14], a[15]), l_ = fminf(a[14], a[15]); a[14] = h_; a[15] = l_; }
    { const float h_ = fmaxf(a[12], a[14]), l_ = fminf(a[12], a[14]); a[12] = h_; a[14] = l_; }
    { const float h_ = fmaxf(a[13], a[15]), l_ = fminf(a[13], a[15]); a[13] = h_; a[15] = l_; }
    { const float h_ = fmaxf(a[13], a[14]), l_ = fminf(a[13], a[14]); a[13] = h_; a[14] = l_; }
    { const float h_ = fmaxf(a[8], a[12]), l_ = fminf(a[8], a[12]); a[8] = h_; a[12] = l_; }
    { const float h_ = fmaxf(a[10], a[14]), l_ = fminf(a[10], a[14]); a[10] = h_; a[14] = l_; }
    { const float h_ = fmaxf(a[10], a[12]), l_ = fminf(a[10], a[12]); a[10] = h_; a[12] = l_; }
    { const float h_ = fmaxf(a[9], a[13]), l_ = fminf(a[9], a[13]); a[9] = h_; a[13] = l_; }
    { const float h_ = fmaxf(a[11], a[15]), l_ = fminf(a[11], a[15]); a[11] = h_; a[15] = l_; }
    { const float h_ = fmaxf(a[11], a[13]), l_ = fminf(a[11], a[13]); a[11] = h_; a[13] = l_; }
    { const float h_ = fmaxf(a[9], a[10]), l_ = fminf(a[9], a[10]); a[9] = h_; a[10] = l_; }
    { const float h_ = fmaxf(a[11], a[12]), l_ = fminf(a[11], a[12]); a[11] = h_; a[12] = l_; }
    { const float h_ = fmaxf(a[13], a[14]), l_ = fminf(a[13], a[14]); a[13] = h_; a[14] = l_; }
    { const float h_ = fmaxf(a[0], a[8]), l_ = fminf(a[0], a[8]); a[0] = h_; a[8] = l_; }
    { const float h_ = fmaxf(a[4], a[12]), l_ = fminf(a[4], a[12]); a[4] = h_; a[12] = l_; }
    { const float h_ = fmaxf(a[4], a[8]), l_ = fminf(a[4], a[8]); a[4] = h_; a[8] = l_; }
    { const float h_ = fmaxf(a[2], a[10]), l_ = fminf(a[2], a[10]); a[2] = h_; a[10] = l_; }
    { const float h_ = fmaxf(a[6], a[14]), l_ = fminf(a[6], a[14]); a[6] = h_; a[14] = l_; }
    { const float h_ = fmaxf(a[6], a[10]), l_ = fminf(a[6], a[10]); a[6] = h_; a[10] = l_; }
    { const float h_ = fmaxf(a[2], a[4]), l_ = fminf(a[2], a[4]); a[2] = h_; a[4] = l_; }
    { const float h_ = fmaxf(a[6], a[8]), l_ = fminf(a[6], a[8]); a[6] = h_; a[8] = l_; }
    { const float h_ = fmaxf(a[10], a[12]), l_ = fminf(a[10], a[12]); a[10] = h_; a[12] = l_; }
    { const float h_ = fmaxf(a[1], a[9]), l_ = fminf(a[1], a[9]); a[1] = h_; a[9] = l_; }
    { const float h_ = fmaxf(a[5], a[13]), l_ = fminf(a[5], a[13]); a[5] = h_; a[13] = l_; }
    { const float h_ = fmaxf(a[5], a[9]), l_ = fminf(a[5], a[9]); a[5] = h_; a[9] = l_; }
    { const float h_ = fmaxf(a[3], a[11]), l_ = fminf(a[3], a[11]); a[3] = h_; a[11] = l_; }
    { const float h_ = fmaxf(a[7], a[15]), l_ = fminf(a[7], a[15]); a[7] = h_; a[15] = l_; }
    { const float h_ = fmaxf(a[7], a[11]), l_ = fminf(a[7], a[11]); a[7] = h_; a[11] = l_; }
    { const float h_ = fmaxf(a[3], a[5]), l_ = fminf(a[3], a[5]); a[3] = h_; a[5] = l_; }
    { const float h_ = fmaxf(a[7], a[9]), l_ = fminf(a[7], a[9]); a[7] = h_; a[9] = l_; }
    { const float h_ = fmaxf(a[11], a[13]), l_ = fminf(a[11], a[13]); a[11] = h_; a[13] = l_; }
    { const float h_ = fmaxf(a[1], a[2]), l_ = fminf(a[1], a[2]); a[1] = h_; a[2] = l_; }
    { const float h_ = fmaxf(a[3], a[4]), l_ = fminf(a[3], a[4]); a[3] = h_; a[4] = l_; }
    { const float h_ = fmaxf(a[5], a[6]), l_ = fminf(a[5], a[6]); a[5] = h_; a[6] = l_; }
    { const float h_ = fmaxf(a[7], a[8]), l_ = fminf(a[7], a[8]); a[7] = h_; a[8] = l_; }
    { const float h_ = fmaxf(a[9], a[10]), l_ = fminf(a[9], a[10]); a[9] = h_; a[10] = l_; }
    { const float h_ = fmaxf(a[11], a[12]), l_ = fminf(a[11], a[12]); a[11] = h_; a[12] = l_; }
    { const float h_ = fmaxf(a[13], a[14]), l_ = fminf(a[13], a[14]); a[13] = h_; a[14] = l_; }
}
__device__ __forceinline__ void merge16_desc(float (&a)[16], const float (&b)[16]) {
    a[0] = fmaxf(a[0], b[15]);
    a[1] = fmaxf(a[1], b[14]);
    a[2] = fmaxf(a[2], b[13]);
    a[3] = fmaxf(a[3], b[12]);
    a[4] = fmaxf(a[4], b[11]);
    a[5] = fmaxf(a[5], b[10]);
    a[6] = fmaxf(a[6], b[9]);
    a[7] = fmaxf(a[7], b[8]);
    a[8] = fmaxf(a[8], b[7]);
    a[9] = fmaxf(a[9], b[6]);
    a[10] = fmaxf(a[10], b[5]);
    a[11] = fmaxf(a[11], b[4]);
    a[12] = fmaxf(a[12], b[3]);
    a[13] = fmaxf(a[13], b[2]);
    a[14] = fmaxf(a[14], b[1]);
    a[15] = fmaxf(a[15], b[0]);
    { const float h_ = fmaxf(a[0], a[8]), l_ = fminf(a[0], a[8]); a[0] = h_; a[8] = l_; }
    { const float h_ = fmaxf(a[1], a[9]), l_ = fminf(a[1], a[9]); a[1] = h_; a[9] = l_; }
    { const float h_ = fmaxf(a[2], a[10]), l_ = fminf(a[2], a[10]); a[2] = h_; a[10] = l_; }
    { const float h_ = fmaxf(a[3], a[11]), l_ = fminf(a[3], a[11]); a[3] = h_; a[11] = l_; }
    { const float h_ = fmaxf(a[4], a[12]), l_ = fminf(a[4], a[12]); a[4] = h_; a[12] = l_; }
    { const float h_ = fmaxf(a[5], a[13]), l_ = fminf(a[5], a[13]); a[5] = h_; a[13] = l_; }
    { const float h_ = fmaxf(a[6], a[14]), l_ = fminf(a[6], a[14]); a[6] = h_; a[14] = l_; }
    { const float h_ = fmaxf(a[7], a[15]), l_ = fminf(a[7], a[15]); a[7] = h_; a[15] = l_; }
    { const float h_ = fmaxf(a[0], a[4]), l_ = fminf(a[0], a[4]); a[0] = h_; a[4] = l_; }
    { const float h_ = fmaxf(a[1], a[5]), l_ = fminf(a[1], a[5]); a[1] = h_; a[5] = l_; }
    { const float h_ = fmaxf(a[2], a[6]), l_ = fminf(a[2], a[6]); a[2] = h_; a[6] = l_; }
    { const float h_ = fmaxf(a[3], a[7]), l_ = fminf(a[3], a[7]); a[3] = h_; a[7] = l_; }
    { const float h_ = fmaxf(a[8], a[12]), l_ = fminf(a[8], a[12]); a[8] = h_; a[12] = l_; }
    { const float h_ = fmaxf(a[9], a[13]), l_ = fminf(a[9], a[13]); a[9] = h_; a[13] = l_; }
    { const float h_ = fmaxf(a[10], a[14]), l_ = fminf(a[10], a[14]); a[10] = h_; a[14] = l_; }
    { const float h_ = fmaxf(a[11], a[15]), l_ = fminf(a[11], a[15]); a[11] = h_; a[15] = l_; }
    { const float h_ = fmaxf(a[0], a[2]), l_ = fminf(a[0], a[2]); a[0] = h_; a[2] = l_; }
    { const float h_ = fmaxf(a[1], a[3]), l_ = fminf(a[1], a[3]); a[1] = h_; a[3] = l_; }
    { const float h_ = fmaxf(a[4], a[6]), l_ = fminf(a[4], a[6]); a[4] = h_; a[6] = l_; }
    { const float h_ = fmaxf(a[5], a[7]), l_ = fminf(a[5], a[7]); a[5] = h_; a[7] = l_; }
    { const float h_ = fmaxf(a[8], a[10]), l_ = fminf(a[8], a[10]); a[8] = h_; a[10] = l_; }
    { const float h_ = fmaxf(a[9], a[11]), l_ = fminf(a[9], a[11]); a[9] = h_; a[11] = l_; }
    { const float h_ = fmaxf(a[12], a[14]), l_ = fminf(a[12], a[14]); a[12] = h_; a[14] = l_; }
    { const float h_ = fmaxf(a[13], a[15]), l_ = fminf(a[13], a[15]); a[13] = h_; a[15] = l_; }
    { const float h_ = fmaxf(a[0], a[1]), l_ = fminf(a[0], a[1]); a[0] = h_; a[1] = l_; }
    { const float h_ = fmaxf(a[2], a[3]), l_ = fminf(a[2], a[3]); a[2] = h_; a[3] = l_; }
    { const float h_ = fmaxf(a[4], a[5]), l_ = fminf(a[4], a[5]); a[4] = h_; a[5] = l_; }
    { const float h_ = fmaxf(a[6], a[7]), l_ = fminf(a[6], a[7]); a[6] = h_; a[7] = l_; }
    { const float h_ = fmaxf(a[8], a[9]), l_ = fminf(a[8], a[9]); a[8] = h_; a[9] = l_; }
    { const float h_ = fmaxf(a[10], a[11]), l_ = fminf(a[10], a[11]); a[10] = h_; a[11] = l_; }
    { const float h_ = fmaxf(a[12], a[13]), l_ = fminf(a[12], a[13]); a[12] = h_; a[13] = l_; }
    { const float h_ = fmaxf(a[14], a[15]), l_ = fminf(a[14], a[15]); a[14] = h_; a[15] = l_; }
}
constexpr int NB = 8, SEQ = 4096, DM = 1024, NTOK = NB * SEQ;
constexpr int NH = 8, HD = 64, AW = 512, PWD = 256, SWD = 256, INC = 2056;
constexpr int NEXP = 16384, PQW = 2048;
constexpr float EPSN = 1e-6f, LOG2E = 1.4426950408889634f;
constexpr int NWAVES = 8, NTHR = 512;
constexpr size_t MiB = 1u << 20;
constexpr size_t WS_CTL = 0, CTL_ZERO_BYTES = 1 * MiB;
constexpr size_t WS_WIN = 1 * MiB;
constexpr size_t WS_WOUT = 9 * MiB;
constexpr size_t WS_WQ = 13 * MiB;
constexpr size_t WS_KEYS = 21 * MiB;
constexpr size_t WS_WGLU = 22 * MiB;
constexpr size_t WS_WF = 22 * MiB + 512 * 1024;
constexpr size_t WS_CB = 23 * MiB;
constexpr size_t WS_XLOC = 24 * MiB;
constexpr size_t WS_IDX = 28 * MiB;
constexpr size_t WS_GATE = 44 * MiB;
constexpr size_t WS_Z = 60 * MiB;
constexpr size_t WS_U = 76 * MiB;
constexpr size_t WS_V = 140 * MiB;
constexpr size_t WS_XN8 = 172 * MiB;
constexpr size_t WS_HSC = 22 * MiB + 768 * 1024;
constexpr size_t WS_XN = 204 * MiB;
constexpr size_t WS_P = 268 * MiB;
constexpr size_t WS_MG = 396 * MiB;
constexpr size_t WS_END = 460 * MiB;
constexpr int CW_BAR = 4096, CW_AQ = 20480;
constexpr float U8_SCALE = 768.f, V8_SCALE = 32.f, ACT_SCALE = 64.f;
constexpr int RING_BYTES = 131072, LDSCTL_OFF = RING_BYTES, MISC_OFF = LDSCTL_OFF + 320, EPIX_OFF = LDSCTL_OFF + 4096, LDS_BYTES = 163840;
static_assert(attn_body::ATTN_LDS_BYTES + 16 <= RING_BYTES, "attention scratch fits the ring");

typedef _Float16 h16x2 __attribute__((ext_vector_type(2)));
typedef float f32x16 __attribute__((ext_vector_type(16)));
typedef unsigned u32x2 __attribute__((ext_vector_type(2)));

__device__ __forceinline__ float bf2f(unsigned short b) { return __uint_as_float((unsigned)b << 16); }
__device__ __forceinline__ float bflo(unsigned w) { return __uint_as_float(w << 16); }
__device__ __forceinline__ float bfhi(unsigned w) { return __uint_as_float(w & 0xffff0000u); }
__device__ __forceinline__ h16x2 as_h2(unsigned w) { return __builtin_bit_cast(h16x2, w); }
template <bool HI> __device__ __forceinline__ h16x2 cvt8h(int w) { return __builtin_bit_cast(h16x2, __builtin_amdgcn_cvt_scalef32_pk_f16_fp8(w, 1.0f, HI)); }
__device__ __forceinline__ float gelu_tanh(float x) { const float u = 1.5957691216057308f * (x + 0.044715f * x * x * x); return x / (1.f + __expf(-u)); }
__device__ __forceinline__ float wave_sum(float v) {
#pragma unroll
    for (int o = 1; o < 64; o <<= 1) v += __shfl_xor(v, o);
    return v;
}
__device__ __forceinline__ float wave_max(float v) {
#pragma unroll
    for (int o = 1; o < 64; o <<= 1) v = fmaxf(v, __shfl_xor(v, o));
    return v;
}
template <int N, int S0> __device__ __forceinline__ float bfly_reduce(float (&v)[N], int lane) {
    int s = S0;
#pragma unroll
    for (int cnt = N; cnt > 1; cnt >>= 1) {
        const bool up = (lane & s) != 0;
#pragma unroll
        for (int i = 0; i < cnt / 2; ++i) { const float a = v[i], b = v[i + cnt / 2]; const float send = up ? a : b, keep = up ? b : a; v[i] = keep + __shfl_xor(send, s); }
        s >>= 1;
    }
    float r = v[0];
    for (; s >= 1; s >>= 1) r += __shfl_xor(r, s);
    return r;
}

__device__ __forceinline__ void tr_item(const float* W, int ldw, int srccol, bf16* WT, int K, int dstrow, int k0, LAS float* scr, int lane) {
#pragma unroll 8
    for (int i = 0; i < 32; ++i) { const int kk = 2 * i + (lane >> 5); scr[kk * 33 + (lane & 31)] = W[(size_t)(k0 + kk) * ldw + srccol + (lane & 31)]; }
    LDS_WAIT(); asm volatile("" ::: "memory");
    const int c = lane & 7;
#pragma unroll
    for (int j = 0; j < 4; ++j) { const int n = (lane >> 3) + 8 * j; const LAS float* s = scr + (8 * c) * 33 + n;
        v4u o; o.x = pk2(s[0 * 33], s[1 * 33]); o.y = pk2(s[2 * 33], s[3 * 33]); o.z = pk2(s[4 * 33], s[5 * 33]); o.w = pk2(s[6 * 33], s[7 * 33]);
        *(GAS v4u*)(WT + (size_t)(dstrow + n) * K + k0 + 8 * c) = o; }
    LDS_WAIT(); asm volatile("" ::: "memory");
}
__device__ __forceinline__ void phase_prep(KArgs a, LAS unsigned char* lds, int G, int vcu, int tid, int lane, int wave) {
    unsigned char* ws = a->ws;
    LAS float* scr = (LAS float*)(lds + wave * 16384);
    const int gw = vcu * NWAVES + wave, NGW = G * NWAVES;
    constexpr int I_IN = 2048, I_OUT = 1024, I_WQ = 2048, I_GLU = 64;
    for (int it = gw; it < I_IN + I_OUT + I_WQ + I_GLU; it += NGW) {
        int r = it;
        if (r < I_IN) { const int l = r >> 10, q = r & 1023, kb = q >> 6, nb = q & 63, n0 = nb * 32;
            tr_item(a->in[2] + (size_t)l * DM * INC, INC, n0 + (n0 >= 1536 ? 8 : 0), (bf16*)(ws + WS_WIN) + (size_t)l * 2048 * 1024, 1024, n0, kb * 64, scr, lane); continue; }
        r -= I_IN;
        if (r < I_OUT) { const int l = r >> 9, q = r & 511, kb = q >> 5, nb = q & 31;
            tr_item(a->in[19] + (size_t)l * DM * DM, DM, nb * 32, (bf16*)(ws + WS_WOUT) + (size_t)l * 1024 * 1024, 1024, nb * 32, kb * 64, scr, lane); continue; }
        r -= I_OUT;
        if (r < I_WQ) { const int l = r >> 10, q = r & 1023, kb = q >> 6, nb = q & 63;
            tr_item(a->in[21] + (size_t)l * DM * PQW, PQW, nb * 32, (bf16*)(ws + WS_WQ) + (size_t)l * 2048 * 1024, 1024, nb * 32, kb * 64, scr, lane); continue; }
        r -= I_WQ;
        { const int l = r >> 5, q = r & 31, kb = q >> 3, nb = q & 7;
            tr_item(a->in[16] + (size_t)l * 256 * 256, 256, nb * 32, (bf16*)(ws + WS_WGLU) + (size_t)l * 256 * 256, 256, nb * 32, kb * 64, scr, lane); }
    }
    const size_t gt = (size_t)vcu * NTHR + tid, NGT = (size_t)G * NTHR;
    for (size_t i = gt; i < 2 * 8 * 1024; i += NGT) { const int l = (int)(i >> 13), h = (int)(i >> 10) & 7, k = (int)i & 1023;
        ((float*)(ws + WS_WF))[i] = a->in[2][((size_t)l * DM + k) * INC + 1536 + h]; }
    { const float* src = a->in[22]; bf16* dst = (bf16*)(ws + WS_KEYS);
      for (size_t i = gt; i < (size_t)2 * 8 * 2 * 128 * 128 / 8; i += NGT) { const f32x4 x0 = *(const f32x4*)(src + i * 8), x1 = *(const f32x4*)(src + i * 8 + 4);
          v4u o; o.x = pk2(x0[0], x0[1]); o.y = pk2(x0[2], x0[3]); o.z = pk2(x1[0], x1[1]); o.w = pk2(x1[2], x1[3]); *(v4u*)(dst + i * 8) = o; } }
    { const float* src = a->in[23]; unsigned char* dst = ws + WS_U;
#pragma unroll 1
      for (size_t i = gt; i < (size_t)2 * NEXP * DM / 16; i += NGT) { v4u o;
#pragma unroll
          for (int q = 0; q < 4; ++q) { const f32x4 x = *(const f32x4*)(src + i * 16 + 4 * q) * U8_SCALE;
              const int q0 = (int)__builtin_rintf(fminf(fmaxf(x[0], -127.f), 127.f)), q1 = (int)__builtin_rintf(fminf(fmaxf(x[1], -127.f), 127.f)), q2 = (int)__builtin_rintf(fminf(fmaxf(x[2], -127.f), 127.f)), q3 = (int)__builtin_rintf(fminf(fmaxf(x[3], -127.f), 127.f));
              o[q] = (unsigned)((q0 & 255) | ((q1 & 255) << 8) | ((q2 & 255) << 16) | (q3 << 24)); }
          const size_t r = i >> 6; const unsigned cg = (unsigned)(i & 63), l = (unsigned)(r / NEXP), rl = (unsigned)(r % NEXP);
          *(v4u*)(dst + (size_t)l * NEXP * DM + (size_t)(cg >> 3) * NEXP * 128 + (size_t)rl * 128 + (cg & 7u) * 16u) = o; } }
    { const float* src = a->in[24]; unsigned char* dst = ws + WS_V;
#pragma unroll 1
      for (size_t i = gt; i < (size_t)2 * NEXP * DM / 16; i += NGT) { v4u o;
#pragma unroll
          for (int q = 0; q < 4; ++q) { f32x4 x = *(const f32x4*)(src + i * 16 + 4 * q) * V8_SCALE;
              x[0] = fminf(fmaxf(x[0], -448.f), 448.f); x[1] = fminf(fmaxf(x[1], -448.f), 448.f); x[2] = fminf(fmaxf(x[2], -448.f), 448.f); x[3] = fminf(fmaxf(x[3], -448.f), 448.f);
              int w = 0; w = __builtin_amdgcn_cvt_pk_fp8_f32(x[0], x[1], w, false); w = __builtin_amdgcn_cvt_pk_fp8_f32(x[2], x[3], w, true); o[q] = (unsigned)w; }
          const size_t r = i >> 6; const unsigned cg = (unsigned)(i & 63), l = (unsigned)(r / NEXP), rl = (unsigned)(r % NEXP);
          *(v4u*)(dst + (size_t)l * NEXP * DM + (size_t)(cg >> 3) * NEXP * 128 + (size_t)rl * 128 + (cg & 7u) * 16u) = o; } }
}

template <bool FLOGIT> __device__ __forceinline__ void phase_rownorm(const float* x, const float* g, bf16* XN, const float* WF, const float* fbias, float* CB, int G, int vcu, int lane, int wave, unsigned char* XN8 = nullptr, float* HSC = nullptr) {
    const int gw = vcu * NWAVES + wave, NGW = G * NWAVES;
    f32x4 gv[4];
#pragma unroll
    for (int j = 0; j < 4; ++j) gv[j] = *(const f32x4*)(g + 4 * lane + 256 * j);
    f32x4 vn[2][4];
#define RN_LOAD(rg_) do { _Pragma("unroll") for (int r = 0; r < 2; ++r) { const float* xr = x + (size_t)((rg_) * 2 + r) * DM + 4 * lane; _Pragma("unroll") for (int j = 0; j < 4; ++j) vn[r][j] = *(const f32x4*)(xr + 256 * j); } } while (0)
    if (gw < NTOK / 2) RN_LOAD(gw);
    for (int rg = gw; rg < NTOK / 2; rg += NGW) {
        f32x4 v[2][4];
#pragma unroll
        for (int r = 0; r < 2; ++r)
#pragma unroll
            for (int j = 0; j < 4; ++j) v[r][j] = vn[r][j];
        if (rg + NGW < NTOK / 2) RN_LOAD(rg + NGW);
#pragma unroll
        for (int r = 0; r < 2; ++r) { float s = 0.f;
#pragma unroll
            for (int j = 0; j < 4; ++j) s += (v[r][j][0] * v[r][j][0] + v[r][j][1] * v[r][j][1]) + (v[r][j][2] * v[r][j][2] + v[r][j][3] * v[r][j][3]);
            const float rstd = 1.0f / sqrtf(wave_sum(s) * (1.f / DM) + EPSN);
            bf16* orow = XN + (size_t)(rg * 2 + r) * DM + 4 * lane;
#pragma unroll
            for (int j = 0; j < 4; ++j) { v[r][j] = v[r][j] * rstd * gv[j]; u32x2 w; w.x = pk2(v[r][j][0], v[r][j][1]); w.y = pk2(v[r][j][2], v[r][j][3]); *(u32x2*)(orow + 256 * j) = w; }
            if (!FLOGIT && XN8) { float mx = 0.f;
#pragma unroll
                for (int j = 0; j < 4; ++j) mx = fmaxf(fmaxf(mx, fmaxf(fabsf(v[r][j][0]), fabsf(v[r][j][1]))), fmaxf(fabsf(v[r][j][2]), fabsf(v[r][j][3])));
                mx = fmaxf(wave_max(mx), 1e-20f); const float qs = 127.f / mx;
#pragma unroll
                for (int j = 0; j < 4; ++j) { const int q0 = (int)__builtin_rintf(v[r][j][0] * qs), q1 = (int)__builtin_rintf(v[r][j][1] * qs), q2 = (int)__builtin_rintf(v[r][j][2] * qs), q3 = (int)__builtin_rintf(v[r][j][3] * qs);
                    *(unsigned*)(XN8 + (size_t)(rg * 2 + r) * DM + 4 * lane + 256 * j) = (unsigned)((q0 & 255) | ((q1 & 255) << 8) | ((q2 & 255) << 16) | (q3 << 24)); }
                if (lane == 0) HSC[rg * 2 + r] = mx * (1.f / 127.f); } }
        if (FLOGIT) {
            float acc[16];
#pragma unroll
            for (int i = 0; i < 16; ++i) acc[i] = 0.f;
#pragma unroll
            for (int h = 0; h < 8; ++h)
#pragma unroll
                for (int j = 0; j < 4; ++j) { const f32x4 w = *(const f32x4*)(WF + h * 1024 + 4 * lane + 256 * j);
#pragma unroll
                    for (int r = 0; r < 2; ++r) acc[r * 8 + h] += (v[r][j][0] * w[0] + v[r][j][1] * w[1]) + (v[r][j][2] * w[2] + v[r][j][3] * w[3]); }
            const float tot = bfly_reduce<16, 32>(acc, lane);
            if ((lane & 3) == 0) { const int id = (lane >> 2) & 15, r = id >> 3, h = id & 7; const int row = rg * 2 + r, b = row / SEQ, s = row % SEQ;
                const float z = tot + fbias[h];
                const float ls = fminf(z, 0.f) - __logf(1.f + __expf(-fabsf(z)));
                CB[((size_t)(b * NH + h)) * SEQ + s] = ls * LOG2E; }
        }
    }
}

__device__ __forceinline__ void phase_cumsum(float* c, int lane) {
    float carry = 0.f;
#pragma unroll 1
    for (int it0 = 0; it0 < SEQ / 64; it0 += 16) { float vv[16];
#pragma unroll
        for (int q = 0; q < 16; ++q) vv[q] = c[(it0 + q) * 64 + lane];
#pragma unroll
        for (int q = 0; q < 16; ++q) { float v = vv[q];
#pragma unroll
            for (int o = 1; o < 64; o <<= 1) { const float t = __shfl_up(v, o); if (lane >= o) v += t; }
            v += carry; c[(it0 + q) * 64 + lane] = v; carry = __shfl(v, 63); } }
}

__device__ __forceinline__ void phase_pool(const bf16* PS, const float* pw, const float* pscale, const float* ong, bf16* MG, LAS unsigned char* lds, int G, int bx, int tid, int lane, int wave) {
    LAS float* ut = (LAS float*)lds;
    LAS float* pl = (LAS float*)(lds + 47 * 256 * 4);
    const int ch = tid & 255, half = tid >> 8, g = ch >> 6, w = 2 << g;
    float wcol[64];
#pragma unroll
    for (int c = 0; c < 64; ++c) wcol[c] = pw[(g * 64 + c) * 64 + (ch & 63)];
    const float psc = pscale[ch];
    const f32x4 gn = *(const f32x4*)(ong + 512 + 4 * lane);
    v4u wq[3];
#define POOL_LOAD(tile_) do { const int tok0_ = (tile_) * 32, s0_ = tok0_ % SEQ; _Pragma("unroll") for (int q = 0; q < 3; ++q) { const int idx = tid + q * NTHR, rr = idx >> 5, cq = idx & 31, r = rr - 15; \
        wq[q] = (v4u){0u, 0u, 0u, 0u}; if (idx < 47 * 32 && s0_ + r >= 0) wq[q] = *(const v4u*)(PS + (size_t)(tok0_ + r) * 512 + cq * 8); } } while (0)
    if (bx < NTOK / 32) POOL_LOAD(bx);
    for (int tile = bx; tile < NTOK / 32; tile += G) {
        const int tok0 = tile * 32, s0 = tok0 % SEQ;
#pragma unroll
        for (int q = 0; q < 3; ++q) { const int idx = tid + q * NTHR, rr = idx >> 5, cq = idx & 31; const v4u wv = wq[q];
            if (idx < 47 * 32) { LAS float* d = ut + rr * 256 + cq * 8;
                *(LAS f32x4*)d = (f32x4){bflo(wv.x), bfhi(wv.x), bflo(wv.y), bfhi(wv.y)}; *(LAS f32x4*)(d + 4) = (f32x4){bflo(wv.z), bfhi(wv.z), bflo(wv.w), bfhi(wv.w)}; } }
        if (tile + G < NTOK / 32) POOL_LOAD(tile + G);
        __syncthreads();
        { float s = 0.f; const int rr0 = half * 16 + 15;
            for (int j = 1; j < w; ++j) s += ut[(rr0 - j) * 256 + ch];
#pragma unroll 4
            for (int tt = 0; tt < 16; ++tt) { const int ti = half * 16 + tt, rr = ti + 15, pos = s0 + ti; const float cur = ut[rr * 256 + ch];
                s += cur; const int cnt = (pos + 1 < w) ? pos + 1 : w;
                pl[ti * 256 + ch] = s / (float)cnt - cur; s -= ut[(rr - w + 1) * 256 + ch]; } }
        __syncthreads();
#pragma unroll 1
        for (int tt = 0; tt < 16; ++tt) { const int ti = half * 16 + tt; const LAS f32x4* pr = (const LAS f32x4*)(pl + ti * 256 + g * 64);
            float acc = 0.f;
#pragma unroll
            for (int c4 = 0; c4 < 16; ++c4) { const f32x4 v = pr[c4]; acc += (v[0] * wcol[4 * c4] + v[1] * wcol[4 * c4 + 1]) + (v[2] * wcol[4 * c4 + 2] + v[3] * wcol[4 * c4 + 3]); }
            ut[ti * 256 + ch] = acc * psc; }
        __syncthreads();
#pragma unroll
        for (int q = 0; q < 4; ++q) { const int ti = wave * 4 + q; const f32x4 v = *(const LAS f32x4*)(ut + ti * 256 + 4 * lane);
            const float ss = wave_sum((v[0] * v[0] + v[1] * v[1]) + (v[2] * v[2] + v[3] * v[3]));
            const float rstd = 1.0f / sqrtf(ss * (1.f / 256.f) + EPSN);
            u32x2 o; o.x = pk2(v[0] * rstd * gn[0], v[1] * rstd * gn[1]); o.y = pk2(v[2] * rstd * gn[2], v[3] * rstd * gn[3]);
            *(u32x2*)(MG + (size_t)(tok0 + ti) * DM + 512 + 4 * lane) = o; }
        __syncthreads();
    }
}

template <bool PASS2> __device__ __forceinline__ void phase_s5(KArgs a, int l, const bf16* PS, float* XLOC, bf16* Z, LAS unsigned char* lds, int G, int bx, int lane, int wave) {
    constexpr int XST = 132;
    LAS float* Xs = (LAS float*)(lds + wave * (16 * XST * 4));
    const int p = lane, kq = lane >> 4, ln = lane & 15;
    for (int task = bx; task < NB * 16 * 8; task += G) {
        const int b = task >> 7, g = (task >> 3) & 15, c = (task & 7) * 8 + wave;
        const size_t tok_c = (size_t)b * SEQ + c * 64;
        const float a_re = a->in[8][(l * 16 + g) * 64 + p], a_im = a->in[9][(l * 16 + g) * 64 + p], ldt = a->in[10][l * 16 + g];
        u32x2 uraw[4];
#pragma unroll
        for (int sub = 0; sub < 4; ++sub) uraw[sub] = *(const u32x2*)(PS + (tok_c + sub * 16 + ln) * 512 + 256 + g * 16 + 4 * kq);
        float braw[4][4], biaw[4][4];
#pragma unroll
        for (int q = 0; q < 4; ++q)
#pragma unroll
            for (int ks = 0; ks < 4; ++ks) { const size_t bi = ((size_t)((l * 16 + g) * 64 + 16 * q + ln)) * 16 + 4 * kq + ks; braw[q][ks] = a->in[11][bi]; biaw[q][ks] = a->in[12][bi]; }
        bf16x8 cfrag[4]; float dsk = 0.f; unsigned short usk[16];
        if (PASS2) {
#pragma unroll
            for (int s4 = 0; s4 < 4; ++s4) { float cv[8];
#pragma unroll
                for (int j = 0; j < 8; ++j) { const int k = 32 * s4 + 8 * kq + j, pp = k & 63; const size_t ci = ((size_t)((l * 16 + g) * 16 + ln)) * 64 + pp; cv[j] = (s4 < 2) ? a->in[13][ci] : -a->in[14][ci]; }
                const v4u pk = {pk2(cv[0], cv[1]), pk2(cv[2], cv[3]), pk2(cv[4], cv[5]), pk2(cv[6], cv[7])}; cfrag[s4] = __builtin_bit_cast(bf16x8, pk); }
            dsk = a->in[15][l * 256 + g * 16 + ln];
#pragma unroll
            for (int i = 0; i < 16; ++i) usk[i] = PS[(tok_c + (i >> 2) * 16 + 4 * kq + (i & 3)) * 512 + 256 + g * 16 + ln];
        }
        const float dt = expf(ldt);
        float abr, abi, fr, fi;
        { const float xx = a_re * dt, yy = a_im * dt; const float ex = expf(xx); float sn, cs; sincosf(yy, &sn, &cs);
          abr = ex * cs; abi = ex * sn;
          const float sh = sinf(0.5f * yy); const float er = expm1f(xx) * cs - 2.f * sh * sh, ei = abi;
          const float den = a_re * a_re + a_im * a_im; fr = (er * a_re + ei * a_im) / den; fi = (ei * a_re - er * a_im) / den; }
        float bfrag[8][4];
#pragma unroll
        for (int q = 0; q < 4; ++q) { const float frq = __shfl(fr, 16 * q + ln), fiq = __shfl(fi, 16 * q + ln);
#pragma unroll
            for (int ks = 0; ks < 4; ++ks) { bfrag[q][ks] = frq * braw[q][ks] - fiq * biaw[q][ks]; bfrag[4 + q][ks] = frq * biaw[q][ks] + fiq * braw[q][ks]; } }
        float xr = 0.f, xi = 0.f;
        if (PASS2) {
            float pr = abr, pi = abi;
#pragma unroll
            for (int q = 0; q < 6; ++q) { const float nr = pr * pr - pi * pi, ni = 2.f * pr * pi; pr = nr; pi = ni; }
            const float* xl = XLOC + ((size_t)(b * 16 + g) * 64) * 128 + p;
            int j = 0;
#pragma unroll 1
            for (; j + 16 <= c; j += 16) { float lr[16], li[16];
#pragma unroll
                for (int q = 0; q < 16; ++q) { lr[q] = xl[(size_t)(j + q) * 128]; li[q] = xl[(size_t)(j + q) * 128 + 64]; }
#pragma unroll
                for (int q = 0; q < 16; ++q) { const float nr = pr * xr - pi * xi + lr[q], ni = pr * xi + pi * xr + li[q]; xr = nr; xi = ni; } }
            { float lr[16], li[16];
#pragma unroll
                for (int q = 0; q < 16; ++q) { const int jj = (j + q < c) ? j + q : 0; lr[q] = xl[(size_t)jj * 128]; li[q] = xl[(size_t)jj * 128 + 64]; }
#pragma unroll
                for (int q = 0; q < 16; ++q) if (j + q < c) { const float nr = pr * xr - pi * xi + lr[q], ni = pr * xi + pi * xr + li[q]; xr = nr; xi = ni; } }
        }
#pragma unroll
        for (int sub = 0; sub < 4; ++sub) {
            const size_t tokb = tok_c + sub * 16;
            const float ua[4] = {bflo(uraw[sub].x), bfhi(uraw[sub].x), bflo(uraw[sub].y), bfhi(uraw[sub].y)};
#pragma unroll
            for (int nb = 0; nb < 8; ++nb) { f32x4 acc = {0.f, 0.f, 0.f, 0.f};
#pragma unroll
                for (int ks = 0; ks < 4; ++ks) acc = __builtin_amdgcn_mfma_f32_16x16x4f32(ua[ks], bfrag[nb][ks], acc, 0, 0, 0);
#pragma unroll
                for (int r = 0; r < 4; ++r) Xs[(4 * kq + r) * XST + 16 * nb + ln] = acc[r]; }
            float bur[16], bui[16];
#pragma unroll
            for (int i = 0; i < 16; ++i) { bur[i] = Xs[i * XST + p]; bui[i] = Xs[i * XST + 64 + p]; }
#pragma unroll
            for (int i = 0; i < 16; ++i) { const float nr = abr * xr - abi * xi + bur[i], ni = abr * xi + abi * xr + bui[i]; xr = nr; xi = ni;
                if (PASS2) { Xs[i * XST + p] = xr; Xs[i * XST + 64 + p] = xi; } }
            if (PASS2) {
                f32x4 y0 = {0.f, 0.f, 0.f, 0.f};
                asm volatile("" ::: "memory");
#pragma unroll
                for (int s4 = 0; s4 < 4; ++s4) { const f32x4 x0 = *(const LAS f32x4*)(Xs + ln * XST + 32 * s4 + 8 * kq), x1 = *(const LAS f32x4*)(Xs + ln * XST + 32 * s4 + 8 * kq + 4);
                    const v4u pk = {pk2(x0[0], x0[1]), pk2(x0[2], x0[3]), pk2(x1[0], x1[1]), pk2(x1[2], x1[3])};
                    y0 = __builtin_amdgcn_mfma_f32_16x16x32_bf16(__builtin_bit_cast(bf16x8, pk), cfrag[s4], y0, 0, 0, 0); }
                asm volatile("" ::: "memory");
#pragma unroll
                for (int r = 0; r < 4; ++r) { const size_t tk = tokb + 4 * kq + r; const float uv = bf2f(usk[sub * 4 + r]);
                    const float y = y0[r] + dsk * uv; Z[tk * 256 + g * 16 + ln] = (bf16)f2bf(gelu_tanh(y)); }
            }
        }
        if (!PASS2) { float* xl = XLOC + ((size_t)((b * 16 + g) * 64 + c)) * 128 + p; xl[0] = xr; xl[64] = xi; }
    }
}

__device__ __forceinline__ void phase_glu(const bf16* Z, const bf16* WG, const float* gb, const float* ong, bf16* MG, LAS unsigned char* lds, int G, int bx, int vcu, int tid, int lane, int wave) {
    LAS unsigned char* zt = lds;
    LAS float* ssq = (LAS float*)(lds + 64 * 528);
    LAS float* rs = ssq + 64 * 8;
    const int n = 32 * wave + (lane & 31), hs = lane >> 5;
    const float bn = gb[n], gnn = ong[768 + n];
    for (int tile = bx; tile < NTOK / 64; tile += G) {
        const size_t tok0 = (size_t)tile * 64;
        for (int idx = tid; idx < 64 * 32; idx += NTHR) { const int r = idx >> 5, cq = idx & 31; *(LAS v4u*)(zt + r * 528 + cq * 16) = *(const v4u*)(Z + (tok0 + r) * 256 + cq * 8); }
        __syncthreads();
        f32x16 acc[2]; acc[0] = f32x16{}; acc[1] = f32x16{};
#pragma unroll
        for (int ks = 0; ks < 16; ++ks) { const bf16x8 bw = *(const bf16x8*)(WG + (size_t)n * 256 + ks * 16 + 8 * hs);
#pragma unroll
            for (int mb = 0; mb < 2; ++mb) { const bf16x8 az = *(const LAS bf16x8*)(zt + (mb * 32 + (lane & 31)) * 528 + (ks * 16 + 8 * hs) * 2);
                acc[mb] = __builtin_amdgcn_mfma_f32_32x32x16_bf16(az, bw, acc[mb], 0, 0, 0); } }
        float val[32], sq[32];
#pragma unroll
        for (int mb = 0; mb < 2; ++mb)
#pragma unroll
            for (int r = 0; r < 16; ++r) { const int m = mb * 32 + (r & 3) + 8 * (r >> 2) + 4 * hs; const float z = bf2f(*(const LAS unsigned short*)(zt + m * 528 + n * 2));
                const float v = z / (1.f + __expf(-(acc[mb][r] + bn))); val[mb * 16 + r] = v; sq[mb * 16 + r] = v * v; }
        const float tot = bfly_reduce<32, 16>(sq, lane);
        { const int id = lane & 31, mb = id >> 4, r = id & 15, m = mb * 32 + (r & 3) + 8 * (r >> 2) + 4 * hs; ssq[m * 8 + wave] = tot; }
        __syncthreads();
        if (tid < 64) { float s = 0.f;
#pragma unroll
            for (int w8 = 0; w8 < 8; ++w8) s += ssq[tid * 8 + w8];
            rs[tid] = 1.0f / sqrtf(s * (1.f / 256.f) + EPSN); }
        __syncthreads();
#pragma unroll
        for (int mb = 0; mb < 2; ++mb)
#pragma unroll
            for (int r = 0; r < 16; ++r) { const int m = mb * 32 + (r & 3) + 8 * (r >> 2) + 4 * hs;
                MG[(tok0 + m) * DM + 768 + n] = (bf16)f2bf(val[mb * 16 + r] * rs[m] * gnn); }
        __syncthreads();
    }
    const int gw = vcu * NWAVES + wave, NGW = G * NWAVES;
    float g8[8];
#pragma unroll
    for (int j = 0; j < 8; ++j) g8[j] = ong[8 * lane + j];
    for (int row = gw; row < NTOK; row += NGW) {
        bf16* pp = MG + (size_t)row * DM + 8 * lane;
        const v4u w = *(const v4u*)pp; float f[8] = {bflo(w.x), bfhi(w.x), bflo(w.y), bfhi(w.y), bflo(w.z), bfhi(w.z), bflo(w.w), bfhi(w.w)};
        float s = 0.f;
#pragma unroll
        for (int j = 0; j < 8; ++j) s += f[j] * f[j];
        const float rstd = 1.0f / sqrtf(wave_sum(s) * (1.f / 512.f) + EPSN);
        v4u o; o.x = pk2(f[0] * rstd * g8[0], f[1] * rstd * g8[1]); o.y = pk2(f[2] * rstd * g8[2], f[3] * rstd * g8[3]);
        o.z = pk2(f[4] * rstd * g8[4], f[5] * rstd * g8[5]); o.w = pk2(f[6] * rstd * g8[6], f[7] * rstd * g8[7]); *(v4u*)pp = o;
    }
}

__device__ __forceinline__ void ins16(float (&top)[16], float x) {
#pragma unroll
    for (int i = 15; i >= 1; --i) top[i] = __builtin_amdgcn_fmed3f(top[i - 1], top[i], x);
    top[0] = fmaxf(top[0], x);
}
__device__ __forceinline__ float opq(float x) { asm("" : "+v"(x)); return x; }
__device__ __forceinline__ float tagf(float s, unsigned id, unsigned mask) { return __uint_as_float((__float_as_uint(s) & ~mask) | id); }
__device__ __forceinline__ void phase_select(const bf16* PQ, const bf16* KEYS, int* IDX, float* GATE, LAS unsigned char* lds, int G, int vcu, int tid, int lane, int wave) {
    constexpr int KROW = 272, KEYB = 2 * 128 * KROW;
    LAS unsigned* ids = (LAS unsigned*)(lds + KEYB + wave * 4096);
    const int tl = lane & 31, hs = lane >> 5;
    const float NEG = -__builtin_inff();
    const int nslot = (G >= 8) ? G / 8 : 1;
    for (int h = vcu % 8; h < 8; h += (G >= 8 ? 8 : G)) {
        __syncthreads();
        for (int idx = tid; idx < 2 * 128 * 16; idx += NTHR) { const int row = idx >> 4, cq = idx & 15;
            *(LAS v4u*)(lds + row * KROW + cq * 16) = *(const v4u*)((const char*)(KEYS + (size_t)h * 256 * 128) + (unsigned)(row * 256 + cq * 16)); }
        __syncthreads();
        const int slot = (G >= 8) ? vcu / 8 : 0;
        bf16x8 bq[2][8];
        int tb = slot * 8 + wave;
        if (tb < NTOK / 32) {
#pragma unroll
            for (int ks = 0; ks < 8; ++ks) bq[0][ks] = *(const bf16x8*)((const char*)(PQ + (size_t)tb * 32 * PQW + h * 256) + (unsigned)((tl * PQW + 8 * hs + ks * 16) * 2));
        }
#pragma unroll 1
        for (; tb < NTOK / 32; tb += 8 * nslot) {
            const size_t tok = (size_t)tb * 32 + tl;
            float t1[16], t2[16];
#pragma unroll
            for (int half = 0; half < 2; ++half) {
                { const int ntb = (half == 0) ? tb : tb + 8 * nslot; const int ntbc = (ntb < NTOK / 32) ? ntb : tb;
                  const bf16* qn = PQ + (size_t)ntbc * 32 * PQW + h * 256 + (half == 0 ? 128 : 0);
#pragma unroll
                  for (int ks = 0; ks < 8; ++ks) bq[half ^ 1][ks] = *(const bf16x8*)((const char*)qn + (unsigned)((tl * PQW + 8 * hs + ks * 16) * 2)); }
                f32x16 acc[4]; acc[0] = f32x16{}; acc[1] = f32x16{}; acc[2] = f32x16{}; acc[3] = f32x16{};
                const LAS unsigned char* kp = lds + (half * 128 + tl) * KROW + 16 * hs;
#pragma unroll
                for (int ks = 0; ks < 8; ++ks)
#pragma unroll
                    for (int kb = 0; kb < 4; ++kb) { const bf16x8 ak = *(const LAS bf16x8*)(kp + kb * 32 * KROW + ks * 32); acc[kb] = __builtin_amdgcn_mfma_f32_32x32x16_bf16(ak, bq[half][ks], acc[kb], 0, 0, 0); }
                float top[16], tb_[16], tc_[16], td_[16];
#pragma unroll
                for (int r = 0; r < 16; ++r) { const unsigned id = (unsigned)((r & 3) + 8 * (r >> 2) + 4 * hs);
                    top[r] = tagf(acc[0][r], id, 127u); tb_[r] = tagf(acc[1][r], 32u + id, 127u); tc_[r] = tagf(acc[2][r], 64u + id, 127u); td_[r] = tagf(acc[3][r], 96u + id, 127u); }
                sort16_desc(top); sort16_desc(tb_); sort16_desc(tc_); sort16_desc(td_);
                merge16_desc(top, tb_); merge16_desc(tc_, td_); merge16_desc(top, tc_);
                float oth[16];
#pragma unroll
                for (int i = 0; i < 16; ++i) oth[i] = __shfl_xor(top[i], 32);
                merge16_desc(top, oth);
#pragma unroll
                for (int i = 0; i < 16; ++i) { if (half == 0) t1[i] = top[i]; else t2[i] = top[i]; }
            }
#pragma unroll
            for (int i = 0; i < 16; ++i) ids[(tl * 2 + hs) * 16 + i] = __float_as_uint(hs ? opq(t2[i]) : opq(t1[i])) & 127u;
            float best[16];
#pragma unroll
            for (int i = 0; i < 16; ++i) best[i] = NEG;
#define CAND(a0, b0, a1, b1) { const float s0_ = opq(t1[a0] + t2[b0]), s1_ = opq(t1[a1] + t2[b1]); ins16(best, hs ? tagf(s1_, (unsigned)((a1) * 16 + (b1)), 255u) : tagf(s0_, (unsigned)((a0) * 16 + (b0)), 255u)); }
            CAND_LIST
#undef CAND
            { float oth[16];
#pragma unroll
              for (int i = 0; i < 16; ++i) oth[i] = __shfl_xor(best[i], 32);
              merge16_desc(best, oth); }
            float e[16], den = 0.f;
#pragma unroll
            for (int i = 0; i < 16; ++i) { e[i] = __expf(best[i] - best[0]); den += e[i]; }
            const float rden = 1.f / den;
            int ex[8]; float gt[8];
#pragma unroll
            for (int j = 0; j < 8; ++j) { const float bj = hs ? opq(best[8 + j]) : opq(best[j]); const unsigned id = __float_as_uint(bj) & 255u;
                const unsigned i1 = ids[(tl * 2 + 0) * 16 + (id >> 4)], i2 = ids[(tl * 2 + 1) * 16 + (id & 15u)];
                ex[j] = (int)(i1 * 128u + i2); gt[j] = (hs ? opq(e[8 + j]) : opq(e[j])) * rden; }
            int* ip = IDX + tok * 128 + h * 16 + hs * 8; float* gp = GATE + tok * 128 + h * 16 + hs * 8;
            *(v4u*)ip = (v4u){(unsigned)ex[0], (unsigned)ex[1], (unsigned)ex[2], (unsigned)ex[3]}; *(v4u*)(ip + 4) = (v4u){(unsigned)ex[4], (unsigned)ex[5], (unsigned)ex[6], (unsigned)ex[7]};
            *(f32x4*)gp = (f32x4){gt[0], gt[1], gt[2], gt[3]}; *(f32x4*)(gp + 4) = (f32x4){gt[4], gt[5], gt[6], gt[7]};
        }
    }
}

constexpr int GCH = 64;
constexpr int CW_Q = 8192;
template <int CTRL> __device__ __forceinline__ float dpp_mov(float v) { return __builtin_bit_cast(float, __builtin_amdgcn_update_dpp(0, __builtin_bit_cast(int, v), CTRL, 0xF, 0xF, true)); }
__device__ __forceinline__ float sum8(float s) {
    s += dpp_mov<0xB1>(s); s += dpp_mov<0x4E>(s); s += dpp_mov<0x141>(s); return s;
}
__device__ __forceinline__ void phase_gather_u(const unsigned char* XN8, const int* IDX, const unsigned char* U, float* PART, unsigned* queue, int lane, unsigned imask = 0xffffffffu) {
    const unsigned xcc = xb_xcc_id() & 7u; const int g = lane >> 3, j = lane & 7;
#pragma unroll 1
    for (unsigned sx = 0; sx < 8; ++sx) { const unsigned x = (xcc + sx) & 7u; unsigned* q = queue + x * 64;
        const unsigned char* Ux = U + (size_t)x * NEXP * 128; const unsigned jo = (unsigned)j * 16u, lane4 = (unsigned)lane * 4u; const unsigned char* Hx = XN8 + x * 128 + j * 16; const int* Ig = IDX + 16 * g;
#pragma unroll 1
        for (;;) {
            unsigned c = 0; if (lane == 0) c = __hip_atomic_fetch_add(q, 1u, __ATOMIC_RELAXED, __HIP_MEMORY_SCOPE_AGENT);
            c = (unsigned)__builtin_amdgcn_readfirstlane((int)c); if (c >= (unsigned)(NTOK / GCH)) break;
            const size_t tb = (size_t)c * GCH;
            v4u ix[2][4], hw[2], rw[16];
#define G1_IDX(ib, tok_) do { _Pragma("unroll") for (int q4 = 0; q4 < 4; ++q4) ix[ib][q4] = *(const v4u*)(Ig + (tok_) * 128 + 4 * q4) & imask; } while (0)
#define G1_AUX(ab, tok_) do { hw[ab] = *(const v4u*)(Hx + (tok_) * DM); } while (0)
#define G1_TOKEN(p, tt_) do { G1_IDX(p, tb + (((tt_) + 2 < GCH) ? (tt_) + 2 : (tt_))); G1_AUX((p) ^ 1, tb + (((tt_) + 1 < GCH) ? (tt_) + 1 : (tt_))); \
            const v4u hq_ = hw[p]; int r0 = 0, r1 = 0; \
            _Pragma("unroll") for (int i = 0; i < 16; ++i) { const v4u rv_ = rw[i]; \
                rw[i] = *(const v4u*)(Ux + (ix[(p) ^ 1][i >> 2][i & 3] * 128u + jo)); \
                int s = __builtin_amdgcn_sdot4((int)hq_[0], (int)rv_[0], 0, false); s = __builtin_amdgcn_sdot4((int)hq_[1], (int)rv_[1], s, false); \
                s = __builtin_amdgcn_sdot4((int)hq_[2], (int)rv_[2], s, false); s = __builtin_amdgcn_sdot4((int)hq_[3], (int)rv_[3], s, false); \
                s += __builtin_amdgcn_update_dpp(0, s, 0xB1, 0xF, 0xF, true); s += __builtin_amdgcn_update_dpp(0, s, 0x4E, 0xF, 0xF, true); s += __builtin_amdgcn_update_dpp(0, s, 0x141, 0xF, 0xF, true); \
                if (i < 8) r0 = ((i & 7) == j) ? s : r0; else r1 = ((i & 7) == j) ? s : r1; } \
            unsigned* pp = (unsigned*)PART + ((size_t)x * NTOK + tb + (tt_)) * 64; *(unsigned*)((char*)pp + lane4) = pk2((float)r0, (float)r1);     \
            } while (0)
            G1_IDX(0, tb); G1_IDX(1, tb + 1); G1_AUX(0, tb);
#pragma unroll
            for (int i = 0; i < 16; ++i) rw[i] = *(const v4u*)(Ux + (ix[0][i >> 2][i & 3] * 128u + jo));
#pragma unroll 1
            for (int tt = 0; tt < GCH; tt += 2) { G1_TOKEN(0, tt); G1_TOKEN(1, tt + 1); }
#undef G1_IDX
#undef G1_AUX
#undef G1_TOKEN
        }
    }
}
__device__ __forceinline__ void phase_gather_act(const float* PART, const float* GATE, const float* HSC, float* ACT, int G, int vcu, int tid) {
    const size_t gt = (size_t)vcu * NTHR + tid, NGT = (size_t)G * NTHR;
    for (size_t e4 = gt; e4 < (size_t)NTOK * 32; e4 += NGT) { const size_t tok = e4 >> 5; const int p = (int)(e4 & 31) * 4;
        f32x4 s = {0.f, 0.f, 0.f, 0.f};
#pragma unroll
        for (int x = 0; x < 8; ++x) { const v4u w = *(const v4u*)((const unsigned*)PART + ((size_t)x * NTOK + tok) * 64 + (p & 63));
            if (p < 64) { s[0] += bflo(w.x); s[1] += bflo(w.y); s[2] += bflo(w.z); s[3] += bflo(w.w); } else { s[0] += bfhi(w.x); s[1] += bfhi(w.y); s[2] += bfhi(w.z); s[3] += bfhi(w.w); } }
        const int k = (p < 64) ? 16 * (p >> 3) + (p & 7) : 16 * ((p - 64) >> 3) + 8 + (p & 7);
        const f32x4 gv = *(const f32x4*)(GATE + tok * 128 + k);
        f32x4 o;
        const float ds = HSC[tok] * (1.f / U8_SCALE);
#pragma unroll
        for (int i = 0; i < 4; ++i) { const _Float16 ah = (_Float16)(gv[i] * gelu_tanh(s[i] * ds) * (ACT_SCALE / V8_SCALE)); const h16x2 a2 = {ah, ah}; o[i] = __builtin_bit_cast(float, a2); }
        *(f32x4*)(ACT + e4 * 4) = o; }
}
template <int VAR> __device__ __forceinline__ void phase_gather_v(const float* ACT, const int* IDX, const unsigned char* V, float* out, unsigned* queue, int lane) {
    const unsigned xcc = xb_xcc_id() & 7u; const int g = lane >> 3, j = lane & 7;
    typedef float f32x2v __attribute__((ext_vector_type(2)));
#pragma unroll 1
    for (unsigned sx = 0; sx < 8; ++sx) { const unsigned x = (xcc + sx) & 7u; unsigned* q = queue + x * 64;
        const unsigned char* Vx = V + (size_t)x * NEXP * 128; const unsigned jo = (unsigned)j * 16u; const int* Ig = IDX + 16 * g; float* Ob = out + x * 128; const unsigned lo = (unsigned)(16 * j + 2 * g) * 4u;
#pragma unroll 1
        for (;;) {
            unsigned c = 0; if (lane == 0) c = __hip_atomic_fetch_add(q, 1u, __ATOMIC_RELAXED, __HIP_MEMORY_SCOPE_AGENT);
            c = (unsigned)__builtin_amdgcn_readfirstlane((int)c); if (c >= (unsigned)(NTOK / GCH)) break;
            const size_t tb = (size_t)c * GCH;
            v4u ix[2][4], rw[16]; float a0[2], a1[2]; f32x2v ov[2]; const int bsel = (lane & ~7) * 4; const unsigned lane4 = (unsigned)lane * 4u;
#define G3_IDX(ib, tok_) do { _Pragma("unroll") for (int q4 = 0; q4 < 4; ++q4) ix[ib][q4] = *(const v4u*)(Ig + (tok_) * 128 + 4 * q4); } while (0)
#define G3_AUX(ab, tok_) do { if (VAR == 4) { a0[ab] = 1.f; a1[ab] = 2.f; } else { a0[ab] = *(const float*)((const char*)(ACT + (tok_) * 128) + lane4); a1[ab] = *(const float*)((const char*)(ACT + (tok_) * 128 + 64) + lane4); } if (VAR == 3 || VAR == 4) ov[ab] = (f32x2v){0.f, 0.f}; else { unsigned lo_ = lo; asm volatile("" : "+v"(lo_)); ov[ab] = *(const f32x2v*)((const char*)(Ob + (tok_) * DM) + lo_); } } while (0)
#define G3_TOKEN(p, tt_) do { G3_IDX(p, tb + (((tt_) + 2 < GCH) ? (tt_) + 2 : (tt_))); G3_AUX((p) ^ 1, tb + (((tt_) + 1 < GCH) ? (tt_) + 1 : (tt_))); \
            h16x2 hacc[8]; \
            _Pragma("unroll") for (int i = 0; i < 8; ++i) hacc[i] = (h16x2){(_Float16)0.f, (_Float16)0.f}; \
            _Pragma("unroll") for (int i = 0; i < 16; ++i) { const v4u rv_ = rw[i]; \
                if (VAR == 8) asm volatile("s_waitcnt vmcnt(12)" ::: "memory"); \
                rw[i] = *(const v4u*)(Vx + (ix[(p) ^ 1][i >> 2][i & 3] * 128u + jo)); \
                const float a = (VAR == 6) ? ((i < 8) ? a0[p] : a1[p]) : __builtin_bit_cast(float, __builtin_amdgcn_ds_bpermute(bsel + 4 * (i & 7), __builtin_bit_cast(int, (i < 8) ? a0[p] : a1[p])));   \
                const h16x2 a2 = __builtin_bit_cast(h16x2, a); \
                _Pragma("unroll") for (int q4 = 0; q4 < 4; ++q4) { const int w = (int)rv_[q4]; \
                    if (VAR == 1) { hacc[2 * q4] = __builtin_elementwise_fma(__builtin_bit_cast(h16x2, w), a2, hacc[2 * q4]); } else { \
                    hacc[2 * q4] = __builtin_elementwise_fma(cvt8h<false>(w), a2, hacc[2 * q4]); \
                    hacc[2 * q4 + 1] = __builtin_elementwise_fma(cvt8h<true>(w), a2, hacc[2 * q4 + 1]); } } } \
            float acc[16]; \
            _Pragma("unroll") for (int i = 0; i < 8; ++i) { acc[2 * i] = (float)hacc[i].x; acc[2 * i + 1] = (float)hacc[i].y; } \
            int s_ = 32; \
            if (VAR == 5) { _Pragma("unroll") for (int i = 2; i < 16; ++i) acc[i & 1] += acc[i]; } else \
            _Pragma("unroll") for (int cnt = 16; cnt > 2; cnt >>= 1) { const bool up = (lane & s_) != 0; \
                _Pragma("unroll") for (int i = 0; i < cnt / 2; ++i) { const float a = acc[i], b = acc[i + cnt / 2]; const float send = up ? a : b, keep = up ? b : a; acc[i] = keep + __shfl_xor(send, s_); } \
                s_ >>= 1; } \
            f32x2v o = ov[p]; o[0] += acc[0] * (1.f / ACT_SCALE); o[1] += acc[1] * (1.f / ACT_SCALE); \
            { unsigned lo_ = lo; asm volatile("" : "+v"(lo_)); *(f32x2v*)((char*)(Ob + (((VAR == 3 || VAR == 4) ? 0 : tb) + (tt_)) * DM) + lo_) = o; } \
            } while (0)
            G3_IDX(0, tb); G3_IDX(1, tb + 1); G3_AUX(0, tb);
#pragma unroll
            for (int i = 0; i < 16; ++i) rw[i] = *(const v4u*)(Vx + (ix[0][i >> 2][i & 3] * 128u + jo));
#pragma unroll 1
            for (int tt = 0; tt < GCH; tt += 2) { G3_TOKEN(0, tt); G3_TOKEN(1, tt + 1); }
#undef G3_IDX
#undef G3_AUX
#undef G3_TOKEN
        }
    }
}

__device__ __forceinline__ void phase_gather_naive(const bf16* XN, const int* IDX, const float* GATE, const float* U, const float* V, float* out, int G, int vcu, int lane, int wave) {
    const int gw = vcu * NWAVES + wave, NGW = G * NWAVES;
    for (int tok = gw; tok < NTOK; tok += NGW) {
        float hv[16], acc[16];
#pragma unroll
        for (int j = 0; j < 16; ++j) { hv[j] = bf2f(XN[(size_t)tok * DM + lane + 64 * j]); acc[j] = 0.f; }
        for (int k = 0; k < 128; ++k) { const int e = IDX[(size_t)tok * 128 + k]; const float g = GATE[(size_t)tok * 128 + k];
            float s = 0.f;
#pragma unroll
            for (int j = 0; j < 16; ++j) s += hv[j] * U[(size_t)e * DM + lane + 64 * j];
            s = wave_sum(s); const float a = g * gelu_tanh(s);
#pragma unroll
            for (int j = 0; j < 16; ++j) acc[j] += a * V[(size_t)e * DM + lane + 64 * j]; }
#pragma unroll
        for (int j = 0; j < 16; ++j) out[(size_t)tok * DM + lane + 64 * j] += acc[j];
    }
}
constexpr int PH_PER_LAYER = 15, N_PHASES = 1 + 2 * PH_PER_LAYER;
__device__ __forceinline__ KArgs kargs() { KArgs p = (KArgs)__builtin_amdgcn_kernarg_segment_ptr(); asm volatile("" : "+s"(p)); return p; }
__global__ void __launch_bounds__(NTHR, 2) mega_fwd(Args a_unused) {
    extern __shared__ __attribute__((aligned(16))) unsigned char lds_raw[];
    LAS unsigned char* lds = (LAS unsigned char*)lds_raw;
    volatile LAS unsigned* MISC = (volatile LAS unsigned*)(lds + MISC_OFF);
    const int tid0 = threadIdx.x;
    for (int u = tid0; u < (LDS_BYTES - LDSCTL_OFF) / 4; u += NTHR) ((LAS unsigned*)(lds + LDSCTL_OFF))[u] = 0u;
    __syncthreads();
    { const unsigned hw = (unsigned)__builtin_amdgcn_s_getreg((6 << 11) | 4); if ((tid0 & 63) == 0) *(volatile LAS int*)(lds + OTID_LDS_OFF + 4 * (hw & 63u)) = tid0 >> 6; }
    __syncthreads();
    XcdBarrier bar; { KArgs ka = kargs(); unsigned char* ws0 = ka->ws; bar.bar = (unsigned*)(ws0 + WS_CTL) + CW_BAR; bar.x = 0; bar.st = nullptr;
      if (ka->use_bar) bar = xcd_barrier_post((unsigned*)(ws0 + WS_CTL) + CW_BAR, MISC + 8); }
    const int ph_lo = kargs()->ph_lo, ph_hi = kargs()->ph_hi;
#define TLW const int tid = otid(), lane = tid & 63, wave = __builtin_amdgcn_readfirstlane(tid >> 6); (void)tid; (void)lane; (void)wave;
#pragma unroll 1
    for (int pc = ph_lo; pc < ph_hi + (DUP_PH >= 0 ? 1 : 0); ++pc) {
        const int ph = (DUP_PH >= 0 && pc > DUP_PH) ? pc - 1 : pc;
        unsigned long long tph0_ = 0; if (TIME_PH >= 0 && (pc == TIME_PH || TIME_PH == 99)) tph0_ = __builtin_amdgcn_s_memrealtime();
        KArgs a = kargs(); unsigned char* ws = a->ws;
        int G = gridDim.x, bx = blockIdx.x; asm volatile("" : "+s"(G), "+s"(bx)); const int vcu = (G % 8 == 0) ? (bx % 8) * (G / 8) + bx / 8 : bx;
        bf16* const XN = (bf16*)(ws + WS_XN); bf16* const Pq = (bf16*)(ws + WS_P); bf16* const Pk = Pq + (size_t)NTOK * 512; bf16* const Pv = Pk + (size_t)NTOK * 512; bf16* const Ps = Pv + (size_t)NTOK * 512;
        bf16* const MG = (bf16*)(ws + WS_MG); float* const CB = (float*)(ws + WS_CB); float* const XLOC = (float*)(ws + WS_XLOC); bf16* const Z = (bf16*)(ws + WS_Z);
        int* const IDX = (int*)(ws + WS_IDX); float* const GATE = (float*)(ws + WS_GATE);
        if (ph == 0) { TLW if (PH_MASK & 1u) phase_prep(a, lds, G, vcu, tid, lane, wave); }
        else {
            const int l = (ph - 1) / PH_PER_LAYER, sub = (ph - 1) % PH_PER_LAYER;
            const float* xin = (l == 0) ? a->in[0] : a->out;
            switch (sub) {
            case 0: if (PH_MASK & (1u << 1)) { TLW phase_rownorm<true>(xin, a->in[1] + l * DM, XN, (const float*)(ws + WS_WF) + l * 8 * 1024, a->in[3] + l * 8, CB, G, vcu, lane, wave); } break;
            case 1: if (PH_MASK & (1u << 2)) { TLW
                { float* CBm = CB; const int gw_ = vcu * NWAVES + wave; if (gw_ < NB * NH) phase_cumsum(CBm + (size_t)gw_ * SEQ, lane); }
                pg8::Gemm g{XN, (const bf16*)(ws + WS_WIN) + (size_t)l * 2048 * 1024, NTOK, 2048, 1024}; pg8::StaticOrder S; S.init(NTOK, 2048, G, bx);
                pg8::EpiQKVN E{Pq, (size_t)NTOK * 512, a->in[4] + l * 64, a->in[5] + l * 64, (PG8_LAS float*)(lds + EPIX_OFF), EPSN, 0.125f * LOG2E};
                pg8::gemm_phase<pg8::EpiQKVN, pg8::StaticOrder, true, true>(lds, g, S, E); } break;
            case 2: break;
            case 5: if (PH_MASK & (1u << 4)) { TLW { const float gq = wave_max(fabsf(a->in[4][l * 64 + lane])), gk = wave_max(fabsf(a->in[5][l * 64 + lane]));
                const float qkb = 8.f * gq * gk * LOG2E * 1.02f + 0.25f;
                const attn_body::AttnTensors AT{(const attn_body::bf16*)Pq, (const attn_body::bf16*)Pk, (const attn_body::bf16*)Pv, (attn_body::bf16*)MG, CB, qkb};
                attn_body::attn_phase_q<ATT_SKIP>((char*)lds_raw, AT, (unsigned*)(ws + WS_CTL) + CW_AQ + l * 512); } } break;
            case 3: if (PH_MASK & (1u << 5)) { TLW phase_pool(Ps, a->in[6] + (size_t)l * 4 * 64 * 64, a->in[7] + l * 256, a->in[18] + l * DM, MG, lds, G, bx, tid, lane, wave); } break;
            case 4: if (PH_MASK & (1u << 6)) { TLW phase_s5<false>(a, l, Ps, XLOC, Z, lds, G, bx, lane, wave); } break;
            case 6: if (PH_MASK & (1u << 7)) { TLW phase_s5<true>(a, l, Ps, XLOC, Z, lds, G, bx, lane, wave); } break;
            case 7: if (PH_MASK & (1u << 8)) { TLW phase_glu(Z, (const bf16*)(ws + WS_WGLU) + (size_t)l * 256 * 256, a->in[17] + l * 256, a->in[18] + l * DM, MG, lds, G, bx, vcu, tid, lane, wave); } break;
            case 8: if (PH_MASK & (1u << 9)) { pg8::Gemm g{MG, (const bf16*)(ws + WS_WOUT) + (size_t)l * 1024 * 1024, NTOK, 1024, 1024}; pg8::StaticOrder S; S.init(NTOK, 1024, G, bx);
                pg8::EpiResF32 E{xin, a->out, DM};
                pg8::gemm_phase<pg8::EpiResF32, pg8::StaticOrder, true, true>(lds, g, S, E); } break;
            case 9: if (PH_MASK & (1u << 10)) { TLW phase_rownorm<false>(a->out, a->in[20] + l * DM, XN, nullptr, nullptr, nullptr, G, vcu, lane, wave, ws + WS_XN8, (float*)(ws + WS_HSC)); } break;
            case 10: if (PH_MASK & (1u << 11)) { pg8::Gemm g{XN, (const bf16*)(ws + WS_WQ) + (size_t)l * 2048 * 1024, NTOK, 2048, 1024}; pg8::StaticOrder S; S.init(NTOK, 2048, G, bx);
                pg8::EpiBf16<0> E{Pq, PQW, nullptr, 0, 0, 1.f};
                pg8::gemm_phase<pg8::EpiBf16<0>, pg8::StaticOrder, true, true>(lds, g, S, E); } break;
            case 11: if (PH_MASK & (1u << 12)) { TLW phase_select(Pq, (const bf16*)(ws + WS_KEYS) + (size_t)l * 8 * 2 * 128 * 128, IDX, GATE, lds, G, vcu, tid, lane, wave); } break;
            case 12: if (PH_MASK & (1u << 13)) { TLW phase_gather_u(ws + WS_XN8, IDX, (const unsigned char*)(ws + WS_U) + (size_t)l * NEXP * DM, (float*)(ws + WS_P), (unsigned*)(ws + WS_CTL) + CW_Q + (l * 2 + 0) * 512 + ((DUP_PH >= 0 && pc == DUP_PH + 1) ? 4096 : 0), lane, (DUP_PH >= 0 && pc == DUP_PH) ? DIAG_IMASK : 0xffffffffu); } break;
            case 13: if (PH_MASK & (1u << 14)) { TLW phase_gather_act((const float*)(ws + WS_P), GATE, (const float*)(ws + WS_HSC), (float*)(ws + WS_Z), G, vcu, tid); } break;
            default: if (PH_MASK & (1u << 15)) { TLW if (DUP_PH >= 0 && pc == DUP_PH) phase_gather_v<GV_VAR>((const float*)(ws + WS_Z), IDX, (const unsigned char*)(ws + WS_V) + (size_t)l * NEXP * DM, (float*)(ws + WS_P), (unsigned*)(ws + WS_CTL) + CW_Q + (l * 2 + 1) * 512 + 4096, lane);
                else phase_gather_v<GV_MAIN>((const float*)(ws + WS_Z), IDX, (const unsigned char*)(ws + WS_V) + (size_t)l * NEXP * DM, a->out, (unsigned*)(ws + WS_CTL) + CW_Q + (l * 2 + 1) * 512, lane); } break;
            }
        }
        const int subb_ = (ph >= 1) ? (ph - 1) % PH_PER_LAYER : -1;
        if (pc + 1 < ph_hi + (DUP_PH >= 0 ? 1 : 0) && (MK_ONE_LAUNCH == 0 || (subb_ != 2 && subb_ != 3 && subb_ != 4))) { XcdBarrier b2 = bar; asm volatile("" : "+s"(b2.bar)); xcd_barrier(b2);
            if (TIME_PH >= 0 && (pc == TIME_PH || TIME_PH == 99)) { const unsigned long long t1_ = __builtin_amdgcn_s_memrealtime(), te_ = t1_ + TIME_MUL * (t1_ - tph0_); while (__builtin_amdgcn_s_memrealtime() < te_) __builtin_amdgcn_s_sleep(8); } }
    }
}

extern "C" void kernel_launch(void* const* d_in, const int* in_sizes, int n_in, void* d_out, int out_size, void* d_ws, size_t ws_size, hipStream_t stream) {
    static int grid = 0;
    if (grid == 0) {
        if (n_in != 25 || in_sizes[0] != NTOK * DM || out_size != NTOK * DM || ws_size < WS_END) {
            fprintf(stderr, "kernel_launch: unexpected problem: n_in %d in0 %d out %d ws %zu (need %zu); nothing launched\n", n_in, n_in > 0 ? in_sizes[0] : -1, out_size, ws_size, (size_t)WS_END); grid = -1; return; }
        int dev = 0, cus = 0;
        if (hipGetDevice(&dev) != hipSuccess || hipDeviceGetAttribute(&cus, hipDeviceAttributeMultiprocessorCount, dev) != hipSuccess) { fprintf(stderr, "kernel_launch: device query failed\n"); grid = -1; return; }
        if (hipFuncSetAttribute((const void*)mega_fwd, hipFuncAttributeMaxDynamicSharedMemorySize, LDS_BYTES) != hipSuccess) { fprintf(stderr, "kernel_launch: hipFuncSetAttribute failed\n"); grid = -1; return; }
        (void)hipGetLastError();
        grid = cus;
    }
    if (grid < 0) return;
    (void)hipMemsetAsync((char*)d_ws + WS_CTL, 0, CTL_ZERO_BYTES, stream);
    Args a{};
    for (int i = 0; i < 25; ++i) a.in[i] = (const float*)d_in[i];
    a.out = (float*)d_out; a.ws = (unsigned char*)d_ws;
#if MK_ONE_LAUNCH
    a.ph_lo = 0; a.ph_hi = N_PHASES; a.use_bar = 1;
    hipLaunchKernelGGL(mega_fwd, dim3(grid), dim3(NTHR), LDS_BYTES, stream, a);
#else
    for (int ph = 0; ph < N_PHASES; ++ph) { a.ph_lo = ph; a.ph_hi = ph + 1; a.use_bar = 0;
        hipLaunchKernelGGL(mega_fwd, dim3(grid), dim3(NTHR), LDS_BYTES, stream, a); }
#endif
    const hipError_t le = hipPeekAtLastError();
    if (le != hipSuccess) fprintf(stderr, "kernel_launch: launch failed: %s\n", hipGetErrorName(le));
}
```
